# Optimizing an MI355X kernel written in HIP

```python
import math
import jax, jax.numpy as jnp
from jax import lax


D_MODEL = 1024
BATCH = 8
SEQ = 2048
DEPTH = 2
DEC_BATCH = 128
DEC_SEQ = 4
PAST_LEN = 16384
PAGE_SIZE = 128

BRANCH_WIDTH = D_MODEL // 2
HEAD_DIM = 64
N_Q_HEADS = BRANCH_WIDTH // HEAD_DIM
N_KV_HEADS = max(N_Q_HEADS // 4, 1)
GROUP = N_Q_HEADS // N_KV_HEADS
WINDOW = 128
BLOCK = WINDOW
N_BUCKETS = 32
MAX_DISTANCE = 128
SSM_WIDTH = BRANCH_WIDTH
SSM_GROUP = 16
N_SSM_GROUPS = SSM_WIDTH // SSM_GROUP
SSM_STATE = 64
LRU_WIDTH = BRANCH_WIDTH
LRU_BLOCKS = 8
LRU_BLOCK_DIM = LRU_WIDTH // LRU_BLOCKS
CONV_WIDTH = 4
LRU_C = 8.0
DN_ALPHA = (2 * DEPTH) ** 0.25
DN_BETA = (8 * DEPTH) ** -0.25
LN_EPS = 1e-5
NEG = -1e30

SPLITS = (N_Q_HEADS * HEAD_DIM, N_KV_HEADS * HEAD_DIM, N_KV_HEADS * HEAD_DIM, BRANCH_WIDTH,
          SSM_WIDTH, SSM_WIDTH, LRU_WIDTH, LRU_WIDTH, 3 * D_MODEL)
IN_COLS = sum(SPLITS)

kernel_name = 'hybrid_gated_swa_s5_rglru_deepnorm_step'

f32 = jnp.float32


def _split_points():
    pts, acc = [], 0
    for s in SPLITS[:-1]:
        acc += s
        pts.append(acc)
    return pts


def _t5_bucket(dist):
    max_exact = N_BUCKETS // 2
    d = jnp.maximum(dist, 0)
    large = max_exact + (jnp.log(jnp.maximum(d, 1).astype(f32) / max_exact)
                         / math.log(MAX_DISTANCE / max_exact) * (N_BUCKETS - max_exact)).astype(jnp.int32)
    large = jnp.minimum(large, N_BUCKETS - 1)
    return jnp.where(d < max_exact, d, large)


def _band_attend(q, k, v, key_valid, rel_bias, sinks):
    T, S = q.shape[2], k.shape[2]
    dist = jnp.arange(T)[:, None] + (S - T) - jnp.arange(S)[None, :]
    in_band = (dist >= 0) & (dist < WINDOW)
    bias = rel_bias.astype(f32)[_t5_bucket(dist)]
    bias = bias.reshape(T, S, N_KV_HEADS, GROUP).transpose(2, 3, 0, 1)
    mask = in_band[None] & key_valid[:, None, :]
    scores = jnp.einsum('bntkgd,bnskd->bnkgts', q.astype(f32), k.astype(f32)) * (HEAD_DIM ** -0.5) + bias
    scores = jnp.where(mask[None, :, None, None], scores, NEG)
    sink = sinks.astype(f32).reshape(N_KV_HEADS, GROUP)[:, :, None, None]
    m = jnp.maximum(scores.max(-1, keepdims=True), sink)
    p = jnp.exp(scores - m)
    denom = p.sum(-1, keepdims=True) + jnp.exp(sink - m)
    return jnp.einsum('bnkgts,bnskd->bntkgd', p / denom, v.astype(f32))


def _attn_prompt(q, k, v, rel_bias, sinks):
    B, T, _ = q.shape
    nb = T // BLOCK
    qb = q.reshape(B, nb, BLOCK, N_KV_HEADS, GROUP, HEAD_DIM)
    kb = k.reshape(B, nb, BLOCK, N_KV_HEADS, HEAD_DIM)
    vb = v.reshape(B, nb, BLOCK, N_KV_HEADS, HEAD_DIM)
    pad = ((0, 0), (1, 0), (0, 0), (0, 0), (0, 0))
    kk = jnp.concatenate([jnp.pad(kb, pad)[:, :-1], kb], axis=2)
    vv = jnp.concatenate([jnp.pad(vb, pad)[:, :-1], vb], axis=2)
    prev_ok = jnp.broadcast_to((jnp.arange(nb) > 0)[:, None], (nb, BLOCK))
    key_valid = jnp.concatenate([prev_ok, jnp.ones((nb, BLOCK), bool)], axis=1)
    out = _band_attend(qb, kk, vv, key_valid, rel_bias, sinks)
    return out.reshape(B, T, N_Q_HEADS * HEAD_DIM)


def _attn_sample(q, k, v, k_cache, v_cache, rel_bias, sinks):
    B, T, _ = q.shape
    kk = jnp.concatenate([k_cache, k.reshape(B, T, N_KV_HEADS, HEAD_DIM)], axis=1)
    vv = jnp.concatenate([v_cache, v.reshape(B, T, N_KV_HEADS, HEAD_DIM)], axis=1)
    key_valid = jnp.ones((1, kk.shape[1]), bool)
    out = _band_attend(q.reshape(B, 1, T, N_KV_HEADS, GROUP, HEAD_DIM), kk[:, None], vv[:, None],
                       key_valid, rel_bias, sinks)
    return out.reshape(B, T, N_Q_HEADS * HEAD_DIM), kk[:, T:], vv[:, T:]


def _lin_scan(a, b):
    def comb(c1, c2):
        a1, b1 = c1
        a2, b2 = c2
        return a1 * a2, a2 * b1 + b2
    return lax.associative_scan(comb, (a, b), axis=1)[1]


def _clin_scan(a_re, a_im, b_re, b_im):
    def comb(c1, c2):
        ar1, ai1, br1, bi1 = c1
        ar2, ai2, br2, bi2 = c2
        return (ar2 * ar1 - ai2 * ai1, ar2 * ai1 + ai2 * ar1,
                ar2 * br1 - ai2 * bi1 + br2, ar2 * bi1 + ai2 * br1 + bi2)
    out = lax.associative_scan(comb, (a_re, a_im, b_re, b_im), axis=1)
    return out[2], out[3]


def _s5_branch(u, h0_re, h0_im, lam_re, lam_im, log_step, b_re, b_im, c_re, c_im, d, w_glu):
    B, T, _ = u.shape
    uf = u.astype(f32).reshape(B, T, N_SSM_GROUPS, SSM_GROUP)
    lr = jnp.minimum(lam_re.astype(f32), -1e-4)
    li = lam_im.astype(f32)
    step = jnp.exp(log_step.astype(f32))[:, None]
    mag = jnp.exp(lr * step)
    ab_re = mag * jnp.cos(li * step)
    ab_im = mag * jnp.sin(li * step)
    den = lr * lr + li * li
    f_re = ((ab_re - 1.0) * lr + ab_im * li) / den
    f_im = (ab_im * lr - (ab_re - 1.0) * li) / den
    bre, bim = b_re.astype(f32), b_im.astype(f32)
    bb_re = f_re[..., None] * bre - f_im[..., None] * bim
    bb_im = f_re[..., None] * bim + f_im[..., None] * bre
    x_re = jnp.einsum('btgc,gpc->btgp', uf, bb_re)
    x_im = jnp.einsum('btgc,gpc->btgp', uf, bb_im)
    x_re = x_re.at[:, 0].add(ab_re * h0_re - ab_im * h0_im)
    x_im = x_im.at[:, 0].add(ab_re * h0_im + ab_im * h0_re)
    h_re, h_im = _clin_scan(jnp.broadcast_to(ab_re, x_re.shape), jnp.broadcast_to(ab_im, x_im.shape), x_re, x_im)
    y = (jnp.einsum('btgp,gcp->btgc', h_re, c_re.astype(f32))
         - jnp.einsum('btgp,gcp->btgc', h_im, c_im.astype(f32)))
    y = y.reshape(B, T, SSM_WIDTH) + d.astype(f32) * uf.reshape(B, T, SSM_WIDTH)
    z = jax.nn.gelu(y)
    z = z * jax.nn.sigmoid(z @ w_glu.astype(f32))
    return z, h_re[:, -1], h_im[:, -1]


def _rglru_branch(xc, conv_buf, h0, conv_w, conv_b, w_a, b_a, w_x, b_x, lam):
    B, T, _ = xc.shape
    xp = jnp.concatenate([conv_buf.astype(xc.dtype), xc], axis=1)
    conv = conv_b + conv_w[0] * xp[:, 0:T]
    for j in range(1, CONV_WIDTH):
        conv = conv + conv_w[j] * xp[:, j:j + T]
    xf = conv.astype(f32)
    xb = xf.reshape(B, T, LRU_BLOCKS, LRU_BLOCK_DIM)
    r = jax.nn.sigmoid(jnp.einsum('btnd,nde->btne', xb, w_a.astype(f32)).reshape(B, T, LRU_WIDTH) + b_a.astype(f32))
    i = jax.nn.sigmoid(jnp.einsum('btnd,nde->btne', xb, w_x.astype(f32)).reshape(B, T, LRU_WIDTH) + b_x.astype(f32))
    log_a = LRU_C * r * jax.nn.log_sigmoid(lam.astype(f32))
    a = jnp.exp(log_a)
    b = xf * i * jnp.sqrt(-jnp.expm1(2.0 * log_a))
    b = b.at[:, 0].add(a[:, 0] * h0.astype(f32))
    h = _lin_scan(a, b)
    return h, h[:, -1], xp[:, -(CONV_WIDTH - 1):]


def _layernorm(h, g, b):
    hf = h.astype(f32)
    mu = hf.mean(-1, keepdims=True)
    var = jnp.square(hf - mu).mean(-1, keepdims=True)
    return (hf - mu) * lax.rsqrt(var + LN_EPS) * g.astype(f32) + b.astype(f32)


def _layer(x, p, rel_bias, state):
    B, T, _ = x.shape
    dt = x.dtype
    proj = x @ p['w_in']
    q, k, v, g_a, u_b, g_b, x_c, g_c, g_m = jnp.split(proj, _split_points(), axis=-1)
    if state is None:
        attn = _attn_prompt(q, k, v, rel_bias, p['sinks'])
        k_buf = k[:, -WINDOW:].reshape(B, WINDOW, N_KV_HEADS, HEAD_DIM)
        v_buf = v[:, -WINDOW:].reshape(B, WINDOW, N_KV_HEADS, HEAD_DIM)
        h0_re = jnp.zeros((B, N_SSM_GROUPS, SSM_STATE), f32)
        h0_im = jnp.zeros((B, N_SSM_GROUPS, SSM_STATE), f32)
        lru_h0 = jnp.zeros((B, LRU_WIDTH), f32)
        conv_buf = jnp.zeros((B, CONV_WIDTH - 1, LRU_WIDTH), dt)
    else:
        k_cache, v_cache, h0_re, h0_im, lru_h0, conv_buf = state
        attn, k_buf, v_buf = _attn_sample(q, k, v, k_cache, v_cache, rel_bias, p['sinks'])
    y_b, h_re, h_im = _s5_branch(u_b, h0_re.astype(f32), h0_im.astype(f32), p['lam_re'], p['lam_im'],
                                 p['log_step'], p['b_re'], p['b_im'], p['c_re'], p['c_im'], p['d'], p['w_glu'])
    y_c, lru_h, conv_new = _rglru_branch(x_c, conv_buf, lru_h0, p['conv_w'], p['conv_b'], p['w_a'],
                                         p['b_a'], p['w_x'], p['b_x'], p['lam'])
    ya = (attn * jax.nn.silu(g_a.astype(f32))).astype(dt) @ p['w_br_a']
    yb = (y_b * jax.nn.silu(g_b.astype(f32))).astype(dt) @ p['w_br_b']
    yc = (y_c * jax.nn.silu(g_c.astype(f32))).astype(dt) @ p['w_br_c']
    ga, gb, gc = jnp.split(jax.nn.sigmoid(g_m.astype(f32)), 3, axis=-1)
    merged = (ga * ya.astype(f32) + gb * yb.astype(f32) + gc * yc.astype(f32)).astype(dt)
    out = merged @ p['w_out']
    y = _layernorm(DN_ALPHA * x.astype(f32) + out.astype(f32), p['ln_g'], p['ln_b']).astype(dt)
    return y, (k_buf, v_buf, h_re, h_im, lru_h, conv_new)


def setup_inputs(seed: int = 0) -> dict:
    key = jax.random.key(seed)
    ks = iter(jax.random.split(key, 40))

    def nrm(shape, scale):
        return scale * jax.random.normal(next(ks), shape, f32)

    win = min(WINDOW, PAST_LEN)
    x_prompt = nrm((BATCH, SEQ, D_MODEL), 1.0)
    x_sample = nrm((DEC_BATCH, DEC_SEQ, D_MODEL), 1.0)
    cache_k = nrm((DEPTH, DEC_BATCH, win, N_KV_HEADS, HEAD_DIM), 1.0)
    cache_v = nrm((DEPTH, DEC_BATCH, win, N_KV_HEADS, HEAD_DIM), 1.0)
    state_ssm_re = nrm((DEPTH, DEC_BATCH, N_SSM_GROUPS, SSM_STATE), 0.1)
    state_ssm_im = nrm((DEPTH, DEC_BATCH, N_SSM_GROUPS, SSM_STATE), 0.1)
    state_lru = nrm((DEPTH, DEC_BATCH, LRU_WIDTH), 0.5)
    state_conv = nrm((DEPTH, DEC_BATCH, CONV_WIDTH - 1, LRU_WIDTH), 1.0)
    rel_bias = nrm((N_BUCKETS, N_Q_HEADS), 0.5)
    w_in = nrm((DEPTH, D_MODEL, IN_COLS), D_MODEL ** -0.5)
    sinks = nrm((DEPTH, N_Q_HEADS), 0.5)
    w_branch_a = nrm((DEPTH, BRANCH_WIDTH, D_MODEL), BRANCH_WIDTH ** -0.5)
    ssm_lambda_re = -0.5 + nrm((DEPTH, N_SSM_GROUPS, SSM_STATE), 0.01)
    ssm_lambda_im = math.pi * jnp.arange(SSM_STATE, dtype=f32) + nrm((DEPTH, N_SSM_GROUPS, SSM_STATE), 0.01)
    ssm_log_step = jax.random.uniform(next(ks), (DEPTH, N_SSM_GROUPS), f32, math.log(1e-3), math.log(1e-1))
    ssm_b_re = nrm((DEPTH, N_SSM_GROUPS, SSM_STATE, SSM_GROUP), (2 * SSM_GROUP) ** -0.5)
    ssm_b_im = nrm((DEPTH, N_SSM_GROUPS, SSM_STATE, SSM_GROUP), (2 * SSM_GROUP) ** -0.5)
    ssm_c_re = nrm((DEPTH, N_SSM_GROUPS, SSM_GROUP, SSM_STATE), (2 * SSM_STATE) ** -0.5)
    ssm_c_im = nrm((DEPTH, N_SSM_GROUPS, SSM_GROUP, SSM_STATE), (2 * SSM_STATE) ** -0.5)
    ssm_d = nrm((DEPTH, SSM_WIDTH), 1.0)
    ssm_w_glu = nrm((DEPTH, SSM_WIDTH, SSM_WIDTH), SSM_WIDTH ** -0.5)
    w_branch_b = nrm((DEPTH, SSM_WIDTH, D_MODEL), SSM_WIDTH ** -0.5)
    conv_w = nrm((DEPTH, CONV_WIDTH, LRU_WIDTH), CONV_WIDTH ** -0.5)
    conv_b = nrm((DEPTH, LRU_WIDTH), 0.01)
    lru_w_a = nrm((DEPTH, LRU_BLOCKS, LRU_BLOCK_DIM, LRU_BLOCK_DIM), LRU_BLOCK_DIM ** -0.5)
    lru_b_a = nrm((DEPTH, LRU_WIDTH), 0.01)
    lru_w_x = nrm((DEPTH, LRU_BLOCKS, LRU_BLOCK_DIM, LRU_BLOCK_DIM), LRU_BLOCK_DIM ** -0.5)
    lru_b_x = nrm((DEPTH, LRU_WIDTH), 0.01)
    a_c = jax.random.uniform(next(ks), (DEPTH, LRU_WIDTH), f32, 0.9, 0.999)
    s = a_c ** (1.0 / LRU_C)
    lru_lambda = jnp.log(s) - jnp.log1p(-s)
    w_branch_c = nrm((DEPTH, LRU_WIDTH, D_MODEL), LRU_WIDTH ** -0.5)
    w_out = nrm((DEPTH, D_MODEL, D_MODEL), DN_BETA * D_MODEL ** -0.5)
    ln_g = 1.0 + nrm((DEPTH, D_MODEL), 0.01)
    ln_b = nrm((DEPTH, D_MODEL), 0.01)
    return {'x_prompt': x_prompt, 'x_sample': x_sample, 'cache_k': cache_k, 'cache_v': cache_v,
            'state_ssm_re': state_ssm_re, 'state_ssm_im': state_ssm_im, 'state_lru': state_lru,
            'state_conv': state_conv, 'rel_bias': rel_bias, 'w_in': w_in, 'sinks': sinks,
            'w_branch_a': w_branch_a, 'ssm_lambda_re': ssm_lambda_re, 'ssm_lambda_im': ssm_lambda_im,
            'ssm_log_step': ssm_log_step, 'ssm_b_re': ssm_b_re, 'ssm_b_im': ssm_b_im,
            'ssm_c_re': ssm_c_re, 'ssm_c_im': ssm_c_im, 'ssm_d': ssm_d, 'ssm_w_glu': ssm_w_glu,
            'w_branch_b': w_branch_b, 'conv_w': conv_w, 'conv_b': conv_b, 'lru_w_a': lru_w_a,
            'lru_b_a': lru_b_a, 'lru_w_x': lru_w_x, 'lru_b_x': lru_b_x, 'lru_lambda': lru_lambda,
            'w_branch_c': w_branch_c, 'w_out': w_out, 'ln_g': ln_g, 'ln_b': ln_b}


def reference(x_prompt, x_sample, cache_k, cache_v, state_ssm_re, state_ssm_im, state_lru, state_conv,
              rel_bias, w_in, sinks, w_branch_a, ssm_lambda_re, ssm_lambda_im, ssm_log_step,
              ssm_b_re, ssm_b_im, ssm_c_re, ssm_c_im, ssm_d, ssm_w_glu, w_branch_b, conv_w, conv_b,
              lru_w_a, lru_b_a, lru_w_x, lru_b_x, lru_lambda, w_branch_c, w_out, ln_g, ln_b):
    y_prompt, y_sample = x_prompt, x_sample
    st_p, st_s = [], []
    for l in range(DEPTH):
        prm = {'w_in': w_in[l], 'sinks': sinks[l], 'w_br_a': w_branch_a[l],
               'lam_re': ssm_lambda_re[l], 'lam_im': ssm_lambda_im[l], 'log_step': ssm_log_step[l],
               'b_re': ssm_b_re[l], 'b_im': ssm_b_im[l], 'c_re': ssm_c_re[l], 'c_im': ssm_c_im[l],
               'd': ssm_d[l], 'w_glu': ssm_w_glu[l], 'w_br_b': w_branch_b[l],
               'conv_w': conv_w[l], 'conv_b': conv_b[l], 'w_a': lru_w_a[l], 'b_a': lru_b_a[l],
               'w_x': lru_w_x[l], 'b_x': lru_b_x[l], 'lam': lru_lambda[l], 'w_br_c': w_branch_c[l],
               'w_out': w_out[l], 'ln_g': ln_g[l], 'ln_b': ln_b[l]}
        y_prompt, sp = _layer(y_prompt, prm, rel_bias, None)
        y_sample, ss = _layer(y_sample, prm, rel_bias,
                              (cache_k[l], cache_v[l], state_ssm_re[l], state_ssm_im[l], state_lru[l], state_conv[l]))
        st_p.append(sp)
        st_s.append(ss)
    new_k_prompt = jnp.stack([s[0] for s in st_p])
    new_v_prompt = jnp.stack([s[1] for s in st_p])
    new_ssm_re_prompt = jnp.stack([s[2] for s in st_p])
    new_ssm_im_prompt = jnp.stack([s[3] for s in st_p])
    new_lru_prompt = jnp.stack([s[4] for s in st_p])
    new_conv_prompt = jnp.stack([s[5] for s in st_p])
    new_k_sample = jnp.stack([s[0] for s in st_s])
    new_v_sample = jnp.stack([s[1] for s in st_s])
    new_ssm_re_sample = jnp.stack([s[2] for s in st_s])
    new_ssm_im_sample = jnp.stack([s[3] for s in st_s])
    new_lru_sample = jnp.stack([s[4] for s in st_s])
    new_conv_sample = jnp.stack([s[5] for s in st_s])
    return (y_prompt, y_sample, new_k_prompt, new_v_prompt, new_ssm_re_prompt, new_ssm_im_prompt,
            new_lru_prompt, new_conv_prompt, new_k_sample, new_v_sample, new_ssm_re_sample,
            new_ssm_im_sample, new_lru_sample, new_conv_sample)
```

```cpp
#include <hip/hip_runtime.h>
#include <cstdint>
#include <cstdio>

typedef unsigned short bf16_t;
typedef short bf16x8 __attribute__((ext_vector_type(8)));
typedef float f32x16 __attribute__((ext_vector_type(16)));
typedef float f32x4 __attribute__((ext_vector_type(4)));

constexpr int D_MODEL = 1024, BATCH = 8, SEQ = 2048, DEPTH = 2, DEC_BATCH = 128, DEC_SEQ = 4;
constexpr int M_P = BATCH * SEQ;
constexpr int M_S = DEC_BATCH * DEC_SEQ;
constexpr int M_TOT = M_P + M_S;
constexpr int IN_COLS = 6400;
constexpr int C_Q = 0, C_K = 512, C_V = 640, C_GA = 768, C_UB = 1280, C_GB = 1792, C_XC = 2304, C_GC = 2816, C_GM = 3328;
constexpr int WINDOW = 128, NKV = 2, HD = 64, NQH = 8;
constexpr int NG = 32, NP = 64, NC = 16;
constexpr float DN_ALPHA = 1.4142135623730951f;
constexpr float LN_EPS = 1e-5f;

constexpr size_t O_YP = 0;
constexpr size_t O_YS = O_YP + (size_t)M_P * D_MODEL;
constexpr size_t O_KP = O_YS + (size_t)M_S * D_MODEL;
constexpr size_t SZ_KP = (size_t)DEPTH * BATCH * WINDOW * NKV * HD;
constexpr size_t O_VP = O_KP + SZ_KP;
constexpr size_t O_SRP = O_VP + SZ_KP;
constexpr size_t SZ_SP = (size_t)DEPTH * BATCH * NG * NP;
constexpr size_t O_SIP = O_SRP + SZ_SP;
constexpr size_t O_LP = O_SIP + SZ_SP;
constexpr size_t SZ_LP = (size_t)DEPTH * BATCH * 512;
constexpr size_t O_CP = O_LP + SZ_LP;
constexpr size_t SZ_CP = (size_t)DEPTH * BATCH * 3 * 512;
constexpr size_t O_KS = O_CP + SZ_CP;
constexpr size_t SZ_KS = (size_t)DEPTH * DEC_BATCH * WINDOW * NKV * HD;
constexpr size_t O_VS = O_KS + SZ_KS;
constexpr size_t O_SRS = O_VS + SZ_KS;
constexpr size_t SZ_SS = (size_t)DEPTH * DEC_BATCH * NG * NP;
constexpr size_t O_SIS = O_SRS + SZ_SS;
constexpr size_t O_LS = O_SIS + SZ_SS;
constexpr size_t SZ_LS = (size_t)DEPTH * DEC_BATCH * 512;
constexpr size_t O_CS = O_LS + SZ_LS;
constexpr size_t SZ_CS = (size_t)DEPTH * DEC_BATCH * 3 * 512;
constexpr size_t O_END = O_CS + SZ_CS;

constexpr size_t WS_PROJ = 0;
constexpr size_t WS_XB = WS_PROJ + (size_t)M_TOT * IN_COLS * 2;
constexpr size_t WS_WOUT = WS_XB + (size_t)M_TOT * D_MODEL * 2;
constexpr size_t WS_TAB = WS_WOUT + (size_t)DEPTH * 1024 * 1024 * 2;
constexpr size_t TAB_AB = 0;
constexpr size_t TAB_BB = TAB_AB + (size_t)DEPTH * NG * NP * 2 * 4;
constexpr size_t TAB_BYTES = TAB_BB + (size_t)DEPTH * NG * NP * NC * 2 * 4;
constexpr size_t WS_END = WS_TAB + TAB_BYTES;
constexpr size_t DO_WIN = 0;
constexpr size_t DO_WBR = DO_WIN + (size_t)DEPTH * IN_COLS * 1024 * 2;
constexpr size_t DO_WGLU = DO_WBR + (size_t)DEPTH * 3 * 1024 * 512 * 2;
constexpr size_t DO_LRUW = DO_WGLU + (size_t)DEPTH * 512 * 512 * 2;
constexpr size_t DO_END = DO_LRUW;
static_assert(DO_END <= (size_t)M_P * D_MODEL * 4, "weights fit in y_prompt region");
static_assert(WS_END <= 268435456ull, "workspace fits 256 MiB");

__constant__ unsigned char T5_BUCKET[128] = {0, 1, 2, 3, 4, 5, 6, 7, 8, 9, 10, 11, 12, 13, 14, 15, 16, 16, 16, 17, 17, 18, 18, 18, 19, 19, 19, 20, 20, 20, 20, 21, 21, 21, 21, 22, 22, 22, 22, 22, 23, 23, 23, 23, 23, 23, 24, 24, 24, 24, 24, 24, 25, 25, 25, 25, 25, 25, 25, 26, 26, 26, 26, 26, 26, 26, 26, 27, 27, 27, 27, 27, 27, 27, 27, 27, 27, 28, 28, 28, 28, 28, 28, 28, 28, 28, 28, 29, 29, 29, 29, 29, 29, 29, 29, 29, 29, 29, 29, 30, 30, 30, 30, 30, 30, 30, 30, 30, 30, 30, 30, 30, 30, 31, 31, 31, 31, 31, 31, 31, 31, 31, 31, 31, 31, 31, 31, 31};

__device__ __forceinline__ float bf2f(bf16_t v) { return __uint_as_float(((unsigned)v) << 16); }
__device__ __forceinline__ bf16_t f2bf(float f) { unsigned u = __float_as_uint(f); return (bf16_t)((u + 0x7fffu + ((u >> 16) & 1u)) >> 16); }
__device__ __forceinline__ float sigmoidf_(float x) { return 1.0f / (1.0f + __expf(-x)); }
__device__ __forceinline__ float siluf_(float x) { return x * sigmoidf_(x); }
__device__ __forceinline__ float gelu_tanh(float y) { const float t = tanhf(0.7978845608028654f * (y + 0.044715f * y * y * y)); return 0.5f * y * (1.0f + t); }

struct P {
    const float* in[33];
    float* out;
    unsigned char* ws;
};

__global__ void k_convert_x(P p) {
    bf16_t* XB = (bf16_t*)(p.ws + WS_XB);
    const size_t n = (size_t)M_TOT * D_MODEL;
    for (size_t i = (size_t)blockIdx.x * blockDim.x + threadIdx.x; i < n; i += (size_t)gridDim.x * blockDim.x) {
        const float v = i < (size_t)M_P * D_MODEL ? p.in[0][i] : p.in[1][i - (size_t)M_P * D_MODEL];
        XB[i] = f2bf(v);
    }
}
__global__ void k_transpose_w(const float* W, bf16_t* WT, int K, int N) {
    const size_t n = (size_t)K * N;
    for (size_t i = (size_t)blockIdx.x * blockDim.x + threadIdx.x; i < n; i += (size_t)gridDim.x * blockDim.x) {
        const int nn = (int)(i / K), kk = (int)(i % K);
        WT[i] = f2bf(W[(size_t)kk * N + nn]);
    }
}
__global__ void k_s5_tables(P p) {
    float* AB = (float*)(p.ws + WS_TAB + TAB_AB);
    float* BB = (float*)(p.ws + WS_TAB + TAB_BB);
    const int i = blockIdx.x * blockDim.x + threadIdx.x;
    if (i >= DEPTH * NG * NP) return;
    const int l = i / (NG * NP), g = (i / NP) % NG;
    const float lr = fminf(p.in[12][i], -1e-4f), li = p.in[13][i];
    const float step = expf(p.in[14][l * NG + g]);
    const float mag = expf(lr * step);
    float sn, cs; sincosf(li * step, &sn, &cs);
    const float ab_re = mag * cs, ab_im = mag * sn;
    const float den = lr * lr + li * li;
    const float f_re = ((ab_re - 1.0f) * lr + ab_im * li) / den;
    const float f_im = (ab_im * lr - (ab_re - 1.0f) * li) / den;
    AB[2 * i] = ab_re; AB[2 * i + 1] = ab_im;
    for (int c = 0; c < NC; ++c) {
        const float bre = p.in[15][(size_t)i * NC + c], bim = p.in[16][(size_t)i * NC + c];
        BB[((size_t)i * NC + c) * 2] = f_re * bre - f_im * bim;
        BB[((size_t)i * NC + c) * 2 + 1] = f_re * bim + f_im * bre;
    }
}

template <class Epi>
__device__ __forceinline__ void gemm_simple(const bf16_t* A, int lda, const bf16_t* Bt, int ldb, int M, int N, int K, Epi epi) {
    const int lane = threadIdx.x & 63, wave = threadIdx.x >> 6, nwb = blockDim.x >> 6;
    const int gw = blockIdx.x * nwb + wave, ngw = gridDim.x * nwb;
    const int ntn = N / 32, ntiles = (M / 32) * ntn;
    for (int tile = gw; tile < ntiles; tile += ngw) {
        const int tm = tile / ntn, tn = tile % ntn;
        f32x16 acc = {};
        const bf16_t* ar = A + (size_t)(tm * 32 + (lane & 31)) * lda + 8 * (lane >> 5);
        const bf16_t* br = Bt + (size_t)(tn * 32 + (lane & 31)) * ldb + 8 * (lane >> 5);
        for (int k0 = 0; k0 < K; k0 += 16) {
            const bf16x8 a = *(const bf16x8*)(ar + k0);
            const bf16x8 b = *(const bf16x8*)(br + k0);
            acc = __builtin_amdgcn_mfma_f32_32x32x16_bf16(a, b, acc, 0, 0, 0);
        }
#pragma unroll
        for (int r = 0; r < 16; ++r) {
            const int row = tm * 32 + (r & 3) + 8 * (r >> 2) + 4 * (lane >> 5), col = tn * 32 + (lane & 31);
            epi(row, col, acc[r]);
        }
    }
}

struct EpiProj { bf16_t* PROJ; __device__ void operator()(int r, int c, float v) const { PROJ[(size_t)r * IN_COLS + c] = f2bf(v); } };
__global__ void __launch_bounds__(256) k_gemm_in(P p, int l) {
    bf16_t* PROJ = (bf16_t*)(p.ws + WS_PROJ);
    const bf16_t* XB = (const bf16_t*)(p.ws + WS_XB);
    const bf16_t* WT = (const bf16_t*)((unsigned char*)p.out + DO_WIN) + (size_t)l * IN_COLS * 1024;
    gemm_simple(XB, D_MODEL, WT, 1024, M_TOT, IN_COLS, 1024, EpiProj{PROJ});
}

__global__ void k_kv_out(P p, int l) {
    const bf16_t* PROJ = (const bf16_t*)(p.ws + WS_PROJ);
    const int i = blockIdx.x * blockDim.x + threadIdx.x;
    if (i < BATCH * WINDOW * 128) {
        const int b = i / (WINDOW * 128), w = (i / 128) % WINDOW, c = i % 128;
        const size_t row = (size_t)b * SEQ + (SEQ - WINDOW) + w;
        p.out[O_KP + (size_t)l * BATCH * WINDOW * 128 + i] = bf2f(PROJ[row * IN_COLS + C_K + c]);
        p.out[O_VP + (size_t)l * BATCH * WINDOW * 128 + i] = bf2f(PROJ[row * IN_COLS + C_V + c]);
    }
    if (i < DEC_BATCH * WINDOW * 128) {
        const int b = i / (WINDOW * 128), w = (i / 128) % WINDOW, c = i % 128;
        float kv, vv;
        if (w < WINDOW - DEC_SEQ) {
            const size_t ci = (((size_t)l * DEC_BATCH + b) * WINDOW + (w + DEC_SEQ)) * 128 + c;
            kv = p.in[2][ci]; vv = p.in[3][ci];
        } else {
            const size_t row = (size_t)M_P + b * DEC_SEQ + (w - (WINDOW - DEC_SEQ));
            kv = bf2f(PROJ[row * IN_COLS + C_K + c]); vv = bf2f(PROJ[row * IN_COLS + C_V + c]);
        }
        p.out[O_KS + (size_t)l * DEC_BATCH * WINDOW * 128 + i] = kv;
        p.out[O_VS + (size_t)l * DEC_BATCH * WINDOW * 128 + i] = vv;
    }
}

__global__ void __launch_bounds__(64) k_attn(P p, int l) {
    bf16_t* PROJ = (bf16_t*)(p.ws + WS_PROJ);
    const int m = blockIdx.x / NQH, h = blockIdx.x % NQH, kvh = h / 4, lane = threadIdx.x;
    const bool samp = m >= M_P;
    const int b = samp ? (m - M_P) / DEC_SEQ : m / SEQ, t = samp ? (m - M_P) % DEC_SEQ : m % SEQ;
    float q[64];
    {
        const bf16_t* qp = PROJ + (size_t)m * IN_COLS + C_Q + h * 64;
#pragma unroll
        for (int d = 0; d < 64; ++d) q[d] = bf2f(qp[d]);
    }
    const float* rel_bias = p.in[8];
    const float sink = p.in[10][l * NQH + h];
    float s[2];
#pragma unroll
    for (int j = 0; j < 2; ++j) {
        const int d = lane + 64 * j;
        const int tk = t - d;
        float sc = -1e30f;
        if (!samp) {
            if (tk >= 0) {
                const bf16_t* kp = PROJ + ((size_t)b * SEQ + tk) * IN_COLS + C_K + kvh * 64;
                float a = 0.f;
#pragma unroll
                for (int e = 0; e < 64; ++e) a += q[e] * bf2f(kp[e]);
                sc = a * 0.125f + rel_bias[T5_BUCKET[d] * NQH + h];
            }
        } else {
            float a = 0.f;
            if (tk >= 0) {
                const bf16_t* kp = PROJ + ((size_t)M_P + b * DEC_SEQ + tk) * IN_COLS + C_K + kvh * 64;
#pragma unroll
                for (int e = 0; e < 64; ++e) a += q[e] * bf2f(kp[e]);
            } else {
                const float* kp = p.in[2] + ((((size_t)l * DEC_BATCH + b) * WINDOW + (WINDOW + tk)) * NKV + kvh) * HD;
#pragma unroll
                for (int e = 0; e < 64; ++e) a += q[e] * kp[e];
            }
            sc = a * 0.125f + rel_bias[T5_BUCKET[d] * NQH + h];
        }
        s[j] = sc;
    }
    float mx = fmaxf(fmaxf(s[0], s[1]), sink);
    for (int o = 32; o > 0; o >>= 1) mx = fmaxf(mx, __shfl_xor(mx, o));
    const float p0 = s[0] > -1e29f ? __expf(s[0] - mx) : 0.f, p1 = s[1] > -1e29f ? __expf(s[1] - mx) : 0.f;
    float sum = p0 + p1;
    for (int o = 32; o > 0; o >>= 1) sum += __shfl_xor(sum, o);
    const float denom = sum + __expf(sink - mx);
    float o = 0.f;
    for (int d = 0; d < 128; ++d) {
        const float pj = __shfl(d < 64 ? p0 : p1, d & 63);
        const int tk = t - d;
        float vv = 0.f;
        if (!samp) { if (tk >= 0) vv = bf2f(PROJ[((size_t)b * SEQ + tk) * IN_COLS + C_V + kvh * 64 + lane]); }
        else if (tk >= 0) vv = bf2f(PROJ[((size_t)M_P + b * DEC_SEQ + tk) * IN_COLS + C_V + kvh * 64 + lane]);
        else vv = p.in[3][((((size_t)l * DEC_BATCH + b) * WINDOW + (WINDOW + tk)) * NKV + kvh) * HD + lane];
        o += pj * vv;
    }
    o /= denom;
    const float ga = bf2f(PROJ[(size_t)m * IN_COLS + C_GA + h * 64 + lane]);
    PROJ[(size_t)m * IN_COLS + C_Q + h * 64 + lane] = f2bf(o * siluf_(ga));
}

__global__ void __launch_bounds__(64) k_s5(P p, int l) {
    __shared__ float sm[64][17];
    bf16_t* PROJ = (bf16_t*)(p.ws + WS_PROJ);
    const float* AB = (const float*)(p.ws + WS_TAB + TAB_AB);
    const float* BB = (const float*)(p.ws + WS_TAB + TAB_BB);
    const int seq = blockIdx.x / NG, g = blockIdx.x % NG, pp = threadIdx.x;
    const bool samp = seq >= BATCH;
    const int b = samp ? seq - BATCH : seq, T = samp ? DEC_SEQ : SEQ;
    const size_t row0 = samp ? (size_t)M_P + b * DEC_SEQ : (size_t)b * SEQ;
    const int sidx = (l * NG + g) * NP + pp;
    const float ab_re = AB[2 * sidx], ab_im = AB[2 * sidx + 1];
    float bbr[16], bbi[16], cr[16], ci[16];
#pragma unroll
    for (int c = 0; c < 16; ++c) {
        bbr[c] = BB[((size_t)sidx * NC + c) * 2]; bbi[c] = BB[((size_t)sidx * NC + c) * 2 + 1];
        cr[c] = p.in[17][((size_t)(l * NG + g) * NC + c) * NP + pp]; ci[c] = p.in[18][((size_t)(l * NG + g) * NC + c) * NP + pp];
    }
    const float dd = pp < 16 ? p.in[19][l * 512 + g * 16 + pp] : 0.f;
    float hr = 0.f, hi = 0.f;
    if (samp) { const size_t si = (((size_t)l * DEC_BATCH + b) * NG + g) * NP + pp; hr = p.in[4][si]; hi = p.in[5][si]; }
    for (int t = 0; t < T; ++t) {
        bf16_t* up = PROJ + (row0 + t) * IN_COLS + C_UB + g * 16;
        float u[16];
#pragma unroll
        for (int c = 0; c < 16; ++c) u[c] = bf2f(up[c]);
        float xr = 0.f, xi = 0.f;
#pragma unroll
        for (int c = 0; c < 16; ++c) { xr += bbr[c] * u[c]; xi += bbi[c] * u[c]; }
        const float nr = ab_re * hr - ab_im * hi + xr, ni = ab_re * hi + ab_im * hr + xi;
        hr = nr; hi = ni;
#pragma unroll
        for (int c = 0; c < 16; ++c) sm[pp][c] = cr[c] * hr - ci[c] * hi;
        __syncthreads();
        if (pp < 16) {
            float y = 0.f;
            for (int q = 0; q < 64; ++q) y += sm[q][pp];
            y += dd * bf2f(up[pp]);
            up[pp] = f2bf(gelu_tanh(y));
        }
        __syncthreads();
    }
    if (!samp) { const size_t oi = (((size_t)l * BATCH + b) * NG + g) * NP + pp; p.out[O_SRP + oi] = hr; p.out[O_SIP + oi] = hi; }
    else { const size_t oi = (((size_t)l * DEC_BATCH + b) * NG + g) * NP + pp; p.out[O_SRS + oi] = hr; p.out[O_SIS + oi] = hi; }
}

struct EpiGlu { bf16_t* PROJ; __device__ void operator()(int r, int c, float v) const {
    const float z = bf2f(PROJ[(size_t)r * IN_COLS + C_UB + c]), gb = bf2f(PROJ[(size_t)r * IN_COLS + C_GB + c]);
    PROJ[(size_t)r * IN_COLS + C_GB + c] = f2bf(z * sigmoidf_(v) * siluf_(gb)); } };
__global__ void __launch_bounds__(256) k_gemm_glu(P p, int l) {
    bf16_t* PROJ = (bf16_t*)(p.ws + WS_PROJ);
    const bf16_t* WT = (const bf16_t*)((unsigned char*)p.out + DO_WGLU) + (size_t)l * 512 * 512;
    gemm_simple(PROJ + C_UB, IN_COLS, WT, 512, M_TOT, 512, 512, EpiGlu{PROJ});
}

__global__ void __launch_bounds__(64) k_lru(P p, int l) {
    __shared__ float sx[64];
    bf16_t* PROJ = (bf16_t*)(p.ws + WS_PROJ);
    const int seq = blockIdx.x / 8, n = blockIdx.x % 8, e = threadIdx.x, ch = n * 64 + e;
    const bool samp = seq >= BATCH;
    const int b = samp ? seq - BATCH : seq, T = samp ? DEC_SEQ : SEQ;
    const size_t row0 = samp ? (size_t)M_P + b * DEC_SEQ : (size_t)b * SEQ;
    float wa[64], wx[64];
#pragma unroll
    for (int d = 0; d < 64; ++d) { wa[d] = p.in[24][(((size_t)l * 8 + n) * 64 + d) * 64 + e]; wx[d] = p.in[26][(((size_t)l * 8 + n) * 64 + d) * 64 + e]; }
    const float ba = p.in[25][l * 512 + ch], bx = p.in[27][l * 512 + ch], lam = p.in[28][l * 512 + ch];
    const float lsig = -log1pf(expf(-lam));
    const float cw0 = p.in[22][(l * 4 + 0) * 512 + ch], cw1 = p.in[22][(l * 4 + 1) * 512 + ch], cw2 = p.in[22][(l * 4 + 2) * 512 + ch], cw3 = p.in[22][(l * 4 + 3) * 512 + ch];
    const float cb = p.in[23][l * 512 + ch];
    float xm3 = 0.f, xm2 = 0.f, xm1 = 0.f, h = 0.f;
    if (samp) {
        const size_t ci = (((size_t)l * DEC_BATCH + b) * 3) * 512 + ch;
        xm3 = p.in[7][ci]; xm2 = p.in[7][ci + 512]; xm1 = p.in[7][ci + 1024];
        h = p.in[6][((size_t)l * DEC_BATCH + b) * 512 + ch];
    }
    for (int t = 0; t < T; ++t) {
        bf16_t* rp = PROJ + (row0 + t) * IN_COLS;
        const float xc = bf2f(rp[C_XC + ch]);
        const float xf = cb + cw0 * xm3 + cw1 * xm2 + cw2 * xm1 + cw3 * xc;
        xm3 = xm2; xm2 = xm1; xm1 = xc;
        sx[e] = xf;
        __syncthreads();
        float r = ba, i = bx;
#pragma unroll
        for (int d = 0; d < 64; ++d) { const float xv = sx[d]; r += xv * wa[d]; i += xv * wx[d]; }
        __syncthreads();
        r = sigmoidf_(r); i = sigmoidf_(i);
        const float log_a = 8.0f * r * lsig;
        const float a = expf(log_a);
        const float bt = xf * i * sqrtf(-expm1f(2.0f * log_a));
        h = a * h + bt;
        const float gc = bf2f(rp[C_GC + ch]);
        rp[C_XC + ch] = f2bf(h * siluf_(gc));
    }
    if (!samp) {
        p.out[O_LP + ((size_t)l * BATCH + b) * 512 + ch] = h;
        const size_t ci = (((size_t)l * BATCH + b) * 3) * 512 + ch;
        p.out[O_CP + ci] = xm3; p.out[O_CP + ci + 512] = xm2; p.out[O_CP + ci + 1024] = xm1;
    } else {
        p.out[O_LS + ((size_t)l * DEC_BATCH + b) * 512 + ch] = h;
        const size_t ci = (((size_t)l * DEC_BATCH + b) * 3) * 512 + ch;
        p.out[O_CS + ci] = xm3; p.out[O_CS + ci + 512] = xm2; p.out[O_CS + ci + 1024] = xm1;
    }
}

__global__ void __launch_bounds__(256) k_gemm_branch(P p, int l) {
    bf16_t* PROJ = (bf16_t*)(p.ws + WS_PROJ);
    const bf16_t* WB = (const bf16_t*)((unsigned char*)p.out + DO_WBR) + (size_t)l * 3 * 1024 * 512;
    const int lane = threadIdx.x & 63, wave = threadIdx.x >> 6, nwb = blockDim.x >> 6;
    const int gw = blockIdx.x * nwb + wave, ngw = gridDim.x * nwb;
    const int ntn = 1024 / 32, ntiles = (M_TOT / 32) * ntn;
    const int acol[3] = {C_Q, C_GB, C_XC};
    for (int tile = gw; tile < ntiles; tile += ngw) {
        const int tm = tile / ntn, tn = tile % ntn;
        f32x16 acc[3];
#pragma unroll
        for (int br = 0; br < 3; ++br) {
            acc[br] = (f32x16){};
            const bf16_t* ar = PROJ + (size_t)(tm * 32 + (lane & 31)) * IN_COLS + acol[br] + 8 * (lane >> 5);
            const bf16_t* bp = WB + (size_t)br * 1024 * 512 + (size_t)(tn * 32 + (lane & 31)) * 512 + 8 * (lane >> 5);
            for (int k0 = 0; k0 < 512; k0 += 16)
                acc[br] = __builtin_amdgcn_mfma_f32_32x32x16_bf16(*(const bf16x8*)(ar + k0), *(const bf16x8*)(bp + k0), acc[br], 0, 0, 0);
        }
#pragma unroll
        for (int r = 0; r < 16; ++r) {
            const int row = tm * 32 + (r & 3) + 8 * (r >> 2) + 4 * (lane >> 5), col = tn * 32 + (lane & 31);
            bf16_t* gp = PROJ + (size_t)row * IN_COLS + C_GM + col;
            const float m = sigmoidf_(bf2f(gp[0])) * acc[0][r] + sigmoidf_(bf2f(gp[1024])) * acc[1][r] + sigmoidf_(bf2f(gp[2048])) * acc[2][r];
            gp[0] = f2bf(m);
        }
    }
}

__device__ __forceinline__ float* pre_row(unsigned char* ws, int r) { return (float*)(ws + WS_PROJ + (size_t)r * IN_COLS * 2 + (size_t)(C_GM + 1024) * 2); }
struct EpiOut { P p; int l; __device__ void operator()(int r, int c, float v) const {
    float x;
    if (l == 0) x = r < M_P ? p.in[0][(size_t)r * D_MODEL + c] : p.in[1][(size_t)(r - M_P) * D_MODEL + c];
    else x = bf2f(((const bf16_t*)(p.ws + WS_XB))[(size_t)r * D_MODEL + c]);
    pre_row(p.ws, r)[c] = DN_ALPHA * x + v; } };
__global__ void __launch_bounds__(256) k_gemm_out(P p, int l) {
    const bf16_t* PROJ = (const bf16_t*)(p.ws + WS_PROJ);
    const bf16_t* WT = (const bf16_t*)(p.ws + WS_WOUT) + (size_t)l * 1024 * 1024;
    gemm_simple(PROJ + C_GM, IN_COLS, WT, 1024, M_TOT, 1024, 1024, EpiOut{p, l});
}

__global__ void __launch_bounds__(256) k_ln(P p, int l) {
    const int lane = threadIdx.x & 63, wave = threadIdx.x >> 6, nwb = blockDim.x >> 6;
    const float* g = p.in[31] + l * 1024; const float* bb = p.in[32] + l * 1024;
    for (int r = blockIdx.x * nwb + wave; r < M_TOT; r += gridDim.x * nwb) {
        const float* pr = pre_row(p.ws, r);
        float v[16]; float s = 0.f;
#pragma unroll
        for (int j = 0; j < 16; ++j) { v[j] = pr[lane + 64 * j]; s += v[j]; }
        for (int o = 32; o > 0; o >>= 1) s += __shfl_xor(s, o);
        const float mu = s * (1.0f / 1024.0f);
        float q = 0.f;
#pragma unroll
        for (int j = 0; j < 16; ++j) { const float d = v[j] - mu; q += d * d; }
        for (int o = 32; o > 0; o >>= 1) q += __shfl_xor(q, o);
        const float rstd = rsqrtf(q * (1.0f / 1024.0f) + LN_EPS);
#pragma unroll
        for (int j = 0; j < 16; ++j) {
            const int c = lane + 64 * j;
            const float y = (v[j] - mu) * rstd * g[c] + bb[c];
            if (l == 0) ((bf16_t*)(p.ws + WS_XB))[(size_t)r * D_MODEL + c] = f2bf(y);
            else if (r < M_P) p.out[O_YP + (size_t)r * D_MODEL + c] = y;
            else p.out[O_YS + (size_t)(r - M_P) * D_MODEL + c] = y;
        }
    }
}

extern "C" void kernel_launch(void* const* d_in, const int* in_sizes, int n_in, void* d_out, int out_size, void* d_ws, size_t ws_size, hipStream_t stream) {
    if (n_in != 33 || (size_t)out_size != O_END || ws_size < WS_END) { fprintf(stderr, "kernel_launch: unexpected sizes n_in %d out %d ws %zu\n", n_in, out_size, ws_size); return; }
    P p{};
    for (int i = 0; i < 33; ++i) p.in[i] = (const float*)d_in[i];
    p.out = (float*)d_out; p.ws = (unsigned char*)d_ws;
    unsigned char* dob = (unsigned char*)d_out;
    k_convert_x<<<2048, 256, 0, stream>>>(p);
    for (int l = 0; l < DEPTH; ++l) {
        k_transpose_w<<<2048, 256, 0, stream>>>(p.in[9] + (size_t)l * 1024 * IN_COLS, (bf16_t*)(dob + DO_WIN) + (size_t)l * IN_COLS * 1024, 1024, IN_COLS);
        k_transpose_w<<<512, 256, 0, stream>>>(p.in[11] + (size_t)l * 512 * 1024, (bf16_t*)(dob + DO_WBR) + ((size_t)l * 3 + 0) * 1024 * 512, 512, 1024);
        k_transpose_w<<<512, 256, 0, stream>>>(p.in[21] + (size_t)l * 512 * 1024, (bf16_t*)(dob + DO_WBR) + ((size_t)l * 3 + 1) * 1024 * 512, 512, 1024);
        k_transpose_w<<<512, 256, 0, stream>>>(p.in[29] + (size_t)l * 512 * 1024, (bf16_t*)(dob + DO_WBR) + ((size_t)l * 3 + 2) * 1024 * 512, 512, 1024);
        k_transpose_w<<<256, 256, 0, stream>>>(p.in[20] + (size_t)l * 512 * 512, (bf16_t*)(dob + DO_WGLU) + (size_t)l * 512 * 512, 512, 512);
        k_transpose_w<<<1024, 256, 0, stream>>>(p.in[30] + (size_t)l * 1024 * 1024, (bf16_t*)((unsigned char*)d_ws + WS_WOUT) + (size_t)l * 1024 * 1024, 1024, 1024);
    }
    k_s5_tables<<<(DEPTH * NG * NP + 255) / 256, 256, 0, stream>>>(p);
    for (int l = 0; l < DEPTH; ++l) {
        k_gemm_in<<<2048, 256, 0, stream>>>(p, l);
        k_kv_out<<<(DEC_BATCH * WINDOW * 128 + 255) / 256, 256, 0, stream>>>(p, l);
        k_attn<<<M_TOT * NQH, 64, 0, stream>>>(p, l);
        k_s5<<<(BATCH + DEC_BATCH) * NG, 64, 0, stream>>>(p, l);
        k_gemm_glu<<<1024, 256, 0, stream>>>(p, l);
        k_lru<<<(BATCH + DEC_BATCH) * 8, 64, 0, stream>>>(p, l);
        k_gemm_branch<<<2048, 256, 0, stream>>>(p, l);
        k_gemm_out<<<2048, 256, 0, stream>>>(p, l);
        k_ln<<<2048, 256, 0, stream>>>(p, l);
    }
}
```

```cpp
#include <hip/hip_runtime.h>
#include <cstdint>
#include <cstdio>

typedef unsigned short bf16_t;
typedef short bf16x8 __attribute__((ext_vector_type(8)));
typedef float f32x16 __attribute__((ext_vector_type(16)));
typedef float f32x4 __attribute__((ext_vector_type(4)));

constexpr int D_MODEL = 1024, BATCH = 8, SEQ = 2048, DEPTH = 2, DEC_BATCH = 128, DEC_SEQ = 4;
constexpr int M_P = BATCH * SEQ;
constexpr int M_S = DEC_BATCH * DEC_SEQ;
constexpr int M_TOT = M_P + M_S;
constexpr int IN_COLS = 6400;
constexpr int C_Q = 0, C_K = 512, C_V = 640, C_GA = 768, C_UB = 1280, C_GB = 1792, C_XC = 2304, C_GC = 2816, C_GM = 3328;
constexpr int WINDOW = 128, NKV = 2, HD = 64, NQH = 8;
constexpr int NG = 32, NP = 64, NC = 16;
constexpr float DN_ALPHA = 1.4142135623730951f;
constexpr float LN_EPS = 1e-5f;

constexpr size_t O_YP = 0;
constexpr size_t O_YS = O_YP + (size_t)M_P * D_MODEL;
constexpr size_t O_KP = O_YS + (size_t)M_S * D_MODEL;
constexpr size_t SZ_KP = (size_t)DEPTH * BATCH * WINDOW * NKV * HD;
constexpr size_t O_VP = O_KP + SZ_KP;
constexpr size_t O_SRP = O_VP + SZ_KP;
constexpr size_t SZ_SP = (size_t)DEPTH * BATCH * NG * NP;
constexpr size_t O_SIP = O_SRP + SZ_SP;
constexpr size_t O_LP = O_SIP + SZ_SP;
constexpr size_t SZ_LP = (size_t)DEPTH * BATCH * 512;
constexpr size_t O_CP = O_LP + SZ_LP;
constexpr size_t SZ_CP = (size_t)DEPTH * BATCH * 3 * 512;
constexpr size_t O_KS = O_CP + SZ_CP;
constexpr size_t SZ_KS = (size_t)DEPTH * DEC_BATCH * WINDOW * NKV * HD;
constexpr size_t O_VS = O_KS + SZ_KS;
constexpr size_t O_SRS = O_VS + SZ_KS;
constexpr size_t SZ_SS = (size_t)DEPTH * DEC_BATCH * NG * NP;
constexpr size_t O_SIS = O_SRS + SZ_SS;
constexpr size_t O_LS = O_SIS + SZ_SS;
constexpr size_t SZ_LS = (size_t)DEPTH * DEC_BATCH * 512;
constexpr size_t O_CS = O_LS + SZ_LS;
constexpr size_t SZ_CS = (size_t)DEPTH * DEC_BATCH * 3 * 512;
constexpr size_t O_END = O_CS + SZ_CS;

constexpr size_t WS_PROJ = 0;
constexpr size_t WS_XB = WS_PROJ + (size_t)M_TOT * IN_COLS * 2;
constexpr size_t WS_WOUT = WS_XB + (size_t)M_TOT * D_MODEL * 2;
constexpr size_t WS_TAB = WS_WOUT + (size_t)DEPTH * 1024 * 1024 * 2;
constexpr size_t TAB_AB = 0;
constexpr size_t TAB_BB = TAB_AB + (size_t)DEPTH * NG * NP * 2 * 4;
constexpr size_t TAB_BYTES = TAB_BB + (size_t)DEPTH * NG * NP * NC * 2 * 4;
constexpr size_t WS_END = WS_TAB + TAB_BYTES;
constexpr size_t DO_WIN = 0;
constexpr size_t DO_WBR = DO_WIN + (size_t)DEPTH * IN_COLS * 1024 * 2;
constexpr size_t DO_WGLU = DO_WBR + (size_t)DEPTH * 3 * 1024 * 512 * 2;
constexpr size_t DO_LRUW = DO_WGLU + (size_t)DEPTH * 512 * 512 * 2;
constexpr size_t DO_END = DO_LRUW;
static_assert(DO_END <= (size_t)M_P * D_MODEL * 4, "weights fit in y_prompt region");
static_assert(WS_END <= 268435456ull, "workspace fits 256 MiB");

__constant__ unsigned char T5_BUCKET[128] = {0, 1, 2, 3, 4, 5, 6, 7, 8, 9, 10, 11, 12, 13, 14, 15, 16, 16, 16, 17, 17, 18, 18, 18, 19, 19, 19, 20, 20, 20, 20, 21, 21, 21, 21, 22, 22, 22, 22, 22, 23, 23, 23, 23, 23, 23, 24, 24, 24, 24, 24, 24, 25, 25, 25, 25, 25, 25, 25, 26, 26, 26, 26, 26, 26, 26, 26, 27, 27, 27, 27, 27, 27, 27, 27, 27, 27, 28, 28, 28, 28, 28, 28, 28, 28, 28, 28, 29, 29, 29, 29, 29, 29, 29, 29, 29, 29, 29, 29, 30, 30, 30, 30, 30, 30, 30, 30, 30, 30, 30, 30, 30, 30, 31, 31, 31, 31, 31, 31, 31, 31, 31, 31, 31, 31, 31, 31, 31};

__device__ __forceinline__ float bf2f(bf16_t v) { return __uint_as_float(((unsigned)v) << 16); }
__device__ __forceinline__ bf16_t f2bf(float f) { unsigned u = __float_as_uint(f); return (bf16_t)((u + 0x7fffu + ((u >> 16) & 1u)) >> 16); }
__device__ __forceinline__ float sigmoidf_(float x) { return 1.0f / (1.0f + __expf(-x)); }
__device__ __forceinline__ float siluf_(float x) { return x * sigmoidf_(x); }
__device__ __forceinline__ float gelu_tanh(float y) { const float t = tanhf(0.7978845608028654f * (y + 0.044715f * y * y * y)); return 0.5f * y * (1.0f + t); }

struct P {
    const float* in[33];
    float* out;
    unsigned char* ws;
};

constexpr size_t WS_CTL = (WS_END + 4095) & ~(size_t)4095;
constexpr size_t CTL_BYTES = 65536;
static_assert(WS_CTL + CTL_BYTES <= 268435456ull, "workspace fits 256 MiB");
constexpr int NTHREADS = 512, NWAVES = 8;
constexpr int LDS_BYTES = 147456;
constexpr int LDS_MISC = 135168;

#define LAS __attribute__((address_space(3)))
#define XB_TMO      128
#define XB_XCNT(j)  (256  + 64 * (j))
#define XB_XSUB(j)  (1280 + 64 * (j))
#define XB_XGEN(j)  (2304 + 64 * (j))
#define XB_TOP      3328
#define XB_TOPGEN   3392
#define XCD_BAR_WORDS 3456
#define XB_SPIN_CAP (1u << 18)
__device__ __forceinline__ unsigned xb_ld(unsigned* p)              { return __hip_atomic_load(p, __ATOMIC_RELAXED, __HIP_MEMORY_SCOPE_AGENT); }
__device__ __forceinline__ unsigned xb_add(unsigned* p, unsigned v) { return __hip_atomic_fetch_add(p, v, __ATOMIC_RELAXED, __HIP_MEMORY_SCOPE_AGENT); }
__device__ __forceinline__ unsigned xb_xcc_id() { return (unsigned)__builtin_amdgcn_s_getreg((3 << 11) | 20) & 0xFu; }
#define XB_SPIN(cond, bar) do { unsigned _sp = 0; while (cond) { __builtin_amdgcn_s_sleep(1); \
    if ((++_sp & 255u) == 0u) { if (xb_ld(&(bar)[XB_TMO])) break; if (_sp > XB_SPIN_CAP) { atomicAdd(&(bar)[XB_TMO], 1u); break; } } } } while (0)
struct XcdBarrier { unsigned* bar; unsigned x; volatile LAS unsigned* st; };
__device__ __forceinline__ XcdBarrier xcd_barrier_post(unsigned* bar, volatile LAS unsigned* st) {
    XcdBarrier b; b.bar = bar; b.x = xb_xcc_id(); b.st = st;
    if (threadIdx.x == 0) (void)xb_add(&bar[XB_XCNT(b.x)], 1u);
    return b;
}
__device__ __forceinline__ void xcd_barrier_complete(unsigned* bar, unsigned x, unsigned& nloc, unsigned& nx) {
    const unsigned G = gridDim.x * gridDim.y * gridDim.z;
    unsigned sum, cnt, mine, sp = 0u;
    for (;;) {
        sum = 0u; cnt = 0u; mine = 0u;
#pragma unroll
        for (unsigned j = 0; j < 16; ++j) { const unsigned c = xb_ld(&bar[XB_XCNT(j)]); sum += c; cnt += (c > 0u) ? 1u : 0u; mine = (j == x) ? c : mine; }
        if (sum == G) break;
        __builtin_amdgcn_s_sleep(1);
        if ((++sp & 255u) == 0u) { if (xb_ld(&bar[XB_TMO])) break; if (sp > XB_SPIN_CAP) { atomicAdd(&bar[XB_TMO], 1u); break; } }
    }
    nloc = mine > 0u ? mine : 1u; nx = cnt > 0u ? cnt : 1u;
}
__device__ __forceinline__ void xcd_barrier(const XcdBarrier& b) {
    asm volatile("s_waitcnt vmcnt(0)" ::: "memory");
    __syncthreads();
    if (threadIdx.x == 0) {
        unsigned* bar = b.bar;
        __builtin_amdgcn_s_waitcnt(0);
        unsigned nloc = b.st[0], nx = b.st[1];
        if (nloc == 0u) { xcd_barrier_complete(bar, b.x, nloc, nx); b.st[0] = nloc; b.st[1] = nx; }
        const unsigned old = xb_add(&bar[XB_XSUB(b.x)], 1u);
        const unsigned gen = old / nloc;
        if (old + 1u == (gen + 1u) * nloc) {
            __builtin_amdgcn_fence(__ATOMIC_RELEASE, "agent");
            asm volatile("s_waitcnt vmcnt(0)" ::: "memory");
            const unsigned og = xb_add(&bar[XB_TOP], 1u);
            const unsigned tg = og / nx;
            if (og + 1u == (tg + 1u) * nx) xb_add(&bar[XB_TOPGEN], 1u);
            else XB_SPIN(xb_ld(&bar[XB_TOPGEN]) == tg, bar);
            __builtin_amdgcn_fence(__ATOMIC_ACQUIRE, "agent");
            xb_add(&bar[XB_XGEN(b.x)], 1u);
            asm volatile("s_waitcnt vmcnt(0)" ::: "memory");
        } else {
            XB_SPIN(xb_ld(&bar[XB_XGEN(b.x)]) == gen, bar);
            __builtin_amdgcn_fence(__ATOMIC_ACQUIRE, "agent");
            asm volatile("s_waitcnt vmcnt(0)" ::: "memory");
        }
    }
    __syncthreads();
}

struct Ctx { int tid, lane, wave, gw, ngw; size_t gt, ngt; };
#define WAVE_LDS_SYNC() do { asm volatile("s_waitcnt lgkmcnt(0)" ::: "memory"); __builtin_amdgcn_wave_barrier(); } while (0)

__device__ __forceinline__ void st_convert_x(const P& p, const Ctx& c) {
    bf16_t* XB = (bf16_t*)(p.ws + WS_XB);
    const size_t n = (size_t)M_TOT * D_MODEL;
    for (size_t i = c.gt; i < n; i += c.ngt) {
        const float v = i < (size_t)M_P * D_MODEL ? p.in[0][i] : p.in[1][i - (size_t)M_P * D_MODEL];
        XB[i] = f2bf(v);
    }
}
__device__ __forceinline__ void st_transpose_w(const float* W, bf16_t* WT, int K, int N, const Ctx& c) {
    const size_t n = (size_t)K * N;
    for (size_t i = c.gt; i < n; i += c.ngt) { const int nn = (int)(i / K), kk = (int)(i % K); WT[i] = f2bf(W[(size_t)kk * N + nn]); }
}
__device__ __forceinline__ void st_s5_tables(const P& p, const Ctx& c) {
    float* AB = (float*)(p.ws + WS_TAB + TAB_AB);
    float* BB = (float*)(p.ws + WS_TAB + TAB_BB);
    for (size_t ii = c.gt; ii < (size_t)DEPTH * NG * NP; ii += c.ngt) {
        const int i = (int)ii, l = i / (NG * NP), g = (i / NP) % NG;
        const float lr = fminf(p.in[12][i], -1e-4f), li = p.in[13][i];
        const float step = expf(p.in[14][l * NG + g]);
        const float mag = expf(lr * step);
        float sn, cs; sincosf(li * step, &sn, &cs);
        const float ab_re = mag * cs, ab_im = mag * sn;
        const float den = lr * lr + li * li;
        const float f_re = ((ab_re - 1.0f) * lr + ab_im * li) / den;
        const float f_im = (ab_im * lr - (ab_re - 1.0f) * li) / den;
        AB[2 * i] = ab_re; AB[2 * i + 1] = ab_im;
        for (int cc = 0; cc < NC; ++cc) {
            const float bre = p.in[15][(size_t)i * NC + cc], bim = p.in[16][(size_t)i * NC + cc];
            BB[((size_t)i * NC + cc) * 2] = f_re * bre - f_im * bim;
            BB[((size_t)i * NC + cc) * 2 + 1] = f_re * bim + f_im * bre;
        }
    }
}

template <class Epi>
__device__ __forceinline__ void gemm_simple(const bf16_t* A, int lda, const bf16_t* Bt, int ldb, int M, int N, int K, Epi epi, const Ctx& c) {
    const int lane = c.lane;
    const int ntn = N / 32, ntiles = (M / 32) * ntn;
    for (int tile = c.gw; tile < ntiles; tile += c.ngw) {
        const int tm = tile / ntn, tn = tile % ntn;
        f32x16 acc = {};
        const bf16_t* ar = A + (size_t)(tm * 32 + (lane & 31)) * lda + 8 * (lane >> 5);
        const bf16_t* br = Bt + (size_t)(tn * 32 + (lane & 31)) * ldb + 8 * (lane >> 5);
        for (int k0 = 0; k0 < K; k0 += 16) {
            const bf16x8 a = *(const bf16x8*)(ar + k0);
            const bf16x8 b = *(const bf16x8*)(br + k0);
            acc = __builtin_amdgcn_mfma_f32_32x32x16_bf16(a, b, acc, 0, 0, 0);
        }
#pragma unroll
        for (int r = 0; r < 16; ++r) {
            const int row = tm * 32 + (r & 3) + 8 * (r >> 2) + 4 * (lane >> 5), col = tn * 32 + (lane & 31);
            epi(row, col, acc[r]);
        }
    }
}
struct EpiProj { bf16_t* PROJ; __device__ void operator()(int r, int c, float v) const { PROJ[(size_t)r * IN_COLS + c] = f2bf(v); } };

__device__ __forceinline__ void st_kv_out(const P& p, int l, const Ctx& c) {
    const bf16_t* PROJ = (const bf16_t*)(p.ws + WS_PROJ);
    for (size_t ii = c.gt; ii < (size_t)DEC_BATCH * WINDOW * 128; ii += c.ngt) {
        const int i = (int)ii;
        if (i < BATCH * WINDOW * 128) {
            const int b = i / (WINDOW * 128), w = (i / 128) % WINDOW, cc = i % 128;
            const size_t row = (size_t)b * SEQ + (SEQ - WINDOW) + w;
            p.out[O_KP + (size_t)l * BATCH * WINDOW * 128 + i] = bf2f(PROJ[row * IN_COLS + C_K + cc]);
            p.out[O_VP + (size_t)l * BATCH * WINDOW * 128 + i] = bf2f(PROJ[row * IN_COLS + C_V + cc]);
        }
        {
            const int b = i / (WINDOW * 128), w = (i / 128) % WINDOW, cc = i % 128;
            float kv, vv;
            if (w < WINDOW - DEC_SEQ) {
                const size_t ci = (((size_t)l * DEC_BATCH + b) * WINDOW + (w + DEC_SEQ)) * 128 + cc;
                kv = p.in[2][ci]; vv = p.in[3][ci];
            } else {
                const size_t row = (size_t)M_P + b * DEC_SEQ + (w - (WINDOW - DEC_SEQ));
                kv = bf2f(PROJ[row * IN_COLS + C_K + cc]); vv = bf2f(PROJ[row * IN_COLS + C_V + cc]);
            }
            p.out[O_KS + (size_t)l * DEC_BATCH * WINDOW * 128 + i] = kv;
            p.out[O_VS + (size_t)l * DEC_BATCH * WINDOW * 128 + i] = vv;
        }
    }
}

__device__ __forceinline__ void st_attn_simple(const P& p, int l, const Ctx& c) {
    bf16_t* PROJ = (bf16_t*)(p.ws + WS_PROJ);
    const int lane = c.lane;
    const float* rel_bias = p.in[8];
    for (int item = c.gw; item < M_TOT * NQH; item += c.ngw) {
        const int m = item / NQH, h = item % NQH, kvh = h / 4;
        const bool samp = m >= M_P;
        const int b = samp ? (m - M_P) / DEC_SEQ : m / SEQ, t = samp ? (m - M_P) % DEC_SEQ : m % SEQ;
        float q[64];
        {
            const bf16_t* qp = PROJ + (size_t)m * IN_COLS + C_Q + h * 64;
#pragma unroll
            for (int d = 0; d < 64; ++d) q[d] = bf2f(qp[d]);
        }
        const float sink = p.in[10][l * NQH + h];
        float s[2];
#pragma unroll
        for (int j = 0; j < 2; ++j) {
            const int d = lane + 64 * j;
            const int tk = t - d;
            float sc = -1e30f;
            if (!samp) {
                if (tk >= 0) {
                    const bf16_t* kp = PROJ + ((size_t)b * SEQ + tk) * IN_COLS + C_K + kvh * 64;
                    float a = 0.f;
#pragma unroll
                    for (int e = 0; e < 64; ++e) a += q[e] * bf2f(kp[e]);
                    sc = a * 0.125f + rel_bias[T5_BUCKET[d] * NQH + h];
                }
            } else {
                float a = 0.f;
                if (tk >= 0) {
                    const bf16_t* kp = PROJ + ((size_t)M_P + b * DEC_SEQ + tk) * IN_COLS + C_K + kvh * 64;
#pragma unroll
                    for (int e = 0; e < 64; ++e) a += q[e] * bf2f(kp[e]);
                } else {
                    const float* kp = p.in[2] + ((((size_t)l * DEC_BATCH + b) * WINDOW + (WINDOW + tk)) * NKV + kvh) * HD;
#pragma unroll
                    for (int e = 0; e < 64; ++e) a += q[e] * kp[e];
                }
                sc = a * 0.125f + rel_bias[T5_BUCKET[d] * NQH + h];
            }
            s[j] = sc;
        }
        float mx = fmaxf(fmaxf(s[0], s[1]), sink);
        for (int o = 32; o > 0; o >>= 1) mx = fmaxf(mx, __shfl_xor(mx, o));
        const float p0 = s[0] > -1e29f ? __expf(s[0] - mx) : 0.f, p1 = s[1] > -1e29f ? __expf(s[1] - mx) : 0.f;
        float sum = p0 + p1;
        for (int o = 32; o > 0; o >>= 1) sum += __shfl_xor(sum, o);
        const float denom = sum + __expf(sink - mx);
        float o = 0.f;
        for (int d = 0; d < 128; ++d) {
            const float pj = __shfl(d < 64 ? p0 : p1, d & 63);
            const int tk = t - d;
            float vv = 0.f;
            if (!samp) { if (tk >= 0) vv = bf2f(PROJ[((size_t)b * SEQ + tk) * IN_COLS + C_V + kvh * 64 + lane]); }
            else if (tk >= 0) vv = bf2f(PROJ[((size_t)M_P + b * DEC_SEQ + tk) * IN_COLS + C_V + kvh * 64 + lane]);
            else vv = p.in[3][((((size_t)l * DEC_BATCH + b) * WINDOW + (WINDOW + tk)) * NKV + kvh) * HD + lane];
            o += pj * vv;
        }
        o /= denom;
        const float ga = bf2f(PROJ[(size_t)m * IN_COLS + C_GA + h * 64 + lane]);
        PROJ[(size_t)m * IN_COLS + C_Q + h * 64 + lane] = f2bf(o * siluf_(ga));
    }
}

__device__ __forceinline__ void st_s5_simple(const P& p, int l, const Ctx& c, LAS float* wsm) {
    bf16_t* PROJ = (bf16_t*)(p.ws + WS_PROJ);
    const float* AB = (const float*)(p.ws + WS_TAB + TAB_AB);
    const float* BB = (const float*)(p.ws + WS_TAB + TAB_BB);
    const int pp = c.lane;
    for (int item = c.gw; item < (BATCH + DEC_BATCH) * NG; item += c.ngw) {
        const int seq = item / NG, g = item % NG;
        const bool samp = seq >= BATCH;
        const int b = samp ? seq - BATCH : seq, T = samp ? DEC_SEQ : SEQ;
        const size_t row0 = samp ? (size_t)M_P + b * DEC_SEQ : (size_t)b * SEQ;
        const int sidx = (l * NG + g) * NP + pp;
        const float ab_re = AB[2 * sidx], ab_im = AB[2 * sidx + 1];
        float bbr[16], bbi[16], cr[16], ci[16];
#pragma unroll
        for (int cc = 0; cc < 16; ++cc) {
            bbr[cc] = BB[((size_t)sidx * NC + cc) * 2]; bbi[cc] = BB[((size_t)sidx * NC + cc) * 2 + 1];
            cr[cc] = p.in[17][((size_t)(l * NG + g) * NC + cc) * NP + pp]; ci[cc] = p.in[18][((size_t)(l * NG + g) * NC + cc) * NP + pp];
        }
        const float dd = pp < 16 ? p.in[19][l * 512 + g * 16 + pp] : 0.f;
        float hr = 0.f, hi = 0.f;
        if (samp) { const size_t si = (((size_t)l * DEC_BATCH + b) * NG + g) * NP + pp; hr = p.in[4][si]; hi = p.in[5][si]; }
        for (int t = 0; t < T; ++t) {
            bf16_t* up = PROJ + (row0 + t) * IN_COLS + C_UB + g * 16;
            float u[16];
#pragma unroll
            for (int cc = 0; cc < 16; ++cc) u[cc] = bf2f(up[cc]);
            float xr = 0.f, xi = 0.f;
#pragma unroll
            for (int cc = 0; cc < 16; ++cc) { xr += bbr[cc] * u[cc]; xi += bbi[cc] * u[cc]; }
            const float nr = ab_re * hr - ab_im * hi + xr, ni = ab_re * hi + ab_im * hr + xi;
            hr = nr; hi = ni;
#pragma unroll
            for (int cc = 0; cc < 16; ++cc) wsm[pp * 17 + cc] = cr[cc] * hr - ci[cc] * hi;
            WAVE_LDS_SYNC();
            if (pp < 16) {
                float y = 0.f;
                for (int q = 0; q < 64; ++q) y += wsm[q * 17 + pp];
                y += dd * bf2f(up[pp]);
                up[pp] = f2bf(gelu_tanh(y));
            }
            WAVE_LDS_SYNC();
        }
        if (!samp) { const size_t oi = (((size_t)l * BATCH + b) * NG + g) * NP + pp; p.out[O_SRP + oi] = hr; p.out[O_SIP + oi] = hi; }
        else { const size_t oi = (((size_t)l * DEC_BATCH + b) * NG + g) * NP + pp; p.out[O_SRS + oi] = hr; p.out[O_SIS + oi] = hi; }
    }
}

struct EpiGlu { bf16_t* PROJ; __device__ void operator()(int r, int c, float v) const {
    const float z = bf2f(PROJ[(size_t)r * IN_COLS + C_UB + c]), gb = bf2f(PROJ[(size_t)r * IN_COLS + C_GB + c]);
    PROJ[(size_t)r * IN_COLS + C_GB + c] = f2bf(z * sigmoidf_(v) * siluf_(gb)); } };

__device__ __forceinline__ void st_lru_simple(const P& p, int l, const Ctx& c, LAS float* wsm) {
    bf16_t* PROJ = (bf16_t*)(p.ws + WS_PROJ);
    const int e = c.lane;
    for (int item = c.gw; item < (BATCH + DEC_BATCH) * 8; item += c.ngw) {
        const int seq = item / 8, n = item % 8, ch = n * 64 + e;
        const bool samp = seq >= BATCH;
        const int b = samp ? seq - BATCH : seq, T = samp ? DEC_SEQ : SEQ;
        const size_t row0 = samp ? (size_t)M_P + b * DEC_SEQ : (size_t)b * SEQ;
        float wa[64], wx[64];
#pragma unroll
        for (int d = 0; d < 64; ++d) { wa[d] = p.in[24][(((size_t)l * 8 + n) * 64 + d) * 64 + e]; wx[d] = p.in[26][(((size_t)l * 8 + n) * 64 + d) * 64 + e]; }
        const float ba = p.in[25][l * 512 + ch], bx = p.in[27][l * 512 + ch], lam = p.in[28][l * 512 + ch];
        const float lsig = -log1pf(expf(-lam));
        const float cw0 = p.in[22][(l * 4 + 0) * 512 + ch], cw1 = p.in[22][(l * 4 + 1) * 512 + ch], cw2 = p.in[22][(l * 4 + 2) * 512 + ch], cw3 = p.in[22][(l * 4 + 3) * 512 + ch];
        const float cb = p.in[23][l * 512 + ch];
        float xm3 = 0.f, xm2 = 0.f, xm1 = 0.f, h = 0.f;
        if (samp) {
            const size_t ci = (((size_t)l * DEC_BATCH + b) * 3) * 512 + ch;
            xm3 = p.in[7][ci]; xm2 = p.in[7][ci + 512]; xm1 = p.in[7][ci + 1024];
            h = p.in[6][((size_t)l * DEC_BATCH + b) * 512 + ch];
        }
        for (int t = 0; t < T; ++t) {
            bf16_t* rp = PROJ + (row0 + t) * IN_COLS;
            const float xc = bf2f(rp[C_XC + ch]);
            const float xf = cb + cw0 * xm3 + cw1 * xm2 + cw2 * xm1 + cw3 * xc;
            xm3 = xm2; xm2 = xm1; xm1 = xc;
            wsm[e] = xf;
            WAVE_LDS_SYNC();
            float r = ba, i = bx;
#pragma unroll
            for (int d = 0; d < 64; ++d) { const float xv = wsm[d]; r += xv * wa[d]; i += xv * wx[d]; }
            WAVE_LDS_SYNC();
            r = sigmoidf_(r); i = sigmoidf_(i);
            const float log_a = 8.0f * r * lsig;
            const float a = expf(log_a);
            const float bt = xf * i * sqrtf(-expm1f(2.0f * log_a));
            h = a * h + bt;
            const float gc = bf2f(rp[C_GC + ch]);
            rp[C_XC + ch] = f2bf(h * siluf_(gc));
        }
        if (!samp) {
            p.out[O_LP + ((size_t)l * BATCH + b) * 512 + ch] = h;
            const size_t ci = (((size_t)l * BATCH + b) * 3) * 512 + ch;
            p.out[O_CP + ci] = xm3; p.out[O_CP + ci + 512] = xm2; p.out[O_CP + ci + 1024] = xm1;
        } else {
            p.out[O_LS + ((size_t)l * DEC_BATCH + b) * 512 + ch] = h;
            const size_t ci = (((size_t)l * DEC_BATCH + b) * 3) * 512 + ch;
            p.out[O_CS + ci] = xm3; p.out[O_CS + ci + 512] = xm2; p.out[O_CS + ci + 1024] = xm1;
        }
    }
}

__device__ __forceinline__ void st_branch_simple(const P& p, int l, const Ctx& c) {
    bf16_t* PROJ = (bf16_t*)(p.ws + WS_PROJ);
    const bf16_t* WB = (const bf16_t*)((unsigned char*)p.out + DO_WBR) + (size_t)l * 3 * 1024 * 512;
    const int lane = c.lane;
    const int ntn = 1024 / 32, ntiles = (M_TOT / 32) * ntn;
    for (int tile = c.gw; tile < ntiles; tile += c.ngw) {
        const int tm = tile / ntn, tn = tile % ntn;
        f32x16 acc[3];
#pragma unroll
        for (int br = 0; br < 3; ++br) {
            const int acol = br == 0 ? C_Q : (br == 1 ? C_GB : C_XC);
            acc[br] = (f32x16){};
            const bf16_t* ar = PROJ + (size_t)(tm * 32 + (lane & 31)) * IN_COLS + acol + 8 * (lane >> 5);
            const bf16_t* bp = WB + (size_t)br * 1024 * 512 + (size_t)(tn * 32 + (lane & 31)) * 512 + 8 * (lane >> 5);
            for (int k0 = 0; k0 < 512; k0 += 16)
                acc[br] = __builtin_amdgcn_mfma_f32_32x32x16_bf16(*(const bf16x8*)(ar + k0), *(const bf16x8*)(bp + k0), acc[br], 0, 0, 0);
        }
#pragma unroll
        for (int r = 0; r < 16; ++r) {
            const int row = tm * 32 + (r & 3) + 8 * (r >> 2) + 4 * (lane >> 5), col = tn * 32 + (lane & 31);
            bf16_t* gp = PROJ + (size_t)row * IN_COLS + C_GM + col;
            const float m = sigmoidf_(bf2f(gp[0])) * acc[0][r] + sigmoidf_(bf2f(gp[1024])) * acc[1][r] + sigmoidf_(bf2f(gp[2048])) * acc[2][r];
            gp[0] = f2bf(m);
        }
    }
}

__device__ __forceinline__ float* pre_row(unsigned char* ws, int r) { return (float*)(ws + WS_PROJ + (size_t)r * IN_COLS * 2 + (size_t)(C_GM + 1024) * 2); }
struct EpiOut { const P* p; int l; __device__ void operator()(int r, int c, float v) const {
    float x;
    if (l == 0) x = r < M_P ? p->in[0][(size_t)r * D_MODEL + c] : p->in[1][(size_t)(r - M_P) * D_MODEL + c];
    else x = bf2f(((const bf16_t*)(p->ws + WS_XB))[(size_t)r * D_MODEL + c]);
    pre_row(p->ws, r)[c] = DN_ALPHA * x + v; } };

__device__ __forceinline__ void st_ln(const P& p, int l, const Ctx& c) {
    const int lane = c.lane;
    const float* g = p.in[31] + l * 1024; const float* bb = p.in[32] + l * 1024;
    for (int r = c.gw; r < M_TOT; r += c.ngw) {
        const float* pr = pre_row(p.ws, r);
        float v[16]; float s = 0.f;
#pragma unroll
        for (int j = 0; j < 16; ++j) { v[j] = pr[lane + 64 * j]; s += v[j]; }
        for (int o = 32; o > 0; o >>= 1) s += __shfl_xor(s, o);
        const float mu = s * (1.0f / 1024.0f);
        float q = 0.f;
#pragma unroll
        for (int j = 0; j < 16; ++j) { const float d = v[j] - mu; q += d * d; }
        for (int o = 32; o > 0; o >>= 1) q += __shfl_xor(q, o);
        const float rstd = rsqrtf(q * (1.0f / 1024.0f) + LN_EPS);
#pragma unroll
        for (int j = 0; j < 16; ++j) {
            const int cc = lane + 64 * j;
            const float y = (v[j] - mu) * rstd * g[cc] + bb[cc];
            if (l == 0) ((bf16_t*)(p.ws + WS_XB))[(size_t)r * D_MODEL + cc] = f2bf(y);
            else if (r < M_P) p.out[O_YP + (size_t)r * D_MODEL + cc] = y;
            else p.out[O_YS + (size_t)(r - M_P) * D_MODEL + cc] = y;
        }
    }
}

__global__ void __launch_bounds__(NTHREADS) mega_fwd(P p) {
    extern __shared__ __attribute__((aligned(16))) unsigned char lds_raw[];
    LAS unsigned char* lds = (LAS unsigned char*)lds_raw;
    Ctx c;
    c.tid = threadIdx.x; c.lane = c.tid & 63; c.wave = __builtin_amdgcn_readfirstlane(c.tid >> 6);
    c.gw = c.wave * gridDim.x + blockIdx.x; c.ngw = gridDim.x * NWAVES;
    c.gt = (size_t)blockIdx.x * NTHREADS + c.tid; c.ngt = (size_t)gridDim.x * NTHREADS;
    volatile LAS unsigned* misc = (volatile LAS unsigned*)(lds + LDS_MISC);
    if (c.tid < 32) misc[c.tid] = 0u;
    __syncthreads();
    XcdBarrier bar = xcd_barrier_post((unsigned*)(p.ws + WS_CTL), misc);
    LAS float* wsm = (LAS float*)(lds + c.wave * 8192);
    unsigned char* dob = (unsigned char*)p.out;
    bf16_t* PROJ = (bf16_t*)(p.ws + WS_PROJ);

    st_convert_x(p, c);
    for (int l = 0; l < DEPTH; ++l) {
        st_transpose_w(p.in[9] + (size_t)l * 1024 * IN_COLS, (bf16_t*)(dob + DO_WIN) + (size_t)l * IN_COLS * 1024, 1024, IN_COLS, c);
        st_transpose_w(p.in[11] + (size_t)l * 512 * 1024, (bf16_t*)(dob + DO_WBR) + ((size_t)l * 3 + 0) * 1024 * 512, 512, 1024, c);
        st_transpose_w(p.in[21] + (size_t)l * 512 * 1024, (bf16_t*)(dob + DO_WBR) + ((size_t)l * 3 + 1) * 1024 * 512, 512, 1024, c);
        st_transpose_w(p.in[29] + (size_t)l * 512 * 1024, (bf16_t*)(dob + DO_WBR) + ((size_t)l * 3 + 2) * 1024 * 512, 512, 1024, c);
        st_transpose_w(p.in[20] + (size_t)l * 512 * 512, (bf16_t*)(dob + DO_WGLU) + (size_t)l * 512 * 512, 512, 512, c);
        st_transpose_w(p.in[30] + (size_t)l * 1024 * 1024, (bf16_t*)(p.ws + WS_WOUT) + (size_t)l * 1024 * 1024, 1024, 1024, c);
    }
    st_s5_tables(p, c);
    xcd_barrier(bar);

    for (int l = 0; l < DEPTH; ++l) {
        gemm_simple((const bf16_t*)(p.ws + WS_XB), D_MODEL, (const bf16_t*)(dob + DO_WIN) + (size_t)l * IN_COLS * 1024, 1024, M_TOT, IN_COLS, 1024, EpiProj{PROJ}, c);
        xcd_barrier(bar);
        st_kv_out(p, l, c);
        st_s5_simple(p, l, c, wsm);
        st_lru_simple(p, l, c, wsm);
        st_attn_simple(p, l, c);
        xcd_barrier(bar);
        gemm_simple(PROJ + C_UB, IN_COLS, (const bf16_t*)(dob + DO_WGLU) + (size_t)l * 512 * 512, 512, M_TOT, 512, 512, EpiGlu{PROJ}, c);
        xcd_barrier(bar);
        st_branch_simple(p, l, c);
        xcd_barrier(bar);
        gemm_simple(PROJ + C_GM, IN_COLS, (const bf16_t*)(p.ws + WS_WOUT) + (size_t)l * 1024 * 1024, 1024, M_TOT, 1024, 1024, EpiOut{&p, l}, c);
        xcd_barrier(bar);
        st_ln(p, l, c);
        if (l + 1 < DEPTH) xcd_barrier(bar);
    }
}

extern "C" void kernel_launch(void* const* d_in, const int* in_sizes, int n_in, void* d_out, int out_size, void* d_ws, size_t ws_size, hipStream_t stream) {
    static int grid = 0;
    if (grid == 0) {
        if (n_in != 33 || (size_t)out_size != O_END || ws_size < WS_CTL + CTL_BYTES) { fprintf(stderr, "kernel_launch: unexpected sizes n_in %d out %d ws %zu\n", n_in, out_size, ws_size); grid = -1; return; }
        int dev = 0, cus = 0, per_cu = 0;
        if (hipGetDevice(&dev) != hipSuccess || hipDeviceGetAttribute(&cus, hipDeviceAttributeMultiprocessorCount, dev) != hipSuccess) { grid = -1; return; }
        if (hipFuncSetAttribute((const void*)mega_fwd, hipFuncAttributeMaxDynamicSharedMemorySize, LDS_BYTES) != hipSuccess) { fprintf(stderr, "kernel_launch: hipFuncSetAttribute failed\n"); grid = -1; return; }
        if (hipOccupancyMaxActiveBlocksPerMultiprocessor(&per_cu, (const void*)mega_fwd, NTHREADS, LDS_BYTES) != hipSuccess || per_cu < 1) { fprintf(stderr, "kernel_launch: occupancy query says %d blocks/CU\n", per_cu); grid = -1; return; }
        grid = cus;
    }
    if (grid < 0) return;
    (void)hipMemsetAsync((unsigned char*)d_ws + WS_CTL, 0, CTL_BYTES, stream);
    P p{};
    for (int i = 0; i < 33; ++i) p.in[i] = (const float*)d_in[i];
    p.out = (float*)d_out; p.ws = (unsigned char*)d_ws;
    void* args[] = {&p};
    hipError_t e = hipLaunchCooperativeKernel((const void*)mega_fwd, dim3(grid), dim3(NTHREADS), args, LDS_BYTES, stream);
    if (e != hipSuccess) fprintf(stderr, "kernel_launch: cooperative launch failed: %s (grid %d)\n", hipGetErrorString(e), grid);
}
```

```cpp
#include <hip/hip_runtime.h>
#include <cstdint>
#include <cstdio>

typedef unsigned short bf16_t;
typedef short bf16x8 __attribute__((ext_vector_type(8)));
typedef float f32x16 __attribute__((ext_vector_type(16)));
typedef float f32x4 __attribute__((ext_vector_type(4)));

constexpr int D_MODEL = 1024, BATCH = 8, SEQ = 2048, DEPTH = 2, DEC_BATCH = 128, DEC_SEQ = 4;
constexpr int M_P = BATCH * SEQ;
constexpr int M_S = DEC_BATCH * DEC_SEQ;
constexpr int M_TOT = M_P + M_S;
constexpr int IN_COLS = 6400;
constexpr int C_Q = 0, C_K = 512, C_V = 640, C_GA = 768, C_UB = 1280, C_GB = 1792, C_XC = 2304, C_GC = 2816, C_GM = 3328;
constexpr int WINDOW = 128, NKV = 2, HD = 64, NQH = 8;
constexpr int NG = 32, NP = 64, NC = 16;
constexpr float DN_ALPHA = 1.4142135623730951f;
constexpr float LN_EPS = 1e-5f;

constexpr size_t O_YP = 0;
constexpr size_t O_YS = O_YP + (size_t)M_P * D_MODEL;
constexpr size_t O_KP = O_YS + (size_t)M_S * D_MODEL;
constexpr size_t SZ_KP = (size_t)DEPTH * BATCH * WINDOW * NKV * HD;
constexpr size_t O_VP = O_KP + SZ_KP;
constexpr size_t O_SRP = O_VP + SZ_KP;
constexpr size_t SZ_SP = (size_t)DEPTH * BATCH * NG * NP;
constexpr size_t O_SIP = O_SRP + SZ_SP;
constexpr size_t O_LP = O_SIP + SZ_SP;
constexpr size_t SZ_LP = (size_t)DEPTH * BATCH * 512;
constexpr size_t O_CP = O_LP + SZ_LP;
constexpr size_t SZ_CP = (size_t)DEPTH * BATCH * 3 * 512;
constexpr size_t O_KS = O_CP + SZ_CP;
constexpr size_t SZ_KS = (size_t)DEPTH * DEC_BATCH * WINDOW * NKV * HD;
constexpr size_t O_VS = O_KS + SZ_KS;
constexpr size_t O_SRS = O_VS + SZ_KS;
constexpr size_t SZ_SS = (size_t)DEPTH * DEC_BATCH * NG * NP;
constexpr size_t O_SIS = O_SRS + SZ_SS;
constexpr size_t O_LS = O_SIS + SZ_SS;
constexpr size_t SZ_LS = (size_t)DEPTH * DEC_BATCH * 512;
constexpr size_t O_CS = O_LS + SZ_LS;
constexpr size_t SZ_CS = (size_t)DEPTH * DEC_BATCH * 3 * 512;
constexpr size_t O_END = O_CS + SZ_CS;

constexpr size_t WS_PROJ = 0;
constexpr size_t WS_XB = WS_PROJ + (size_t)M_TOT * IN_COLS * 2;
constexpr size_t WS_WOUT = WS_XB + (size_t)M_TOT * D_MODEL * 2;
constexpr size_t WS_TAB = WS_WOUT + (size_t)DEPTH * 1024 * 1024 * 2;
constexpr size_t TAB_AB = 0;
constexpr size_t TAB_BB = TAB_AB + (size_t)DEPTH * NG * NP * 2 * 4;
constexpr size_t TAB_BYTES = TAB_BB + (size_t)DEPTH * NG * NP * NC * 2 * 4;
constexpr size_t WS_END = WS_TAB + TAB_BYTES;
constexpr size_t DO_WIN = 0;
constexpr size_t DO_WBR = DO_WIN + (size_t)DEPTH * IN_COLS * 1024 * 2;
constexpr size_t DO_WGLU = DO_WBR + (size_t)DEPTH * 3 * 1024 * 512 * 2;
constexpr size_t DO_LRUW = DO_WGLU + (size_t)DEPTH * 512 * 512 * 2;
constexpr size_t DO_END = DO_LRUW;
static_assert(DO_END <= (size_t)M_P * D_MODEL * 4, "weights fit in y_prompt region");
static_assert(WS_END <= 268435456ull, "workspace fits 256 MiB");

__constant__ unsigned char T5_BUCKET[128] = {0, 1, 2, 3, 4, 5, 6, 7, 8, 9, 10, 11, 12, 13, 14, 15, 16, 16, 16, 17, 17, 18, 18, 18, 19, 19, 19, 20, 20, 20, 20, 21, 21, 21, 21, 22, 22, 22, 22, 22, 23, 23, 23, 23, 23, 23, 24, 24, 24, 24, 24, 24, 25, 25, 25, 25, 25, 25, 25, 26, 26, 26, 26, 26, 26, 26, 26, 27, 27, 27, 27, 27, 27, 27, 27, 27, 27, 28, 28, 28, 28, 28, 28, 28, 28, 28, 28, 29, 29, 29, 29, 29, 29, 29, 29, 29, 29, 29, 29, 30, 30, 30, 30, 30, 30, 30, 30, 30, 30, 30, 30, 30, 30, 31, 31, 31, 31, 31, 31, 31, 31, 31, 31, 31, 31, 31, 31, 31};

__device__ __forceinline__ float bf2f(bf16_t v) { return __uint_as_float(((unsigned)v) << 16); }
__device__ __forceinline__ bf16_t f2bf(float f) { unsigned u = __float_as_uint(f); return (bf16_t)((u + 0x7fffu + ((u >> 16) & 1u)) >> 16); }
__device__ __forceinline__ float sigmoidf_(float x) { return 1.0f / (1.0f + __expf(-x)); }
__device__ __forceinline__ float siluf_(float x) { return x * sigmoidf_(x); }
__device__ __forceinline__ float gelu_tanh(float y) { const float t = tanhf(0.7978845608028654f * (y + 0.044715f * y * y * y)); return 0.5f * y * (1.0f + t); }

struct P {
    const float* in[33];
    float* out;
    unsigned char* ws;
};

typedef const P __attribute__((address_space(4)))* KP;
__device__ __forceinline__ KP get_kp() { KP k = (KP)__builtin_amdgcn_kernarg_segment_ptr(); asm volatile("" : "+s"(k)); return k; }

constexpr size_t WS_CTL = (WS_END + 4095) & ~(size_t)4095;
constexpr size_t CTL_BYTES = 65536;
static_assert(WS_CTL + CTL_BYTES <= 268435456ull, "workspace fits 256 MiB");
constexpr int NTHREADS = 512, NWAVES = 8;
constexpr int LDS_BYTES = 147456;
constexpr int LDS_MISC = 135168;

#define LAS __attribute__((address_space(3)))
#define XB_TMO      128
#define XB_XCNT(j)  (256  + 64 * (j))
#define XB_XSUB(j)  (1280 + 64 * (j))
#define XB_XGEN(j)  (2304 + 64 * (j))
#define XB_TOP      3328
#define XB_TOPGEN   3392
#define XCD_BAR_WORDS 3456
#define XB_SPIN_CAP (1u << 18)
__device__ __forceinline__ unsigned xb_ld(unsigned* p)              { return __hip_atomic_load(p, __ATOMIC_RELAXED, __HIP_MEMORY_SCOPE_AGENT); }
__device__ __forceinline__ unsigned xb_add(unsigned* p, unsigned v) { return __hip_atomic_fetch_add(p, v, __ATOMIC_RELAXED, __HIP_MEMORY_SCOPE_AGENT); }
__device__ __forceinline__ unsigned xb_xcc_id() { return (unsigned)__builtin_amdgcn_s_getreg((3 << 11) | 20) & 0xFu; }
#define XB_SPIN(cond, bar) do { unsigned _sp = 0; while (cond) { __builtin_amdgcn_s_sleep(1); \
    if ((++_sp & 255u) == 0u) { if (xb_ld(&(bar)[XB_TMO])) break; if (_sp > XB_SPIN_CAP) { atomicAdd(&(bar)[XB_TMO], 1u); break; } } } } while (0)
struct XcdBarrier { unsigned* bar; unsigned x; volatile LAS unsigned* st; };
__device__ __forceinline__ XcdBarrier xcd_barrier_post(unsigned* bar, volatile LAS unsigned* st) {
    XcdBarrier b; b.bar = bar; b.x = xb_xcc_id(); b.st = st;
    if (threadIdx.x == 0) (void)xb_add(&bar[XB_XCNT(b.x)], 1u);
    return b;
}
__device__ __forceinline__ void xcd_barrier_complete(unsigned* bar, unsigned x, unsigned& nloc, unsigned& nx) {
    const unsigned G = gridDim.x * gridDim.y * gridDim.z;
    unsigned sum, cnt, mine, sp = 0u;
    for (;;) {
        sum = 0u; cnt = 0u; mine = 0u;
#pragma unroll
        for (unsigned j = 0; j < 16; ++j) { const unsigned c = xb_ld(&bar[XB_XCNT(j)]); sum += c; cnt += (c > 0u) ? 1u : 0u; mine = (j == x) ? c : mine; }
        if (sum == G) break;
        __builtin_amdgcn_s_sleep(1);
        if ((++sp & 255u) == 0u) { if (xb_ld(&bar[XB_TMO])) break; if (sp > XB_SPIN_CAP) { atomicAdd(&bar[XB_TMO], 1u); break; } }
    }
    nloc = mine > 0u ? mine : 1u; nx = cnt > 0u ? cnt : 1u;
}
__device__ __forceinline__ void xcd_barrier(const XcdBarrier& b) {
    asm volatile("s_waitcnt vmcnt(0)" ::: "memory");
    __syncthreads();
    if (threadIdx.x == 0) {
        unsigned* bar = b.bar;
        __builtin_amdgcn_s_waitcnt(0);
        unsigned nloc = b.st[0], nx = b.st[1];
        if (nloc == 0u) { xcd_barrier_complete(bar, b.x, nloc, nx); b.st[0] = nloc; b.st[1] = nx; }
        const unsigned old = xb_add(&bar[XB_XSUB(b.x)], 1u);
        const unsigned gen = old / nloc;
        if (old + 1u == (gen + 1u) * nloc) {
            __builtin_amdgcn_fence(__ATOMIC_RELEASE, "agent");
            asm volatile("s_waitcnt vmcnt(0)" ::: "memory");
            const unsigned og = xb_add(&bar[XB_TOP], 1u);
            const unsigned tg = og / nx;
            if (og + 1u == (tg + 1u) * nx) xb_add(&bar[XB_TOPGEN], 1u);
            else XB_SPIN(xb_ld(&bar[XB_TOPGEN]) == tg, bar);
            __builtin_amdgcn_fence(__ATOMIC_ACQUIRE, "agent");
            xb_add(&bar[XB_XGEN(b.x)], 1u);
            asm volatile("s_waitcnt vmcnt(0)" ::: "memory");
        } else {
            XB_SPIN(xb_ld(&bar[XB_XGEN(b.x)]) == gen, bar);
            __builtin_amdgcn_fence(__ATOMIC_ACQUIRE, "agent");
            asm volatile("s_waitcnt vmcnt(0)" ::: "memory");
        }
    }
    __syncthreads();
}

namespace pg8 {
#define PG8_LAS __attribute__((address_space(3)))
typedef unsigned short bf16_t;
typedef short bf16x8 __attribute__((ext_vector_type(8)));
typedef float f32x4 __attribute__((ext_vector_type(4)));
typedef unsigned u32x4 __attribute__((ext_vector_type(4)));
constexpr int BM = 256, BK = 64, HALF = 128, HTB = HALF * BK * 2  , STAGE_BYTES = 8 * HTB, NXCD = 8, WGM = 8;

__host__ __device__ __forceinline__ int lds_byte(int r, int c) { const int st = (r >> 4) * 2 + (c >> 5), rr = r & 15, cc = c & 31, ob = rr * 64 + cc * 2; return st * 1024 + (ob ^ (((ob >> 9) & 1) << 5)); }
__host__ __device__ __forceinline__ void stage_rc(int b, int& R, int& C) { const int st = b / 1024, sb = b % 1024, swz = sb ^ (((sb >> 9) & 1) << 5); R = (st >> 1) * 16 + swz / 64; C = (st & 1) * 32 + (swz % 64) / 2; }
__host__ __device__ __forceinline__ int perm32(int rho) { const int n = rho >> 4, i = rho & 15; return 8 * (i >> 2) + 4 * n + (i & 3); }

struct Unit { int pm, pn, z; };
struct Gemm { const bf16_t* A; int lda; const bf16_t* Bt; int K; };

struct StaticOrder {
    int nM, nN, nwg, G, c;
    __host__ __device__ void init(int M, int N, int G_, int c_) { nM = M / BM; nN = N / BM; nwg = nM * nN; G = G_; c = c_; }
    __host__ __device__ bool next(int i, Unit& u) const {
        const long L = (long)i * G + c; if (L >= nwg) return false;
        int wgid = (int)L; { const int q = nwg / NXCD, r = nwg % NXCD, xcd = wgid % NXCD, off = wgid / NXCD; wgid = (xcd < r ? xcd * (q + 1) : r * (q + 1) + (xcd - r) * q) + off; }
        const int nig = WGM * nN, gid = wgid / nig, fm = gid * WGM, gsz = (nM - fm) < WGM ? (nM - fm) : WGM;
        u.pm = fm + ((wgid % nig) % gsz); u.pn = (wgid % nig) / gsz; u.z = 0; return true;
    }
    __device__ __forceinline__ size_t a_off(const Unit&) const { return 0; }
    __device__ __forceinline__ size_t b_off(const Unit&) const { return 0; }
    __device__ __forceinline__ void a_ready(const Unit&) const {}
    __device__ __forceinline__ void done(const Unit&) const {}
};

__device__ __forceinline__ unsigned cvt_pk_bf16(float lo, float hi) { unsigned r; asm volatile("v_cvt_pk_bf16_f32 %0, %1, %2" : "=v"(r) : "v"(lo), "v"(hi)); return r; }
typedef float f32x2 __attribute__((ext_vector_type(2)));
__device__ __forceinline__ f32x2 gelu_pk(f32x2 v) {
    const f32x2 av = __builtin_elementwise_abs(v), d = av * 0.2316418882f + 1.0f;
    f32x2 t; t.x = __builtin_amdgcn_rcpf(d.x); t.y = __builtin_amdgcn_rcpf(d.y);
    f32x2 q = t * 0.5307027145f + (-0.7265760135f); q = q * t + 0.7107068705f; q = q * t + (-0.142248368f); q = q * t + 0.127414796f; q = q * t;
    const f32x2 s = (v * v) * (-0.72134752044f);
    f32x2 e; e.x = __builtin_amdgcn_exp2f(s.x); e.y = __builtin_amdgcn_exp2f(s.y);
    const f32x2 m = v * (q * e), r = v - m;
    f32x2 o; o.x = v.x < 0.f ? m.x : r.x; o.y = v.y < 0.f ? m.y : r.y; return o;
}

template <class Epi, class Sched, bool ALIGN_EPI = false, bool SP2 = false>
__device__ __forceinline__ void gemm_phase(PG8_LAS unsigned char* lds, const Gemm g, const Sched& S, const Epi& E) {
    const int tid = threadIdx.x, wid = __builtin_amdgcn_readfirstlane(tid >> 6), lane = tid & 63, wr = wid >> 2, wc = wid & 3, fr = lane & 15, fq = lane >> 4;
    const int K = g.K, nt = K / BK;
    unsigned voffA[2], voffB[2];
#pragma unroll
    for (int i = 0; i < 2; ++i) { int R, C; stage_rc(tid * 16 + i * 8192, R, C); const int Rb = Epi::PERM ? ((R & ~31) + perm32(R & 31)) : R;
        voffA[i] = (unsigned)(R * g.lda + C) * 2u; voffB[i] = (unsigned)(Rb * K + C) * 2u; }
    const size_t kstep = (size_t)(BK * 2);
    const size_t hstepA = (size_t)HALF * g.lda * 2, hstepB = (size_t)HALF * K * 2;
    const size_t tstepA = 2 * hstepA, tstepB = 2 * hstepB;
    const unsigned ldsw = (unsigned)wid * 1024u;
    const int aoff = lds_byte(wr * 64 + fr, fq * 8), boff = lds_byte(wc * 32 + fr, fq * 8);
#define PG8_SA(b, h) (((b) * 2 + (h)) * HTB)
#define PG8_SB(b, h) ((4 + (b) * 2 + (h)) * HTB)
#define PG8_STAGE(bufoff, gbase, voff) do { _Pragma("unroll") for (int _i = 0; _i < 2; ++_i) \
        __builtin_amdgcn_global_load_lds((const unsigned*)((const char*)(gbase) + (voff)[_i]), (PG8_LAS unsigned*)(lds + (bufoff) + ldsw + _i * 8192), 16, 0, 0); } while (0)
#define PG8_LDA(dst, b, h) do { _Pragma("unroll") for (int m = 0; m < 4; ++m) _Pragma("unroll") for (int k = 0; k < 2; ++k) dst[m][k] = *(const PG8_LAS bf16x8*)(lds + PG8_SA(b, h) + aoff + m * 2048 + k * 1024); } while (0)
#define PG8_LDB(dst, b, h) do { _Pragma("unroll") for (int n = 0; n < 2; ++n) _Pragma("unroll") for (int k = 0; k < 2; ++k) dst[n][k] = *(const PG8_LAS bf16x8*)(lds + PG8_SB(b, h) + boff + n * 2048 + k * 1024); } while (0)
#define PG8_MMA(ai, bj, At, Bt) do { __builtin_amdgcn_s_setprio(1); _Pragma("unroll") for (int m = 0; m < 4; ++m) _Pragma("unroll") for (int n = 0; n < 2; ++n) _Pragma("unroll") for (int k = 0; k < 2; ++k) \
        acc[ai][bj][m][n] = __builtin_amdgcn_mfma_f32_16x16x32_bf16(Bt[n][k], At[m][k], acc[ai][bj][m][n], 0, 0, 0); __builtin_amdgcn_s_setprio(0); } while (0)
#define PG8_WAIT_V(n) asm volatile("s_waitcnt vmcnt(" #n ")" ::: "memory")
#define PG8_WAIT_L(n) asm volatile("s_waitcnt lgkmcnt(" #n ")" ::: "memory")
#define PG8_BAR __builtin_amdgcn_s_barrier()
#define PG8_SCHED __builtin_amdgcn_sched_barrier(0)
    Unit cur, nxt; int ui = 0;
    if (!S.next(0, cur)) return;
    f32x4 acc[2][2][4][2];
#pragma unroll
    for (int a = 0; a < 2; ++a)
#pragma unroll
        for (int b = 0; b < 2; ++b)
#pragma unroll
            for (int m = 0; m < 4; ++m)
#pragma unroll
                for (int n = 0; n < 2; ++n) acc[a][b][m][n] = (f32x4){0.f, 0.f, 0.f, 0.f};
    bf16x8 At[4][2], B0[2][2], B1[2][2];
    const char* cA = (const char*)g.A + (size_t)cur.pm * tstepA + S.a_off(cur); const char* cB = (const char*)g.Bt + (size_t)cur.pn * tstepB + S.b_off(cur);
    S.a_ready(cur);
    if constexpr (SP2) {
        PG8_STAGE(PG8_SB(0, 0), cB, voffB); PG8_STAGE(PG8_SB(0, 1), cB + hstepB, voffB); PG8_STAGE(PG8_SA(0, 0), cA, voffA); PG8_STAGE(PG8_SA(0, 1), cA + hstepA, voffA);
        if (wr == 1) PG8_BAR;
        PG8_WAIT_V(2); PG8_BAR;
        PG8_STAGE(PG8_SB(1, 0), cB + kstep, voffB); PG8_STAGE(PG8_SA(1, 0), cA + kstep, voffA); PG8_STAGE(PG8_SB(1, 1), cB + hstepB + kstep, voffB);
        PG8_WAIT_V(6); PG8_BAR;
    } else {
        PG8_STAGE(PG8_SB(0, 0), cB, voffB); PG8_STAGE(PG8_SA(0, 0), cA, voffA); PG8_STAGE(PG8_SB(0, 1), cB + hstepB, voffB); PG8_STAGE(PG8_SA(0, 1), cA + hstepA, voffA);
        if (wr == 1) PG8_BAR;
        PG8_WAIT_V(4); PG8_BAR;
        PG8_STAGE(PG8_SB(1, 0), cB + kstep, voffB); PG8_STAGE(PG8_SA(1, 0), cA + kstep, voffA); PG8_STAGE(PG8_SB(1, 1), cB + hstepB + kstep, voffB);
        PG8_WAIT_V(6); PG8_BAR;
    }
    for (;;) {
        const bool has_next = S.next(ui + 1, nxt);
        const char* nA = has_next ? (const char*)g.A + (size_t)nxt.pm * tstepA + S.a_off(nxt) : cA; const char* nB = has_next ? (const char*)g.Bt + (size_t)nxt.pn * tstepB + S.b_off(nxt) : cB;
        for (int t = 0; t < nt; t += 2) {
            const bool last = (t == nt - 2);
            const char* a1 = cA + (size_t)(t + 1) * kstep;
            const char* a2 = last ? nA : cA + (size_t)(t + 2) * kstep; const char* b2 = last ? nB : cB + (size_t)(t + 2) * kstep;
            const char* a3 = a2 + kstep; const char* b3 = b2 + kstep;
            if (last && has_next) S.a_ready(nxt);
            if constexpr (SP2) {
            PG8_LDB(B0, 0, 0); PG8_LDB(B1, 0, 1); PG8_SCHED; PG8_LDA(At, 0, 0); PG8_STAGE(PG8_SA(1, 1), a1 + hstepA, voffA);
            PG8_WAIT_V(8); PG8_WAIT_L(0); PG8_BAR; PG8_MMA(0, 0, At, B0); PG8_MMA(0, 1, At, B1); PG8_BAR; PG8_SCHED;
            PG8_LDA(At, 0, 1); PG8_STAGE(PG8_SB(0, 0), b2, voffB); PG8_STAGE(PG8_SB(0, 1), b2 + hstepB, voffB); PG8_STAGE(PG8_SA(0, 0), a2, voffA);
            PG8_WAIT_V(8); PG8_WAIT_L(0); PG8_BAR; PG8_MMA(1, 0, At, B0); PG8_MMA(1, 1, At, B1); PG8_BAR; PG8_SCHED;
            PG8_LDB(B0, 1, 0); PG8_LDB(B1, 1, 1); PG8_SCHED; PG8_LDA(At, 1, 0); PG8_STAGE(PG8_SA(0, 1), a2 + hstepA, voffA);
            PG8_WAIT_V(8); PG8_WAIT_L(0); PG8_BAR; PG8_MMA(0, 0, At, B0); PG8_MMA(0, 1, At, B1); PG8_BAR; PG8_SCHED;
            PG8_LDA(At, 1, 1); PG8_STAGE(PG8_SB(1, 0), b3, voffB); PG8_STAGE(PG8_SB(1, 1), b3 + hstepB, voffB); PG8_STAGE(PG8_SA(1, 0), a3, voffA);
            PG8_WAIT_V(8); PG8_WAIT_L(0); PG8_BAR; PG8_MMA(1, 0, At, B0); PG8_MMA(1, 1, At, B1); PG8_BAR; PG8_SCHED;
            } else {
            PG8_LDB(B0, 0, 0); PG8_SCHED; PG8_LDA(At, 0, 0); PG8_STAGE(PG8_SA(1, 1), a1 + hstepA, voffA);
            PG8_WAIT_L(8); PG8_BAR; PG8_WAIT_L(0); PG8_MMA(0, 0, At, B0); PG8_BAR; PG8_SCHED;
            PG8_LDB(B1, 0, 1); PG8_STAGE(PG8_SB(0, 0), b2, voffB);
            PG8_BAR; PG8_WAIT_L(0); PG8_MMA(0, 1, At, B1); PG8_BAR;
            PG8_LDA(At, 0, 1); PG8_STAGE(PG8_SA(0, 0), a2, voffA);
            PG8_BAR; PG8_WAIT_L(0); PG8_MMA(1, 0, At, B0); PG8_BAR; PG8_SCHED;
            PG8_STAGE(PG8_SB(0, 1), b2 + hstepB, voffB);
            PG8_WAIT_V(6); PG8_BAR; PG8_MMA(1, 1, At, B1); PG8_BAR;
            PG8_LDB(B0, 1, 0); PG8_SCHED; PG8_LDA(At, 1, 0); PG8_STAGE(PG8_SA(0, 1), a2 + hstepA, voffA);
            PG8_WAIT_L(8); PG8_BAR; PG8_WAIT_L(0); PG8_MMA(0, 0, At, B0); PG8_BAR; PG8_SCHED;
            PG8_LDB(B1, 1, 1); PG8_STAGE(PG8_SB(1, 0), b3, voffB);
            PG8_BAR; PG8_WAIT_L(0); PG8_MMA(0, 1, At, B1); PG8_BAR;
            PG8_LDA(At, 1, 1); PG8_STAGE(PG8_SA(1, 0), a3, voffA);
            PG8_BAR; PG8_WAIT_L(0); PG8_MMA(1, 0, At, B0); PG8_BAR; PG8_SCHED;
            PG8_STAGE(PG8_SB(1, 1), b3 + hstepB, voffB);
            PG8_WAIT_V(6); PG8_BAR; PG8_MMA(1, 1, At, B1); PG8_BAR;
            }
        }
        if constexpr (ALIGN_EPI) { if (wr == 0) PG8_BAR; }
        if constexpr (!Epi::AFTER_DRAIN) { E(acc, cur, wr, wc, fr, fq); S.done(cur); }
        if (!has_next) break;
#pragma unroll
        for (int a = 0; a < 2; ++a)
#pragma unroll
            for (int b = 0; b < 2; ++b)
#pragma unroll
                for (int m = 0; m < 4; ++m)
#pragma unroll
                    for (int n = 0; n < 2; ++n) acc[a][b][m][n] = (f32x4){0.f, 0.f, 0.f, 0.f};
        cur = nxt; cA = nA; cB = nB; ++ui;
        if constexpr (ALIGN_EPI) { if (wr == 1) PG8_BAR; }
    }
    PG8_WAIT_V(0);
    if constexpr (!ALIGN_EPI) { if (wr == 0) PG8_BAR; }
    PG8_BAR;
    if constexpr (Epi::AFTER_DRAIN) { E.fused(acc, cur, wr, wc, fr, fq, lds, wid, lane); S.done(cur); }
#undef PG8_SA
#undef PG8_SB
#undef PG8_STAGE
#undef PG8_LDA
#undef PG8_LDB
#undef PG8_MMA
#undef PG8_WAIT_V
#undef PG8_WAIT_L
#undef PG8_BAR
#undef PG8_SCHED
}
}

namespace pg8 {
typedef unsigned u32x2 __attribute__((ext_vector_type(2)));
__device__ __forceinline__ float bflo(unsigned w) { return __uint_as_float(w << 16); }
__device__ __forceinline__ float bfhi(unsigned w) { return __uint_as_float(w & 0xffff0000u); }
__device__ __forceinline__ float sigm(float x) { return __builtin_amdgcn_rcpf(1.0f + __expf(-x)); }
struct EpiProjB {
    static constexpr bool PERM = true, AFTER_DRAIN = false;
    bf16_t* O; int ldc;
    __device__ __forceinline__ void operator()(const f32x4 (&acc)[2][2][4][2], const Unit& u, int wr, int wc, int fr, int fq) const {
        const int row0 = u.pm * BM + wr * 64 + fr, col0 = u.pn * BM + wc * 32 + 8 * fq;
#pragma unroll
        for (int ai = 0; ai < 2; ++ai)
#pragma unroll
            for (int m = 0; m < 4; ++m) { bf16_t* rowp = O + (size_t)(row0 + ai * HALF + m * 16) * ldc + col0;
#pragma unroll
                for (int bj = 0; bj < 2; ++bj) { const f32x4 v0 = acc[ai][bj][m][0], v1 = acc[ai][bj][m][1];
                    u32x4 w; w.x = cvt_pk_bf16(v0[0], v0[1]); w.y = cvt_pk_bf16(v0[2], v0[3]); w.z = cvt_pk_bf16(v1[0], v1[1]); w.w = cvt_pk_bf16(v1[2], v1[3]);
                    *(u32x4*)(rowp + bj * HALF) = w; } }
    }
};
struct EpiGluB {
    static constexpr bool PERM = true, AFTER_DRAIN = false;
    bf16_t* PROJ;
    __device__ __forceinline__ void operator()(const f32x4 (&acc)[2][2][4][2], const Unit& u, int wr, int wc, int fr, int fq) const {
        const int row0 = u.pm * BM + wr * 64 + fr, col0 = u.pn * BM + wc * 32 + 8 * fq;
#pragma unroll
        for (int ai = 0; ai < 2; ++ai)
#pragma unroll
            for (int m = 0; m < 4; ++m) { bf16_t* rowp = PROJ + (size_t)(row0 + ai * HALF + m * 16) * IN_COLS + col0;
#pragma unroll
                for (int bj = 0; bj < 2; ++bj) {
                    const u32x4 zz = *(const u32x4*)(rowp + C_UB + bj * HALF), gg = *(const u32x4*)(rowp + C_GB + bj * HALF);
                    const f32x4 v0 = acc[ai][bj][m][0], v1 = acc[ai][bj][m][1];
                    float o[8];
#pragma unroll
                    for (int e = 0; e < 4; ++e) {
                        const float va = e < 2 ? v0[2 * e] : v1[2 * (e - 2)], vb = e < 2 ? v0[2 * e + 1] : v1[2 * (e - 2) + 1];
                        const float za = bflo(zz[e]), zb = bfhi(zz[e]), ga = bflo(gg[e]), gb = bfhi(gg[e]);
                        o[2 * e] = za * sigm(va) * ga * sigm(ga); o[2 * e + 1] = zb * sigm(vb) * gb * sigm(gb);
                    }
                    u32x4 w; w.x = cvt_pk_bf16(o[0], o[1]); w.y = cvt_pk_bf16(o[2], o[3]); w.z = cvt_pk_bf16(o[4], o[5]); w.w = cvt_pk_bf16(o[6], o[7]);
                    *(u32x4*)(rowp + C_GB + bj * HALF) = w; } }
    }
};
struct EpiBranchB {
    static constexpr bool PERM = true, AFTER_DRAIN = false;
    bf16_t* PROJ;
    __device__ __forceinline__ void operator()(const f32x4 (&acc)[2][2][4][2], const Unit& u, int wr, int wc, int fr, int fq) const {
        const int row0 = u.pm * BM + wr * 64 + fr, col0 = u.pn * BM + wc * 32 + 8 * fq;
        const int z = u.z;
#pragma unroll
        for (int ai = 0; ai < 2; ++ai)
#pragma unroll
            for (int m = 0; m < 4; ++m) { bf16_t* rowp = PROJ + (size_t)(row0 + ai * HALF + m * 16) * IN_COLS + C_GM + col0;
#pragma unroll
                for (int bj = 0; bj < 2; ++bj) {
                    const u32x4 gg = *(const u32x4*)(rowp + z * 1024 + bj * HALF);
                    u32x4 pp = (u32x4){0u, 0u, 0u, 0u};
                    if (z > 0) pp = *(const u32x4*)(rowp + bj * HALF);
                    const f32x4 v0 = acc[ai][bj][m][0], v1 = acc[ai][bj][m][1];
                    float o[8];
#pragma unroll
                    for (int e = 0; e < 4; ++e) {
                        const float va = e < 2 ? v0[2 * e] : v1[2 * (e - 2)], vb = e < 2 ? v0[2 * e + 1] : v1[2 * (e - 2) + 1];
                        o[2 * e] = bflo(pp[e]) + sigm(bflo(gg[e])) * va; o[2 * e + 1] = bfhi(pp[e]) + sigm(bfhi(gg[e])) * vb;
                    }
                    u32x4 w; w.x = cvt_pk_bf16(o[0], o[1]); w.y = cvt_pk_bf16(o[2], o[3]); w.z = cvt_pk_bf16(o[4], o[5]); w.w = cvt_pk_bf16(o[6], o[7]);
                    *(u32x4*)(rowp + bj * HALF) = w; } }
    }
};
struct BranchOrder : StaticOrder {
    __device__ bool next(int i, Unit& u) const { if (!StaticOrder::next(i / 3, u)) return false; u.z = i % 3; return true; }
    __device__ __forceinline__ size_t a_off(const Unit& u) const { return (size_t)(u.z == 0 ? C_Q : (u.z == 1 ? C_GB : C_XC)) * 2; }
    __device__ __forceinline__ size_t b_off(const Unit& u) const { return (size_t)u.z * 1024 * 512 * 2; }
};
struct EpiOutB {
    static constexpr bool PERM = false, AFTER_DRAIN = false;
    const float* xp; const float* xs; const bf16_t* XB; unsigned char* ws; int l;
    __device__ __forceinline__ void operator()(const f32x4 (&acc)[2][2][4][2], const Unit& u, int wr, int wc, int fr, int fq) const {
        const int row0 = u.pm * BM + wr * 64 + fr, col0 = u.pn * BM + wc * 32 + 4 * fq;
#pragma unroll
        for (int ai = 0; ai < 2; ++ai)
#pragma unroll
            for (int m = 0; m < 4; ++m) { const int r = row0 + ai * HALF + m * 16;
                float* prow = (float*)(ws + WS_PROJ + (size_t)r * IN_COLS * 2 + (size_t)(C_GM + 1024) * 2) + col0;
#pragma unroll
                for (int bj = 0; bj < 2; ++bj)
#pragma unroll
                    for (int n = 0; n < 2; ++n) {
                        const int co = bj * HALF + n * 16;
                        f32x4 x;
                        if (l == 0) x = r < M_P ? *(const f32x4*)(xp + (size_t)r * D_MODEL + col0 + co) : *(const f32x4*)(xs + (size_t)(r - M_P) * D_MODEL + col0 + co);
                        else { const u32x2 xx = *(const u32x2*)(XB + (size_t)r * D_MODEL + col0 + co); x = (f32x4){bflo(xx.x), bfhi(xx.x), bflo(xx.y), bfhi(xx.y)}; }
                        *(f32x4*)(prow + co) = x * DN_ALPHA + acc[ai][bj][m][n];
                    } }
    }
};
}

struct Ctx { int tid, lane, wave, gw, ngw; size_t gt, ngt; };
__device__ __forceinline__ Ctx make_ctx() {
    int zv = 0; asm volatile("" : "+v"(zv)); int zs = 0; asm volatile("" : "+s"(zs));
    Ctx c; c.tid = (int)threadIdx.x + zv; c.lane = c.tid & 63; c.wave = __builtin_amdgcn_readfirstlane(c.tid >> 6);
    const int bid = (int)blockIdx.x + zs, nb = (int)gridDim.x + zs;
    c.gw = c.wave * nb + bid; c.ngw = nb * NWAVES; c.gt = (size_t)bid * NTHREADS + c.tid; c.ngt = (size_t)nb * NTHREADS; return c;
}
#define WAVE_LDS_SYNC() do { asm volatile("s_waitcnt lgkmcnt(0)" ::: "memory"); __builtin_amdgcn_wave_barrier(); } while (0)

__device__ __forceinline__ void st_convert_x(KP p, const Ctx& c) {
    bf16_t* XB = (bf16_t*)(p->ws + WS_XB);
    const size_t n = (size_t)M_TOT * D_MODEL;
    for (size_t i = c.gt; i < n; i += c.ngt) {
        const float v = i < (size_t)M_P * D_MODEL ? p->in[0][i] : p->in[1][i - (size_t)M_P * D_MODEL];
        XB[i] = f2bf(v);
    }
}
__device__ __forceinline__ void st_transpose_w(const float* W, bf16_t* WT, int K, int N, const Ctx& c) {
    const size_t n = (size_t)K * N;
    for (size_t i = c.gt; i < n; i += c.ngt) { const int nn = (int)(i / K), kk = (int)(i % K); WT[i] = f2bf(W[(size_t)kk * N + nn]); }
}
__device__ __forceinline__ void st_s5_tables(KP p, const Ctx& c) {
    float* AB = (float*)(p->ws + WS_TAB + TAB_AB);
    float* BB = (float*)(p->ws + WS_TAB + TAB_BB);
    for (size_t ii = c.gt; ii < (size_t)DEPTH * NG * NP; ii += c.ngt) {
        const int i = (int)ii, l = i / (NG * NP), g = (i / NP) % NG;
        const float lr = fminf(p->in[12][i], -1e-4f), li = p->in[13][i];
        const float step = expf(p->in[14][l * NG + g]);
        const float mag = expf(lr * step);
        float sn, cs; sincosf(li * step, &sn, &cs);
        const float ab_re = mag * cs, ab_im = mag * sn;
        const float den = lr * lr + li * li;
        const float f_re = ((ab_re - 1.0f) * lr + ab_im * li) / den;
        const float f_im = (ab_im * lr - (ab_re - 1.0f) * li) / den;
        AB[2 * i] = ab_re; AB[2 * i + 1] = ab_im;
        for (int cc = 0; cc < NC; ++cc) {
            const float bre = p->in[15][(size_t)i * NC + cc], bim = p->in[16][(size_t)i * NC + cc];
            BB[((size_t)i * NC + cc) * 2] = f_re * bre - f_im * bim;
            BB[((size_t)i * NC + cc) * 2 + 1] = f_re * bim + f_im * bre;
        }
    }
}

template <class Epi>
__device__ __forceinline__ void gemm_simple(const bf16_t* A, int lda, const bf16_t* Bt, int ldb, int M, int N, int K, Epi epi, const Ctx& c) {
    const int lane = c.lane;
    const int ntn = N / 32, ntiles = (M / 32) * ntn;
    for (int tile = c.gw; tile < ntiles; tile += c.ngw) {
        const int tm = tile / ntn, tn = tile % ntn;
        f32x16 acc = {};
        const bf16_t* ar = A + (size_t)(tm * 32 + (lane & 31)) * lda + 8 * (lane >> 5);
        const bf16_t* br = Bt + (size_t)(tn * 32 + (lane & 31)) * ldb + 8 * (lane >> 5);
        for (int k0 = 0; k0 < K; k0 += 16) {
            const bf16x8 a = *(const bf16x8*)(ar + k0);
            const bf16x8 b = *(const bf16x8*)(br + k0);
            acc = __builtin_amdgcn_mfma_f32_32x32x16_bf16(a, b, acc, 0, 0, 0);
        }
#pragma unroll
        for (int r = 0; r < 16; ++r) {
            const int row = tm * 32 + (r & 3) + 8 * (r >> 2) + 4 * (lane >> 5), col = tn * 32 + (lane & 31);
            epi(row, col, acc[r]);
        }
    }
}
struct EpiProj { bf16_t* PROJ; __device__ void operator()(int r, int c, float v) const { PROJ[(size_t)r * IN_COLS + c] = f2bf(v); } };

__device__ __forceinline__ void st_kv_out(KP p, int l, const Ctx& c) {
    const bf16_t* PROJ = (const bf16_t*)(p->ws + WS_PROJ);
    for (size_t ii = c.gt; ii < (size_t)DEC_BATCH * WINDOW * 128; ii += c.ngt) {
        const int i = (int)ii;
        if (i < BATCH * WINDOW * 128) {
            const int b = i / (WINDOW * 128), w = (i / 128) % WINDOW, cc = i % 128;
            const size_t row = (size_t)b * SEQ + (SEQ - WINDOW) + w;
            p->out[O_KP + (size_t)l * BATCH * WINDOW * 128 + i] = bf2f(PROJ[row * IN_COLS + C_K + cc]);
            p->out[O_VP + (size_t)l * BATCH * WINDOW * 128 + i] = bf2f(PROJ[row * IN_COLS + C_V + cc]);
        }
        {
            const int b = i / (WINDOW * 128), w = (i / 128) % WINDOW, cc = i % 128;
            float kv, vv;
            if (w < WINDOW - DEC_SEQ) {
                const size_t ci = (((size_t)l * DEC_BATCH + b) * WINDOW + (w + DEC_SEQ)) * 128 + cc;
                kv = p->in[2][ci]; vv = p->in[3][ci];
            } else {
                const size_t row = (size_t)M_P + b * DEC_SEQ + (w - (WINDOW - DEC_SEQ));
                kv = bf2f(PROJ[row * IN_COLS + C_K + cc]); vv = bf2f(PROJ[row * IN_COLS + C_V + cc]);
            }
            p->out[O_KS + (size_t)l * DEC_BATCH * WINDOW * 128 + i] = kv;
            p->out[O_VS + (size_t)l * DEC_BATCH * WINDOW * 128 + i] = vv;
        }
    }
}

__device__ __forceinline__ void st_attn_simple(KP p, int l, const Ctx& c) {
    bf16_t* PROJ = (bf16_t*)(p->ws + WS_PROJ);
    const int lane = c.lane;
    const float* rel_bias = p->in[8];
    for (int item = c.gw; item < M_TOT * NQH; item += c.ngw) {
        const int m = item / NQH, h = item % NQH, kvh = h / 4;
        const bool samp = m >= M_P;
        const int b = samp ? (m - M_P) / DEC_SEQ : m / SEQ, t = samp ? (m - M_P) % DEC_SEQ : m % SEQ;
        float q[64];
        {
            const bf16_t* qp = PROJ + (size_t)m * IN_COLS + C_Q + h * 64;
#pragma unroll
            for (int d = 0; d < 64; ++d) q[d] = bf2f(qp[d]);
        }
        const float sink = p->in[10][l * NQH + h];
        float s[2];
#pragma unroll
        for (int j = 0; j < 2; ++j) {
            const int d = lane + 64 * j;
            const int tk = t - d;
            float sc = -1e30f;
            if (!samp) {
                if (tk >= 0) {
                    const bf16_t* kp = PROJ + ((size_t)b * SEQ + tk) * IN_COLS + C_K + kvh * 64;
                    float a = 0.f;
#pragma unroll
                    for (int e = 0; e < 64; ++e) a += q[e] * bf2f(kp[e]);
                    sc = a * 0.125f + rel_bias[T5_BUCKET[d] * NQH + h];
                }
            } else {
                float a = 0.f;
                if (tk >= 0) {
                    const bf16_t* kp = PROJ + ((size_t)M_P + b * DEC_SEQ + tk) * IN_COLS + C_K + kvh * 64;
#pragma unroll
                    for (int e = 0; e < 64; ++e) a += q[e] * bf2f(kp[e]);
                } else {
                    const float* kp = p->in[2] + ((((size_t)l * DEC_BATCH + b) * WINDOW + (WINDOW + tk)) * NKV + kvh) * HD;
#pragma unroll
                    for (int e = 0; e < 64; ++e) a += q[e] * kp[e];
                }
                sc = a * 0.125f + rel_bias[T5_BUCKET[d] * NQH + h];
            }
            s[j] = sc;
        }
        float mx = fmaxf(fmaxf(s[0], s[1]), sink);
        for (int o = 32; o > 0; o >>= 1) mx = fmaxf(mx, __shfl_xor(mx, o));
        const float p0 = s[0] > -1e29f ? __expf(s[0] - mx) : 0.f, p1 = s[1] > -1e29f ? __expf(s[1] - mx) : 0.f;
        float sum = p0 + p1;
        for (int o = 32; o > 0; o >>= 1) sum += __shfl_xor(sum, o);
        const float denom = sum + __expf(sink - mx);
        float o = 0.f;
        for (int d = 0; d < 128; ++d) {
            const float pj = __shfl(d < 64 ? p0 : p1, d & 63);
            const int tk = t - d;
            float vv = 0.f;
            if (!samp) { if (tk >= 0) vv = bf2f(PROJ[((size_t)b * SEQ + tk) * IN_COLS + C_V + kvh * 64 + lane]); }
            else if (tk >= 0) vv = bf2f(PROJ[((size_t)M_P + b * DEC_SEQ + tk) * IN_COLS + C_V + kvh * 64 + lane]);
            else vv = p->in[3][((((size_t)l * DEC_BATCH + b) * WINDOW + (WINDOW + tk)) * NKV + kvh) * HD + lane];
            o += pj * vv;
        }
        o /= denom;
        const float ga = bf2f(PROJ[(size_t)m * IN_COLS + C_GA + h * 64 + lane]);
        PROJ[(size_t)m * IN_COLS + C_Q + h * 64 + lane] = f2bf(o * siluf_(ga));
    }
}

__device__ __forceinline__ void st_s5_simple(KP p, int l, const Ctx& c, LAS float* wsm) {
    bf16_t* PROJ = (bf16_t*)(p->ws + WS_PROJ);
    const float* AB = (const float*)(p->ws + WS_TAB + TAB_AB);
    const float* BB = (const float*)(p->ws + WS_TAB + TAB_BB);
    const int pp = c.lane;
    for (int item = c.gw; item < (BATCH + DEC_BATCH) * NG; item += c.ngw) {
        const int seq = item / NG, g = item % NG;
        const bool samp = seq >= BATCH;
        const int b = samp ? seq - BATCH : seq, T = samp ? DEC_SEQ : SEQ;
        const size_t row0 = samp ? (size_t)M_P + b * DEC_SEQ : (size_t)b * SEQ;
        const int sidx = (l * NG + g) * NP + pp;
        const float ab_re = AB[2 * sidx], ab_im = AB[2 * sidx + 1];
        float bbr[16], bbi[16], cr[16], ci[16];
#pragma unroll
        for (int cc = 0; cc < 16; ++cc) {
            bbr[cc] = BB[((size_t)sidx * NC + cc) * 2]; bbi[cc] = BB[((size_t)sidx * NC + cc) * 2 + 1];
            cr[cc] = p->in[17][((size_t)(l * NG + g) * NC + cc) * NP + pp]; ci[cc] = p->in[18][((size_t)(l * NG + g) * NC + cc) * NP + pp];
        }
        const float dd = pp < 16 ? p->in[19][l * 512 + g * 16 + pp] : 0.f;
        float hr = 0.f, hi = 0.f;
        if (samp) { const size_t si = (((size_t)l * DEC_BATCH + b) * NG + g) * NP + pp; hr = p->in[4][si]; hi = p->in[5][si]; }
        for (int t = 0; t < T; ++t) {
            bf16_t* up = PROJ + (row0 + t) * IN_COLS + C_UB + g * 16;
            float u[16];
#pragma unroll
            for (int cc = 0; cc < 16; ++cc) u[cc] = bf2f(up[cc]);
            float xr = 0.f, xi = 0.f;
#pragma unroll
            for (int cc = 0; cc < 16; ++cc) { xr += bbr[cc] * u[cc]; xi += bbi[cc] * u[cc]; }
            const float nr = ab_re * hr - ab_im * hi + xr, ni = ab_re * hi + ab_im * hr + xi;
            hr = nr; hi = ni;
#pragma unroll
            for (int cc = 0; cc < 16; ++cc) wsm[pp * 17 + cc] = cr[cc] * hr - ci[cc] * hi;
            WAVE_LDS_SYNC();
            if (pp < 16) {
                float y = 0.f;
                for (int q = 0; q < 64; ++q) y += wsm[q * 17 + pp];
                y += dd * bf2f(up[pp]);
                up[pp] = f2bf(gelu_tanh(y));
            }
            WAVE_LDS_SYNC();
        }
        if (!samp) { const size_t oi = (((size_t)l * BATCH + b) * NG + g) * NP + pp; p->out[O_SRP + oi] = hr; p->out[O_SIP + oi] = hi; }
        else { const size_t oi = (((size_t)l * DEC_BATCH + b) * NG + g) * NP + pp; p->out[O_SRS + oi] = hr; p->out[O_SIS + oi] = hi; }
    }
}

struct EpiGlu { bf16_t* PROJ; __device__ void operator()(int r, int c, float v) const {
    const float z = bf2f(PROJ[(size_t)r * IN_COLS + C_UB + c]), gb = bf2f(PROJ[(size_t)r * IN_COLS + C_GB + c]);
    PROJ[(size_t)r * IN_COLS + C_GB + c] = f2bf(z * sigmoidf_(v) * siluf_(gb)); } };

__device__ __forceinline__ void st_lru_simple(KP p, int l, const Ctx& c, LAS float* wsm) {
    bf16_t* PROJ = (bf16_t*)(p->ws + WS_PROJ);
    const int e = c.lane;
    for (int item = c.gw; item < (BATCH + DEC_BATCH) * 8; item += c.ngw) {
        const int seq = item / 8, n = item % 8, ch = n * 64 + e;
        const bool samp = seq >= BATCH;
        const int b = samp ? seq - BATCH : seq, T = samp ? DEC_SEQ : SEQ;
        const size_t row0 = samp ? (size_t)M_P + b * DEC_SEQ : (size_t)b * SEQ;
        float wa[64], wx[64];
#pragma unroll
        for (int d = 0; d < 64; ++d) { wa[d] = p->in[24][(((size_t)l * 8 + n) * 64 + d) * 64 + e]; wx[d] = p->in[26][(((size_t)l * 8 + n) * 64 + d) * 64 + e]; }
        const float ba = p->in[25][l * 512 + ch], bx = p->in[27][l * 512 + ch], lam = p->in[28][l * 512 + ch];
        const float lsig = -log1pf(expf(-lam));
        const float cw0 = p->in[22][(l * 4 + 0) * 512 + ch], cw1 = p->in[22][(l * 4 + 1) * 512 + ch], cw2 = p->in[22][(l * 4 + 2) * 512 + ch], cw3 = p->in[22][(l * 4 + 3) * 512 + ch];
        const float cb = p->in[23][l * 512 + ch];
        float xm3 = 0.f, xm2 = 0.f, xm1 = 0.f, h = 0.f;
        if (samp) {
            const size_t ci = (((size_t)l * DEC_BATCH + b) * 3) * 512 + ch;
            xm3 = p->in[7][ci]; xm2 = p->in[7][ci + 512]; xm1 = p->in[7][ci + 1024];
            h = p->in[6][((size_t)l * DEC_BATCH + b) * 512 + ch];
        }
        for (int t = 0; t < T; ++t) {
            bf16_t* rp = PROJ + (row0 + t) * IN_COLS;
            const float xc = bf2f(rp[C_XC + ch]);
            const float xf = cb + cw0 * xm3 + cw1 * xm2 + cw2 * xm1 + cw3 * xc;
            xm3 = xm2; xm2 = xm1; xm1 = xc;
            wsm[e] = xf;
            WAVE_LDS_SYNC();
            float r = ba, i = bx;
#pragma unroll
            for (int d = 0; d < 64; ++d) { const float xv = wsm[d]; r += xv * wa[d]; i += xv * wx[d]; }
            WAVE_LDS_SYNC();
            r = sigmoidf_(r); i = sigmoidf_(i);
            const float log_a = 8.0f * r * lsig;
            const float a = expf(log_a);
            const float bt = xf * i * sqrtf(-expm1f(2.0f * log_a));
            h = a * h + bt;
            const float gc = bf2f(rp[C_GC + ch]);
            rp[C_XC + ch] = f2bf(h * siluf_(gc));
        }
        if (!samp) {
            p->out[O_LP + ((size_t)l * BATCH + b) * 512 + ch] = h;
            const size_t ci = (((size_t)l * BATCH + b) * 3) * 512 + ch;
            p->out[O_CP + ci] = xm3; p->out[O_CP + ci + 512] = xm2; p->out[O_CP + ci + 1024] = xm1;
        } else {
            p->out[O_LS + ((size_t)l * DEC_BATCH + b) * 512 + ch] = h;
            const size_t ci = (((size_t)l * DEC_BATCH + b) * 3) * 512 + ch;
            p->out[O_CS + ci] = xm3; p->out[O_CS + ci + 512] = xm2; p->out[O_CS + ci + 1024] = xm1;
        }
    }
}

__device__ __forceinline__ void st_branch_simple(KP p, int l, const Ctx& c) {
    bf16_t* PROJ = (bf16_t*)(p->ws + WS_PROJ);
    const bf16_t* WB = (const bf16_t*)((unsigned char*)p->out + DO_WBR) + (size_t)l * 3 * 1024 * 512;
    const int lane = c.lane;
    const int ntn = 1024 / 32, ntiles = (M_TOT / 32) * ntn;
    for (int tile = c.gw; tile < ntiles; tile += c.ngw) {
        const int tm = tile / ntn, tn = tile % ntn;
        f32x16 acc[3];
#pragma unroll
        for (int br = 0; br < 3; ++br) {
            const int acol = br == 0 ? C_Q : (br == 1 ? C_GB : C_XC);
            acc[br] = (f32x16){};
            const bf16_t* ar = PROJ + (size_t)(tm * 32 + (lane & 31)) * IN_COLS + acol + 8 * (lane >> 5);
            const bf16_t* bp = WB + (size_t)br * 1024 * 512 + (size_t)(tn * 32 + (lane & 31)) * 512 + 8 * (lane >> 5);
            for (int k0 = 0; k0 < 512; k0 += 16)
                acc[br] = __builtin_amdgcn_mfma_f32_32x32x16_bf16(*(const bf16x8*)(ar + k0), *(const bf16x8*)(bp + k0), acc[br], 0, 0, 0);
        }
#pragma unroll
        for (int r = 0; r < 16; ++r) {
            const int row = tm * 32 + (r & 3) + 8 * (r >> 2) + 4 * (lane >> 5), col = tn * 32 + (lane & 31);
            bf16_t* gp = PROJ + (size_t)row * IN_COLS + C_GM + col;
            const float m = sigmoidf_(bf2f(gp[0])) * acc[0][r] + sigmoidf_(bf2f(gp[1024])) * acc[1][r] + sigmoidf_(bf2f(gp[2048])) * acc[2][r];
            gp[0] = f2bf(m);
        }
    }
}

__device__ __forceinline__ float* pre_row(unsigned char* ws, int r) { return (float*)(ws + WS_PROJ + (size_t)r * IN_COLS * 2 + (size_t)(C_GM + 1024) * 2); }
struct EpiOut { KP p; int l; __device__ void operator()(int r, int c, float v) const {
    float x;
    if (l == 0) x = r < M_P ? p->in[0][(size_t)r * D_MODEL + c] : p->in[1][(size_t)(r - M_P) * D_MODEL + c];
    else x = bf2f(((const bf16_t*)(p->ws + WS_XB))[(size_t)r * D_MODEL + c]);
    pre_row(p->ws, r)[c] = DN_ALPHA * x + v; } };

__device__ __forceinline__ void st_ln(KP p, int l, const Ctx& c) {
    const int lane = c.lane;
    const float* g = p->in[31] + l * 1024; const float* bb = p->in[32] + l * 1024;
    for (int r = c.gw; r < M_TOT; r += c.ngw) {
        const float* pr = pre_row(p->ws, r);
        float v[16]; float s = 0.f;
#pragma unroll
        for (int j = 0; j < 16; ++j) { v[j] = pr[lane + 64 * j]; s += v[j]; }
        for (int o = 32; o > 0; o >>= 1) s += __shfl_xor(s, o);
        const float mu = s * (1.0f / 1024.0f);
        float q = 0.f;
#pragma unroll
        for (int j = 0; j < 16; ++j) { const float d = v[j] - mu; q += d * d; }
        for (int o = 32; o > 0; o >>= 1) q += __shfl_xor(q, o);
        const float rstd = rsqrtf(q * (1.0f / 1024.0f) + LN_EPS);
#pragma unroll
        for (int j = 0; j < 16; ++j) {
            const int cc = lane + 64 * j;
            const float y = (v[j] - mu) * rstd * g[cc] + bb[cc];
            if (l == 0) ((bf16_t*)(p->ws + WS_XB))[(size_t)r * D_MODEL + cc] = f2bf(y);
            else if (r < M_P) p->out[O_YP + (size_t)r * D_MODEL + cc] = y;
            else p->out[O_YS + (size_t)(r - M_P) * D_MODEL + cc] = y;
        }
    }
}

__global__ void __launch_bounds__(NTHREADS, 2) mega_fwd(P p_unused) {
    extern __shared__ __attribute__((aligned(16))) unsigned char lds_raw[];
    LAS unsigned char* lds = (LAS unsigned char*)lds_raw;
    volatile LAS unsigned* misc = (volatile LAS unsigned*)(lds + LDS_MISC);
    if (threadIdx.x < 32) misc[threadIdx.x] = 0u;
    __syncthreads();
    XcdBarrier bar;
    { KP p = get_kp(); bar = xcd_barrier_post((unsigned*)(p->ws + WS_CTL), misc); }

    { KP p = get_kp(); const Ctx c = make_ctx(); unsigned char* dob = (unsigned char*)p->out;
      st_convert_x(p, c);
      for (int l = 0; l < DEPTH; ++l) {
        st_transpose_w(p->in[9] + (size_t)l * 1024 * IN_COLS, (bf16_t*)(dob + DO_WIN) + (size_t)l * IN_COLS * 1024, 1024, IN_COLS, c);
        st_transpose_w(p->in[11] + (size_t)l * 512 * 1024, (bf16_t*)(dob + DO_WBR) + ((size_t)l * 3 + 0) * 1024 * 512, 512, 1024, c);
        st_transpose_w(p->in[21] + (size_t)l * 512 * 1024, (bf16_t*)(dob + DO_WBR) + ((size_t)l * 3 + 1) * 1024 * 512, 512, 1024, c);
        st_transpose_w(p->in[29] + (size_t)l * 512 * 1024, (bf16_t*)(dob + DO_WBR) + ((size_t)l * 3 + 2) * 1024 * 512, 512, 1024, c);
        st_transpose_w(p->in[20] + (size_t)l * 512 * 512, (bf16_t*)(dob + DO_WGLU) + (size_t)l * 512 * 512, 512, 512, c);
        st_transpose_w(p->in[30] + (size_t)l * 1024 * 1024, (bf16_t*)(p->ws + WS_WOUT) + (size_t)l * 1024 * 1024, 1024, 1024, c);
      }
      st_s5_tables(p, c); }
    xcd_barrier(bar);

    for (int l = 0; l < DEPTH; ++l) {
        { KP p = get_kp(); int zs = 0; asm volatile("" : "+s"(zs));
          pg8::Gemm g{(const bf16_t*)(p->ws + WS_XB), D_MODEL, (const bf16_t*)((unsigned char*)p->out + DO_WIN) + (size_t)l * IN_COLS * 1024, 1024};
          pg8::StaticOrder S; S.init(M_TOT, IN_COLS, (int)gridDim.x + zs, (int)blockIdx.x + zs);
          pg8::gemm_phase<pg8::EpiProjB, pg8::StaticOrder, true, true>(lds, g, S, pg8::EpiProjB{(bf16_t*)(p->ws + WS_PROJ), IN_COLS}); }
        xcd_barrier(bar);
        { KP p = get_kp(); const Ctx c = make_ctx(); LAS float* wsm = (LAS float*)(lds + c.wave * 8192);
          st_kv_out(p, l, c);
          st_s5_simple(p, l, c, wsm);
          st_lru_simple(p, l, c, wsm);
          st_attn_simple(p, l, c); }
        xcd_barrier(bar);
        { KP p = get_kp(); int zs = 0; asm volatile("" : "+s"(zs)); bf16_t* PROJ = (bf16_t*)(p->ws + WS_PROJ);
          pg8::Gemm g{PROJ + C_UB, IN_COLS, (const bf16_t*)((unsigned char*)p->out + DO_WGLU) + (size_t)l * 512 * 512, 512};
          pg8::StaticOrder S; S.init(M_TOT, 512, (int)gridDim.x + zs, (int)blockIdx.x + zs);
          pg8::gemm_phase<pg8::EpiGluB, pg8::StaticOrder, true, true>(lds, g, S, pg8::EpiGluB{PROJ}); }
        xcd_barrier(bar);
        { KP p = get_kp(); int zs = 0; asm volatile("" : "+s"(zs)); bf16_t* PROJ = (bf16_t*)(p->ws + WS_PROJ);
          pg8::Gemm g{PROJ, IN_COLS, (const bf16_t*)((unsigned char*)p->out + DO_WBR) + (size_t)l * 3 * 1024 * 512, 512};
          pg8::BranchOrder S; S.init(M_TOT, 1024, (int)gridDim.x + zs, (int)blockIdx.x + zs);
          pg8::gemm_phase<pg8::EpiBranchB, pg8::BranchOrder, true, true>(lds, g, S, pg8::EpiBranchB{PROJ}); }
        xcd_barrier(bar);
        { KP p = get_kp(); int zs = 0; asm volatile("" : "+s"(zs)); bf16_t* PROJ = (bf16_t*)(p->ws + WS_PROJ);
          pg8::Gemm g{PROJ + C_GM, IN_COLS, (const bf16_t*)(p->ws + WS_WOUT) + (size_t)l * 1024 * 1024, 1024};
          pg8::StaticOrder S; S.init(M_TOT, 1024, (int)gridDim.x + zs, (int)blockIdx.x + zs);
          pg8::gemm_phase<pg8::EpiOutB, pg8::StaticOrder, true, true>(lds, g, S, pg8::EpiOutB{p->in[0], p->in[1], (const bf16_t*)(p->ws + WS_XB), p->ws, l}); }
        xcd_barrier(bar);
        { KP p = get_kp(); const Ctx c = make_ctx(); st_ln(p, l, c); }
        if (l + 1 < DEPTH) xcd_barrier(bar);
    }
}

extern "C" void kernel_launch(void* const* d_in, const int* in_sizes, int n_in, void* d_out, int out_size, void* d_ws, size_t ws_size, hipStream_t stream) {
    static int grid = 0;
    if (grid == 0) {
        if (n_in != 33 || (size_t)out_size != O_END || ws_size < WS_CTL + CTL_BYTES) { fprintf(stderr, "kernel_launch: unexpected sizes n_in %d out %d ws %zu\n", n_in, out_size, ws_size); grid = -1; return; }
        int dev = 0, cus = 0, per_cu = 0;
        if (hipGetDevice(&dev) != hipSuccess || hipDeviceGetAttribute(&cus, hipDeviceAttributeMultiprocessorCount, dev) != hipSuccess) { grid = -1; return; }
        if (hipFuncSetAttribute((const void*)mega_fwd, hipFuncAttributeMaxDynamicSharedMemorySize, LDS_BYTES) != hipSuccess) { fprintf(stderr, "kernel_launch: hipFuncSetAttribute failed\n"); grid = -1; return; }
        if (hipOccupancyMaxActiveBlocksPerMultiprocessor(&per_cu, (const void*)mega_fwd, NTHREADS, LDS_BYTES) != hipSuccess || per_cu < 1) { fprintf(stderr, "kernel_launch: occupancy query says %d blocks/CU\n", per_cu); grid = -1; return; }
        grid = cus;
    }
    if (grid < 0) return;
    (void)hipMemsetAsync((unsigned char*)d_ws + WS_CTL, 0, CTL_BYTES, stream);
    P p{};
    for (int i = 0; i < 33; ++i) p.in[i] = (const float*)d_in[i];
    p.out = (float*)d_out; p.ws = (unsigned char*)d_ws;
    void* args[] = {&p};
    hipError_t e = hipLaunchCooperativeKernel((const void*)mega_fwd, dim3(grid), dim3(NTHREADS), args, LDS_BYTES, stream);
    if (e != hipSuccess) fprintf(stderr, "kernel_launch: cooperative launch failed: %s (grid %d)\n", hipGetErrorString(e), grid);
}
```

```cpp
#include <hip/hip_runtime.h>
#include <cstdint>
#include <cstdio>

typedef unsigned short bf16_t;
typedef short bf16x8 __attribute__((ext_vector_type(8)));
typedef float f32x16 __attribute__((ext_vector_type(16)));
typedef float f32x4 __attribute__((ext_vector_type(4)));

constexpr int D_MODEL = 1024, BATCH = 8, SEQ = 2048, DEPTH = 2, DEC_BATCH = 128, DEC_SEQ = 4;
constexpr int M_P = BATCH * SEQ;
constexpr int M_S = DEC_BATCH * DEC_SEQ;
constexpr int M_TOT = M_P + M_S;
constexpr int IN_COLS = 6400;
constexpr int C_Q = 0, C_K = 512, C_V = 640, C_GA = 768, C_UB = 1280, C_GB = 1792, C_XC = 2304, C_GC = 2816, C_GM = 3328;
constexpr int WINDOW = 128, NKV = 2, HD = 64, NQH = 8;
constexpr int NG = 32, NP = 64, NC = 16;
constexpr float DN_ALPHA = 1.4142135623730951f;
constexpr float LN_EPS = 1e-5f;

constexpr size_t O_YP = 0;
constexpr size_t O_YS = O_YP + (size_t)M_P * D_MODEL;
constexpr size_t O_KP = O_YS + (size_t)M_S * D_MODEL;
constexpr size_t SZ_KP = (size_t)DEPTH * BATCH * WINDOW * NKV * HD;
constexpr size_t O_VP = O_KP + SZ_KP;
constexpr size_t O_SRP = O_VP + SZ_KP;
constexpr size_t SZ_SP = (size_t)DEPTH * BATCH * NG * NP;
constexpr size_t O_SIP = O_SRP + SZ_SP;
constexpr size_t O_LP = O_SIP + SZ_SP;
constexpr size_t SZ_LP = (size_t)DEPTH * BATCH * 512;
constexpr size_t O_CP = O_LP + SZ_LP;
constexpr size_t SZ_CP = (size_t)DEPTH * BATCH * 3 * 512;
constexpr size_t O_KS = O_CP + SZ_CP;
constexpr size_t SZ_KS = (size_t)DEPTH * DEC_BATCH * WINDOW * NKV * HD;
constexpr size_t O_VS = O_KS + SZ_KS;
constexpr size_t O_SRS = O_VS + SZ_KS;
constexpr size_t SZ_SS = (size_t)DEPTH * DEC_BATCH * NG * NP;
constexpr size_t O_SIS = O_SRS + SZ_SS;
constexpr size_t O_LS = O_SIS + SZ_SS;
constexpr size_t SZ_LS = (size_t)DEPTH * DEC_BATCH * 512;
constexpr size_t O_CS = O_LS + SZ_LS;
constexpr size_t SZ_CS = (size_t)DEPTH * DEC_BATCH * 3 * 512;
constexpr size_t O_END = O_CS + SZ_CS;

constexpr size_t WS_PROJ = 0;
constexpr size_t WS_XB = WS_PROJ + (size_t)M_TOT * IN_COLS * 2;
constexpr size_t WS_WOUT = WS_XB + (size_t)M_TOT * D_MODEL * 2;
constexpr size_t WS_TAB = WS_WOUT + (size_t)DEPTH * 1024 * 1024 * 2;
constexpr size_t TAB_AB = 0;
constexpr size_t TAB_BB = TAB_AB + (size_t)DEPTH * NG * NP * 2 * 4;
constexpr size_t TAB_BYTES = TAB_BB + (size_t)DEPTH * NG * NP * NC * 2 * 4;
constexpr size_t WS_END = WS_TAB + TAB_BYTES;
constexpr size_t DO_WIN = 0;
constexpr size_t DO_WBR = DO_WIN + (size_t)DEPTH * IN_COLS * 1024 * 2;
constexpr size_t DO_WGLU = DO_WBR + (size_t)DEPTH * 3 * 1024 * 512 * 2;
constexpr size_t DO_LRUW = DO_WGLU + (size_t)DEPTH * 512 * 512 * 2;
constexpr size_t DO_END = DO_LRUW;
static_assert(DO_END <= (size_t)M_P * D_MODEL * 4, "weights fit in y_prompt region");
static_assert(WS_END <= 268435456ull, "workspace fits 256 MiB");

__constant__ unsigned char T5_BUCKET[128] = {0, 1, 2, 3, 4, 5, 6, 7, 8, 9, 10, 11, 12, 13, 14, 15, 16, 16, 16, 17, 17, 18, 18, 18, 19, 19, 19, 20, 20, 20, 20, 21, 21, 21, 21, 22, 22, 22, 22, 22, 23, 23, 23, 23, 23, 23, 24, 24, 24, 24, 24, 24, 25, 25, 25, 25, 25, 25, 25, 26, 26, 26, 26, 26, 26, 26, 26, 27, 27, 27, 27, 27, 27, 27, 27, 27, 27, 28, 28, 28, 28, 28, 28, 28, 28, 28, 28, 29, 29, 29, 29, 29, 29, 29, 29, 29, 29, 29, 29, 30, 30, 30, 30, 30, 30, 30, 30, 30, 30, 30, 30, 30, 30, 31, 31, 31, 31, 31, 31, 31, 31, 31, 31, 31, 31, 31, 31, 31};

__device__ __forceinline__ float bf2f(bf16_t v) { return __uint_as_float(((unsigned)v) << 16); }
__device__ __forceinline__ bf16_t f2bf(float f) { unsigned u = __float_as_uint(f); return (bf16_t)((u + 0x7fffu + ((u >> 16) & 1u)) >> 16); }
__device__ __forceinline__ float sigmoidf_(float x) { return 1.0f / (1.0f + __expf(-x)); }
__device__ __forceinline__ float siluf_(float x) { return x * sigmoidf_(x); }
__device__ __forceinline__ float gelu_tanh(float y) { const float t = tanhf(0.7978845608028654f * (y + 0.044715f * y * y * y)); return 0.5f * y * (1.0f + t); }

struct P {
    const float* in[33];
    float* out;
    unsigned char* ws;
};

typedef const P __attribute__((address_space(4)))* KP;
__device__ __forceinline__ KP get_kp() { KP k = (KP)__builtin_amdgcn_kernarg_segment_ptr(); asm volatile("" : "+s"(k)); return k; }

constexpr size_t WS_CTL = (WS_END + 4095) & ~(size_t)4095;
constexpr size_t CTL_BYTES = 65536;
static_assert(WS_CTL + CTL_BYTES <= 268435456ull, "workspace fits 256 MiB");
constexpr int NTHREADS = 512, NWAVES = 8;
constexpr int LDS_BYTES = 147456;
constexpr int LDS_MISC = 135168;

#define LAS __attribute__((address_space(3)))
#define XB_TMO      128
#define XB_XCNT(j)  (256  + 64 * (j))
#define XB_XSUB(j)  (1280 + 64 * (j))
#define XB_XGEN(j)  (2304 + 64 * (j))
#define XB_TOP      3328
#define XB_TOPGEN   3392
#define XCD_BAR_WORDS 3456
#define XB_SPIN_CAP (1u << 18)
__device__ __forceinline__ unsigned xb_ld(unsigned* p)              { return __hip_atomic_load(p, __ATOMIC_RELAXED, __HIP_MEMORY_SCOPE_AGENT); }
__device__ __forceinline__ unsigned xb_add(unsigned* p, unsigned v) { return __hip_atomic_fetch_add(p, v, __ATOMIC_RELAXED, __HIP_MEMORY_SCOPE_AGENT); }
__device__ __forceinline__ unsigned xb_xcc_id() { return (unsigned)__builtin_amdgcn_s_getreg((3 << 11) | 20) & 0xFu; }
#define XB_SPIN(cond, bar) do { unsigned _sp = 0; while (cond) { __builtin_amdgcn_s_sleep(1); \
    if ((++_sp & 255u) == 0u) { if (xb_ld(&(bar)[XB_TMO])) break; if (_sp > XB_SPIN_CAP) { atomicAdd(&(bar)[XB_TMO], 1u); break; } } } } while (0)
struct XcdBarrier { unsigned* bar; unsigned x; volatile LAS unsigned* st; };
__device__ __forceinline__ XcdBarrier xcd_barrier_post(unsigned* bar, volatile LAS unsigned* st) {
    XcdBarrier b; b.bar = bar; b.x = xb_xcc_id(); b.st = st;
    if (threadIdx.x == 0) (void)xb_add(&bar[XB_XCNT(b.x)], 1u);
    return b;
}
__device__ __forceinline__ void xcd_barrier_complete(unsigned* bar, unsigned x, unsigned& nloc, unsigned& nx) {
    const unsigned G = gridDim.x * gridDim.y * gridDim.z;
    unsigned sum, cnt, mine, sp = 0u;
    for (;;) {
        sum = 0u; cnt = 0u; mine = 0u;
#pragma unroll
        for (unsigned j = 0; j < 16; ++j) { const unsigned c = xb_ld(&bar[XB_XCNT(j)]); sum += c; cnt += (c > 0u) ? 1u : 0u; mine = (j == x) ? c : mine; }
        if (sum == G) break;
        __builtin_amdgcn_s_sleep(1);
        if ((++sp & 255u) == 0u) { if (xb_ld(&bar[XB_TMO])) break; if (sp > XB_SPIN_CAP) { atomicAdd(&bar[XB_TMO], 1u); break; } }
    }
    nloc = mine > 0u ? mine : 1u; nx = cnt > 0u ? cnt : 1u;
}
__device__ __forceinline__ void xcd_barrier(const XcdBarrier& b) {
    asm volatile("s_waitcnt vmcnt(0)" ::: "memory");
    __syncthreads();
    if (threadIdx.x == 0) {
        unsigned* bar = b.bar; asm volatile("" : "+s"(bar));
        __builtin_amdgcn_s_waitcnt(0);
        unsigned nloc = b.st[0], nx = b.st[1];
        if (nloc == 0u) { xcd_barrier_complete(bar, b.x, nloc, nx); b.st[0] = nloc; b.st[1] = nx; }
        const unsigned old = xb_add(&bar[XB_XSUB(b.x)], 1u);
        const unsigned gen = old / nloc;
        if (old + 1u == (gen + 1u) * nloc) {
            __builtin_amdgcn_fence(__ATOMIC_RELEASE, "agent");
            asm volatile("s_waitcnt vmcnt(0)" ::: "memory");
            const unsigned og = xb_add(&bar[XB_TOP], 1u);
            const unsigned tg = og / nx;
            if (og + 1u == (tg + 1u) * nx) xb_add(&bar[XB_TOPGEN], 1u);
            else XB_SPIN(xb_ld(&bar[XB_TOPGEN]) == tg, bar);
            __builtin_amdgcn_fence(__ATOMIC_ACQUIRE, "agent");
            xb_add(&bar[XB_XGEN(b.x)], 1u);
            asm volatile("s_waitcnt vmcnt(0)" ::: "memory");
        } else {
            XB_SPIN(xb_ld(&bar[XB_XGEN(b.x)]) == gen, bar);
            __builtin_amdgcn_fence(__ATOMIC_ACQUIRE, "agent");
            asm volatile("s_waitcnt vmcnt(0)" ::: "memory");
        }
    }
    __syncthreads();
}

namespace pg8 {
#define PG8_LAS __attribute__((address_space(3)))
typedef unsigned short bf16_t;
typedef short bf16x8 __attribute__((ext_vector_type(8)));
typedef float f32x4 __attribute__((ext_vector_type(4)));
typedef unsigned u32x4 __attribute__((ext_vector_type(4)));
constexpr int BM = 256, BK = 64, HALF = 128, HTB = HALF * BK * 2  , STAGE_BYTES = 8 * HTB, NXCD = 8, WGM = 8;

__host__ __device__ __forceinline__ int lds_byte(int r, int c) { const int st = (r >> 4) * 2 + (c >> 5), rr = r & 15, cc = c & 31, ob = rr * 64 + cc * 2; return st * 1024 + (ob ^ (((ob >> 9) & 1) << 5)); }
__host__ __device__ __forceinline__ void stage_rc(int b, int& R, int& C) { const int st = b / 1024, sb = b % 1024, swz = sb ^ (((sb >> 9) & 1) << 5); R = (st >> 1) * 16 + swz / 64; C = (st & 1) * 32 + (swz % 64) / 2; }
__host__ __device__ __forceinline__ int perm32(int rho) { const int n = rho >> 4, i = rho & 15; return 8 * (i >> 2) + 4 * n + (i & 3); }

struct Unit { int pm, pn, z; };
struct Gemm { const bf16_t* A; int lda; const bf16_t* Bt; int K; };

struct StaticOrder {
    int nM, nN, nwg, G, c;
    __host__ __device__ void init(int M, int N, int G_, int c_) { nM = M / BM; nN = N / BM; nwg = nM * nN; G = G_; c = c_; }
    __host__ __device__ bool next(int i, Unit& u) const {
        const long L = (long)i * G + c; if (L >= nwg) return false;
        int wgid = (int)L; { const int q = nwg / NXCD, r = nwg % NXCD, xcd = wgid % NXCD, off = wgid / NXCD; wgid = (xcd < r ? xcd * (q + 1) : r * (q + 1) + (xcd - r) * q) + off; }
        const int nig = WGM * nN, gid = wgid / nig, fm = gid * WGM, gsz = (nM - fm) < WGM ? (nM - fm) : WGM;
        u.pm = fm + ((wgid % nig) % gsz); u.pn = (wgid % nig) / gsz; u.z = 0; return true;
    }
    __device__ __forceinline__ size_t a_off(const Unit&) const { return 0; }
    __device__ __forceinline__ size_t b_off(const Unit&) const { return 0; }
    __device__ __forceinline__ void a_ready(const Unit&) const {}
    __device__ __forceinline__ void done(const Unit&) const {}
};

__device__ __forceinline__ unsigned cvt_pk_bf16(float lo, float hi) { unsigned r; asm volatile("v_cvt_pk_bf16_f32 %0, %1, %2" : "=v"(r) : "v"(lo), "v"(hi)); return r; }
typedef float f32x2 __attribute__((ext_vector_type(2)));
__device__ __forceinline__ f32x2 gelu_pk(f32x2 v) {
    const f32x2 av = __builtin_elementwise_abs(v), d = av * 0.2316418882f + 1.0f;
    f32x2 t; t.x = __builtin_amdgcn_rcpf(d.x); t.y = __builtin_amdgcn_rcpf(d.y);
    f32x2 q = t * 0.5307027145f + (-0.7265760135f); q = q * t + 0.7107068705f; q = q * t + (-0.142248368f); q = q * t + 0.127414796f; q = q * t;
    const f32x2 s = (v * v) * (-0.72134752044f);
    f32x2 e; e.x = __builtin_amdgcn_exp2f(s.x); e.y = __builtin_amdgcn_exp2f(s.y);
    const f32x2 m = v * (q * e), r = v - m;
    f32x2 o; o.x = v.x < 0.f ? m.x : r.x; o.y = v.y < 0.f ? m.y : r.y; return o;
}

template <class Epi, class Sched, bool ALIGN_EPI = false, bool SP2 = false>
__device__ __forceinline__ void gemm_phase(PG8_LAS unsigned char* lds, const Gemm g, const Sched& S, const Epi& E) {
    int zv_ = 0; asm volatile("" : "+v"(zv_));
    const int tid = (int)threadIdx.x + zv_, wid = __builtin_amdgcn_readfirstlane(tid >> 6), lane = tid & 63, wr = wid >> 2, wc = wid & 3, fr = lane & 15, fq = lane >> 4;
    const int K = g.K, nt = K / BK;
    unsigned voffA[2], voffB[2];
#pragma unroll
    for (int i = 0; i < 2; ++i) { int R, C; stage_rc(tid * 16 + i * 8192, R, C); const int Rb = Epi::PERM ? ((R & ~31) + perm32(R & 31)) : R;
        voffA[i] = (unsigned)(R * g.lda + C) * 2u; voffB[i] = (unsigned)(Rb * K + C) * 2u; }
    const size_t kstep = (size_t)(BK * 2);
    const size_t hstepA = (size_t)HALF * g.lda * 2, hstepB = (size_t)HALF * K * 2;
    const size_t tstepA = 2 * hstepA, tstepB = 2 * hstepB;
    const unsigned ldsw = (unsigned)wid * 1024u;
    const int aoff = lds_byte(wr * 64 + fr, fq * 8), boff = lds_byte(wc * 32 + fr, fq * 8);
#define PG8_SA(b, h) (((b) * 2 + (h)) * HTB)
#define PG8_SB(b, h) ((4 + (b) * 2 + (h)) * HTB)
#define PG8_STAGE(bufoff, gbase, voff) do { _Pragma("unroll") for (int _i = 0; _i < 2; ++_i) \
        __builtin_amdgcn_global_load_lds((const unsigned*)((const char*)(gbase) + (voff)[_i]), (PG8_LAS unsigned*)(lds + (bufoff) + ldsw + _i * 8192), 16, 0, 0); } while (0)
#define PG8_LDA(dst, b, h) do { _Pragma("unroll") for (int m = 0; m < 4; ++m) _Pragma("unroll") for (int k = 0; k < 2; ++k) dst[m][k] = *(const PG8_LAS bf16x8*)(lds + PG8_SA(b, h) + aoff + m * 2048 + k * 1024); } while (0)
#define PG8_LDB(dst, b, h) do { _Pragma("unroll") for (int n = 0; n < 2; ++n) _Pragma("unroll") for (int k = 0; k < 2; ++k) dst[n][k] = *(const PG8_LAS bf16x8*)(lds + PG8_SB(b, h) + boff + n * 2048 + k * 1024); } while (0)
#define PG8_MMA(ai, bj, At, Bt) do { __builtin_amdgcn_s_setprio(1); _Pragma("unroll") for (int m = 0; m < 4; ++m) _Pragma("unroll") for (int n = 0; n < 2; ++n) _Pragma("unroll") for (int k = 0; k < 2; ++k) \
        acc[ai][bj][m][n] = __builtin_amdgcn_mfma_f32_16x16x32_bf16(Bt[n][k], At[m][k], acc[ai][bj][m][n], 0, 0, 0); __builtin_amdgcn_s_setprio(0); } while (0)
#define PG8_WAIT_V(n) asm volatile("s_waitcnt vmcnt(" #n ")" ::: "memory")
#define PG8_WAIT_L(n) asm volatile("s_waitcnt lgkmcnt(" #n ")" ::: "memory")
#define PG8_BAR __builtin_amdgcn_s_barrier()
#define PG8_SCHED __builtin_amdgcn_sched_barrier(0)
    Unit cur, nxt; int ui = 0;
    if (!S.next(0, cur)) return;
    f32x4 acc[2][2][4][2];
#pragma unroll
    for (int a = 0; a < 2; ++a)
#pragma unroll
        for (int b = 0; b < 2; ++b)
#pragma unroll
            for (int m = 0; m < 4; ++m)
#pragma unroll
                for (int n = 0; n < 2; ++n) acc[a][b][m][n] = (f32x4){0.f, 0.f, 0.f, 0.f};
    bf16x8 At[4][2], B0[2][2], B1[2][2];
    const char* cA = (const char*)g.A + (size_t)cur.pm * tstepA + S.a_off(cur); const char* cB = (const char*)g.Bt + (size_t)cur.pn * tstepB + S.b_off(cur);
    S.a_ready(cur);
    if constexpr (SP2) {
        PG8_STAGE(PG8_SB(0, 0), cB, voffB); PG8_STAGE(PG8_SB(0, 1), cB + hstepB, voffB); PG8_STAGE(PG8_SA(0, 0), cA, voffA); PG8_STAGE(PG8_SA(0, 1), cA + hstepA, voffA);
        if (wr == 1) PG8_BAR;
        PG8_WAIT_V(2); PG8_BAR;
        PG8_STAGE(PG8_SB(1, 0), cB + kstep, voffB); PG8_STAGE(PG8_SA(1, 0), cA + kstep, voffA); PG8_STAGE(PG8_SB(1, 1), cB + hstepB + kstep, voffB);
        PG8_WAIT_V(6); PG8_BAR;
    } else {
        PG8_STAGE(PG8_SB(0, 0), cB, voffB); PG8_STAGE(PG8_SA(0, 0), cA, voffA); PG8_STAGE(PG8_SB(0, 1), cB + hstepB, voffB); PG8_STAGE(PG8_SA(0, 1), cA + hstepA, voffA);
        if (wr == 1) PG8_BAR;
        PG8_WAIT_V(4); PG8_BAR;
        PG8_STAGE(PG8_SB(1, 0), cB + kstep, voffB); PG8_STAGE(PG8_SA(1, 0), cA + kstep, voffA); PG8_STAGE(PG8_SB(1, 1), cB + hstepB + kstep, voffB);
        PG8_WAIT_V(6); PG8_BAR;
    }
    for (;;) {
        const bool has_next = S.next(ui + 1, nxt);
        const char* nA = has_next ? (const char*)g.A + (size_t)nxt.pm * tstepA + S.a_off(nxt) : cA; const char* nB = has_next ? (const char*)g.Bt + (size_t)nxt.pn * tstepB + S.b_off(nxt) : cB;
        for (int t = 0; t < nt; t += 2) {
            const bool last = (t == nt - 2);
            const char* a1 = cA + (size_t)(t + 1) * kstep;
            const char* a2 = last ? nA : cA + (size_t)(t + 2) * kstep; const char* b2 = last ? nB : cB + (size_t)(t + 2) * kstep;
            const char* a3 = a2 + kstep; const char* b3 = b2 + kstep;
            if (last && has_next) S.a_ready(nxt);
            if constexpr (SP2) {
            PG8_LDB(B0, 0, 0); PG8_LDB(B1, 0, 1); PG8_SCHED; PG8_LDA(At, 0, 0); PG8_STAGE(PG8_SA(1, 1), a1 + hstepA, voffA);
            PG8_WAIT_V(8); PG8_WAIT_L(0); PG8_BAR; PG8_MMA(0, 0, At, B0); PG8_MMA(0, 1, At, B1); PG8_BAR; PG8_SCHED;
            PG8_LDA(At, 0, 1); PG8_STAGE(PG8_SB(0, 0), b2, voffB); PG8_STAGE(PG8_SB(0, 1), b2 + hstepB, voffB); PG8_STAGE(PG8_SA(0, 0), a2, voffA);
            PG8_WAIT_V(8); PG8_WAIT_L(0); PG8_BAR; PG8_MMA(1, 0, At, B0); PG8_MMA(1, 1, At, B1); PG8_BAR; PG8_SCHED;
            PG8_LDB(B0, 1, 0); PG8_LDB(B1, 1, 1); PG8_SCHED; PG8_LDA(At, 1, 0); PG8_STAGE(PG8_SA(0, 1), a2 + hstepA, voffA);
            PG8_WAIT_V(8); PG8_WAIT_L(0); PG8_BAR; PG8_MMA(0, 0, At, B0); PG8_MMA(0, 1, At, B1); PG8_BAR; PG8_SCHED;
            PG8_LDA(At, 1, 1); PG8_STAGE(PG8_SB(1, 0), b3, voffB); PG8_STAGE(PG8_SB(1, 1), b3 + hstepB, voffB); PG8_STAGE(PG8_SA(1, 0), a3, voffA);
            PG8_WAIT_V(8); PG8_WAIT_L(0); PG8_BAR; PG8_MMA(1, 0, At, B0); PG8_MMA(1, 1, At, B1); PG8_BAR; PG8_SCHED;
            } else {
            PG8_LDB(B0, 0, 0); PG8_SCHED; PG8_LDA(At, 0, 0); PG8_STAGE(PG8_SA(1, 1), a1 + hstepA, voffA);
            PG8_WAIT_L(8); PG8_BAR; PG8_WAIT_L(0); PG8_MMA(0, 0, At, B0); PG8_BAR; PG8_SCHED;
            PG8_LDB(B1, 0, 1); PG8_STAGE(PG8_SB(0, 0), b2, voffB);
            PG8_BAR; PG8_WAIT_L(0); PG8_MMA(0, 1, At, B1); PG8_BAR;
            PG8_LDA(At, 0, 1); PG8_STAGE(PG8_SA(0, 0), a2, voffA);
            PG8_BAR; PG8_WAIT_L(0); PG8_MMA(1, 0, At, B0); PG8_BAR; PG8_SCHED;
            PG8_STAGE(PG8_SB(0, 1), b2 + hstepB, voffB);
            PG8_WAIT_V(6); PG8_BAR; PG8_MMA(1, 1, At, B1); PG8_BAR;
            PG8_LDB(B0, 1, 0); PG8_SCHED; PG8_LDA(At, 1, 0); PG8_STAGE(PG8_SA(0, 1), a2 + hstepA, voffA);
            PG8_WAIT_L(8); PG8_BAR; PG8_WAIT_L(0); PG8_MMA(0, 0, At, B0); PG8_BAR; PG8_SCHED;
            PG8_LDB(B1, 1, 1); PG8_STAGE(PG8_SB(1, 0), b3, voffB);
            PG8_BAR; PG8_WAIT_L(0); PG8_MMA(0, 1, At, B1); PG8_BAR;
            PG8_LDA(At, 1, 1); PG8_STAGE(PG8_SA(1, 0), a3, voffA);
            PG8_BAR; PG8_WAIT_L(0); PG8_MMA(1, 0, At, B0); PG8_BAR; PG8_SCHED;
            PG8_STAGE(PG8_SB(1, 1), b3 + hstepB, voffB);
            PG8_WAIT_V(6); PG8_BAR; PG8_MMA(1, 1, At, B1); PG8_BAR;
            }
        }
        if constexpr (ALIGN_EPI) { if (wr == 0) PG8_BAR; }
        if constexpr (!Epi::AFTER_DRAIN) { E(acc, cur, wr, wc, fr, fq); S.done(cur); }
        if (!has_next) break;
#pragma unroll
        for (int a = 0; a < 2; ++a)
#pragma unroll
            for (int b = 0; b < 2; ++b)
#pragma unroll
                for (int m = 0; m < 4; ++m)
#pragma unroll
                    for (int n = 0; n < 2; ++n) acc[a][b][m][n] = (f32x4){0.f, 0.f, 0.f, 0.f};
        cur = nxt; cA = nA; cB = nB; ++ui;
        if constexpr (ALIGN_EPI) { if (wr == 1) PG8_BAR; }
    }
    PG8_WAIT_V(0);
    if constexpr (!ALIGN_EPI) { if (wr == 0) PG8_BAR; }
    PG8_BAR;
    if constexpr (Epi::AFTER_DRAIN) { E.fused(acc, cur, wr, wc, fr, fq, lds, wid, lane); S.done(cur); }
#undef PG8_SA
#undef PG8_SB
#undef PG8_STAGE
#undef PG8_LDA
#undef PG8_LDB
#undef PG8_MMA
#undef PG8_WAIT_V
#undef PG8_WAIT_L
#undef PG8_BAR
#undef PG8_SCHED
}
}

namespace pg8 {
typedef unsigned u32x2 __attribute__((ext_vector_type(2)));
__device__ __forceinline__ float bflo(unsigned w) { return __uint_as_float(w << 16); }
__device__ __forceinline__ float bfhi(unsigned w) { return __uint_as_float(w & 0xffff0000u); }
__device__ __forceinline__ float sigm(float x) { return __builtin_amdgcn_rcpf(1.0f + __expf(-x)); }
struct EpiProjB {
    static constexpr bool PERM = true, AFTER_DRAIN = false;
    bf16_t* O; int ldc;
    __device__ __forceinline__ void operator()(const f32x4 (&acc)[2][2][4][2], const Unit& u, int wr, int wc, int fr, int fq) const {
        const int row0 = u.pm * BM + wr * 64 + fr, col0 = u.pn * BM + wc * 32 + 8 * fq;
#pragma unroll
        for (int ai = 0; ai < 2; ++ai)
#pragma unroll
            for (int m = 0; m < 4; ++m) { bf16_t* rowp = O + (size_t)(row0 + ai * HALF + m * 16) * ldc + col0;
#pragma unroll
                for (int bj = 0; bj < 2; ++bj) { const f32x4 v0 = acc[ai][bj][m][0], v1 = acc[ai][bj][m][1];
                    u32x4 w; w.x = cvt_pk_bf16(v0[0], v0[1]); w.y = cvt_pk_bf16(v0[2], v0[3]); w.z = cvt_pk_bf16(v1[0], v1[1]); w.w = cvt_pk_bf16(v1[2], v1[3]);
                    *(u32x4*)(rowp + bj * HALF) = w; } }
    }
};
struct EpiGluB {
    static constexpr bool PERM = true, AFTER_DRAIN = false;
    bf16_t* PROJ;
    __device__ __forceinline__ void operator()(const f32x4 (&acc)[2][2][4][2], const Unit& u, int wr, int wc, int fr, int fq) const {
        const int row0 = u.pm * BM + wr * 64 + fr, col0 = u.pn * BM + wc * 32 + 8 * fq;
#pragma unroll
        for (int ai = 0; ai < 2; ++ai)
#pragma unroll
            for (int m = 0; m < 4; ++m) { bf16_t* rowp = PROJ + (size_t)(row0 + ai * HALF + m * 16) * IN_COLS + col0;
#pragma unroll
                for (int bj = 0; bj < 2; ++bj) {
                    const u32x4 zz = *(const u32x4*)(rowp + C_UB + bj * HALF), gg = *(const u32x4*)(rowp + C_GB + bj * HALF);
                    const f32x4 v0 = acc[ai][bj][m][0], v1 = acc[ai][bj][m][1];
                    float o[8];
#pragma unroll
                    for (int e = 0; e < 4; ++e) {
                        const float va = e < 2 ? v0[2 * e] : v1[2 * (e - 2)], vb = e < 2 ? v0[2 * e + 1] : v1[2 * (e - 2) + 1];
                        const float za = bflo(zz[e]), zb = bfhi(zz[e]), ga = bflo(gg[e]), gb = bfhi(gg[e]);
                        o[2 * e] = za * sigm(va) * ga * sigm(ga); o[2 * e + 1] = zb * sigm(vb) * gb * sigm(gb);
                    }
                    u32x4 w; w.x = cvt_pk_bf16(o[0], o[1]); w.y = cvt_pk_bf16(o[2], o[3]); w.z = cvt_pk_bf16(o[4], o[5]); w.w = cvt_pk_bf16(o[6], o[7]);
                    *(u32x4*)(rowp + C_GB + bj * HALF) = w; } }
    }
};
struct EpiBranchB {
    static constexpr bool PERM = true, AFTER_DRAIN = false;
    bf16_t* PROJ;
    __device__ __forceinline__ void operator()(const f32x4 (&acc)[2][2][4][2], const Unit& u, int wr, int wc, int fr, int fq) const {
        const int row0 = u.pm * BM + wr * 64 + fr, col0 = u.pn * BM + wc * 32 + 8 * fq;
        const int z = u.z;
#pragma unroll
        for (int ai = 0; ai < 2; ++ai)
#pragma unroll
            for (int m = 0; m < 4; ++m) { bf16_t* rowp = PROJ + (size_t)(row0 + ai * HALF + m * 16) * IN_COLS + C_GM + col0;
#pragma unroll
                for (int bj = 0; bj < 2; ++bj) {
                    const u32x4 gg = *(const u32x4*)(rowp + z * 1024 + bj * HALF);
                    u32x4 pp = (u32x4){0u, 0u, 0u, 0u};
                    if (z > 0) pp = *(const u32x4*)(rowp + bj * HALF);
                    const f32x4 v0 = acc[ai][bj][m][0], v1 = acc[ai][bj][m][1];
                    float o[8];
#pragma unroll
                    for (int e = 0; e < 4; ++e) {
                        const float va = e < 2 ? v0[2 * e] : v1[2 * (e - 2)], vb = e < 2 ? v0[2 * e + 1] : v1[2 * (e - 2) + 1];
                        o[2 * e] = bflo(pp[e]) + sigm(bflo(gg[e])) * va; o[2 * e + 1] = bfhi(pp[e]) + sigm(bfhi(gg[e])) * vb;
                    }
                    u32x4 w; w.x = cvt_pk_bf16(o[0], o[1]); w.y = cvt_pk_bf16(o[2], o[3]); w.z = cvt_pk_bf16(o[4], o[5]); w.w = cvt_pk_bf16(o[6], o[7]);
                    *(u32x4*)(rowp + bj * HALF) = w; } }
    }
};
struct BranchOrder : StaticOrder {
    __device__ bool next(int i, Unit& u) const { if (!StaticOrder::next(i / 3, u)) return false; u.z = i % 3; return true; }
    __device__ __forceinline__ size_t a_off(const Unit& u) const { return (size_t)(u.z == 0 ? C_Q : (u.z == 1 ? C_GB : C_XC)) * 2; }
    __device__ __forceinline__ size_t b_off(const Unit& u) const { return (size_t)u.z * 1024 * 512 * 2; }
};
struct EpiOutB {
    static constexpr bool PERM = false, AFTER_DRAIN = false;
    const float* xp; const float* xs; const bf16_t* XB; unsigned char* ws; int l;
    __device__ __forceinline__ void operator()(const f32x4 (&acc)[2][2][4][2], const Unit& u, int wr, int wc, int fr, int fq) const {
        const int row0 = u.pm * BM + wr * 64 + fr, col0 = u.pn * BM + wc * 32 + 4 * fq;
#pragma unroll
        for (int ai = 0; ai < 2; ++ai)
#pragma unroll
            for (int m = 0; m < 4; ++m) { const int r = row0 + ai * HALF + m * 16;
                float* prow = (float*)(ws + WS_PROJ + (size_t)r * IN_COLS * 2 + (size_t)(C_GM + 1024) * 2) + col0;
#pragma unroll
                for (int bj = 0; bj < 2; ++bj)
#pragma unroll
                    for (int n = 0; n < 2; ++n) {
                        const int co = bj * HALF + n * 16;
                        f32x4 x;
                        if (l == 0) x = r < M_P ? *(const f32x4*)(xp + (size_t)r * D_MODEL + col0 + co) : *(const f32x4*)(xs + (size_t)(r - M_P) * D_MODEL + col0 + co);
                        else { const u32x2 xx = *(const u32x2*)(XB + (size_t)r * D_MODEL + col0 + co); x = (f32x4){bflo(xx.x), bfhi(xx.x), bflo(xx.y), bfhi(xx.y)}; }
                        *(f32x4*)(prow + co) = x * DN_ALPHA + acc[ai][bj][m][n];
                    } }
    }
};
}

struct Ctx { int tid, lane, wave, gw, ngw; size_t gt, ngt; };
__device__ __forceinline__ Ctx make_ctx() {
    int zv = 0; asm volatile("" : "+v"(zv)); int zs = 0; asm volatile("" : "+s"(zs));
    Ctx c; c.tid = (int)threadIdx.x + zv; c.lane = c.tid & 63; c.wave = __builtin_amdgcn_readfirstlane(c.tid >> 6);
    const int bid = (int)blockIdx.x + zs, nb = (int)gridDim.x + zs;
    c.gw = c.wave * nb + bid; c.ngw = nb * NWAVES; c.gt = (size_t)bid * NTHREADS + c.tid; c.ngt = (size_t)nb * NTHREADS; return c;
}
#define WAVE_LDS_SYNC() do { asm volatile("s_waitcnt lgkmcnt(0)" ::: "memory"); __builtin_amdgcn_wave_barrier(); } while (0)

__device__ __forceinline__ void st_convert_x(KP p, const Ctx& c) {
    bf16_t* XB = (bf16_t*)(p->ws + WS_XB);
    const size_t n = (size_t)M_TOT * D_MODEL;
    for (size_t i = c.gt; i < n; i += c.ngt) {
        const float v = i < (size_t)M_P * D_MODEL ? p->in[0][i] : p->in[1][i - (size_t)M_P * D_MODEL];
        XB[i] = f2bf(v);
    }
}
__device__ __forceinline__ void st_transpose_w(const float* W, bf16_t* WT, int K, int N, const Ctx& c) {
    const size_t n = (size_t)K * N;
    for (size_t i = c.gt; i < n; i += c.ngt) { const int nn = (int)(i / K), kk = (int)(i % K); WT[i] = f2bf(W[(size_t)kk * N + nn]); }
}
__device__ __forceinline__ void st_s5_tables(KP p, const Ctx& c) {
    float* AB = (float*)(p->ws + WS_TAB + TAB_AB);
    float* BB = (float*)(p->ws + WS_TAB + TAB_BB);
    for (size_t ii = c.gt; ii < (size_t)DEPTH * NG * NP; ii += c.ngt) {
        const int i = (int)ii, l = i / (NG * NP), g = (i / NP) % NG;
        const float lr = fminf(p->in[12][i], -1e-4f), li = p->in[13][i];
        const float step = expf(p->in[14][l * NG + g]);
        const float mag = expf(lr * step);
        float sn, cs; sincosf(li * step, &sn, &cs);
        const float ab_re = mag * cs, ab_im = mag * sn;
        const float den = lr * lr + li * li;
        const float f_re = ((ab_re - 1.0f) * lr + ab_im * li) / den;
        const float f_im = (ab_im * lr - (ab_re - 1.0f) * li) / den;
        AB[2 * i] = ab_re; AB[2 * i + 1] = ab_im;
        for (int cc = 0; cc < NC; ++cc) {
            const float bre = p->in[15][(size_t)i * NC + cc], bim = p->in[16][(size_t)i * NC + cc];
            BB[((size_t)i * NC + cc) * 2] = f_re * bre - f_im * bim;
            BB[((size_t)i * NC + cc) * 2 + 1] = f_re * bim + f_im * bre;
        }
    }
}

template <class Epi>
__device__ __forceinline__ void gemm_simple(const bf16_t* A, int lda, const bf16_t* Bt, int ldb, int M, int N, int K, Epi epi, const Ctx& c) {
    const int lane = c.lane;
    const int ntn = N / 32, ntiles = (M / 32) * ntn;
    for (int tile = c.gw; tile < ntiles; tile += c.ngw) {
        const int tm = tile / ntn, tn = tile % ntn;
        f32x16 acc = {};
        const bf16_t* ar = A + (size_t)(tm * 32 + (lane & 31)) * lda + 8 * (lane >> 5);
        const bf16_t* br = Bt + (size_t)(tn * 32 + (lane & 31)) * ldb + 8 * (lane >> 5);
        for (int k0 = 0; k0 < K; k0 += 16) {
            const bf16x8 a = *(const bf16x8*)(ar + k0);
            const bf16x8 b = *(const bf16x8*)(br + k0);
            acc = __builtin_amdgcn_mfma_f32_32x32x16_bf16(a, b, acc, 0, 0, 0);
        }
#pragma unroll
        for (int r = 0; r < 16; ++r) {
            const int row = tm * 32 + (r & 3) + 8 * (r >> 2) + 4 * (lane >> 5), col = tn * 32 + (lane & 31);
            epi(row, col, acc[r]);
        }
    }
}
struct EpiProj { bf16_t* PROJ; __device__ void operator()(int r, int c, float v) const { PROJ[(size_t)r * IN_COLS + c] = f2bf(v); } };

__device__ __forceinline__ void st_kv_out(KP p, int l, const Ctx& c) {
    const bf16_t* PROJ = (const bf16_t*)(p->ws + WS_PROJ);
    for (size_t ii = c.gt; ii < (size_t)DEC_BATCH * WINDOW * 128; ii += c.ngt) {
        const int i = (int)ii;
        if (i < BATCH * WINDOW * 128) {
            const int b = i / (WINDOW * 128), w = (i / 128) % WINDOW, cc = i % 128;
            const size_t row = (size_t)b * SEQ + (SEQ - WINDOW) + w;
            p->out[O_KP + (size_t)l * BATCH * WINDOW * 128 + i] = bf2f(PROJ[row * IN_COLS + C_K + cc]);
            p->out[O_VP + (size_t)l * BATCH * WINDOW * 128 + i] = bf2f(PROJ[row * IN_COLS + C_V + cc]);
        }
        {
            const int b = i / (WINDOW * 128), w = (i / 128) % WINDOW, cc = i % 128;
            float kv, vv;
            if (w < WINDOW - DEC_SEQ) {
                const size_t ci = (((size_t)l * DEC_BATCH + b) * WINDOW + (w + DEC_SEQ)) * 128 + cc;
                kv = p->in[2][ci]; vv = p->in[3][ci];
            } else {
                const size_t row = (size_t)M_P + b * DEC_SEQ + (w - (WINDOW - DEC_SEQ));
                kv = bf2f(PROJ[row * IN_COLS + C_K + cc]); vv = bf2f(PROJ[row * IN_COLS + C_V + cc]);
            }
            p->out[O_KS + (size_t)l * DEC_BATCH * WINDOW * 128 + i] = kv;
            p->out[O_VS + (size_t)l * DEC_BATCH * WINDOW * 128 + i] = vv;
        }
    }
}

__device__ __forceinline__ void st_attn_simple(KP p, int l, const Ctx& c) {
    bf16_t* PROJ = (bf16_t*)(p->ws + WS_PROJ);
    const int lane = c.lane;
    const float* rel_bias = p->in[8];
    for (int item = c.gw; item < M_S * NQH; item += c.ngw) {
        const int m = M_P + item / NQH, h = item % NQH, kvh = h / 4;
        const bool samp = m >= M_P;
        const int b = samp ? (m - M_P) / DEC_SEQ : m / SEQ, t = samp ? (m - M_P) % DEC_SEQ : m % SEQ;
        float q[64];
        {
            const bf16_t* qp = PROJ + (size_t)m * IN_COLS + C_Q + h * 64;
#pragma unroll
            for (int d = 0; d < 64; ++d) q[d] = bf2f(qp[d]);
        }
        const float sink = p->in[10][l * NQH + h];
        float s[2];
#pragma unroll
        for (int j = 0; j < 2; ++j) {
            const int d = lane + 64 * j;
            const int tk = t - d;
            float sc = -1e30f;
            if (!samp) {
                if (tk >= 0) {
                    const bf16_t* kp = PROJ + ((size_t)b * SEQ + tk) * IN_COLS + C_K + kvh * 64;
                    float a = 0.f;
#pragma unroll
                    for (int e = 0; e < 64; ++e) a += q[e] * bf2f(kp[e]);
                    sc = a * 0.125f + rel_bias[T5_BUCKET[d] * NQH + h];
                }
            } else {
                float a = 0.f;
                if (tk >= 0) {
                    const bf16_t* kp = PROJ + ((size_t)M_P + b * DEC_SEQ + tk) * IN_COLS + C_K + kvh * 64;
#pragma unroll
                    for (int e = 0; e < 64; ++e) a += q[e] * bf2f(kp[e]);
                } else {
                    const float* kp = p->in[2] + ((((size_t)l * DEC_BATCH + b) * WINDOW + (WINDOW + tk)) * NKV + kvh) * HD;
#pragma unroll
                    for (int e = 0; e < 64; ++e) a += q[e] * kp[e];
                }
                sc = a * 0.125f + rel_bias[T5_BUCKET[d] * NQH + h];
            }
            s[j] = sc;
        }
        float mx = fmaxf(fmaxf(s[0], s[1]), sink);
        for (int o = 32; o > 0; o >>= 1) mx = fmaxf(mx, __shfl_xor(mx, o));
        const float p0 = s[0] > -1e29f ? __expf(s[0] - mx) : 0.f, p1 = s[1] > -1e29f ? __expf(s[1] - mx) : 0.f;
        float sum = p0 + p1;
        for (int o = 32; o > 0; o >>= 1) sum += __shfl_xor(sum, o);
        const float denom = sum + __expf(sink - mx);
        float o = 0.f;
        for (int d = 0; d < 128; ++d) {
            const float pj = __shfl(d < 64 ? p0 : p1, d & 63);
            const int tk = t - d;
            float vv = 0.f;
            if (!samp) { if (tk >= 0) vv = bf2f(PROJ[((size_t)b * SEQ + tk) * IN_COLS + C_V + kvh * 64 + lane]); }
            else if (tk >= 0) vv = bf2f(PROJ[((size_t)M_P + b * DEC_SEQ + tk) * IN_COLS + C_V + kvh * 64 + lane]);
            else vv = p->in[3][((((size_t)l * DEC_BATCH + b) * WINDOW + (WINDOW + tk)) * NKV + kvh) * HD + lane];
            o += pj * vv;
        }
        o /= denom;
        const float ga = bf2f(PROJ[(size_t)m * IN_COLS + C_GA + h * 64 + lane]);
        PROJ[(size_t)m * IN_COLS + C_Q + h * 64 + lane] = f2bf(o * siluf_(ga));
    }
}

typedef short s16x4 __attribute__((ext_vector_type(4)));
typedef short v4i16_t __attribute__((ext_vector_type(4)));
typedef unsigned u32x4 __attribute__((ext_vector_type(4)));
typedef float f32x2_t __attribute__((ext_vector_type(2)));
typedef __bf16 bf16x2_t __attribute__((ext_vector_type(2)));
__device__ __forceinline__ unsigned cvtpk(float lo, float hi) { f32x2_t v = {lo, hi}; bf16x2_t b = __builtin_convertvector(v, bf16x2_t); return __builtin_bit_cast(unsigned, b); }
__device__ __forceinline__ bf16x8 pack8(float a0, float a1, float a2, float a3, float a4, float a5, float a6, float a7) {
    u32x4 p; p.x = cvtpk(a0, a1); p.y = cvtpk(a2, a3); p.z = cvtpk(a4, a5); p.w = cvtpk(a6, a7); return __builtin_bit_cast(bf16x8, p); }
__device__ __forceinline__ s16x4 tr_read(LAS const unsigned char* p) { return __builtin_bit_cast(s16x4, __builtin_amdgcn_ds_read_tr16_b64_v4i16((LAS v4i16_t*)p)); }
__device__ __forceinline__ bf16x8 cat8(s16x4 lo, s16x4 hi) { return __builtin_shufflevector(lo, hi, 0, 1, 2, 3, 4, 5, 6, 7); }
#define MFMA32(a, b, c) __builtin_amdgcn_mfma_f32_32x32x16_bf16((a), (b), (c), 0, 0, 0)
#define MFMA16(a, b, c) __builtin_amdgcn_mfma_f32_16x16x32_bf16((a), (b), (c), 0, 0, 0)

constexpr int AT_KSTR = 144, AT_VSTR = 192;
constexpr int AT_K = 0, AT_V = AT_K + 256 * AT_KSTR, AT_BIAS = AT_V + 256 * AT_VSTR, AT_WS = AT_BIAS + 4 * 128 * 4, AT_END = AT_WS + 8 * 256;
static_assert(AT_END <= 131072, "attention LDS");

__device__ __forceinline__ void st_attn_prompt(KP p, int l, LAS unsigned char* lds) {
    int zv = 0; asm volatile("" : "+v"(zv));
    const int tid = (int)threadIdx.x + zv, lane = tid & 63, wave = __builtin_amdgcn_readfirstlane(tid >> 6);
    const int c31 = lane & 31, h = lane >> 5;
    bf16_t* PROJ = (bf16_t*)(p->ws + WS_PROJ);
    const float* rel_bias = p->in[8];
    for (int item = blockIdx.x; item < BATCH * 16 * NKV; item += gridDim.x) {
        const int b = item / 32, nb = (item >> 1) & 15, kvh = item & 1;
        const size_t rowq0 = (size_t)b * SEQ + (size_t)nb * 128;
#pragma unroll
        for (int i = 0; i < 4; ++i) {
            const int id = tid + 512 * i, row = id >> 3, pc = id & 7;
            u32x4 kk = (u32x4){0u, 0u, 0u, 0u}, vv = kk;
            if (nb > 0 || row >= 128) {
                const bf16_t* src = PROJ + (rowq0 - 128 + row) * IN_COLS + kvh * 64 + pc * 8;
                kk = *(const u32x4*)(src + C_K); vv = *(const u32x4*)(src + C_V);
            }
            *(LAS u32x4*)(lds + AT_K + row * AT_KSTR + pc * 16) = kk;
            *(LAS u32x4*)(lds + AT_V + row * AT_VSTR + pc * 16) = vv;
        }
        { const int g = tid >> 7, d = tid & 127; ((LAS float*)(lds + AT_BIAS))[tid] = rel_bias[T5_BUCKET[d] * NQH + kvh * 4 + g]; }
        __syncthreads();
        const int g = wave >> 1, hq = kvh * 4 + g;
        const float sink = p->in[10][l * NQH + hq];
        LAS const float* biasd = (LAS const float*)(lds + AT_BIAS) + g * 128;
        LAS float* wsf = (LAS float*)(lds + AT_WS + wave * 256);
#pragma unroll 1
        for (int qi = 0; qi < 2; ++qi) {
            const int qt = 2 * (wave & 1) + qi, q0 = 32 * qt;
            bf16x8 qf[4];
            { const bf16_t* qp = PROJ + (rowq0 + q0 + c31) * IN_COLS + C_Q + hq * 64 + 8 * h;
#pragma unroll
              for (int ks = 0; ks < 4; ++ks) qf[ks] = *(const bf16x8*)(qp + 16 * ks); }
            f32x16 S[5];
#pragma unroll
            for (int j = 0; j < 5; ++j) {
                S[j] = (f32x16){};
                LAS const unsigned char* kp = lds + AT_K + (32 * (qt + j) + c31) * AT_KSTR + 16 * h;
#pragma unroll
                for (int ks = 0; ks < 4; ++ks) S[j] = MFMA32(*(LAS const bf16x8*)(kp + 32 * ks), qf[ks], S[j]);
            }
            const int iq = q0 + c31;
            float mx = sink;
#pragma unroll
            for (int j = 0; j < 5; ++j)
#pragma unroll
                for (int r = 0; r < 16; ++r) {
                    const int kv = 32 * (qt + j) + (r & 3) + 8 * (r >> 2) + 4 * h;
                    const int dist = iq + 128 - kv;
                    const bool ok = (dist >= 0) && (dist < 128) && (nb > 0 || kv >= 128);
                    const float s = ok ? S[j][r] * 0.125f + biasd[dist & 127] : -1e30f;
                    S[j][r] = s; mx = fmaxf(mx, s);
                }
            mx = fmaxf(mx, __shfl_xor(mx, 32));
            float sum = 0.f;
#pragma unroll
            for (int j = 0; j < 5; ++j)
#pragma unroll
                for (int r = 0; r < 16; ++r) { const float e = S[j][r] > -1e29f ? __expf(S[j][r] - mx) : 0.f; S[j][r] = e; sum += e; }
            sum += __shfl_xor(sum, 32);
            const float rden = 1.0f / (sum + __expf(sink - mx));
            if (h == 0) wsf[c31] = rden;
            f32x16 O[2]; O[0] = (f32x16){}; O[1] = (f32x16){};
            const int i16 = lane & 15, qq = i16 >> 2, pp = i16 & 3, blk = (lane >> 4) & 1;
#pragma unroll
            for (int j = 0; j < 5; ++j)
#pragma unroll
                for (int s = 0; s < 2; ++s) {
                    const bf16x8 pf = pack8(S[j][8 * s], S[j][8 * s + 1], S[j][8 * s + 2], S[j][8 * s + 3], S[j][8 * s + 4], S[j][8 * s + 5], S[j][8 * s + 6], S[j][8 * s + 7]);
                    LAS const unsigned char* vp = lds + AT_V + (32 * (qt + j) + 16 * s + 4 * h + qq) * AT_VSTR + (16 * blk + 4 * pp) * 2;
#pragma unroll
                    for (int dt = 0; dt < 2; ++dt) {
                        const bf16x8 vf = cat8(tr_read(vp + dt * 64), tr_read(vp + dt * 64 + 8 * AT_VSTR));
                        O[dt] = MFMA32(pf, vf, O[dt]);
                    }
                }
            WAVE_LDS_SYNC();
#pragma unroll
            for (int r = 0; r < 16; ++r) {
                const int qr = (r & 3) + 8 * (r >> 2) + 4 * h;
                const float rd = wsf[qr];
                bf16_t* rowp = PROJ + (rowq0 + q0 + qr) * IN_COLS + hq * 64 + c31;
#pragma unroll
                for (int dt = 0; dt < 2; ++dt) {
                    const float ga = bf2f(rowp[C_GA + 32 * dt]);
                    rowp[C_Q + 32 * dt] = f2bf(O[dt][r] * rd * siluf_(ga));
                }
            }
            WAVE_LDS_SYNC();
        }
        __syncthreads();
    }
}

__device__ __forceinline__ void st_s5_simple(KP p, int l, const Ctx& c, LAS float* wsm) {
    bf16_t* PROJ = (bf16_t*)(p->ws + WS_PROJ);
    const float* AB = (const float*)(p->ws + WS_TAB + TAB_AB);
    const float* BB = (const float*)(p->ws + WS_TAB + TAB_BB);
    const int pp = c.lane;
    for (int item = c.gw; item < (BATCH + DEC_BATCH) * NG; item += c.ngw) {
        const int seq = item / NG, g = item % NG;
        const bool samp = seq >= BATCH;
        const int b = samp ? seq - BATCH : seq, T = samp ? DEC_SEQ : SEQ;
        const size_t row0 = samp ? (size_t)M_P + b * DEC_SEQ : (size_t)b * SEQ;
        const int sidx = (l * NG + g) * NP + pp;
        const float ab_re = AB[2 * sidx], ab_im = AB[2 * sidx + 1];
        float bbr[16], bbi[16], cr[16], ci[16];
#pragma unroll
        for (int cc = 0; cc < 16; ++cc) {
            bbr[cc] = BB[((size_t)sidx * NC + cc) * 2]; bbi[cc] = BB[((size_t)sidx * NC + cc) * 2 + 1];
            cr[cc] = p->in[17][((size_t)(l * NG + g) * NC + cc) * NP + pp]; ci[cc] = p->in[18][((size_t)(l * NG + g) * NC + cc) * NP + pp];
        }
        const float dd = pp < 16 ? p->in[19][l * 512 + g * 16 + pp] : 0.f;
        float hr = 0.f, hi = 0.f;
        if (samp) { const size_t si = (((size_t)l * DEC_BATCH + b) * NG + g) * NP + pp; hr = p->in[4][si]; hi = p->in[5][si]; }
        for (int t = 0; t < T; ++t) {
            bf16_t* up = PROJ + (row0 + t) * IN_COLS + C_UB + g * 16;
            float u[16];
#pragma unroll
            for (int cc = 0; cc < 16; ++cc) u[cc] = bf2f(up[cc]);
            float xr = 0.f, xi = 0.f;
#pragma unroll
            for (int cc = 0; cc < 16; ++cc) { xr += bbr[cc] * u[cc]; xi += bbi[cc] * u[cc]; }
            const float nr = ab_re * hr - ab_im * hi + xr, ni = ab_re * hi + ab_im * hr + xi;
            hr = nr; hi = ni;
#pragma unroll
            for (int cc = 0; cc < 16; ++cc) wsm[pp * 17 + cc] = cr[cc] * hr - ci[cc] * hi;
            WAVE_LDS_SYNC();
            if (pp < 16) {
                float y = 0.f;
                for (int q = 0; q < 64; ++q) y += wsm[q * 17 + pp];
                y += dd * bf2f(up[pp]);
                up[pp] = f2bf(gelu_tanh(y));
            }
            WAVE_LDS_SYNC();
        }
        if (!samp) { const size_t oi = (((size_t)l * BATCH + b) * NG + g) * NP + pp; p->out[O_SRP + oi] = hr; p->out[O_SIP + oi] = hi; }
        else { const size_t oi = (((size_t)l * DEC_BATCH + b) * NG + g) * NP + pp; p->out[O_SRS + oi] = hr; p->out[O_SIS + oi] = hi; }
    }
}

struct EpiGlu { bf16_t* PROJ; __device__ void operator()(int r, int c, float v) const {
    const float z = bf2f(PROJ[(size_t)r * IN_COLS + C_UB + c]), gb = bf2f(PROJ[(size_t)r * IN_COLS + C_GB + c]);
    PROJ[(size_t)r * IN_COLS + C_GB + c] = f2bf(z * sigmoidf_(v) * siluf_(gb)); } };

__device__ __forceinline__ void st_lru_simple(KP p, int l, const Ctx& c, LAS float* wsm) {
    bf16_t* PROJ = (bf16_t*)(p->ws + WS_PROJ);
    const int e = c.lane;
    for (int item = c.gw; item < (BATCH + DEC_BATCH) * 8; item += c.ngw) {
        const int seq = item / 8, n = item % 8, ch = n * 64 + e;
        const bool samp = seq >= BATCH;
        const int b = samp ? seq - BATCH : seq, T = samp ? DEC_SEQ : SEQ;
        const size_t row0 = samp ? (size_t)M_P + b * DEC_SEQ : (size_t)b * SEQ;
        float wa[64], wx[64];
#pragma unroll
        for (int d = 0; d < 64; ++d) { wa[d] = p->in[24][(((size_t)l * 8 + n) * 64 + d) * 64 + e]; wx[d] = p->in[26][(((size_t)l * 8 + n) * 64 + d) * 64 + e]; }
        const float ba = p->in[25][l * 512 + ch], bx = p->in[27][l * 512 + ch], lam = p->in[28][l * 512 + ch];
        const float lsig = -log1pf(expf(-lam));
        const float cw0 = p->in[22][(l * 4 + 0) * 512 + ch], cw1 = p->in[22][(l * 4 + 1) * 512 + ch], cw2 = p->in[22][(l * 4 + 2) * 512 + ch], cw3 = p->in[22][(l * 4 + 3) * 512 + ch];
        const float cb = p->in[23][l * 512 + ch];
        float xm3 = 0.f, xm2 = 0.f, xm1 = 0.f, h = 0.f;
        if (samp) {
            const size_t ci = (((size_t)l * DEC_BATCH + b) * 3) * 512 + ch;
            xm3 = p->in[7][ci]; xm2 = p->in[7][ci + 512]; xm1 = p->in[7][ci + 1024];
            h = p->in[6][((size_t)l * DEC_BATCH + b) * 512 + ch];
        }
        for (int t = 0; t < T; ++t) {
            bf16_t* rp = PROJ + (row0 + t) * IN_COLS;
            const float xc = bf2f(rp[C_XC + ch]);
            const float xf = cb + cw0 * xm3 + cw1 * xm2 + cw2 * xm1 + cw3 * xc;
            xm3 = xm2; xm2 = xm1; xm1 = xc;
            wsm[e] = xf;
            WAVE_LDS_SYNC();
            float r = ba, i = bx;
#pragma unroll
            for (int d = 0; d < 64; ++d) { const float xv = wsm[d]; r += xv * wa[d]; i += xv * wx[d]; }
            WAVE_LDS_SYNC();
            r = sigmoidf_(r); i = sigmoidf_(i);
            const float log_a = 8.0f * r * lsig;
            const float a = expf(log_a);
            const float bt = xf * i * sqrtf(-expm1f(2.0f * log_a));
            h = a * h + bt;
            const float gc = bf2f(rp[C_GC + ch]);
            rp[C_XC + ch] = f2bf(h * siluf_(gc));
        }
        if (!samp) {
            p->out[O_LP + ((size_t)l * BATCH + b) * 512 + ch] = h;
            const size_t ci = (((size_t)l * BATCH + b) * 3) * 512 + ch;
            p->out[O_CP + ci] = xm3; p->out[O_CP + ci + 512] = xm2; p->out[O_CP + ci + 1024] = xm1;
        } else {
            p->out[O_LS + ((size_t)l * DEC_BATCH + b) * 512 + ch] = h;
            const size_t ci = (((size_t)l * DEC_BATCH + b) * 3) * 512 + ch;
            p->out[O_CS + ci] = xm3; p->out[O_CS + ci + 512] = xm2; p->out[O_CS + ci + 1024] = xm1;
        }
    }
}

__device__ __forceinline__ void st_branch_simple(KP p, int l, const Ctx& c) {
    bf16_t* PROJ = (bf16_t*)(p->ws + WS_PROJ);
    const bf16_t* WB = (const bf16_t*)((unsigned char*)p->out + DO_WBR) + (size_t)l * 3 * 1024 * 512;
    const int lane = c.lane;
    const int ntn = 1024 / 32, ntiles = (M_TOT / 32) * ntn;
    for (int tile = c.gw; tile < ntiles; tile += c.ngw) {
        const int tm = tile / ntn, tn = tile % ntn;
        f32x16 acc[3];
#pragma unroll
        for (int br = 0; br < 3; ++br) {
            const int acol = br == 0 ? C_Q : (br == 1 ? C_GB : C_XC);
            acc[br] = (f32x16){};
            const bf16_t* ar = PROJ + (size_t)(tm * 32 + (lane & 31)) * IN_COLS + acol + 8 * (lane >> 5);
            const bf16_t* bp = WB + (size_t)br * 1024 * 512 + (size_t)(tn * 32 + (lane & 31)) * 512 + 8 * (lane >> 5);
            for (int k0 = 0; k0 < 512; k0 += 16)
                acc[br] = __builtin_amdgcn_mfma_f32_32x32x16_bf16(*(const bf16x8*)(ar + k0), *(const bf16x8*)(bp + k0), acc[br], 0, 0, 0);
        }
#pragma unroll
        for (int r = 0; r < 16; ++r) {
            const int row = tm * 32 + (r & 3) + 8 * (r >> 2) + 4 * (lane >> 5), col = tn * 32 + (lane & 31);
            bf16_t* gp = PROJ + (size_t)row * IN_COLS + C_GM + col;
            const float m = sigmoidf_(bf2f(gp[0])) * acc[0][r] + sigmoidf_(bf2f(gp[1024])) * acc[1][r] + sigmoidf_(bf2f(gp[2048])) * acc[2][r];
            gp[0] = f2bf(m);
        }
    }
}

__device__ __forceinline__ float* pre_row(unsigned char* ws, int r) { return (float*)(ws + WS_PROJ + (size_t)r * IN_COLS * 2 + (size_t)(C_GM + 1024) * 2); }
struct EpiOut { KP p; int l; __device__ void operator()(int r, int c, float v) const {
    float x;
    if (l == 0) x = r < M_P ? p->in[0][(size_t)r * D_MODEL + c] : p->in[1][(size_t)(r - M_P) * D_MODEL + c];
    else x = bf2f(((const bf16_t*)(p->ws + WS_XB))[(size_t)r * D_MODEL + c]);
    pre_row(p->ws, r)[c] = DN_ALPHA * x + v; } };

__device__ __forceinline__ void st_ln(KP p, int l, const Ctx& c) {
    const int lane = c.lane;
    const float* g = p->in[31] + l * 1024; const float* bb = p->in[32] + l * 1024;
    for (int r = c.gw; r < M_TOT; r += c.ngw) {
        const float* pr = pre_row(p->ws, r);
        float v[16]; float s = 0.f;
#pragma unroll
        for (int j = 0; j < 16; ++j) { v[j] = pr[lane + 64 * j]; s += v[j]; }
        for (int o = 32; o > 0; o >>= 1) s += __shfl_xor(s, o);
        const float mu = s * (1.0f / 1024.0f);
        float q = 0.f;
#pragma unroll
        for (int j = 0; j < 16; ++j) { const float d = v[j] - mu; q += d * d; }
        for (int o = 32; o > 0; o >>= 1) q += __shfl_xor(q, o);
        const float rstd = rsqrtf(q * (1.0f / 1024.0f) + LN_EPS);
#pragma unroll
        for (int j = 0; j < 16; ++j) {
            const int cc = lane + 64 * j;
            const float y = (v[j] - mu) * rstd * g[cc] + bb[cc];
            if (l == 0) ((bf16_t*)(p->ws + WS_XB))[(size_t)r * D_MODEL + cc] = f2bf(y);
            else if (r < M_P) p->out[O_YP + (size_t)r * D_MODEL + cc] = y;
            else p->out[O_YS + (size_t)(r - M_P) * D_MODEL + cc] = y;
        }
    }
}

__global__ void __launch_bounds__(NTHREADS, 2) mega_fwd(P p_unused) {
    extern __shared__ __attribute__((aligned(16))) unsigned char lds_raw[];
    LAS unsigned char* lds = (LAS unsigned char*)lds_raw;
    volatile LAS unsigned* misc = (volatile LAS unsigned*)(lds + LDS_MISC);
    if (threadIdx.x < 32) misc[threadIdx.x] = 0u;
    __syncthreads();
    XcdBarrier bar;
    { KP p = get_kp(); bar = xcd_barrier_post((unsigned*)(p->ws + WS_CTL), misc); }

    { KP p = get_kp(); const Ctx c = make_ctx(); unsigned char* dob = (unsigned char*)p->out;
      st_convert_x(p, c);
      for (int l = 0; l < DEPTH; ++l) {
        st_transpose_w(p->in[9] + (size_t)l * 1024 * IN_COLS, (bf16_t*)(dob + DO_WIN) + (size_t)l * IN_COLS * 1024, 1024, IN_COLS, c);
        st_transpose_w(p->in[11] + (size_t)l * 512 * 1024, (bf16_t*)(dob + DO_WBR) + ((size_t)l * 3 + 0) * 1024 * 512, 512, 1024, c);
        st_transpose_w(p->in[21] + (size_t)l * 512 * 1024, (bf16_t*)(dob + DO_WBR) + ((size_t)l * 3 + 1) * 1024 * 512, 512, 1024, c);
        st_transpose_w(p->in[29] + (size_t)l * 512 * 1024, (bf16_t*)(dob + DO_WBR) + ((size_t)l * 3 + 2) * 1024 * 512, 512, 1024, c);
        st_transpose_w(p->in[20] + (size_t)l * 512 * 512, (bf16_t*)(dob + DO_WGLU) + (size_t)l * 512 * 512, 512, 512, c);
        st_transpose_w(p->in[30] + (size_t)l * 1024 * 1024, (bf16_t*)(p->ws + WS_WOUT) + (size_t)l * 1024 * 1024, 1024, 1024, c);
      }
      st_s5_tables(p, c); }
    xcd_barrier(bar);

    for (int l = 0; l < DEPTH; ++l) {
        { KP p = get_kp(); int zs = 0; asm volatile("" : "+s"(zs));
          pg8::Gemm g{(const bf16_t*)(p->ws + WS_XB), D_MODEL, (const bf16_t*)((unsigned char*)p->out + DO_WIN) + (size_t)l * IN_COLS * 1024, 1024};
          pg8::StaticOrder S; S.init(M_TOT, IN_COLS, (int)gridDim.x + zs, (int)blockIdx.x + zs);
          pg8::gemm_phase<pg8::EpiProjB, pg8::StaticOrder, true, true>(lds, g, S, pg8::EpiProjB{(bf16_t*)(p->ws + WS_PROJ), IN_COLS}); }
        xcd_barrier(bar);
        { KP p = get_kp(); const Ctx c = make_ctx(); LAS float* wsm = (LAS float*)(lds + c.wave * 8192);
          st_kv_out(p, l, c);
          st_s5_simple(p, l, c, wsm);
          st_lru_simple(p, l, c, wsm);
          st_attn_simple(p, l, c); }
        __syncthreads();
        { KP p = get_kp(); st_attn_prompt(p, l, lds); }
        xcd_barrier(bar);
        { KP p = get_kp(); int zs = 0; asm volatile("" : "+s"(zs)); bf16_t* PROJ = (bf16_t*)(p->ws + WS_PROJ);
          pg8::Gemm g{PROJ + C_UB, IN_COLS, (const bf16_t*)((unsigned char*)p->out + DO_WGLU) + (size_t)l * 512 * 512, 512};
          pg8::StaticOrder S; S.init(M_TOT, 512, (int)gridDim.x + zs, (int)blockIdx.x + zs);
          pg8::gemm_phase<pg8::EpiGluB, pg8::StaticOrder, true, true>(lds, g, S, pg8::EpiGluB{PROJ}); }
        xcd_barrier(bar);
        { KP p = get_kp(); int zs = 0; asm volatile("" : "+s"(zs)); bf16_t* PROJ = (bf16_t*)(p->ws + WS_PROJ);
          pg8::Gemm g{PROJ, IN_COLS, (const bf16_t*)((unsigned char*)p->out + DO_WBR) + (size_t)l * 3 * 1024 * 512, 512};
          pg8::BranchOrder S; S.init(M_TOT, 1024, (int)gridDim.x + zs, (int)blockIdx.x + zs);
          pg8::gemm_phase<pg8::EpiBranchB, pg8::BranchOrder, true, true>(lds, g, S, pg8::EpiBranchB{PROJ}); }
        xcd_barrier(bar);
        { KP p = get_kp(); int zs = 0; asm volatile("" : "+s"(zs)); bf16_t* PROJ = (bf16_t*)(p->ws + WS_PROJ);
          pg8::Gemm g{PROJ + C_GM, IN_COLS, (const bf16_t*)(p->ws + WS_WOUT) + (size_t)l * 1024 * 1024, 1024};
          pg8::StaticOrder S; S.init(M_TOT, 1024, (int)gridDim.x + zs, (int)blockIdx.x + zs);
          pg8::gemm_phase<pg8::EpiOutB, pg8::StaticOrder, true, true>(lds, g, S, pg8::EpiOutB{p->in[0], p->in[1], (const bf16_t*)(p->ws + WS_XB), p->ws, l}); }
        xcd_barrier(bar);
        { KP p = get_kp(); const Ctx c = make_ctx(); st_ln(p, l, c); }
        if (l + 1 < DEPTH) xcd_barrier(bar);
    }
}

extern "C" void kernel_launch(void* const* d_in, const int* in_sizes, int n_in, void* d_out, int out_size, void* d_ws, size_t ws_size, hipStream_t stream) {
    static int grid = 0;
    if (grid == 0) {
        if (n_in != 33 || (size_t)out_size != O_END || ws_size < WS_CTL + CTL_BYTES) { fprintf(stderr, "kernel_launch: unexpected sizes n_in %d out %d ws %zu\n", n_in, out_size, ws_size); grid = -1; return; }
        int dev = 0, cus = 0, per_cu = 0;
        if (hipGetDevice(&dev) != hipSuccess || hipDeviceGetAttribute(&cus, hipDeviceAttributeMultiprocessorCount, dev) != hipSuccess) { grid = -1; return; }
        if (hipFuncSetAttribute((const void*)mega_fwd, hipFuncAttributeMaxDynamicSharedMemorySize, LDS_BYTES) != hipSuccess) { fprintf(stderr, "kernel_launch: hipFuncSetAttribute failed\n"); grid = -1; return; }
        if (hipOccupancyMaxActiveBlocksPerMultiprocessor(&per_cu, (const void*)mega_fwd, NTHREADS, LDS_BYTES) != hipSuccess || per_cu < 1) { fprintf(stderr, "kernel_launch: occupancy query says %d blocks/CU\n", per_cu); grid = -1; return; }
        grid = cus;
    }
    if (grid < 0) return;
    (void)hipMemsetAsync((unsigned char*)d_ws + WS_CTL, 0, CTL_BYTES, stream);
    P p{};
    for (int i = 0; i < 33; ++i) p.in[i] = (const float*)d_in[i];
    p.out = (float*)d_out; p.ws = (unsigned char*)d_ws;
    void* args[] = {&p};
    hipError_t e = hipLaunchCooperativeKernel((const void*)mega_fwd, dim3(grid), dim3(NTHREADS), args, LDS_BYTES, stream);
    if (e != hipSuccess) fprintf(stderr, "kernel_launch: cooperative launch failed: %s (grid %d)\n", hipGetErrorString(e), grid);
}
```

```cpp
#include <hip/hip_runtime.h>
#include <cstdint>
#include <cstdio>

typedef unsigned short bf16_t;
typedef short bf16x8 __attribute__((ext_vector_type(8)));
typedef float f32x16 __attribute__((ext_vector_type(16)));
typedef float f32x4 __attribute__((ext_vector_type(4)));

constexpr int D_MODEL = 1024, BATCH = 8, SEQ = 2048, DEPTH = 2, DEC_BATCH = 128, DEC_SEQ = 4;
constexpr int M_P = BATCH * SEQ;
constexpr int M_S = DEC_BATCH * DEC_SEQ;
constexpr int M_TOT = M_P + M_S;
constexpr int IN_COLS = 6400;
constexpr int C_Q = 0, C_K = 512, C_V = 640, C_GA = 768, C_UB = 1280, C_GB = 1792, C_XC = 2304, C_GC = 2816, C_GM = 3328;
constexpr int WINDOW = 128, NKV = 2, HD = 64, NQH = 8;
constexpr int NG = 32, NP = 64, NC = 16;
constexpr float DN_ALPHA = 1.4142135623730951f;
constexpr float LN_EPS = 1e-5f;

constexpr size_t O_YP = 0;
constexpr size_t O_YS = O_YP + (size_t)M_P * D_MODEL;
constexpr size_t O_KP = O_YS + (size_t)M_S * D_MODEL;
constexpr size_t SZ_KP = (size_t)DEPTH * BATCH * WINDOW * NKV * HD;
constexpr size_t O_VP = O_KP + SZ_KP;
constexpr size_t O_SRP = O_VP + SZ_KP;
constexpr size_t SZ_SP = (size_t)DEPTH * BATCH * NG * NP;
constexpr size_t O_SIP = O_SRP + SZ_SP;
constexpr size_t O_LP = O_SIP + SZ_SP;
constexpr size_t SZ_LP = (size_t)DEPTH * BATCH * 512;
constexpr size_t O_CP = O_LP + SZ_LP;
constexpr size_t SZ_CP = (size_t)DEPTH * BATCH * 3 * 512;
constexpr size_t O_KS = O_CP + SZ_CP;
constexpr size_t SZ_KS = (size_t)DEPTH * DEC_BATCH * WINDOW * NKV * HD;
constexpr size_t O_VS = O_KS + SZ_KS;
constexpr size_t O_SRS = O_VS + SZ_KS;
constexpr size_t SZ_SS = (size_t)DEPTH * DEC_BATCH * NG * NP;
constexpr size_t O_SIS = O_SRS + SZ_SS;
constexpr size_t O_LS = O_SIS + SZ_SS;
constexpr size_t SZ_LS = (size_t)DEPTH * DEC_BATCH * 512;
constexpr size_t O_CS = O_LS + SZ_LS;
constexpr size_t SZ_CS = (size_t)DEPTH * DEC_BATCH * 3 * 512;
constexpr size_t O_END = O_CS + SZ_CS;

constexpr size_t WS_PROJ = 0;
constexpr size_t WS_XB = WS_PROJ + (size_t)M_TOT * IN_COLS * 2;
constexpr size_t WS_WOUT = WS_XB + (size_t)M_TOT * D_MODEL * 2;
constexpr size_t WS_TAB = WS_WOUT + (size_t)DEPTH * 1024 * 1024 * 2;
constexpr size_t TAB_AB = 0;
constexpr size_t TAB_BB = TAB_AB + (size_t)DEPTH * NG * NP * 2 * 4;
constexpr size_t TAB_BYTES = TAB_BB + (size_t)DEPTH * NG * NP * NC * 2 * 4;
constexpr size_t WS_S5POW = WS_TAB + TAB_BYTES;
constexpr size_t WS_S5PINV = WS_S5POW + (size_t)DEPTH * NG * 11 * NP * 8;
constexpr size_t WS_S5BCAT = WS_S5PINV + (size_t)DEPTH * NG * 9 * NP * 8;
constexpr size_t WS_S5CCAT = WS_S5BCAT + (size_t)DEPTH * NG * 128 * NC * 2;
constexpr size_t WS_S5SUM = WS_S5CCAT + (size_t)DEPTH * NG * 128 * NC * 2;
constexpr size_t WS_END = WS_S5SUM + (size_t)BATCH * 8 * NG * NP * 8;
constexpr size_t DO_WIN = 0;
constexpr size_t DO_WBR = DO_WIN + (size_t)DEPTH * IN_COLS * 1024 * 2;
constexpr size_t DO_WGLU = DO_WBR + (size_t)DEPTH * 3 * 1024 * 512 * 2;
constexpr size_t DO_LRUW = DO_WGLU + (size_t)DEPTH * 512 * 512 * 2;
constexpr size_t DO_END = DO_LRUW;
static_assert(DO_END <= (size_t)M_P * D_MODEL * 4, "weights fit in y_prompt region");
static_assert(WS_END <= 268435456ull, "workspace fits 256 MiB");

__constant__ unsigned char T5_BUCKET[128] = {0, 1, 2, 3, 4, 5, 6, 7, 8, 9, 10, 11, 12, 13, 14, 15, 16, 16, 16, 17, 17, 18, 18, 18, 19, 19, 19, 20, 20, 20, 20, 21, 21, 21, 21, 22, 22, 22, 22, 22, 23, 23, 23, 23, 23, 23, 24, 24, 24, 24, 24, 24, 25, 25, 25, 25, 25, 25, 25, 26, 26, 26, 26, 26, 26, 26, 26, 27, 27, 27, 27, 27, 27, 27, 27, 27, 27, 28, 28, 28, 28, 28, 28, 28, 28, 28, 28, 29, 29, 29, 29, 29, 29, 29, 29, 29, 29, 29, 29, 30, 30, 30, 30, 30, 30, 30, 30, 30, 30, 30, 30, 30, 30, 31, 31, 31, 31, 31, 31, 31, 31, 31, 31, 31, 31, 31, 31, 31};

__device__ __forceinline__ float bf2f(bf16_t v) { return __uint_as_float(((unsigned)v) << 16); }
__device__ __forceinline__ bf16_t f2bf(float f) { unsigned u = __float_as_uint(f); return (bf16_t)((u + 0x7fffu + ((u >> 16) & 1u)) >> 16); }
__device__ __forceinline__ float sigmoidf_(float x) { return 1.0f / (1.0f + __expf(-x)); }
__device__ __forceinline__ float siluf_(float x) { return x * sigmoidf_(x); }
__device__ __forceinline__ float gelu_tanh(float y) { const float t = tanhf(0.7978845608028654f * (y + 0.044715f * y * y * y)); return 0.5f * y * (1.0f + t); }

struct P {
    const float* in[33];
    float* out;
    unsigned char* ws;
};

typedef const P __attribute__((address_space(4)))* KP;
__device__ __forceinline__ KP get_kp() { KP k = (KP)__builtin_amdgcn_kernarg_segment_ptr(); asm volatile("" : "+s"(k)); return k; }

constexpr size_t WS_CTL = (WS_END + 4095) & ~(size_t)4095;
constexpr size_t CTL_BYTES = 65536;
static_assert(WS_CTL + CTL_BYTES <= 268435456ull, "workspace fits 256 MiB");
constexpr int NTHREADS = 512, NWAVES = 8;
constexpr int LDS_BYTES = 147456;
constexpr int LDS_MISC = 135168;

#define LAS __attribute__((address_space(3)))
#define XB_TMO      128
#define XB_XCNT(j)  (256  + 64 * (j))
#define XB_XSUB(j)  (1280 + 64 * (j))
#define XB_XGEN(j)  (2304 + 64 * (j))
#define XB_TOP      3328
#define XB_TOPGEN   3392
#define XCD_BAR_WORDS 3456
#define XB_SPIN_CAP (1u << 18)
__device__ __forceinline__ unsigned xb_ld(unsigned* p)              { return __hip_atomic_load(p, __ATOMIC_RELAXED, __HIP_MEMORY_SCOPE_AGENT); }
__device__ __forceinline__ unsigned xb_add(unsigned* p, unsigned v) { return __hip_atomic_fetch_add(p, v, __ATOMIC_RELAXED, __HIP_MEMORY_SCOPE_AGENT); }
__device__ __forceinline__ unsigned xb_xcc_id() { return (unsigned)__builtin_amdgcn_s_getreg((3 << 11) | 20) & 0xFu; }
#define XB_SPIN(cond, bar) do { unsigned _sp = 0; while (cond) { __builtin_amdgcn_s_sleep(1); \
    if ((++_sp & 255u) == 0u) { if (xb_ld(&(bar)[XB_TMO])) break; if (_sp > XB_SPIN_CAP) { atomicAdd(&(bar)[XB_TMO], 1u); break; } } } } while (0)
struct XcdBarrier { unsigned* bar; unsigned x; volatile LAS unsigned* st; };
__device__ __forceinline__ XcdBarrier xcd_barrier_post(unsigned* bar, volatile LAS unsigned* st) {
    XcdBarrier b; b.bar = bar; b.x = xb_xcc_id(); b.st = st;
    if (threadIdx.x == 0) (void)xb_add(&bar[XB_XCNT(b.x)], 1u);
    return b;
}
__device__ __forceinline__ void xcd_barrier_complete(unsigned* bar, unsigned x, unsigned& nloc, unsigned& nx) {
    const unsigned G = gridDim.x * gridDim.y * gridDim.z;
    unsigned sum, cnt, mine, sp = 0u;
    for (;;) {
        sum = 0u; cnt = 0u; mine = 0u;
#pragma unroll
        for (unsigned j = 0; j < 16; ++j) { const unsigned c = xb_ld(&bar[XB_XCNT(j)]); sum += c; cnt += (c > 0u) ? 1u : 0u; mine = (j == x) ? c : mine; }
        if (sum == G) break;
        __builtin_amdgcn_s_sleep(1);
        if ((++sp & 255u) == 0u) { if (xb_ld(&bar[XB_TMO])) break; if (sp > XB_SPIN_CAP) { atomicAdd(&bar[XB_TMO], 1u); break; } }
    }
    nloc = mine > 0u ? mine : 1u; nx = cnt > 0u ? cnt : 1u;
}
__device__ __forceinline__ void xcd_barrier(const XcdBarrier& b) {
    asm volatile("s_waitcnt vmcnt(0)" ::: "memory");
    __syncthreads();
    if (threadIdx.x == 0) {
        unsigned* bar = b.bar; asm volatile("" : "+s"(bar));
        __builtin_amdgcn_s_waitcnt(0);
        unsigned nloc = b.st[0], nx = b.st[1];
        if (nloc == 0u) { xcd_barrier_complete(bar, b.x, nloc, nx); b.st[0] = nloc; b.st[1] = nx; }
        const unsigned old = xb_add(&bar[XB_XSUB(b.x)], 1u);
        const unsigned gen = old / nloc;
        if (old + 1u == (gen + 1u) * nloc) {
            __builtin_amdgcn_fence(__ATOMIC_RELEASE, "agent");
            asm volatile("s_waitcnt vmcnt(0)" ::: "memory");
            const unsigned og = xb_add(&bar[XB_TOP], 1u);
            const unsigned tg = og / nx;
            if (og + 1u == (tg + 1u) * nx) xb_add(&bar[XB_TOPGEN], 1u);
            else XB_SPIN(xb_ld(&bar[XB_TOPGEN]) == tg, bar);
            __builtin_amdgcn_fence(__ATOMIC_ACQUIRE, "agent");
            xb_add(&bar[XB_XGEN(b.x)], 1u);
            asm volatile("s_waitcnt vmcnt(0)" ::: "memory");
        } else {
            XB_SPIN(xb_ld(&bar[XB_XGEN(b.x)]) == gen, bar);
            __builtin_amdgcn_fence(__ATOMIC_ACQUIRE, "agent");
            asm volatile("s_waitcnt vmcnt(0)" ::: "memory");
        }
    }
    __syncthreads();
}

namespace pg8 {
#define PG8_LAS __attribute__((address_space(3)))
typedef unsigned short bf16_t;
typedef short bf16x8 __attribute__((ext_vector_type(8)));
typedef float f32x4 __attribute__((ext_vector_type(4)));
typedef unsigned u32x4 __attribute__((ext_vector_type(4)));
constexpr int BM = 256, BK = 64, HALF = 128, HTB = HALF * BK * 2  , STAGE_BYTES = 8 * HTB, NXCD = 8, WGM = 8;

__host__ __device__ __forceinline__ int lds_byte(int r, int c) { const int st = (r >> 4) * 2 + (c >> 5), rr = r & 15, cc = c & 31, ob = rr * 64 + cc * 2; return st * 1024 + (ob ^ (((ob >> 9) & 1) << 5)); }
__host__ __device__ __forceinline__ void stage_rc(int b, int& R, int& C) { const int st = b / 1024, sb = b % 1024, swz = sb ^ (((sb >> 9) & 1) << 5); R = (st >> 1) * 16 + swz / 64; C = (st & 1) * 32 + (swz % 64) / 2; }
__host__ __device__ __forceinline__ int perm32(int rho) { const int n = rho >> 4, i = rho & 15; return 8 * (i >> 2) + 4 * n + (i & 3); }

struct Unit { int pm, pn, z; };
struct Gemm { const bf16_t* A; int lda; const bf16_t* Bt; int K; };

struct StaticOrder {
    int nM, nN, nwg, G, c;
    __host__ __device__ void init(int M, int N, int G_, int c_) { nM = M / BM; nN = N / BM; nwg = nM * nN; G = G_; c = c_; }
    __host__ __device__ bool next(int i, Unit& u) const {
        const long L = (long)i * G + c; if (L >= nwg) return false;
        int wgid = (int)L; { const int q = nwg / NXCD, r = nwg % NXCD, xcd = wgid % NXCD, off = wgid / NXCD; wgid = (xcd < r ? xcd * (q + 1) : r * (q + 1) + (xcd - r) * q) + off; }
        const int nig = WGM * nN, gid = wgid / nig, fm = gid * WGM, gsz = (nM - fm) < WGM ? (nM - fm) : WGM;
        u.pm = fm + ((wgid % nig) % gsz); u.pn = (wgid % nig) / gsz; u.z = 0; return true;
    }
    __device__ __forceinline__ size_t a_off(const Unit&) const { return 0; }
    __device__ __forceinline__ size_t b_off(const Unit&) const { return 0; }
    __device__ __forceinline__ void a_ready(const Unit&) const {}
    __device__ __forceinline__ void done(const Unit&) const {}
};

__device__ __forceinline__ unsigned cvt_pk_bf16(float lo, float hi) { unsigned r; asm volatile("v_cvt_pk_bf16_f32 %0, %1, %2" : "=v"(r) : "v"(lo), "v"(hi)); return r; }
typedef float f32x2 __attribute__((ext_vector_type(2)));
__device__ __forceinline__ f32x2 gelu_pk(f32x2 v) {
    const f32x2 av = __builtin_elementwise_abs(v), d = av * 0.2316418882f + 1.0f;
    f32x2 t; t.x = __builtin_amdgcn_rcpf(d.x); t.y = __builtin_amdgcn_rcpf(d.y);
    f32x2 q = t * 0.5307027145f + (-0.7265760135f); q = q * t + 0.7107068705f; q = q * t + (-0.142248368f); q = q * t + 0.127414796f; q = q * t;
    const f32x2 s = (v * v) * (-0.72134752044f);
    f32x2 e; e.x = __builtin_amdgcn_exp2f(s.x); e.y = __builtin_amdgcn_exp2f(s.y);
    const f32x2 m = v * (q * e), r = v - m;
    f32x2 o; o.x = v.x < 0.f ? m.x : r.x; o.y = v.y < 0.f ? m.y : r.y; return o;
}

template <class Epi, class Sched, bool ALIGN_EPI = false, bool SP2 = false>
__device__ __forceinline__ void gemm_phase(PG8_LAS unsigned char* lds, const Gemm g, const Sched& S, const Epi& E) {
    int zv_ = 0; asm volatile("" : "+v"(zv_));
    const int tid = (int)threadIdx.x + zv_, wid = __builtin_amdgcn_readfirstlane(tid >> 6), lane = tid & 63, wr = wid >> 2, wc = wid & 3, fr = lane & 15, fq = lane >> 4;
    const int K = g.K, nt = K / BK;
    unsigned voffA[2], voffB[2];
#pragma unroll
    for (int i = 0; i < 2; ++i) { int R, C; stage_rc(tid * 16 + i * 8192, R, C); const int Rb = Epi::PERM ? ((R & ~31) + perm32(R & 31)) : R;
        voffA[i] = (unsigned)(R * g.lda + C) * 2u; voffB[i] = (unsigned)(Rb * K + C) * 2u; }
    const size_t kstep = (size_t)(BK * 2);
    const size_t hstepA = (size_t)HALF * g.lda * 2, hstepB = (size_t)HALF * K * 2;
    const size_t tstepA = 2 * hstepA, tstepB = 2 * hstepB;
    const unsigned ldsw = (unsigned)wid * 1024u;
    const int aoff = lds_byte(wr * 64 + fr, fq * 8), boff = lds_byte(wc * 32 + fr, fq * 8);
#define PG8_SA(b, h) (((b) * 2 + (h)) * HTB)
#define PG8_SB(b, h) ((4 + (b) * 2 + (h)) * HTB)
#define PG8_STAGE(bufoff, gbase, voff) do { _Pragma("unroll") for (int _i = 0; _i < 2; ++_i) \
        __builtin_amdgcn_global_load_lds((const unsigned*)((const char*)(gbase) + (voff)[_i]), (PG8_LAS unsigned*)(lds + (bufoff) + ldsw + _i * 8192), 16, 0, 0); } while (0)
#define PG8_LDA(dst, b, h) do { _Pragma("unroll") for (int m = 0; m < 4; ++m) _Pragma("unroll") for (int k = 0; k < 2; ++k) dst[m][k] = *(const PG8_LAS bf16x8*)(lds + PG8_SA(b, h) + aoff + m * 2048 + k * 1024); } while (0)
#define PG8_LDB(dst, b, h) do { _Pragma("unroll") for (int n = 0; n < 2; ++n) _Pragma("unroll") for (int k = 0; k < 2; ++k) dst[n][k] = *(const PG8_LAS bf16x8*)(lds + PG8_SB(b, h) + boff + n * 2048 + k * 1024); } while (0)
#define PG8_MMA(ai, bj, At, Bt) do { __builtin_amdgcn_s_setprio(1); _Pragma("unroll") for (int m = 0; m < 4; ++m) _Pragma("unroll") for (int n = 0; n < 2; ++n) _Pragma("unroll") for (int k = 0; k < 2; ++k) \
        acc[ai][bj][m][n] = __builtin_amdgcn_mfma_f32_16x16x32_bf16(Bt[n][k], At[m][k], acc[ai][bj][m][n], 0, 0, 0); __builtin_amdgcn_s_setprio(0); } while (0)
#define PG8_WAIT_V(n) asm volatile("s_waitcnt vmcnt(" #n ")" ::: "memory")
#define PG8_WAIT_L(n) asm volatile("s_waitcnt lgkmcnt(" #n ")" ::: "memory")
#define PG8_BAR __builtin_amdgcn_s_barrier()
#define PG8_SCHED __builtin_amdgcn_sched_barrier(0)
    Unit cur, nxt; int ui = 0;
    if (!S.next(0, cur)) return;
    f32x4 acc[2][2][4][2];
#pragma unroll
    for (int a = 0; a < 2; ++a)
#pragma unroll
        for (int b = 0; b < 2; ++b)
#pragma unroll
            for (int m = 0; m < 4; ++m)
#pragma unroll
                for (int n = 0; n < 2; ++n) acc[a][b][m][n] = (f32x4){0.f, 0.f, 0.f, 0.f};
    bf16x8 At[4][2], B0[2][2], B1[2][2];
    const char* cA = (const char*)g.A + (size_t)cur.pm * tstepA + S.a_off(cur); const char* cB = (const char*)g.Bt + (size_t)cur.pn * tstepB + S.b_off(cur);
    S.a_ready(cur);
    if constexpr (SP2) {
        PG8_STAGE(PG8_SB(0, 0), cB, voffB); PG8_STAGE(PG8_SB(0, 1), cB + hstepB, voffB); PG8_STAGE(PG8_SA(0, 0), cA, voffA); PG8_STAGE(PG8_SA(0, 1), cA + hstepA, voffA);
        if (wr == 1) PG8_BAR;
        PG8_WAIT_V(2); PG8_BAR;
        PG8_STAGE(PG8_SB(1, 0), cB + kstep, voffB); PG8_STAGE(PG8_SA(1, 0), cA + kstep, voffA); PG8_STAGE(PG8_SB(1, 1), cB + hstepB + kstep, voffB);
        PG8_WAIT_V(6); PG8_BAR;
    } else {
        PG8_STAGE(PG8_SB(0, 0), cB, voffB); PG8_STAGE(PG8_SA(0, 0), cA, voffA); PG8_STAGE(PG8_SB(0, 1), cB + hstepB, voffB); PG8_STAGE(PG8_SA(0, 1), cA + hstepA, voffA);
        if (wr == 1) PG8_BAR;
        PG8_WAIT_V(4); PG8_BAR;
        PG8_STAGE(PG8_SB(1, 0), cB + kstep, voffB); PG8_STAGE(PG8_SA(1, 0), cA + kstep, voffA); PG8_STAGE(PG8_SB(1, 1), cB + hstepB + kstep, voffB);
        PG8_WAIT_V(6); PG8_BAR;
    }
    for (;;) {
        const bool has_next = S.next(ui + 1, nxt);
        const char* nA = has_next ? (const char*)g.A + (size_t)nxt.pm * tstepA + S.a_off(nxt) : cA; const char* nB = has_next ? (const char*)g.Bt + (size_t)nxt.pn * tstepB + S.b_off(nxt) : cB;
        for (int t = 0; t < nt; t += 2) {
            const bool last = (t == nt - 2);
            const char* a1 = cA + (size_t)(t + 1) * kstep;
            const char* a2 = last ? nA : cA + (size_t)(t + 2) * kstep; const char* b2 = last ? nB : cB + (size_t)(t + 2) * kstep;
            const char* a3 = a2 + kstep; const char* b3 = b2 + kstep;
            if (last && has_next) S.a_ready(nxt);
            if constexpr (SP2) {
            PG8_LDB(B0, 0, 0); PG8_LDB(B1, 0, 1); PG8_SCHED; PG8_LDA(At, 0, 0); PG8_STAGE(PG8_SA(1, 1), a1 + hstepA, voffA);
            PG8_WAIT_V(8); PG8_WAIT_L(0); PG8_BAR; PG8_MMA(0, 0, At, B0); PG8_MMA(0, 1, At, B1); PG8_BAR; PG8_SCHED;
            PG8_LDA(At, 0, 1); PG8_STAGE(PG8_SB(0, 0), b2, voffB); PG8_STAGE(PG8_SB(0, 1), b2 + hstepB, voffB); PG8_STAGE(PG8_SA(0, 0), a2, voffA);
            PG8_WAIT_V(8); PG8_WAIT_L(0); PG8_BAR; PG8_MMA(1, 0, At, B0); PG8_MMA(1, 1, At, B1); PG8_BAR; PG8_SCHED;
            PG8_LDB(B0, 1, 0); PG8_LDB(B1, 1, 1); PG8_SCHED; PG8_LDA(At, 1, 0); PG8_STAGE(PG8_SA(0, 1), a2 + hstepA, voffA);
            PG8_WAIT_V(8); PG8_WAIT_L(0); PG8_BAR; PG8_MMA(0, 0, At, B0); PG8_MMA(0, 1, At, B1); PG8_BAR; PG8_SCHED;
            PG8_LDA(At, 1, 1); PG8_STAGE(PG8_SB(1, 0), b3, voffB); PG8_STAGE(PG8_SB(1, 1), b3 + hstepB, voffB); PG8_STAGE(PG8_SA(1, 0), a3, voffA);
            PG8_WAIT_V(8); PG8_WAIT_L(0); PG8_BAR; PG8_MMA(1, 0, At, B0); PG8_MMA(1, 1, At, B1); PG8_BAR; PG8_SCHED;
            } else {
            PG8_LDB(B0, 0, 0); PG8_SCHED; PG8_LDA(At, 0, 0); PG8_STAGE(PG8_SA(1, 1), a1 + hstepA, voffA);
            PG8_WAIT_L(8); PG8_BAR; PG8_WAIT_L(0); PG8_MMA(0, 0, At, B0); PG8_BAR; PG8_SCHED;
            PG8_LDB(B1, 0, 1); PG8_STAGE(PG8_SB(0, 0), b2, voffB);
            PG8_BAR; PG8_WAIT_L(0); PG8_MMA(0, 1, At, B1); PG8_BAR;
            PG8_LDA(At, 0, 1); PG8_STAGE(PG8_SA(0, 0), a2, voffA);
            PG8_BAR; PG8_WAIT_L(0); PG8_MMA(1, 0, At, B0); PG8_BAR; PG8_SCHED;
            PG8_STAGE(PG8_SB(0, 1), b2 + hstepB, voffB);
            PG8_WAIT_V(6); PG8_BAR; PG8_MMA(1, 1, At, B1); PG8_BAR;
            PG8_LDB(B0, 1, 0); PG8_SCHED; PG8_LDA(At, 1, 0); PG8_STAGE(PG8_SA(0, 1), a2 + hstepA, voffA);
            PG8_WAIT_L(8); PG8_BAR; PG8_WAIT_L(0); PG8_MMA(0, 0, At, B0); PG8_BAR; PG8_SCHED;
            PG8_LDB(B1, 1, 1); PG8_STAGE(PG8_SB(1, 0), b3, voffB);
            PG8_BAR; PG8_WAIT_L(0); PG8_MMA(0, 1, At, B1); PG8_BAR;
            PG8_LDA(At, 1, 1); PG8_STAGE(PG8_SA(1, 0), a3, voffA);
            PG8_BAR; PG8_WAIT_L(0); PG8_MMA(1, 0, At, B0); PG8_BAR; PG8_SCHED;
            PG8_STAGE(PG8_SB(1, 1), b3 + hstepB, voffB);
            PG8_WAIT_V(6); PG8_BAR; PG8_MMA(1, 1, At, B1); PG8_BAR;
            }
        }
        if constexpr (ALIGN_EPI) { if (wr == 0) PG8_BAR; }
        if constexpr (!Epi::AFTER_DRAIN) { E(acc, cur, wr, wc, fr, fq); S.done(cur); }
        if (!has_next) break;
#pragma unroll
        for (int a = 0; a < 2; ++a)
#pragma unroll
            for (int b = 0; b < 2; ++b)
#pragma unroll
                for (int m = 0; m < 4; ++m)
#pragma unroll
                    for (int n = 0; n < 2; ++n) acc[a][b][m][n] = (f32x4){0.f, 0.f, 0.f, 0.f};
        cur = nxt; cA = nA; cB = nB; ++ui;
        if constexpr (ALIGN_EPI) { if (wr == 1) PG8_BAR; }
    }
    PG8_WAIT_V(0);
    if constexpr (!ALIGN_EPI) { if (wr == 0) PG8_BAR; }
    PG8_BAR;
    if constexpr (Epi::AFTER_DRAIN) { E.fused(acc, cur, wr, wc, fr, fq, lds, wid, lane); S.done(cur); }
#undef PG8_SA
#undef PG8_SB
#undef PG8_STAGE
#undef PG8_LDA
#undef PG8_LDB
#undef PG8_MMA
#undef PG8_WAIT_V
#undef PG8_WAIT_L
#undef PG8_BAR
#undef PG8_SCHED
}
}

namespace pg8 {
typedef unsigned u32x2 __attribute__((ext_vector_type(2)));
__device__ __forceinline__ float bflo(unsigned w) { return __uint_as_float(w << 16); }
__device__ __forceinline__ float bfhi(unsigned w) { return __uint_as_float(w & 0xffff0000u); }
__device__ __forceinline__ float sigm(float x) { return __builtin_amdgcn_rcpf(1.0f + __expf(-x)); }
struct EpiProjB {
    static constexpr bool PERM = true, AFTER_DRAIN = false;
    bf16_t* O; int ldc;
    __device__ __forceinline__ void operator()(const f32x4 (&acc)[2][2][4][2], const Unit& u, int wr, int wc, int fr, int fq) const {
        const int row0 = u.pm * BM + wr * 64 + fr, col0 = u.pn * BM + wc * 32 + 8 * fq;
#pragma unroll
        for (int ai = 0; ai < 2; ++ai)
#pragma unroll
            for (int m = 0; m < 4; ++m) { bf16_t* rowp = O + (size_t)(row0 + ai * HALF + m * 16) * ldc + col0;
#pragma unroll
                for (int bj = 0; bj < 2; ++bj) { const f32x4 v0 = acc[ai][bj][m][0], v1 = acc[ai][bj][m][1];
                    u32x4 w; w.x = cvt_pk_bf16(v0[0], v0[1]); w.y = cvt_pk_bf16(v0[2], v0[3]); w.z = cvt_pk_bf16(v1[0], v1[1]); w.w = cvt_pk_bf16(v1[2], v1[3]);
                    *(u32x4*)(rowp + bj * HALF) = w; } }
    }
};
struct EpiGluB {
    static constexpr bool PERM = true, AFTER_DRAIN = false;
    bf16_t* PROJ;
    __device__ __forceinline__ void operator()(const f32x4 (&acc)[2][2][4][2], const Unit& u, int wr, int wc, int fr, int fq) const {
        const int row0 = u.pm * BM + wr * 64 + fr, col0 = u.pn * BM + wc * 32 + 8 * fq;
#pragma unroll
        for (int ai = 0; ai < 2; ++ai)
#pragma unroll
            for (int m = 0; m < 4; ++m) { bf16_t* rowp = PROJ + (size_t)(row0 + ai * HALF + m * 16) * IN_COLS + col0;
#pragma unroll
                for (int bj = 0; bj < 2; ++bj) {
                    const u32x4 zz = *(const u32x4*)(rowp + C_UB + bj * HALF), gg = *(const u32x4*)(rowp + C_GB + bj * HALF);
                    const f32x4 v0 = acc[ai][bj][m][0], v1 = acc[ai][bj][m][1];
                    float o[8];
#pragma unroll
                    for (int e = 0; e < 4; ++e) {
                        const float va = e < 2 ? v0[2 * e] : v1[2 * (e - 2)], vb = e < 2 ? v0[2 * e + 1] : v1[2 * (e - 2) + 1];
                        const float za = bflo(zz[e]), zb = bfhi(zz[e]), ga = bflo(gg[e]), gb = bfhi(gg[e]);
                        o[2 * e] = za * sigm(va) * ga * sigm(ga); o[2 * e + 1] = zb * sigm(vb) * gb * sigm(gb);
                    }
                    u32x4 w; w.x = cvt_pk_bf16(o[0], o[1]); w.y = cvt_pk_bf16(o[2], o[3]); w.z = cvt_pk_bf16(o[4], o[5]); w.w = cvt_pk_bf16(o[6], o[7]);
                    *(u32x4*)(rowp + C_GB + bj * HALF) = w; } }
    }
};
struct EpiBranchB {
    static constexpr bool PERM = true, AFTER_DRAIN = false;
    bf16_t* PROJ;
    __device__ __forceinline__ void operator()(const f32x4 (&acc)[2][2][4][2], const Unit& u, int wr, int wc, int fr, int fq) const {
        const int row0 = u.pm * BM + wr * 64 + fr, col0 = u.pn * BM + wc * 32 + 8 * fq;
        const int z = u.z;
#pragma unroll
        for (int ai = 0; ai < 2; ++ai)
#pragma unroll
            for (int m = 0; m < 4; ++m) { bf16_t* rowp = PROJ + (size_t)(row0 + ai * HALF + m * 16) * IN_COLS + C_GM + col0;
#pragma unroll
                for (int bj = 0; bj < 2; ++bj) {
                    const u32x4 gg = *(const u32x4*)(rowp + z * 1024 + bj * HALF);
                    u32x4 pp = (u32x4){0u, 0u, 0u, 0u};
                    if (z > 0) pp = *(const u32x4*)(rowp + bj * HALF);
                    const f32x4 v0 = acc[ai][bj][m][0], v1 = acc[ai][bj][m][1];
                    float o[8];
#pragma unroll
                    for (int e = 0; e < 4; ++e) {
                        const float va = e < 2 ? v0[2 * e] : v1[2 * (e - 2)], vb = e < 2 ? v0[2 * e + 1] : v1[2 * (e - 2) + 1];
                        o[2 * e] = bflo(pp[e]) + sigm(bflo(gg[e])) * va; o[2 * e + 1] = bfhi(pp[e]) + sigm(bfhi(gg[e])) * vb;
                    }
                    u32x4 w; w.x = cvt_pk_bf16(o[0], o[1]); w.y = cvt_pk_bf16(o[2], o[3]); w.z = cvt_pk_bf16(o[4], o[5]); w.w = cvt_pk_bf16(o[6], o[7]);
                    *(u32x4*)(rowp + bj * HALF) = w; } }
    }
};
struct BranchOrder : StaticOrder {
    __device__ bool next(int i, Unit& u) const { if (!StaticOrder::next(i / 3, u)) return false; u.z = i % 3; return true; }
    __device__ __forceinline__ size_t a_off(const Unit& u) const { return (size_t)(u.z == 0 ? C_Q : (u.z == 1 ? C_GB : C_XC)) * 2; }
    __device__ __forceinline__ size_t b_off(const Unit& u) const { return (size_t)u.z * 1024 * 512 * 2; }
};
struct EpiOutB {
    static constexpr bool PERM = false, AFTER_DRAIN = false;
    const float* xp; const float* xs; const bf16_t* XB; unsigned char* ws; int l;
    __device__ __forceinline__ void operator()(const f32x4 (&acc)[2][2][4][2], const Unit& u, int wr, int wc, int fr, int fq) const {
        const int row0 = u.pm * BM + wr * 64 + fr, col0 = u.pn * BM + wc * 32 + 4 * fq;
#pragma unroll
        for (int ai = 0; ai < 2; ++ai)
#pragma unroll
            for (int m = 0; m < 4; ++m) { const int r = row0 + ai * HALF + m * 16;
                float* prow = (float*)(ws + WS_PROJ + (size_t)r * IN_COLS * 2 + (size_t)(C_GM + 1024) * 2) + col0;
#pragma unroll
                for (int bj = 0; bj < 2; ++bj)
#pragma unroll
                    for (int n = 0; n < 2; ++n) {
                        const int co = bj * HALF + n * 16;
                        f32x4 x;
                        if (l == 0) x = r < M_P ? *(const f32x4*)(xp + (size_t)r * D_MODEL + col0 + co) : *(const f32x4*)(xs + (size_t)(r - M_P) * D_MODEL + col0 + co);
                        else { const u32x2 xx = *(const u32x2*)(XB + (size_t)r * D_MODEL + col0 + co); x = (f32x4){bflo(xx.x), bfhi(xx.x), bflo(xx.y), bfhi(xx.y)}; }
                        *(f32x4*)(prow + co) = x * DN_ALPHA + acc[ai][bj][m][n];
                    } }
    }
};
}

struct Ctx { int tid, lane, wave, gw, ngw; size_t gt, ngt; };
__device__ __forceinline__ Ctx make_ctx() {
    int zv = 0; asm volatile("" : "+v"(zv)); int zs = 0; asm volatile("" : "+s"(zs));
    Ctx c; c.tid = (int)threadIdx.x + zv; c.lane = c.tid & 63; c.wave = __builtin_amdgcn_readfirstlane(c.tid >> 6);
    const int bid = (int)blockIdx.x + zs, nb = (int)gridDim.x + zs;
    c.gw = c.wave * nb + bid; c.ngw = nb * NWAVES; c.gt = (size_t)bid * NTHREADS + c.tid; c.ngt = (size_t)nb * NTHREADS; return c;
}
#define WAVE_LDS_SYNC() do { asm volatile("s_waitcnt lgkmcnt(0)" ::: "memory"); __builtin_amdgcn_wave_barrier(); } while (0)

__device__ __forceinline__ void st_convert_x(KP p, const Ctx& c) {
    bf16_t* XB = (bf16_t*)(p->ws + WS_XB);
    const size_t n = (size_t)M_TOT * D_MODEL;
    for (size_t i = c.gt; i < n; i += c.ngt) {
        const float v = i < (size_t)M_P * D_MODEL ? p->in[0][i] : p->in[1][i - (size_t)M_P * D_MODEL];
        XB[i] = f2bf(v);
    }
}
__device__ __forceinline__ void st_transpose_w(const float* W, bf16_t* WT, int K, int N, const Ctx& c) {
    const size_t n = (size_t)K * N;
    for (size_t i = c.gt; i < n; i += c.ngt) { const int nn = (int)(i / K), kk = (int)(i % K); WT[i] = f2bf(W[(size_t)kk * N + nn]); }
}
__device__ __forceinline__ void st_s5_tables(KP p, const Ctx& c) {
    float* AB = (float*)(p->ws + WS_TAB + TAB_AB);
    float* BB = (float*)(p->ws + WS_TAB + TAB_BB);
    for (size_t ii = c.gt; ii < (size_t)DEPTH * NG * NP; ii += c.ngt) {
        const int i = (int)ii, l = i / (NG * NP), g = (i / NP) % NG;
        const float lr = fminf(p->in[12][i], -1e-4f), li = p->in[13][i];
        const float step = expf(p->in[14][l * NG + g]);
        const float mag = expf(lr * step);
        float sn, cs; sincosf(li * step, &sn, &cs);
        const float ab_re = mag * cs, ab_im = mag * sn;
        const float den = lr * lr + li * li;
        const float f_re = ((ab_re - 1.0f) * lr + ab_im * li) / den;
        const float f_im = (ab_im * lr - (ab_re - 1.0f) * li) / den;
        AB[2 * i] = ab_re; AB[2 * i + 1] = ab_im;
        for (int cc = 0; cc < NC; ++cc) {
            const float bre = p->in[15][(size_t)i * NC + cc], bim = p->in[16][(size_t)i * NC + cc];
            BB[((size_t)i * NC + cc) * 2] = f_re * bre - f_im * bim;
            BB[((size_t)i * NC + cc) * 2 + 1] = f_re * bim + f_im * bre;
        }
    }
}

template <class Epi>
__device__ __forceinline__ void gemm_simple(const bf16_t* A, int lda, const bf16_t* Bt, int ldb, int M, int N, int K, Epi epi, const Ctx& c) {
    const int lane = c.lane;
    const int ntn = N / 32, ntiles = (M / 32) * ntn;
    for (int tile = c.gw; tile < ntiles; tile += c.ngw) {
        const int tm = tile / ntn, tn = tile % ntn;
        f32x16 acc = {};
        const bf16_t* ar = A + (size_t)(tm * 32 + (lane & 31)) * lda + 8 * (lane >> 5);
        const bf16_t* br = Bt + (size_t)(tn * 32 + (lane & 31)) * ldb + 8 * (lane >> 5);
        for (int k0 = 0; k0 < K; k0 += 16) {
            const bf16x8 a = *(const bf16x8*)(ar + k0);
            const bf16x8 b = *(const bf16x8*)(br + k0);
            acc = __builtin_amdgcn_mfma_f32_32x32x16_bf16(a, b, acc, 0, 0, 0);
        }
#pragma unroll
        for (int r = 0; r < 16; ++r) {
            const int row = tm * 32 + (r & 3) + 8 * (r >> 2) + 4 * (lane >> 5), col = tn * 32 + (lane & 31);
            epi(row, col, acc[r]);
        }
    }
}
struct EpiProj { bf16_t* PROJ; __device__ void operator()(int r, int c, float v) const { PROJ[(size_t)r * IN_COLS + c] = f2bf(v); } };

__device__ __forceinline__ void st_kv_out(KP p, int l, const Ctx& c) {
    const bf16_t* PROJ = (const bf16_t*)(p->ws + WS_PROJ);
    for (size_t ii = c.gt; ii < (size_t)DEC_BATCH * WINDOW * 128; ii += c.ngt) {
        const int i = (int)ii;
        if (i < BATCH * WINDOW * 128) {
            const int b = i / (WINDOW * 128), w = (i / 128) % WINDOW, cc = i % 128;
            const size_t row = (size_t)b * SEQ + (SEQ - WINDOW) + w;
            p->out[O_KP + (size_t)l * BATCH * WINDOW * 128 + i] = bf2f(PROJ[row * IN_COLS + C_K + cc]);
            p->out[O_VP + (size_t)l * BATCH * WINDOW * 128 + i] = bf2f(PROJ[row * IN_COLS + C_V + cc]);
        }
        {
            const int b = i / (WINDOW * 128), w = (i / 128) % WINDOW, cc = i % 128;
            float kv, vv;
            if (w < WINDOW - DEC_SEQ) {
                const size_t ci = (((size_t)l * DEC_BATCH + b) * WINDOW + (w + DEC_SEQ)) * 128 + cc;
                kv = p->in[2][ci]; vv = p->in[3][ci];
            } else {
                const size_t row = (size_t)M_P + b * DEC_SEQ + (w - (WINDOW - DEC_SEQ));
                kv = bf2f(PROJ[row * IN_COLS + C_K + cc]); vv = bf2f(PROJ[row * IN_COLS + C_V + cc]);
            }
            p->out[O_KS + (size_t)l * DEC_BATCH * WINDOW * 128 + i] = kv;
            p->out[O_VS + (size_t)l * DEC_BATCH * WINDOW * 128 + i] = vv;
        }
    }
}

__device__ __forceinline__ void st_attn_simple(KP p, int l, const Ctx& c) {
    bf16_t* PROJ = (bf16_t*)(p->ws + WS_PROJ);
    const int lane = c.lane;
    const float* rel_bias = p->in[8];
    for (int item = c.gw; item < M_S * NQH; item += c.ngw) {
        const int m = M_P + item / NQH, h = item % NQH, kvh = h / 4;
        const bool samp = m >= M_P;
        const int b = samp ? (m - M_P) / DEC_SEQ : m / SEQ, t = samp ? (m - M_P) % DEC_SEQ : m % SEQ;
        float q[64];
        {
            const bf16_t* qp = PROJ + (size_t)m * IN_COLS + C_Q + h * 64;
#pragma unroll
            for (int d = 0; d < 64; ++d) q[d] = bf2f(qp[d]);
        }
        const float sink = p->in[10][l * NQH + h];
        float s[2];
#pragma unroll
        for (int j = 0; j < 2; ++j) {
            const int d = lane + 64 * j;
            const int tk = t - d;
            float sc = -1e30f;
            if (!samp) {
                if (tk >= 0) {
                    const bf16_t* kp = PROJ + ((size_t)b * SEQ + tk) * IN_COLS + C_K + kvh * 64;
                    float a = 0.f;
#pragma unroll
                    for (int e = 0; e < 64; ++e) a += q[e] * bf2f(kp[e]);
                    sc = a * 0.125f + rel_bias[T5_BUCKET[d] * NQH + h];
                }
            } else {
                float a = 0.f;
                if (tk >= 0) {
                    const bf16_t* kp = PROJ + ((size_t)M_P + b * DEC_SEQ + tk) * IN_COLS + C_K + kvh * 64;
#pragma unroll
                    for (int e = 0; e < 64; ++e) a += q[e] * bf2f(kp[e]);
                } else {
                    const float* kp = p->in[2] + ((((size_t)l * DEC_BATCH + b) * WINDOW + (WINDOW + tk)) * NKV + kvh) * HD;
#pragma unroll
                    for (int e = 0; e < 64; ++e) a += q[e] * kp[e];
                }
                sc = a * 0.125f + rel_bias[T5_BUCKET[d] * NQH + h];
            }
            s[j] = sc;
        }
        float mx = fmaxf(fmaxf(s[0], s[1]), sink);
        for (int o = 32; o > 0; o >>= 1) mx = fmaxf(mx, __shfl_xor(mx, o));
        const float p0 = s[0] > -1e29f ? __expf(s[0] - mx) : 0.f, p1 = s[1] > -1e29f ? __expf(s[1] - mx) : 0.f;
        float sum = p0 + p1;
        for (int o = 32; o > 0; o >>= 1) sum += __shfl_xor(sum, o);
        const float denom = sum + __expf(sink - mx);
        float o = 0.f;
        for (int d = 0; d < 128; ++d) {
            const float pj = __shfl(d < 64 ? p0 : p1, d & 63);
            const int tk = t - d;
            float vv = 0.f;
            if (!samp) { if (tk >= 0) vv = bf2f(PROJ[((size_t)b * SEQ + tk) * IN_COLS + C_V + kvh * 64 + lane]); }
            else if (tk >= 0) vv = bf2f(PROJ[((size_t)M_P + b * DEC_SEQ + tk) * IN_COLS + C_V + kvh * 64 + lane]);
            else vv = p->in[3][((((size_t)l * DEC_BATCH + b) * WINDOW + (WINDOW + tk)) * NKV + kvh) * HD + lane];
            o += pj * vv;
        }
        o /= denom;
        const float ga = bf2f(PROJ[(size_t)m * IN_COLS + C_GA + h * 64 + lane]);
        PROJ[(size_t)m * IN_COLS + C_Q + h * 64 + lane] = f2bf(o * siluf_(ga));
    }
}

typedef short s16x4 __attribute__((ext_vector_type(4)));
typedef short v4i16_t __attribute__((ext_vector_type(4)));
typedef unsigned u32x4 __attribute__((ext_vector_type(4)));
typedef float f32x2_t __attribute__((ext_vector_type(2)));
typedef __bf16 bf16x2_t __attribute__((ext_vector_type(2)));
__device__ __forceinline__ unsigned cvtpk(float lo, float hi) { f32x2_t v = {lo, hi}; bf16x2_t b = __builtin_convertvector(v, bf16x2_t); return __builtin_bit_cast(unsigned, b); }
__device__ __forceinline__ bf16x8 pack8(float a0, float a1, float a2, float a3, float a4, float a5, float a6, float a7) {
    u32x4 p; p.x = cvtpk(a0, a1); p.y = cvtpk(a2, a3); p.z = cvtpk(a4, a5); p.w = cvtpk(a6, a7); return __builtin_bit_cast(bf16x8, p); }
__device__ __forceinline__ s16x4 tr_read(LAS const unsigned char* p) { return __builtin_bit_cast(s16x4, __builtin_amdgcn_ds_read_tr16_b64_v4i16((LAS v4i16_t*)p)); }
__device__ __forceinline__ bf16x8 cat8(s16x4 lo, s16x4 hi) { return __builtin_shufflevector(lo, hi, 0, 1, 2, 3, 4, 5, 6, 7); }
#define MFMA32(a, b, c) __builtin_amdgcn_mfma_f32_32x32x16_bf16((a), (b), (c), 0, 0, 0)
#define MFMA16(a, b, c) __builtin_amdgcn_mfma_f32_16x16x32_bf16((a), (b), (c), 0, 0, 0)

constexpr int AT_KSTR = 144, AT_VSTR = 192;
constexpr int AT_K = 0, AT_V = AT_K + 256 * AT_KSTR, AT_BIAS = AT_V + 256 * AT_VSTR, AT_WS = AT_BIAS + 4 * 128 * 4, AT_END = AT_WS + 8 * 256;
static_assert(AT_END <= 131072, "attention LDS");

__device__ __forceinline__ void st_attn_prompt(KP p, int l, LAS unsigned char* lds) {
    int zv = 0; asm volatile("" : "+v"(zv));
    const int tid = (int)threadIdx.x + zv, lane = tid & 63, wave = __builtin_amdgcn_readfirstlane(tid >> 6);
    const int c31 = lane & 31, h = lane >> 5;
    bf16_t* PROJ = (bf16_t*)(p->ws + WS_PROJ);
    const float* rel_bias = p->in[8];
    for (int item = blockIdx.x; item < BATCH * 16 * NKV; item += gridDim.x) {
        const int b = item / 32, nb = (item >> 1) & 15, kvh = item & 1;
        const size_t rowq0 = (size_t)b * SEQ + (size_t)nb * 128;
#pragma unroll
        for (int i = 0; i < 4; ++i) {
            const int id = tid + 512 * i, row = id >> 3, pc = id & 7;
            u32x4 kk = (u32x4){0u, 0u, 0u, 0u}, vv = kk;
            if (nb > 0 || row >= 128) {
                const bf16_t* src = PROJ + (rowq0 - 128 + row) * IN_COLS + kvh * 64 + pc * 8;
                kk = *(const u32x4*)(src + C_K); vv = *(const u32x4*)(src + C_V);
            }
            *(LAS u32x4*)(lds + AT_K + row * AT_KSTR + pc * 16) = kk;
            *(LAS u32x4*)(lds + AT_V + row * AT_VSTR + pc * 16) = vv;
        }
        { const int g = tid >> 7, d = tid & 127; ((LAS float*)(lds + AT_BIAS))[tid] = rel_bias[T5_BUCKET[d] * NQH + kvh * 4 + g]; }
        __syncthreads();
        const int g = wave >> 1, hq = kvh * 4 + g;
        const float sink = p->in[10][l * NQH + hq];
        LAS const float* biasd = (LAS const float*)(lds + AT_BIAS) + g * 128;
        LAS float* wsf = (LAS float*)(lds + AT_WS + wave * 256);
#pragma unroll 1
        for (int qi = 0; qi < 2; ++qi) {
            const int qt = 2 * (wave & 1) + qi, q0 = 32 * qt;
            bf16x8 qf[4];
            { const bf16_t* qp = PROJ + (rowq0 + q0 + c31) * IN_COLS + C_Q + hq * 64 + 8 * h;
#pragma unroll
              for (int ks = 0; ks < 4; ++ks) qf[ks] = *(const bf16x8*)(qp + 16 * ks); }
            f32x16 S[5];
#pragma unroll
            for (int j = 0; j < 5; ++j) {
                S[j] = (f32x16){};
                LAS const unsigned char* kp = lds + AT_K + (32 * (qt + j) + c31) * AT_KSTR + 16 * h;
#pragma unroll
                for (int ks = 0; ks < 4; ++ks) S[j] = MFMA32(*(LAS const bf16x8*)(kp + 32 * ks), qf[ks], S[j]);
            }
            const int iq = q0 + c31;
            float mx = sink;
#pragma unroll
            for (int j = 0; j < 5; ++j)
#pragma unroll
                for (int r = 0; r < 16; ++r) {
                    const int kv = 32 * (qt + j) + (r & 3) + 8 * (r >> 2) + 4 * h;
                    const int dist = iq + 128 - kv;
                    const bool ok = (dist >= 0) && (dist < 128) && (nb > 0 || kv >= 128);
                    const float s = ok ? S[j][r] * 0.125f + biasd[dist & 127] : -1e30f;
                    S[j][r] = s; mx = fmaxf(mx, s);
                }
            mx = fmaxf(mx, __shfl_xor(mx, 32));
            float sum = 0.f;
#pragma unroll
            for (int j = 0; j < 5; ++j)
#pragma unroll
                for (int r = 0; r < 16; ++r) { const float e = S[j][r] > -1e29f ? __expf(S[j][r] - mx) : 0.f; S[j][r] = e; sum += e; }
            sum += __shfl_xor(sum, 32);
            const float rden = 1.0f / (sum + __expf(sink - mx));
            if (h == 0) wsf[c31] = rden;
            f32x16 O[2]; O[0] = (f32x16){}; O[1] = (f32x16){};
            const int i16 = lane & 15, qq = i16 >> 2, pp = i16 & 3, blk = (lane >> 4) & 1;
#pragma unroll
            for (int j = 0; j < 5; ++j)
#pragma unroll
                for (int s = 0; s < 2; ++s) {
                    const bf16x8 pf = pack8(S[j][8 * s], S[j][8 * s + 1], S[j][8 * s + 2], S[j][8 * s + 3], S[j][8 * s + 4], S[j][8 * s + 5], S[j][8 * s + 6], S[j][8 * s + 7]);
                    LAS const unsigned char* vp = lds + AT_V + (32 * (qt + j) + 16 * s + 4 * h + qq) * AT_VSTR + (16 * blk + 4 * pp) * 2;
#pragma unroll
                    for (int dt = 0; dt < 2; ++dt) {
                        const bf16x8 vf = cat8(tr_read(vp + dt * 64), tr_read(vp + dt * 64 + 8 * AT_VSTR));
                        O[dt] = MFMA32(pf, vf, O[dt]);
                    }
                }
            WAVE_LDS_SYNC();
#pragma unroll
            for (int r = 0; r < 16; ++r) {
                const int qr = (r & 3) + 8 * (r >> 2) + 4 * h;
                const float rd = wsf[qr];
                bf16_t* rowp = PROJ + (rowq0 + q0 + qr) * IN_COLS + hq * 64 + c31;
#pragma unroll
                for (int dt = 0; dt < 2; ++dt) {
                    const float ga = bf2f(rowp[C_GA + 32 * dt]);
                    rowp[C_Q + 32 * dt] = f2bf(O[dt][r] * rd * siluf_(ga));
                }
            }
            WAVE_LDS_SYNC();
        }
        __syncthreads();
    }
}

constexpr int S5_NPOW = 11, S5_NINV = 9, S5_NSEG = 8, S5_SEGLEN = 256;
__device__ __forceinline__ f32x2_t cmul(f32x2_t a, f32x2_t b) { return (f32x2_t){a.x * b.x - a.y * b.y, a.x * b.y + a.y * b.x}; }

__device__ __forceinline__ void st_s5_tables2(KP p, const Ctx& c) {
    f32x2_t* POW = (f32x2_t*)(p->ws + WS_S5POW); f32x2_t* PINV = (f32x2_t*)(p->ws + WS_S5PINV);
    bf16_t* BCAT = (bf16_t*)(p->ws + WS_S5BCAT); bf16_t* CCAT = (bf16_t*)(p->ws + WS_S5CCAT);
    const float* BB = (const float*)(p->ws + WS_TAB + TAB_BB);
    for (size_t ii = c.gt; ii < (size_t)DEPTH * NG * NP; ii += c.ngt) {
        const int i = (int)ii, lg = i / NP, pp = i % NP;
        const double lr = (double)fminf(p->in[12][i], -1e-4f), li = (double)p->in[13][i];
        const double step = (double)expf(p->in[14][lg]);
        for (int k = 0; k < S5_NPOW + S5_NINV; ++k) {
            const int e = k < 9 ? k : (k == 9 ? 64 : (k == 10 ? 256 : -(k - S5_NPOW)));
            double t = (double)e * li * step * 0.15915494309189535; t -= rint(t);
            float sn, cs; sincosf((float)(t * 6.283185307179586), &sn, &cs);
            const float mag = expf((float)((double)e * lr * step));
            const f32x2_t v = {mag * cs, mag * sn};
            if (k < S5_NPOW) POW[((size_t)lg * S5_NPOW + k) * NP + pp] = v; else PINV[((size_t)lg * S5_NINV + (k - S5_NPOW)) * NP + pp] = v;
        }
    }
    for (size_t ii = c.gt; ii < (size_t)DEPTH * NG * 128 * NC; ii += c.ngt) {
        const int i = (int)ii, lg = i / (128 * NC), n = (i / NC) % 128, cc = i % NC, pp = n & 63;
        const int sidx = lg * NP + pp;
        const float lr = fminf(p->in[12][sidx], -1e-4f), li = p->in[13][sidx];
        const float step = expf(p->in[14][lg]);
        const float mag = expf(lr * step);
        float sn, cs; sincosf(li * step, &sn, &cs);
        const float ab_re = mag * cs, ab_im = mag * sn, den = lr * lr + li * li;
        const float f_re = ((ab_re - 1.0f) * lr + ab_im * li) / den, f_im = (ab_im * lr - (ab_re - 1.0f) * li) / den;
        const float bre = p->in[15][(size_t)sidx * NC + cc], bim = p->in[16][(size_t)sidx * NC + cc];
        BCAT[i] = f2bf(n < 64 ? f_re * bre - f_im * bim : f_re * bim + f_im * bre);
        const int c2 = (i / 128) % NC, n2 = i % 128, p2 = n2 & 63;
        const float cv = n2 < 64 ? p->in[17][((size_t)lg * NC + c2) * NP + p2] : -p->in[18][((size_t)lg * NC + c2) * NP + p2];
        CCAT[i] = f2bf(cv);
    }
}

__device__ __forceinline__ void s5_xtiles(f32x16 (&xr)[2], f32x16 (&xi)[2], const bf16x8 (&uf)[2], bf16x8 bre, bf16x8 bim) {
#pragma unroll
    for (int m = 0; m < 2; ++m) { xr[m] = MFMA32(uf[m], bre, (f32x16){}); xi[m] = MFMA32(uf[m], bim, (f32x16){}); }
}

__device__ __forceinline__ void st_s5_phaseA(KP p, int l, const Ctx& c) {
    const bf16_t* PROJ = (const bf16_t*)(p->ws + WS_PROJ);
    const f32x2_t* POW = (const f32x2_t*)(p->ws + WS_S5POW);
    const bf16_t* BCAT = (const bf16_t*)(p->ws + WS_S5BCAT);
    f32x2_t* SUM = (f32x2_t*)(p->ws + WS_S5SUM);
    const int lane = c.lane, c31 = lane & 31, h = lane >> 5;
    for (int item = c.gw; item < BATCH * S5_NSEG * NG; item += c.ngw) {
        const int g = item % NG, seg = (item / NG) % S5_NSEG, b = item / (NG * S5_NSEG);
        const int lg = l * NG + g;
        const size_t row0 = (size_t)b * SEQ + (size_t)seg * S5_SEGLEN;
#pragma unroll 1
        for (int pt = 0; pt < 2; ++pt) {
            const int pp = 32 * pt + c31;
            const f32x2_t* pw = POW + (size_t)lg * S5_NPOW * NP + pp;
            f32x2_t lo[4];
#pragma unroll
            for (int s = 0; s < 4; ++s) lo[s] = pw[(7 - 4 * h - s) * NP];
            const f32x2_t a8 = pw[8 * NP], a64 = pw[9 * NP];
            const bf16x8 bre = *(const bf16x8*)(BCAT + ((size_t)lg * 128 + pp) * NC + 8 * h);
            const bf16x8 bim = *(const bf16x8*)(BCAT + ((size_t)lg * 128 + 64 + pp) * NC + 8 * h);
            f32x2_t sseg = {0.f, 0.f};
#pragma unroll 1
            for (int ch = 0; ch < 4; ++ch) {
                bf16x8 uf[2];
#pragma unroll
                for (int m = 0; m < 2; ++m) uf[m] = *(const bf16x8*)(PROJ + (row0 + 64 * ch + 32 * m + c31) * IN_COLS + C_UB + 16 * g + 8 * h);
                f32x16 xr[2], xi[2];
                s5_xtiles(xr, xi, uf, bre, bim);
                f32x2_t f = {1.f, 0.f}, acc = {0.f, 0.f};
#pragma unroll
                for (int gi = 7; gi >= 0; --gi) {
                    const int m = gi >> 2, q = gi & 3;
                    f32x2_t t = {0.f, 0.f};
#pragma unroll
                    for (int s = 0; s < 4; ++s) { const f32x2_t x = {xr[m][4 * q + s], xi[m][4 * q + s]}; const f32x2_t w = cmul(lo[s], x); t.x += w.x; t.y += w.y; }
                    const f32x2_t w2 = cmul(f, t); acc.x += w2.x; acc.y += w2.y;
                    f = cmul(f, a8);
                }
                acc.x += __shfl_xor(acc.x, 32); acc.y += __shfl_xor(acc.y, 32);
                const f32x2_t d = cmul(a64, sseg); sseg.x = d.x + acc.x; sseg.y = d.y + acc.y;
            }
            if (h == 0) SUM[(((size_t)b * S5_NSEG + seg) * NG + g) * NP + pp] = sseg;
        }
    }
}

constexpr int S5_HT_STR = 144, S5_HT_BYTES = 64 * S5_HT_STR;
__device__ __forceinline__ void st_s5_phaseB(KP p, int l, const Ctx& c, LAS unsigned char* lds) {
    bf16_t* PROJ = (bf16_t*)(p->ws + WS_PROJ);
    const f32x2_t* POW = (const f32x2_t*)(p->ws + WS_S5POW); const f32x2_t* PINV = (const f32x2_t*)(p->ws + WS_S5PINV);
    const bf16_t* BCAT = (const bf16_t*)(p->ws + WS_S5BCAT); const bf16_t* CCAT = (const bf16_t*)(p->ws + WS_S5CCAT);
    const f32x2_t* SUM = (const f32x2_t*)(p->ws + WS_S5SUM);
    const int lane = c.lane, c31 = lane & 31, h = lane >> 5, i16 = lane & 15, kg = lane >> 4, qq = i16 >> 2, p4 = i16 & 3;
    LAS unsigned char* ht = lds + c.wave * S5_HT_BYTES;
    bf16x8 tdiag[2], tones;
#pragma unroll
    for (int s = 0; s < 2; ++s)
#pragma unroll
        for (int j = 0; j < 8; ++j) tdiag[s][j] = (16 * s + 8 * (j >> 2) + 4 * h + (j & 3) <= c31) ? (short)0x3F80 : (short)0;
#pragma unroll
    for (int j = 0; j < 8; ++j) tones[j] = (short)0x3F80;
    for (int item = c.gw; item < BATCH * S5_NSEG * NG; item += c.ngw) {
        const int g = item % NG, seg = (item / NG) % S5_NSEG, b = item / (NG * S5_NSEG);
        const int lg = l * NG + g;
        const size_t row0 = (size_t)b * SEQ + (size_t)seg * S5_SEGLEN;
        f32x2_t hin[2];
#pragma unroll
        for (int pt = 0; pt < 2; ++pt) {
            const int pp = 32 * pt + c31;
            const f32x2_t a256 = POW[((size_t)lg * S5_NPOW + 10) * NP + pp];
            f32x2_t H = {0.f, 0.f};
#pragma unroll
            for (int k = 0; k < S5_NSEG - 1; ++k) if (k < seg) { const f32x2_t sk = SUM[(((size_t)b * S5_NSEG + k) * NG + g) * NP + pp]; const f32x2_t d = cmul(a256, H); H.x = d.x + sk.x; H.y = d.y + sk.y; }
            hin[pt] = H;
        }
        const float dd = p->in[19][l * 512 + g * 16 + i16];
#pragma unroll 1
        for (int ch = 0; ch < 4; ++ch) {
            const size_t crow0 = row0 + 64 * ch;
            bf16x8 uf[2];
#pragma unroll
            for (int m = 0; m < 2; ++m) uf[m] = *(const bf16x8*)(PROJ + (crow0 + 32 * m + c31) * IN_COLS + C_UB + 16 * g + 8 * h);
            f32x4 Y[4];
#pragma unroll
            for (int it = 0; it < 4; ++it) Y[it] = (f32x4){0.f, 0.f, 0.f, 0.f};
#pragma unroll
            for (int pt = 0; pt < 2; ++pt) {
                const int pp = 32 * pt + c31;
                const bf16x8 bre = *(const bf16x8*)(BCAT + ((size_t)lg * 128 + pp) * NC + 8 * h);
                const bf16x8 bim = *(const bf16x8*)(BCAT + ((size_t)lg * 128 + 64 + pp) * NC + 8 * h);
                const f32x2_t* pw = POW + (size_t)lg * S5_NPOW * NP + pp; const f32x2_t* pi = PINV + (size_t)lg * S5_NINV * NP + pp;
                asm volatile("" : "+v"(pw), "+v"(pi));
                f32x2_t ilo[4], plo[4];
#pragma unroll
                for (int s = 0; s < 4; ++s) { ilo[s] = pi[(4 * h + s) * NP]; plo[s] = pw[(4 * h + s) * NP]; }
                const f32x2_t ia8 = pi[8 * NP], a8 = pw[8 * NP], a1 = pw[1 * NP];
                bf16x8 wfr[2][2], wfi[2][2];
                {
                    f32x2_t f = {1.f, 0.f};
#pragma unroll
                    for (int m = 0; m < 2; ++m) {
                        f32x16 xr = MFMA32(uf[m], bre, (f32x16){}), xi = MFMA32(uf[m], bim, (f32x16){});
#pragma unroll
                        for (int q = 0; q < 4; ++q) {
#pragma unroll
                            for (int s = 0; s < 4; ++s) { const f32x2_t x = {xr[4 * q + s], xi[4 * q + s]}; const f32x2_t w = cmul(f, cmul(ilo[s], x)); xr[4 * q + s] = w.x; xi[4 * q + s] = w.y; }
                            f = cmul(f, ia8);
                        }
#pragma unroll
                        for (int s2 = 0; s2 < 2; ++s2) {
                            wfr[m][s2] = pack8(xr[8 * s2], xr[8 * s2 + 1], xr[8 * s2 + 2], xr[8 * s2 + 3], xr[8 * s2 + 4], xr[8 * s2 + 5], xr[8 * s2 + 6], xr[8 * s2 + 7]);
                            wfi[m][s2] = pack8(xi[8 * s2], xi[8 * s2 + 1], xi[8 * s2 + 2], xi[8 * s2 + 3], xi[8 * s2 + 4], xi[8 * s2 + 5], xi[8 * s2 + 6], xi[8 * s2 + 7]);
                        }
                        __builtin_amdgcn_sched_barrier(0);
                    }
                }
                const f32x2_t G = cmul(a1, hin[pt]);
                f32x2_t hlast = {0.f, 0.f};
                WAVE_LDS_SYNC();
                {
                    f32x2_t f = {1.f, 0.f};
#pragma unroll
                    for (int m = 0; m < 2; ++m) {
                        f32x16 cr, ci;
                        if (m == 0) { cr = MFMA32(tdiag[1], wfr[0][1], MFMA32(tdiag[0], wfr[0][0], (f32x16){})); ci = MFMA32(tdiag[1], wfi[0][1], MFMA32(tdiag[0], wfi[0][0], (f32x16){})); }
                        else { cr = MFMA32(tdiag[1], wfr[1][1], MFMA32(tdiag[0], wfr[1][0], MFMA32(tones, wfr[0][1], MFMA32(tones, wfr[0][0], (f32x16){}))));
                               ci = MFMA32(tdiag[1], wfi[1][1], MFMA32(tdiag[0], wfi[1][0], MFMA32(tones, wfi[0][1], MFMA32(tones, wfi[0][0], (f32x16){})))); }
#pragma unroll
                        for (int q = 0; q < 4; ++q) {
                            float hr[4], hi[4];
#pragma unroll
                            for (int s = 0; s < 4; ++s) { const f32x2_t v = {cr[4 * q + s] + G.x, ci[4 * q + s] + G.y}; const f32x2_t w = cmul(f, cmul(plo[s], v)); hr[s] = w.x; hi[s] = w.y; }
                            if (m == 1 && q == 3) { hlast.x = hr[3]; hlast.y = hi[3]; }
                            typedef unsigned u32x2_t __attribute__((ext_vector_type(2)));
                            u32x2_t wr_; wr_.x = cvtpk(hr[0], hr[1]); wr_.y = cvtpk(hr[2], hr[3]);
                            u32x2_t wi_; wi_.x = cvtpk(hi[0], hi[1]); wi_.y = cvtpk(hi[2], hi[3]);
                            *(LAS u32x2_t*)(ht + c31 * S5_HT_STR + (32 * m + 8 * q + 4 * h) * 2) = wr_;
                            *(LAS u32x2_t*)(ht + (32 + c31) * S5_HT_STR + (32 * m + 8 * q + 4 * h) * 2) = wi_;
                            f = cmul(f, a8);
                        }
                        __builtin_amdgcn_sched_barrier(0);
                    }
                }
                hin[pt].x = __shfl(hlast.x, c31 + 32); hin[pt].y = __shfl(hlast.y, c31 + 32);
                WAVE_LDS_SYNC();
#pragma unroll
                for (int ks = 0; ks < 2; ++ks) {
                    const bf16x8 cf = *(const bf16x8*)(CCAT + ((size_t)lg * NC + i16) * 128 + 64 * ks + 32 * pt + 8 * kg);
#pragma unroll
                    for (int it = 0; it < 4; ++it) {
                        LAS const unsigned char* ap = ht + (32 * ks + 8 * kg + qq) * S5_HT_STR + (16 * it + 4 * p4) * 2;
                        const bf16x8 af = cat8(tr_read(ap), tr_read(ap + 4 * S5_HT_STR));
                        Y[it] = MFMA16(af, cf, Y[it]);
                    }
                }
            }
#pragma unroll
            for (int it = 0; it < 4; ++it)
#pragma unroll
                for (int r = 0; r < 4; ++r) {
                    bf16_t* up = PROJ + (crow0 + 16 * it + 4 * kg + r) * IN_COLS + C_UB + 16 * g + i16;
                    const float y = Y[it][r] + dd * bf2f(*up);
                    *up = f2bf(gelu_tanh(y));
                }
        }
        if (seg == S5_NSEG - 1 && h == 0) {
#pragma unroll
            for (int pt = 0; pt < 2; ++pt) { const size_t oi = (((size_t)l * BATCH + b) * NG + g) * NP + 32 * pt + c31; p->out[O_SRP + oi] = hin[pt].x; p->out[O_SIP + oi] = hin[pt].y; }
        }
    }
}

__device__ __forceinline__ void st_s5_simple(KP p, int l, const Ctx& c, LAS float* wsm) {
    bf16_t* PROJ = (bf16_t*)(p->ws + WS_PROJ);
    const float* AB = (const float*)(p->ws + WS_TAB + TAB_AB);
    const float* BB = (const float*)(p->ws + WS_TAB + TAB_BB);
    const int pp = c.lane;
    for (int item = c.gw; item < DEC_BATCH * NG; item += c.ngw) {
        const int seq = BATCH + item / NG, g = item % NG;
        const bool samp = seq >= BATCH;
        const int b = samp ? seq - BATCH : seq, T = samp ? DEC_SEQ : SEQ;
        const size_t row0 = samp ? (size_t)M_P + b * DEC_SEQ : (size_t)b * SEQ;
        const int sidx = (l * NG + g) * NP + pp;
        const float ab_re = AB[2 * sidx], ab_im = AB[2 * sidx + 1];
        float bbr[16], bbi[16], cr[16], ci[16];
#pragma unroll
        for (int cc = 0; cc < 16; ++cc) {
            bbr[cc] = BB[((size_t)sidx * NC + cc) * 2]; bbi[cc] = BB[((size_t)sidx * NC + cc) * 2 + 1];
            cr[cc] = p->in[17][((size_t)(l * NG + g) * NC + cc) * NP + pp]; ci[cc] = p->in[18][((size_t)(l * NG + g) * NC + cc) * NP + pp];
        }
        const float dd = pp < 16 ? p->in[19][l * 512 + g * 16 + pp] : 0.f;
        float hr = 0.f, hi = 0.f;
        if (samp) { const size_t si = (((size_t)l * DEC_BATCH + b) * NG + g) * NP + pp; hr = p->in[4][si]; hi = p->in[5][si]; }
        for (int t = 0; t < T; ++t) {
            bf16_t* up = PROJ + (row0 + t) * IN_COLS + C_UB + g * 16;
            float u[16];
#pragma unroll
            for (int cc = 0; cc < 16; ++cc) u[cc] = bf2f(up[cc]);
            float xr = 0.f, xi = 0.f;
#pragma unroll
            for (int cc = 0; cc < 16; ++cc) { xr += bbr[cc] * u[cc]; xi += bbi[cc] * u[cc]; }
            const float nr = ab_re * hr - ab_im * hi + xr, ni = ab_re * hi + ab_im * hr + xi;
            hr = nr; hi = ni;
#pragma unroll
            for (int cc = 0; cc < 16; ++cc) wsm[pp * 17 + cc] = cr[cc] * hr - ci[cc] * hi;
            WAVE_LDS_SYNC();
            if (pp < 16) {
                float y = 0.f;
                for (int q = 0; q < 64; ++q) y += wsm[q * 17 + pp];
                y += dd * bf2f(up[pp]);
                up[pp] = f2bf(gelu_tanh(y));
            }
            WAVE_LDS_SYNC();
        }
        if (!samp) { const size_t oi = (((size_t)l * BATCH + b) * NG + g) * NP + pp; p->out[O_SRP + oi] = hr; p->out[O_SIP + oi] = hi; }
        else { const size_t oi = (((size_t)l * DEC_BATCH + b) * NG + g) * NP + pp; p->out[O_SRS + oi] = hr; p->out[O_SIS + oi] = hi; }
    }
}

struct EpiGlu { bf16_t* PROJ; __device__ void operator()(int r, int c, float v) const {
    const float z = bf2f(PROJ[(size_t)r * IN_COLS + C_UB + c]), gb = bf2f(PROJ[(size_t)r * IN_COLS + C_GB + c]);
    PROJ[(size_t)r * IN_COLS + C_GB + c] = f2bf(z * sigmoidf_(v) * siluf_(gb)); } };

__device__ __forceinline__ void st_lru_simple(KP p, int l, const Ctx& c, LAS float* wsm) {
    bf16_t* PROJ = (bf16_t*)(p->ws + WS_PROJ);
    const int e = c.lane;
    for (int item = c.gw; item < (BATCH + DEC_BATCH) * 8; item += c.ngw) {
        const int seq = item / 8, n = item % 8, ch = n * 64 + e;
        const bool samp = seq >= BATCH;
        const int b = samp ? seq - BATCH : seq, T = samp ? DEC_SEQ : SEQ;
        const size_t row0 = samp ? (size_t)M_P + b * DEC_SEQ : (size_t)b * SEQ;
        float wa[64], wx[64];
#pragma unroll
        for (int d = 0; d < 64; ++d) { wa[d] = p->in[24][(((size_t)l * 8 + n) * 64 + d) * 64 + e]; wx[d] = p->in[26][(((size_t)l * 8 + n) * 64 + d) * 64 + e]; }
        const float ba = p->in[25][l * 512 + ch], bx = p->in[27][l * 512 + ch], lam = p->in[28][l * 512 + ch];
        const float lsig = -log1pf(expf(-lam));
        const float cw0 = p->in[22][(l * 4 + 0) * 512 + ch], cw1 = p->in[22][(l * 4 + 1) * 512 + ch], cw2 = p->in[22][(l * 4 + 2) * 512 + ch], cw3 = p->in[22][(l * 4 + 3) * 512 + ch];
        const float cb = p->in[23][l * 512 + ch];
        float xm3 = 0.f, xm2 = 0.f, xm1 = 0.f, h = 0.f;
        if (samp) {
            const size_t ci = (((size_t)l * DEC_BATCH + b) * 3) * 512 + ch;
            xm3 = p->in[7][ci]; xm2 = p->in[7][ci + 512]; xm1 = p->in[7][ci + 1024];
            h = p->in[6][((size_t)l * DEC_BATCH + b) * 512 + ch];
        }
        for (int t = 0; t < T; ++t) {
            bf16_t* rp = PROJ + (row0 + t) * IN_COLS;
            const float xc = bf2f(rp[C_XC + ch]);
            const float xf = cb + cw0 * xm3 + cw1 * xm2 + cw2 * xm1 + cw3 * xc;
            xm3 = xm2; xm2 = xm1; xm1 = xc;
            wsm[e] = xf;
            WAVE_LDS_SYNC();
            float r = ba, i = bx;
#pragma unroll
            for (int d = 0; d < 64; ++d) { const float xv = wsm[d]; r += xv * wa[d]; i += xv * wx[d]; }
            WAVE_LDS_SYNC();
            r = sigmoidf_(r); i = sigmoidf_(i);
            const float log_a = 8.0f * r * lsig;
            const float a = expf(log_a);
            const float bt = xf * i * sqrtf(-expm1f(2.0f * log_a));
            h = a * h + bt;
            const float gc = bf2f(rp[C_GC + ch]);
            rp[C_XC + ch] = f2bf(h * siluf_(gc));
        }
        if (!samp) {
            p->out[O_LP + ((size_t)l * BATCH + b) * 512 + ch] = h;
            const size_t ci = (((size_t)l * BATCH + b) * 3) * 512 + ch;
            p->out[O_CP + ci] = xm3; p->out[O_CP + ci + 512] = xm2; p->out[O_CP + ci + 1024] = xm1;
        } else {
            p->out[O_LS + ((size_t)l * DEC_BATCH + b) * 512 + ch] = h;
            const size_t ci = (((size_t)l * DEC_BATCH + b) * 3) * 512 + ch;
            p->out[O_CS + ci] = xm3; p->out[O_CS + ci + 512] = xm2; p->out[O_CS + ci + 1024] = xm1;
        }
    }
}

__device__ __forceinline__ void st_branch_simple(KP p, int l, const Ctx& c) {
    bf16_t* PROJ = (bf16_t*)(p->ws + WS_PROJ);
    const bf16_t* WB = (const bf16_t*)((unsigned char*)p->out + DO_WBR) + (size_t)l * 3 * 1024 * 512;
    const int lane = c.lane;
    const int ntn = 1024 / 32, ntiles = (M_TOT / 32) * ntn;
    for (int tile = c.gw; tile < ntiles; tile += c.ngw) {
        const int tm = tile / ntn, tn = tile % ntn;
        f32x16 acc[3];
#pragma unroll
        for (int br = 0; br < 3; ++br) {
            const int acol = br == 0 ? C_Q : (br == 1 ? C_GB : C_XC);
            acc[br] = (f32x16){};
            const bf16_t* ar = PROJ + (size_t)(tm * 32 + (lane & 31)) * IN_COLS + acol + 8 * (lane >> 5);
            const bf16_t* bp = WB + (size_t)br * 1024 * 512 + (size_t)(tn * 32 + (lane & 31)) * 512 + 8 * (lane >> 5);
            for (int k0 = 0; k0 < 512; k0 += 16)
                acc[br] = __builtin_amdgcn_mfma_f32_32x32x16_bf16(*(const bf16x8*)(ar + k0), *(const bf16x8*)(bp + k0), acc[br], 0, 0, 0);
        }
#pragma unroll
        for (int r = 0; r < 16; ++r) {
            const int row = tm * 32 + (r & 3) + 8 * (r >> 2) + 4 * (lane >> 5), col = tn * 32 + (lane & 31);
            bf16_t* gp = PROJ + (size_t)row * IN_COLS + C_GM + col;
            const float m = sigmoidf_(bf2f(gp[0])) * acc[0][r] + sigmoidf_(bf2f(gp[1024])) * acc[1][r] + sigmoidf_(bf2f(gp[2048])) * acc[2][r];
            gp[0] = f2bf(m);
        }
    }
}

__device__ __forceinline__ float* pre_row(unsigned char* ws, int r) { return (float*)(ws + WS_PROJ + (size_t)r * IN_COLS * 2 + (size_t)(C_GM + 1024) * 2); }
struct EpiOut { KP p; int l; __device__ void operator()(int r, int c, float v) const {
    float x;
    if (l == 0) x = r < M_P ? p->in[0][(size_t)r * D_MODEL + c] : p->in[1][(size_t)(r - M_P) * D_MODEL + c];
    else x = bf2f(((const bf16_t*)(p->ws + WS_XB))[(size_t)r * D_MODEL + c]);
    pre_row(p->ws, r)[c] = DN_ALPHA * x + v; } };

__device__ __forceinline__ void st_ln(KP p, int l, const Ctx& c) {
    const int lane = c.lane;
    const float* g = p->in[31] + l * 1024; const float* bb = p->in[32] + l * 1024;
    for (int r = c.gw; r < M_TOT; r += c.ngw) {
        const float* pr = pre_row(p->ws, r);
        float v[16]; float s = 0.f;
#pragma unroll
        for (int j = 0; j < 16; ++j) { v[j] = pr[lane + 64 * j]; s += v[j]; }
        for (int o = 32; o > 0; o >>= 1) s += __shfl_xor(s, o);
        const float mu = s * (1.0f / 1024.0f);
        float q = 0.f;
#pragma unroll
        for (int j = 0; j < 16; ++j) { const float d = v[j] - mu; q += d * d; }
        for (int o = 32; o > 0; o >>= 1) q += __shfl_xor(q, o);
        const float rstd = rsqrtf(q * (1.0f / 1024.0f) + LN_EPS);
#pragma unroll
        for (int j = 0; j < 16; ++j) {
            const int cc = lane + 64 * j;
            const float y = (v[j] - mu) * rstd * g[cc] + bb[cc];
            if (l == 0) ((bf16_t*)(p->ws + WS_XB))[(size_t)r * D_MODEL + cc] = f2bf(y);
            else if (r < M_P) p->out[O_YP + (size_t)r * D_MODEL + cc] = y;
            else p->out[O_YS + (size_t)(r - M_P) * D_MODEL + cc] = y;
        }
    }
}

__global__ void __launch_bounds__(NTHREADS, 2) mega_fwd(P p_unused) {
    extern __shared__ __attribute__((aligned(16))) unsigned char lds_raw[];
    LAS unsigned char* lds = (LAS unsigned char*)lds_raw;
    volatile LAS unsigned* misc = (volatile LAS unsigned*)(lds + LDS_MISC);
    if (threadIdx.x < 32) misc[threadIdx.x] = 0u;
    __syncthreads();
    XcdBarrier bar;
    { KP p = get_kp(); bar = xcd_barrier_post((unsigned*)(p->ws + WS_CTL), misc); }

    { KP p = get_kp(); const Ctx c = make_ctx(); unsigned char* dob = (unsigned char*)p->out;
      st_convert_x(p, c);
      for (int l = 0; l < DEPTH; ++l) {
        st_transpose_w(p->in[9] + (size_t)l * 1024 * IN_COLS, (bf16_t*)(dob + DO_WIN) + (size_t)l * IN_COLS * 1024, 1024, IN_COLS, c);
        st_transpose_w(p->in[11] + (size_t)l * 512 * 1024, (bf16_t*)(dob + DO_WBR) + ((size_t)l * 3 + 0) * 1024 * 512, 512, 1024, c);
        st_transpose_w(p->in[21] + (size_t)l * 512 * 1024, (bf16_t*)(dob + DO_WBR) + ((size_t)l * 3 + 1) * 1024 * 512, 512, 1024, c);
        st_transpose_w(p->in[29] + (size_t)l * 512 * 1024, (bf16_t*)(dob + DO_WBR) + ((size_t)l * 3 + 2) * 1024 * 512, 512, 1024, c);
        st_transpose_w(p->in[20] + (size_t)l * 512 * 512, (bf16_t*)(dob + DO_WGLU) + (size_t)l * 512 * 512, 512, 512, c);
        st_transpose_w(p->in[30] + (size_t)l * 1024 * 1024, (bf16_t*)(p->ws + WS_WOUT) + (size_t)l * 1024 * 1024, 1024, 1024, c);
      }
      st_s5_tables(p, c); st_s5_tables2(p, c); }
    xcd_barrier(bar);

    for (int l = 0; l < DEPTH; ++l) {
        { KP p = get_kp(); int zs = 0; asm volatile("" : "+s"(zs));
          pg8::Gemm g{(const bf16_t*)(p->ws + WS_XB), D_MODEL, (const bf16_t*)((unsigned char*)p->out + DO_WIN) + (size_t)l * IN_COLS * 1024, 1024};
          pg8::StaticOrder S; S.init(M_TOT, IN_COLS, (int)gridDim.x + zs, (int)blockIdx.x + zs);
          pg8::gemm_phase<pg8::EpiProjB, pg8::StaticOrder, true, true>(lds, g, S, pg8::EpiProjB{(bf16_t*)(p->ws + WS_PROJ), IN_COLS}); }
        xcd_barrier(bar);
        { KP p = get_kp(); const Ctx c = make_ctx(); LAS float* wsm = (LAS float*)(lds + c.wave * 8192);
          st_kv_out(p, l, c);
          st_s5_simple(p, l, c, wsm);
          st_lru_simple(p, l, c, wsm);
          st_attn_simple(p, l, c);
          st_s5_phaseA(p, l, c); }
        __syncthreads();
        { KP p = get_kp(); st_attn_prompt(p, l, lds); }
        xcd_barrier(bar);
        { KP p = get_kp(); const Ctx c = make_ctx(); st_s5_phaseB(p, l, c, lds); }
        xcd_barrier(bar);
        { KP p = get_kp(); int zs = 0; asm volatile("" : "+s"(zs)); bf16_t* PROJ = (bf16_t*)(p->ws + WS_PROJ);
          pg8::Gemm g{PROJ + C_UB, IN_COLS, (const bf16_t*)((unsigned char*)p->out + DO_WGLU) + (size_t)l * 512 * 512, 512};
          pg8::StaticOrder S; S.init(M_TOT, 512, (int)gridDim.x + zs, (int)blockIdx.x + zs);
          pg8::gemm_phase<pg8::EpiGluB, pg8::StaticOrder, true, true>(lds, g, S, pg8::EpiGluB{PROJ}); }
        xcd_barrier(bar);
        { KP p = get_kp(); int zs = 0; asm volatile("" : "+s"(zs)); bf16_t* PROJ = (bf16_t*)(p->ws + WS_PROJ);
          pg8::Gemm g{PROJ, IN_COLS, (const bf16_t*)((unsigned char*)p->out + DO_WBR) + (size_t)l * 3 * 1024 * 512, 512};
          pg8::BranchOrder S; S.init(M_TOT, 1024, (int)gridDim.x + zs, (int)blockIdx.x + zs);
          pg8::gemm_phase<pg8::EpiBranchB, pg8::BranchOrder, true, true>(lds, g, S, pg8::EpiBranchB{PROJ}); }
        xcd_barrier(bar);
        { KP p = get_kp(); int zs = 0; asm volatile("" : "+s"(zs)); bf16_t* PROJ = (bf16_t*)(p->ws + WS_PROJ);
          pg8::Gemm g{PROJ + C_GM, IN_COLS, (const bf16_t*)(p->ws + WS_WOUT) + (size_t)l * 1024 * 1024, 1024};
          pg8::StaticOrder S; S.init(M_TOT, 1024, (int)gridDim.x + zs, (int)blockIdx.x + zs);
          pg8::gemm_phase<pg8::EpiOutB, pg8::StaticOrder, true, true>(lds, g, S, pg8::EpiOutB{p->in[0], p->in[1], (const bf16_t*)(p->ws + WS_XB), p->ws, l}); }
        xcd_barrier(bar);
        { KP p = get_kp(); const Ctx c = make_ctx(); st_ln(p, l, c); }
        if (l + 1 < DEPTH) xcd_barrier(bar);
    }
}

extern "C" void kernel_launch(void* const* d_in, const int* in_sizes, int n_in, void* d_out, int out_size, void* d_ws, size_t ws_size, hipStream_t stream) {
    static int grid = 0;
    if (grid == 0) {
        if (n_in != 33 || (size_t)out_size != O_END || ws_size < WS_CTL + CTL_BYTES) { fprintf(stderr, "kernel_launch: unexpected sizes n_in %d out %d ws %zu\n", n_in, out_size, ws_size); grid = -1; return; }
        int dev = 0, cus = 0, per_cu = 0;
        if (hipGetDevice(&dev) != hipSuccess || hipDeviceGetAttribute(&cus, hipDeviceAttributeMultiprocessorCount, dev) != hipSuccess) { grid = -1; return; }
        if (hipFuncSetAttribute((const void*)mega_fwd, hipFuncAttributeMaxDynamicSharedMemorySize, LDS_BYTES) != hipSuccess) { fprintf(stderr, "kernel_launch: hipFuncSetAttribute failed\n"); grid = -1; return; }
        if (hipOccupancyMaxActiveBlocksPerMultiprocessor(&per_cu, (const void*)mega_fwd, NTHREADS, LDS_BYTES) != hipSuccess || per_cu < 1) { fprintf(stderr, "kernel_launch: occupancy query says %d blocks/CU\n", per_cu); grid = -1; return; }
        grid = cus;
    }
    if (grid < 0) return;
    (void)hipMemsetAsync((unsigned char*)d_ws + WS_CTL, 0, CTL_BYTES, stream);
    P p{};
    for (int i = 0; i < 33; ++i) p.in[i] = (const float*)d_in[i];
    p.out = (float*)d_out; p.ws = (unsigned char*)d_ws;
    void* args[] = {&p};
    hipError_t e = hipLaunchCooperativeKernel((const void*)mega_fwd, dim3(grid), dim3(NTHREADS), args, LDS_BYTES, stream);
    if (e != hipSuccess) fprintf(stderr, "kernel_launch: cooperative launch failed: %s (grid %d)\n", hipGetErrorString(e), grid);
}
```

```cpp
#include <hip/hip_runtime.h>
#include <cstdint>
#include <cstdio>

typedef unsigned short bf16_t;
typedef short bf16x8 __attribute__((ext_vector_type(8)));
typedef float f32x16 __attribute__((ext_vector_type(16)));
typedef float f32x4 __attribute__((ext_vector_type(4)));

constexpr int D_MODEL = 1024, BATCH = 8, SEQ = 2048, DEPTH = 2, DEC_BATCH = 128, DEC_SEQ = 4;
constexpr int M_P = BATCH * SEQ;
constexpr int M_S = DEC_BATCH * DEC_SEQ;
constexpr int M_TOT = M_P + M_S;
constexpr int IN_COLS = 6400;
constexpr int C_Q = 0, C_K = 512, C_V = 640, C_GA = 768, C_UB = 1280, C_GB = 1792, C_XC = 2304, C_GC = 2816, C_GM = 3328;
constexpr int WINDOW = 128, NKV = 2, HD = 64, NQH = 8;
constexpr int NG = 32, NP = 64, NC = 16;
constexpr float DN_ALPHA = 1.4142135623730951f;
constexpr float LN_EPS = 1e-5f;

constexpr size_t O_YP = 0;
constexpr size_t O_YS = O_YP + (size_t)M_P * D_MODEL;
constexpr size_t O_KP = O_YS + (size_t)M_S * D_MODEL;
constexpr size_t SZ_KP = (size_t)DEPTH * BATCH * WINDOW * NKV * HD;
constexpr size_t O_VP = O_KP + SZ_KP;
constexpr size_t O_SRP = O_VP + SZ_KP;
constexpr size_t SZ_SP = (size_t)DEPTH * BATCH * NG * NP;
constexpr size_t O_SIP = O_SRP + SZ_SP;
constexpr size_t O_LP = O_SIP + SZ_SP;
constexpr size_t SZ_LP = (size_t)DEPTH * BATCH * 512;
constexpr size_t O_CP = O_LP + SZ_LP;
constexpr size_t SZ_CP = (size_t)DEPTH * BATCH * 3 * 512;
constexpr size_t O_KS = O_CP + SZ_CP;
constexpr size_t SZ_KS = (size_t)DEPTH * DEC_BATCH * WINDOW * NKV * HD;
constexpr size_t O_VS = O_KS + SZ_KS;
constexpr size_t O_SRS = O_VS + SZ_KS;
constexpr size_t SZ_SS = (size_t)DEPTH * DEC_BATCH * NG * NP;
constexpr size_t O_SIS = O_SRS + SZ_SS;
constexpr size_t O_LS = O_SIS + SZ_SS;
constexpr size_t SZ_LS = (size_t)DEPTH * DEC_BATCH * 512;
constexpr size_t O_CS = O_LS + SZ_LS;
constexpr size_t SZ_CS = (size_t)DEPTH * DEC_BATCH * 3 * 512;
constexpr size_t O_END = O_CS + SZ_CS;

constexpr size_t WS_PROJ = 0;
constexpr size_t WS_XB = WS_PROJ + (size_t)M_TOT * IN_COLS * 2;
constexpr size_t WS_WOUT = WS_XB + (size_t)M_TOT * D_MODEL * 2;
constexpr size_t WS_TAB = WS_WOUT + (size_t)DEPTH * 1024 * 1024 * 2;
constexpr size_t TAB_AB = 0;
constexpr size_t TAB_BB = TAB_AB + (size_t)DEPTH * NG * NP * 2 * 4;
constexpr size_t TAB_BYTES = TAB_BB + (size_t)DEPTH * NG * NP * NC * 2 * 4;
constexpr size_t WS_S5POW = WS_TAB + TAB_BYTES;
constexpr size_t WS_S5PINV = WS_S5POW + (size_t)DEPTH * NG * 11 * NP * 8;
constexpr size_t WS_S5BCAT = WS_S5PINV + (size_t)DEPTH * NG * 9 * NP * 8;
constexpr size_t WS_S5CCAT = WS_S5BCAT + (size_t)DEPTH * NG * 128 * NC * 2;
constexpr size_t WS_S5SUM = WS_S5CCAT + (size_t)DEPTH * NG * 128 * NC * 2;
constexpr size_t WS_LRUW = WS_S5SUM + (size_t)BATCH * 8 * NG * NP * 8;
constexpr size_t WS_LRSUM = WS_LRUW + (size_t)DEPTH * 8 * 2 * 64 * 64 * 2;
constexpr size_t WS_END = WS_LRSUM + (size_t)BATCH * 32 * 512 * 8;
constexpr size_t DO_WIN = 0;
constexpr size_t DO_WBR = DO_WIN + (size_t)DEPTH * IN_COLS * 1024 * 2;
constexpr size_t DO_WGLU = DO_WBR + (size_t)DEPTH * 3 * 1024 * 512 * 2;
constexpr size_t DO_LRUW = DO_WGLU + (size_t)DEPTH * 512 * 512 * 2;
constexpr size_t DO_END = DO_LRUW;
static_assert(DO_END <= (size_t)M_P * D_MODEL * 4, "weights fit in y_prompt region");
static_assert(WS_END <= 268435456ull, "workspace fits 256 MiB");

__constant__ unsigned char T5_BUCKET[128] = {0, 1, 2, 3, 4, 5, 6, 7, 8, 9, 10, 11, 12, 13, 14, 15, 16, 16, 16, 17, 17, 18, 18, 18, 19, 19, 19, 20, 20, 20, 20, 21, 21, 21, 21, 22, 22, 22, 22, 22, 23, 23, 23, 23, 23, 23, 24, 24, 24, 24, 24, 24, 25, 25, 25, 25, 25, 25, 25, 26, 26, 26, 26, 26, 26, 26, 26, 27, 27, 27, 27, 27, 27, 27, 27, 27, 27, 28, 28, 28, 28, 28, 28, 28, 28, 28, 28, 29, 29, 29, 29, 29, 29, 29, 29, 29, 29, 29, 29, 30, 30, 30, 30, 30, 30, 30, 30, 30, 30, 30, 30, 30, 30, 31, 31, 31, 31, 31, 31, 31, 31, 31, 31, 31, 31, 31, 31, 31};

__device__ __forceinline__ float bf2f(bf16_t v) { return __uint_as_float(((unsigned)v) << 16); }
__device__ __forceinline__ bf16_t f2bf(float f) { unsigned u = __float_as_uint(f); return (bf16_t)((u + 0x7fffu + ((u >> 16) & 1u)) >> 16); }
__device__ __forceinline__ float sigmoidf_(float x) { return 1.0f / (1.0f + __expf(-x)); }
__device__ __forceinline__ float siluf_(float x) { return x * sigmoidf_(x); }
__device__ __forceinline__ float gelu_tanh(float y) { const float t = tanhf(0.7978845608028654f * (y + 0.044715f * y * y * y)); return 0.5f * y * (1.0f + t); }

struct P {
    const float* in[33];
    float* out;
    unsigned char* ws;
};

typedef const P __attribute__((address_space(4)))* KP;
__device__ __forceinline__ KP get_kp() { KP k = (KP)__builtin_amdgcn_kernarg_segment_ptr(); asm volatile("" : "+s"(k)); return k; }

constexpr size_t WS_CTL = (WS_END + 4095) & ~(size_t)4095;
constexpr size_t CTL_BYTES = 65536;
static_assert(WS_CTL + CTL_BYTES <= 268435456ull, "workspace fits 256 MiB");
constexpr int NTHREADS = 512, NWAVES = 8;
constexpr int LDS_BYTES = 147456;
constexpr int LDS_MISC = 135168;

#define LAS __attribute__((address_space(3)))
#define XB_TMO      128
#define XB_XCNT(j)  (256  + 64 * (j))
#define XB_XSUB(j)  (1280 + 64 * (j))
#define XB_XGEN(j)  (2304 + 64 * (j))
#define XB_TOP      3328
#define XB_TOPGEN   3392
#define XCD_BAR_WORDS 3456
#define XB_SPIN_CAP (1u << 18)
__device__ __forceinline__ unsigned xb_ld(unsigned* p)              { return __hip_atomic_load(p, __ATOMIC_RELAXED, __HIP_MEMORY_SCOPE_AGENT); }
__device__ __forceinline__ unsigned xb_add(unsigned* p, unsigned v) { return __hip_atomic_fetch_add(p, v, __ATOMIC_RELAXED, __HIP_MEMORY_SCOPE_AGENT); }
__device__ __forceinline__ unsigned xb_xcc_id() { return (unsigned)__builtin_amdgcn_s_getreg((3 << 11) | 20) & 0xFu; }
#define XB_SPIN(cond, bar) do { unsigned _sp = 0; while (cond) { __builtin_amdgcn_s_sleep(1); \
    if ((++_sp & 255u) == 0u) { if (xb_ld(&(bar)[XB_TMO])) break; if (_sp > XB_SPIN_CAP) { atomicAdd(&(bar)[XB_TMO], 1u); break; } } } } while (0)
struct XcdBarrier { unsigned* bar; unsigned x; volatile LAS unsigned* st; };
__device__ __forceinline__ XcdBarrier xcd_barrier_post(unsigned* bar, volatile LAS unsigned* st) {
    XcdBarrier b; b.bar = bar; b.x = xb_xcc_id(); b.st = st;
    if (threadIdx.x == 0) (void)xb_add(&bar[XB_XCNT(b.x)], 1u);
    return b;
}
__device__ __forceinline__ void xcd_barrier_complete(unsigned* bar, unsigned x, unsigned& nloc, unsigned& nx) {
    const unsigned G = gridDim.x * gridDim.y * gridDim.z;
    unsigned sum, cnt, mine, sp = 0u;
    for (;;) {
        sum = 0u; cnt = 0u; mine = 0u;
#pragma unroll
        for (unsigned j = 0; j < 16; ++j) { const unsigned c = xb_ld(&bar[XB_XCNT(j)]); sum += c; cnt += (c > 0u) ? 1u : 0u; mine = (j == x) ? c : mine; }
        if (sum == G) break;
        __builtin_amdgcn_s_sleep(1);
        if ((++sp & 255u) == 0u) { if (xb_ld(&bar[XB_TMO])) break; if (sp > XB_SPIN_CAP) { atomicAdd(&bar[XB_TMO], 1u); break; } }
    }
    nloc = mine > 0u ? mine : 1u; nx = cnt > 0u ? cnt : 1u;
}
__device__ __forceinline__ void xcd_barrier(const XcdBarrier& b) {
    asm volatile("s_waitcnt vmcnt(0)" ::: "memory");
    __syncthreads();
    if (threadIdx.x == 0) {
        unsigned* bar = b.bar; asm volatile("" : "+s"(bar));
        unsigned bx = b.x; asm volatile("" : "+s"(bx));
        __builtin_amdgcn_s_waitcnt(0);
        unsigned nloc = b.st[0], nx = b.st[1];
        if (nloc == 0u) { xcd_barrier_complete(bar, bx, nloc, nx); b.st[0] = nloc; b.st[1] = nx; }
        const unsigned old = xb_add(&bar[XB_XSUB(bx)], 1u);
        const unsigned gen = old / nloc;
        if (old + 1u == (gen + 1u) * nloc) {
            __builtin_amdgcn_fence(__ATOMIC_RELEASE, "agent");
            asm volatile("s_waitcnt vmcnt(0)" ::: "memory");
            const unsigned og = xb_add(&bar[XB_TOP], 1u);
            const unsigned tg = og / nx;
            if (og + 1u == (tg + 1u) * nx) xb_add(&bar[XB_TOPGEN], 1u);
            else XB_SPIN(xb_ld(&bar[XB_TOPGEN]) == tg, bar);
            __builtin_amdgcn_fence(__ATOMIC_ACQUIRE, "agent");
            xb_add(&bar[XB_XGEN(bx)], 1u);
            asm volatile("s_waitcnt vmcnt(0)" ::: "memory");
        } else {
            XB_SPIN(xb_ld(&bar[XB_XGEN(bx)]) == gen, bar);
            __builtin_amdgcn_fence(__ATOMIC_ACQUIRE, "agent");
            asm volatile("s_waitcnt vmcnt(0)" ::: "memory");
        }
    }
    __syncthreads();
}

namespace pg8 {
#define PG8_LAS __attribute__((address_space(3)))
typedef unsigned short bf16_t;
typedef short bf16x8 __attribute__((ext_vector_type(8)));
typedef float f32x4 __attribute__((ext_vector_type(4)));
typedef unsigned u32x4 __attribute__((ext_vector_type(4)));
constexpr int BM = 256, BK = 64, HALF = 128, HTB = HALF * BK * 2  , STAGE_BYTES = 8 * HTB, NXCD = 8, WGM = 8;

__host__ __device__ __forceinline__ int lds_byte(int r, int c) { const int st = (r >> 4) * 2 + (c >> 5), rr = r & 15, cc = c & 31, ob = rr * 64 + cc * 2; return st * 1024 + (ob ^ (((ob >> 9) & 1) << 5)); }
__host__ __device__ __forceinline__ void stage_rc(int b, int& R, int& C) { const int st = b / 1024, sb = b % 1024, swz = sb ^ (((sb >> 9) & 1) << 5); R = (st >> 1) * 16 + swz / 64; C = (st & 1) * 32 + (swz % 64) / 2; }
__host__ __device__ __forceinline__ int perm32(int rho) { const int n = rho >> 4, i = rho & 15; return 8 * (i >> 2) + 4 * n + (i & 3); }

struct Unit { int pm, pn, z; };
struct Gemm { const bf16_t* A; int lda; const bf16_t* Bt; int K; };

struct StaticOrder {
    int nM, nN, nwg, G, c;
    __host__ __device__ void init(int M, int N, int G_, int c_) { nM = M / BM; nN = N / BM; nwg = nM * nN; G = G_; c = c_; }
    __host__ __device__ bool next(int i, Unit& u) const {
        const long L = (long)i * G + c; if (L >= nwg) return false;
        int wgid = (int)L; { const int q = nwg / NXCD, r = nwg % NXCD, xcd = wgid % NXCD, off = wgid / NXCD; wgid = (xcd < r ? xcd * (q + 1) : r * (q + 1) + (xcd - r) * q) + off; }
        const int nig = WGM * nN, gid = wgid / nig, fm = gid * WGM, gsz = (nM - fm) < WGM ? (nM - fm) : WGM;
        u.pm = fm + ((wgid % nig) % gsz); u.pn = (wgid % nig) / gsz; u.z = 0; return true;
    }
    __device__ __forceinline__ size_t a_off(const Unit&) const { return 0; }
    __device__ __forceinline__ size_t b_off(const Unit&) const { return 0; }
    __device__ __forceinline__ void a_ready(const Unit&) const {}
    __device__ __forceinline__ void done(const Unit&) const {}
};

__device__ __forceinline__ unsigned cvt_pk_bf16(float lo, float hi) { unsigned r; asm volatile("v_cvt_pk_bf16_f32 %0, %1, %2" : "=v"(r) : "v"(lo), "v"(hi)); return r; }
typedef float f32x2 __attribute__((ext_vector_type(2)));
__device__ __forceinline__ f32x2 gelu_pk(f32x2 v) {
    const f32x2 av = __builtin_elementwise_abs(v), d = av * 0.2316418882f + 1.0f;
    f32x2 t; t.x = __builtin_amdgcn_rcpf(d.x); t.y = __builtin_amdgcn_rcpf(d.y);
    f32x2 q = t * 0.5307027145f + (-0.7265760135f); q = q * t + 0.7107068705f; q = q * t + (-0.142248368f); q = q * t + 0.127414796f; q = q * t;
    const f32x2 s = (v * v) * (-0.72134752044f);
    f32x2 e; e.x = __builtin_amdgcn_exp2f(s.x); e.y = __builtin_amdgcn_exp2f(s.y);
    const f32x2 m = v * (q * e), r = v - m;
    f32x2 o; o.x = v.x < 0.f ? m.x : r.x; o.y = v.y < 0.f ? m.y : r.y; return o;
}

template <class Epi, class Sched, bool ALIGN_EPI = false, bool SP2 = false>
__device__ __forceinline__ void gemm_phase(PG8_LAS unsigned char* lds, const Gemm g, const Sched& S, const Epi& E) {
    int zv_ = 0; asm volatile("" : "+v"(zv_));
    const int tid = (int)threadIdx.x + zv_, wid = __builtin_amdgcn_readfirstlane(tid >> 6), lane = tid & 63, wr = wid >> 2, wc = wid & 3, fr = lane & 15, fq = lane >> 4;
    const int K = g.K, nt = K / BK;
    unsigned voffA[2], voffB[2];
#pragma unroll
    for (int i = 0; i < 2; ++i) { int R, C; stage_rc(tid * 16 + i * 8192, R, C); const int Rb = Epi::PERM ? ((R & ~31) + perm32(R & 31)) : R;
        voffA[i] = (unsigned)(R * g.lda + C) * 2u; voffB[i] = (unsigned)(Rb * K + C) * 2u; }
    const size_t kstep = (size_t)(BK * 2);
    const size_t hstepA = (size_t)HALF * g.lda * 2, hstepB = (size_t)HALF * K * 2;
    const size_t tstepA = 2 * hstepA, tstepB = 2 * hstepB;
    const unsigned ldsw = (unsigned)wid * 1024u;
    const int aoff = lds_byte(wr * 64 + fr, fq * 8), boff = lds_byte(wc * 32 + fr, fq * 8);
#define PG8_SA(b, h) (((b) * 2 + (h)) * HTB)
#define PG8_SB(b, h) ((4 + (b) * 2 + (h)) * HTB)
#define PG8_STAGE(bufoff, gbase, voff) do { _Pragma("unroll") for (int _i = 0; _i < 2; ++_i) \
        __builtin_amdgcn_global_load_lds((const unsigned*)((const char*)(gbase) + (voff)[_i]), (PG8_LAS unsigned*)(lds + (bufoff) + ldsw + _i * 8192), 16, 0, 0); } while (0)
#define PG8_LDA(dst, b, h) do { _Pragma("unroll") for (int m = 0; m < 4; ++m) _Pragma("unroll") for (int k = 0; k < 2; ++k) dst[m][k] = *(const PG8_LAS bf16x8*)(lds + PG8_SA(b, h) + aoff + m * 2048 + k * 1024); } while (0)
#define PG8_LDB(dst, b, h) do { _Pragma("unroll") for (int n = 0; n < 2; ++n) _Pragma("unroll") for (int k = 0; k < 2; ++k) dst[n][k] = *(const PG8_LAS bf16x8*)(lds + PG8_SB(b, h) + boff + n * 2048 + k * 1024); } while (0)
#define PG8_MMA(ai, bj, At, Bt) do { __builtin_amdgcn_s_setprio(1); _Pragma("unroll") for (int m = 0; m < 4; ++m) _Pragma("unroll") for (int n = 0; n < 2; ++n) _Pragma("unroll") for (int k = 0; k < 2; ++k) \
        acc[ai][bj][m][n] = __builtin_amdgcn_mfma_f32_16x16x32_bf16(Bt[n][k], At[m][k], acc[ai][bj][m][n], 0, 0, 0); __builtin_amdgcn_s_setprio(0); } while (0)
#define PG8_WAIT_V(n) asm volatile("s_waitcnt vmcnt(" #n ")" ::: "memory")
#define PG8_WAIT_L(n) asm volatile("s_waitcnt lgkmcnt(" #n ")" ::: "memory")
#define PG8_BAR __builtin_amdgcn_s_barrier()
#define PG8_SCHED __builtin_amdgcn_sched_barrier(0)
    Unit cur, nxt; int ui = 0;
    if (!S.next(0, cur)) return;
    f32x4 acc[2][2][4][2];
#pragma unroll
    for (int a = 0; a < 2; ++a)
#pragma unroll
        for (int b = 0; b < 2; ++b)
#pragma unroll
            for (int m = 0; m < 4; ++m)
#pragma unroll
                for (int n = 0; n < 2; ++n) acc[a][b][m][n] = (f32x4){0.f, 0.f, 0.f, 0.f};
    bf16x8 At[4][2], B0[2][2], B1[2][2];
    const char* cA = (const char*)g.A + (size_t)cur.pm * tstepA + S.a_off(cur); const char* cB = (const char*)g.Bt + (size_t)cur.pn * tstepB + S.b_off(cur);
    S.a_ready(cur);
    if constexpr (SP2) {
        PG8_STAGE(PG8_SB(0, 0), cB, voffB); PG8_STAGE(PG8_SB(0, 1), cB + hstepB, voffB); PG8_STAGE(PG8_SA(0, 0), cA, voffA); PG8_STAGE(PG8_SA(0, 1), cA + hstepA, voffA);
        if (wr == 1) PG8_BAR;
        PG8_WAIT_V(2); PG8_BAR;
        PG8_STAGE(PG8_SB(1, 0), cB + kstep, voffB); PG8_STAGE(PG8_SA(1, 0), cA + kstep, voffA); PG8_STAGE(PG8_SB(1, 1), cB + hstepB + kstep, voffB);
        PG8_WAIT_V(6); PG8_BAR;
    } else {
        PG8_STAGE(PG8_SB(0, 0), cB, voffB); PG8_STAGE(PG8_SA(0, 0), cA, voffA); PG8_STAGE(PG8_SB(0, 1), cB + hstepB, voffB); PG8_STAGE(PG8_SA(0, 1), cA + hstepA, voffA);
        if (wr == 1) PG8_BAR;
        PG8_WAIT_V(4); PG8_BAR;
        PG8_STAGE(PG8_SB(1, 0), cB + kstep, voffB); PG8_STAGE(PG8_SA(1, 0), cA + kstep, voffA); PG8_STAGE(PG8_SB(1, 1), cB + hstepB + kstep, voffB);
        PG8_WAIT_V(6); PG8_BAR;
    }
    for (;;) {
        const bool has_next = S.next(ui + 1, nxt);
        const char* nA = has_next ? (const char*)g.A + (size_t)nxt.pm * tstepA + S.a_off(nxt) : cA; const char* nB = has_next ? (const char*)g.Bt + (size_t)nxt.pn * tstepB + S.b_off(nxt) : cB;
        for (int t = 0; t < nt; t += 2) {
            const bool last = (t == nt - 2);
            const char* a1 = cA + (size_t)(t + 1) * kstep;
            const char* a2 = last ? nA : cA + (size_t)(t + 2) * kstep; const char* b2 = last ? nB : cB + (size_t)(t + 2) * kstep;
            const char* a3 = a2 + kstep; const char* b3 = b2 + kstep;
            if (last && has_next) S.a_ready(nxt);
            if constexpr (SP2) {
            PG8_LDB(B0, 0, 0); PG8_LDB(B1, 0, 1); PG8_SCHED; PG8_LDA(At, 0, 0); PG8_STAGE(PG8_SA(1, 1), a1 + hstepA, voffA);
            PG8_WAIT_V(8); PG8_WAIT_L(0); PG8_BAR; PG8_MMA(0, 0, At, B0); PG8_MMA(0, 1, At, B1); PG8_BAR; PG8_SCHED;
            PG8_LDA(At, 0, 1); PG8_STAGE(PG8_SB(0, 0), b2, voffB); PG8_STAGE(PG8_SB(0, 1), b2 + hstepB, voffB); PG8_STAGE(PG8_SA(0, 0), a2, voffA);
            PG8_WAIT_V(8); PG8_WAIT_L(0); PG8_BAR; PG8_MMA(1, 0, At, B0); PG8_MMA(1, 1, At, B1); PG8_BAR; PG8_SCHED;
            PG8_LDB(B0, 1, 0); PG8_LDB(B1, 1, 1); PG8_SCHED; PG8_LDA(At, 1, 0); PG8_STAGE(PG8_SA(0, 1), a2 + hstepA, voffA);
            PG8_WAIT_V(8); PG8_WAIT_L(0); PG8_BAR; PG8_MMA(0, 0, At, B0); PG8_MMA(0, 1, At, B1); PG8_BAR; PG8_SCHED;
            PG8_LDA(At, 1, 1); PG8_STAGE(PG8_SB(1, 0), b3, voffB); PG8_STAGE(PG8_SB(1, 1), b3 + hstepB, voffB); PG8_STAGE(PG8_SA(1, 0), a3, voffA);
            PG8_WAIT_V(8); PG8_WAIT_L(0); PG8_BAR; PG8_MMA(1, 0, At, B0); PG8_MMA(1, 1, At, B1); PG8_BAR; PG8_SCHED;
            } else {
            PG8_LDB(B0, 0, 0); PG8_SCHED; PG8_LDA(At, 0, 0); PG8_STAGE(PG8_SA(1, 1), a1 + hstepA, voffA);
            PG8_WAIT_L(8); PG8_BAR; PG8_WAIT_L(0); PG8_MMA(0, 0, At, B0); PG8_BAR; PG8_SCHED;
            PG8_LDB(B1, 0, 1); PG8_STAGE(PG8_SB(0, 0), b2, voffB);
            PG8_BAR; PG8_WAIT_L(0); PG8_MMA(0, 1, At, B1); PG8_BAR;
            PG8_LDA(At, 0, 1); PG8_STAGE(PG8_SA(0, 0), a2, voffA);
            PG8_BAR; PG8_WAIT_L(0); PG8_MMA(1, 0, At, B0); PG8_BAR; PG8_SCHED;
            PG8_STAGE(PG8_SB(0, 1), b2 + hstepB, voffB);
            PG8_WAIT_V(6); PG8_BAR; PG8_MMA(1, 1, At, B1); PG8_BAR;
            PG8_LDB(B0, 1, 0); PG8_SCHED; PG8_LDA(At, 1, 0); PG8_STAGE(PG8_SA(0, 1), a2 + hstepA, voffA);
            PG8_WAIT_L(8); PG8_BAR; PG8_WAIT_L(0); PG8_MMA(0, 0, At, B0); PG8_BAR; PG8_SCHED;
            PG8_LDB(B1, 1, 1); PG8_STAGE(PG8_SB(1, 0), b3, voffB);
            PG8_BAR; PG8_WAIT_L(0); PG8_MMA(0, 1, At, B1); PG8_BAR;
            PG8_LDA(At, 1, 1); PG8_STAGE(PG8_SA(1, 0), a3, voffA);
            PG8_BAR; PG8_WAIT_L(0); PG8_MMA(1, 0, At, B0); PG8_BAR; PG8_SCHED;
            PG8_STAGE(PG8_SB(1, 1), b3 + hstepB, voffB);
            PG8_WAIT_V(6); PG8_BAR; PG8_MMA(1, 1, At, B1); PG8_BAR;
            }
        }
        if constexpr (ALIGN_EPI) { if (wr == 0) PG8_BAR; }
        if constexpr (!Epi::AFTER_DRAIN) { E(acc, cur, wr, wc, fr, fq); S.done(cur); }
        if (!has_next) break;
#pragma unroll
        for (int a = 0; a < 2; ++a)
#pragma unroll
            for (int b = 0; b < 2; ++b)
#pragma unroll
                for (int m = 0; m < 4; ++m)
#pragma unroll
                    for (int n = 0; n < 2; ++n) acc[a][b][m][n] = (f32x4){0.f, 0.f, 0.f, 0.f};
        cur = nxt; cA = nA; cB = nB; ++ui;
        if constexpr (ALIGN_EPI) { if (wr == 1) PG8_BAR; }
    }
    PG8_WAIT_V(0);
    if constexpr (!ALIGN_EPI) { if (wr == 0) PG8_BAR; }
    PG8_BAR;
    if constexpr (Epi::AFTER_DRAIN) { E.fused(acc, cur, wr, wc, fr, fq, lds, wid, lane); S.done(cur); }
#undef PG8_SA
#undef PG8_SB
#undef PG8_STAGE
#undef PG8_LDA
#undef PG8_LDB
#undef PG8_MMA
#undef PG8_WAIT_V
#undef PG8_WAIT_L
#undef PG8_BAR
#undef PG8_SCHED
}
}

namespace pg8 {
typedef unsigned u32x2 __attribute__((ext_vector_type(2)));
__device__ __forceinline__ float bflo(unsigned w) { return __uint_as_float(w << 16); }
__device__ __forceinline__ float bfhi(unsigned w) { return __uint_as_float(w & 0xffff0000u); }
__device__ __forceinline__ float sigm(float x) { return __builtin_amdgcn_rcpf(1.0f + __expf(-x)); }
struct EpiProjB {
    static constexpr bool PERM = true, AFTER_DRAIN = false;
    bf16_t* O; int ldc;
    __device__ __forceinline__ void operator()(const f32x4 (&acc)[2][2][4][2], const Unit& u, int wr, int wc, int fr, int fq) const {
        const int row0 = u.pm * BM + wr * 64 + fr, col0 = u.pn * BM + wc * 32 + 8 * fq;
#pragma unroll
        for (int ai = 0; ai < 2; ++ai)
#pragma unroll
            for (int m = 0; m < 4; ++m) { bf16_t* rowp = O + (size_t)(row0 + ai * HALF + m * 16) * ldc + col0;
#pragma unroll
                for (int bj = 0; bj < 2; ++bj) { const f32x4 v0 = acc[ai][bj][m][0], v1 = acc[ai][bj][m][1];
                    u32x4 w; w.x = cvt_pk_bf16(v0[0], v0[1]); w.y = cvt_pk_bf16(v0[2], v0[3]); w.z = cvt_pk_bf16(v1[0], v1[1]); w.w = cvt_pk_bf16(v1[2], v1[3]);
                    *(u32x4*)(rowp + bj * HALF) = w; } }
    }
};
struct EpiGluB {
    static constexpr bool PERM = true, AFTER_DRAIN = false;
    bf16_t* PROJ;
    __device__ __forceinline__ void operator()(const f32x4 (&acc)[2][2][4][2], const Unit& u, int wr, int wc, int fr, int fq) const {
        const int row0 = u.pm * BM + wr * 64 + fr, col0 = u.pn * BM + wc * 32 + 8 * fq;
#pragma unroll
        for (int ai = 0; ai < 2; ++ai)
#pragma unroll
            for (int m = 0; m < 4; ++m) { bf16_t* rowp = PROJ + (size_t)(row0 + ai * HALF + m * 16) * IN_COLS + col0;
#pragma unroll
                for (int bj = 0; bj < 2; ++bj) {
                    const u32x4 zz = *(const u32x4*)(rowp + C_UB + bj * HALF), gg = *(const u32x4*)(rowp + C_GB + bj * HALF);
                    const f32x4 v0 = acc[ai][bj][m][0], v1 = acc[ai][bj][m][1];
                    float o[8];
#pragma unroll
                    for (int e = 0; e < 4; ++e) {
                        const float va = e < 2 ? v0[2 * e] : v1[2 * (e - 2)], vb = e < 2 ? v0[2 * e + 1] : v1[2 * (e - 2) + 1];
                        const float za = bflo(zz[e]), zb = bfhi(zz[e]), ga = bflo(gg[e]), gb = bfhi(gg[e]);
                        o[2 * e] = za * sigm(va) * ga * sigm(ga); o[2 * e + 1] = zb * sigm(vb) * gb * sigm(gb);
                    }
                    u32x4 w; w.x = cvt_pk_bf16(o[0], o[1]); w.y = cvt_pk_bf16(o[2], o[3]); w.z = cvt_pk_bf16(o[4], o[5]); w.w = cvt_pk_bf16(o[6], o[7]);
                    *(u32x4*)(rowp + C_GB + bj * HALF) = w; } }
    }
};
struct EpiBranchB {
    static constexpr bool PERM = true, AFTER_DRAIN = false;
    bf16_t* PROJ;
    __device__ __forceinline__ void operator()(const f32x4 (&acc)[2][2][4][2], const Unit& u, int wr, int wc, int fr, int fq) const {
        const int row0 = u.pm * BM + wr * 64 + fr, col0 = u.pn * BM + wc * 32 + 8 * fq;
        const int z = u.z;
#pragma unroll
        for (int ai = 0; ai < 2; ++ai)
#pragma unroll
            for (int m = 0; m < 4; ++m) { bf16_t* rowp = PROJ + (size_t)(row0 + ai * HALF + m * 16) * IN_COLS + C_GM + col0;
#pragma unroll
                for (int bj = 0; bj < 2; ++bj) {
                    const u32x4 gg = *(const u32x4*)(rowp + z * 1024 + bj * HALF);
                    u32x4 pp = (u32x4){0u, 0u, 0u, 0u};
                    if (z > 0) pp = *(const u32x4*)(rowp + bj * HALF);
                    const f32x4 v0 = acc[ai][bj][m][0], v1 = acc[ai][bj][m][1];
                    float o[8];
#pragma unroll
                    for (int e = 0; e < 4; ++e) {
                        const float va = e < 2 ? v0[2 * e] : v1[2 * (e - 2)], vb = e < 2 ? v0[2 * e + 1] : v1[2 * (e - 2) + 1];
                        o[2 * e] = bflo(pp[e]) + sigm(bflo(gg[e])) * va; o[2 * e + 1] = bfhi(pp[e]) + sigm(bfhi(gg[e])) * vb;
                    }
                    u32x4 w; w.x = cvt_pk_bf16(o[0], o[1]); w.y = cvt_pk_bf16(o[2], o[3]); w.z = cvt_pk_bf16(o[4], o[5]); w.w = cvt_pk_bf16(o[6], o[7]);
                    *(u32x4*)(rowp + bj * HALF) = w; } }
    }
};
struct BranchOrder : StaticOrder {
    __device__ bool next(int i, Unit& u) const { if (!StaticOrder::next(i / 3, u)) return false; u.z = i % 3; return true; }
    __device__ __forceinline__ size_t a_off(const Unit& u) const { return (size_t)(u.z == 0 ? C_Q : (u.z == 1 ? C_GB : C_GC)) * 2; }
    __device__ __forceinline__ size_t b_off(const Unit& u) const { return (size_t)u.z * 1024 * 512 * 2; }
};
struct EpiOutB {
    static constexpr bool PERM = false, AFTER_DRAIN = false;
    const float* xp; const float* xs; const bf16_t* XB; unsigned char* ws; int l;
    __device__ __forceinline__ void operator()(const f32x4 (&acc)[2][2][4][2], const Unit& u, int wr, int wc, int fr, int fq) const {
        const int row0 = u.pm * BM + wr * 64 + fr, col0 = u.pn * BM + wc * 32 + 4 * fq;
#pragma unroll
        for (int ai = 0; ai < 2; ++ai)
#pragma unroll
            for (int m = 0; m < 4; ++m) { const int r = row0 + ai * HALF + m * 16;
                float* prow = (float*)(ws + WS_PROJ + (size_t)r * IN_COLS * 2 + (size_t)(C_GM + 1024) * 2) + col0;
#pragma unroll
                for (int bj = 0; bj < 2; ++bj)
#pragma unroll
                    for (int n = 0; n < 2; ++n) {
                        const int co = bj * HALF + n * 16;
                        f32x4 x;
                        if (l == 0) x = r < M_P ? *(const f32x4*)(xp + (size_t)r * D_MODEL + col0 + co) : *(const f32x4*)(xs + (size_t)(r - M_P) * D_MODEL + col0 + co);
                        else { const u32x2 xx = *(const u32x2*)(XB + (size_t)r * D_MODEL + col0 + co); x = (f32x4){bflo(xx.x), bfhi(xx.x), bflo(xx.y), bfhi(xx.y)}; }
                        *(f32x4*)(prow + co) = x * DN_ALPHA + acc[ai][bj][m][n];
                    } }
    }
};
}

struct Ctx { int tid, lane, wave, gw, ngw; size_t gt, ngt; };
__device__ __forceinline__ Ctx make_ctx() {
    int zv = 0; asm volatile("" : "+v"(zv)); int zs = 0; asm volatile("" : "+s"(zs));
    Ctx c; c.tid = (int)threadIdx.x + zv; c.lane = c.tid & 63; c.wave = __builtin_amdgcn_readfirstlane(c.tid >> 6);
    const int bid = (int)blockIdx.x + zs, nb = (int)gridDim.x + zs;
    c.gw = c.wave * nb + bid; c.ngw = nb * NWAVES; c.gt = (size_t)bid * NTHREADS + c.tid; c.ngt = (size_t)nb * NTHREADS; return c;
}
#define WAVE_LDS_SYNC() do { asm volatile("s_waitcnt lgkmcnt(0)" ::: "memory"); __builtin_amdgcn_wave_barrier(); } while (0)

__device__ __forceinline__ void st_convert_x(KP p, const Ctx& c) {
    bf16_t* XB = (bf16_t*)(p->ws + WS_XB);
    const size_t n = (size_t)M_TOT * D_MODEL;
    for (size_t i = c.gt; i < n; i += c.ngt) {
        const float v = i < (size_t)M_P * D_MODEL ? p->in[0][i] : p->in[1][i - (size_t)M_P * D_MODEL];
        XB[i] = f2bf(v);
    }
}
__device__ __forceinline__ void st_transpose_w(const float* W, bf16_t* WT, int K, int N, const Ctx& c) {
    const size_t n = (size_t)K * N;
    for (size_t i = c.gt; i < n; i += c.ngt) { const int nn = (int)(i / K), kk = (int)(i % K); WT[i] = f2bf(W[(size_t)kk * N + nn]); }
}
__device__ __forceinline__ void st_s5_tables(KP p, const Ctx& c) {
    float* AB = (float*)(p->ws + WS_TAB + TAB_AB);
    float* BB = (float*)(p->ws + WS_TAB + TAB_BB);
    for (size_t ii = c.gt; ii < (size_t)DEPTH * NG * NP; ii += c.ngt) {
        const int i = (int)ii, l = i / (NG * NP), g = (i / NP) % NG;
        const float lr = fminf(p->in[12][i], -1e-4f), li = p->in[13][i];
        const float step = expf(p->in[14][l * NG + g]);
        const float mag = expf(lr * step);
        float sn, cs; sincosf(li * step, &sn, &cs);
        const float ab_re = mag * cs, ab_im = mag * sn;
        const float den = lr * lr + li * li;
        const float f_re = ((ab_re - 1.0f) * lr + ab_im * li) / den;
        const float f_im = (ab_im * lr - (ab_re - 1.0f) * li) / den;
        AB[2 * i] = ab_re; AB[2 * i + 1] = ab_im;
        for (int cc = 0; cc < NC; ++cc) {
            const float bre = p->in[15][(size_t)i * NC + cc], bim = p->in[16][(size_t)i * NC + cc];
            BB[((size_t)i * NC + cc) * 2] = f_re * bre - f_im * bim;
            BB[((size_t)i * NC + cc) * 2 + 1] = f_re * bim + f_im * bre;
        }
    }
}

template <class Epi>
__device__ __forceinline__ void gemm_simple(const bf16_t* A, int lda, const bf16_t* Bt, int ldb, int M, int N, int K, Epi epi, const Ctx& c) {
    const int lane = c.lane;
    const int ntn = N / 32, ntiles = (M / 32) * ntn;
    for (int tile = c.gw; tile < ntiles; tile += c.ngw) {
        const int tm = tile / ntn, tn = tile % ntn;
        f32x16 acc = {};
        const bf16_t* ar = A + (size_t)(tm * 32 + (lane & 31)) * lda + 8 * (lane >> 5);
        const bf16_t* br = Bt + (size_t)(tn * 32 + (lane & 31)) * ldb + 8 * (lane >> 5);
        for (int k0 = 0; k0 < K; k0 += 16) {
            const bf16x8 a = *(const bf16x8*)(ar + k0);
            const bf16x8 b = *(const bf16x8*)(br + k0);
            acc = __builtin_amdgcn_mfma_f32_32x32x16_bf16(a, b, acc, 0, 0, 0);
        }
#pragma unroll
        for (int r = 0; r < 16; ++r) {
            const int row = tm * 32 + (r & 3) + 8 * (r >> 2) + 4 * (lane >> 5), col = tn * 32 + (lane & 31);
            epi(row, col, acc[r]);
        }
    }
}
struct EpiProj { bf16_t* PROJ; __device__ void operator()(int r, int c, float v) const { PROJ[(size_t)r * IN_COLS + c] = f2bf(v); } };

__device__ __forceinline__ void st_kv_out(KP p, int l, const Ctx& c) {
    const bf16_t* PROJ = (const bf16_t*)(p->ws + WS_PROJ);
    for (size_t ii = c.gt; ii < (size_t)BATCH * 3 * 512; ii += c.ngt) {
        const int i = (int)ii, b = i / 1536, j = (i / 512) % 3, ch = i % 512;
        p->out[O_CP + (size_t)l * BATCH * 1536 + i] = bf2f(PROJ[((size_t)b * SEQ + SEQ - 3 + j) * IN_COLS + C_XC + ch]);
    }
    for (size_t ii = c.gt; ii < (size_t)DEC_BATCH * WINDOW * 128; ii += c.ngt) {
        const int i = (int)ii;
        if (i < BATCH * WINDOW * 128) {
            const int b = i / (WINDOW * 128), w = (i / 128) % WINDOW, cc = i % 128;
            const size_t row = (size_t)b * SEQ + (SEQ - WINDOW) + w;
            p->out[O_KP + (size_t)l * BATCH * WINDOW * 128 + i] = bf2f(PROJ[row * IN_COLS + C_K + cc]);
            p->out[O_VP + (size_t)l * BATCH * WINDOW * 128 + i] = bf2f(PROJ[row * IN_COLS + C_V + cc]);
        }
        {
            const int b = i / (WINDOW * 128), w = (i / 128) % WINDOW, cc = i % 128;
            float kv, vv;
            if (w < WINDOW - DEC_SEQ) {
                const size_t ci = (((size_t)l * DEC_BATCH + b) * WINDOW + (w + DEC_SEQ)) * 128 + cc;
                kv = p->in[2][ci]; vv = p->in[3][ci];
            } else {
                const size_t row = (size_t)M_P + b * DEC_SEQ + (w - (WINDOW - DEC_SEQ));
                kv = bf2f(PROJ[row * IN_COLS + C_K + cc]); vv = bf2f(PROJ[row * IN_COLS + C_V + cc]);
            }
            p->out[O_KS + (size_t)l * DEC_BATCH * WINDOW * 128 + i] = kv;
            p->out[O_VS + (size_t)l * DEC_BATCH * WINDOW * 128 + i] = vv;
        }
    }
}

__device__ __forceinline__ void st_attn_simple(KP p, int l, const Ctx& c) {
    bf16_t* PROJ = (bf16_t*)(p->ws + WS_PROJ);
    const int lane = c.lane;
    const float* rel_bias = p->in[8];
    for (int item = c.gw; item < M_S * NQH; item += c.ngw) {
        const int m = M_P + item / NQH, h = item % NQH, kvh = h / 4;
        const bool samp = m >= M_P;
        const int b = samp ? (m - M_P) / DEC_SEQ : m / SEQ, t = samp ? (m - M_P) % DEC_SEQ : m % SEQ;
        float q[64];
        {
            const bf16_t* qp = PROJ + (size_t)m * IN_COLS + C_Q + h * 64;
#pragma unroll
            for (int d = 0; d < 64; ++d) q[d] = bf2f(qp[d]);
        }
        const float sink = p->in[10][l * NQH + h];
        float s[2];
#pragma unroll
        for (int j = 0; j < 2; ++j) {
            const int d = lane + 64 * j;
            const int tk = t - d;
            float sc = -1e30f;
            if (!samp) {
                if (tk >= 0) {
                    const bf16_t* kp = PROJ + ((size_t)b * SEQ + tk) * IN_COLS + C_K + kvh * 64;
                    float a = 0.f;
#pragma unroll
                    for (int e = 0; e < 64; ++e) a += q[e] * bf2f(kp[e]);
                    sc = a * 0.125f + rel_bias[T5_BUCKET[d] * NQH + h];
                }
            } else {
                float a = 0.f;
                if (tk >= 0) {
                    const bf16_t* kp = PROJ + ((size_t)M_P + b * DEC_SEQ + tk) * IN_COLS + C_K + kvh * 64;
#pragma unroll
                    for (int e = 0; e < 64; ++e) a += q[e] * bf2f(kp[e]);
                } else {
                    const float* kp = p->in[2] + ((((size_t)l * DEC_BATCH + b) * WINDOW + (WINDOW + tk)) * NKV + kvh) * HD;
#pragma unroll
                    for (int e = 0; e < 64; ++e) a += q[e] * kp[e];
                }
                sc = a * 0.125f + rel_bias[T5_BUCKET[d] * NQH + h];
            }
            s[j] = sc;
        }
        float mx = fmaxf(fmaxf(s[0], s[1]), sink);
        for (int o = 32; o > 0; o >>= 1) mx = fmaxf(mx, __shfl_xor(mx, o));
        const float p0 = s[0] > -1e29f ? __expf(s[0] - mx) : 0.f, p1 = s[1] > -1e29f ? __expf(s[1] - mx) : 0.f;
        float sum = p0 + p1;
        for (int o = 32; o > 0; o >>= 1) sum += __shfl_xor(sum, o);
        const float denom = sum + __expf(sink - mx);
        float o = 0.f;
        for (int d = 0; d < 128; ++d) {
            const float pj = __shfl(d < 64 ? p0 : p1, d & 63);
            const int tk = t - d;
            float vv = 0.f;
            if (!samp) { if (tk >= 0) vv = bf2f(PROJ[((size_t)b * SEQ + tk) * IN_COLS + C_V + kvh * 64 + lane]); }
            else if (tk >= 0) vv = bf2f(PROJ[((size_t)M_P + b * DEC_SEQ + tk) * IN_COLS + C_V + kvh * 64 + lane]);
            else vv = p->in[3][((((size_t)l * DEC_BATCH + b) * WINDOW + (WINDOW + tk)) * NKV + kvh) * HD + lane];
            o += pj * vv;
        }
        o /= denom;
        const float ga = bf2f(PROJ[(size_t)m * IN_COLS + C_GA + h * 64 + lane]);
        PROJ[(size_t)m * IN_COLS + C_Q + h * 64 + lane] = f2bf(o * siluf_(ga));
    }
}

typedef short s16x4 __attribute__((ext_vector_type(4)));
typedef short v4i16_t __attribute__((ext_vector_type(4)));
typedef unsigned u32x4 __attribute__((ext_vector_type(4)));
typedef float f32x2_t __attribute__((ext_vector_type(2)));
typedef __bf16 bf16x2_t __attribute__((ext_vector_type(2)));
__device__ __forceinline__ unsigned cvtpk(float lo, float hi) { f32x2_t v = {lo, hi}; bf16x2_t b = __builtin_convertvector(v, bf16x2_t); return __builtin_bit_cast(unsigned, b); }
__device__ __forceinline__ bf16x8 pack8(float a0, float a1, float a2, float a3, float a4, float a5, float a6, float a7) {
    u32x4 p; p.x = cvtpk(a0, a1); p.y = cvtpk(a2, a3); p.z = cvtpk(a4, a5); p.w = cvtpk(a6, a7); return __builtin_bit_cast(bf16x8, p); }
__device__ __forceinline__ s16x4 tr_read(LAS const unsigned char* p) { return __builtin_bit_cast(s16x4, __builtin_amdgcn_ds_read_tr16_b64_v4i16((LAS v4i16_t*)p)); }
__device__ __forceinline__ bf16x8 cat8(s16x4 lo, s16x4 hi) { return __builtin_shufflevector(lo, hi, 0, 1, 2, 3, 4, 5, 6, 7); }
#define MFMA32(a, b, c) __builtin_amdgcn_mfma_f32_32x32x16_bf16((a), (b), (c), 0, 0, 0)
#define MFMA16(a, b, c) __builtin_amdgcn_mfma_f32_16x16x32_bf16((a), (b), (c), 0, 0, 0)

constexpr int AT_KSTR = 144, AT_VSTR = 192;
constexpr int AT_K = 0, AT_V = AT_K + 256 * AT_KSTR, AT_BIAS = AT_V + 256 * AT_VSTR, AT_WS = AT_BIAS + 4 * 128 * 4, AT_END = AT_WS + 8 * 256;
static_assert(AT_END <= 131072, "attention LDS");

__device__ __forceinline__ void st_attn_prompt(KP p, int l, LAS unsigned char* lds) {
    int zv = 0; asm volatile("" : "+v"(zv));
    const int tid = (int)threadIdx.x + zv, lane = tid & 63, wave = __builtin_amdgcn_readfirstlane(tid >> 6);
    const int c31 = lane & 31, h = lane >> 5;
    bf16_t* PROJ = (bf16_t*)(p->ws + WS_PROJ);
    const float* rel_bias = p->in[8];
    for (int item = blockIdx.x; item < BATCH * 16 * NKV; item += gridDim.x) {
        const int b = item / 32, nb = (item >> 1) & 15, kvh = item & 1;
        const size_t rowq0 = (size_t)b * SEQ + (size_t)nb * 128;
#pragma unroll
        for (int i = 0; i < 4; ++i) {
            const int id = tid + 512 * i, row = id >> 3, pc = id & 7;
            u32x4 kk = (u32x4){0u, 0u, 0u, 0u}, vv = kk;
            if (nb > 0 || row >= 128) {
                const bf16_t* src = PROJ + (rowq0 - 128 + row) * IN_COLS + kvh * 64 + pc * 8;
                kk = *(const u32x4*)(src + C_K); vv = *(const u32x4*)(src + C_V);
            }
            *(LAS u32x4*)(lds + AT_K + row * AT_KSTR + pc * 16) = kk;
            *(LAS u32x4*)(lds + AT_V + row * AT_VSTR + pc * 16) = vv;
        }
        { const int g = tid >> 7, d = tid & 127; ((LAS float*)(lds + AT_BIAS))[tid] = rel_bias[T5_BUCKET[d] * NQH + kvh * 4 + g]; }
        __syncthreads();
        const int g = wave >> 1, hq = kvh * 4 + g;
        const float sink = p->in[10][l * NQH + hq];
        LAS const float* biasd = (LAS const float*)(lds + AT_BIAS) + g * 128;
        LAS float* wsf = (LAS float*)(lds + AT_WS + wave * 256);
#pragma unroll 1
        for (int qi = 0; qi < 2; ++qi) {
            const int qt = 2 * (wave & 1) + qi, q0 = 32 * qt;
            bf16x8 qf[4];
            { const bf16_t* qp = PROJ + (rowq0 + q0 + c31) * IN_COLS + C_Q + hq * 64 + 8 * h;
#pragma unroll
              for (int ks = 0; ks < 4; ++ks) qf[ks] = *(const bf16x8*)(qp + 16 * ks); }
            f32x16 S[5];
#pragma unroll
            for (int j = 0; j < 5; ++j) {
                S[j] = (f32x16){};
                LAS const unsigned char* kp = lds + AT_K + (32 * (qt + j) + c31) * AT_KSTR + 16 * h;
#pragma unroll
                for (int ks = 0; ks < 4; ++ks) S[j] = MFMA32(*(LAS const bf16x8*)(kp + 32 * ks), qf[ks], S[j]);
            }
            const int iq = q0 + c31;
            float mx = sink;
#pragma unroll
            for (int j = 0; j < 5; ++j)
#pragma unroll
                for (int r = 0; r < 16; ++r) {
                    const int kv = 32 * (qt + j) + (r & 3) + 8 * (r >> 2) + 4 * h;
                    const int dist = iq + 128 - kv;
                    const bool ok = (dist >= 0) && (dist < 128) && (nb > 0 || kv >= 128);
                    const float s = ok ? S[j][r] * 0.125f + biasd[dist & 127] : -1e30f;
                    S[j][r] = s; mx = fmaxf(mx, s);
                }
            mx = fmaxf(mx, __shfl_xor(mx, 32));
            float sum = 0.f;
#pragma unroll
            for (int j = 0; j < 5; ++j)
#pragma unroll
                for (int r = 0; r < 16; ++r) { const float e = S[j][r] > -1e29f ? __expf(S[j][r] - mx) : 0.f; S[j][r] = e; sum += e; }
            sum += __shfl_xor(sum, 32);
            const float rden = 1.0f / (sum + __expf(sink - mx));
            if (h == 0) wsf[c31] = rden;
            f32x16 O[2]; O[0] = (f32x16){}; O[1] = (f32x16){};
            const int i16 = lane & 15, qq = i16 >> 2, pp = i16 & 3, blk = (lane >> 4) & 1;
#pragma unroll
            for (int j = 0; j < 5; ++j)
#pragma unroll
                for (int s = 0; s < 2; ++s) {
                    const bf16x8 pf = pack8(S[j][8 * s], S[j][8 * s + 1], S[j][8 * s + 2], S[j][8 * s + 3], S[j][8 * s + 4], S[j][8 * s + 5], S[j][8 * s + 6], S[j][8 * s + 7]);
                    LAS const unsigned char* vp = lds + AT_V + (32 * (qt + j) + 16 * s + 4 * h + qq) * AT_VSTR + (16 * blk + 4 * pp) * 2;
#pragma unroll
                    for (int dt = 0; dt < 2; ++dt) {
                        const bf16x8 vf = cat8(tr_read(vp + dt * 64), tr_read(vp + dt * 64 + 8 * AT_VSTR));
                        O[dt] = MFMA32(pf, vf, O[dt]);
                    }
                }
            WAVE_LDS_SYNC();
#pragma unroll
            for (int r = 0; r < 16; ++r) {
                const int qr = (r & 3) + 8 * (r >> 2) + 4 * h;
                const float rd = wsf[qr];
                bf16_t* rowp = PROJ + (rowq0 + q0 + qr) * IN_COLS + hq * 64 + c31;
#pragma unroll
                for (int dt = 0; dt < 2; ++dt) {
                    const float ga = bf2f(rowp[C_GA + 32 * dt]);
                    rowp[C_Q + 32 * dt] = f2bf(O[dt][r] * rd * siluf_(ga));
                }
            }
            WAVE_LDS_SYNC();
        }
        __syncthreads();
    }
}

constexpr int S5_NPOW = 11, S5_NINV = 9, S5_NSEG = 8, S5_SEGLEN = 256;
__device__ __forceinline__ f32x2_t cmul(f32x2_t a, f32x2_t b) { return (f32x2_t){a.x * b.x - a.y * b.y, a.x * b.y + a.y * b.x}; }

__device__ __forceinline__ void st_s5_tables2(KP p, const Ctx& c) {
    f32x2_t* POW = (f32x2_t*)(p->ws + WS_S5POW); f32x2_t* PINV = (f32x2_t*)(p->ws + WS_S5PINV);
    bf16_t* BCAT = (bf16_t*)(p->ws + WS_S5BCAT); bf16_t* CCAT = (bf16_t*)(p->ws + WS_S5CCAT);
    const float* BB = (const float*)(p->ws + WS_TAB + TAB_BB);
    for (size_t ii = c.gt; ii < (size_t)DEPTH * NG * NP; ii += c.ngt) {
        const int i = (int)ii, lg = i / NP, pp = i % NP;
        const double lr = (double)fminf(p->in[12][i], -1e-4f), li = (double)p->in[13][i];
        const double step = (double)expf(p->in[14][lg]);
        for (int k = 0; k < S5_NPOW + S5_NINV; ++k) {
            const int e = k < 9 ? k : (k == 9 ? 64 : (k == 10 ? 256 : -(k - S5_NPOW)));
            double t = (double)e * li * step * 0.15915494309189535; t -= rint(t);
            float sn, cs; sincosf((float)(t * 6.283185307179586), &sn, &cs);
            const float mag = expf((float)((double)e * lr * step));
            const f32x2_t v = {mag * cs, mag * sn};
            if (k < S5_NPOW) POW[((size_t)lg * S5_NPOW + k) * NP + pp] = v; else PINV[((size_t)lg * S5_NINV + (k - S5_NPOW)) * NP + pp] = v;
        }
    }
    for (size_t ii = c.gt; ii < (size_t)DEPTH * NG * 128 * NC; ii += c.ngt) {
        const int i = (int)ii, lg = i / (128 * NC), n = (i / NC) % 128, cc = i % NC, pp = n & 63;
        const int sidx = lg * NP + pp;
        const float lr = fminf(p->in[12][sidx], -1e-4f), li = p->in[13][sidx];
        const float step = expf(p->in[14][lg]);
        const float mag = expf(lr * step);
        float sn, cs; sincosf(li * step, &sn, &cs);
        const float ab_re = mag * cs, ab_im = mag * sn, den = lr * lr + li * li;
        const float f_re = ((ab_re - 1.0f) * lr + ab_im * li) / den, f_im = (ab_im * lr - (ab_re - 1.0f) * li) / den;
        const float bre = p->in[15][(size_t)sidx * NC + cc], bim = p->in[16][(size_t)sidx * NC + cc];
        BCAT[i] = f2bf(n < 64 ? f_re * bre - f_im * bim : f_re * bim + f_im * bre);
        const int c2 = (i / 128) % NC, n2 = i % 128, p2 = n2 & 63;
        const float cv = n2 < 64 ? p->in[17][((size_t)lg * NC + c2) * NP + p2] : -p->in[18][((size_t)lg * NC + c2) * NP + p2];
        CCAT[i] = f2bf(cv);
    }
}

__device__ __forceinline__ void s5_xtiles(f32x16 (&xr)[2], f32x16 (&xi)[2], const bf16x8 (&uf)[2], bf16x8 bre, bf16x8 bim) {
#pragma unroll
    for (int m = 0; m < 2; ++m) { xr[m] = MFMA32(uf[m], bre, (f32x16){}); xi[m] = MFMA32(uf[m], bim, (f32x16){}); }
}

__device__ __forceinline__ void st_s5_phaseA(KP p, int l, const Ctx& c) {
    const bf16_t* PROJ = (const bf16_t*)(p->ws + WS_PROJ);
    const f32x2_t* POW = (const f32x2_t*)(p->ws + WS_S5POW);
    const bf16_t* BCAT = (const bf16_t*)(p->ws + WS_S5BCAT);
    f32x2_t* SUM = (f32x2_t*)(p->ws + WS_S5SUM);
    const int lane = c.lane, c31 = lane & 31, h = lane >> 5;
    for (int item = c.gw; item < BATCH * S5_NSEG * NG; item += c.ngw) {
        const int g = item % NG, seg = (item / NG) % S5_NSEG, b = item / (NG * S5_NSEG);
        const int lg = l * NG + g;
        const size_t row0 = (size_t)b * SEQ + (size_t)seg * S5_SEGLEN;
#pragma unroll 1
        for (int pt = 0; pt < 2; ++pt) {
            const int pp = 32 * pt + c31;
            const f32x2_t* pw = POW + (size_t)lg * S5_NPOW * NP + pp;
            f32x2_t lo[4];
#pragma unroll
            for (int s = 0; s < 4; ++s) lo[s] = pw[(7 - 4 * h - s) * NP];
            const f32x2_t a8 = pw[8 * NP], a64 = pw[9 * NP];
            const bf16x8 bre = *(const bf16x8*)(BCAT + ((size_t)lg * 128 + pp) * NC + 8 * h);
            const bf16x8 bim = *(const bf16x8*)(BCAT + ((size_t)lg * 128 + 64 + pp) * NC + 8 * h);
            f32x2_t sseg = {0.f, 0.f};
#pragma unroll 1
            for (int ch = 0; ch < 4; ++ch) {
                bf16x8 uf[2];
#pragma unroll
                for (int m = 0; m < 2; ++m) uf[m] = *(const bf16x8*)(PROJ + (row0 + 64 * ch + 32 * m + c31) * IN_COLS + C_UB + 16 * g + 8 * h);
                f32x16 xr[2], xi[2];
                s5_xtiles(xr, xi, uf, bre, bim);
                f32x2_t f = {1.f, 0.f}, acc = {0.f, 0.f};
#pragma unroll
                for (int gi = 7; gi >= 0; --gi) {
                    const int m = gi >> 2, q = gi & 3;
                    f32x2_t t = {0.f, 0.f};
#pragma unroll
                    for (int s = 0; s < 4; ++s) { const f32x2_t x = {xr[m][4 * q + s], xi[m][4 * q + s]}; const f32x2_t w = cmul(lo[s], x); t.x += w.x; t.y += w.y; }
                    const f32x2_t w2 = cmul(f, t); acc.x += w2.x; acc.y += w2.y;
                    f = cmul(f, a8);
                }
                acc.x += __shfl_xor(acc.x, 32); acc.y += __shfl_xor(acc.y, 32);
                const f32x2_t d = cmul(a64, sseg); sseg.x = d.x + acc.x; sseg.y = d.y + acc.y;
            }
            if (h == 0) SUM[(((size_t)b * S5_NSEG + seg) * NG + g) * NP + pp] = sseg;
        }
    }
}

constexpr int S5_HT_STR = 144, S5_HT_BYTES = 64 * S5_HT_STR;
__device__ __forceinline__ void st_s5_phaseB(KP p, int l, const Ctx& c, LAS unsigned char* lds) {
    bf16_t* PROJ = (bf16_t*)(p->ws + WS_PROJ);
    const f32x2_t* POW = (const f32x2_t*)(p->ws + WS_S5POW); const f32x2_t* PINV = (const f32x2_t*)(p->ws + WS_S5PINV);
    const bf16_t* BCAT = (const bf16_t*)(p->ws + WS_S5BCAT); const bf16_t* CCAT = (const bf16_t*)(p->ws + WS_S5CCAT);
    const f32x2_t* SUM = (const f32x2_t*)(p->ws + WS_S5SUM);
    const int lane = c.lane, c31 = lane & 31, h = lane >> 5, i16 = lane & 15, kg = lane >> 4, qq = i16 >> 2, p4 = i16 & 3;
    LAS unsigned char* ht = lds + c.wave * S5_HT_BYTES;
    bf16x8 tdiag[2], tones;
#pragma unroll
    for (int s = 0; s < 2; ++s)
#pragma unroll
        for (int j = 0; j < 8; ++j) tdiag[s][j] = (16 * s + 8 * (j >> 2) + 4 * h + (j & 3) <= c31) ? (short)0x3F80 : (short)0;
#pragma unroll
    for (int j = 0; j < 8; ++j) tones[j] = (short)0x3F80;
    for (int item = c.gw; item < BATCH * S5_NSEG * NG; item += c.ngw) {
        const int g = item % NG, seg = (item / NG) % S5_NSEG, b = item / (NG * S5_NSEG);
        const int lg = l * NG + g;
        const size_t row0 = (size_t)b * SEQ + (size_t)seg * S5_SEGLEN;
        f32x2_t hin[2];
#pragma unroll
        for (int pt = 0; pt < 2; ++pt) {
            const int pp = 32 * pt + c31;
            const f32x2_t a256 = POW[((size_t)lg * S5_NPOW + 10) * NP + pp];
            f32x2_t H = {0.f, 0.f};
#pragma unroll
            for (int k = 0; k < S5_NSEG - 1; ++k) if (k < seg) { const f32x2_t sk = SUM[(((size_t)b * S5_NSEG + k) * NG + g) * NP + pp]; const f32x2_t d = cmul(a256, H); H.x = d.x + sk.x; H.y = d.y + sk.y; }
            hin[pt] = H;
        }
        const float dd = p->in[19][l * 512 + g * 16 + i16];
#pragma unroll 1
        for (int ch = 0; ch < 4; ++ch) {
            const size_t crow0 = row0 + 64 * ch;
            bf16x8 uf[2];
#pragma unroll
            for (int m = 0; m < 2; ++m) uf[m] = *(const bf16x8*)(PROJ + (crow0 + 32 * m + c31) * IN_COLS + C_UB + 16 * g + 8 * h);
            f32x4 Y[4];
#pragma unroll
            for (int it = 0; it < 4; ++it) Y[it] = (f32x4){0.f, 0.f, 0.f, 0.f};
#pragma unroll
            for (int pt = 0; pt < 2; ++pt) {
                const int pp = 32 * pt + c31;
                const bf16x8 bre = *(const bf16x8*)(BCAT + ((size_t)lg * 128 + pp) * NC + 8 * h);
                const bf16x8 bim = *(const bf16x8*)(BCAT + ((size_t)lg * 128 + 64 + pp) * NC + 8 * h);
                const f32x2_t* pw = POW + (size_t)lg * S5_NPOW * NP + pp; const f32x2_t* pi = PINV + (size_t)lg * S5_NINV * NP + pp;
                asm volatile("" : "+v"(pw), "+v"(pi));
                f32x2_t ilo[4], plo[4];
#pragma unroll
                for (int s = 0; s < 4; ++s) { ilo[s] = pi[(4 * h + s) * NP]; plo[s] = pw[(4 * h + s) * NP]; }
                const f32x2_t ia8 = pi[8 * NP], a8 = pw[8 * NP], a1 = pw[1 * NP];
                bf16x8 wfr[2][2], wfi[2][2];
                {
                    f32x2_t f = {1.f, 0.f};
#pragma unroll
                    for (int m = 0; m < 2; ++m) {
                        f32x16 xr = MFMA32(uf[m], bre, (f32x16){}), xi = MFMA32(uf[m], bim, (f32x16){});
#pragma unroll
                        for (int q = 0; q < 4; ++q) {
#pragma unroll
                            for (int s = 0; s < 4; ++s) { const f32x2_t x = {xr[4 * q + s], xi[4 * q + s]}; const f32x2_t w = cmul(f, cmul(ilo[s], x)); xr[4 * q + s] = w.x; xi[4 * q + s] = w.y; }
                            f = cmul(f, ia8);
                        }
#pragma unroll
                        for (int s2 = 0; s2 < 2; ++s2) {
                            wfr[m][s2] = pack8(xr[8 * s2], xr[8 * s2 + 1], xr[8 * s2 + 2], xr[8 * s2 + 3], xr[8 * s2 + 4], xr[8 * s2 + 5], xr[8 * s2 + 6], xr[8 * s2 + 7]);
                            wfi[m][s2] = pack8(xi[8 * s2], xi[8 * s2 + 1], xi[8 * s2 + 2], xi[8 * s2 + 3], xi[8 * s2 + 4], xi[8 * s2 + 5], xi[8 * s2 + 6], xi[8 * s2 + 7]);
                        }
                        __builtin_amdgcn_sched_barrier(0);
                    }
                }
                const f32x2_t G = cmul(a1, hin[pt]);
                f32x2_t hlast = {0.f, 0.f};
                WAVE_LDS_SYNC();
                {
                    f32x2_t f = {1.f, 0.f};
#pragma unroll
                    for (int m = 0; m < 2; ++m) {
                        f32x16 cr, ci;
                        if (m == 0) { cr = MFMA32(tdiag[1], wfr[0][1], MFMA32(tdiag[0], wfr[0][0], (f32x16){})); ci = MFMA32(tdiag[1], wfi[0][1], MFMA32(tdiag[0], wfi[0][0], (f32x16){})); }
                        else { cr = MFMA32(tdiag[1], wfr[1][1], MFMA32(tdiag[0], wfr[1][0], MFMA32(tones, wfr[0][1], MFMA32(tones, wfr[0][0], (f32x16){}))));
                               ci = MFMA32(tdiag[1], wfi[1][1], MFMA32(tdiag[0], wfi[1][0], MFMA32(tones, wfi[0][1], MFMA32(tones, wfi[0][0], (f32x16){})))); }
#pragma unroll
                        for (int q = 0; q < 4; ++q) {
                            float hr[4], hi[4];
#pragma unroll
                            for (int s = 0; s < 4; ++s) { const f32x2_t v = {cr[4 * q + s] + G.x, ci[4 * q + s] + G.y}; const f32x2_t w = cmul(f, cmul(plo[s], v)); hr[s] = w.x; hi[s] = w.y; }
                            if (m == 1 && q == 3) { hlast.x = hr[3]; hlast.y = hi[3]; }
                            typedef unsigned u32x2_t __attribute__((ext_vector_type(2)));
                            u32x2_t wr_; wr_.x = cvtpk(hr[0], hr[1]); wr_.y = cvtpk(hr[2], hr[3]);
                            u32x2_t wi_; wi_.x = cvtpk(hi[0], hi[1]); wi_.y = cvtpk(hi[2], hi[3]);
                            *(LAS u32x2_t*)(ht + c31 * S5_HT_STR + (32 * m + 8 * q + 4 * h) * 2) = wr_;
                            *(LAS u32x2_t*)(ht + (32 + c31) * S5_HT_STR + (32 * m + 8 * q + 4 * h) * 2) = wi_;
                            f = cmul(f, a8);
                        }
                        __builtin_amdgcn_sched_barrier(0);
                    }
                }
                hin[pt].x = __shfl(hlast.x, c31 + 32); hin[pt].y = __shfl(hlast.y, c31 + 32);
                WAVE_LDS_SYNC();
#pragma unroll
                for (int ks = 0; ks < 2; ++ks) {
                    const bf16x8 cf = *(const bf16x8*)(CCAT + ((size_t)lg * NC + i16) * 128 + 64 * ks + 32 * pt + 8 * kg);
#pragma unroll
                    for (int it = 0; it < 4; ++it) {
                        LAS const unsigned char* ap = ht + (32 * ks + 8 * kg + qq) * S5_HT_STR + (16 * it + 4 * p4) * 2;
                        const bf16x8 af = cat8(tr_read(ap), tr_read(ap + 4 * S5_HT_STR));
                        Y[it] = MFMA16(af, cf, Y[it]);
                    }
                }
            }
#pragma unroll
            for (int it = 0; it < 4; ++it)
#pragma unroll
                for (int r = 0; r < 4; ++r) {
                    bf16_t* up = PROJ + (crow0 + 16 * it + 4 * kg + r) * IN_COLS + C_UB + 16 * g + i16;
                    const float y = Y[it][r] + dd * bf2f(*up);
                    *up = f2bf(gelu_tanh(y));
                }
        }
        if (seg == S5_NSEG - 1 && h == 0) {
#pragma unroll
            for (int pt = 0; pt < 2; ++pt) { const size_t oi = (((size_t)l * BATCH + b) * NG + g) * NP + 32 * pt + c31; p->out[O_SRP + oi] = hin[pt].x; p->out[O_SIP + oi] = hin[pt].y; }
        }
    }
}

__device__ __forceinline__ void st_s5_simple(KP p, int l, const Ctx& c, LAS float* wsm) {
    bf16_t* PROJ = (bf16_t*)(p->ws + WS_PROJ);
    const float* AB = (const float*)(p->ws + WS_TAB + TAB_AB);
    const float* BB = (const float*)(p->ws + WS_TAB + TAB_BB);
    const int pp = c.lane;
    for (int item = c.gw; item < DEC_BATCH * NG; item += c.ngw) {
        const int seq = BATCH + item / NG, g = item % NG;
        const bool samp = seq >= BATCH;
        const int b = samp ? seq - BATCH : seq, T = samp ? DEC_SEQ : SEQ;
        const size_t row0 = samp ? (size_t)M_P + b * DEC_SEQ : (size_t)b * SEQ;
        const int sidx = (l * NG + g) * NP + pp;
        const float ab_re = AB[2 * sidx], ab_im = AB[2 * sidx + 1];
        float bbr[16], bbi[16], cr[16], ci[16];
#pragma unroll
        for (int cc = 0; cc < 16; ++cc) {
            bbr[cc] = BB[((size_t)sidx * NC + cc) * 2]; bbi[cc] = BB[((size_t)sidx * NC + cc) * 2 + 1];
            cr[cc] = p->in[17][((size_t)(l * NG + g) * NC + cc) * NP + pp]; ci[cc] = p->in[18][((size_t)(l * NG + g) * NC + cc) * NP + pp];
        }
        const float dd = pp < 16 ? p->in[19][l * 512 + g * 16 + pp] : 0.f;
        float hr = 0.f, hi = 0.f;
        if (samp) { const size_t si = (((size_t)l * DEC_BATCH + b) * NG + g) * NP + pp; hr = p->in[4][si]; hi = p->in[5][si]; }
        for (int t = 0; t < T; ++t) {
            bf16_t* up = PROJ + (row0 + t) * IN_COLS + C_UB + g * 16;
            float u[16];
#pragma unroll
            for (int cc = 0; cc < 16; ++cc) u[cc] = bf2f(up[cc]);
            float xr = 0.f, xi = 0.f;
#pragma unroll
            for (int cc = 0; cc < 16; ++cc) { xr += bbr[cc] * u[cc]; xi += bbi[cc] * u[cc]; }
            const float nr = ab_re * hr - ab_im * hi + xr, ni = ab_re * hi + ab_im * hr + xi;
            hr = nr; hi = ni;
#pragma unroll
            for (int cc = 0; cc < 16; ++cc) wsm[pp * 17 + cc] = cr[cc] * hr - ci[cc] * hi;
            WAVE_LDS_SYNC();
            if (pp < 16) {
                float y = 0.f;
                for (int q = 0; q < 64; ++q) y += wsm[q * 17 + pp];
                y += dd * bf2f(up[pp]);
                up[pp] = f2bf(gelu_tanh(y));
            }
            WAVE_LDS_SYNC();
        }
        if (!samp) { const size_t oi = (((size_t)l * BATCH + b) * NG + g) * NP + pp; p->out[O_SRP + oi] = hr; p->out[O_SIP + oi] = hi; }
        else { const size_t oi = (((size_t)l * DEC_BATCH + b) * NG + g) * NP + pp; p->out[O_SRS + oi] = hr; p->out[O_SIS + oi] = hi; }
    }
}

struct EpiGlu { bf16_t* PROJ; __device__ void operator()(int r, int c, float v) const {
    const float z = bf2f(PROJ[(size_t)r * IN_COLS + C_UB + c]), gb = bf2f(PROJ[(size_t)r * IN_COLS + C_GB + c]);
    PROJ[(size_t)r * IN_COLS + C_GB + c] = f2bf(z * sigmoidf_(v) * siluf_(gb)); } };

constexpr int LR_NSEG = 32;
__device__ __forceinline__ float neg_expm1_small(float y) {
    float q = 1.0f / 5040.0f; q = q * y + 1.0f / 720.0f; q = q * y + 1.0f / 120.0f; q = q * y + 1.0f / 24.0f; q = q * y + 1.0f / 6.0f; q = q * y + 0.5f; q = q * y + 1.0f; return -(q * y);
}
template <bool PHASE_B>
__device__ __forceinline__ void st_lru_mfma(KP p, int l, const Ctx& c, LAS unsigned char* lds) {
    bf16_t* PROJ = (bf16_t*)(p->ws + WS_PROJ);
    const bf16_t* LRUW = (const bf16_t*)(p->ws + WS_LRUW);
    f32x2_t* LSUM = (f32x2_t*)(p->ws + WS_LRSUM);
    for (int item = c.gw; item < BATCH * LR_NSEG * 8; item += c.ngw) {
        int zi = 0; asm volatile("" : "+v"(zi));
        const int lane = c.lane + zi, c31 = lane & 31, h = lane >> 5;
        const int n = item & 7, seg = (item >> 3) % LR_NSEG, b = item / (8 * LR_NSEG);
        const size_t row0 = (size_t)b * SEQ + (size_t)seg * 64;
        const int ch0 = n * 64;
        LAS unsigned char* xim = lds + c.wave * 9216;
        WAVE_LDS_SYNC();
#pragma unroll 1
        for (int ks = 0; ks < 4; ++ks) {
            const int chb = ch0 + 16 * ks + 8 * h;
            float w[4][8], cb[8];
#pragma unroll
            for (int j = 0; j < 4; ++j) {
                const f32x4 w0 = *(const f32x4*)(p->in[22] + (l * 4 + j) * 512 + chb), w1 = *(const f32x4*)(p->in[22] + (l * 4 + j) * 512 + chb + 4);
                w[j][0] = w0[0]; w[j][1] = w0[1]; w[j][2] = w0[2]; w[j][3] = w0[3]; w[j][4] = w1[0]; w[j][5] = w1[1]; w[j][6] = w1[2]; w[j][7] = w1[3];
            }
            { const f32x4 b0 = *(const f32x4*)(p->in[23] + l * 512 + chb), b1 = *(const f32x4*)(p->in[23] + l * 512 + chb + 4);
              cb[0] = b0[0]; cb[1] = b0[1]; cb[2] = b0[2]; cb[3] = b0[3]; cb[4] = b1[0]; cb[5] = b1[1]; cb[6] = b1[2]; cb[7] = b1[3]; }
#pragma unroll
            for (int m = 0; m < 2; ++m) {
                const int t = seg * 64 + 32 * m + c31;
                float xf[8];
#pragma unroll
                for (int e = 0; e < 8; ++e) xf[e] = cb[e];
#pragma unroll
                for (int j = 0; j < 4; ++j) {
                    u32x4 xx = (u32x4){0u, 0u, 0u, 0u};
                    if (t - 3 + j >= 0) xx = *(const u32x4*)(PROJ + (row0 + 32 * m + c31 - 3 + j) * IN_COLS + C_XC + chb);
#pragma unroll
                    for (int e = 0; e < 4; ++e) { xf[2 * e] += w[j][2 * e] * __uint_as_float(xx[e] << 16); xf[2 * e + 1] += w[j][2 * e + 1] * __uint_as_float(xx[e] & 0xffff0000u); }
                }
                *(LAS bf16x8*)(xim + (32 * m + c31) * 144 + (16 * ks + 8 * h) * 2) = pack8(xf[0], xf[1], xf[2], xf[3], xf[4], xf[5], xf[6], xf[7]);
            }
        }
        WAVE_LDS_SYNC();
#pragma unroll 1
        for (int et = 0; et < 2; ++et) {
            const int ch = ch0 + 32 * et + c31;
            const float ba = p->in[25][l * 512 + ch], bx = p->in[27][l * 512 + ch], lam = p->in[28][l * 512 + ch];
            const float lsig8 = -8.0f * log1pf(expf(-lam));
            const bf16_t* wp = LRUW + (((size_t)(l * 8 + n) * 2) * 64 + 32 * et + c31) * 64 + 8 * h;
            f32x16 R[2], I[2];
            float Ar[8], Br[8];
            __builtin_amdgcn_sched_barrier(0);
#pragma unroll
            for (int m = 0; m < 2; ++m) {
                f32x16 X = (f32x16){}; R[m] = (f32x16){}; I[m] = (f32x16){};
#pragma unroll
                for (int ks = 0; ks < 4; ++ks) {
                    const bf16x8 wa = *(const bf16x8*)(wp + 16 * ks), wx = *(const bf16x8*)(wp + 64 * 64 + 16 * ks);
                    bf16x8 id;
#pragma unroll
                    for (int j = 0; j < 8; ++j) id[j] = (16 * ks + 8 * h + j == 32 * et + c31) ? (short)0x3F80 : (short)0;
                    const bf16x8 afr = *(LAS const bf16x8*)(xim + (32 * m + c31) * 144 + (16 * ks + 8 * h) * 2);
                    R[m] = MFMA32(afr, wa, R[m]); I[m] = MFMA32(afr, wx, I[m]); X = MFMA32(afr, id, X);
                }
#pragma unroll
                for (int q = 0; q < 4; ++q) {
                    float cp = 1.f, hl = 0.f;
#pragma unroll
                    for (int s = 0; s < 4; ++s) {
                        const int r = 4 * q + s;
                        const float rg = sigmoidf_(R[m][r] + ba), ig = sigmoidf_(I[m][r] + bx);
                        const float la = rg * lsig8;
                        const float a = __expf(la);
                        const float bg = X[r] * ig * sqrtf(neg_expm1_small(2.0f * la));
                        cp *= a; hl = a * hl + bg;
                        R[m][r] = cp; I[m][r] = hl;
                    }
                    Ar[4 * m + q] = cp; Br[4 * m + q] = hl;
                }
                __builtin_amdgcn_sched_barrier(0);
            }
            float Hc = 0.f;
            if (PHASE_B) {
                for (int k0 = 0; k0 < seg; k0 += 8) {
                    f32x2_t ab[8];
#pragma unroll
                    for (int j = 0; j < 8; ++j) ab[j] = (k0 + j < seg) ? LSUM[((size_t)b * LR_NSEG + k0 + j) * 512 + ch] : (f32x2_t){1.f, 0.f};
#pragma unroll
                    for (int j = 0; j < 8; ++j) Hc = ab[j].x * Hc + ab[j].y;
                }
            }
            float st = Hc, At = 1.f, cin[8];
#pragma unroll
            for (int gi = 0; gi < 8; ++gi) {
                const float Ao = __shfl_xor(Ar[gi], 32), Bo = __shfl_xor(Br[gi], 32);
                const float A0 = h == 0 ? Ar[gi] : Ao, B0 = h == 0 ? Br[gi] : Bo, A1 = h == 0 ? Ao : Ar[gi], B1 = h == 0 ? Bo : Br[gi];
                const float s1 = A0 * st + B0;
                cin[gi] = h == 0 ? st : s1;
                st = A1 * s1 + B1; At *= A0 * A1;
            }
            if (!PHASE_B) {
                if (h == 0) LSUM[((size_t)b * LR_NSEG + seg) * 512 + ch] = (f32x2_t){At, st};
            } else {
#pragma unroll
                for (int m = 0; m < 2; ++m)
#pragma unroll
                    for (int r = 0; r < 16; ++r) {
                        const float hv = I[m][r] + R[m][r] * cin[4 * m + (r >> 2)];
                        bf16_t* gp = PROJ + (row0 + 32 * m + (r & 3) + 8 * (r >> 2) + 4 * h) * IN_COLS + C_GC + ch;
                        const float gc = bf2f(*gp);
                        *gp = f2bf(hv * siluf_(gc));
                        if (m == 1 && r == 15 && h == 1 && seg == LR_NSEG - 1) p->out[O_LP + ((size_t)l * BATCH + b) * 512 + ch] = hv;
                    }
            }
        }
    }
}

__device__ __forceinline__ void st_lru_simple(KP p, int l, const Ctx& c, LAS float* wsm) {
    bf16_t* PROJ = (bf16_t*)(p->ws + WS_PROJ);
    const int e = c.lane;
    for (int item = c.gw; item < DEC_BATCH * 8; item += c.ngw) {
        const int seq = BATCH + item / 8, n = item % 8, ch = n * 64 + e;
        const bool samp = seq >= BATCH;
        const int b = samp ? seq - BATCH : seq, T = samp ? DEC_SEQ : SEQ;
        const size_t row0 = samp ? (size_t)M_P + b * DEC_SEQ : (size_t)b * SEQ;
        float wa[64], wx[64];
#pragma unroll
        for (int d = 0; d < 64; ++d) { wa[d] = p->in[24][(((size_t)l * 8 + n) * 64 + d) * 64 + e]; wx[d] = p->in[26][(((size_t)l * 8 + n) * 64 + d) * 64 + e]; }
        const float ba = p->in[25][l * 512 + ch], bx = p->in[27][l * 512 + ch], lam = p->in[28][l * 512 + ch];
        const float lsig = -log1pf(expf(-lam));
        const float cw0 = p->in[22][(l * 4 + 0) * 512 + ch], cw1 = p->in[22][(l * 4 + 1) * 512 + ch], cw2 = p->in[22][(l * 4 + 2) * 512 + ch], cw3 = p->in[22][(l * 4 + 3) * 512 + ch];
        const float cb = p->in[23][l * 512 + ch];
        float xm3 = 0.f, xm2 = 0.f, xm1 = 0.f, h = 0.f;
        if (samp) {
            const size_t ci = (((size_t)l * DEC_BATCH + b) * 3) * 512 + ch;
            xm3 = p->in[7][ci]; xm2 = p->in[7][ci + 512]; xm1 = p->in[7][ci + 1024];
            h = p->in[6][((size_t)l * DEC_BATCH + b) * 512 + ch];
        }
        for (int t = 0; t < T; ++t) {
            bf16_t* rp = PROJ + (row0 + t) * IN_COLS;
            const float xc = bf2f(rp[C_XC + ch]);
            const float xf = cb + cw0 * xm3 + cw1 * xm2 + cw2 * xm1 + cw3 * xc;
            xm3 = xm2; xm2 = xm1; xm1 = xc;
            wsm[e] = xf;
            WAVE_LDS_SYNC();
            float r = ba, i = bx;
#pragma unroll
            for (int d = 0; d < 64; ++d) { const float xv = wsm[d]; r += xv * wa[d]; i += xv * wx[d]; }
            WAVE_LDS_SYNC();
            r = sigmoidf_(r); i = sigmoidf_(i);
            const float log_a = 8.0f * r * lsig;
            const float a = expf(log_a);
            const float bt = xf * i * sqrtf(-expm1f(2.0f * log_a));
            h = a * h + bt;
            const float gc = bf2f(rp[C_GC + ch]);
            rp[C_GC + ch] = f2bf(h * siluf_(gc));
        }
        if (!samp) {
            p->out[O_LP + ((size_t)l * BATCH + b) * 512 + ch] = h;
            const size_t ci = (((size_t)l * BATCH + b) * 3) * 512 + ch;
            p->out[O_CP + ci] = xm3; p->out[O_CP + ci + 512] = xm2; p->out[O_CP + ci + 1024] = xm1;
        } else {
            p->out[O_LS + ((size_t)l * DEC_BATCH + b) * 512 + ch] = h;
            const size_t ci = (((size_t)l * DEC_BATCH + b) * 3) * 512 + ch;
            p->out[O_CS + ci] = xm3; p->out[O_CS + ci + 512] = xm2; p->out[O_CS + ci + 1024] = xm1;
        }
    }
}

__device__ __forceinline__ void st_branch_simple(KP p, int l, const Ctx& c) {
    bf16_t* PROJ = (bf16_t*)(p->ws + WS_PROJ);
    const bf16_t* WB = (const bf16_t*)((unsigned char*)p->out + DO_WBR) + (size_t)l * 3 * 1024 * 512;
    const int lane = c.lane;
    const int ntn = 1024 / 32, ntiles = (M_TOT / 32) * ntn;
    for (int tile = c.gw; tile < ntiles; tile += c.ngw) {
        const int tm = tile / ntn, tn = tile % ntn;
        f32x16 acc[3];
#pragma unroll
        for (int br = 0; br < 3; ++br) {
            const int acol = br == 0 ? C_Q : (br == 1 ? C_GB : C_XC);
            acc[br] = (f32x16){};
            const bf16_t* ar = PROJ + (size_t)(tm * 32 + (lane & 31)) * IN_COLS + acol + 8 * (lane >> 5);
            const bf16_t* bp = WB + (size_t)br * 1024 * 512 + (size_t)(tn * 32 + (lane & 31)) * 512 + 8 * (lane >> 5);
            for (int k0 = 0; k0 < 512; k0 += 16)
                acc[br] = __builtin_amdgcn_mfma_f32_32x32x16_bf16(*(const bf16x8*)(ar + k0), *(const bf16x8*)(bp + k0), acc[br], 0, 0, 0);
        }
#pragma unroll
        for (int r = 0; r < 16; ++r) {
            const int row = tm * 32 + (r & 3) + 8 * (r >> 2) + 4 * (lane >> 5), col = tn * 32 + (lane & 31);
            bf16_t* gp = PROJ + (size_t)row * IN_COLS + C_GM + col;
            const float m = sigmoidf_(bf2f(gp[0])) * acc[0][r] + sigmoidf_(bf2f(gp[1024])) * acc[1][r] + sigmoidf_(bf2f(gp[2048])) * acc[2][r];
            gp[0] = f2bf(m);
        }
    }
}

__device__ __forceinline__ float* pre_row(unsigned char* ws, int r) { return (float*)(ws + WS_PROJ + (size_t)r * IN_COLS * 2 + (size_t)(C_GM + 1024) * 2); }
struct EpiOut { KP p; int l; __device__ void operator()(int r, int c, float v) const {
    float x;
    if (l == 0) x = r < M_P ? p->in[0][(size_t)r * D_MODEL + c] : p->in[1][(size_t)(r - M_P) * D_MODEL + c];
    else x = bf2f(((const bf16_t*)(p->ws + WS_XB))[(size_t)r * D_MODEL + c]);
    pre_row(p->ws, r)[c] = DN_ALPHA * x + v; } };

__device__ __forceinline__ void st_ln(KP p, int l, const Ctx& c) {
    const int lane = c.lane;
    const float* g = p->in[31] + l * 1024; const float* bb = p->in[32] + l * 1024;
    for (int r = c.gw; r < M_TOT; r += c.ngw) {
        const float* pr = pre_row(p->ws, r);
        float v[16]; float s = 0.f;
#pragma unroll
        for (int j = 0; j < 16; ++j) { v[j] = pr[lane + 64 * j]; s += v[j]; }
        for (int o = 32; o > 0; o >>= 1) s += __shfl_xor(s, o);
        const float mu = s * (1.0f / 1024.0f);
        float q = 0.f;
#pragma unroll
        for (int j = 0; j < 16; ++j) { const float d = v[j] - mu; q += d * d; }
        for (int o = 32; o > 0; o >>= 1) q += __shfl_xor(q, o);
        const float rstd = rsqrtf(q * (1.0f / 1024.0f) + LN_EPS);
#pragma unroll
        for (int j = 0; j < 16; ++j) {
            const int cc = lane + 64 * j;
            const float y = (v[j] - mu) * rstd * g[cc] + bb[cc];
            if (l == 0) ((bf16_t*)(p->ws + WS_XB))[(size_t)r * D_MODEL + cc] = f2bf(y);
            else if (r < M_P) p->out[O_YP + (size_t)r * D_MODEL + cc] = y;
            else p->out[O_YS + (size_t)(r - M_P) * D_MODEL + cc] = y;
        }
    }
}

__global__ void __launch_bounds__(NTHREADS, 2) mega_fwd(P p_unused) {
    extern __shared__ __attribute__((aligned(16))) unsigned char lds_raw[];
    LAS unsigned char* lds = (LAS unsigned char*)lds_raw;
    volatile LAS unsigned* misc = (volatile LAS unsigned*)(lds + LDS_MISC);
    if (threadIdx.x < 32) misc[threadIdx.x] = 0u;
    __syncthreads();
    XcdBarrier bar;
    { KP p = get_kp(); bar = xcd_barrier_post((unsigned*)(p->ws + WS_CTL), misc); }

    { KP p = get_kp(); const Ctx c = make_ctx(); unsigned char* dob = (unsigned char*)p->out;
      st_convert_x(p, c);
      for (int l = 0; l < DEPTH; ++l) {
        st_transpose_w(p->in[9] + (size_t)l * 1024 * IN_COLS, (bf16_t*)(dob + DO_WIN) + (size_t)l * IN_COLS * 1024, 1024, IN_COLS, c);
        st_transpose_w(p->in[11] + (size_t)l * 512 * 1024, (bf16_t*)(dob + DO_WBR) + ((size_t)l * 3 + 0) * 1024 * 512, 512, 1024, c);
        st_transpose_w(p->in[21] + (size_t)l * 512 * 1024, (bf16_t*)(dob + DO_WBR) + ((size_t)l * 3 + 1) * 1024 * 512, 512, 1024, c);
        st_transpose_w(p->in[29] + (size_t)l * 512 * 1024, (bf16_t*)(dob + DO_WBR) + ((size_t)l * 3 + 2) * 1024 * 512, 512, 1024, c);
        st_transpose_w(p->in[20] + (size_t)l * 512 * 512, (bf16_t*)(dob + DO_WGLU) + (size_t)l * 512 * 512, 512, 512, c);
        st_transpose_w(p->in[30] + (size_t)l * 1024 * 1024, (bf16_t*)(p->ws + WS_WOUT) + (size_t)l * 1024 * 1024, 1024, 1024, c);
      }
      st_s5_tables(p, c); st_s5_tables2(p, c);
      { bf16_t* LRUW = (bf16_t*)(p->ws + WS_LRUW);
        for (size_t i = c.gt; i < (size_t)DEPTH * 8 * 2 * 64 * 64; i += c.ngt) {
            const int d = (int)(i & 63), e = (int)((i >> 6) & 63), mat = (int)((i >> 12) & 1), ln = (int)(i >> 13);
            LRUW[i] = f2bf(p->in[mat ? 26 : 24][((size_t)ln * 64 + d) * 64 + e]); } } }
    xcd_barrier(bar);

    for (int l = 0; l < DEPTH; ++l) {
        { KP p = get_kp(); int zs = 0; asm volatile("" : "+s"(zs));
          pg8::Gemm g{(const bf16_t*)(p->ws + WS_XB), D_MODEL, (const bf16_t*)((unsigned char*)p->out + DO_WIN) + (size_t)l * IN_COLS * 1024, 1024};
          pg8::StaticOrder S; S.init(M_TOT, IN_COLS, (int)gridDim.x + zs, (int)blockIdx.x + zs);
          pg8::gemm_phase<pg8::EpiProjB, pg8::StaticOrder, true, true>(lds, g, S, pg8::EpiProjB{(bf16_t*)(p->ws + WS_PROJ), IN_COLS}); }
        xcd_barrier(bar);
        { KP p = get_kp(); const Ctx c = make_ctx(); LAS float* wsm = (LAS float*)(lds + c.wave * 8192);
          st_kv_out(p, l, c);
          st_s5_simple(p, l, c, wsm);
          st_lru_simple(p, l, c, wsm);
          st_attn_simple(p, l, c);
          st_s5_phaseA(p, l, c);
          st_lru_mfma<false>(p, l, c, lds); }
        __syncthreads();
        { KP p = get_kp(); st_attn_prompt(p, l, lds); }
        xcd_barrier(bar);
        { KP p = get_kp(); const Ctx c = make_ctx(); st_s5_phaseB(p, l, c, lds); }
        { KP p = get_kp(); const Ctx c = make_ctx(); st_lru_mfma<true>(p, l, c, lds); }
        xcd_barrier(bar);
        { KP p = get_kp(); int zs = 0; asm volatile("" : "+s"(zs)); bf16_t* PROJ = (bf16_t*)(p->ws + WS_PROJ);
          pg8::Gemm g{PROJ + C_UB, IN_COLS, (const bf16_t*)((unsigned char*)p->out + DO_WGLU) + (size_t)l * 512 * 512, 512};
          pg8::StaticOrder S; S.init(M_TOT, 512, (int)gridDim.x + zs, (int)blockIdx.x + zs);
          pg8::gemm_phase<pg8::EpiGluB, pg8::StaticOrder, true, true>(lds, g, S, pg8::EpiGluB{PROJ}); }
        xcd_barrier(bar);
        { KP p = get_kp(); int zs = 0; asm volatile("" : "+s"(zs)); bf16_t* PROJ = (bf16_t*)(p->ws + WS_PROJ);
          pg8::Gemm g{PROJ, IN_COLS, (const bf16_t*)((unsigned char*)p->out + DO_WBR) + (size_t)l * 3 * 1024 * 512, 512};
          pg8::BranchOrder S; S.init(M_TOT, 1024, (int)gridDim.x + zs, (int)blockIdx.x + zs);
          pg8::gemm_phase<pg8::EpiBranchB, pg8::BranchOrder, true, true>(lds, g, S, pg8::EpiBranchB{PROJ}); }
        xcd_barrier(bar);
        { KP p = get_kp(); int zs = 0; asm volatile("" : "+s"(zs)); bf16_t* PROJ = (bf16_t*)(p->ws + WS_PROJ);
          pg8::Gemm g{PROJ + C_GM, IN_COLS, (const bf16_t*)(p->ws + WS_WOUT) + (size_t)l * 1024 * 1024, 1024};
          pg8::StaticOrder S; S.init(M_TOT, 1024, (int)gridDim.x + zs, (int)blockIdx.x + zs);
          pg8::gemm_phase<pg8::EpiOutB, pg8::StaticOrder, true, true>(lds, g, S, pg8::EpiOutB{p->in[0], p->in[1], (const bf16_t*)(p->ws + WS_XB), p->ws, l}); }
        xcd_barrier(bar);
        { KP p = get_kp(); const Ctx c = make_ctx(); st_ln(p, l, c); }
        if (l + 1 < DEPTH) xcd_barrier(bar);
    }
}

extern "C" void kernel_launch(void* const* d_in, const int* in_sizes, int n_in, void* d_out, int out_size, void* d_ws, size_t ws_size, hipStream_t stream) {
    static int grid = 0;
    if (grid == 0) {
        if (n_in != 33 || (size_t)out_size != O_END || ws_size < WS_CTL + CTL_BYTES) { fprintf(stderr, "kernel_launch: unexpected sizes n_in %d out %d ws %zu\n", n_in, out_size, ws_size); grid = -1; return; }
        int dev = 0, cus = 0, per_cu = 0;
        if (hipGetDevice(&dev) != hipSuccess || hipDeviceGetAttribute(&cus, hipDeviceAttributeMultiprocessorCount, dev) != hipSuccess) { grid = -1; return; }
        if (hipFuncSetAttribute((const void*)mega_fwd, hipFuncAttributeMaxDynamicSharedMemorySize, LDS_BYTES) != hipSuccess) { fprintf(stderr, "kernel_launch: hipFuncSetAttribute failed\n"); grid = -1; return; }
        if (hipOccupancyMaxActiveBlocksPerMultiprocessor(&per_cu, (const void*)mega_fwd, NTHREADS, LDS_BYTES) != hipSuccess || per_cu < 1) { fprintf(stderr, "kernel_launch: occupancy query says %d blocks/CU\n", per_cu); grid = -1; return; }
        grid = cus;
    }
    if (grid < 0) return;
    (void)hipMemsetAsync((unsigned char*)d_ws + WS_CTL, 0, CTL_BYTES, stream);
    P p{};
    for (int i = 0; i < 33; ++i) p.in[i] = (const float*)d_in[i];
    p.out = (float*)d_out; p.ws = (unsigned char*)d_ws;
    void* args[] = {&p};
    hipError_t e = hipLaunchCooperativeKernel((const void*)mega_fwd, dim3(grid), dim3(NTHREADS), args, LDS_BYTES, stream);
    if (e != hipSuccess) fprintf(stderr, "kernel_launch: cooperative launch failed: %s (grid %d)\n", hipGetErrorString(e), grid);
}
```

```cpp
#include <hip/hip_runtime.h>
#include <cstdint>
#include <cstdio>

typedef unsigned short bf16_t;
typedef short bf16x8 __attribute__((ext_vector_type(8)));
typedef float f32x16 __attribute__((ext_vector_type(16)));
typedef float f32x4 __attribute__((ext_vector_type(4)));

constexpr int D_MODEL = 1024, BATCH = 8, SEQ = 2048, DEPTH = 2, DEC_BATCH = 128, DEC_SEQ = 4;
constexpr int M_P = BATCH * SEQ;
constexpr int M_S = DEC_BATCH * DEC_SEQ;
constexpr int M_TOT = M_P + M_S;
constexpr int IN_COLS = 6400;
constexpr int C_Q = 0, C_K = 512, C_V = 640, C_GA = 768, C_UB = 1280, C_GB = 1792, C_XC = 2304, C_GC = 2816, C_GM = 3328;
constexpr int WINDOW = 128, NKV = 2, HD = 64, NQH = 8;
constexpr int NG = 32, NP = 64, NC = 16;
constexpr float DN_ALPHA = 1.4142135623730951f;
constexpr float LN_EPS = 1e-5f;

constexpr size_t O_YP = 0;
constexpr size_t O_YS = O_YP + (size_t)M_P * D_MODEL;
constexpr size_t O_KP = O_YS + (size_t)M_S * D_MODEL;
constexpr size_t SZ_KP = (size_t)DEPTH * BATCH * WINDOW * NKV * HD;
constexpr size_t O_VP = O_KP + SZ_KP;
constexpr size_t O_SRP = O_VP + SZ_KP;
constexpr size_t SZ_SP = (size_t)DEPTH * BATCH * NG * NP;
constexpr size_t O_SIP = O_SRP + SZ_SP;
constexpr size_t O_LP = O_SIP + SZ_SP;
constexpr size_t SZ_LP = (size_t)DEPTH * BATCH * 512;
constexpr size_t O_CP = O_LP + SZ_LP;
constexpr size_t SZ_CP = (size_t)DEPTH * BATCH * 3 * 512;
constexpr size_t O_KS = O_CP + SZ_CP;
constexpr size_t SZ_KS = (size_t)DEPTH * DEC_BATCH * WINDOW * NKV * HD;
constexpr size_t O_VS = O_KS + SZ_KS;
constexpr size_t O_SRS = O_VS + SZ_KS;
constexpr size_t SZ_SS = (size_t)DEPTH * DEC_BATCH * NG * NP;
constexpr size_t O_SIS = O_SRS + SZ_SS;
constexpr size_t O_LS = O_SIS + SZ_SS;
constexpr size_t SZ_LS = (size_t)DEPTH * DEC_BATCH * 512;
constexpr size_t O_CS = O_LS + SZ_LS;
constexpr size_t SZ_CS = (size_t)DEPTH * DEC_BATCH * 3 * 512;
constexpr size_t O_END = O_CS + SZ_CS;

constexpr size_t WS_PROJ = 0;
constexpr size_t WS_XB = WS_PROJ + (size_t)M_TOT * IN_COLS * 2;
constexpr size_t WS_WOUT = WS_XB + (size_t)M_TOT * D_MODEL * 2;
constexpr size_t WS_TAB = WS_WOUT + (size_t)DEPTH * 1024 * 1024 * 2;
constexpr size_t TAB_AB = 0;
constexpr size_t TAB_BB = TAB_AB + (size_t)DEPTH * NG * NP * 2 * 4;
constexpr size_t TAB_BYTES = TAB_BB + (size_t)DEPTH * NG * NP * NC * 2 * 4;
constexpr size_t WS_S5POW = WS_TAB + TAB_BYTES;
constexpr size_t WS_S5PINV = WS_S5POW + (size_t)DEPTH * NG * 11 * NP * 8;
constexpr size_t WS_S5BCAT = WS_S5PINV + (size_t)DEPTH * NG * 9 * NP * 8;
constexpr size_t WS_S5CCAT = WS_S5BCAT + (size_t)DEPTH * NG * 128 * NC * 2;
constexpr size_t WS_S5SUM = WS_S5CCAT + (size_t)DEPTH * NG * 128 * NC * 2;
constexpr size_t WS_LRUW = WS_S5SUM + (size_t)BATCH * 8 * NG * NP * 8;
constexpr size_t WS_LRSUM = WS_LRUW + (size_t)DEPTH * 8 * 2 * 64 * 64 * 2;
constexpr size_t WS_END = WS_LRSUM + (size_t)BATCH * 32 * 512 * 8;
constexpr size_t DO_WIN = 0;
constexpr size_t DO_WBR = DO_WIN + (size_t)DEPTH * IN_COLS * 1024 * 2;
constexpr size_t DO_WGLU = DO_WBR + (size_t)DEPTH * 3 * 1024 * 512 * 2;
constexpr size_t DO_LRUW = DO_WGLU + (size_t)DEPTH * 512 * 512 * 2;
constexpr size_t DO_END = DO_LRUW;
static_assert(DO_END <= (size_t)M_P * D_MODEL * 4, "weights fit in y_prompt region");
static_assert(WS_END <= 268435456ull, "workspace fits 256 MiB");

__constant__ unsigned char T5_BUCKET[128] = {0, 1, 2, 3, 4, 5, 6, 7, 8, 9, 10, 11, 12, 13, 14, 15, 16, 16, 16, 17, 17, 18, 18, 18, 19, 19, 19, 20, 20, 20, 20, 21, 21, 21, 21, 22, 22, 22, 22, 22, 23, 23, 23, 23, 23, 23, 24, 24, 24, 24, 24, 24, 25, 25, 25, 25, 25, 25, 25, 26, 26, 26, 26, 26, 26, 26, 26, 27, 27, 27, 27, 27, 27, 27, 27, 27, 27, 28, 28, 28, 28, 28, 28, 28, 28, 28, 28, 29, 29, 29, 29, 29, 29, 29, 29, 29, 29, 29, 29, 30, 30, 30, 30, 30, 30, 30, 30, 30, 30, 30, 30, 30, 30, 31, 31, 31, 31, 31, 31, 31, 31, 31, 31, 31, 31, 31, 31, 31};

__device__ __forceinline__ float bf2f(bf16_t v) { return __uint_as_float(((unsigned)v) << 16); }
__device__ __forceinline__ bf16_t f2bf(float f) { unsigned u = __float_as_uint(f); return (bf16_t)((u + 0x7fffu + ((u >> 16) & 1u)) >> 16); }
__device__ __forceinline__ float sigmoidf_(float x) { return 1.0f / (1.0f + __expf(-x)); }
__device__ __forceinline__ float siluf_(float x) { return x * sigmoidf_(x); }
__device__ __forceinline__ float gelu_tanh(float y) { const float t = tanhf(0.7978845608028654f * (y + 0.044715f * y * y * y)); return 0.5f * y * (1.0f + t); }

typedef unsigned u32x4 __attribute__((ext_vector_type(4)));
typedef float f32x2_t __attribute__((ext_vector_type(2)));
typedef __bf16 bf16x2_t __attribute__((ext_vector_type(2)));
__device__ __forceinline__ unsigned cvtpk(float lo, float hi) { f32x2_t v = {lo, hi}; bf16x2_t b = __builtin_convertvector(v, bf16x2_t); return __builtin_bit_cast(unsigned, b); }

struct P {
    const float* in[33];
    float* out;
    unsigned char* ws;
};

typedef const P __attribute__((address_space(4)))* KP;
__device__ __forceinline__ KP get_kp() { KP k = (KP)__builtin_amdgcn_kernarg_segment_ptr(); asm volatile("" : "+s"(k)); return k; }

constexpr size_t WS_CTL = (WS_END + 4095) & ~(size_t)4095;
constexpr size_t CTL_BYTES = 65536;
static_assert(WS_CTL + CTL_BYTES <= 268435456ull, "workspace fits 256 MiB");
constexpr int NTHREADS = 512, NWAVES = 8;
constexpr int LDS_BYTES = 147456;
constexpr int LDS_MISC = 135168;

#define LAS __attribute__((address_space(3)))
#define XB_TMO      128
#define XB_XCNT(j)  (256  + 64 * (j))
#define XB_XSUB(j)  (1280 + 64 * (j))
#define XB_XGEN(j)  (2304 + 64 * (j))
#define XB_TOP      3328
#define XB_TOPGEN   3392
#define XCD_BAR_WORDS 3456
#define XB_SPIN_CAP (1u << 18)
__device__ __forceinline__ unsigned xb_ld(unsigned* p)              { return __hip_atomic_load(p, __ATOMIC_RELAXED, __HIP_MEMORY_SCOPE_AGENT); }
__device__ __forceinline__ unsigned xb_add(unsigned* p, unsigned v) { return __hip_atomic_fetch_add(p, v, __ATOMIC_RELAXED, __HIP_MEMORY_SCOPE_AGENT); }
__device__ __forceinline__ unsigned xb_xcc_id() { return (unsigned)__builtin_amdgcn_s_getreg((3 << 11) | 20) & 0xFu; }
#define XB_SPIN(cond, bar) do { unsigned _sp = 0; while (cond) { __builtin_amdgcn_s_sleep(1); \
    if ((++_sp & 255u) == 0u) { if (xb_ld(&(bar)[XB_TMO])) break; if (_sp > XB_SPIN_CAP) { atomicAdd(&(bar)[XB_TMO], 1u); break; } } } } while (0)
struct XcdBarrier { unsigned* bar; unsigned x; volatile LAS unsigned* st; };
__device__ __forceinline__ XcdBarrier xcd_barrier_post(unsigned* bar, volatile LAS unsigned* st) {
    XcdBarrier b; b.bar = bar; b.x = xb_xcc_id(); b.st = st;
    if (threadIdx.x == 0) (void)xb_add(&bar[XB_XCNT(b.x)], 1u);
    return b;
}
__device__ __forceinline__ void xcd_barrier_complete(unsigned* bar, unsigned x, unsigned& nloc, unsigned& nx) {
    const unsigned G = gridDim.x * gridDim.y * gridDim.z;
    unsigned sum, cnt, mine, sp = 0u;
    for (;;) {
        sum = 0u; cnt = 0u; mine = 0u;
#pragma unroll
        for (unsigned j = 0; j < 16; ++j) { const unsigned c = xb_ld(&bar[XB_XCNT(j)]); sum += c; cnt += (c > 0u) ? 1u : 0u; mine = (j == x) ? c : mine; }
        if (sum == G) break;
        __builtin_amdgcn_s_sleep(1);
        if ((++sp & 255u) == 0u) { if (xb_ld(&bar[XB_TMO])) break; if (sp > XB_SPIN_CAP) { atomicAdd(&bar[XB_TMO], 1u); break; } }
    }
    nloc = mine > 0u ? mine : 1u; nx = cnt > 0u ? cnt : 1u;
}
__device__ __forceinline__ void xcd_barrier(const XcdBarrier& b) {
    asm volatile("s_waitcnt vmcnt(0)" ::: "memory");
    __syncthreads();
    if (threadIdx.x == 0) {
        unsigned* bar = b.bar; asm volatile("" : "+s"(bar));
        unsigned bx = b.x; asm volatile("" : "+s"(bx));
        __builtin_amdgcn_s_waitcnt(0);
        unsigned nloc = b.st[0], nx = b.st[1];
        if (nloc == 0u) { xcd_barrier_complete(bar, bx, nloc, nx); b.st[0] = nloc; b.st[1] = nx; }
        const unsigned old = xb_add(&bar[XB_XSUB(bx)], 1u);
        const unsigned gen = old / nloc;
        if (old + 1u == (gen + 1u) * nloc) {
            __builtin_amdgcn_fence(__ATOMIC_RELEASE, "agent");
            asm volatile("s_waitcnt vmcnt(0)" ::: "memory");
            const unsigned og = xb_add(&bar[XB_TOP], 1u);
            const unsigned tg = og / nx;
            if (og + 1u == (tg + 1u) * nx) xb_add(&bar[XB_TOPGEN], 1u);
            else XB_SPIN(xb_ld(&bar[XB_TOPGEN]) == tg, bar);
            __builtin_amdgcn_fence(__ATOMIC_ACQUIRE, "agent");
            xb_add(&bar[XB_XGEN(bx)], 1u);
            asm volatile("s_waitcnt vmcnt(0)" ::: "memory");
        } else {
            XB_SPIN(xb_ld(&bar[XB_XGEN(bx)]) == gen, bar);
            __builtin_amdgcn_fence(__ATOMIC_ACQUIRE, "agent");
            asm volatile("s_waitcnt vmcnt(0)" ::: "memory");
        }
    }
    __syncthreads();
}

namespace pg8 {
#define PG8_LAS __attribute__((address_space(3)))
typedef unsigned short bf16_t;
typedef short bf16x8 __attribute__((ext_vector_type(8)));
typedef float f32x4 __attribute__((ext_vector_type(4)));
typedef unsigned u32x4 __attribute__((ext_vector_type(4)));
constexpr int BM = 256, BK = 64, HALF = 128, HTB = HALF * BK * 2  , STAGE_BYTES = 8 * HTB, NXCD = 8, WGM = 8;

__host__ __device__ __forceinline__ int lds_byte(int r, int c) { const int st = (r >> 4) * 2 + (c >> 5), rr = r & 15, cc = c & 31, ob = rr * 64 + cc * 2; return st * 1024 + (ob ^ (((ob >> 9) & 1) << 5)); }
__host__ __device__ __forceinline__ void stage_rc(int b, int& R, int& C) { const int st = b / 1024, sb = b % 1024, swz = sb ^ (((sb >> 9) & 1) << 5); R = (st >> 1) * 16 + swz / 64; C = (st & 1) * 32 + (swz % 64) / 2; }
__host__ __device__ __forceinline__ int perm32(int rho) { const int n = rho >> 4, i = rho & 15; return 8 * (i >> 2) + 4 * n + (i & 3); }

struct Unit { int pm, pn, z; };
struct Gemm { const bf16_t* A; int lda; const bf16_t* Bt; int K; };

struct StaticOrder {
    int nM, nN, nwg, G, c;
    __host__ __device__ void init(int M, int N, int G_, int c_) { nM = M / BM; nN = N / BM; nwg = nM * nN; G = G_; c = c_; }
    __host__ __device__ bool next(int i, Unit& u) const {
        const long L = (long)i * G + c; if (L >= nwg) return false;
        int wgid = (int)L; { const int q = nwg / NXCD, r = nwg % NXCD, xcd = wgid % NXCD, off = wgid / NXCD; wgid = (xcd < r ? xcd * (q + 1) : r * (q + 1) + (xcd - r) * q) + off; }
        const int nig = WGM * nN, gid = wgid / nig, fm = gid * WGM, gsz = (nM - fm) < WGM ? (nM - fm) : WGM;
        u.pm = fm + ((wgid % nig) % gsz); u.pn = (wgid % nig) / gsz; u.z = 0; return true;
    }
    __device__ __forceinline__ size_t a_off(const Unit&) const { return 0; }
    __device__ __forceinline__ size_t b_off(const Unit&) const { return 0; }
    __device__ __forceinline__ void a_ready(const Unit&) const {}
    __device__ __forceinline__ void done(const Unit&) const {}
};

__device__ __forceinline__ unsigned cvt_pk_bf16(float lo, float hi) { unsigned r; asm volatile("v_cvt_pk_bf16_f32 %0, %1, %2" : "=v"(r) : "v"(lo), "v"(hi)); return r; }
typedef float f32x2 __attribute__((ext_vector_type(2)));
__device__ __forceinline__ f32x2 gelu_pk(f32x2 v) {
    const f32x2 av = __builtin_elementwise_abs(v), d = av * 0.2316418882f + 1.0f;
    f32x2 t; t.x = __builtin_amdgcn_rcpf(d.x); t.y = __builtin_amdgcn_rcpf(d.y);
    f32x2 q = t * 0.5307027145f + (-0.7265760135f); q = q * t + 0.7107068705f; q = q * t + (-0.142248368f); q = q * t + 0.127414796f; q = q * t;
    const f32x2 s = (v * v) * (-0.72134752044f);
    f32x2 e; e.x = __builtin_amdgcn_exp2f(s.x); e.y = __builtin_amdgcn_exp2f(s.y);
    const f32x2 m = v * (q * e), r = v - m;
    f32x2 o; o.x = v.x < 0.f ? m.x : r.x; o.y = v.y < 0.f ? m.y : r.y; return o;
}

template <class Epi, class Sched, bool ALIGN_EPI = false, bool SP2 = false>
__device__ __forceinline__ void gemm_phase(PG8_LAS unsigned char* lds, const Gemm g, const Sched& S, const Epi& E) {
    int zv_ = 0; asm volatile("" : "+v"(zv_));
    const int tid = (int)threadIdx.x + zv_, wid = __builtin_amdgcn_readfirstlane(tid >> 6), lane = tid & 63, wr = wid >> 2, wc = wid & 3, fr = lane & 15, fq = lane >> 4;
    const int K = g.K, nt = K / BK;
    unsigned voffA[2], voffB[2];
#pragma unroll
    for (int i = 0; i < 2; ++i) { int R, C; stage_rc(tid * 16 + i * 8192, R, C); const int Rb = Epi::PERM ? ((R & ~31) + perm32(R & 31)) : R;
        voffA[i] = (unsigned)(R * g.lda + C) * 2u; voffB[i] = (unsigned)(Rb * K + C) * 2u; }
    const size_t kstep = (size_t)(BK * 2);
    const size_t hstepA = (size_t)HALF * g.lda * 2, hstepB = (size_t)HALF * K * 2;
    const size_t tstepA = 2 * hstepA, tstepB = 2 * hstepB;
    const unsigned ldsw = (unsigned)wid * 1024u;
    const int aoff = lds_byte(wr * 64 + fr, fq * 8), boff = lds_byte(wc * 32 + fr, fq * 8);
#define PG8_SA(b, h) (((b) * 2 + (h)) * HTB)
#define PG8_SB(b, h) ((4 + (b) * 2 + (h)) * HTB)
#define PG8_STAGE(bufoff, gbase, voff) do { _Pragma("unroll") for (int _i = 0; _i < 2; ++_i) \
        __builtin_amdgcn_global_load_lds((const unsigned*)((const char*)(gbase) + (voff)[_i]), (PG8_LAS unsigned*)(lds + (bufoff) + ldsw + _i * 8192), 16, 0, 0); } while (0)
#define PG8_LDA(dst, b, h) do { _Pragma("unroll") for (int m = 0; m < 4; ++m) _Pragma("unroll") for (int k = 0; k < 2; ++k) dst[m][k] = *(const PG8_LAS bf16x8*)(lds + PG8_SA(b, h) + aoff + m * 2048 + k * 1024); } while (0)
#define PG8_LDB(dst, b, h) do { _Pragma("unroll") for (int n = 0; n < 2; ++n) _Pragma("unroll") for (int k = 0; k < 2; ++k) dst[n][k] = *(const PG8_LAS bf16x8*)(lds + PG8_SB(b, h) + boff + n * 2048 + k * 1024); } while (0)
#define PG8_MMA(ai, bj, At, Bt) do { __builtin_amdgcn_s_setprio(1); _Pragma("unroll") for (int m = 0; m < 4; ++m) _Pragma("unroll") for (int n = 0; n < 2; ++n) _Pragma("unroll") for (int k = 0; k < 2; ++k) \
        acc[ai][bj][m][n] = __builtin_amdgcn_mfma_f32_16x16x32_bf16(Bt[n][k], At[m][k], acc[ai][bj][m][n], 0, 0, 0); __builtin_amdgcn_s_setprio(0); } while (0)
#define PG8_WAIT_V(n) asm volatile("s_waitcnt vmcnt(" #n ")" ::: "memory")
#define PG8_WAIT_L(n) asm volatile("s_waitcnt lgkmcnt(" #n ")" ::: "memory")
#define PG8_BAR __builtin_amdgcn_s_barrier()
#define PG8_SCHED __builtin_amdgcn_sched_barrier(0)
    Unit cur, nxt; int ui = 0;
    if (!S.next(0, cur)) return;
    f32x4 acc[2][2][4][2];
#pragma unroll
    for (int a = 0; a < 2; ++a)
#pragma unroll
        for (int b = 0; b < 2; ++b)
#pragma unroll
            for (int m = 0; m < 4; ++m)
#pragma unroll
                for (int n = 0; n < 2; ++n) acc[a][b][m][n] = (f32x4){0.f, 0.f, 0.f, 0.f};
    bf16x8 At[4][2], B0[2][2], B1[2][2];
    const char* cA = (const char*)g.A + (size_t)cur.pm * tstepA + S.a_off(cur); const char* cB = (const char*)g.Bt + (size_t)cur.pn * tstepB + S.b_off(cur);
    S.a_ready(cur);
    if constexpr (SP2) {
        PG8_STAGE(PG8_SB(0, 0), cB, voffB); PG8_STAGE(PG8_SB(0, 1), cB + hstepB, voffB); PG8_STAGE(PG8_SA(0, 0), cA, voffA); PG8_STAGE(PG8_SA(0, 1), cA + hstepA, voffA);
        if (wr == 1) PG8_BAR;
        PG8_WAIT_V(2); PG8_BAR;
        PG8_STAGE(PG8_SB(1, 0), cB + kstep, voffB); PG8_STAGE(PG8_SA(1, 0), cA + kstep, voffA); PG8_STAGE(PG8_SB(1, 1), cB + hstepB + kstep, voffB);
        PG8_WAIT_V(6); PG8_BAR;
    } else {
        PG8_STAGE(PG8_SB(0, 0), cB, voffB); PG8_STAGE(PG8_SA(0, 0), cA, voffA); PG8_STAGE(PG8_SB(0, 1), cB + hstepB, voffB); PG8_STAGE(PG8_SA(0, 1), cA + hstepA, voffA);
        if (wr == 1) PG8_BAR;
        PG8_WAIT_V(4); PG8_BAR;
        PG8_STAGE(PG8_SB(1, 0), cB + kstep, voffB); PG8_STAGE(PG8_SA(1, 0), cA + kstep, voffA); PG8_STAGE(PG8_SB(1, 1), cB + hstepB + kstep, voffB);
        PG8_WAIT_V(6); PG8_BAR;
    }
    for (;;) {
        const bool has_next = S.next(ui + 1, nxt);
        const char* nA = has_next ? (const char*)g.A + (size_t)nxt.pm * tstepA + S.a_off(nxt) : cA; const char* nB = has_next ? (const char*)g.Bt + (size_t)nxt.pn * tstepB + S.b_off(nxt) : cB;
        for (int t = 0; t < nt; t += 2) {
            const bool last = (t == nt - 2);
            const char* a1 = cA + (size_t)(t + 1) * kstep;
            const char* a2 = last ? nA : cA + (size_t)(t + 2) * kstep; const char* b2 = last ? nB : cB + (size_t)(t + 2) * kstep;
            const char* a3 = a2 + kstep; const char* b3 = b2 + kstep;
            if (last && has_next) S.a_ready(nxt);
            if constexpr (SP2) {
            PG8_LDB(B0, 0, 0); PG8_LDB(B1, 0, 1); PG8_SCHED; PG8_LDA(At, 0, 0); PG8_STAGE(PG8_SA(1, 1), a1 + hstepA, voffA);
            PG8_WAIT_V(8); PG8_WAIT_L(0); PG8_BAR; PG8_MMA(0, 0, At, B0); PG8_MMA(0, 1, At, B1); PG8_BAR; PG8_SCHED;
            PG8_LDA(At, 0, 1); PG8_STAGE(PG8_SB(0, 0), b2, voffB); PG8_STAGE(PG8_SB(0, 1), b2 + hstepB, voffB); PG8_STAGE(PG8_SA(0, 0), a2, voffA);
            PG8_WAIT_V(8); PG8_WAIT_L(0); PG8_BAR; PG8_MMA(1, 0, At, B0); PG8_MMA(1, 1, At, B1); PG8_BAR; PG8_SCHED;
            PG8_LDB(B0, 1, 0); PG8_LDB(B1, 1, 1); PG8_SCHED; PG8_LDA(At, 1, 0); PG8_STAGE(PG8_SA(0, 1), a2 + hstepA, voffA);
            PG8_WAIT_V(8); PG8_WAIT_L(0); PG8_BAR; PG8_MMA(0, 0, At, B0); PG8_MMA(0, 1, At, B1); PG8_BAR; PG8_SCHED;
            PG8_LDA(At, 1, 1); PG8_STAGE(PG8_SB(1, 0), b3, voffB); PG8_STAGE(PG8_SB(1, 1), b3 + hstepB, voffB); PG8_STAGE(PG8_SA(1, 0), a3, voffA);
            PG8_WAIT_V(8); PG8_WAIT_L(0); PG8_BAR; PG8_MMA(1, 0, At, B0); PG8_MMA(1, 1, At, B1); PG8_BAR; PG8_SCHED;
            } else {
            PG8_LDB(B0, 0, 0); PG8_SCHED; PG8_LDA(At, 0, 0); PG8_STAGE(PG8_SA(1, 1), a1 + hstepA, voffA);
            PG8_WAIT_L(8); PG8_BAR; PG8_WAIT_L(0); PG8_MMA(0, 0, At, B0); PG8_BAR; PG8_SCHED;
            PG8_LDB(B1, 0, 1); PG8_STAGE(PG8_SB(0, 0), b2, voffB);
            PG8_BAR; PG8_WAIT_L(0); PG8_MMA(0, 1, At, B1); PG8_BAR;
            PG8_LDA(At, 0, 1); PG8_STAGE(PG8_SA(0, 0), a2, voffA);
            PG8_BAR; PG8_WAIT_L(0); PG8_MMA(1, 0, At, B0); PG8_BAR; PG8_SCHED;
            PG8_STAGE(PG8_SB(0, 1), b2 + hstepB, voffB);
            PG8_WAIT_V(6); PG8_BAR; PG8_MMA(1, 1, At, B1); PG8_BAR;
            PG8_LDB(B0, 1, 0); PG8_SCHED; PG8_LDA(At, 1, 0); PG8_STAGE(PG8_SA(0, 1), a2 + hstepA, voffA);
            PG8_WAIT_L(8); PG8_BAR; PG8_WAIT_L(0); PG8_MMA(0, 0, At, B0); PG8_BAR; PG8_SCHED;
            PG8_LDB(B1, 1, 1); PG8_STAGE(PG8_SB(1, 0), b3, voffB);
            PG8_BAR; PG8_WAIT_L(0); PG8_MMA(0, 1, At, B1); PG8_BAR;
            PG8_LDA(At, 1, 1); PG8_STAGE(PG8_SA(1, 0), a3, voffA);
            PG8_BAR; PG8_WAIT_L(0); PG8_MMA(1, 0, At, B0); PG8_BAR; PG8_SCHED;
            PG8_STAGE(PG8_SB(1, 1), b3 + hstepB, voffB);
            PG8_WAIT_V(6); PG8_BAR; PG8_MMA(1, 1, At, B1); PG8_BAR;
            }
        }
        if constexpr (ALIGN_EPI) { if (wr == 0) PG8_BAR; }
        if constexpr (!Epi::AFTER_DRAIN) { E(acc, cur, wr, wc, fr, fq); S.done(cur); }
        if (!has_next) break;
#pragma unroll
        for (int a = 0; a < 2; ++a)
#pragma unroll
            for (int b = 0; b < 2; ++b)
#pragma unroll
                for (int m = 0; m < 4; ++m)
#pragma unroll
                    for (int n = 0; n < 2; ++n) acc[a][b][m][n] = (f32x4){0.f, 0.f, 0.f, 0.f};
        cur = nxt; cA = nA; cB = nB; ++ui;
        if constexpr (ALIGN_EPI) { if (wr == 1) PG8_BAR; }
    }
    PG8_WAIT_V(0);
    if constexpr (!ALIGN_EPI) { if (wr == 0) PG8_BAR; }
    PG8_BAR;
    if constexpr (Epi::AFTER_DRAIN) { E.fused(acc, cur, wr, wc, fr, fq, lds, wid, lane); S.done(cur); }
#undef PG8_SA
#undef PG8_SB
#undef PG8_STAGE
#undef PG8_LDA
#undef PG8_LDB
#undef PG8_MMA
#undef PG8_WAIT_V
#undef PG8_WAIT_L
#undef PG8_BAR
#undef PG8_SCHED
}
}

namespace pg8 {
typedef unsigned u32x2 __attribute__((ext_vector_type(2)));
__device__ __forceinline__ float bflo(unsigned w) { return __uint_as_float(w << 16); }
__device__ __forceinline__ float bfhi(unsigned w) { return __uint_as_float(w & 0xffff0000u); }
__device__ __forceinline__ float sigm(float x) { return __builtin_amdgcn_rcpf(1.0f + __expf(-x)); }
struct EpiProjB {
    static constexpr bool PERM = true, AFTER_DRAIN = false;
    bf16_t* O; int ldc;
    __device__ __forceinline__ void operator()(const f32x4 (&acc)[2][2][4][2], const Unit& u, int wr, int wc, int fr, int fq) const {
        const int row0 = u.pm * BM + wr * 64 + fr, col0 = u.pn * BM + wc * 32 + 8 * fq;
#pragma unroll
        for (int ai = 0; ai < 2; ++ai)
#pragma unroll
            for (int m = 0; m < 4; ++m) { bf16_t* rowp = O + (size_t)(row0 + ai * HALF + m * 16) * ldc + col0;
#pragma unroll
                for (int bj = 0; bj < 2; ++bj) { const f32x4 v0 = acc[ai][bj][m][0], v1 = acc[ai][bj][m][1];
                    u32x4 w; w.x = cvt_pk_bf16(v0[0], v0[1]); w.y = cvt_pk_bf16(v0[2], v0[3]); w.z = cvt_pk_bf16(v1[0], v1[1]); w.w = cvt_pk_bf16(v1[2], v1[3]);
                    *(u32x4*)(rowp + bj * HALF) = w; } }
    }
};
struct EpiGluB {
    static constexpr bool PERM = true, AFTER_DRAIN = false;
    bf16_t* PROJ;
    __device__ __forceinline__ void operator()(const f32x4 (&acc)[2][2][4][2], const Unit& u, int wr, int wc, int fr, int fq) const {
        const int row0 = u.pm * BM + wr * 64 + fr, col0 = u.pn * BM + wc * 32 + 8 * fq;
#pragma unroll
        for (int ai = 0; ai < 2; ++ai)
#pragma unroll
            for (int m = 0; m < 4; ++m) { bf16_t* rowp = PROJ + (size_t)(row0 + ai * HALF + m * 16) * IN_COLS + col0;
#pragma unroll
                for (int bj = 0; bj < 2; ++bj) {
                    const u32x4 zz = *(const u32x4*)(rowp + C_UB + bj * HALF), gg = *(const u32x4*)(rowp + C_GB + bj * HALF);
                    const f32x4 v0 = acc[ai][bj][m][0], v1 = acc[ai][bj][m][1];
                    float o[8];
#pragma unroll
                    for (int e = 0; e < 4; ++e) {
                        const float va = e < 2 ? v0[2 * e] : v1[2 * (e - 2)], vb = e < 2 ? v0[2 * e + 1] : v1[2 * (e - 2) + 1];
                        const float za = bflo(zz[e]), zb = bfhi(zz[e]), ga = bflo(gg[e]), gb = bfhi(gg[e]);
                        o[2 * e] = za * sigm(va) * ga * sigm(ga); o[2 * e + 1] = zb * sigm(vb) * gb * sigm(gb);
                    }
                    u32x4 w; w.x = cvt_pk_bf16(o[0], o[1]); w.y = cvt_pk_bf16(o[2], o[3]); w.z = cvt_pk_bf16(o[4], o[5]); w.w = cvt_pk_bf16(o[6], o[7]);
                    *(u32x4*)(rowp + C_GB + bj * HALF) = w; } }
    }
};
struct EpiBranchB {
    static constexpr bool PERM = true, AFTER_DRAIN = false;
    bf16_t* PROJ;
    __device__ __forceinline__ void operator()(const f32x4 (&acc)[2][2][4][2], const Unit& u, int wr, int wc, int fr, int fq) const {
        const int row0 = u.pm * BM + wr * 64 + fr, col0 = u.pn * BM + wc * 32 + 8 * fq;
        const int z = u.z;
#pragma unroll
        for (int ai = 0; ai < 2; ++ai)
#pragma unroll
            for (int m = 0; m < 4; ++m) { bf16_t* rowp = PROJ + (size_t)(row0 + ai * HALF + m * 16) * IN_COLS + C_GM + col0;
#pragma unroll
                for (int bj = 0; bj < 2; ++bj) {
                    const u32x4 gg = *(const u32x4*)(rowp + z * 1024 + bj * HALF);
                    u32x4 pp = (u32x4){0u, 0u, 0u, 0u};
                    if (z > 0) pp = *(const u32x4*)(rowp + bj * HALF);
                    const f32x4 v0 = acc[ai][bj][m][0], v1 = acc[ai][bj][m][1];
                    float o[8];
#pragma unroll
                    for (int e = 0; e < 4; ++e) {
                        const float va = e < 2 ? v0[2 * e] : v1[2 * (e - 2)], vb = e < 2 ? v0[2 * e + 1] : v1[2 * (e - 2) + 1];
                        o[2 * e] = bflo(pp[e]) + sigm(bflo(gg[e])) * va; o[2 * e + 1] = bfhi(pp[e]) + sigm(bfhi(gg[e])) * vb;
                    }
                    u32x4 w; w.x = cvt_pk_bf16(o[0], o[1]); w.y = cvt_pk_bf16(o[2], o[3]); w.z = cvt_pk_bf16(o[4], o[5]); w.w = cvt_pk_bf16(o[6], o[7]);
                    *(u32x4*)(rowp + bj * HALF) = w; } }
    }
};
struct BranchOrder : StaticOrder {
    __device__ bool next(int i, Unit& u) const { if (!StaticOrder::next(i / 3, u)) return false; u.z = i % 3; return true; }
    __device__ __forceinline__ size_t a_off(const Unit& u) const { return (size_t)(u.z == 0 ? C_Q : (u.z == 1 ? C_GB : C_GC)) * 2; }
    __device__ __forceinline__ size_t b_off(const Unit& u) const { return (size_t)u.z * 1024 * 512 * 2; }
};
struct EpiOutB {
    static constexpr bool PERM = false, AFTER_DRAIN = false;
    const float* xp; const float* xs; const bf16_t* XB; unsigned char* ws; int l;
    __device__ __forceinline__ void operator()(const f32x4 (&acc)[2][2][4][2], const Unit& u, int wr, int wc, int fr, int fq) const {
        const int row0 = u.pm * BM + wr * 64 + fr, col0 = u.pn * BM + wc * 32 + 4 * fq;
#pragma unroll
        for (int ai = 0; ai < 2; ++ai)
#pragma unroll
            for (int m = 0; m < 4; ++m) { const int r = row0 + ai * HALF + m * 16;
                float* prow = (float*)(ws + WS_PROJ + (size_t)r * IN_COLS * 2 + (size_t)(C_GM + 1024) * 2) + col0;
#pragma unroll
                for (int bj = 0; bj < 2; ++bj)
#pragma unroll
                    for (int n = 0; n < 2; ++n) {
                        const int co = bj * HALF + n * 16;
                        f32x4 x;
                        if (l == 0) x = r < M_P ? *(const f32x4*)(xp + (size_t)r * D_MODEL + col0 + co) : *(const f32x4*)(xs + (size_t)(r - M_P) * D_MODEL + col0 + co);
                        else { const u32x2 xx = *(const u32x2*)(XB + (size_t)r * D_MODEL + col0 + co); x = (f32x4){bflo(xx.x), bfhi(xx.x), bflo(xx.y), bfhi(xx.y)}; }
                        *(f32x4*)(prow + co) = x * DN_ALPHA + acc[ai][bj][m][n];
                    } }
    }
};
}

struct Ctx { int tid, lane, wave, gw, ngw; size_t gt, ngt; };
__device__ __forceinline__ Ctx make_ctx() {
    int zv = 0; asm volatile("" : "+v"(zv)); int zs = 0; asm volatile("" : "+s"(zs));
    Ctx c; c.tid = (int)threadIdx.x + zv; c.lane = c.tid & 63; c.wave = __builtin_amdgcn_readfirstlane(c.tid >> 6);
    const int bid = (int)blockIdx.x + zs, nb = (int)gridDim.x + zs;
    c.gw = c.wave * nb + bid; c.ngw = nb * NWAVES; c.gt = (size_t)bid * NTHREADS + c.tid; c.ngt = (size_t)nb * NTHREADS; return c;
}
#define WAVE_LDS_SYNC() do { asm volatile("s_waitcnt lgkmcnt(0)" ::: "memory"); __builtin_amdgcn_wave_barrier(); } while (0)

__device__ __forceinline__ void st_convert_x(KP p, const Ctx& c) {
    u32x4* XB = (u32x4*)(p->ws + WS_XB);
    const size_t n8 = (size_t)M_TOT * D_MODEL / 8, np8 = (size_t)M_P * D_MODEL / 8;
    for (size_t i = c.gt; i < n8; i += c.ngt) {
        const f32x4* src = i < np8 ? (const f32x4*)p->in[0] + 2 * i : (const f32x4*)p->in[1] + 2 * (i - np8);
        const f32x4 a = src[0], b = src[1];
        u32x4 o; o.x = cvtpk(a[0], a[1]); o.y = cvtpk(a[2], a[3]); o.z = cvtpk(b[0], b[1]); o.w = cvtpk(b[2], b[3]);
        XB[i] = o;
    }
}
__device__ __forceinline__ void st_transpose_w(const float* W, bf16_t* WT, int K, int N, const Ctx& c) {
    const size_t n = (size_t)K * N;
    for (size_t i = c.gt; i < n; i += c.ngt) { const int nn = (int)(i / K), kk = (int)(i % K); WT[i] = f2bf(W[(size_t)kk * N + nn]); }
}

__device__ __forceinline__ unsigned pk2bf(float lo, float hi) { return (unsigned)f2bf(lo) | ((unsigned)f2bf(hi) << 16); }
__device__ __forceinline__ void p0_transpose_item(const float* W, int K, int N, bf16_t* WT, LAS float* scr, int item, int lane) {
    const int nblk = N / 32, kb = item / nblk, nb = item % nblk, k0 = 64 * kb, n0 = 32 * nb;
#pragma unroll 8
    for (int i = 0; i < 32; ++i) { const int kk = 2 * i + (lane >> 5); scr[kk * 33 + (lane & 31)] = W[(size_t)(k0 + kk) * N + n0 + (lane & 31)]; }
    WAVE_LDS_SYNC();
    const int cch = lane & 7;
#pragma unroll
    for (int j = 0; j < 4; ++j) { const int n = (lane >> 3) + 8 * j; const LAS float* sp = scr + (8 * cch) * 33 + n;
        u32x4 o; o.x = pk2bf(sp[0 * 33], sp[1 * 33]); o.y = pk2bf(sp[2 * 33], sp[3 * 33]); o.z = pk2bf(sp[4 * 33], sp[5 * 33]); o.w = pk2bf(sp[6 * 33], sp[7 * 33]);
        *(u32x4*)(WT + (size_t)(n0 + n) * K + k0 + 8 * cch) = o; }
    WAVE_LDS_SYNC();
}
__device__ __forceinline__ void st_prologue_weights(KP p, const Ctx& c, LAS float* scr) {
    unsigned char* dob = (unsigned char*)p->out;
    constexpr int I_IN = 16 * 200, I_BR = 8 * 32, I_GLU = 8 * 16, I_OUT = 16 * 32, I_LAYER = I_IN + 3 * I_BR + I_GLU + I_OUT;
    for (int it = c.gw; it < DEPTH * I_LAYER; it += c.ngw) {
        const int l = it / I_LAYER; int r = it % I_LAYER;
        if (r < I_IN) { p0_transpose_item(p->in[9] + (size_t)l * 1024 * IN_COLS, 1024, IN_COLS, (bf16_t*)(dob + DO_WIN) + (size_t)l * IN_COLS * 1024, scr, r, c.lane); continue; } r -= I_IN;
        if (r < I_BR) { p0_transpose_item(p->in[11] + (size_t)l * 512 * 1024, 512, 1024, (bf16_t*)(dob + DO_WBR) + ((size_t)l * 3 + 0) * 1024 * 512, scr, r, c.lane); continue; } r -= I_BR;
        if (r < I_BR) { p0_transpose_item(p->in[21] + (size_t)l * 512 * 1024, 512, 1024, (bf16_t*)(dob + DO_WBR) + ((size_t)l * 3 + 1) * 1024 * 512, scr, r, c.lane); continue; } r -= I_BR;
        if (r < I_BR) { p0_transpose_item(p->in[29] + (size_t)l * 512 * 1024, 512, 1024, (bf16_t*)(dob + DO_WBR) + ((size_t)l * 3 + 2) * 1024 * 512, scr, r, c.lane); continue; } r -= I_BR;
        if (r < I_GLU) { p0_transpose_item(p->in[20] + (size_t)l * 512 * 512, 512, 512, (bf16_t*)(dob + DO_WGLU) + (size_t)l * 512 * 512, scr, r, c.lane); continue; } r -= I_GLU;
        p0_transpose_item(p->in[30] + (size_t)l * 1024 * 1024, 1024, 1024, (bf16_t*)(p->ws + WS_WOUT) + (size_t)l * 1024 * 1024, scr, r, c.lane);
    }
}
__device__ __forceinline__ void st_s5_tables(KP p, const Ctx& c) {
    float* AB = (float*)(p->ws + WS_TAB + TAB_AB);
    float* BB = (float*)(p->ws + WS_TAB + TAB_BB);
    for (size_t ii = c.gt; ii < (size_t)DEPTH * NG * NP; ii += c.ngt) {
        const int i = (int)ii, l = i / (NG * NP), g = (i / NP) % NG;
        const float lr = fminf(p->in[12][i], -1e-4f), li = p->in[13][i];
        const float step = expf(p->in[14][l * NG + g]);
        const float mag = expf(lr * step);
        float sn, cs; sincosf(li * step, &sn, &cs);
        const float ab_re = mag * cs, ab_im = mag * sn;
        const float den = lr * lr + li * li;
        const float f_re = ((ab_re - 1.0f) * lr + ab_im * li) / den;
        const float f_im = (ab_im * lr - (ab_re - 1.0f) * li) / den;
        AB[2 * i] = ab_re; AB[2 * i + 1] = ab_im;
        for (int cc = 0; cc < NC; ++cc) {
            const float bre = p->in[15][(size_t)i * NC + cc], bim = p->in[16][(size_t)i * NC + cc];
            BB[((size_t)i * NC + cc) * 2] = f_re * bre - f_im * bim;
            BB[((size_t)i * NC + cc) * 2 + 1] = f_re * bim + f_im * bre;
        }
    }
}

template <class Epi>
__device__ __forceinline__ void gemm_simple(const bf16_t* A, int lda, const bf16_t* Bt, int ldb, int M, int N, int K, Epi epi, const Ctx& c) {
    const int lane = c.lane;
    const int ntn = N / 32, ntiles = (M / 32) * ntn;
    for (int tile = c.gw; tile < ntiles; tile += c.ngw) {
        const int tm = tile / ntn, tn = tile % ntn;
        f32x16 acc = {};
        const bf16_t* ar = A + (size_t)(tm * 32 + (lane & 31)) * lda + 8 * (lane >> 5);
        const bf16_t* br = Bt + (size_t)(tn * 32 + (lane & 31)) * ldb + 8 * (lane >> 5);
        for (int k0 = 0; k0 < K; k0 += 16) {
            const bf16x8 a = *(const bf16x8*)(ar + k0);
            const bf16x8 b = *(const bf16x8*)(br + k0);
            acc = __builtin_amdgcn_mfma_f32_32x32x16_bf16(a, b, acc, 0, 0, 0);
        }
#pragma unroll
        for (int r = 0; r < 16; ++r) {
            const int row = tm * 32 + (r & 3) + 8 * (r >> 2) + 4 * (lane >> 5), col = tn * 32 + (lane & 31);
            epi(row, col, acc[r]);
        }
    }
}
struct EpiProj { bf16_t* PROJ; __device__ void operator()(int r, int c, float v) const { PROJ[(size_t)r * IN_COLS + c] = f2bf(v); } };

__device__ __forceinline__ void st_kv_out(KP p, int l, const Ctx& c) {
    const bf16_t* PROJ = (const bf16_t*)(p->ws + WS_PROJ);
    for (size_t ii = c.gt; ii < (size_t)BATCH * 3 * 512; ii += c.ngt) {
        const int i = (int)ii, b = i / 1536, j = (i / 512) % 3, ch = i % 512;
        p->out[O_CP + (size_t)l * BATCH * 1536 + i] = bf2f(PROJ[((size_t)b * SEQ + SEQ - 3 + j) * IN_COLS + C_XC + ch]);
    }
    for (size_t ii = c.gt; ii < (size_t)DEC_BATCH * WINDOW * 128; ii += c.ngt) {
        const int i = (int)ii;
        if (i < BATCH * WINDOW * 128) {
            const int b = i / (WINDOW * 128), w = (i / 128) % WINDOW, cc = i % 128;
            const size_t row = (size_t)b * SEQ + (SEQ - WINDOW) + w;
            p->out[O_KP + (size_t)l * BATCH * WINDOW * 128 + i] = bf2f(PROJ[row * IN_COLS + C_K + cc]);
            p->out[O_VP + (size_t)l * BATCH * WINDOW * 128 + i] = bf2f(PROJ[row * IN_COLS + C_V + cc]);
        }
        {
            const int b = i / (WINDOW * 128), w = (i / 128) % WINDOW, cc = i % 128;
            float kv, vv;
            if (w < WINDOW - DEC_SEQ) {
                const size_t ci = (((size_t)l * DEC_BATCH + b) * WINDOW + (w + DEC_SEQ)) * 128 + cc;
                kv = p->in[2][ci]; vv = p->in[3][ci];
            } else {
                const size_t row = (size_t)M_P + b * DEC_SEQ + (w - (WINDOW - DEC_SEQ));
                kv = bf2f(PROJ[row * IN_COLS + C_K + cc]); vv = bf2f(PROJ[row * IN_COLS + C_V + cc]);
            }
            p->out[O_KS + (size_t)l * DEC_BATCH * WINDOW * 128 + i] = kv;
            p->out[O_VS + (size_t)l * DEC_BATCH * WINDOW * 128 + i] = vv;
        }
    }
}

__device__ __forceinline__ void st_attn_simple(KP p, int l, const Ctx& c) {
    bf16_t* PROJ = (bf16_t*)(p->ws + WS_PROJ);
    const int lane = c.lane;
    const float* rel_bias = p->in[8];
    for (int item = c.gw; item < M_S * NQH; item += c.ngw) {
        const int m = M_P + item / NQH, h = item % NQH, kvh = h / 4;
        const bool samp = m >= M_P;
        const int b = samp ? (m - M_P) / DEC_SEQ : m / SEQ, t = samp ? (m - M_P) % DEC_SEQ : m % SEQ;
        float q[64];
        {
            const bf16_t* qp = PROJ + (size_t)m * IN_COLS + C_Q + h * 64;
#pragma unroll
            for (int d = 0; d < 64; ++d) q[d] = bf2f(qp[d]);
        }
        const float sink = p->in[10][l * NQH + h];
        float s[2];
#pragma unroll
        for (int j = 0; j < 2; ++j) {
            const int d = lane + 64 * j;
            const int tk = t - d;
            float sc = -1e30f;
            if (!samp) {
                if (tk >= 0) {
                    const bf16_t* kp = PROJ + ((size_t)b * SEQ + tk) * IN_COLS + C_K + kvh * 64;
                    float a = 0.f;
#pragma unroll
                    for (int e = 0; e < 64; ++e) a += q[e] * bf2f(kp[e]);
                    sc = a * 0.125f + rel_bias[T5_BUCKET[d] * NQH + h];
                }
            } else {
                float a = 0.f;
                if (tk >= 0) {
                    const bf16_t* kp = PROJ + ((size_t)M_P + b * DEC_SEQ + tk) * IN_COLS + C_K + kvh * 64;
#pragma unroll
                    for (int e = 0; e < 64; ++e) a += q[e] * bf2f(kp[e]);
                } else {
                    const float* kp = p->in[2] + ((((size_t)l * DEC_BATCH + b) * WINDOW + (WINDOW + tk)) * NKV + kvh) * HD;
#pragma unroll
                    for (int e = 0; e < 64; ++e) a += q[e] * kp[e];
                }
                sc = a * 0.125f + rel_bias[T5_BUCKET[d] * NQH + h];
            }
            s[j] = sc;
        }
        float mx = fmaxf(fmaxf(s[0], s[1]), sink);
        for (int o = 32; o > 0; o >>= 1) mx = fmaxf(mx, __shfl_xor(mx, o));
        const float p0 = s[0] > -1e29f ? __expf(s[0] - mx) : 0.f, p1 = s[1] > -1e29f ? __expf(s[1] - mx) : 0.f;
        float sum = p0 + p1;
        for (int o = 32; o > 0; o >>= 1) sum += __shfl_xor(sum, o);
        const float denom = sum + __expf(sink - mx);
        float o = 0.f;
        for (int d = 0; d < 128; ++d) {
            const float pj = __shfl(d < 64 ? p0 : p1, d & 63);
            const int tk = t - d;
            float vv = 0.f;
            if (!samp) { if (tk >= 0) vv = bf2f(PROJ[((size_t)b * SEQ + tk) * IN_COLS + C_V + kvh * 64 + lane]); }
            else if (tk >= 0) vv = bf2f(PROJ[((size_t)M_P + b * DEC_SEQ + tk) * IN_COLS + C_V + kvh * 64 + lane]);
            else vv = p->in[3][((((size_t)l * DEC_BATCH + b) * WINDOW + (WINDOW + tk)) * NKV + kvh) * HD + lane];
            o += pj * vv;
        }
        o /= denom;
        const float ga = bf2f(PROJ[(size_t)m * IN_COLS + C_GA + h * 64 + lane]);
        PROJ[(size_t)m * IN_COLS + C_Q + h * 64 + lane] = f2bf(o * siluf_(ga));
    }
}

typedef short s16x4 __attribute__((ext_vector_type(4)));
typedef short v4i16_t __attribute__((ext_vector_type(4)));
__device__ __forceinline__ bf16x8 pack8(float a0, float a1, float a2, float a3, float a4, float a5, float a6, float a7) {
    u32x4 p; p.x = cvtpk(a0, a1); p.y = cvtpk(a2, a3); p.z = cvtpk(a4, a5); p.w = cvtpk(a6, a7); return __builtin_bit_cast(bf16x8, p); }
__device__ __forceinline__ s16x4 tr_read(LAS const unsigned char* p) { return __builtin_bit_cast(s16x4, __builtin_amdgcn_ds_read_tr16_b64_v4i16((LAS v4i16_t*)p)); }
__device__ __forceinline__ bf16x8 cat8(s16x4 lo, s16x4 hi) { return __builtin_shufflevector(lo, hi, 0, 1, 2, 3, 4, 5, 6, 7); }
#define MFMA32(a, b, c) __builtin_amdgcn_mfma_f32_32x32x16_bf16((a), (b), (c), 0, 0, 0)
#define MFMA16(a, b, c) __builtin_amdgcn_mfma_f32_16x16x32_bf16((a), (b), (c), 0, 0, 0)

constexpr int AT_KSTR = 144, AT_VSTR = 192;
constexpr int AT_K = 0, AT_V = AT_K + 256 * AT_KSTR, AT_BIAS = AT_V + 256 * AT_VSTR, AT_WS = AT_BIAS + 4 * 128 * 4, AT_END = AT_WS + 8 * 256;
static_assert(AT_END <= 131072, "attention LDS");

__device__ __forceinline__ void st_attn_prompt(KP p, int l, LAS unsigned char* lds) {
    int zv = 0; asm volatile("" : "+v"(zv));
    const int tid = (int)threadIdx.x + zv, lane = tid & 63, wave = __builtin_amdgcn_readfirstlane(tid >> 6);
    const int c31 = lane & 31, h = lane >> 5;
    bf16_t* PROJ = (bf16_t*)(p->ws + WS_PROJ);
    const float* rel_bias = p->in[8];
    for (int item = blockIdx.x; item < BATCH * 16 * NKV; item += gridDim.x) {
        const int b = item / 32, nb = (item >> 1) & 15, kvh = item & 1;
        const size_t rowq0 = (size_t)b * SEQ + (size_t)nb * 128;
#pragma unroll
        for (int i = 0; i < 4; ++i) {
            const int id = tid + 512 * i, row = id >> 3, pc = id & 7;
            u32x4 kk = (u32x4){0u, 0u, 0u, 0u}, vv = kk;
            if (nb > 0 || row >= 128) {
                const bf16_t* src = PROJ + (rowq0 - 128 + row) * IN_COLS + kvh * 64 + pc * 8;
                kk = *(const u32x4*)(src + C_K); vv = *(const u32x4*)(src + C_V);
            }
            *(LAS u32x4*)(lds + AT_K + row * AT_KSTR + pc * 16) = kk;
            *(LAS u32x4*)(lds + AT_V + row * AT_VSTR + pc * 16) = vv;
        }
        { const int g = tid >> 7, d = tid & 127; ((LAS float*)(lds + AT_BIAS))[tid] = rel_bias[T5_BUCKET[d] * NQH + kvh * 4 + g]; }
        __syncthreads();
        const int g = wave >> 1, hq = kvh * 4 + g;
        const float sink = p->in[10][l * NQH + hq];
        LAS const float* biasd = (LAS const float*)(lds + AT_BIAS) + g * 128;
        LAS float* wsf = (LAS float*)(lds + AT_WS + wave * 256);
#pragma unroll 1
        for (int qi = 0; qi < 2; ++qi) {
            const int qt = 2 * (wave & 1) + qi, q0 = 32 * qt;
            bf16x8 qf[4];
            { const bf16_t* qp = PROJ + (rowq0 + q0 + c31) * IN_COLS + C_Q + hq * 64 + 8 * h;
#pragma unroll
              for (int ks = 0; ks < 4; ++ks) qf[ks] = *(const bf16x8*)(qp + 16 * ks); }
            f32x16 S[5];
#pragma unroll
            for (int j = 0; j < 5; ++j) {
                S[j] = (f32x16){};
                LAS const unsigned char* kp = lds + AT_K + (32 * (qt + j) + c31) * AT_KSTR + 16 * h;
#pragma unroll
                for (int ks = 0; ks < 4; ++ks) S[j] = MFMA32(*(LAS const bf16x8*)(kp + 32 * ks), qf[ks], S[j]);
            }
            const int iq = q0 + c31;
            float mx = sink;
#pragma unroll
            for (int j = 0; j < 5; ++j)
#pragma unroll
                for (int r = 0; r < 16; ++r) {
                    const int kv = 32 * (qt + j) + (r & 3) + 8 * (r >> 2) + 4 * h;
                    const int dist = iq + 128 - kv;
                    const bool ok = (dist >= 0) && (dist < 128) && (nb > 0 || kv >= 128);
                    const float s = ok ? S[j][r] * 0.125f + biasd[dist & 127] : -1e30f;
                    S[j][r] = s; mx = fmaxf(mx, s);
                }
            mx = fmaxf(mx, __shfl_xor(mx, 32));
            float sum = 0.f;
#pragma unroll
            for (int j = 0; j < 5; ++j)
#pragma unroll
                for (int r = 0; r < 16; ++r) { const float e = S[j][r] > -1e29f ? __expf(S[j][r] - mx) : 0.f; S[j][r] = e; sum += e; }
            sum += __shfl_xor(sum, 32);
            const float rden = 1.0f / (sum + __expf(sink - mx));
            if (h == 0) wsf[c31] = rden;
            f32x16 O[2]; O[0] = (f32x16){}; O[1] = (f32x16){};
            const int i16 = lane & 15, qq = i16 >> 2, pp = i16 & 3, blk = (lane >> 4) & 1;
#pragma unroll
            for (int j = 0; j < 5; ++j)
#pragma unroll
                for (int s = 0; s < 2; ++s) {
                    const bf16x8 pf = pack8(S[j][8 * s], S[j][8 * s + 1], S[j][8 * s + 2], S[j][8 * s + 3], S[j][8 * s + 4], S[j][8 * s + 5], S[j][8 * s + 6], S[j][8 * s + 7]);
                    LAS const unsigned char* vp = lds + AT_V + (32 * (qt + j) + 16 * s + 4 * h + qq) * AT_VSTR + (16 * blk + 4 * pp) * 2;
#pragma unroll
                    for (int dt = 0; dt < 2; ++dt) {
                        const bf16x8 vf = cat8(tr_read(vp + dt * 64), tr_read(vp + dt * 64 + 8 * AT_VSTR));
                        O[dt] = MFMA32(pf, vf, O[dt]);
                    }
                }
            WAVE_LDS_SYNC();
#pragma unroll
            for (int r = 0; r < 16; ++r) {
                const int qr = (r & 3) + 8 * (r >> 2) + 4 * h;
                const float rd = wsf[qr];
                bf16_t* rowp = PROJ + (rowq0 + q0 + qr) * IN_COLS + hq * 64 + c31;
#pragma unroll
                for (int dt = 0; dt < 2; ++dt) {
                    const float ga = bf2f(rowp[C_GA + 32 * dt]);
                    rowp[C_Q + 32 * dt] = f2bf(O[dt][r] * rd * siluf_(ga));
                }
            }
            WAVE_LDS_SYNC();
        }
        __syncthreads();
    }
}

constexpr int S5_NPOW = 11, S5_NINV = 9, S5_NSEG = 8, S5_SEGLEN = 256;
__device__ __forceinline__ f32x2_t cmul(f32x2_t a, f32x2_t b) { return (f32x2_t){a.x * b.x - a.y * b.y, a.x * b.y + a.y * b.x}; }

__device__ __forceinline__ void st_s5_tables2(KP p, const Ctx& c) {
    f32x2_t* POW = (f32x2_t*)(p->ws + WS_S5POW); f32x2_t* PINV = (f32x2_t*)(p->ws + WS_S5PINV);
    bf16_t* BCAT = (bf16_t*)(p->ws + WS_S5BCAT); bf16_t* CCAT = (bf16_t*)(p->ws + WS_S5CCAT);
    const float* BB = (const float*)(p->ws + WS_TAB + TAB_BB);
    for (size_t ii = c.gt; ii < (size_t)DEPTH * NG * NP; ii += c.ngt) {
        const int i = (int)ii, lg = i / NP, pp = i % NP;
        const double lr = (double)fminf(p->in[12][i], -1e-4f), li = (double)p->in[13][i];
        const double step = (double)expf(p->in[14][lg]);
        for (int k = 0; k < S5_NPOW + S5_NINV; ++k) {
            const int e = k < 9 ? k : (k == 9 ? 64 : (k == 10 ? 256 : -(k - S5_NPOW)));
            double t = (double)e * li * step * 0.15915494309189535; t -= rint(t);
            float sn, cs; sincosf((float)(t * 6.283185307179586), &sn, &cs);
            const float mag = expf((float)((double)e * lr * step));
            const f32x2_t v = {mag * cs, mag * sn};
            if (k < S5_NPOW) POW[((size_t)lg * S5_NPOW + k) * NP + pp] = v; else PINV[((size_t)lg * S5_NINV + (k - S5_NPOW)) * NP + pp] = v;
        }
    }
    for (size_t ii = c.gt; ii < (size_t)DEPTH * NG * 128 * NC; ii += c.ngt) {
        const int i = (int)ii, lg = i / (128 * NC), n = (i / NC) % 128, cc = i % NC, pp = n & 63;
        const int sidx = lg * NP + pp;
        const float lr = fminf(p->in[12][sidx], -1e-4f), li = p->in[13][sidx];
        const float step = expf(p->in[14][lg]);
        const float mag = expf(lr * step);
        float sn, cs; sincosf(li * step, &sn, &cs);
        const float ab_re = mag * cs, ab_im = mag * sn, den = lr * lr + li * li;
        const float f_re = ((ab_re - 1.0f) * lr + ab_im * li) / den, f_im = (ab_im * lr - (ab_re - 1.0f) * li) / den;
        const float bre = p->in[15][(size_t)sidx * NC + cc], bim = p->in[16][(size_t)sidx * NC + cc];
        BCAT[i] = f2bf(n < 64 ? f_re * bre - f_im * bim : f_re * bim + f_im * bre);
        const int c2 = (i / 128) % NC, n2 = i % 128, p2 = n2 & 63;
        const float cv = n2 < 64 ? p->in[17][((size_t)lg * NC + c2) * NP + p2] : -p->in[18][((size_t)lg * NC + c2) * NP + p2];
        CCAT[i] = f2bf(cv);
    }
}

__device__ __forceinline__ void s5_xtiles(f32x16 (&xr)[2], f32x16 (&xi)[2], const bf16x8 (&uf)[2], bf16x8 bre, bf16x8 bim) {
#pragma unroll
    for (int m = 0; m < 2; ++m) { xr[m] = MFMA32(uf[m], bre, (f32x16){}); xi[m] = MFMA32(uf[m], bim, (f32x16){}); }
}

__device__ __forceinline__ void st_s5_phaseA(KP p, int l, const Ctx& c) {
    const bf16_t* PROJ = (const bf16_t*)(p->ws + WS_PROJ);
    const f32x2_t* POW = (const f32x2_t*)(p->ws + WS_S5POW);
    const bf16_t* BCAT = (const bf16_t*)(p->ws + WS_S5BCAT);
    f32x2_t* SUM = (f32x2_t*)(p->ws + WS_S5SUM);
    const int lane = c.lane, c31 = lane & 31, h = lane >> 5;
    for (int item = c.gw; item < BATCH * S5_NSEG * NG; item += c.ngw) {
        const int g = item % NG, seg = (item / NG) % S5_NSEG, b = item / (NG * S5_NSEG);
        const int lg = l * NG + g;
        const size_t row0 = (size_t)b * SEQ + (size_t)seg * S5_SEGLEN;
#pragma unroll 1
        for (int pt = 0; pt < 2; ++pt) {
            const int pp = 32 * pt + c31;
            const f32x2_t* pw = POW + (size_t)lg * S5_NPOW * NP + pp;
            f32x2_t lo[4];
#pragma unroll
            for (int s = 0; s < 4; ++s) lo[s] = pw[(7 - 4 * h - s) * NP];
            const f32x2_t a8 = pw[8 * NP], a64 = pw[9 * NP];
            const bf16x8 bre = *(const bf16x8*)(BCAT + ((size_t)lg * 128 + pp) * NC + 8 * h);
            const bf16x8 bim = *(const bf16x8*)(BCAT + ((size_t)lg * 128 + 64 + pp) * NC + 8 * h);
            f32x2_t sseg = {0.f, 0.f};
#pragma unroll 1
            for (int ch = 0; ch < 4; ++ch) {
                bf16x8 uf[2];
#pragma unroll
                for (int m = 0; m < 2; ++m) uf[m] = *(const bf16x8*)(PROJ + (row0 + 64 * ch + 32 * m + c31) * IN_COLS + C_UB + 16 * g + 8 * h);
                f32x16 xr[2], xi[2];
                s5_xtiles(xr, xi, uf, bre, bim);
                f32x2_t f = {1.f, 0.f}, acc = {0.f, 0.f};
#pragma unroll
                for (int gi = 7; gi >= 0; --gi) {
                    const int m = gi >> 2, q = gi & 3;
                    f32x2_t t = {0.f, 0.f};
#pragma unroll
                    for (int s = 0; s < 4; ++s) { const f32x2_t x = {xr[m][4 * q + s], xi[m][4 * q + s]}; const f32x2_t w = cmul(lo[s], x); t.x += w.x; t.y += w.y; }
                    const f32x2_t w2 = cmul(f, t); acc.x += w2.x; acc.y += w2.y;
                    f = cmul(f, a8);
                }
                acc.x += __shfl_xor(acc.x, 32); acc.y += __shfl_xor(acc.y, 32);
                const f32x2_t d = cmul(a64, sseg); sseg.x = d.x + acc.x; sseg.y = d.y + acc.y;
            }
            if (h == 0) SUM[(((size_t)b * S5_NSEG + seg) * NG + g) * NP + pp] = sseg;
        }
    }
}

constexpr int S5_HT_STR = 144, S5_HT_BYTES = 64 * S5_HT_STR;
__device__ __forceinline__ void st_s5_phaseB(KP p, int l, const Ctx& c, LAS unsigned char* lds) {
    bf16_t* PROJ = (bf16_t*)(p->ws + WS_PROJ);
    const f32x2_t* POW = (const f32x2_t*)(p->ws + WS_S5POW); const f32x2_t* PINV = (const f32x2_t*)(p->ws + WS_S5PINV);
    const bf16_t* BCAT = (const bf16_t*)(p->ws + WS_S5BCAT); const bf16_t* CCAT = (const bf16_t*)(p->ws + WS_S5CCAT);
    const f32x2_t* SUM = (const f32x2_t*)(p->ws + WS_S5SUM);
    const int lane = c.lane, c31 = lane & 31, h = lane >> 5, i16 = lane & 15, kg = lane >> 4, qq = i16 >> 2, p4 = i16 & 3;
    LAS unsigned char* ht = lds + c.wave * S5_HT_BYTES;
    bf16x8 tdiag[2], tones;
#pragma unroll
    for (int s = 0; s < 2; ++s)
#pragma unroll
        for (int j = 0; j < 8; ++j) tdiag[s][j] = (16 * s + 8 * (j >> 2) + 4 * h + (j & 3) <= c31) ? (short)0x3F80 : (short)0;
#pragma unroll
    for (int j = 0; j < 8; ++j) tones[j] = (short)0x3F80;
    for (int item = c.gw; item < BATCH * S5_NSEG * NG; item += c.ngw) {
        const int g = item % NG, seg = (item / NG) % S5_NSEG, b = item / (NG * S5_NSEG);
        const int lg = l * NG + g;
        const size_t row0 = (size_t)b * SEQ + (size_t)seg * S5_SEGLEN;
        f32x2_t hin[2];
#pragma unroll
        for (int pt = 0; pt < 2; ++pt) {
            const int pp = 32 * pt + c31;
            const f32x2_t a256 = POW[((size_t)lg * S5_NPOW + 10) * NP + pp];
            f32x2_t H = {0.f, 0.f};
#pragma unroll
            for (int k = 0; k < S5_NSEG - 1; ++k) if (k < seg) { const f32x2_t sk = SUM[(((size_t)b * S5_NSEG + k) * NG + g) * NP + pp]; const f32x2_t d = cmul(a256, H); H.x = d.x + sk.x; H.y = d.y + sk.y; }
            hin[pt] = H;
        }
        const float dd = p->in[19][l * 512 + g * 16 + i16];
#pragma unroll 1
        for (int ch = 0; ch < 4; ++ch) {
            const size_t crow0 = row0 + 64 * ch;
            bf16x8 uf[2];
#pragma unroll
            for (int m = 0; m < 2; ++m) uf[m] = *(const bf16x8*)(PROJ + (crow0 + 32 * m + c31) * IN_COLS + C_UB + 16 * g + 8 * h);
            f32x4 Y[4];
#pragma unroll
            for (int it = 0; it < 4; ++it) Y[it] = (f32x4){0.f, 0.f, 0.f, 0.f};
#pragma unroll
            for (int pt = 0; pt < 2; ++pt) {
                const int pp = 32 * pt + c31;
                const bf16x8 bre = *(const bf16x8*)(BCAT + ((size_t)lg * 128 + pp) * NC + 8 * h);
                const bf16x8 bim = *(const bf16x8*)(BCAT + ((size_t)lg * 128 + 64 + pp) * NC + 8 * h);
                const f32x2_t* pw = POW + (size_t)lg * S5_NPOW * NP + pp; const f32x2_t* pi = PINV + (size_t)lg * S5_NINV * NP + pp;
                asm volatile("" : "+v"(pw), "+v"(pi));
                f32x2_t ilo[4], plo[4];
#pragma unroll
                for (int s = 0; s < 4; ++s) { ilo[s] = pi[(4 * h + s) * NP]; plo[s] = pw[(4 * h + s) * NP]; }
                const f32x2_t ia8 = pi[8 * NP], a8 = pw[8 * NP], a1 = pw[1 * NP];
                bf16x8 wfr[2][2], wfi[2][2];
                {
                    f32x2_t f = {1.f, 0.f};
#pragma unroll
                    for (int m = 0; m < 2; ++m) {
                        f32x16 xr = MFMA32(uf[m], bre, (f32x16){}), xi = MFMA32(uf[m], bim, (f32x16){});
#pragma unroll
                        for (int q = 0; q < 4; ++q) {
#pragma unroll
                            for (int s = 0; s < 4; ++s) { const f32x2_t x = {xr[4 * q + s], xi[4 * q + s]}; const f32x2_t w = cmul(f, cmul(ilo[s], x)); xr[4 * q + s] = w.x; xi[4 * q + s] = w.y; }
                            f = cmul(f, ia8);
                        }
#pragma unroll
                        for (int s2 = 0; s2 < 2; ++s2) {
                            wfr[m][s2] = pack8(xr[8 * s2], xr[8 * s2 + 1], xr[8 * s2 + 2], xr[8 * s2 + 3], xr[8 * s2 + 4], xr[8 * s2 + 5], xr[8 * s2 + 6], xr[8 * s2 + 7]);
                            wfi[m][s2] = pack8(xi[8 * s2], xi[8 * s2 + 1], xi[8 * s2 + 2], xi[8 * s2 + 3], xi[8 * s2 + 4], xi[8 * s2 + 5], xi[8 * s2 + 6], xi[8 * s2 + 7]);
                        }
                        __builtin_amdgcn_sched_barrier(0);
                    }
                }
                const f32x2_t G = cmul(a1, hin[pt]);
                f32x2_t hlast = {0.f, 0.f};
                WAVE_LDS_SYNC();
                {
                    f32x2_t f = {1.f, 0.f};
#pragma unroll
                    for (int m = 0; m < 2; ++m) {
                        f32x16 cr, ci;
                        if (m == 0) { cr = MFMA32(tdiag[1], wfr[0][1], MFMA32(tdiag[0], wfr[0][0], (f32x16){})); ci = MFMA32(tdiag[1], wfi[0][1], MFMA32(tdiag[0], wfi[0][0], (f32x16){})); }
                        else { cr = MFMA32(tdiag[1], wfr[1][1], MFMA32(tdiag[0], wfr[1][0], MFMA32(tones, wfr[0][1], MFMA32(tones, wfr[0][0], (f32x16){}))));
                               ci = MFMA32(tdiag[1], wfi[1][1], MFMA32(tdiag[0], wfi[1][0], MFMA32(tones, wfi[0][1], MFMA32(tones, wfi[0][0], (f32x16){})))); }
#pragma unroll
                        for (int q = 0; q < 4; ++q) {
                            float hr[4], hi[4];
#pragma unroll
                            for (int s = 0; s < 4; ++s) { const f32x2_t v = {cr[4 * q + s] + G.x, ci[4 * q + s] + G.y}; const f32x2_t w = cmul(f, cmul(plo[s], v)); hr[s] = w.x; hi[s] = w.y; }
                            if (m == 1 && q == 3) { hlast.x = hr[3]; hlast.y = hi[3]; }
                            typedef unsigned u32x2_t __attribute__((ext_vector_type(2)));
                            u32x2_t wr_; wr_.x = cvtpk(hr[0], hr[1]); wr_.y = cvtpk(hr[2], hr[3]);
                            u32x2_t wi_; wi_.x = cvtpk(hi[0], hi[1]); wi_.y = cvtpk(hi[2], hi[3]);
                            *(LAS u32x2_t*)(ht + c31 * S5_HT_STR + (32 * m + 8 * q + 4 * h) * 2) = wr_;
                            *(LAS u32x2_t*)(ht + (32 + c31) * S5_HT_STR + (32 * m + 8 * q + 4 * h) * 2) = wi_;
                            f = cmul(f, a8);
                        }
                        __builtin_amdgcn_sched_barrier(0);
                    }
                }
                hin[pt].x = __shfl(hlast.x, c31 + 32); hin[pt].y = __shfl(hlast.y, c31 + 32);
                WAVE_LDS_SYNC();
#pragma unroll
                for (int ks = 0; ks < 2; ++ks) {
                    const bf16x8 cf = *(const bf16x8*)(CCAT + ((size_t)lg * NC + i16) * 128 + 64 * ks + 32 * pt + 8 * kg);
#pragma unroll
                    for (int it = 0; it < 4; ++it) {
                        LAS const unsigned char* ap = ht + (32 * ks + 8 * kg + qq) * S5_HT_STR + (16 * it + 4 * p4) * 2;
                        const bf16x8 af = cat8(tr_read(ap), tr_read(ap + 4 * S5_HT_STR));
                        Y[it] = MFMA16(af, cf, Y[it]);
                    }
                }
            }
#pragma unroll
            for (int it = 0; it < 4; ++it)
#pragma unroll
                for (int r = 0; r < 4; ++r) {
                    bf16_t* up = PROJ + (crow0 + 16 * it + 4 * kg + r) * IN_COLS + C_UB + 16 * g + i16;
                    const float y = Y[it][r] + dd * bf2f(*up);
                    *up = f2bf(gelu_tanh(y));
                }
        }
        if (seg == S5_NSEG - 1 && h == 0) {
#pragma unroll
            for (int pt = 0; pt < 2; ++pt) { const size_t oi = (((size_t)l * BATCH + b) * NG + g) * NP + 32 * pt + c31; p->out[O_SRP + oi] = hin[pt].x; p->out[O_SIP + oi] = hin[pt].y; }
        }
    }
}

__device__ __forceinline__ void st_s5_simple(KP p, int l, const Ctx& c, LAS float* wsm) {
    bf16_t* PROJ = (bf16_t*)(p->ws + WS_PROJ);
    const float* AB = (const float*)(p->ws + WS_TAB + TAB_AB);
    const float* BB = (const float*)(p->ws + WS_TAB + TAB_BB);
    const int pp = c.lane;
    for (int item = c.gw; item < DEC_BATCH * NG; item += c.ngw) {
        const int seq = BATCH + item / NG, g = item % NG;
        const bool samp = seq >= BATCH;
        const int b = samp ? seq - BATCH : seq, T = samp ? DEC_SEQ : SEQ;
        const size_t row0 = samp ? (size_t)M_P + b * DEC_SEQ : (size_t)b * SEQ;
        const int sidx = (l * NG + g) * NP + pp;
        const float ab_re = AB[2 * sidx], ab_im = AB[2 * sidx + 1];
        float bbr[16], bbi[16], cr[16], ci[16];
#pragma unroll
        for (int cc = 0; cc < 16; ++cc) {
            bbr[cc] = BB[((size_t)sidx * NC + cc) * 2]; bbi[cc] = BB[((size_t)sidx * NC + cc) * 2 + 1];
            cr[cc] = p->in[17][((size_t)(l * NG + g) * NC + cc) * NP + pp]; ci[cc] = p->in[18][((size_t)(l * NG + g) * NC + cc) * NP + pp];
        }
        const float dd = pp < 16 ? p->in[19][l * 512 + g * 16 + pp] : 0.f;
        float hr = 0.f, hi = 0.f;
        if (samp) { const size_t si = (((size_t)l * DEC_BATCH + b) * NG + g) * NP + pp; hr = p->in[4][si]; hi = p->in[5][si]; }
        for (int t = 0; t < T; ++t) {
            bf16_t* up = PROJ + (row0 + t) * IN_COLS + C_UB + g * 16;
            float u[16];
#pragma unroll
            for (int cc = 0; cc < 16; ++cc) u[cc] = bf2f(up[cc]);
            float xr = 0.f, xi = 0.f;
#pragma unroll
            for (int cc = 0; cc < 16; ++cc) { xr += bbr[cc] * u[cc]; xi += bbi[cc] * u[cc]; }
            const float nr = ab_re * hr - ab_im * hi + xr, ni = ab_re * hi + ab_im * hr + xi;
            hr = nr; hi = ni;
#pragma unroll
            for (int cc = 0; cc < 16; ++cc) wsm[pp * 17 + cc] = cr[cc] * hr - ci[cc] * hi;
            WAVE_LDS_SYNC();
            if (pp < 16) {
                float y = 0.f;
                for (int q = 0; q < 64; ++q) y += wsm[q * 17 + pp];
                y += dd * bf2f(up[pp]);
                up[pp] = f2bf(gelu_tanh(y));
            }
            WAVE_LDS_SYNC();
        }
        if (!samp) { const size_t oi = (((size_t)l * BATCH + b) * NG + g) * NP + pp; p->out[O_SRP + oi] = hr; p->out[O_SIP + oi] = hi; }
        else { const size_t oi = (((size_t)l * DEC_BATCH + b) * NG + g) * NP + pp; p->out[O_SRS + oi] = hr; p->out[O_SIS + oi] = hi; }
    }
}

struct EpiGlu { bf16_t* PROJ; __device__ void operator()(int r, int c, float v) const {
    const float z = bf2f(PROJ[(size_t)r * IN_COLS + C_UB + c]), gb = bf2f(PROJ[(size_t)r * IN_COLS + C_GB + c]);
    PROJ[(size_t)r * IN_COLS + C_GB + c] = f2bf(z * sigmoidf_(v) * siluf_(gb)); } };

constexpr int LR_NSEG = 32;
__device__ __forceinline__ float neg_expm1_small(float y) {
    float q = 1.0f / 5040.0f; q = q * y + 1.0f / 720.0f; q = q * y + 1.0f / 120.0f; q = q * y + 1.0f / 24.0f; q = q * y + 1.0f / 6.0f; q = q * y + 0.5f; q = q * y + 1.0f; return -(q * y);
}
template <bool PHASE_B>
__device__ __forceinline__ void st_lru_mfma(KP p, int l, const Ctx& c, LAS unsigned char* lds) {
    bf16_t* PROJ = (bf16_t*)(p->ws + WS_PROJ);
    const bf16_t* LRUW = (const bf16_t*)(p->ws + WS_LRUW);
    f32x2_t* LSUM = (f32x2_t*)(p->ws + WS_LRSUM);
    for (int item = c.gw; item < BATCH * LR_NSEG * 8; item += c.ngw) {
        int zi = 0; asm volatile("" : "+v"(zi));
        const int lane = c.lane + zi, c31 = lane & 31, h = lane >> 5;
        const int n = item & 7, seg = (item >> 3) % LR_NSEG, b = item / (8 * LR_NSEG);
        const size_t row0 = (size_t)b * SEQ + (size_t)seg * 64;
        const int ch0 = n * 64;
        LAS unsigned char* xim = lds + c.wave * 9216;
        WAVE_LDS_SYNC();
#pragma unroll 1
        for (int ks = 0; ks < 4; ++ks) {
            const int chb = ch0 + 16 * ks + 8 * h;
            float w[4][8], cb[8];
#pragma unroll
            for (int j = 0; j < 4; ++j) {
                const f32x4 w0 = *(const f32x4*)(p->in[22] + (l * 4 + j) * 512 + chb), w1 = *(const f32x4*)(p->in[22] + (l * 4 + j) * 512 + chb + 4);
                w[j][0] = w0[0]; w[j][1] = w0[1]; w[j][2] = w0[2]; w[j][3] = w0[3]; w[j][4] = w1[0]; w[j][5] = w1[1]; w[j][6] = w1[2]; w[j][7] = w1[3];
            }
            { const f32x4 b0 = *(const f32x4*)(p->in[23] + l * 512 + chb), b1 = *(const f32x4*)(p->in[23] + l * 512 + chb + 4);
              cb[0] = b0[0]; cb[1] = b0[1]; cb[2] = b0[2]; cb[3] = b0[3]; cb[4] = b1[0]; cb[5] = b1[1]; cb[6] = b1[2]; cb[7] = b1[3]; }
#pragma unroll
            for (int m = 0; m < 2; ++m) {
                const int t = seg * 64 + 32 * m + c31;
                float xf[8];
#pragma unroll
                for (int e = 0; e < 8; ++e) xf[e] = cb[e];
#pragma unroll
                for (int j = 0; j < 4; ++j) {
                    u32x4 xx = (u32x4){0u, 0u, 0u, 0u};
                    if (t - 3 + j >= 0) xx = *(const u32x4*)(PROJ + (row0 + 32 * m + c31 - 3 + j) * IN_COLS + C_XC + chb);
#pragma unroll
                    for (int e = 0; e < 4; ++e) { xf[2 * e] += w[j][2 * e] * __uint_as_float(xx[e] << 16); xf[2 * e + 1] += w[j][2 * e + 1] * __uint_as_float(xx[e] & 0xffff0000u); }
                }
                *(LAS bf16x8*)(xim + (32 * m + c31) * 144 + (16 * ks + 8 * h) * 2) = pack8(xf[0], xf[1], xf[2], xf[3], xf[4], xf[5], xf[6], xf[7]);
            }
        }
        WAVE_LDS_SYNC();
#pragma unroll 1
        for (int et = 0; et < 2; ++et) {
            const int ch = ch0 + 32 * et + c31;
            const float ba = p->in[25][l * 512 + ch], bx = p->in[27][l * 512 + ch], lam = p->in[28][l * 512 + ch];
            const float lsig8 = -8.0f * log1pf(expf(-lam));
            const bf16_t* wp = LRUW + (((size_t)(l * 8 + n) * 2) * 64 + 32 * et + c31) * 64 + 8 * h;
            f32x16 R[2], I[2];
            float Ar[8], Br[8];
            __builtin_amdgcn_sched_barrier(0);
#pragma unroll
            for (int m = 0; m < 2; ++m) {
                f32x16 X = (f32x16){}; R[m] = (f32x16){}; I[m] = (f32x16){};
#pragma unroll
                for (int ks = 0; ks < 4; ++ks) {
                    const bf16x8 wa = *(const bf16x8*)(wp + 16 * ks), wx = *(const bf16x8*)(wp + 64 * 64 + 16 * ks);
                    bf16x8 id;
#pragma unroll
                    for (int j = 0; j < 8; ++j) id[j] = (16 * ks + 8 * h + j == 32 * et + c31) ? (short)0x3F80 : (short)0;
                    const bf16x8 afr = *(LAS const bf16x8*)(xim + (32 * m + c31) * 144 + (16 * ks + 8 * h) * 2);
                    R[m] = MFMA32(afr, wa, R[m]); I[m] = MFMA32(afr, wx, I[m]); X = MFMA32(afr, id, X);
                }
#pragma unroll
                for (int q = 0; q < 4; ++q) {
                    float cp = 1.f, hl = 0.f;
#pragma unroll
                    for (int s = 0; s < 4; ++s) {
                        const int r = 4 * q + s;
                        const float rg = sigmoidf_(R[m][r] + ba), ig = sigmoidf_(I[m][r] + bx);
                        const float la = rg * lsig8;
                        const float a = __expf(la);
                        const float bg = X[r] * ig * sqrtf(neg_expm1_small(2.0f * la));
                        cp *= a; hl = a * hl + bg;
                        R[m][r] = cp; I[m][r] = hl;
                    }
                    Ar[4 * m + q] = cp; Br[4 * m + q] = hl;
                }
                __builtin_amdgcn_sched_barrier(0);
            }
            float Hc = 0.f;
            if (PHASE_B) {
                for (int k0 = 0; k0 < seg; k0 += 8) {
                    f32x2_t ab[8];
#pragma unroll
                    for (int j = 0; j < 8; ++j) ab[j] = (k0 + j < seg) ? LSUM[((size_t)b * LR_NSEG + k0 + j) * 512 + ch] : (f32x2_t){1.f, 0.f};
#pragma unroll
                    for (int j = 0; j < 8; ++j) Hc = ab[j].x * Hc + ab[j].y;
                }
            }
            float st = Hc, At = 1.f, cin[8];
#pragma unroll
            for (int gi = 0; gi < 8; ++gi) {
                const float Ao = __shfl_xor(Ar[gi], 32), Bo = __shfl_xor(Br[gi], 32);
                const float A0 = h == 0 ? Ar[gi] : Ao, B0 = h == 0 ? Br[gi] : Bo, A1 = h == 0 ? Ao : Ar[gi], B1 = h == 0 ? Bo : Br[gi];
                const float s1 = A0 * st + B0;
                cin[gi] = h == 0 ? st : s1;
                st = A1 * s1 + B1; At *= A0 * A1;
            }
            if (!PHASE_B) {
                if (h == 0) LSUM[((size_t)b * LR_NSEG + seg) * 512 + ch] = (f32x2_t){At, st};
            } else {
#pragma unroll
                for (int m = 0; m < 2; ++m)
#pragma unroll
                    for (int r = 0; r < 16; ++r) {
                        const float hv = I[m][r] + R[m][r] * cin[4 * m + (r >> 2)];
                        bf16_t* gp = PROJ + (row0 + 32 * m + (r & 3) + 8 * (r >> 2) + 4 * h) * IN_COLS + C_GC + ch;
                        const float gc = bf2f(*gp);
                        *gp = f2bf(hv * siluf_(gc));
                        if (m == 1 && r == 15 && h == 1 && seg == LR_NSEG - 1) p->out[O_LP + ((size_t)l * BATCH + b) * 512 + ch] = hv;
                    }
            }
        }
    }
}

__device__ __forceinline__ void st_lru_simple(KP p, int l, const Ctx& c, LAS float* wsm) {
    bf16_t* PROJ = (bf16_t*)(p->ws + WS_PROJ);
    const int e = c.lane;
    for (int item = c.gw; item < DEC_BATCH * 8; item += c.ngw) {
        const int seq = BATCH + item / 8, n = item % 8, ch = n * 64 + e;
        const bool samp = seq >= BATCH;
        const int b = samp ? seq - BATCH : seq, T = samp ? DEC_SEQ : SEQ;
        const size_t row0 = samp ? (size_t)M_P + b * DEC_SEQ : (size_t)b * SEQ;
        float wa[64], wx[64];
#pragma unroll
        for (int d = 0; d < 64; ++d) { wa[d] = p->in[24][(((size_t)l * 8 + n) * 64 + d) * 64 + e]; wx[d] = p->in[26][(((size_t)l * 8 + n) * 64 + d) * 64 + e]; }
        const float ba = p->in[25][l * 512 + ch], bx = p->in[27][l * 512 + ch], lam = p->in[28][l * 512 + ch];
        const float lsig = -log1pf(expf(-lam));
        const float cw0 = p->in[22][(l * 4 + 0) * 512 + ch], cw1 = p->in[22][(l * 4 + 1) * 512 + ch], cw2 = p->in[22][(l * 4 + 2) * 512 + ch], cw3 = p->in[22][(l * 4 + 3) * 512 + ch];
        const float cb = p->in[23][l * 512 + ch];
        float xm3 = 0.f, xm2 = 0.f, xm1 = 0.f, h = 0.f;
        if (samp) {
            const size_t ci = (((size_t)l * DEC_BATCH + b) * 3) * 512 + ch;
            xm3 = p->in[7][ci]; xm2 = p->in[7][ci + 512]; xm1 = p->in[7][ci + 1024];
            h = p->in[6][((size_t)l * DEC_BATCH + b) * 512 + ch];
        }
        for (int t = 0; t < T; ++t) {
            bf16_t* rp = PROJ + (row0 + t) * IN_COLS;
            const float xc = bf2f(rp[C_XC + ch]);
            const float xf = cb + cw0 * xm3 + cw1 * xm2 + cw2 * xm1 + cw3 * xc;
            xm3 = xm2; xm2 = xm1; xm1 = xc;
            wsm[e] = xf;
            WAVE_LDS_SYNC();
            float r = ba, i = bx;
#pragma unroll
            for (int d = 0; d < 64; ++d) { const float xv = wsm[d]; r += xv * wa[d]; i += xv * wx[d]; }
            WAVE_LDS_SYNC();
            r = sigmoidf_(r); i = sigmoidf_(i);
            const float log_a = 8.0f * r * lsig;
            const float a = expf(log_a);
            const float bt = xf * i * sqrtf(-expm1f(2.0f * log_a));
            h = a * h + bt;
            const float gc = bf2f(rp[C_GC + ch]);
            rp[C_GC + ch] = f2bf(h * siluf_(gc));
        }
        if (!samp) {
            p->out[O_LP + ((size_t)l * BATCH + b) * 512 + ch] = h;
            const size_t ci = (((size_t)l * BATCH + b) * 3) * 512 + ch;
            p->out[O_CP + ci] = xm3; p->out[O_CP + ci + 512] = xm2; p->out[O_CP + ci + 1024] = xm1;
        } else {
            p->out[O_LS + ((size_t)l * DEC_BATCH + b) * 512 + ch] = h;
            const size_t ci = (((size_t)l * DEC_BATCH + b) * 3) * 512 + ch;
            p->out[O_CS + ci] = xm3; p->out[O_CS + ci + 512] = xm2; p->out[O_CS + ci + 1024] = xm1;
        }
    }
}

__device__ __forceinline__ void st_branch_simple(KP p, int l, const Ctx& c) {
    bf16_t* PROJ = (bf16_t*)(p->ws + WS_PROJ);
    const bf16_t* WB = (const bf16_t*)((unsigned char*)p->out + DO_WBR) + (size_t)l * 3 * 1024 * 512;
    const int lane = c.lane;
    const int ntn = 1024 / 32, ntiles = (M_TOT / 32) * ntn;
    for (int tile = c.gw; tile < ntiles; tile += c.ngw) {
        const int tm = tile / ntn, tn = tile % ntn;
        f32x16 acc[3];
#pragma unroll
        for (int br = 0; br < 3; ++br) {
            const int acol = br == 0 ? C_Q : (br == 1 ? C_GB : C_XC);
            acc[br] = (f32x16){};
            const bf16_t* ar = PROJ + (size_t)(tm * 32 + (lane & 31)) * IN_COLS + acol + 8 * (lane >> 5);
            const bf16_t* bp = WB + (size_t)br * 1024 * 512 + (size_t)(tn * 32 + (lane & 31)) * 512 + 8 * (lane >> 5);
            for (int k0 = 0; k0 < 512; k0 += 16)
                acc[br] = __builtin_amdgcn_mfma_f32_32x32x16_bf16(*(const bf16x8*)(ar + k0), *(const bf16x8*)(bp + k0), acc[br], 0, 0, 0);
        }
#pragma unroll
        for (int r = 0; r < 16; ++r) {
            const int row = tm * 32 + (r & 3) + 8 * (r >> 2) + 4 * (lane >> 5), col = tn * 32 + (lane & 31);
            bf16_t* gp = PROJ + (size_t)row * IN_COLS + C_GM + col;
            const float m = sigmoidf_(bf2f(gp[0])) * acc[0][r] + sigmoidf_(bf2f(gp[1024])) * acc[1][r] + sigmoidf_(bf2f(gp[2048])) * acc[2][r];
            gp[0] = f2bf(m);
        }
    }
}

__device__ __forceinline__ float* pre_row(unsigned char* ws, int r) { return (float*)(ws + WS_PROJ + (size_t)r * IN_COLS * 2 + (size_t)(C_GM + 1024) * 2); }
struct EpiOut { KP p; int l; __device__ void operator()(int r, int c, float v) const {
    float x;
    if (l == 0) x = r < M_P ? p->in[0][(size_t)r * D_MODEL + c] : p->in[1][(size_t)(r - M_P) * D_MODEL + c];
    else x = bf2f(((const bf16_t*)(p->ws + WS_XB))[(size_t)r * D_MODEL + c]);
    pre_row(p->ws, r)[c] = DN_ALPHA * x + v; } };

__device__ __forceinline__ void st_ln(KP p, int l, const Ctx& c) {
    const int lane = c.lane;
    const float* g = p->in[31] + l * 1024; const float* bb = p->in[32] + l * 1024;
    for (int r = c.gw; r < M_TOT; r += c.ngw) {
        const float* pr = pre_row(p->ws, r);
        float v[16]; float s = 0.f;
#pragma unroll
        for (int j = 0; j < 16; ++j) { v[j] = pr[lane + 64 * j]; s += v[j]; }
        for (int o = 32; o > 0; o >>= 1) s += __shfl_xor(s, o);
        const float mu = s * (1.0f / 1024.0f);
        float q = 0.f;
#pragma unroll
        for (int j = 0; j < 16; ++j) { const float d = v[j] - mu; q += d * d; }
        for (int o = 32; o > 0; o >>= 1) q += __shfl_xor(q, o);
        const float rstd = rsqrtf(q * (1.0f / 1024.0f) + LN_EPS);
#pragma unroll
        for (int j = 0; j < 16; ++j) {
            const int cc = lane + 64 * j;
            const float y = (v[j] - mu) * rstd * g[cc] + bb[cc];
            if (l == 0) ((bf16_t*)(p->ws + WS_XB))[(size_t)r * D_MODEL + cc] = f2bf(y);
            else if (r < M_P) p->out[O_YP + (size_t)r * D_MODEL + cc] = y;
            else p->out[O_YS + (size_t)(r - M_P) * D_MODEL + cc] = y;
        }
    }
}

__global__ void __launch_bounds__(NTHREADS, 2) mega_fwd(P p_unused) {
    extern __shared__ __attribute__((aligned(16))) unsigned char lds_raw[];
    LAS unsigned char* lds = (LAS unsigned char*)lds_raw;
    volatile LAS unsigned* misc = (volatile LAS unsigned*)(lds + LDS_MISC);
    if (threadIdx.x < 32) misc[threadIdx.x] = 0u;
    __syncthreads();
    XcdBarrier bar;
    { KP p = get_kp(); bar = xcd_barrier_post((unsigned*)(p->ws + WS_CTL), misc); }

    { KP p = get_kp(); const Ctx c = make_ctx(); unsigned char* dob = (unsigned char*)p->out;
      st_convert_x(p, c);
      st_prologue_weights(p, c, (LAS float*)(lds + c.wave * 9216));
      st_s5_tables(p, c); st_s5_tables2(p, c);
      { bf16_t* LRUW = (bf16_t*)(p->ws + WS_LRUW);
        for (size_t i = c.gt; i < (size_t)DEPTH * 8 * 2 * 64 * 64; i += c.ngt) {
            const int d = (int)(i & 63), e = (int)((i >> 6) & 63), mat = (int)((i >> 12) & 1), ln = (int)(i >> 13);
            LRUW[i] = f2bf(p->in[mat ? 26 : 24][((size_t)ln * 64 + d) * 64 + e]); } } }
    xcd_barrier(bar);

    for (int l = 0; l < DEPTH; ++l) {
        { KP p = get_kp(); int zs = 0; asm volatile("" : "+s"(zs));
          pg8::Gemm g{(const bf16_t*)(p->ws + WS_XB), D_MODEL, (const bf16_t*)((unsigned char*)p->out + DO_WIN) + (size_t)l * IN_COLS * 1024, 1024};
          pg8::StaticOrder S; S.init(M_TOT, IN_COLS, (int)gridDim.x + zs, (int)blockIdx.x + zs);
          pg8::gemm_phase<pg8::EpiProjB, pg8::StaticOrder, true, true>(lds, g, S, pg8::EpiProjB{(bf16_t*)(p->ws + WS_PROJ), IN_COLS}); }
        xcd_barrier(bar);
        { KP p = get_kp(); const Ctx c = make_ctx(); LAS float* wsm = (LAS float*)(lds + c.wave * 8192);
          st_kv_out(p, l, c);
          st_s5_simple(p, l, c, wsm);
          st_lru_simple(p, l, c, wsm);
          st_attn_simple(p, l, c);
          st_s5_phaseA(p, l, c);
          st_lru_mfma<false>(p, l, c, lds); }
        __syncthreads();
        { KP p = get_kp(); st_attn_prompt(p, l, lds); }
        xcd_barrier(bar);
        { KP p = get_kp(); const Ctx c = make_ctx(); st_s5_phaseB(p, l, c, lds); }
        { KP p = get_kp(); const Ctx c = make_ctx(); st_lru_mfma<true>(p, l, c, lds); }
        xcd_barrier(bar);
        { KP p = get_kp(); int zs = 0; asm volatile("" : "+s"(zs)); bf16_t* PROJ = (bf16_t*)(p->ws + WS_PROJ);
          pg8::Gemm g{PROJ + C_UB, IN_COLS, (const bf16_t*)((unsigned char*)p->out + DO_WGLU) + (size_t)l * 512 * 512, 512};
          pg8::StaticOrder S; S.init(M_TOT, 512, (int)gridDim.x + zs, (int)blockIdx.x + zs);
          pg8::gemm_phase<pg8::EpiGluB, pg8::StaticOrder, true, true>(lds, g, S, pg8::EpiGluB{PROJ}); }
        xcd_barrier(bar);
        { KP p = get_kp(); int zs = 0; asm volatile("" : "+s"(zs)); bf16_t* PROJ = (bf16_t*)(p->ws + WS_PROJ);
          pg8::Gemm g{PROJ, IN_COLS, (const bf16_t*)((unsigned char*)p->out + DO_WBR) + (size_t)l * 3 * 1024 * 512, 512};
          pg8::BranchOrder S; S.init(M_TOT, 1024, (int)gridDim.x + zs, (int)blockIdx.x + zs);
          pg8::gemm_phase<pg8::EpiBranchB, pg8::BranchOrder, true, true>(lds, g, S, pg8::EpiBranchB{PROJ}); }
        xcd_barrier(bar);
        { KP p = get_kp(); int zs = 0; asm volatile("" : "+s"(zs)); bf16_t* PROJ = (bf16_t*)(p->ws + WS_PROJ);
          pg8::Gemm g{PROJ + C_GM, IN_COLS, (const bf16_t*)(p->ws + WS_WOUT) + (size_t)l * 1024 * 1024, 1024};
          pg8::StaticOrder S; S.init(M_TOT, 1024, (int)gridDim.x + zs, (int)blockIdx.x + zs);
          pg8::gemm_phase<pg8::EpiOutB, pg8::StaticOrder, true, true>(lds, g, S, pg8::EpiOutB{p->in[0], p->in[1], (const bf16_t*)(p->ws + WS_XB), p->ws, l}); }
        xcd_barrier(bar);
        { KP p = get_kp(); const Ctx c = make_ctx(); st_ln(p, l, c); }
        if (l + 1 < DEPTH) xcd_barrier(bar);
    }
}

extern "C" void kernel_launch(void* const* d_in, const int* in_sizes, int n_in, void* d_out, int out_size, void* d_ws, size_t ws_size, hipStream_t stream) {
    static int grid = 0;
    if (grid == 0) {
        if (n_in != 33 || (size_t)out_size != O_END || ws_size < WS_CTL + CTL_BYTES) { fprintf(stderr, "kernel_launch: unexpected sizes n_in %d out %d ws %zu\n", n_in, out_size, ws_size); grid = -1; return; }
        int dev = 0, cus = 0, per_cu = 0;
        if (hipGetDevice(&dev) != hipSuccess || hipDeviceGetAttribute(&cus, hipDeviceAttributeMultiprocessorCount, dev) != hipSuccess) { grid = -1; return; }
        if (hipFuncSetAttribute((const void*)mega_fwd, hipFuncAttributeMaxDynamicSharedMemorySize, LDS_BYTES) != hipSuccess) { fprintf(stderr, "kernel_launch: hipFuncSetAttribute failed\n"); grid = -1; return; }
        if (hipOccupancyMaxActiveBlocksPerMultiprocessor(&per_cu, (const void*)mega_fwd, NTHREADS, LDS_BYTES) != hipSuccess || per_cu < 1) { fprintf(stderr, "kernel_launch: occupancy query says %d blocks/CU\n", per_cu); grid = -1; return; }
        grid = cus;
    }
    if (grid < 0) return;
    (void)hipMemsetAsync((unsigned char*)d_ws + WS_CTL, 0, CTL_BYTES, stream);
    P p{};
    for (int i = 0; i < 33; ++i) p.in[i] = (const float*)d_in[i];
    p.out = (float*)d_out; p.ws = (unsigned char*)d_ws;
    void* args[] = {&p};
    hipError_t e = hipLaunchCooperativeKernel((const void*)mega_fwd, dim3(grid), dim3(NTHREADS), args, LDS_BYTES, stream);
    if (e != hipSuccess) fprintf(stderr, "kernel_launch: cooperative launch failed: %s (grid %d)\n", hipGetErrorString(e), grid);
}
```

```cpp
#include <hip/hip_runtime.h>
#include <cstdint>
#include <cstdio>

typedef unsigned short bf16_t;
typedef short bf16x8 __attribute__((ext_vector_type(8)));
typedef float f32x16 __attribute__((ext_vector_type(16)));
typedef float f32x4 __attribute__((ext_vector_type(4)));

constexpr int D_MODEL = 1024, BATCH = 8, SEQ = 2048, DEPTH = 2, DEC_BATCH = 128, DEC_SEQ = 4;
constexpr int M_P = BATCH * SEQ;
constexpr int M_S = DEC_BATCH * DEC_SEQ;
constexpr int M_TOT = M_P + M_S;
constexpr int IN_COLS = 6400;
constexpr int C_Q = 0, C_K = 512, C_V = 640, C_GA = 768, C_UB = 1280, C_GB = 1792, C_XC = 2304, C_GC = 2816, C_GM = 3328;
constexpr int WINDOW = 128, NKV = 2, HD = 64, NQH = 8;
constexpr int NG = 32, NP = 64, NC = 16;
constexpr float DN_ALPHA = 1.4142135623730951f;
constexpr float LN_EPS = 1e-5f;

constexpr size_t O_YP = 0;
constexpr size_t O_YS = O_YP + (size_t)M_P * D_MODEL;
constexpr size_t O_KP = O_YS + (size_t)M_S * D_MODEL;
constexpr size_t SZ_KP = (size_t)DEPTH * BATCH * WINDOW * NKV * HD;
constexpr size_t O_VP = O_KP + SZ_KP;
constexpr size_t O_SRP = O_VP + SZ_KP;
constexpr size_t SZ_SP = (size_t)DEPTH * BATCH * NG * NP;
constexpr size_t O_SIP = O_SRP + SZ_SP;
constexpr size_t O_LP = O_SIP + SZ_SP;
constexpr size_t SZ_LP = (size_t)DEPTH * BATCH * 512;
constexpr size_t O_CP = O_LP + SZ_LP;
constexpr size_t SZ_CP = (size_t)DEPTH * BATCH * 3 * 512;
constexpr size_t O_KS = O_CP + SZ_CP;
constexpr size_t SZ_KS = (size_t)DEPTH * DEC_BATCH * WINDOW * NKV * HD;
constexpr size_t O_VS = O_KS + SZ_KS;
constexpr size_t O_SRS = O_VS + SZ_KS;
constexpr size_t SZ_SS = (size_t)DEPTH * DEC_BATCH * NG * NP;
constexpr size_t O_SIS = O_SRS + SZ_SS;
constexpr size_t O_LS = O_SIS + SZ_SS;
constexpr size_t SZ_LS = (size_t)DEPTH * DEC_BATCH * 512;
constexpr size_t O_CS = O_LS + SZ_LS;
constexpr size_t SZ_CS = (size_t)DEPTH * DEC_BATCH * 3 * 512;
constexpr size_t O_END = O_CS + SZ_CS;

constexpr size_t WS_PROJ = 0;
constexpr size_t WS_XB = WS_PROJ + (size_t)M_TOT * IN_COLS * 2;
constexpr size_t WS_WOUT = WS_XB + (size_t)M_TOT * D_MODEL * 2;
constexpr size_t WS_TAB = WS_WOUT + (size_t)DEPTH * 1024 * 1024 * 2;
constexpr size_t TAB_AB = 0;
constexpr size_t TAB_BB = TAB_AB + (size_t)DEPTH * NG * NP * 2 * 4;
constexpr size_t TAB_BYTES = TAB_BB + (size_t)DEPTH * NG * NP * NC * 2 * 4;
constexpr size_t WS_S5POW = WS_TAB + TAB_BYTES;
constexpr size_t WS_S5PINV = WS_S5POW + (size_t)DEPTH * NG * 11 * NP * 8;
constexpr size_t WS_S5BCAT = WS_S5PINV + (size_t)DEPTH * NG * 9 * NP * 8;
constexpr size_t WS_S5CCAT = WS_S5BCAT + (size_t)DEPTH * NG * 128 * NC * 2;
constexpr size_t WS_S5SUM = WS_S5CCAT + (size_t)DEPTH * NG * 128 * NC * 2;
constexpr size_t WS_LRUW = WS_S5SUM + (size_t)BATCH * 8 * NG * NP * 8;
constexpr size_t WS_LRSUM = WS_LRUW + (size_t)DEPTH * 8 * 2 * 64 * 64 * 2;
constexpr size_t WS_END = WS_LRSUM + (size_t)BATCH * 32 * 512 * 8;
constexpr size_t DO_WIN = 0;
constexpr size_t DO_WBR = DO_WIN + (size_t)DEPTH * IN_COLS * 1024 * 2;
constexpr size_t DO_WGLU = DO_WBR + (size_t)DEPTH * 3 * 1024 * 512 * 2;
constexpr size_t DO_LRUW = DO_WGLU + (size_t)DEPTH * 512 * 512 * 2;
constexpr size_t DO_END = DO_LRUW;
static_assert(DO_END <= (size_t)M_P * D_MODEL * 4, "weights fit in y_prompt region");
static_assert(WS_END <= 268435456ull, "workspace fits 256 MiB");

__constant__ unsigned char T5_BUCKET[128] = {0, 1, 2, 3, 4, 5, 6, 7, 8, 9, 10, 11, 12, 13, 14, 15, 16, 16, 16, 17, 17, 18, 18, 18, 19, 19, 19, 20, 20, 20, 20, 21, 21, 21, 21, 22, 22, 22, 22, 22, 23, 23, 23, 23, 23, 23, 24, 24, 24, 24, 24, 24, 25, 25, 25, 25, 25, 25, 25, 26, 26, 26, 26, 26, 26, 26, 26, 27, 27, 27, 27, 27, 27, 27, 27, 27, 27, 28, 28, 28, 28, 28, 28, 28, 28, 28, 28, 29, 29, 29, 29, 29, 29, 29, 29, 29, 29, 29, 29, 30, 30, 30, 30, 30, 30, 30, 30, 30, 30, 30, 30, 30, 30, 31, 31, 31, 31, 31, 31, 31, 31, 31, 31, 31, 31, 31, 31, 31};

__device__ __forceinline__ float bf2f(bf16_t v) { return __uint_as_float(((unsigned)v) << 16); }
__device__ __forceinline__ bf16_t f2bf(float f) { unsigned u = __float_as_uint(f); return (bf16_t)((u + 0x7fffu + ((u >> 16) & 1u)) >> 16); }
__device__ __forceinline__ float sigmoidf_(float x) { return 1.0f / (1.0f + __expf(-x)); }
__device__ __forceinline__ float siluf_(float x) { return x * sigmoidf_(x); }
__device__ __forceinline__ float gelu_tanh(float y) { const float t = tanhf(0.7978845608028654f * (y + 0.044715f * y * y * y)); return 0.5f * y * (1.0f + t); }

typedef unsigned u32x4 __attribute__((ext_vector_type(4)));
typedef float f32x2_t __attribute__((ext_vector_type(2)));
typedef __bf16 bf16x2_t __attribute__((ext_vector_type(2)));
__device__ __forceinline__ unsigned cvtpk(float lo, float hi) { f32x2_t v = {lo, hi}; bf16x2_t b = __builtin_convertvector(v, bf16x2_t); return __builtin_bit_cast(unsigned, b); }

struct P {
    const float* in[33];
    float* out;
    unsigned char* ws;
};

typedef const P __attribute__((address_space(4)))* KP;
__device__ __forceinline__ KP get_kp() { KP k = (KP)__builtin_amdgcn_kernarg_segment_ptr(); asm volatile("" : "+s"(k)); return k; }

constexpr size_t WS_CTL = (WS_END + 4095) & ~(size_t)4095;
constexpr size_t CTL_BYTES = 65536;
static_assert(WS_CTL + CTL_BYTES <= 268435456ull, "workspace fits 256 MiB");
constexpr int NTHREADS = 512, NWAVES = 8;
constexpr int LDS_BYTES = 147456;
constexpr int LDS_MISC = 135168;

#define LAS __attribute__((address_space(3)))
#define XB_TMO      128
#define XB_XCNT(j)  (256  + 64 * (j))
#define XB_XSUB(j)  (1280 + 64 * (j))
#define XB_XGEN(j)  (2304 + 64 * (j))
#define XB_TOP      3328
#define XB_TOPGEN   3392
#define XCD_BAR_WORDS 3456
#define XB_SPIN_CAP (1u << 18)
__device__ __forceinline__ unsigned xb_ld(unsigned* p)              { return __hip_atomic_load(p, __ATOMIC_RELAXED, __HIP_MEMORY_SCOPE_AGENT); }
__device__ __forceinline__ unsigned xb_add(unsigned* p, unsigned v) { return __hip_atomic_fetch_add(p, v, __ATOMIC_RELAXED, __HIP_MEMORY_SCOPE_AGENT); }
__device__ __forceinline__ unsigned xb_xcc_id() { return (unsigned)__builtin_amdgcn_s_getreg((3 << 11) | 20) & 0xFu; }
#define XB_SPIN(cond, bar) do { unsigned _sp = 0; while (cond) { __builtin_amdgcn_s_sleep(1); \
    if ((++_sp & 255u) == 0u) { if (xb_ld(&(bar)[XB_TMO])) break; if (_sp > XB_SPIN_CAP) { atomicAdd(&(bar)[XB_TMO], 1u); break; } } } } while (0)
struct XcdBarrier { unsigned* bar; unsigned x; volatile LAS unsigned* st; };
__device__ __forceinline__ XcdBarrier xcd_barrier_post(unsigned* bar, volatile LAS unsigned* st) {
    XcdBarrier b; b.bar = bar; b.x = xb_xcc_id(); b.st = st;
    if (threadIdx.x == 0) (void)xb_add(&bar[XB_XCNT(b.x)], 1u);
    return b;
}
__device__ __forceinline__ void xcd_barrier_complete(unsigned* bar, unsigned x, unsigned& nloc, unsigned& nx) {
    const unsigned G = gridDim.x * gridDim.y * gridDim.z;
    unsigned sum, cnt, mine, sp = 0u;
    for (;;) {
        sum = 0u; cnt = 0u; mine = 0u;
#pragma unroll
        for (unsigned j = 0; j < 16; ++j) { const unsigned c = xb_ld(&bar[XB_XCNT(j)]); sum += c; cnt += (c > 0u) ? 1u : 0u; mine = (j == x) ? c : mine; }
        if (sum == G) break;
        __builtin_amdgcn_s_sleep(1);
        if ((++sp & 255u) == 0u) { if (xb_ld(&bar[XB_TMO])) break; if (sp > XB_SPIN_CAP) { atomicAdd(&bar[XB_TMO], 1u); break; } }
    }
    nloc = mine > 0u ? mine : 1u; nx = cnt > 0u ? cnt : 1u;
}
__device__ __forceinline__ void xcd_barrier(const XcdBarrier& b) {
    asm volatile("s_waitcnt vmcnt(0)" ::: "memory");
    __syncthreads();
    if (threadIdx.x == 0) {
        unsigned* bar = b.bar; asm volatile("" : "+s"(bar));
        unsigned bx = b.x; asm volatile("" : "+s"(bx));
        __builtin_amdgcn_s_waitcnt(0);
        unsigned nloc = b.st[0], nx = b.st[1];
        if (nloc == 0u) { xcd_barrier_complete(bar, bx, nloc, nx); b.st[0] = nloc; b.st[1] = nx; }
        const unsigned old = xb_add(&bar[XB_XSUB(bx)], 1u);
        const unsigned gen = old / nloc;
        if (old + 1u == (gen + 1u) * nloc) {
            __builtin_amdgcn_fence(__ATOMIC_RELEASE, "agent");
            asm volatile("s_waitcnt vmcnt(0)" ::: "memory");
            const unsigned og = xb_add(&bar[XB_TOP], 1u);
            const unsigned tg = og / nx;
            if (og + 1u == (tg + 1u) * nx) xb_add(&bar[XB_TOPGEN], 1u);
            else XB_SPIN(xb_ld(&bar[XB_TOPGEN]) == tg, bar);
            __builtin_amdgcn_fence(__ATOMIC_ACQUIRE, "agent");
            xb_add(&bar[XB_XGEN(bx)], 1u);
            asm volatile("s_waitcnt vmcnt(0)" ::: "memory");
        } else {
            XB_SPIN(xb_ld(&bar[XB_XGEN(bx)]) == gen, bar);
            __builtin_amdgcn_fence(__ATOMIC_ACQUIRE, "agent");
            asm volatile("s_waitcnt vmcnt(0)" ::: "memory");
        }
    }
    __syncthreads();
}

namespace pg8 {
#define PG8_LAS __attribute__((address_space(3)))
typedef unsigned short bf16_t;
typedef short bf16x8 __attribute__((ext_vector_type(8)));
typedef float f32x4 __attribute__((ext_vector_type(4)));
typedef unsigned u32x4 __attribute__((ext_vector_type(4)));
constexpr int BM = 256, BK = 64, HALF = 128, HTB = HALF * BK * 2  , STAGE_BYTES = 8 * HTB, NXCD = 8, WGM = 8;

__host__ __device__ __forceinline__ int lds_byte(int r, int c) { const int st = (r >> 4) * 2 + (c >> 5), rr = r & 15, cc = c & 31, ob = rr * 64 + cc * 2; return st * 1024 + (ob ^ (((ob >> 9) & 1) << 5)); }
__host__ __device__ __forceinline__ void stage_rc(int b, int& R, int& C) { const int st = b / 1024, sb = b % 1024, swz = sb ^ (((sb >> 9) & 1) << 5); R = (st >> 1) * 16 + swz / 64; C = (st & 1) * 32 + (swz % 64) / 2; }
__host__ __device__ __forceinline__ int perm32(int rho) { const int n = rho >> 4, i = rho & 15; return 8 * (i >> 2) + 4 * n + (i & 3); }

struct Unit { int pm, pn, z; };
struct Gemm { const bf16_t* A; int lda; const bf16_t* Bt; int K; };

struct StaticOrder {
    int nM, nN, nwg, G, c;
    __host__ __device__ void init(int M, int N, int G_, int c_) { nM = M / BM; nN = N / BM; nwg = nM * nN; G = G_; c = c_; }
    __host__ __device__ bool next(int i, Unit& u) const {
        const long L = (long)i * G + c; if (L >= nwg) return false;
        int wgid = (int)L; { const int q = nwg / NXCD, r = nwg % NXCD, xcd = wgid % NXCD, off = wgid / NXCD; wgid = (xcd < r ? xcd * (q + 1) : r * (q + 1) + (xcd - r) * q) + off; }
        const int nig = WGM * nN, gid = wgid / nig, fm = gid * WGM, gsz = (nM - fm) < WGM ? (nM - fm) : WGM;
        u.pm = fm + ((wgid % nig) % gsz); u.pn = (wgid % nig) / gsz; u.z = 0; return true;
    }
    __device__ __forceinline__ size_t a_off(const Unit&) const { return 0; }
    __device__ __forceinline__ size_t b_off(const Unit&) const { return 0; }
    __device__ __forceinline__ void a_ready(const Unit&) const {}
    __device__ __forceinline__ void done(const Unit&) const {}
};

__device__ __forceinline__ unsigned cvt_pk_bf16(float lo, float hi) { unsigned r; asm volatile("v_cvt_pk_bf16_f32 %0, %1, %2" : "=v"(r) : "v"(lo), "v"(hi)); return r; }
typedef float f32x2 __attribute__((ext_vector_type(2)));
__device__ __forceinline__ f32x2 gelu_pk(f32x2 v) {
    const f32x2 av = __builtin_elementwise_abs(v), d = av * 0.2316418882f + 1.0f;
    f32x2 t; t.x = __builtin_amdgcn_rcpf(d.x); t.y = __builtin_amdgcn_rcpf(d.y);
    f32x2 q = t * 0.5307027145f + (-0.7265760135f); q = q * t + 0.7107068705f; q = q * t + (-0.142248368f); q = q * t + 0.127414796f; q = q * t;
    const f32x2 s = (v * v) * (-0.72134752044f);
    f32x2 e; e.x = __builtin_amdgcn_exp2f(s.x); e.y = __builtin_amdgcn_exp2f(s.y);
    const f32x2 m = v * (q * e), r = v - m;
    f32x2 o; o.x = v.x < 0.f ? m.x : r.x; o.y = v.y < 0.f ? m.y : r.y; return o;
}

template <class Epi, class Sched, bool ALIGN_EPI = false, bool SP2 = false>
__device__ __forceinline__ void gemm_phase(PG8_LAS unsigned char* lds, const Gemm g, const Sched& S, const Epi& E) {
    int zv_ = 0; asm volatile("" : "+v"(zv_));
    const int tid = (int)threadIdx.x + zv_, wid = __builtin_amdgcn_readfirstlane(tid >> 6), lane = tid & 63, wr = wid >> 2, wc = wid & 3, fr = lane & 15, fq = lane >> 4;
    const int K = g.K, nt = K / BK;
    unsigned voffA[2], voffB[2];
#pragma unroll
    for (int i = 0; i < 2; ++i) { int R, C; stage_rc(tid * 16 + i * 8192, R, C); const int Rb = Epi::PERM ? ((R & ~31) + perm32(R & 31)) : R;
        voffA[i] = (unsigned)(R * g.lda + C) * 2u; voffB[i] = (unsigned)(Rb * K + C) * 2u; }
    const size_t kstep = (size_t)(BK * 2);
    const size_t hstepA = (size_t)HALF * g.lda * 2, hstepB = (size_t)HALF * K * 2;
    const size_t tstepA = 2 * hstepA, tstepB = 2 * hstepB;
    const unsigned ldsw = (unsigned)wid * 1024u;
    const int aoff = lds_byte(wr * 64 + fr, fq * 8), boff = lds_byte(wc * 32 + fr, fq * 8);
#define PG8_SA(b, h) (((b) * 2 + (h)) * HTB)
#define PG8_SB(b, h) ((4 + (b) * 2 + (h)) * HTB)
#define PG8_STAGE(bufoff, gbase, voff) do { _Pragma("unroll") for (int _i = 0; _i < 2; ++_i) \
        __builtin_amdgcn_global_load_lds((const unsigned*)((const char*)(gbase) + (voff)[_i]), (PG8_LAS unsigned*)(lds + (bufoff) + ldsw + _i * 8192), 16, 0, 0); } while (0)
#define PG8_LDA(dst, b, h) do { _Pragma("unroll") for (int m = 0; m < 4; ++m) _Pragma("unroll") for (int k = 0; k < 2; ++k) dst[m][k] = *(const PG8_LAS bf16x8*)(lds + PG8_SA(b, h) + aoff + m * 2048 + k * 1024); } while (0)
#define PG8_LDB(dst, b, h) do { _Pragma("unroll") for (int n = 0; n < 2; ++n) _Pragma("unroll") for (int k = 0; k < 2; ++k) dst[n][k] = *(const PG8_LAS bf16x8*)(lds + PG8_SB(b, h) + boff + n * 2048 + k * 1024); } while (0)
#define PG8_MMA(ai, bj, At, Bt) do { __builtin_amdgcn_s_setprio(1); _Pragma("unroll") for (int m = 0; m < 4; ++m) _Pragma("unroll") for (int n = 0; n < 2; ++n) _Pragma("unroll") for (int k = 0; k < 2; ++k) \
        acc[ai][bj][m][n] = __builtin_amdgcn_mfma_f32_16x16x32_bf16(Bt[n][k], At[m][k], acc[ai][bj][m][n], 0, 0, 0); __builtin_amdgcn_s_setprio(0); } while (0)
#define PG8_WAIT_V(n) asm volatile("s_waitcnt vmcnt(" #n ")" ::: "memory")
#define PG8_WAIT_L(n) asm volatile("s_waitcnt lgkmcnt(" #n ")" ::: "memory")
#define PG8_BAR __builtin_amdgcn_s_barrier()
#define PG8_SCHED __builtin_amdgcn_sched_barrier(0)
    Unit cur, nxt; int ui = 0;
    if (!S.next(0, cur)) return;
    f32x4 acc[2][2][4][2];
#pragma unroll
    for (int a = 0; a < 2; ++a)
#pragma unroll
        for (int b = 0; b < 2; ++b)
#pragma unroll
            for (int m = 0; m < 4; ++m)
#pragma unroll
                for (int n = 0; n < 2; ++n) acc[a][b][m][n] = (f32x4){0.f, 0.f, 0.f, 0.f};
    bf16x8 At[4][2], B0[2][2], B1[2][2];
    const char* cA = (const char*)g.A + (size_t)cur.pm * tstepA + S.a_off(cur); const char* cB = (const char*)g.Bt + (size_t)cur.pn * tstepB + S.b_off(cur);
    S.a_ready(cur);
    if constexpr (SP2) {
        PG8_STAGE(PG8_SB(0, 0), cB, voffB); PG8_STAGE(PG8_SB(0, 1), cB + hstepB, voffB); PG8_STAGE(PG8_SA(0, 0), cA, voffA); PG8_STAGE(PG8_SA(0, 1), cA + hstepA, voffA);
        if (wr == 1) PG8_BAR;
        PG8_WAIT_V(2); PG8_BAR;
        PG8_STAGE(PG8_SB(1, 0), cB + kstep, voffB); PG8_STAGE(PG8_SA(1, 0), cA + kstep, voffA); PG8_STAGE(PG8_SB(1, 1), cB + hstepB + kstep, voffB);
        PG8_WAIT_V(6); PG8_BAR;
    } else {
        PG8_STAGE(PG8_SB(0, 0), cB, voffB); PG8_STAGE(PG8_SA(0, 0), cA, voffA); PG8_STAGE(PG8_SB(0, 1), cB + hstepB, voffB); PG8_STAGE(PG8_SA(0, 1), cA + hstepA, voffA);
        if (wr == 1) PG8_BAR;
        PG8_WAIT_V(4); PG8_BAR;
        PG8_STAGE(PG8_SB(1, 0), cB + kstep, voffB); PG8_STAGE(PG8_SA(1, 0), cA + kstep, voffA); PG8_STAGE(PG8_SB(1, 1), cB + hstepB + kstep, voffB);
        PG8_WAIT_V(6); PG8_BAR;
    }
    for (;;) {
        const bool has_next = S.next(ui + 1, nxt);
        const char* nA = has_next ? (const char*)g.A + (size_t)nxt.pm * tstepA + S.a_off(nxt) : cA; const char* nB = has_next ? (const char*)g.Bt + (size_t)nxt.pn * tstepB + S.b_off(nxt) : cB;
        for (int t = 0; t < nt; t += 2) {
            const bool last = (t == nt - 2);
            const char* a1 = cA + (size_t)(t + 1) * kstep;
            const char* a2 = last ? nA : cA + (size_t)(t + 2) * kstep; const char* b2 = last ? nB : cB + (size_t)(t + 2) * kstep;
            const char* a3 = a2 + kstep; const char* b3 = b2 + kstep;
            if (last && has_next) S.a_ready(nxt);
            if constexpr (SP2) {
            PG8_LDB(B0, 0, 0); PG8_LDB(B1, 0, 1); PG8_SCHED; PG8_LDA(At, 0, 0); PG8_STAGE(PG8_SA(1, 1), a1 + hstepA, voffA);
            PG8_WAIT_V(8); PG8_WAIT_L(0); PG8_BAR; PG8_MMA(0, 0, At, B0); PG8_MMA(0, 1, At, B1); PG8_BAR; PG8_SCHED;
            PG8_LDA(At, 0, 1); PG8_STAGE(PG8_SB(0, 0), b2, voffB); PG8_STAGE(PG8_SB(0, 1), b2 + hstepB, voffB); PG8_STAGE(PG8_SA(0, 0), a2, voffA);
            PG8_WAIT_V(8); PG8_WAIT_L(0); PG8_BAR; PG8_MMA(1, 0, At, B0); PG8_MMA(1, 1, At, B1); PG8_BAR; PG8_SCHED;
            PG8_LDB(B0, 1, 0); PG8_LDB(B1, 1, 1); PG8_SCHED; PG8_LDA(At, 1, 0); PG8_STAGE(PG8_SA(0, 1), a2 + hstepA, voffA);
            PG8_WAIT_V(8); PG8_WAIT_L(0); PG8_BAR; PG8_MMA(0, 0, At, B0); PG8_MMA(0, 1, At, B1); PG8_BAR; PG8_SCHED;
            PG8_LDA(At, 1, 1); PG8_STAGE(PG8_SB(1, 0), b3, voffB); PG8_STAGE(PG8_SB(1, 1), b3 + hstepB, voffB); PG8_STAGE(PG8_SA(1, 0), a3, voffA);
            PG8_WAIT_V(8); PG8_WAIT_L(0); PG8_BAR; PG8_MMA(1, 0, At, B0); PG8_MMA(1, 1, At, B1); PG8_BAR; PG8_SCHED;
            } else {
            PG8_LDB(B0, 0, 0); PG8_SCHED; PG8_LDA(At, 0, 0); PG8_STAGE(PG8_SA(1, 1), a1 + hstepA, voffA);
            PG8_WAIT_L(8); PG8_BAR; PG8_WAIT_L(0); PG8_MMA(0, 0, At, B0); PG8_BAR; PG8_SCHED;
            PG8_LDB(B1, 0, 1); PG8_STAGE(PG8_SB(0, 0), b2, voffB);
            PG8_BAR; PG8_WAIT_L(0); PG8_MMA(0, 1, At, B1); PG8_BAR;
            PG8_LDA(At, 0, 1); PG8_STAGE(PG8_SA(0, 0), a2, voffA);
            PG8_BAR; PG8_WAIT_L(0); PG8_MMA(1, 0, At, B0); PG8_BAR; PG8_SCHED;
            PG8_STAGE(PG8_SB(0, 1), b2 + hstepB, voffB);
            PG8_WAIT_V(6); PG8_BAR; PG8_MMA(1, 1, At, B1); PG8_BAR;
            PG8_LDB(B0, 1, 0); PG8_SCHED; PG8_LDA(At, 1, 0); PG8_STAGE(PG8_SA(0, 1), a2 + hstepA, voffA);
            PG8_WAIT_L(8); PG8_BAR; PG8_WAIT_L(0); PG8_MMA(0, 0, At, B0); PG8_BAR; PG8_SCHED;
            PG8_LDB(B1, 1, 1); PG8_STAGE(PG8_SB(1, 0), b3, voffB);
            PG8_BAR; PG8_WAIT_L(0); PG8_MMA(0, 1, At, B1); PG8_BAR;
            PG8_LDA(At, 1, 1); PG8_STAGE(PG8_SA(1, 0), a3, voffA);
            PG8_BAR; PG8_WAIT_L(0); PG8_MMA(1, 0, At, B0); PG8_BAR; PG8_SCHED;
            PG8_STAGE(PG8_SB(1, 1), b3 + hstepB, voffB);
            PG8_WAIT_V(6); PG8_BAR; PG8_MMA(1, 1, At, B1); PG8_BAR;
            }
        }
        if constexpr (ALIGN_EPI) { if (wr == 0) PG8_BAR; }
        if constexpr (!Epi::AFTER_DRAIN) { E(acc, cur, wr, wc, fr, fq); S.done(cur); }
        if (!has_next) break;
#pragma unroll
        for (int a = 0; a < 2; ++a)
#pragma unroll
            for (int b = 0; b < 2; ++b)
#pragma unroll
                for (int m = 0; m < 4; ++m)
#pragma unroll
                    for (int n = 0; n < 2; ++n) acc[a][b][m][n] = (f32x4){0.f, 0.f, 0.f, 0.f};
        cur = nxt; cA = nA; cB = nB; ++ui;
        if constexpr (ALIGN_EPI) { if (wr == 1) PG8_BAR; }
    }
    PG8_WAIT_V(0);
    if constexpr (!ALIGN_EPI) { if (wr == 0) PG8_BAR; }
    PG8_BAR;
    if constexpr (Epi::AFTER_DRAIN) { E.fused(acc, cur, wr, wc, fr, fq, lds, wid, lane); S.done(cur); }
#undef PG8_SA
#undef PG8_SB
#undef PG8_STAGE
#undef PG8_LDA
#undef PG8_LDB
#undef PG8_MMA
#undef PG8_WAIT_V
#undef PG8_WAIT_L
#undef PG8_BAR
#undef PG8_SCHED
}
}

namespace pg8 {
typedef unsigned u32x2 __attribute__((ext_vector_type(2)));
__device__ __forceinline__ float bflo(unsigned w) { return __uint_as_float(w << 16); }
__device__ __forceinline__ float bfhi(unsigned w) { return __uint_as_float(w & 0xffff0000u); }
__device__ __forceinline__ float sigm(float x) { return __builtin_amdgcn_rcpf(1.0f + __expf(-x)); }
struct EpiProjB {
    static constexpr bool PERM = true, AFTER_DRAIN = false;
    bf16_t* O; int ldc;
    __device__ __forceinline__ void operator()(const f32x4 (&acc)[2][2][4][2], const Unit& u, int wr, int wc, int fr, int fq) const {
        const int row0 = u.pm * BM + wr * 64 + fr, col0 = u.pn * BM + wc * 32 + 8 * fq;
#pragma unroll
        for (int ai = 0; ai < 2; ++ai)
#pragma unroll
            for (int m = 0; m < 4; ++m) { bf16_t* rowp = O + (size_t)(row0 + ai * HALF + m * 16) * ldc + col0;
#pragma unroll
                for (int bj = 0; bj < 2; ++bj) { const f32x4 v0 = acc[ai][bj][m][0], v1 = acc[ai][bj][m][1];
                    u32x4 w; w.x = cvt_pk_bf16(v0[0], v0[1]); w.y = cvt_pk_bf16(v0[2], v0[3]); w.z = cvt_pk_bf16(v1[0], v1[1]); w.w = cvt_pk_bf16(v1[2], v1[3]);
                    *(u32x4*)(rowp + bj * HALF) = w; } }
    }
};
struct EpiGluB {
    static constexpr bool PERM = true, AFTER_DRAIN = false;
    bf16_t* PROJ; bool dry;
    __device__ __forceinline__ void operator()(const f32x4 (&acc)[2][2][4][2], const Unit& u, int wr, int wc, int fr, int fq) const {
        const int row0 = u.pm * BM + wr * 64 + fr, col0 = u.pn * BM + wc * 32 + 8 * fq;
#pragma unroll
        for (int ai = 0; ai < 2; ++ai)
#pragma unroll
            for (int m = 0; m < 4; ++m) { bf16_t* rowp = PROJ + (size_t)(row0 + ai * HALF + m * 16) * IN_COLS + col0;
#pragma unroll
                for (int bj = 0; bj < 2; ++bj) {
                    const u32x4 zz = *(const u32x4*)(rowp + C_UB + bj * HALF), gg = *(const u32x4*)(rowp + C_GB + bj * HALF);
                    const f32x4 v0 = acc[ai][bj][m][0], v1 = acc[ai][bj][m][1];
                    float o[8];
#pragma unroll
                    for (int e = 0; e < 4; ++e) {
                        const float va = e < 2 ? v0[2 * e] : v1[2 * (e - 2)], vb = e < 2 ? v0[2 * e + 1] : v1[2 * (e - 2) + 1];
                        const float za = bflo(zz[e]), zb = bfhi(zz[e]), ga = bflo(gg[e]), gb = bfhi(gg[e]);
                        o[2 * e] = za * sigm(va) * ga * sigm(ga); o[2 * e + 1] = zb * sigm(vb) * gb * sigm(gb);
                    }
                    u32x4 w; w.x = cvt_pk_bf16(o[0], o[1]); w.y = cvt_pk_bf16(o[2], o[3]); w.z = cvt_pk_bf16(o[4], o[5]); w.w = cvt_pk_bf16(o[6], o[7]);
                    if (!dry) *(u32x4*)(rowp + C_GB + bj * HALF) = w; } }
    }
};
struct EpiBranchB {
    static constexpr bool PERM = true, AFTER_DRAIN = false;
    bf16_t* PROJ; bool dry;
    __device__ __forceinline__ void operator()(const f32x4 (&acc)[2][2][4][2], const Unit& u, int wr, int wc, int fr, int fq) const {
        const int row0 = u.pm * BM + wr * 64 + fr, col0 = u.pn * BM + wc * 32 + 8 * fq;
        const int z = u.z;
#pragma unroll
        for (int ai = 0; ai < 2; ++ai)
#pragma unroll
            for (int m = 0; m < 4; ++m) { bf16_t* rowp = PROJ + (size_t)(row0 + ai * HALF + m * 16) * IN_COLS + C_GM + col0;
#pragma unroll
                for (int bj = 0; bj < 2; ++bj) {
                    const u32x4 gg = *(const u32x4*)(rowp + z * 1024 + bj * HALF);
                    u32x4 pp = (u32x4){0u, 0u, 0u, 0u};
                    if (z > 0) pp = *(const u32x4*)(rowp + bj * HALF);
                    const f32x4 v0 = acc[ai][bj][m][0], v1 = acc[ai][bj][m][1];
                    float o[8];
#pragma unroll
                    for (int e = 0; e < 4; ++e) {
                        const float va = e < 2 ? v0[2 * e] : v1[2 * (e - 2)], vb = e < 2 ? v0[2 * e + 1] : v1[2 * (e - 2) + 1];
                        o[2 * e] = bflo(pp[e]) + sigm(bflo(gg[e])) * va; o[2 * e + 1] = bfhi(pp[e]) + sigm(bfhi(gg[e])) * vb;
                    }
                    u32x4 w; w.x = cvt_pk_bf16(o[0], o[1]); w.y = cvt_pk_bf16(o[2], o[3]); w.z = cvt_pk_bf16(o[4], o[5]); w.w = cvt_pk_bf16(o[6], o[7]);
                    if (!dry) *(u32x4*)(rowp + bj * HALF) = w; } }
    }
};
struct BranchOrder : StaticOrder {
    __device__ bool next(int i, Unit& u) const { if (!StaticOrder::next(i / 3, u)) return false; u.z = i % 3; return true; }
    __device__ __forceinline__ size_t a_off(const Unit& u) const { return (size_t)(u.z == 0 ? C_Q : (u.z == 1 ? C_GB : C_GC)) * 2; }
    __device__ __forceinline__ size_t b_off(const Unit& u) const { return (size_t)u.z * 1024 * 512 * 2; }
};
struct EpiOutB {
    static constexpr bool PERM = false, AFTER_DRAIN = false;
    const float* xp; const float* xs; const bf16_t* XB; unsigned char* ws; int l;
    __device__ __forceinline__ void operator()(const f32x4 (&acc)[2][2][4][2], const Unit& u, int wr, int wc, int fr, int fq) const {
        const int row0 = u.pm * BM + wr * 64 + fr, col0 = u.pn * BM + wc * 32 + 4 * fq;
#pragma unroll
        for (int ai = 0; ai < 2; ++ai)
#pragma unroll
            for (int m = 0; m < 4; ++m) { const int r = row0 + ai * HALF + m * 16;
                float* prow = (float*)(ws + WS_PROJ + (size_t)r * IN_COLS * 2 + (size_t)(C_GM + 1024) * 2) + col0;
#pragma unroll
                for (int bj = 0; bj < 2; ++bj)
#pragma unroll
                    for (int n = 0; n < 2; ++n) {
                        const int co = bj * HALF + n * 16;
                        f32x4 x;
                        if (l == 0) x = r < M_P ? *(const f32x4*)(xp + (size_t)r * D_MODEL + col0 + co) : *(const f32x4*)(xs + (size_t)(r - M_P) * D_MODEL + col0 + co);
                        else { const u32x2 xx = *(const u32x2*)(XB + (size_t)r * D_MODEL + col0 + co); x = (f32x4){bflo(xx.x), bfhi(xx.x), bflo(xx.y), bfhi(xx.y)}; }
                        *(f32x4*)(prow + co) = x * DN_ALPHA + acc[ai][bj][m][n];
                    } }
    }
};
}

struct Ctx { int tid, lane, wave, gw, ngw; size_t gt, ngt; };
__device__ __forceinline__ Ctx make_ctx() {
    int zv = 0; asm volatile("" : "+v"(zv)); int zs = 0; asm volatile("" : "+s"(zs));
    Ctx c; c.tid = (int)threadIdx.x + zv; c.lane = c.tid & 63; c.wave = __builtin_amdgcn_readfirstlane(c.tid >> 6);
    const int bid = (int)blockIdx.x + zs, nb = (int)gridDim.x + zs;
    c.gw = c.wave * nb + bid; c.ngw = nb * NWAVES; c.gt = (size_t)bid * NTHREADS + c.tid; c.ngt = (size_t)nb * NTHREADS; return c;
}
#define WAVE_LDS_SYNC() do { asm volatile("s_waitcnt lgkmcnt(0)" ::: "memory"); __builtin_amdgcn_wave_barrier(); } while (0)

__device__ __forceinline__ void st_convert_x(KP p, const Ctx& c) {
    u32x4* XB = (u32x4*)(p->ws + WS_XB);
    const size_t n8 = (size_t)M_TOT * D_MODEL / 8, np8 = (size_t)M_P * D_MODEL / 8;
    for (size_t i = c.gt; i < n8; i += c.ngt) {
        const f32x4* src = i < np8 ? (const f32x4*)p->in[0] + 2 * i : (const f32x4*)p->in[1] + 2 * (i - np8);
        const f32x4 a = src[0], b = src[1];
        u32x4 o; o.x = cvtpk(a[0], a[1]); o.y = cvtpk(a[2], a[3]); o.z = cvtpk(b[0], b[1]); o.w = cvtpk(b[2], b[3]);
        XB[i] = o;
    }
}
__device__ __forceinline__ void st_transpose_w(const float* W, bf16_t* WT, int K, int N, const Ctx& c) {
    const size_t n = (size_t)K * N;
    for (size_t i = c.gt; i < n; i += c.ngt) { const int nn = (int)(i / K), kk = (int)(i % K); WT[i] = f2bf(W[(size_t)kk * N + nn]); }
}

__device__ __forceinline__ unsigned pk2bf(float lo, float hi) { return (unsigned)f2bf(lo) | ((unsigned)f2bf(hi) << 16); }
__device__ __forceinline__ void p0_transpose_item(const float* W, int K, int N, bf16_t* WT, LAS float* scr, int item, int lane) {
    const int nblk = N / 32, kb = item / nblk, nb = item % nblk, k0 = 64 * kb, n0 = 32 * nb;
#pragma unroll 8
    for (int i = 0; i < 32; ++i) { const int kk = 2 * i + (lane >> 5); scr[kk * 33 + (lane & 31)] = W[(size_t)(k0 + kk) * N + n0 + (lane & 31)]; }
    WAVE_LDS_SYNC();
    const int cch = lane & 7;
#pragma unroll
    for (int j = 0; j < 4; ++j) { const int n = (lane >> 3) + 8 * j; const LAS float* sp = scr + (8 * cch) * 33 + n;
        u32x4 o; o.x = pk2bf(sp[0 * 33], sp[1 * 33]); o.y = pk2bf(sp[2 * 33], sp[3 * 33]); o.z = pk2bf(sp[4 * 33], sp[5 * 33]); o.w = pk2bf(sp[6 * 33], sp[7 * 33]);
        *(u32x4*)(WT + (size_t)(n0 + n) * K + k0 + 8 * cch) = o; }
    WAVE_LDS_SYNC();
}
__device__ __forceinline__ void st_prologue_weights(KP p, const Ctx& c, LAS float* scr) {
    unsigned char* dob = (unsigned char*)p->out;
    constexpr int I_IN = 16 * 200, I_BR = 8 * 32, I_GLU = 8 * 16, I_OUT = 16 * 32, I_LAYER = I_IN + 3 * I_BR + I_GLU + I_OUT;
    for (int it = c.gw; it < DEPTH * I_LAYER; it += c.ngw) {
        const int l = it / I_LAYER; int r = it % I_LAYER;
        if (r < I_IN) { p0_transpose_item(p->in[9] + (size_t)l * 1024 * IN_COLS, 1024, IN_COLS, (bf16_t*)(dob + DO_WIN) + (size_t)l * IN_COLS * 1024, scr, r, c.lane); continue; } r -= I_IN;
        if (r < I_BR) { p0_transpose_item(p->in[11] + (size_t)l * 512 * 1024, 512, 1024, (bf16_t*)(dob + DO_WBR) + ((size_t)l * 3 + 0) * 1024 * 512, scr, r, c.lane); continue; } r -= I_BR;
        if (r < I_BR) { p0_transpose_item(p->in[21] + (size_t)l * 512 * 1024, 512, 1024, (bf16_t*)(dob + DO_WBR) + ((size_t)l * 3 + 1) * 1024 * 512, scr, r, c.lane); continue; } r -= I_BR;
        if (r < I_BR) { p0_transpose_item(p->in[29] + (size_t)l * 512 * 1024, 512, 1024, (bf16_t*)(dob + DO_WBR) + ((size_t)l * 3 + 2) * 1024 * 512, scr, r, c.lane); continue; } r -= I_BR;
        if (r < I_GLU) { p0_transpose_item(p->in[20] + (size_t)l * 512 * 512, 512, 512, (bf16_t*)(dob + DO_WGLU) + (size_t)l * 512 * 512, scr, r, c.lane); continue; } r -= I_GLU;
        p0_transpose_item(p->in[30] + (size_t)l * 1024 * 1024, 1024, 1024, (bf16_t*)(p->ws + WS_WOUT) + (size_t)l * 1024 * 1024, scr, r, c.lane);
    }
}
__device__ __forceinline__ void st_s5_tables(KP p, const Ctx& c) {
    float* AB = (float*)(p->ws + WS_TAB + TAB_AB);
    float* BB = (float*)(p->ws + WS_TAB + TAB_BB);
    for (size_t ii = c.gt; ii < (size_t)DEPTH * NG * NP; ii += c.ngt) {
        const int i = (int)ii, l = i / (NG * NP), g = (i / NP) % NG;
        const float lr = fminf(p->in[12][i], -1e-4f), li = p->in[13][i];
        const float step = expf(p->in[14][l * NG + g]);
        const float mag = expf(lr * step);
        float sn, cs; sincosf(li * step, &sn, &cs);
        const float ab_re = mag * cs, ab_im = mag * sn;
        const float den = lr * lr + li * li;
        const float f_re = ((ab_re - 1.0f) * lr + ab_im * li) / den;
        const float f_im = (ab_im * lr - (ab_re - 1.0f) * li) / den;
        AB[2 * i] = ab_re; AB[2 * i + 1] = ab_im;
        for (int cc = 0; cc < NC; ++cc) {
            const float bre = p->in[15][(size_t)i * NC + cc], bim = p->in[16][(size_t)i * NC + cc];
            BB[((size_t)i * NC + cc) * 2] = f_re * bre - f_im * bim;
            BB[((size_t)i * NC + cc) * 2 + 1] = f_re * bim + f_im * bre;
        }
    }
}

template <class Epi>
__device__ __forceinline__ void gemm_simple(const bf16_t* A, int lda, const bf16_t* Bt, int ldb, int M, int N, int K, Epi epi, const Ctx& c) {
    const int lane = c.lane;
    const int ntn = N / 32, ntiles = (M / 32) * ntn;
    for (int tile = c.gw; tile < ntiles; tile += c.ngw) {
        const int tm = tile / ntn, tn = tile % ntn;
        f32x16 acc = {};
        const bf16_t* ar = A + (size_t)(tm * 32 + (lane & 31)) * lda + 8 * (lane >> 5);
        const bf16_t* br = Bt + (size_t)(tn * 32 + (lane & 31)) * ldb + 8 * (lane >> 5);
        for (int k0 = 0; k0 < K; k0 += 16) {
            const bf16x8 a = *(const bf16x8*)(ar + k0);
            const bf16x8 b = *(const bf16x8*)(br + k0);
            acc = __builtin_amdgcn_mfma_f32_32x32x16_bf16(a, b, acc, 0, 0, 0);
        }
#pragma unroll
        for (int r = 0; r < 16; ++r) {
            const int row = tm * 32 + (r & 3) + 8 * (r >> 2) + 4 * (lane >> 5), col = tn * 32 + (lane & 31);
            epi(row, col, acc[r]);
        }
    }
}
struct EpiProj { bf16_t* PROJ; __device__ void operator()(int r, int c, float v) const { PROJ[(size_t)r * IN_COLS + c] = f2bf(v); } };

__device__ __forceinline__ void st_kv_out(KP p, int l, const Ctx& c) {
    const bf16_t* PROJ = (const bf16_t*)(p->ws + WS_PROJ);
    for (size_t ii = c.gt; ii < (size_t)BATCH * 3 * 512; ii += c.ngt) {
        const int i = (int)ii, b = i / 1536, j = (i / 512) % 3, ch = i % 512;
        p->out[O_CP + (size_t)l * BATCH * 1536 + i] = bf2f(PROJ[((size_t)b * SEQ + SEQ - 3 + j) * IN_COLS + C_XC + ch]);
    }
    for (size_t ii = c.gt; ii < (size_t)DEC_BATCH * 3 * 512; ii += c.ngt) {
        const int i = (int)ii, b = i / 1536, j = (i / 512) % 3, ch = i % 512;
        p->out[O_CS + (size_t)l * DEC_BATCH * 1536 + i] = bf2f(PROJ[((size_t)M_P + 4 * b + 1 + j) * IN_COLS + C_XC + ch]);
    }
    for (size_t ii = c.gt; ii < (size_t)DEC_BATCH * WINDOW * 128; ii += c.ngt) {
        const int i = (int)ii;
        if (i < BATCH * WINDOW * 128) {
            const int b = i / (WINDOW * 128), w = (i / 128) % WINDOW, cc = i % 128;
            const size_t row = (size_t)b * SEQ + (SEQ - WINDOW) + w;
            p->out[O_KP + (size_t)l * BATCH * WINDOW * 128 + i] = bf2f(PROJ[row * IN_COLS + C_K + cc]);
            p->out[O_VP + (size_t)l * BATCH * WINDOW * 128 + i] = bf2f(PROJ[row * IN_COLS + C_V + cc]);
        }
        {
            const int b = i / (WINDOW * 128), w = (i / 128) % WINDOW, cc = i % 128;
            float kv, vv;
            if (w < WINDOW - DEC_SEQ) {
                const size_t ci = (((size_t)l * DEC_BATCH + b) * WINDOW + (w + DEC_SEQ)) * 128 + cc;
                kv = p->in[2][ci]; vv = p->in[3][ci];
            } else {
                const size_t row = (size_t)M_P + b * DEC_SEQ + (w - (WINDOW - DEC_SEQ));
                kv = bf2f(PROJ[row * IN_COLS + C_K + cc]); vv = bf2f(PROJ[row * IN_COLS + C_V + cc]);
            }
            p->out[O_KS + (size_t)l * DEC_BATCH * WINDOW * 128 + i] = kv;
            p->out[O_VS + (size_t)l * DEC_BATCH * WINDOW * 128 + i] = vv;
        }
    }
}

__device__ __forceinline__ void st_attn_simple(KP p, int l, const Ctx& c, bool dry) {
    bf16_t* PROJ = (bf16_t*)(p->ws + WS_PROJ);
    const int lane = c.lane;
    const float* rel_bias = p->in[8];
    for (int item = c.gw; item < M_S * NQH; item += c.ngw) {
        const int m = M_P + item / NQH, h = item % NQH, kvh = h / 4;
        const bool samp = m >= M_P;
        const int b = samp ? (m - M_P) / DEC_SEQ : m / SEQ, t = samp ? (m - M_P) % DEC_SEQ : m % SEQ;
        float q[64];
        {
            const bf16_t* qp = PROJ + (size_t)m * IN_COLS + C_Q + h * 64;
#pragma unroll
            for (int d = 0; d < 64; ++d) q[d] = bf2f(qp[d]);
        }
        const float sink = p->in[10][l * NQH + h];
        float s[2];
#pragma unroll
        for (int j = 0; j < 2; ++j) {
            const int d = lane + 64 * j;
            const int tk = t - d;
            float sc = -1e30f;
            if (!samp) {
                if (tk >= 0) {
                    const bf16_t* kp = PROJ + ((size_t)b * SEQ + tk) * IN_COLS + C_K + kvh * 64;
                    float a = 0.f;
#pragma unroll
                    for (int e = 0; e < 64; ++e) a += q[e] * bf2f(kp[e]);
                    sc = a * 0.125f + rel_bias[T5_BUCKET[d] * NQH + h];
                }
            } else {
                float a = 0.f;
                if (tk >= 0) {
                    const bf16_t* kp = PROJ + ((size_t)M_P + b * DEC_SEQ + tk) * IN_COLS + C_K + kvh * 64;
#pragma unroll
                    for (int e = 0; e < 64; ++e) a += q[e] * bf2f(kp[e]);
                } else {
                    const float* kp = p->in[2] + ((((size_t)l * DEC_BATCH + b) * WINDOW + (WINDOW + tk)) * NKV + kvh) * HD;
#pragma unroll
                    for (int e = 0; e < 64; ++e) a += q[e] * kp[e];
                }
                sc = a * 0.125f + rel_bias[T5_BUCKET[d] * NQH + h];
            }
            s[j] = sc;
        }
        float mx = fmaxf(fmaxf(s[0], s[1]), sink);
        for (int o = 32; o > 0; o >>= 1) mx = fmaxf(mx, __shfl_xor(mx, o));
        const float p0 = s[0] > -1e29f ? __expf(s[0] - mx) : 0.f, p1 = s[1] > -1e29f ? __expf(s[1] - mx) : 0.f;
        float sum = p0 + p1;
        for (int o = 32; o > 0; o >>= 1) sum += __shfl_xor(sum, o);
        const float denom = sum + __expf(sink - mx);
        float o = 0.f;
        for (int d = 0; d < 128; ++d) {
            const float pj = __shfl(d < 64 ? p0 : p1, d & 63);
            const int tk = t - d;
            float vv = 0.f;
            if (!samp) { if (tk >= 0) vv = bf2f(PROJ[((size_t)b * SEQ + tk) * IN_COLS + C_V + kvh * 64 + lane]); }
            else if (tk >= 0) vv = bf2f(PROJ[((size_t)M_P + b * DEC_SEQ + tk) * IN_COLS + C_V + kvh * 64 + lane]);
            else vv = p->in[3][((((size_t)l * DEC_BATCH + b) * WINDOW + (WINDOW + tk)) * NKV + kvh) * HD + lane];
            o += pj * vv;
        }
        o /= denom;
        const float ga = bf2f(PROJ[(size_t)m * IN_COLS + C_GA + h * 64 + lane]);
        if (!dry) PROJ[(size_t)m * IN_COLS + C_Q + h * 64 + lane] = f2bf(o * siluf_(ga));
    }
}

typedef short s16x4 __attribute__((ext_vector_type(4)));
typedef short v4i16_t __attribute__((ext_vector_type(4)));
__device__ __forceinline__ bf16x8 pack8(float a0, float a1, float a2, float a3, float a4, float a5, float a6, float a7) {
    u32x4 p; p.x = cvtpk(a0, a1); p.y = cvtpk(a2, a3); p.z = cvtpk(a4, a5); p.w = cvtpk(a6, a7); return __builtin_bit_cast(bf16x8, p); }
__device__ __forceinline__ s16x4 tr_read(LAS const unsigned char* p) { return __builtin_bit_cast(s16x4, __builtin_amdgcn_ds_read_tr16_b64_v4i16((LAS v4i16_t*)p)); }
__device__ __forceinline__ bf16x8 cat8(s16x4 lo, s16x4 hi) { return __builtin_shufflevector(lo, hi, 0, 1, 2, 3, 4, 5, 6, 7); }
#define MFMA32(a, b, c) __builtin_amdgcn_mfma_f32_32x32x16_bf16((a), (b), (c), 0, 0, 0)
#define MFMA16(a, b, c) __builtin_amdgcn_mfma_f32_16x16x32_bf16((a), (b), (c), 0, 0, 0)

constexpr int AT_KSTR = 144, AT_VSTR = 192;
constexpr int AT_K = 0, AT_V = AT_K + 256 * AT_KSTR, AT_BIAS = AT_V + 256 * AT_VSTR, AT_WS = AT_BIAS + 4 * 128 * 4, AT_END = AT_WS + 8 * 256;
static_assert(AT_END <= 131072, "attention LDS");

__device__ __forceinline__ void st_attn_prompt(KP p, int l, LAS unsigned char* lds, bool dry) {
    int zv = 0; asm volatile("" : "+v"(zv));
    const int tid = (int)threadIdx.x + zv, lane = tid & 63, wave = __builtin_amdgcn_readfirstlane(tid >> 6);
    const int c31 = lane & 31, h = lane >> 5;
    bf16_t* PROJ = (bf16_t*)(p->ws + WS_PROJ);
    const float* rel_bias = p->in[8];
    for (int item = blockIdx.x; item < BATCH * 16 * NKV; item += gridDim.x) {
        const int b = item / 32, nb = (item >> 1) & 15, kvh = item & 1;
        const size_t rowq0 = (size_t)b * SEQ + (size_t)nb * 128;
#pragma unroll
        for (int i = 0; i < 4; ++i) {
            const int id = tid + 512 * i, row = id >> 3, pc = id & 7;
            u32x4 kk = (u32x4){0u, 0u, 0u, 0u}, vv = kk;
            if (nb > 0 || row >= 128) {
                const bf16_t* src = PROJ + (rowq0 - 128 + row) * IN_COLS + kvh * 64 + pc * 8;
                kk = *(const u32x4*)(src + C_K); vv = *(const u32x4*)(src + C_V);
            }
            *(LAS u32x4*)(lds + AT_K + row * AT_KSTR + pc * 16) = kk;
            *(LAS u32x4*)(lds + AT_V + row * AT_VSTR + pc * 16) = vv;
        }
        { const int g = tid >> 7, d = tid & 127; ((LAS float*)(lds + AT_BIAS))[tid] = rel_bias[T5_BUCKET[d] * NQH + kvh * 4 + g]; }
        __syncthreads();
        const int g = wave >> 1, hq = kvh * 4 + g;
        const float sink = p->in[10][l * NQH + hq];
        LAS const float* biasd = (LAS const float*)(lds + AT_BIAS) + g * 128;
        LAS float* wsf = (LAS float*)(lds + AT_WS + wave * 256);
#pragma unroll 1
        for (int qi = 0; qi < 2; ++qi) {
            const int qt = 2 * (wave & 1) + qi, q0 = 32 * qt;
            bf16x8 qf[4];
            { const bf16_t* qp = PROJ + (rowq0 + q0 + c31) * IN_COLS + C_Q + hq * 64 + 8 * h;
#pragma unroll
              for (int ks = 0; ks < 4; ++ks) qf[ks] = *(const bf16x8*)(qp + 16 * ks); }
            f32x16 S[5];
#pragma unroll
            for (int j = 0; j < 5; ++j) {
                S[j] = (f32x16){};
                LAS const unsigned char* kp = lds + AT_K + (32 * (qt + j) + c31) * AT_KSTR + 16 * h;
#pragma unroll
                for (int ks = 0; ks < 4; ++ks) S[j] = MFMA32(*(LAS const bf16x8*)(kp + 32 * ks), qf[ks], S[j]);
            }
            const int iq = q0 + c31;
            float mx = sink;
#pragma unroll
            for (int j = 0; j < 5; ++j)
#pragma unroll
                for (int r = 0; r < 16; ++r) {
                    const int kv = 32 * (qt + j) + (r & 3) + 8 * (r >> 2) + 4 * h;
                    const int dist = iq + 128 - kv;
                    const bool ok = (dist >= 0) && (dist < 128) && (nb > 0 || kv >= 128);
                    const float s = ok ? S[j][r] * 0.125f + biasd[dist & 127] : -1e30f;
                    S[j][r] = s; mx = fmaxf(mx, s);
                }
            mx = fmaxf(mx, __shfl_xor(mx, 32));
            float sum = 0.f;
#pragma unroll
            for (int j = 0; j < 5; ++j)
#pragma unroll
                for (int r = 0; r < 16; ++r) { const float e = S[j][r] > -1e29f ? __expf(S[j][r] - mx) : 0.f; S[j][r] = e; sum += e; }
            sum += __shfl_xor(sum, 32);
            const float rden = 1.0f / (sum + __expf(sink - mx));
            if (h == 0) wsf[c31] = rden;
            f32x16 O[2]; O[0] = (f32x16){}; O[1] = (f32x16){};
            const int i16 = lane & 15, qq = i16 >> 2, pp = i16 & 3, blk = (lane >> 4) & 1;
#pragma unroll
            for (int j = 0; j < 5; ++j)
#pragma unroll
                for (int s = 0; s < 2; ++s) {
                    const bf16x8 pf = pack8(S[j][8 * s], S[j][8 * s + 1], S[j][8 * s + 2], S[j][8 * s + 3], S[j][8 * s + 4], S[j][8 * s + 5], S[j][8 * s + 6], S[j][8 * s + 7]);
                    LAS const unsigned char* vp = lds + AT_V + (32 * (qt + j) + 16 * s + 4 * h + qq) * AT_VSTR + (16 * blk + 4 * pp) * 2;
#pragma unroll
                    for (int dt = 0; dt < 2; ++dt) {
                        const bf16x8 vf = cat8(tr_read(vp + dt * 64), tr_read(vp + dt * 64 + 8 * AT_VSTR));
                        O[dt] = MFMA32(pf, vf, O[dt]);
                    }
                }
            WAVE_LDS_SYNC();
#pragma unroll
            for (int r = 0; r < 16; ++r) {
                const int qr = (r & 3) + 8 * (r >> 2) + 4 * h;
                const float rd = wsf[qr];
                bf16_t* rowp = PROJ + (rowq0 + q0 + qr) * IN_COLS + hq * 64 + c31;
#pragma unroll
                for (int dt = 0; dt < 2; ++dt) {
                    const float ga = bf2f(rowp[C_GA + 32 * dt]);
                    if (!dry) rowp[C_Q + 32 * dt] = f2bf(O[dt][r] * rd * siluf_(ga));
                }
            }
            WAVE_LDS_SYNC();
        }
        __syncthreads();
    }
}

constexpr int S5_NPOW = 11, S5_NINV = 9, S5_NSEG = 8, S5_SEGLEN = 256;
__device__ __forceinline__ float neg_expm1_small(float y) {
    float q = 1.0f / 5040.0f; q = q * y + 1.0f / 720.0f; q = q * y + 1.0f / 120.0f; q = q * y + 1.0f / 24.0f; q = q * y + 1.0f / 6.0f; q = q * y + 0.5f; q = q * y + 1.0f; return -(q * y);
}
__device__ __forceinline__ f32x2_t cmul(f32x2_t a, f32x2_t b) { return (f32x2_t){a.x * b.x - a.y * b.y, a.x * b.y + a.y * b.x}; }

__device__ __forceinline__ void st_s5_tables2(KP p, const Ctx& c) {
    f32x2_t* POW = (f32x2_t*)(p->ws + WS_S5POW); f32x2_t* PINV = (f32x2_t*)(p->ws + WS_S5PINV);
    bf16_t* BCAT = (bf16_t*)(p->ws + WS_S5BCAT); bf16_t* CCAT = (bf16_t*)(p->ws + WS_S5CCAT);
    const float* BB = (const float*)(p->ws + WS_TAB + TAB_BB);
    for (size_t ii = c.gt; ii < (size_t)DEPTH * NG * NP; ii += c.ngt) {
        const int i = (int)ii, lg = i / NP, pp = i % NP;
        const double lr = (double)fminf(p->in[12][i], -1e-4f), li = (double)p->in[13][i];
        const double step = (double)expf(p->in[14][lg]);
        for (int k = 0; k < S5_NPOW + S5_NINV; ++k) {
            const int e = k < 9 ? k : (k == 9 ? 64 : (k == 10 ? 256 : -(k - S5_NPOW)));
            double t = (double)e * li * step * 0.15915494309189535; t -= rint(t);
            float sn, cs; sincosf((float)(t * 6.283185307179586), &sn, &cs);
            const float mag = expf((float)((double)e * lr * step));
            const f32x2_t v = {mag * cs, mag * sn};
            if (k < S5_NPOW) POW[((size_t)lg * S5_NPOW + k) * NP + pp] = v; else PINV[((size_t)lg * S5_NINV + (k - S5_NPOW)) * NP + pp] = v;
        }
    }
    for (size_t ii = c.gt; ii < (size_t)DEPTH * NG * 128 * NC; ii += c.ngt) {
        const int i = (int)ii, lg = i / (128 * NC), n = (i / NC) % 128, cc = i % NC, pp = n & 63;
        const int sidx = lg * NP + pp;
        const float lr = fminf(p->in[12][sidx], -1e-4f), li = p->in[13][sidx];
        const float step = expf(p->in[14][lg]);
        const float mag = expf(lr * step);
        float sn, cs; sincosf(li * step, &sn, &cs);
        const float ab_re = mag * cs, ab_im = mag * sn, den = lr * lr + li * li;
        const float f_re = ((ab_re - 1.0f) * lr + ab_im * li) / den, f_im = (ab_im * lr - (ab_re - 1.0f) * li) / den;
        const float bre = p->in[15][(size_t)sidx * NC + cc], bim = p->in[16][(size_t)sidx * NC + cc];
        BCAT[i] = f2bf(n < 64 ? f_re * bre - f_im * bim : f_re * bim + f_im * bre);
        const int c2 = (i / 128) % NC, n2 = i % 128, p2 = n2 & 63;
        const float cv = n2 < 64 ? p->in[17][((size_t)lg * NC + c2) * NP + p2] : -p->in[18][((size_t)lg * NC + c2) * NP + p2];
        CCAT[i] = f2bf(cv);
    }
}

__device__ __forceinline__ void s5_xtiles(f32x16 (&xr)[2], f32x16 (&xi)[2], const bf16x8 (&uf)[2], bf16x8 bre, bf16x8 bim) {
#pragma unroll
    for (int m = 0; m < 2; ++m) { xr[m] = MFMA32(uf[m], bre, (f32x16){}); xi[m] = MFMA32(uf[m], bim, (f32x16){}); }
}

__device__ __forceinline__ void st_s5_phaseA(KP p, int l, const Ctx& c) {
    const bf16_t* PROJ = (const bf16_t*)(p->ws + WS_PROJ);
    const f32x2_t* POW = (const f32x2_t*)(p->ws + WS_S5POW);
    const bf16_t* BCAT = (const bf16_t*)(p->ws + WS_S5BCAT);
    f32x2_t* SUM = (f32x2_t*)(p->ws + WS_S5SUM);
    const int lane = c.lane, c31 = lane & 31, h = lane >> 5;
    for (int item = c.gw; item < BATCH * S5_NSEG * NG; item += c.ngw) {
        const int g = item % NG, seg = (item / NG) % S5_NSEG, b = item / (NG * S5_NSEG);
        const int lg = l * NG + g;
        const size_t row0 = (size_t)b * SEQ + (size_t)seg * S5_SEGLEN;
#pragma unroll 1
        for (int pt = 0; pt < 2; ++pt) {
            const int pp = 32 * pt + c31;
            const f32x2_t* pw = POW + (size_t)lg * S5_NPOW * NP + pp;
            f32x2_t lo[4];
#pragma unroll
            for (int s = 0; s < 4; ++s) lo[s] = pw[(7 - 4 * h - s) * NP];
            const f32x2_t a8 = pw[8 * NP], a64 = pw[9 * NP];
            const bf16x8 bre = *(const bf16x8*)(BCAT + ((size_t)lg * 128 + pp) * NC + 8 * h);
            const bf16x8 bim = *(const bf16x8*)(BCAT + ((size_t)lg * 128 + 64 + pp) * NC + 8 * h);
            f32x2_t sseg = {0.f, 0.f};
#pragma unroll 1
            for (int ch = 0; ch < 4; ++ch) {
                bf16x8 uf[2];
#pragma unroll
                for (int m = 0; m < 2; ++m) uf[m] = *(const bf16x8*)(PROJ + (row0 + 64 * ch + 32 * m + c31) * IN_COLS + C_UB + 16 * g + 8 * h);
                f32x16 xr[2], xi[2];
                s5_xtiles(xr, xi, uf, bre, bim);
                f32x2_t f = {1.f, 0.f}, acc = {0.f, 0.f};
#pragma unroll
                for (int gi = 7; gi >= 0; --gi) {
                    const int m = gi >> 2, q = gi & 3;
                    f32x2_t t = {0.f, 0.f};
#pragma unroll
                    for (int s = 0; s < 4; ++s) { const f32x2_t x = {xr[m][4 * q + s], xi[m][4 * q + s]}; const f32x2_t w = cmul(lo[s], x); t.x += w.x; t.y += w.y; }
                    const f32x2_t w2 = cmul(f, t); acc.x += w2.x; acc.y += w2.y;
                    f = cmul(f, a8);
                }
                acc.x += __shfl_xor(acc.x, 32); acc.y += __shfl_xor(acc.y, 32);
                const f32x2_t d = cmul(a64, sseg); sseg.x = d.x + acc.x; sseg.y = d.y + acc.y;
            }
            if (h == 0) SUM[(((size_t)b * S5_NSEG + seg) * NG + g) * NP + pp] = sseg;
        }
    }
}

constexpr int S5_HT_STR = 144, S5_HT_BYTES = 64 * S5_HT_STR;
__device__ __forceinline__ void st_s5_phaseB(KP p, int l, const Ctx& c, LAS unsigned char* lds, bool dry) {
    bf16_t* PROJ = (bf16_t*)(p->ws + WS_PROJ);
    const f32x2_t* POW = (const f32x2_t*)(p->ws + WS_S5POW); const f32x2_t* PINV = (const f32x2_t*)(p->ws + WS_S5PINV);
    const bf16_t* BCAT = (const bf16_t*)(p->ws + WS_S5BCAT); const bf16_t* CCAT = (const bf16_t*)(p->ws + WS_S5CCAT);
    const f32x2_t* SUM = (const f32x2_t*)(p->ws + WS_S5SUM);
    const int lane = c.lane, c31 = lane & 31, h = lane >> 5, i16 = lane & 15, kg = lane >> 4, qq = i16 >> 2, p4 = i16 & 3;
    LAS unsigned char* ht = lds + c.wave * S5_HT_BYTES;
    bf16x8 tdiag[2], tones;
#pragma unroll
    for (int s = 0; s < 2; ++s)
#pragma unroll
        for (int j = 0; j < 8; ++j) tdiag[s][j] = (16 * s + 8 * (j >> 2) + 4 * h + (j & 3) <= c31) ? (short)0x3F80 : (short)0;
#pragma unroll
    for (int j = 0; j < 8; ++j) tones[j] = (short)0x3F80;
    for (int item = c.gw; item < BATCH * S5_NSEG * NG; item += c.ngw) {
        const int g = item % NG, seg = (item / NG) % S5_NSEG, b = item / (NG * S5_NSEG);
        const int lg = l * NG + g;
        const size_t row0 = (size_t)b * SEQ + (size_t)seg * S5_SEGLEN;
        f32x2_t hin[2];
#pragma unroll
        for (int pt = 0; pt < 2; ++pt) {
            const int pp = 32 * pt + c31;
            const f32x2_t a256 = POW[((size_t)lg * S5_NPOW + 10) * NP + pp];
            f32x2_t H = {0.f, 0.f};
#pragma unroll
            for (int k = 0; k < S5_NSEG - 1; ++k) if (k < seg) { const f32x2_t sk = SUM[(((size_t)b * S5_NSEG + k) * NG + g) * NP + pp]; const f32x2_t d = cmul(a256, H); H.x = d.x + sk.x; H.y = d.y + sk.y; }
            hin[pt] = H;
        }
        const float dd = p->in[19][l * 512 + g * 16 + i16];
#pragma unroll 1
        for (int ch = 0; ch < 4; ++ch) {
            const size_t crow0 = row0 + 64 * ch;
            bf16x8 uf[2];
#pragma unroll
            for (int m = 0; m < 2; ++m) uf[m] = *(const bf16x8*)(PROJ + (crow0 + 32 * m + c31) * IN_COLS + C_UB + 16 * g + 8 * h);
            f32x4 Y[4];
#pragma unroll
            for (int it = 0; it < 4; ++it) Y[it] = (f32x4){0.f, 0.f, 0.f, 0.f};
#pragma unroll
            for (int pt = 0; pt < 2; ++pt) {
                const int pp = 32 * pt + c31;
                const bf16x8 bre = *(const bf16x8*)(BCAT + ((size_t)lg * 128 + pp) * NC + 8 * h);
                const bf16x8 bim = *(const bf16x8*)(BCAT + ((size_t)lg * 128 + 64 + pp) * NC + 8 * h);
                const f32x2_t* pw = POW + (size_t)lg * S5_NPOW * NP + pp; const f32x2_t* pi = PINV + (size_t)lg * S5_NINV * NP + pp;
                asm volatile("" : "+v"(pw), "+v"(pi));
                f32x2_t ilo[4], plo[4];
#pragma unroll
                for (int s = 0; s < 4; ++s) { ilo[s] = pi[(4 * h + s) * NP]; plo[s] = pw[(4 * h + s) * NP]; }
                const f32x2_t ia8 = pi[8 * NP], a8 = pw[8 * NP], a1 = pw[1 * NP];
                bf16x8 wfr[2][2], wfi[2][2];
                {
                    f32x2_t f = {1.f, 0.f};
#pragma unroll
                    for (int m = 0; m < 2; ++m) {
                        f32x16 xr = MFMA32(uf[m], bre, (f32x16){}), xi = MFMA32(uf[m], bim, (f32x16){});
#pragma unroll
                        for (int q = 0; q < 4; ++q) {
#pragma unroll
                            for (int s = 0; s < 4; ++s) { const f32x2_t x = {xr[4 * q + s], xi[4 * q + s]}; const f32x2_t w = cmul(f, cmul(ilo[s], x)); xr[4 * q + s] = w.x; xi[4 * q + s] = w.y; }
                            f = cmul(f, ia8);
                        }
#pragma unroll
                        for (int s2 = 0; s2 < 2; ++s2) {
                            wfr[m][s2] = pack8(xr[8 * s2], xr[8 * s2 + 1], xr[8 * s2 + 2], xr[8 * s2 + 3], xr[8 * s2 + 4], xr[8 * s2 + 5], xr[8 * s2 + 6], xr[8 * s2 + 7]);
                            wfi[m][s2] = pack8(xi[8 * s2], xi[8 * s2 + 1], xi[8 * s2 + 2], xi[8 * s2 + 3], xi[8 * s2 + 4], xi[8 * s2 + 5], xi[8 * s2 + 6], xi[8 * s2 + 7]);
                        }
                        __builtin_amdgcn_sched_barrier(0);
                    }
                }
                const f32x2_t G = cmul(a1, hin[pt]);
                f32x2_t hlast = {0.f, 0.f};
                WAVE_LDS_SYNC();
                {
                    f32x2_t f = {1.f, 0.f};
#pragma unroll
                    for (int m = 0; m < 2; ++m) {
                        f32x16 cr, ci;
                        if (m == 0) { cr = MFMA32(tdiag[1], wfr[0][1], MFMA32(tdiag[0], wfr[0][0], (f32x16){})); ci = MFMA32(tdiag[1], wfi[0][1], MFMA32(tdiag[0], wfi[0][0], (f32x16){})); }
                        else { cr = MFMA32(tdiag[1], wfr[1][1], MFMA32(tdiag[0], wfr[1][0], MFMA32(tones, wfr[0][1], MFMA32(tones, wfr[0][0], (f32x16){}))));
                               ci = MFMA32(tdiag[1], wfi[1][1], MFMA32(tdiag[0], wfi[1][0], MFMA32(tones, wfi[0][1], MFMA32(tones, wfi[0][0], (f32x16){})))); }
#pragma unroll
                        for (int q = 0; q < 4; ++q) {
                            float hr[4], hi[4];
#pragma unroll
                            for (int s = 0; s < 4; ++s) { const f32x2_t v = {cr[4 * q + s] + G.x, ci[4 * q + s] + G.y}; const f32x2_t w = cmul(f, cmul(plo[s], v)); hr[s] = w.x; hi[s] = w.y; }
                            if (m == 1 && q == 3) { hlast.x = hr[3]; hlast.y = hi[3]; }
                            typedef unsigned u32x2_t __attribute__((ext_vector_type(2)));
                            u32x2_t wr_; wr_.x = cvtpk(hr[0], hr[1]); wr_.y = cvtpk(hr[2], hr[3]);
                            u32x2_t wi_; wi_.x = cvtpk(hi[0], hi[1]); wi_.y = cvtpk(hi[2], hi[3]);
                            *(LAS u32x2_t*)(ht + c31 * S5_HT_STR + (32 * m + 8 * q + 4 * h) * 2) = wr_;
                            *(LAS u32x2_t*)(ht + (32 + c31) * S5_HT_STR + (32 * m + 8 * q + 4 * h) * 2) = wi_;
                            f = cmul(f, a8);
                        }
                        __builtin_amdgcn_sched_barrier(0);
                    }
                }
                hin[pt].x = __shfl(hlast.x, c31 + 32); hin[pt].y = __shfl(hlast.y, c31 + 32);
                WAVE_LDS_SYNC();
#pragma unroll
                for (int ks = 0; ks < 2; ++ks) {
                    const bf16x8 cf = *(const bf16x8*)(CCAT + ((size_t)lg * NC + i16) * 128 + 64 * ks + 32 * pt + 8 * kg);
#pragma unroll
                    for (int it = 0; it < 4; ++it) {
                        LAS const unsigned char* ap = ht + (32 * ks + 8 * kg + qq) * S5_HT_STR + (16 * it + 4 * p4) * 2;
                        const bf16x8 af = cat8(tr_read(ap), tr_read(ap + 4 * S5_HT_STR));
                        Y[it] = MFMA16(af, cf, Y[it]);
                    }
                }
            }
#pragma unroll
            for (int it = 0; it < 4; ++it)
#pragma unroll
                for (int r = 0; r < 4; ++r) {
                    bf16_t* up = PROJ + (crow0 + 16 * it + 4 * kg + r) * IN_COLS + C_UB + 16 * g + i16;
                    const float y = Y[it][r] + dd * bf2f(*up);
                    if (!dry) *up = f2bf(gelu_tanh(y));
                }
        }
        if (seg == S5_NSEG - 1 && h == 0) {
#pragma unroll
            for (int pt = 0; pt < 2; ++pt) { const size_t oi = (((size_t)l * BATCH + b) * NG + g) * NP + 32 * pt + c31; p->out[O_SRP + oi] = hin[pt].x; p->out[O_SIP + oi] = hin[pt].y; }
        }
    }
}

__device__ __forceinline__ void st_s5_sample(KP p, int l, const Ctx& c, LAS unsigned char* lds, bool dry) {
    bf16_t* PROJ = (bf16_t*)(p->ws + WS_PROJ);
    const f32x2_t* POW = (const f32x2_t*)(p->ws + WS_S5POW); const f32x2_t* PINV = (const f32x2_t*)(p->ws + WS_S5PINV);
    const bf16_t* BCAT = (const bf16_t*)(p->ws + WS_S5BCAT); const bf16_t* CCAT = (const bf16_t*)(p->ws + WS_S5CCAT);
    LAS unsigned char* ht = lds + c.wave * S5_HT_BYTES;
    for (int item = c.gw; item < (DEC_BATCH / 16) * NG; item += c.ngw) {
        int zi = 0; asm volatile("" : "+v"(zi));
        const int lane = c.lane + zi, c31 = lane & 31, h = lane >> 5, i16 = lane & 15, kg = lane >> 4, qq = i16 >> 2, p4 = i16 & 3;
        const int g = item % NG, sg = item / NG, lg = l * NG + g;
        const size_t crow0 = (size_t)M_P + 64 * sg;
        bf16x8 tds[2];
#pragma unroll
        for (int s = 0; s < 2; ++s)
#pragma unroll
            for (int j = 0; j < 8; ++j) { const int kr = 16 * s + 8 * (j >> 2) + 4 * h + (j & 3); tds[s][j] = ((kr >> 2) == (c31 >> 2) && kr <= c31) ? (short)0x3F80 : (short)0; }
        const float dd = p->in[19][l * 512 + g * 16 + i16];
        bf16x8 uf[2];
#pragma unroll
        for (int m = 0; m < 2; ++m) uf[m] = *(const bf16x8*)(PROJ + (crow0 + 32 * m + c31) * IN_COLS + C_UB + 16 * g + 8 * h);
        f32x4 Y[4];
#pragma unroll
        for (int it = 0; it < 4; ++it) Y[it] = (f32x4){0.f, 0.f, 0.f, 0.f};
#pragma unroll
        for (int pt = 0; pt < 2; ++pt) {
            const int pp = 32 * pt + c31;
            const bf16x8 bre = *(const bf16x8*)(BCAT + ((size_t)lg * 128 + pp) * NC + 8 * h);
            const bf16x8 bim = *(const bf16x8*)(BCAT + ((size_t)lg * 128 + 64 + pp) * NC + 8 * h);
            const f32x2_t* pw = POW + (size_t)lg * S5_NPOW * NP + pp; const f32x2_t* pi = PINV + (size_t)lg * S5_NINV * NP + pp;
            f32x2_t ilo[4], plo[4];
#pragma unroll
            for (int s = 0; s < 4; ++s) { ilo[s] = pi[s * NP]; plo[s] = pw[s * NP]; }
            const f32x2_t a1 = pw[1 * NP];
            WAVE_LDS_SYNC();
#pragma unroll
            for (int m = 0; m < 2; ++m) {
                f32x16 xr = MFMA32(uf[m], bre, (f32x16){}), xi = MFMA32(uf[m], bim, (f32x16){});
#pragma unroll
                for (int q = 0; q < 4; ++q)
#pragma unroll
                    for (int s = 0; s < 4; ++s) { const f32x2_t x = {xr[4 * q + s], xi[4 * q + s]}; const f32x2_t w = cmul(ilo[s], x); xr[4 * q + s] = w.x; xi[4 * q + s] = w.y; }
                bf16x8 wr0 = pack8(xr[0], xr[1], xr[2], xr[3], xr[4], xr[5], xr[6], xr[7]), wr1 = pack8(xr[8], xr[9], xr[10], xr[11], xr[12], xr[13], xr[14], xr[15]);
                bf16x8 wi0 = pack8(xi[0], xi[1], xi[2], xi[3], xi[4], xi[5], xi[6], xi[7]), wi1 = pack8(xi[8], xi[9], xi[10], xi[11], xi[12], xi[13], xi[14], xi[15]);
                const f32x16 cr = MFMA32(tds[1], wr1, MFMA32(tds[0], wr0, (f32x16){})), ci = MFMA32(tds[1], wi1, MFMA32(tds[0], wi0, (f32x16){}));
#pragma unroll
                for (int q = 0; q < 4; ++q) {
                    const int seq = 16 * sg + 8 * m + 2 * q + h;
                    const size_t si = (((size_t)l * DEC_BATCH + seq) * NG + g) * NP + pp;
                    const f32x2_t G = cmul(a1, (f32x2_t){p->in[4][si], p->in[5][si]});
                    float hr[4], hi[4];
#pragma unroll
                    for (int s = 0; s < 4; ++s) { const f32x2_t v = {cr[4 * q + s] + G.x, ci[4 * q + s] + G.y}; const f32x2_t w = cmul(plo[s], v); hr[s] = w.x; hi[s] = w.y; }
                    p->out[O_SRS + si] = hr[3]; p->out[O_SIS + si] = hi[3];
                    typedef unsigned u32x2_t __attribute__((ext_vector_type(2)));
                    u32x2_t wr_; wr_.x = cvtpk(hr[0], hr[1]); wr_.y = cvtpk(hr[2], hr[3]);
                    u32x2_t wi_; wi_.x = cvtpk(hi[0], hi[1]); wi_.y = cvtpk(hi[2], hi[3]);
                    *(LAS u32x2_t*)(ht + c31 * S5_HT_STR + (32 * m + 8 * q + 4 * h) * 2) = wr_;
                    *(LAS u32x2_t*)(ht + (32 + c31) * S5_HT_STR + (32 * m + 8 * q + 4 * h) * 2) = wi_;
                }
                __builtin_amdgcn_sched_barrier(0);
            }
            WAVE_LDS_SYNC();
#pragma unroll
            for (int ks = 0; ks < 2; ++ks) {
                const bf16x8 cf = *(const bf16x8*)(CCAT + ((size_t)lg * NC + i16) * 128 + 64 * ks + 32 * pt + 8 * kg);
#pragma unroll
                for (int it = 0; it < 4; ++it) {
                    LAS const unsigned char* ap = ht + (32 * ks + 8 * kg + qq) * S5_HT_STR + (16 * it + 4 * p4) * 2;
                    const bf16x8 af = cat8(tr_read(ap), tr_read(ap + 4 * S5_HT_STR));
                    Y[it] = MFMA16(af, cf, Y[it]);
                }
            }
        }
#pragma unroll
        for (int it = 0; it < 4; ++it)
#pragma unroll
            for (int r = 0; r < 4; ++r) {
                bf16_t* up = PROJ + (crow0 + 16 * it + 4 * kg + r) * IN_COLS + C_UB + 16 * g + i16;
                const float y = Y[it][r] + dd * bf2f(*up);
                if (!dry) *up = f2bf(gelu_tanh(y));
            }
    }
}

__device__ __forceinline__ void st_lru_sample(KP p, int l, const Ctx& c, LAS unsigned char* lds, bool dry) {
    bf16_t* PROJ = (bf16_t*)(p->ws + WS_PROJ);
    const bf16_t* LRUW = (const bf16_t*)(p->ws + WS_LRUW);
    for (int item = c.gw; item < (DEC_BATCH / 16) * 8; item += c.ngw) {
        int zi = 0; asm volatile("" : "+v"(zi));
        const int lane = c.lane + zi, c31 = lane & 31, h = lane >> 5;
        const int n = item & 7, sg = item >> 3;
        const size_t row0 = (size_t)M_P + 64 * sg;
        const int ch0 = n * 64;
        LAS unsigned char* xim = lds + c.wave * 9216;
        WAVE_LDS_SYNC();
#pragma unroll 1
        for (int ks = 0; ks < 4; ++ks) {
            const int chb = ch0 + 16 * ks + 8 * h;
            float w[4][8], cb[8];
#pragma unroll
            for (int j = 0; j < 4; ++j) {
                const f32x4 w0 = *(const f32x4*)(p->in[22] + (l * 4 + j) * 512 + chb), w1 = *(const f32x4*)(p->in[22] + (l * 4 + j) * 512 + chb + 4);
                w[j][0] = w0[0]; w[j][1] = w0[1]; w[j][2] = w0[2]; w[j][3] = w0[3]; w[j][4] = w1[0]; w[j][5] = w1[1]; w[j][6] = w1[2]; w[j][7] = w1[3];
            }
            { const f32x4 b0 = *(const f32x4*)(p->in[23] + l * 512 + chb), b1 = *(const f32x4*)(p->in[23] + l * 512 + chb + 4);
              cb[0] = b0[0]; cb[1] = b0[1]; cb[2] = b0[2]; cb[3] = b0[3]; cb[4] = b1[0]; cb[5] = b1[1]; cb[6] = b1[2]; cb[7] = b1[3]; }
#pragma unroll
            for (int m = 0; m < 2; ++m) {
                const int i = 32 * m + c31, t = i & 3, seq = 16 * sg + (i >> 2);
                float xf[8];
#pragma unroll
                for (int e = 0; e < 8; ++e) xf[e] = cb[e];
#pragma unroll
                for (int j = 0; j < 4; ++j) {
                    const int tau = t - 3 + j;
                    float xv[8];
                    if (tau >= 0) {
                        const u32x4 xx = *(const u32x4*)(PROJ + ((size_t)M_P + 4 * seq + tau) * IN_COLS + C_XC + chb);
#pragma unroll
                        for (int e = 0; e < 4; ++e) { xv[2 * e] = __uint_as_float(xx[e] << 16); xv[2 * e + 1] = __uint_as_float(xx[e] & 0xffff0000u); }
                    } else {
                        const float* cp = p->in[7] + (((size_t)l * DEC_BATCH + seq) * 3 + (3 + tau)) * 512 + chb;
                        const f32x4 c0 = *(const f32x4*)cp, c1 = *(const f32x4*)(cp + 4);
                        xv[0] = c0[0]; xv[1] = c0[1]; xv[2] = c0[2]; xv[3] = c0[3]; xv[4] = c1[0]; xv[5] = c1[1]; xv[6] = c1[2]; xv[7] = c1[3];
                    }
#pragma unroll
                    for (int e = 0; e < 8; ++e) xf[e] += w[j][e] * xv[e];
                }
                *(LAS bf16x8*)(xim + (32 * m + c31) * 144 + (16 * ks + 8 * h) * 2) = pack8(xf[0], xf[1], xf[2], xf[3], xf[4], xf[5], xf[6], xf[7]);
            }
        }
        WAVE_LDS_SYNC();
#pragma unroll 1
        for (int et = 0; et < 2; ++et) {
            const int ch = ch0 + 32 * et + c31;
            const float ba = p->in[25][l * 512 + ch], bx = p->in[27][l * 512 + ch], lam = p->in[28][l * 512 + ch];
            const float lsig8 = -8.0f * log1pf(expf(-lam));
            const bf16_t* wp = LRUW + (((size_t)(l * 8 + n) * 2) * 64 + 32 * et + c31) * 64 + 8 * h;
#pragma unroll
            for (int m = 0; m < 2; ++m) {
                f32x16 X = (f32x16){}, R = (f32x16){}, I = (f32x16){};
#pragma unroll
                for (int ks = 0; ks < 4; ++ks) {
                    const bf16x8 wa = *(const bf16x8*)(wp + 16 * ks), wx = *(const bf16x8*)(wp + 64 * 64 + 16 * ks);
                    bf16x8 id;
#pragma unroll
                    for (int j = 0; j < 8; ++j) id[j] = (16 * ks + 8 * h + j == 32 * et + c31) ? (short)0x3F80 : (short)0;
                    const bf16x8 afr = *(LAS const bf16x8*)(xim + (32 * m + c31) * 144 + (16 * ks + 8 * h) * 2);
                    R = MFMA32(afr, wa, R); I = MFMA32(afr, wx, I); X = MFMA32(afr, id, X);
                }
#pragma unroll
                for (int q = 0; q < 4; ++q) {
                    const int seq = 16 * sg + 8 * m + 2 * q + h;
                    float hv = p->in[6][((size_t)l * DEC_BATCH + seq) * 512 + ch];
#pragma unroll
                    for (int s = 0; s < 4; ++s) {
                        const int r = 4 * q + s;
                        const float rg = sigmoidf_(R[r] + ba), ig = sigmoidf_(I[r] + bx);
                        const float la = rg * lsig8;
                        const float a = __expf(la);
                        const float bg = X[r] * ig * sqrtf(neg_expm1_small(2.0f * la));
                        hv = a * hv + bg;
                        bf16_t* gp = PROJ + ((size_t)M_P + 4 * seq + s) * IN_COLS + C_GC + ch;
                        const float gc = bf2f(*gp);
                        if (!dry) *gp = f2bf(hv * siluf_(gc));
                    }
                    p->out[O_LS + ((size_t)l * DEC_BATCH + seq) * 512 + ch] = hv;
                }
                __builtin_amdgcn_sched_barrier(0);
            }
        }
    }
}

__device__ __forceinline__ void st_attn_sample(KP p, int l, LAS unsigned char* lds, bool dry) {
    int zv = 0; asm volatile("" : "+v"(zv));
    const int tid = (int)threadIdx.x + zv, lane = tid & 63, wave = __builtin_amdgcn_readfirstlane(tid >> 6);
    const int c31 = lane & 31, h = lane >> 5;
    bf16_t* PROJ = (bf16_t*)(p->ws + WS_PROJ);
    const float* rel_bias = p->in[8];
    for (int item = blockIdx.x; item < DEC_BATCH * NKV; item += gridDim.x) {
        const int b = item >> 1, kvh = item & 1;
#pragma unroll
        for (int i = 0; i < 3; ++i) {
            const int id = tid + 512 * i, row = id >> 3, pc = id & 7;
            if (id < 160 * 8) {
                u32x4 kk = (u32x4){0u, 0u, 0u, 0u}, vv = kk;
                if (row < WINDOW) {
                    const size_t ci = ((((size_t)l * DEC_BATCH + b) * WINDOW + row) * NKV + kvh) * HD + pc * 8;
                    const f32x4 k0 = *(const f32x4*)(p->in[2] + ci), k1 = *(const f32x4*)(p->in[2] + ci + 4), v0 = *(const f32x4*)(p->in[3] + ci), v1 = *(const f32x4*)(p->in[3] + ci + 4);
                    kk.x = cvtpk(k0[0], k0[1]); kk.y = cvtpk(k0[2], k0[3]); kk.z = cvtpk(k1[0], k1[1]); kk.w = cvtpk(k1[2], k1[3]);
                    vv.x = cvtpk(v0[0], v0[1]); vv.y = cvtpk(v0[2], v0[3]); vv.z = cvtpk(v1[0], v1[1]); vv.w = cvtpk(v1[2], v1[3]);
                } else if (row < WINDOW + DEC_SEQ) {
                    const bf16_t* src = PROJ + ((size_t)M_P + 4 * b + (row - WINDOW)) * IN_COLS + kvh * 64 + pc * 8;
                    kk = *(const u32x4*)(src + C_K); vv = *(const u32x4*)(src + C_V);
                }
                *(LAS u32x4*)(lds + AT_K + row * AT_KSTR + pc * 16) = kk;
                *(LAS u32x4*)(lds + AT_V + row * AT_VSTR + pc * 16) = vv;
            }
        }
        { const int g = tid >> 7, d = tid & 127; ((LAS float*)(lds + AT_BIAS))[tid] = rel_bias[T5_BUCKET[d] * NQH + kvh * 4 + g]; }
        __syncthreads();
        if (wave == 0) {
            const int qc = c31 & 15, g = qc >> 2, iq = qc & 3, hq = kvh * 4 + g;
            const float sink = p->in[10][l * NQH + hq];
            LAS const float* biasd = (LAS const float*)(lds + AT_BIAS) + g * 128;
            LAS float* wsf = (LAS float*)(lds + AT_WS);
            bf16x8 qf[4];
            { const bf16_t* qp = PROJ + ((size_t)M_P + 4 * b + iq) * IN_COLS + C_Q + hq * 64 + 8 * h;
#pragma unroll
              for (int ks = 0; ks < 4; ++ks) qf[ks] = *(const bf16x8*)(qp + 16 * ks); }
            f32x16 S[5];
#pragma unroll
            for (int j = 0; j < 5; ++j) {
                S[j] = (f32x16){};
                LAS const unsigned char* kp = lds + AT_K + (32 * j + c31) * AT_KSTR + 16 * h;
#pragma unroll
                for (int ks = 0; ks < 4; ++ks) S[j] = MFMA32(*(LAS const bf16x8*)(kp + 32 * ks), qf[ks], S[j]);
            }
            float mx = sink;
#pragma unroll
            for (int j = 0; j < 5; ++j)
#pragma unroll
                for (int r = 0; r < 16; ++r) {
                    const int kv = 32 * j + (r & 3) + 8 * (r >> 2) + 4 * h;
                    const int dist = iq + 128 - kv;
                    const bool ok = (dist >= 0) && (dist < 128);
                    const float s = ok ? S[j][r] * 0.125f + biasd[dist & 127] : -1e30f;
                    S[j][r] = s; mx = fmaxf(mx, s);
                }
            mx = fmaxf(mx, __shfl_xor(mx, 32));
            float sum = 0.f;
#pragma unroll
            for (int j = 0; j < 5; ++j)
#pragma unroll
                for (int r = 0; r < 16; ++r) { const float e = S[j][r] > -1e29f ? __expf(S[j][r] - mx) : 0.f; S[j][r] = e; sum += e; }
            sum += __shfl_xor(sum, 32);
            const float rden = 1.0f / (sum + __expf(sink - mx));
            if (h == 0) wsf[c31] = rden;
            f32x16 O[2]; O[0] = (f32x16){}; O[1] = (f32x16){};
            const int i16 = lane & 15, qq = i16 >> 2, pp = i16 & 3, blk = (lane >> 4) & 1;
#pragma unroll
            for (int j = 0; j < 5; ++j)
#pragma unroll
                for (int s = 0; s < 2; ++s) {
                    const bf16x8 pf = pack8(S[j][8 * s], S[j][8 * s + 1], S[j][8 * s + 2], S[j][8 * s + 3], S[j][8 * s + 4], S[j][8 * s + 5], S[j][8 * s + 6], S[j][8 * s + 7]);
                    LAS const unsigned char* vp = lds + AT_V + (32 * j + 16 * s + 4 * h + qq) * AT_VSTR + (16 * blk + 4 * pp) * 2;
#pragma unroll
                    for (int dt = 0; dt < 2; ++dt) {
                        const bf16x8 vf = cat8(tr_read(vp + dt * 64), tr_read(vp + dt * 64 + 8 * AT_VSTR));
                        O[dt] = MFMA32(pf, vf, O[dt]);
                    }
                }
            WAVE_LDS_SYNC();
#pragma unroll
            for (int r = 0; r < 8; ++r) {
                const int qr = (r & 3) + 8 * (r >> 2) + 4 * h, g2 = qr >> 2, i2 = qr & 3;
                const float rd = wsf[qr];
                bf16_t* rowp = PROJ + ((size_t)M_P + 4 * b + i2) * IN_COLS + (kvh * 4 + g2) * 64 + c31;
#pragma unroll
                for (int dt = 0; dt < 2; ++dt) {
                    const float ga = bf2f(rowp[C_GA + 32 * dt]);
                    if (!dry) rowp[C_Q + 32 * dt] = f2bf(O[dt][r] * rd * siluf_(ga));
                }
            }
        }
        __syncthreads();
    }
}

__device__ __forceinline__ void st_s5_simple(KP p, int l, const Ctx& c, LAS float* wsm, bool dry) {
    bf16_t* PROJ = (bf16_t*)(p->ws + WS_PROJ);
    const float* AB = (const float*)(p->ws + WS_TAB + TAB_AB);
    const float* BB = (const float*)(p->ws + WS_TAB + TAB_BB);
    const int pp = c.lane;
    for (int item = c.gw; item < DEC_BATCH * NG; item += c.ngw) {
        const int seq = BATCH + item / NG, g = item % NG;
        const bool samp = seq >= BATCH;
        const int b = samp ? seq - BATCH : seq, T = samp ? DEC_SEQ : SEQ;
        const size_t row0 = samp ? (size_t)M_P + b * DEC_SEQ : (size_t)b * SEQ;
        const int sidx = (l * NG + g) * NP + pp;
        const float ab_re = AB[2 * sidx], ab_im = AB[2 * sidx + 1];
        float bbr[16], bbi[16], cr[16], ci[16];
#pragma unroll
        for (int cc = 0; cc < 16; ++cc) {
            bbr[cc] = BB[((size_t)sidx * NC + cc) * 2]; bbi[cc] = BB[((size_t)sidx * NC + cc) * 2 + 1];
            cr[cc] = p->in[17][((size_t)(l * NG + g) * NC + cc) * NP + pp]; ci[cc] = p->in[18][((size_t)(l * NG + g) * NC + cc) * NP + pp];
        }
        const float dd = pp < 16 ? p->in[19][l * 512 + g * 16 + pp] : 0.f;
        float hr = 0.f, hi = 0.f;
        if (samp) { const size_t si = (((size_t)l * DEC_BATCH + b) * NG + g) * NP + pp; hr = p->in[4][si]; hi = p->in[5][si]; }
        for (int t = 0; t < T; ++t) {
            bf16_t* up = PROJ + (row0 + t) * IN_COLS + C_UB + g * 16;
            float u[16];
#pragma unroll
            for (int cc = 0; cc < 16; ++cc) u[cc] = bf2f(up[cc]);
            float xr = 0.f, xi = 0.f;
#pragma unroll
            for (int cc = 0; cc < 16; ++cc) { xr += bbr[cc] * u[cc]; xi += bbi[cc] * u[cc]; }
            const float nr = ab_re * hr - ab_im * hi + xr, ni = ab_re * hi + ab_im * hr + xi;
            hr = nr; hi = ni;
#pragma unroll
            for (int cc = 0; cc < 16; ++cc) wsm[pp * 17 + cc] = cr[cc] * hr - ci[cc] * hi;
            WAVE_LDS_SYNC();
            if (pp < 16) {
                float y = 0.f;
                for (int q = 0; q < 64; ++q) y += wsm[q * 17 + pp];
                y += dd * bf2f(up[pp]);
                if (!dry) up[pp] = f2bf(gelu_tanh(y));
            }
            WAVE_LDS_SYNC();
        }
        if (!samp) { const size_t oi = (((size_t)l * BATCH + b) * NG + g) * NP + pp; p->out[O_SRP + oi] = hr; p->out[O_SIP + oi] = hi; }
        else { const size_t oi = (((size_t)l * DEC_BATCH + b) * NG + g) * NP + pp; p->out[O_SRS + oi] = hr; p->out[O_SIS + oi] = hi; }
    }
}

struct EpiGlu { bf16_t* PROJ; __device__ void operator()(int r, int c, float v) const {
    const float z = bf2f(PROJ[(size_t)r * IN_COLS + C_UB + c]), gb = bf2f(PROJ[(size_t)r * IN_COLS + C_GB + c]);
    PROJ[(size_t)r * IN_COLS + C_GB + c] = f2bf(z * sigmoidf_(v) * siluf_(gb)); } };

constexpr int LR_NSEG = 32;
template <bool PHASE_B>
__device__ __forceinline__ void st_lru_mfma(KP p, int l, const Ctx& c, LAS unsigned char* lds, bool dry) {
    bf16_t* PROJ = (bf16_t*)(p->ws + WS_PROJ);
    const bf16_t* LRUW = (const bf16_t*)(p->ws + WS_LRUW);
    f32x2_t* LSUM = (f32x2_t*)(p->ws + WS_LRSUM);
    for (int item = c.gw; item < BATCH * LR_NSEG * 8; item += c.ngw) {
        int zi = 0; asm volatile("" : "+v"(zi));
        const int lane = c.lane + zi, c31 = lane & 31, h = lane >> 5;
        const int n = item & 7, seg = (item >> 3) % LR_NSEG, b = item / (8 * LR_NSEG);
        const size_t row0 = (size_t)b * SEQ + (size_t)seg * 64;
        const int ch0 = n * 64;
        LAS unsigned char* xim = lds + c.wave * 9216;
        WAVE_LDS_SYNC();
#pragma unroll 1
        for (int ks = 0; ks < 4; ++ks) {
            const int chb = ch0 + 16 * ks + 8 * h;
            float w[4][8], cb[8];
#pragma unroll
            for (int j = 0; j < 4; ++j) {
                const f32x4 w0 = *(const f32x4*)(p->in[22] + (l * 4 + j) * 512 + chb), w1 = *(const f32x4*)(p->in[22] + (l * 4 + j) * 512 + chb + 4);
                w[j][0] = w0[0]; w[j][1] = w0[1]; w[j][2] = w0[2]; w[j][3] = w0[3]; w[j][4] = w1[0]; w[j][5] = w1[1]; w[j][6] = w1[2]; w[j][7] = w1[3];
            }
            { const f32x4 b0 = *(const f32x4*)(p->in[23] + l * 512 + chb), b1 = *(const f32x4*)(p->in[23] + l * 512 + chb + 4);
              cb[0] = b0[0]; cb[1] = b0[1]; cb[2] = b0[2]; cb[3] = b0[3]; cb[4] = b1[0]; cb[5] = b1[1]; cb[6] = b1[2]; cb[7] = b1[3]; }
#pragma unroll
            for (int m = 0; m < 2; ++m) {
                const int t = seg * 64 + 32 * m + c31;
                float xf[8];
#pragma unroll
                for (int e = 0; e < 8; ++e) xf[e] = cb[e];
#pragma unroll
                for (int j = 0; j < 4; ++j) {
                    u32x4 xx = (u32x4){0u, 0u, 0u, 0u};
                    if (t - 3 + j >= 0) xx = *(const u32x4*)(PROJ + (row0 + 32 * m + c31 - 3 + j) * IN_COLS + C_XC + chb);
#pragma unroll
                    for (int e = 0; e < 4; ++e) { xf[2 * e] += w[j][2 * e] * __uint_as_float(xx[e] << 16); xf[2 * e + 1] += w[j][2 * e + 1] * __uint_as_float(xx[e] & 0xffff0000u); }
                }
                *(LAS bf16x8*)(xim + (32 * m + c31) * 144 + (16 * ks + 8 * h) * 2) = pack8(xf[0], xf[1], xf[2], xf[3], xf[4], xf[5], xf[6], xf[7]);
            }
        }
        WAVE_LDS_SYNC();
#pragma unroll 1
        for (int et = 0; et < 2; ++et) {
            const int ch = ch0 + 32 * et + c31;
            const float ba = p->in[25][l * 512 + ch], bx = p->in[27][l * 512 + ch], lam = p->in[28][l * 512 + ch];
            const float lsig8 = -8.0f * log1pf(expf(-lam));
            const bf16_t* wp = LRUW + (((size_t)(l * 8 + n) * 2) * 64 + 32 * et + c31) * 64 + 8 * h;
            f32x16 R[2], I[2];
            float Ar[8], Br[8];
            __builtin_amdgcn_sched_barrier(0);
#pragma unroll
            for (int m = 0; m < 2; ++m) {
                f32x16 X = (f32x16){}; R[m] = (f32x16){}; I[m] = (f32x16){};
#pragma unroll
                for (int ks = 0; ks < 4; ++ks) {
                    const bf16x8 wa = *(const bf16x8*)(wp + 16 * ks), wx = *(const bf16x8*)(wp + 64 * 64 + 16 * ks);
                    bf16x8 id;
#pragma unroll
                    for (int j = 0; j < 8; ++j) id[j] = (16 * ks + 8 * h + j == 32 * et + c31) ? (short)0x3F80 : (short)0;
                    const bf16x8 afr = *(LAS const bf16x8*)(xim + (32 * m + c31) * 144 + (16 * ks + 8 * h) * 2);
                    R[m] = MFMA32(afr, wa, R[m]); I[m] = MFMA32(afr, wx, I[m]); X = MFMA32(afr, id, X);
                }
#pragma unroll
                for (int q = 0; q < 4; ++q) {
                    float cp = 1.f, hl = 0.f;
#pragma unroll
                    for (int s = 0; s < 4; ++s) {
                        const int r = 4 * q + s;
                        const float rg = sigmoidf_(R[m][r] + ba), ig = sigmoidf_(I[m][r] + bx);
                        const float la = rg * lsig8;
                        const float a = __expf(la);
                        const float bg = X[r] * ig * sqrtf(neg_expm1_small(2.0f * la));
                        cp *= a; hl = a * hl + bg;
                        R[m][r] = cp; I[m][r] = hl;
                    }
                    Ar[4 * m + q] = cp; Br[4 * m + q] = hl;
                }
                __builtin_amdgcn_sched_barrier(0);
            }
            float Hc = 0.f;
            if (PHASE_B) {
                for (int k0 = 0; k0 < seg; k0 += 8) {
                    f32x2_t ab[8];
#pragma unroll
                    for (int j = 0; j < 8; ++j) ab[j] = (k0 + j < seg) ? LSUM[((size_t)b * LR_NSEG + k0 + j) * 512 + ch] : (f32x2_t){1.f, 0.f};
#pragma unroll
                    for (int j = 0; j < 8; ++j) Hc = ab[j].x * Hc + ab[j].y;
                }
            }
            float st = Hc, At = 1.f, cin[8];
#pragma unroll
            for (int gi = 0; gi < 8; ++gi) {
                const float Ao = __shfl_xor(Ar[gi], 32), Bo = __shfl_xor(Br[gi], 32);
                const float A0 = h == 0 ? Ar[gi] : Ao, B0 = h == 0 ? Br[gi] : Bo, A1 = h == 0 ? Ao : Ar[gi], B1 = h == 0 ? Bo : Br[gi];
                const float s1 = A0 * st + B0;
                cin[gi] = h == 0 ? st : s1;
                st = A1 * s1 + B1; At *= A0 * A1;
            }
            if (!PHASE_B) {
                if (h == 0) LSUM[((size_t)b * LR_NSEG + seg) * 512 + ch] = (f32x2_t){At, st};
            } else {
#pragma unroll
                for (int m = 0; m < 2; ++m)
#pragma unroll
                    for (int r = 0; r < 16; ++r) {
                        const float hv = I[m][r] + R[m][r] * cin[4 * m + (r >> 2)];
                        bf16_t* gp = PROJ + (row0 + 32 * m + (r & 3) + 8 * (r >> 2) + 4 * h) * IN_COLS + C_GC + ch;
                        const float gc = bf2f(*gp);
                        if (!dry) *gp = f2bf(hv * siluf_(gc));
                        if (m == 1 && r == 15 && h == 1 && seg == LR_NSEG - 1) p->out[O_LP + ((size_t)l * BATCH + b) * 512 + ch] = hv;
                    }
            }
        }
    }
}

__device__ __forceinline__ void st_lru_simple(KP p, int l, const Ctx& c, LAS float* wsm, bool dry) {
    bf16_t* PROJ = (bf16_t*)(p->ws + WS_PROJ);
    const int e = c.lane;
    for (int item = c.gw; item < DEC_BATCH * 8; item += c.ngw) {
        const int seq = BATCH + item / 8, n = item % 8, ch = n * 64 + e;
        const bool samp = seq >= BATCH;
        const int b = samp ? seq - BATCH : seq, T = samp ? DEC_SEQ : SEQ;
        const size_t row0 = samp ? (size_t)M_P + b * DEC_SEQ : (size_t)b * SEQ;
        float wa[64], wx[64];
#pragma unroll
        for (int d = 0; d < 64; ++d) { wa[d] = p->in[24][(((size_t)l * 8 + n) * 64 + d) * 64 + e]; wx[d] = p->in[26][(((size_t)l * 8 + n) * 64 + d) * 64 + e]; }
        const float ba = p->in[25][l * 512 + ch], bx = p->in[27][l * 512 + ch], lam = p->in[28][l * 512 + ch];
        const float lsig = -log1pf(expf(-lam));
        const float cw0 = p->in[22][(l * 4 + 0) * 512 + ch], cw1 = p->in[22][(l * 4 + 1) * 512 + ch], cw2 = p->in[22][(l * 4 + 2) * 512 + ch], cw3 = p->in[22][(l * 4 + 3) * 512 + ch];
        const float cb = p->in[23][l * 512 + ch];
        float xm3 = 0.f, xm2 = 0.f, xm1 = 0.f, h = 0.f;
        if (samp) {
            const size_t ci = (((size_t)l * DEC_BATCH + b) * 3) * 512 + ch;
            xm3 = p->in[7][ci]; xm2 = p->in[7][ci + 512]; xm1 = p->in[7][ci + 1024];
            h = p->in[6][((size_t)l * DEC_BATCH + b) * 512 + ch];
        }
        for (int t = 0; t < T; ++t) {
            bf16_t* rp = PROJ + (row0 + t) * IN_COLS;
            const float xc = bf2f(rp[C_XC + ch]);
            const float xf = cb + cw0 * xm3 + cw1 * xm2 + cw2 * xm1 + cw3 * xc;
            xm3 = xm2; xm2 = xm1; xm1 = xc;
            wsm[e] = xf;
            WAVE_LDS_SYNC();
            float r = ba, i = bx;
#pragma unroll
            for (int d = 0; d < 64; ++d) { const float xv = wsm[d]; r += xv * wa[d]; i += xv * wx[d]; }
            WAVE_LDS_SYNC();
            r = sigmoidf_(r); i = sigmoidf_(i);
            const float log_a = 8.0f * r * lsig;
            const float a = expf(log_a);
            const float bt = xf * i * sqrtf(-expm1f(2.0f * log_a));
            h = a * h + bt;
            const float gc = bf2f(rp[C_GC + ch]);
            if (!dry) rp[C_GC + ch] = f2bf(h * siluf_(gc));
        }
        if (!samp) {
            p->out[O_LP + ((size_t)l * BATCH + b) * 512 + ch] = h;
            const size_t ci = (((size_t)l * BATCH + b) * 3) * 512 + ch;
            p->out[O_CP + ci] = xm3; p->out[O_CP + ci + 512] = xm2; p->out[O_CP + ci + 1024] = xm1;
        } else {
            p->out[O_LS + ((size_t)l * DEC_BATCH + b) * 512 + ch] = h;
            const size_t ci = (((size_t)l * DEC_BATCH + b) * 3) * 512 + ch;
            p->out[O_CS + ci] = xm3; p->out[O_CS + ci + 512] = xm2; p->out[O_CS + ci + 1024] = xm1;
        }
    }
}

__device__ __forceinline__ void st_branch_simple(KP p, int l, const Ctx& c) {
    bf16_t* PROJ = (bf16_t*)(p->ws + WS_PROJ);
    const bf16_t* WB = (const bf16_t*)((unsigned char*)p->out + DO_WBR) + (size_t)l * 3 * 1024 * 512;
    const int lane = c.lane;
    const int ntn = 1024 / 32, ntiles = (M_TOT / 32) * ntn;
    for (int tile = c.gw; tile < ntiles; tile += c.ngw) {
        const int tm = tile / ntn, tn = tile % ntn;
        f32x16 acc[3];
#pragma unroll
        for (int br = 0; br < 3; ++br) {
            const int acol = br == 0 ? C_Q : (br == 1 ? C_GB : C_XC);
            acc[br] = (f32x16){};
            const bf16_t* ar = PROJ + (size_t)(tm * 32 + (lane & 31)) * IN_COLS + acol + 8 * (lane >> 5);
            const bf16_t* bp = WB + (size_t)br * 1024 * 512 + (size_t)(tn * 32 + (lane & 31)) * 512 + 8 * (lane >> 5);
            for (int k0 = 0; k0 < 512; k0 += 16)
                acc[br] = __builtin_amdgcn_mfma_f32_32x32x16_bf16(*(const bf16x8*)(ar + k0), *(const bf16x8*)(bp + k0), acc[br], 0, 0, 0);
        }
#pragma unroll
        for (int r = 0; r < 16; ++r) {
            const int row = tm * 32 + (r & 3) + 8 * (r >> 2) + 4 * (lane >> 5), col = tn * 32 + (lane & 31);
            bf16_t* gp = PROJ + (size_t)row * IN_COLS + C_GM + col;
            const float m = sigmoidf_(bf2f(gp[0])) * acc[0][r] + sigmoidf_(bf2f(gp[1024])) * acc[1][r] + sigmoidf_(bf2f(gp[2048])) * acc[2][r];
            gp[0] = f2bf(m);
        }
    }
}

__device__ __forceinline__ float* pre_row(unsigned char* ws, int r) { return (float*)(ws + WS_PROJ + (size_t)r * IN_COLS * 2 + (size_t)(C_GM + 1024) * 2); }
struct EpiOut { KP p; int l; __device__ void operator()(int r, int c, float v) const {
    float x;
    if (l == 0) x = r < M_P ? p->in[0][(size_t)r * D_MODEL + c] : p->in[1][(size_t)(r - M_P) * D_MODEL + c];
    else x = bf2f(((const bf16_t*)(p->ws + WS_XB))[(size_t)r * D_MODEL + c]);
    pre_row(p->ws, r)[c] = DN_ALPHA * x + v; } };

__device__ __forceinline__ void st_ln(KP p, int l, const Ctx& c) {
    const int lane = c.lane;
    const float* g = p->in[31] + l * 1024; const float* bb = p->in[32] + l * 1024;
    f32x4 gv[4], bv[4];
#pragma unroll
    for (int j = 0; j < 4; ++j) { gv[j] = *(const f32x4*)(g + 4 * lane + 256 * j); bv[j] = *(const f32x4*)(bb + 4 * lane + 256 * j); }
    constexpr int NR = 3;
    for (int r0 = c.gw * NR; r0 < M_TOT; r0 += c.ngw * NR) {
        f32x4 v[NR][4];
#pragma unroll
        for (int k = 0; k < NR; ++k) { const int r = r0 + k < M_TOT ? r0 + k : M_TOT - 1; const float* pr = pre_row(p->ws, r);
#pragma unroll
            for (int j = 0; j < 4; ++j) v[k][j] = *(const f32x4*)(pr + 4 * lane + 256 * j); }
#pragma unroll
        for (int k = 0; k < NR; ++k) {
            const int r = r0 + k;
            float s = 0.f;
#pragma unroll
            for (int j = 0; j < 4; ++j) s += (v[k][j][0] + v[k][j][1]) + (v[k][j][2] + v[k][j][3]);
            for (int o = 32; o > 0; o >>= 1) s += __shfl_xor(s, o);
            const float mu = s * (1.0f / 1024.0f);
            float q = 0.f;
#pragma unroll
            for (int j = 0; j < 4; ++j) { const f32x4 d = v[k][j] - mu; q += (d[0] * d[0] + d[1] * d[1]) + (d[2] * d[2] + d[3] * d[3]); }
            for (int o = 32; o > 0; o >>= 1) q += __shfl_xor(q, o);
            const float rstd = rsqrtf(q * (1.0f / 1024.0f) + LN_EPS);
            if (r < M_TOT) {
#pragma unroll
                for (int j = 0; j < 4; ++j) {
                    const f32x4 y = (v[k][j] - mu) * rstd * gv[j] + bv[j];
                    const int cc = 4 * lane + 256 * j;
                    if (l == 0) { typedef unsigned u32x2_t __attribute__((ext_vector_type(2))); u32x2_t o; o.x = cvtpk(y[0], y[1]); o.y = cvtpk(y[2], y[3]);
                                  *(u32x2_t*)((bf16_t*)(p->ws + WS_XB) + (size_t)r * D_MODEL + cc) = o; }
                    else if (r < M_P) *(f32x4*)(p->out + O_YP + (size_t)r * D_MODEL + cc) = y;
                    else *(f32x4*)(p->out + O_YS + (size_t)(r - M_P) * D_MODEL + cc) = y;
                }
            }
        }
    }
}

__global__ void __launch_bounds__(NTHREADS, 2) mega_fwd(P p_unused) {
    extern __shared__ __attribute__((aligned(16))) unsigned char lds_raw[];
    LAS unsigned char* lds = (LAS unsigned char*)lds_raw;
    volatile LAS unsigned* misc = (volatile LAS unsigned*)(lds + LDS_MISC);
    if (threadIdx.x < 32) misc[threadIdx.x] = 0u;
    __syncthreads();
    XcdBarrier bar;
    { KP p = get_kp(); bar = xcd_barrier_post((unsigned*)(p->ws + WS_CTL), misc); }

    { KP p = get_kp(); const Ctx c = make_ctx(); unsigned char* dob = (unsigned char*)p->out;
      st_convert_x(p, c);
      st_prologue_weights(p, c, (LAS float*)(lds + c.wave * 9216));
      st_s5_tables(p, c); st_s5_tables2(p, c);
      { bf16_t* LRUW = (bf16_t*)(p->ws + WS_LRUW);
        for (size_t i = c.gt; i < (size_t)DEPTH * 8 * 2 * 64 * 64; i += c.ngt) {
            const int d = (int)(i & 63), e = (int)((i >> 6) & 63), mat = (int)((i >> 12) & 1), ln = (int)(i >> 13);
            LRUW[i] = f2bf(p->in[mat ? 26 : 24][((size_t)ln * 64 + d) * 64 + e]); } } }
    xcd_barrier(bar);

#ifndef PROBE
#define PROBE 0
#endif
#define PROBE_RUN(K, BODY) do { if (PROBE == (K)) { int d_ = 1; asm volatile("" : "+s"(d_)); const bool dry = d_ != 0; BODY; __syncthreads(); } { const bool dry = false; BODY; } } while (0)
#define PH_P1 { KP p = get_kp(); int zs = 0; asm volatile("" : "+s"(zs)); (void)dry; \
          pg8::Gemm g{(const bf16_t*)(p->ws + WS_XB), D_MODEL, (const bf16_t*)((unsigned char*)p->out + DO_WIN) + (size_t)l * IN_COLS * 1024, 1024}; \
          pg8::StaticOrder S; S.init(M_TOT, IN_COLS, (int)gridDim.x + zs, (int)blockIdx.x + zs); \
          pg8::gemm_phase<pg8::EpiProjB, pg8::StaticOrder, true, true>(lds, g, S, pg8::EpiProjB{(bf16_t*)(p->ws + WS_PROJ), IN_COLS}); }
#define PH_SAMPLE { KP p = get_kp(); const Ctx c = make_ctx(); st_s5_sample(p, l, c, lds, dry); st_lru_sample(p, l, c, lds, dry); }
#define PH_SUMM { KP p = get_kp(); const Ctx c = make_ctx(); (void)dry; st_kv_out(p, l, c); st_s5_phaseA(p, l, c); st_lru_mfma<false>(p, l, c, lds, false); }
#define PH_ATTN { __syncthreads(); KP p = get_kp(); st_attn_prompt(p, l, lds, dry); st_attn_sample(p, l, lds, dry); }
#define PH_S5B { KP p = get_kp(); const Ctx c = make_ctx(); st_s5_phaseB(p, l, c, lds, dry); }
#define PH_LRUB { KP p = get_kp(); const Ctx c = make_ctx(); st_lru_mfma<true>(p, l, c, lds, dry); }
#define PH_GLU { KP p = get_kp(); int zs = 0; asm volatile("" : "+s"(zs)); bf16_t* PROJ = (bf16_t*)(p->ws + WS_PROJ); \
          pg8::Gemm g{PROJ + C_UB, IN_COLS, (const bf16_t*)((unsigned char*)p->out + DO_WGLU) + (size_t)l * 512 * 512, 512}; \
          pg8::StaticOrder S; S.init(M_TOT, 512, (int)gridDim.x + zs, (int)blockIdx.x + zs); \
          pg8::gemm_phase<pg8::EpiGluB, pg8::StaticOrder, true, true>(lds, g, S, pg8::EpiGluB{PROJ, dry}); }
#define PH_BRANCH { KP p = get_kp(); int zs = 0; asm volatile("" : "+s"(zs)); bf16_t* PROJ = (bf16_t*)(p->ws + WS_PROJ); \
          pg8::Gemm g{PROJ, IN_COLS, (const bf16_t*)((unsigned char*)p->out + DO_WBR) + (size_t)l * 3 * 1024 * 512, 512}; \
          pg8::BranchOrder S; S.init(M_TOT, 1024, (int)gridDim.x + zs, (int)blockIdx.x + zs); \
          pg8::gemm_phase<pg8::EpiBranchB, pg8::BranchOrder, true, true>(lds, g, S, pg8::EpiBranchB{PROJ, dry}); }
#define PH_OUT { KP p = get_kp(); int zs = 0; asm volatile("" : "+s"(zs)); bf16_t* PROJ = (bf16_t*)(p->ws + WS_PROJ); (void)dry; \
          pg8::Gemm g{PROJ + C_GM, IN_COLS, (const bf16_t*)(p->ws + WS_WOUT) + (size_t)l * 1024 * 1024, 1024}; \
          pg8::StaticOrder S; S.init(M_TOT, 1024, (int)gridDim.x + zs, (int)blockIdx.x + zs); \
          pg8::gemm_phase<pg8::EpiOutB, pg8::StaticOrder, true, true>(lds, g, S, pg8::EpiOutB{p->in[0], p->in[1], (const bf16_t*)(p->ws + WS_XB), p->ws, l}); }
#define PH_LN { KP p = get_kp(); const Ctx c = make_ctx(); (void)dry; st_ln(p, l, c); }
    for (int l = 0; l < DEPTH; ++l) {
        PROBE_RUN(1, PH_P1);
        xcd_barrier(bar);
        PROBE_RUN(2, PH_SAMPLE);
        PROBE_RUN(3, PH_SUMM);
        PROBE_RUN(4, PH_ATTN);
        xcd_barrier(bar);
        PROBE_RUN(5, PH_S5B);
        PROBE_RUN(6, PH_LRUB);
        xcd_barrier(bar);
        PROBE_RUN(7, PH_GLU);
        xcd_barrier(bar);
        PROBE_RUN(8, PH_BRANCH);
        xcd_barrier(bar);
        PROBE_RUN(9, PH_OUT);
        xcd_barrier(bar);
        PROBE_RUN(10, PH_LN);
        if (l + 1 < DEPTH) xcd_barrier(bar);
    }
}

extern "C" void kernel_launch(void* const* d_in, const int* in_sizes, int n_in, void* d_out, int out_size, void* d_ws, size_t ws_size, hipStream_t stream) {
    static int grid = 0;
    if (grid == 0) {
        if (n_in != 33 || (size_t)out_size != O_END || ws_size < WS_CTL + CTL_BYTES) { fprintf(stderr, "kernel_launch: unexpected sizes n_in %d out %d ws %zu\n", n_in, out_size, ws_size); grid = -1; return; }
        int dev = 0, cus = 0, per_cu = 0;
        if (hipGetDevice(&dev) != hipSuccess || hipDeviceGetAttribute(&cus, hipDeviceAttributeMultiprocessorCount, dev) != hipSuccess) { grid = -1; return; }
        if (hipFuncSetAttribute((const void*)mega_fwd, hipFuncAttributeMaxDynamicSharedMemorySize, LDS_BYTES) != hipSuccess) { fprintf(stderr, "kernel_launch: hipFuncSetAttribute failed\n"); grid = -1; return; }
        if (hipOccupancyMaxActiveBlocksPerMultiprocessor(&per_cu, (const void*)mega_fwd, NTHREADS, LDS_BYTES) != hipSuccess || per_cu < 1) { fprintf(stderr, "kernel_launch: occupancy query says %d blocks/CU\n", per_cu); grid = -1; return; }
        grid = cus;
    }
    if (grid < 0) return;
    (void)hipMemsetAsync((unsigned char*)d_ws + WS_CTL, 0, CTL_BYTES, stream);
    P p{};
    for (int i = 0; i < 33; ++i) p.in[i] = (const float*)d_in[i];
    p.out = (float*)d_out; p.ws = (unsigned char*)d_ws;
    void* args[] = {&p};
    hipError_t e = hipLaunchCooperativeKernel((const void*)mega_fwd, dim3(grid), dim3(NTHREADS), args, LDS_BYTES, stream);
    if (e != hipSuccess) fprintf(stderr, "kernel_launch: cooperative launch failed: %s (grid %d)\n", hipGetErrorString(e), grid);
}
```

```cpp
#include <hip/hip_runtime.h>
#include <cstdint>
#include <cstdio>

typedef unsigned short bf16_t;
typedef short bf16x8 __attribute__((ext_vector_type(8)));
typedef float f32x16 __attribute__((ext_vector_type(16)));
typedef float f32x4 __attribute__((ext_vector_type(4)));

constexpr int D_MODEL = 1024, BATCH = 8, SEQ = 2048, DEPTH = 2, DEC_BATCH = 128, DEC_SEQ = 4;
constexpr int M_P = BATCH * SEQ;
constexpr int M_S = DEC_BATCH * DEC_SEQ;
constexpr int M_TOT = M_P + M_S;
constexpr int IN_COLS = 6400;
constexpr int C_Q = 0, C_K = 512, C_V = 640, C_GA = 768, C_UB = 1280, C_GB = 1792, C_XC = 2304, C_GC = 2816, C_GM = 3328;
constexpr int WINDOW = 128, NKV = 2, HD = 64, NQH = 8;
constexpr int NG = 32, NP = 64, NC = 16;
constexpr float DN_ALPHA = 1.4142135623730951f;
constexpr float LN_EPS = 1e-5f;

constexpr size_t O_YP = 0;
constexpr size_t O_YS = O_YP + (size_t)M_P * D_MODEL;
constexpr size_t O_KP = O_YS + (size_t)M_S * D_MODEL;
constexpr size_t SZ_KP = (size_t)DEPTH * BATCH * WINDOW * NKV * HD;
constexpr size_t O_VP = O_KP + SZ_KP;
constexpr size_t O_SRP = O_VP + SZ_KP;
constexpr size_t SZ_SP = (size_t)DEPTH * BATCH * NG * NP;
constexpr size_t O_SIP = O_SRP + SZ_SP;
constexpr size_t O_LP = O_SIP + SZ_SP;
constexpr size_t SZ_LP = (size_t)DEPTH * BATCH * 512;
constexpr size_t O_CP = O_LP + SZ_LP;
constexpr size_t SZ_CP = (size_t)DEPTH * BATCH * 3 * 512;
constexpr size_t O_KS = O_CP + SZ_CP;
constexpr size_t SZ_KS = (size_t)DEPTH * DEC_BATCH * WINDOW * NKV * HD;
constexpr size_t O_VS = O_KS + SZ_KS;
constexpr size_t O_SRS = O_VS + SZ_KS;
constexpr size_t SZ_SS = (size_t)DEPTH * DEC_BATCH * NG * NP;
constexpr size_t O_SIS = O_SRS + SZ_SS;
constexpr size_t O_LS = O_SIS + SZ_SS;
constexpr size_t SZ_LS = (size_t)DEPTH * DEC_BATCH * 512;
constexpr size_t O_CS = O_LS + SZ_LS;
constexpr size_t SZ_CS = (size_t)DEPTH * DEC_BATCH * 3 * 512;
constexpr size_t O_END = O_CS + SZ_CS;

constexpr size_t WS_PROJ = 0;
constexpr size_t WS_XB = WS_PROJ + (size_t)M_TOT * IN_COLS * 2;
constexpr size_t WS_WOUT = WS_XB + (size_t)M_TOT * D_MODEL * 2;
constexpr size_t WS_TAB = WS_WOUT + (size_t)DEPTH * 1024 * 1024 * 2;
constexpr size_t TAB_AB = 0;
constexpr size_t TAB_BB = TAB_AB + (size_t)DEPTH * NG * NP * 2 * 4;
constexpr size_t TAB_BYTES = TAB_BB + (size_t)DEPTH * NG * NP * NC * 2 * 4;
constexpr size_t WS_S5POW = WS_TAB + TAB_BYTES;
constexpr size_t WS_S5PINV = WS_S5POW + (size_t)DEPTH * NG * 11 * NP * 8;
constexpr size_t WS_S5BCAT = WS_S5PINV + (size_t)DEPTH * NG * 9 * NP * 8;
constexpr size_t WS_S5CCAT = WS_S5BCAT + (size_t)DEPTH * NG * 128 * NC * 2;
constexpr size_t WS_S5SUM = WS_S5CCAT + (size_t)DEPTH * NG * 128 * NC * 2;
constexpr size_t WS_LRUW = WS_S5SUM + (size_t)BATCH * 8 * NG * NP * 8;
constexpr size_t WS_LRSUM = WS_LRUW + (size_t)DEPTH * 8 * 2 * 64 * 64 * 2;
constexpr size_t WS_END = WS_LRSUM + (size_t)BATCH * 32 * 512 * 8;
constexpr size_t DO_WIN = 0;
constexpr size_t DO_WBR = DO_WIN + (size_t)DEPTH * IN_COLS * 1024 * 2;
constexpr size_t DO_WGLU = DO_WBR + (size_t)DEPTH * 3 * 1024 * 512 * 2;
constexpr size_t DO_LRUW = DO_WGLU + (size_t)DEPTH * 512 * 512 * 2;
constexpr size_t DO_END = DO_LRUW;
static_assert(DO_END <= (size_t)M_P * D_MODEL * 4, "weights fit in y_prompt region");
static_assert(WS_END <= 268435456ull, "workspace fits 256 MiB");

__constant__ unsigned char T5_BUCKET[128] = {0, 1, 2, 3, 4, 5, 6, 7, 8, 9, 10, 11, 12, 13, 14, 15, 16, 16, 16, 17, 17, 18, 18, 18, 19, 19, 19, 20, 20, 20, 20, 21, 21, 21, 21, 22, 22, 22, 22, 22, 23, 23, 23, 23, 23, 23, 24, 24, 24, 24, 24, 24, 25, 25, 25, 25, 25, 25, 25, 26, 26, 26, 26, 26, 26, 26, 26, 27, 27, 27, 27, 27, 27, 27, 27, 27, 27, 28, 28, 28, 28, 28, 28, 28, 28, 28, 28, 29, 29, 29, 29, 29, 29, 29, 29, 29, 29, 29, 29, 30, 30, 30, 30, 30, 30, 30, 30, 30, 30, 30, 30, 30, 30, 31, 31, 31, 31, 31, 31, 31, 31, 31, 31, 31, 31, 31, 31, 31};

__device__ __forceinline__ float bf2f(bf16_t v) { return __uint_as_float(((unsigned)v) << 16); }
__device__ __forceinline__ bf16_t f2bf(float f) { unsigned u = __float_as_uint(f); return (bf16_t)((u + 0x7fffu + ((u >> 16) & 1u)) >> 16); }
__device__ __forceinline__ float sigmoidf_(float x) { return 1.0f / (1.0f + __expf(-x)); }
__device__ __forceinline__ float siluf_(float x) { return x * sigmoidf_(x); }
__device__ __forceinline__ float gelu_tanh(float y) { const float t = tanhf(0.7978845608028654f * (y + 0.044715f * y * y * y)); return 0.5f * y * (1.0f + t); }

typedef unsigned u32x4 __attribute__((ext_vector_type(4)));
typedef float f32x2_t __attribute__((ext_vector_type(2)));
typedef __bf16 bf16x2_t __attribute__((ext_vector_type(2)));
__device__ __forceinline__ unsigned cvtpk(float lo, float hi) { f32x2_t v = {lo, hi}; bf16x2_t b = __builtin_convertvector(v, bf16x2_t); return __builtin_bit_cast(unsigned, b); }

struct P {
    const float* in[33];
    float* out;
    unsigned char* ws;
};

typedef const P __attribute__((address_space(4)))* KP;
__device__ __forceinline__ KP get_kp() { KP k = (KP)__builtin_amdgcn_kernarg_segment_ptr(); asm volatile("" : "+s"(k)); return k; }

constexpr size_t WS_CTL = (WS_END + 4095) & ~(size_t)4095;
constexpr size_t CTL_BYTES = 65536;
static_assert(WS_CTL + CTL_BYTES <= 268435456ull, "workspace fits 256 MiB");
constexpr int NTHREADS = 512, NWAVES = 8;
constexpr int LDS_BYTES = 147456;
constexpr int LDS_MISC = 135168;

#define LAS __attribute__((address_space(3)))
#define XB_TMO      128
#define XB_XCNT(j)  (256  + 64 * (j))
#define XB_XSUB(j)  (1280 + 64 * (j))
#define XB_XGEN(j)  (2304 + 64 * (j))
#define XB_TOP      3328
#define XB_TOPGEN   3392
#define XCD_BAR_WORDS 3456
#define XB_SPIN_CAP (1u << 18)
__device__ __forceinline__ unsigned xb_ld(unsigned* p)              { return __hip_atomic_load(p, __ATOMIC_RELAXED, __HIP_MEMORY_SCOPE_AGENT); }
__device__ __forceinline__ unsigned xb_add(unsigned* p, unsigned v) { return __hip_atomic_fetch_add(p, v, __ATOMIC_RELAXED, __HIP_MEMORY_SCOPE_AGENT); }
__device__ __forceinline__ unsigned xb_xcc_id() { return (unsigned)__builtin_amdgcn_s_getreg((3 << 11) | 20) & 0xFu; }
#define XB_SPIN(cond, bar) do { unsigned _sp = 0; while (cond) { __builtin_amdgcn_s_sleep(1); \
    if ((++_sp & 255u) == 0u) { if (xb_ld(&(bar)[XB_TMO])) break; if (_sp > XB_SPIN_CAP) { atomicAdd(&(bar)[XB_TMO], 1u); break; } } } } while (0)
struct XcdBarrier { unsigned* bar; unsigned x; volatile LAS unsigned* st; };
__device__ __forceinline__ XcdBarrier xcd_barrier_post(unsigned* bar, volatile LAS unsigned* st) {
    XcdBarrier b; b.bar = bar; b.x = xb_xcc_id(); b.st = st;
    if (threadIdx.x == 0) (void)xb_add(&bar[XB_XCNT(b.x)], 1u);
    return b;
}
__device__ __forceinline__ void xcd_barrier_complete(unsigned* bar, unsigned x, unsigned& nloc, unsigned& nx) {
    const unsigned G = gridDim.x * gridDim.y * gridDim.z;
    unsigned sum, cnt, mine, sp = 0u;
    for (;;) {
        sum = 0u; cnt = 0u; mine = 0u;
#pragma unroll
        for (unsigned j = 0; j < 16; ++j) { const unsigned c = xb_ld(&bar[XB_XCNT(j)]); sum += c; cnt += (c > 0u) ? 1u : 0u; mine = (j == x) ? c : mine; }
        if (sum == G) break;
        __builtin_amdgcn_s_sleep(1);
        if ((++sp & 255u) == 0u) { if (xb_ld(&bar[XB_TMO])) break; if (sp > XB_SPIN_CAP) { atomicAdd(&bar[XB_TMO], 1u); break; } }
    }
    nloc = mine > 0u ? mine : 1u; nx = cnt > 0u ? cnt : 1u;
}
__device__ __forceinline__ void xcd_barrier(const XcdBarrier& b) {
    asm volatile("s_waitcnt vmcnt(0)" ::: "memory");
    __syncthreads();
    if (threadIdx.x == 0) {
        unsigned* bar = b.bar; asm volatile("" : "+s"(bar));
        unsigned bx = b.x; asm volatile("" : "+s"(bx));
        __builtin_amdgcn_s_waitcnt(0);
        unsigned nloc = b.st[0], nx = b.st[1];
        if (nloc == 0u) { xcd_barrier_complete(bar, bx, nloc, nx); b.st[0] = nloc; b.st[1] = nx; }
        const unsigned old = xb_add(&bar[XB_XSUB(bx)], 1u);
        const unsigned gen = old / nloc;
        if (old + 1u == (gen + 1u) * nloc) {
            __builtin_amdgcn_fence(__ATOMIC_RELEASE, "agent");
            asm volatile("s_waitcnt vmcnt(0)" ::: "memory");
            const unsigned og = xb_add(&bar[XB_TOP], 1u);
            const unsigned tg = og / nx;
            if (og + 1u == (tg + 1u) * nx) xb_add(&bar[XB_TOPGEN], 1u);
            else XB_SPIN(xb_ld(&bar[XB_TOPGEN]) == tg, bar);
            __builtin_amdgcn_fence(__ATOMIC_ACQUIRE, "agent");
            xb_add(&bar[XB_XGEN(bx)], 1u);
            asm volatile("s_waitcnt vmcnt(0)" ::: "memory");
        } else {
            XB_SPIN(xb_ld(&bar[XB_XGEN(bx)]) == gen, bar);
            __builtin_amdgcn_fence(__ATOMIC_ACQUIRE, "agent");
            asm volatile("s_waitcnt vmcnt(0)" ::: "memory");
        }
    }
    __syncthreads();
}

namespace pg8 {
#define PG8_LAS __attribute__((address_space(3)))
typedef unsigned short bf16_t;
typedef short bf16x8 __attribute__((ext_vector_type(8)));
typedef float f32x4 __attribute__((ext_vector_type(4)));
typedef unsigned u32x4 __attribute__((ext_vector_type(4)));
constexpr int BM = 256, BK = 64, HALF = 128, HTB = HALF * BK * 2  , STAGE_BYTES = 8 * HTB, NXCD = 8, WGM = 8;

__host__ __device__ __forceinline__ int lds_byte(int r, int c) { const int st = (r >> 4) * 2 + (c >> 5), rr = r & 15, cc = c & 31, ob = rr * 64 + cc * 2; return st * 1024 + (ob ^ (((ob >> 9) & 1) << 5)); }
__host__ __device__ __forceinline__ void stage_rc(int b, int& R, int& C) { const int st = b / 1024, sb = b % 1024, swz = sb ^ (((sb >> 9) & 1) << 5); R = (st >> 1) * 16 + swz / 64; C = (st & 1) * 32 + (swz % 64) / 2; }
__host__ __device__ __forceinline__ int perm32(int rho) { const int n = rho >> 4, i = rho & 15; return 8 * (i >> 2) + 4 * n + (i & 3); }

struct Unit { int pm, pn, z; };
struct Gemm { const bf16_t* A; int lda; const bf16_t* Bt; int K; };

struct StaticOrder {
    int nM, nN, nwg, G, c;
    __host__ __device__ void init(int M, int N, int G_, int c_) { nM = M / BM; nN = N / BM; nwg = nM * nN; G = G_; c = c_; }
    __host__ __device__ bool next(int i, Unit& u) const {
        const long L = (long)i * G + c; if (L >= nwg) return false;
        int wgid = (int)L; { const int q = nwg / NXCD, r = nwg % NXCD, xcd = wgid % NXCD, off = wgid / NXCD; wgid = (xcd < r ? xcd * (q + 1) : r * (q + 1) + (xcd - r) * q) + off; }
        const int nig = WGM * nN, gid = wgid / nig, fm = gid * WGM, gsz = (nM - fm) < WGM ? (nM - fm) : WGM;
        u.pm = fm + ((wgid % nig) % gsz); u.pn = (wgid % nig) / gsz; u.z = 0; return true;
    }
    __device__ __forceinline__ size_t a_off(const Unit&) const { return 0; }
    __device__ __forceinline__ size_t b_off(const Unit&) const { return 0; }
    __device__ __forceinline__ void a_ready(const Unit&) const {}
    __device__ __forceinline__ void done(const Unit&) const {}
};

__device__ __forceinline__ unsigned cvt_pk_bf16(float lo, float hi) { unsigned r; asm volatile("v_cvt_pk_bf16_f32 %0, %1, %2" : "=v"(r) : "v"(lo), "v"(hi)); return r; }
typedef float f32x2 __attribute__((ext_vector_type(2)));
__device__ __forceinline__ f32x2 gelu_pk(f32x2 v) {
    const f32x2 av = __builtin_elementwise_abs(v), d = av * 0.2316418882f + 1.0f;
    f32x2 t; t.x = __builtin_amdgcn_rcpf(d.x); t.y = __builtin_amdgcn_rcpf(d.y);
    f32x2 q = t * 0.5307027145f + (-0.7265760135f); q = q * t + 0.7107068705f; q = q * t + (-0.142248368f); q = q * t + 0.127414796f; q = q * t;
    const f32x2 s = (v * v) * (-0.72134752044f);
    f32x2 e; e.x = __builtin_amdgcn_exp2f(s.x); e.y = __builtin_amdgcn_exp2f(s.y);
    const f32x2 m = v * (q * e), r = v - m;
    f32x2 o; o.x = v.x < 0.f ? m.x : r.x; o.y = v.y < 0.f ? m.y : r.y; return o;
}

template <class Epi, class Sched, bool ALIGN_EPI = false, bool SP2 = false>
__device__ __forceinline__ void gemm_phase(PG8_LAS unsigned char* lds, const Gemm g, const Sched& S, const Epi& E) {
    int zv_ = 0; asm volatile("" : "+v"(zv_));
    const int tid = (int)threadIdx.x + zv_, wid = __builtin_amdgcn_readfirstlane(tid >> 6), lane = tid & 63, wr = wid >> 2, wc = wid & 3, fr = lane & 15, fq = lane >> 4;
    const int K = g.K, nt = K / BK;
    unsigned voffA[2], voffB[2];
#pragma unroll
    for (int i = 0; i < 2; ++i) { int R, C; stage_rc(tid * 16 + i * 8192, R, C); const int Rb = Epi::PERM ? ((R & ~31) + perm32(R & 31)) : R;
        voffA[i] = (unsigned)(R * g.lda + C) * 2u; voffB[i] = (unsigned)(Rb * K + C) * 2u; }
    const size_t kstep = (size_t)(BK * 2);
    const size_t hstepA = (size_t)HALF * g.lda * 2, hstepB = (size_t)HALF * K * 2;
    const size_t tstepA = 2 * hstepA, tstepB = 2 * hstepB;
    const unsigned ldsw = (unsigned)wid * 1024u;
    const int aoff = lds_byte(wr * 64 + fr, fq * 8), boff = lds_byte(wc * 32 + fr, fq * 8);
#define PG8_SA(b, h) (((b) * 2 + (h)) * HTB)
#define PG8_SB(b, h) ((4 + (b) * 2 + (h)) * HTB)
#define PG8_STAGE(bufoff, gbase, voff) do { _Pragma("unroll") for (int _i = 0; _i < 2; ++_i) \
        __builtin_amdgcn_global_load_lds((const unsigned*)((const char*)(gbase) + (voff)[_i]), (PG8_LAS unsigned*)(lds + (bufoff) + ldsw + _i * 8192), 16, 0, 0); } while (0)
#define PG8_LDA(dst, b, h) do { _Pragma("unroll") for (int m = 0; m < 4; ++m) _Pragma("unroll") for (int k = 0; k < 2; ++k) dst[m][k] = *(const PG8_LAS bf16x8*)(lds + PG8_SA(b, h) + aoff + m * 2048 + k * 1024); } while (0)
#define PG8_LDB(dst, b, h) do { _Pragma("unroll") for (int n = 0; n < 2; ++n) _Pragma("unroll") for (int k = 0; k < 2; ++k) dst[n][k] = *(const PG8_LAS bf16x8*)(lds + PG8_SB(b, h) + boff + n * 2048 + k * 1024); } while (0)
#define PG8_MMA(ai, bj, At, Bt) do { __builtin_amdgcn_s_setprio(1); _Pragma("unroll") for (int m = 0; m < 4; ++m) _Pragma("unroll") for (int n = 0; n < 2; ++n) _Pragma("unroll") for (int k = 0; k < 2; ++k) \
        acc[ai][bj][m][n] = __builtin_amdgcn_mfma_f32_16x16x32_bf16(Bt[n][k], At[m][k], acc[ai][bj][m][n], 0, 0, 0); __builtin_amdgcn_s_setprio(0); } while (0)
#define PG8_WAIT_V(n) asm volatile("s_waitcnt vmcnt(" #n ")" ::: "memory")
#define PG8_WAIT_L(n) asm volatile("s_waitcnt lgkmcnt(" #n ")" ::: "memory")
#define PG8_BAR __builtin_amdgcn_s_barrier()
#define PG8_SCHED __builtin_amdgcn_sched_barrier(0)
    Unit cur, nxt; int ui = 0;
    if (!S.next(0, cur)) return;
    f32x4 acc[2][2][4][2];
#pragma unroll
    for (int a = 0; a < 2; ++a)
#pragma unroll
        for (int b = 0; b < 2; ++b)
#pragma unroll
            for (int m = 0; m < 4; ++m)
#pragma unroll
                for (int n = 0; n < 2; ++n) acc[a][b][m][n] = (f32x4){0.f, 0.f, 0.f, 0.f};
    bf16x8 At[4][2], B0[2][2], B1[2][2];
    const char* cA = (const char*)g.A + (size_t)cur.pm * tstepA + S.a_off(cur); const char* cB = (const char*)g.Bt + (size_t)cur.pn * tstepB + S.b_off(cur);
    S.a_ready(cur);
    if constexpr (SP2) {
        PG8_STAGE(PG8_SB(0, 0), cB, voffB); PG8_STAGE(PG8_SB(0, 1), cB + hstepB, voffB); PG8_STAGE(PG8_SA(0, 0), cA, voffA); PG8_STAGE(PG8_SA(0, 1), cA + hstepA, voffA);
        if (wr == 1) PG8_BAR;
        PG8_WAIT_V(2); PG8_BAR;
        PG8_STAGE(PG8_SB(1, 0), cB + kstep, voffB); PG8_STAGE(PG8_SA(1, 0), cA + kstep, voffA); PG8_STAGE(PG8_SB(1, 1), cB + hstepB + kstep, voffB);
        PG8_WAIT_V(6); PG8_BAR;
    } else {
        PG8_STAGE(PG8_SB(0, 0), cB, voffB); PG8_STAGE(PG8_SA(0, 0), cA, voffA); PG8_STAGE(PG8_SB(0, 1), cB + hstepB, voffB); PG8_STAGE(PG8_SA(0, 1), cA + hstepA, voffA);
        if (wr == 1) PG8_BAR;
        PG8_WAIT_V(4); PG8_BAR;
        PG8_STAGE(PG8_SB(1, 0), cB + kstep, voffB); PG8_STAGE(PG8_SA(1, 0), cA + kstep, voffA); PG8_STAGE(PG8_SB(1, 1), cB + hstepB + kstep, voffB);
        PG8_WAIT_V(6); PG8_BAR;
    }
    for (;;) {
        const bool has_next = S.next(ui + 1, nxt);
        const char* nA = has_next ? (const char*)g.A + (size_t)nxt.pm * tstepA + S.a_off(nxt) : cA; const char* nB = has_next ? (const char*)g.Bt + (size_t)nxt.pn * tstepB + S.b_off(nxt) : cB;
        for (int t = 0; t < nt; t += 2) {
            const bool last = (t == nt - 2);
            const char* a1 = cA + (size_t)(t + 1) * kstep;
            const char* a2 = last ? nA : cA + (size_t)(t + 2) * kstep; const char* b2 = last ? nB : cB + (size_t)(t + 2) * kstep;
            const char* a3 = a2 + kstep; const char* b3 = b2 + kstep;
            if (last && has_next) S.a_ready(nxt);
            if constexpr (SP2) {
            PG8_LDB(B0, 0, 0); PG8_LDB(B1, 0, 1); PG8_SCHED; PG8_LDA(At, 0, 0); PG8_STAGE(PG8_SA(1, 1), a1 + hstepA, voffA);
            PG8_WAIT_V(8); PG8_WAIT_L(0); PG8_BAR; PG8_MMA(0, 0, At, B0); PG8_MMA(0, 1, At, B1); PG8_BAR; PG8_SCHED;
            PG8_LDA(At, 0, 1); PG8_STAGE(PG8_SB(0, 0), b2, voffB); PG8_STAGE(PG8_SB(0, 1), b2 + hstepB, voffB); PG8_STAGE(PG8_SA(0, 0), a2, voffA);
            PG8_WAIT_V(8); PG8_WAIT_L(0); PG8_BAR; PG8_MMA(1, 0, At, B0); PG8_MMA(1, 1, At, B1); PG8_BAR; PG8_SCHED;
            PG8_LDB(B0, 1, 0); PG8_LDB(B1, 1, 1); PG8_SCHED; PG8_LDA(At, 1, 0); PG8_STAGE(PG8_SA(0, 1), a2 + hstepA, voffA);
            PG8_WAIT_V(8); PG8_WAIT_L(0); PG8_BAR; PG8_MMA(0, 0, At, B0); PG8_MMA(0, 1, At, B1); PG8_BAR; PG8_SCHED;
            PG8_LDA(At, 1, 1); PG8_STAGE(PG8_SB(1, 0), b3, voffB); PG8_STAGE(PG8_SB(1, 1), b3 + hstepB, voffB); PG8_STAGE(PG8_SA(1, 0), a3, voffA);
            PG8_WAIT_V(8); PG8_WAIT_L(0); PG8_BAR; PG8_MMA(1, 0, At, B0); PG8_MMA(1, 1, At, B1); PG8_BAR; PG8_SCHED;
            } else {
            PG8_LDB(B0, 0, 0); PG8_SCHED; PG8_LDA(At, 0, 0); PG8_STAGE(PG8_SA(1, 1), a1 + hstepA, voffA);
            PG8_WAIT_L(8); PG8_BAR; PG8_WAIT_L(0); PG8_MMA(0, 0, At, B0); PG8_BAR; PG8_SCHED;
            PG8_LDB(B1, 0, 1); PG8_STAGE(PG8_SB(0, 0), b2, voffB);
            PG8_BAR; PG8_WAIT_L(0); PG8_MMA(0, 1, At, B1); PG8_BAR;
            PG8_LDA(At, 0, 1); PG8_STAGE(PG8_SA(0, 0), a2, voffA);
            PG8_BAR; PG8_WAIT_L(0); PG8_MMA(1, 0, At, B0); PG8_BAR; PG8_SCHED;
            PG8_STAGE(PG8_SB(0, 1), b2 + hstepB, voffB);
            PG8_WAIT_V(6); PG8_BAR; PG8_MMA(1, 1, At, B1); PG8_BAR;
            PG8_LDB(B0, 1, 0); PG8_SCHED; PG8_LDA(At, 1, 0); PG8_STAGE(PG8_SA(0, 1), a2 + hstepA, voffA);
            PG8_WAIT_L(8); PG8_BAR; PG8_WAIT_L(0); PG8_MMA(0, 0, At, B0); PG8_BAR; PG8_SCHED;
            PG8_LDB(B1, 1, 1); PG8_STAGE(PG8_SB(1, 0), b3, voffB);
            PG8_BAR; PG8_WAIT_L(0); PG8_MMA(0, 1, At, B1); PG8_BAR;
            PG8_LDA(At, 1, 1); PG8_STAGE(PG8_SA(1, 0), a3, voffA);
            PG8_BAR; PG8_WAIT_L(0); PG8_MMA(1, 0, At, B0); PG8_BAR; PG8_SCHED;
            PG8_STAGE(PG8_SB(1, 1), b3 + hstepB, voffB);
            PG8_WAIT_V(6); PG8_BAR; PG8_MMA(1, 1, At, B1); PG8_BAR;
            }
        }
        if constexpr (ALIGN_EPI) { if (wr == 0) PG8_BAR; }
        if constexpr (!Epi::AFTER_DRAIN) { E(acc, cur, wr, wc, fr, fq); S.done(cur); }
        if (!has_next) break;
#pragma unroll
        for (int a = 0; a < 2; ++a)
#pragma unroll
            for (int b = 0; b < 2; ++b)
#pragma unroll
                for (int m = 0; m < 4; ++m)
#pragma unroll
                    for (int n = 0; n < 2; ++n) acc[a][b][m][n] = (f32x4){0.f, 0.f, 0.f, 0.f};
        cur = nxt; cA = nA; cB = nB; ++ui;
        if constexpr (ALIGN_EPI) { if (wr == 1) PG8_BAR; }
    }
    PG8_WAIT_V(0);
    if constexpr (!ALIGN_EPI) { if (wr == 0) PG8_BAR; }
    PG8_BAR;
    if constexpr (Epi::AFTER_DRAIN) { E.fused(acc, cur, wr, wc, fr, fq, lds, wid, lane); S.done(cur); }
#undef PG8_SA
#undef PG8_SB
#undef PG8_STAGE
#undef PG8_LDA
#undef PG8_LDB
#undef PG8_MMA
#undef PG8_WAIT_V
#undef PG8_WAIT_L
#undef PG8_BAR
#undef PG8_SCHED
}
}

namespace pg8 {
typedef unsigned u32x2 __attribute__((ext_vector_type(2)));
__device__ __forceinline__ float bflo(unsigned w) { return __uint_as_float(w << 16); }
__device__ __forceinline__ float bfhi(unsigned w) { return __uint_as_float(w & 0xffff0000u); }
__device__ __forceinline__ float sigm(float x) { return __builtin_amdgcn_rcpf(1.0f + __expf(-x)); }
struct EpiProjB {
    static constexpr bool PERM = true, AFTER_DRAIN = false;
    bf16_t* O; int ldc;
    __device__ __forceinline__ void operator()(const f32x4 (&acc)[2][2][4][2], const Unit& u, int wr, int wc, int fr, int fq) const {
        const int row0 = u.pm * BM + wr * 64 + fr, col0 = u.pn * BM + wc * 32 + 8 * fq;
#pragma unroll
        for (int ai = 0; ai < 2; ++ai)
#pragma unroll
            for (int m = 0; m < 4; ++m) { bf16_t* rowp = O + (size_t)(row0 + ai * HALF + m * 16) * ldc + col0;
#pragma unroll
                for (int bj = 0; bj < 2; ++bj) { const f32x4 v0 = acc[ai][bj][m][0], v1 = acc[ai][bj][m][1];
                    u32x4 w; w.x = cvt_pk_bf16(v0[0], v0[1]); w.y = cvt_pk_bf16(v0[2], v0[3]); w.z = cvt_pk_bf16(v1[0], v1[1]); w.w = cvt_pk_bf16(v1[2], v1[3]);
                    *(u32x4*)(rowp + bj * HALF) = w; } }
    }
};
struct EpiGluB {
    static constexpr bool PERM = true, AFTER_DRAIN = false;
    bf16_t* PROJ; bool dry;
    __device__ __forceinline__ void operator()(const f32x4 (&acc)[2][2][4][2], const Unit& u, int wr, int wc, int fr, int fq) const {
        const int row0 = u.pm * BM + wr * 64 + fr, col0 = u.pn * BM + wc * 32 + 8 * fq;
#pragma unroll
        for (int ai = 0; ai < 2; ++ai)
#pragma unroll
            for (int m = 0; m < 4; ++m) { bf16_t* rowp = PROJ + (size_t)(row0 + ai * HALF + m * 16) * IN_COLS + col0;
#pragma unroll
                for (int bj = 0; bj < 2; ++bj) {
                    const u32x4 zz = *(const u32x4*)(rowp + C_UB + bj * HALF), gg = *(const u32x4*)(rowp + C_GB + bj * HALF);
                    const f32x4 v0 = acc[ai][bj][m][0], v1 = acc[ai][bj][m][1];
                    float o[8];
#pragma unroll
                    for (int e = 0; e < 4; ++e) {
                        const float va = e < 2 ? v0[2 * e] : v1[2 * (e - 2)], vb = e < 2 ? v0[2 * e + 1] : v1[2 * (e - 2) + 1];
                        const float za = bflo(zz[e]), zb = bfhi(zz[e]), ga = bflo(gg[e]), gb = bfhi(gg[e]);
                        o[2 * e] = za * sigm(va) * ga * sigm(ga); o[2 * e + 1] = zb * sigm(vb) * gb * sigm(gb);
                    }
                    u32x4 w; w.x = cvt_pk_bf16(o[0], o[1]); w.y = cvt_pk_bf16(o[2], o[3]); w.z = cvt_pk_bf16(o[4], o[5]); w.w = cvt_pk_bf16(o[6], o[7]);
                    if (!dry) *(u32x4*)(rowp + C_GB + bj * HALF) = w; } }
    }
};
struct EpiBranchB {
    static constexpr bool PERM = true, AFTER_DRAIN = false;
    bf16_t* PROJ; bool dry;
    __device__ __forceinline__ void operator()(const f32x4 (&acc)[2][2][4][2], const Unit& u, int wr, int wc, int fr, int fq) const {
        const int row0 = u.pm * BM + wr * 64 + fr, col0 = u.pn * BM + wc * 32 + 8 * fq;
        const int z = u.z;
#pragma unroll
        for (int ai = 0; ai < 2; ++ai)
#pragma unroll
            for (int m = 0; m < 4; ++m) { bf16_t* rowp = PROJ + (size_t)(row0 + ai * HALF + m * 16) * IN_COLS + C_GM + col0;
#pragma unroll
                for (int bj = 0; bj < 2; ++bj) {
                    const u32x4 gg = *(const u32x4*)(rowp + z * 1024 + bj * HALF);
                    u32x4 pp = (u32x4){0u, 0u, 0u, 0u};
                    if (z > 0) pp = *(const u32x4*)(rowp + bj * HALF);
                    const f32x4 v0 = acc[ai][bj][m][0], v1 = acc[ai][bj][m][1];
                    float o[8];
#pragma unroll
                    for (int e = 0; e < 4; ++e) {
                        const float va = e < 2 ? v0[2 * e] : v1[2 * (e - 2)], vb = e < 2 ? v0[2 * e + 1] : v1[2 * (e - 2) + 1];
                        o[2 * e] = bflo(pp[e]) + sigm(bflo(gg[e])) * va; o[2 * e + 1] = bfhi(pp[e]) + sigm(bfhi(gg[e])) * vb;
                    }
                    u32x4 w; w.x = cvt_pk_bf16(o[0], o[1]); w.y = cvt_pk_bf16(o[2], o[3]); w.z = cvt_pk_bf16(o[4], o[5]); w.w = cvt_pk_bf16(o[6], o[7]);
                    if (!dry) *(u32x4*)(rowp + bj * HALF) = w; } }
    }
};
struct BranchOrder : StaticOrder {
    __device__ bool next(int i, Unit& u) const { if (!StaticOrder::next(i / 3, u)) return false; u.z = i % 3; return true; }
    __device__ __forceinline__ size_t a_off(const Unit& u) const { return (size_t)(u.z == 0 ? C_Q : (u.z == 1 ? C_GB : C_GC)) * 2; }
    __device__ __forceinline__ size_t b_off(const Unit& u) const { return (size_t)u.z * 1024 * 512 * 2; }
};
struct EpiOutB {
    static constexpr bool PERM = false, AFTER_DRAIN = false;
    const float* xp; const float* xs; const bf16_t* XB; unsigned char* ws; int l;
    __device__ __forceinline__ void operator()(const f32x4 (&acc)[2][2][4][2], const Unit& u, int wr, int wc, int fr, int fq) const {
        const int row0 = u.pm * BM + wr * 64 + fr, col0 = u.pn * BM + wc * 32 + 4 * fq;
#pragma unroll
        for (int ai = 0; ai < 2; ++ai)
#pragma unroll
            for (int m = 0; m < 4; ++m) { const int r = row0 + ai * HALF + m * 16;
                float* prow = (float*)(ws + WS_PROJ + (size_t)r * IN_COLS * 2 + (size_t)(C_GM + 1024) * 2) + col0;
#pragma unroll
                for (int bj = 0; bj < 2; ++bj)
#pragma unroll
                    for (int n = 0; n < 2; ++n) {
                        const int co = bj * HALF + n * 16;
                        f32x4 x;
                        if (l == 0) x = r < M_P ? *(const f32x4*)(xp + (size_t)r * D_MODEL + col0 + co) : *(const f32x4*)(xs + (size_t)(r - M_P) * D_MODEL + col0 + co);
                        else { const u32x2 xx = *(const u32x2*)(XB + (size_t)r * D_MODEL + col0 + co); x = (f32x4){bflo(xx.x), bfhi(xx.x), bflo(xx.y), bfhi(xx.y)}; }
                        *(f32x4*)(prow + co) = x * DN_ALPHA + acc[ai][bj][m][n];
                    } }
    }
};
}

struct Ctx { int tid, lane, wave, gw, ngw; size_t gt, ngt; };
__device__ __forceinline__ Ctx make_ctx() {
    int zv = 0; asm volatile("" : "+v"(zv)); int zs = 0; asm volatile("" : "+s"(zs));
    Ctx c; c.tid = (int)threadIdx.x + zv; c.lane = c.tid & 63; c.wave = __builtin_amdgcn_readfirstlane(c.tid >> 6);
    const int bid = (int)blockIdx.x + zs, nb = (int)gridDim.x + zs;
    c.gw = c.wave * nb + bid; c.ngw = nb * NWAVES; c.gt = (size_t)bid * NTHREADS + c.tid; c.ngt = (size_t)nb * NTHREADS; return c;
}
#define WAVE_LDS_SYNC() do { asm volatile("s_waitcnt lgkmcnt(0)" ::: "memory"); __builtin_amdgcn_wave_barrier(); } while (0)

__device__ __forceinline__ void st_convert_x(KP p, const Ctx& c) {
    u32x4* XB = (u32x4*)(p->ws + WS_XB);
    const size_t n8 = (size_t)M_TOT * D_MODEL / 8, np8 = (size_t)M_P * D_MODEL / 8;
    for (size_t i = c.gt; i < n8; i += c.ngt) {
        const f32x4* src = i < np8 ? (const f32x4*)p->in[0] + 2 * i : (const f32x4*)p->in[1] + 2 * (i - np8);
        const f32x4 a = src[0], b = src[1];
        u32x4 o; o.x = cvtpk(a[0], a[1]); o.y = cvtpk(a[2], a[3]); o.z = cvtpk(b[0], b[1]); o.w = cvtpk(b[2], b[3]);
        XB[i] = o;
    }
}
__device__ __forceinline__ void st_transpose_w(const float* W, bf16_t* WT, int K, int N, const Ctx& c) {
    const size_t n = (size_t)K * N;
    for (size_t i = c.gt; i < n; i += c.ngt) { const int nn = (int)(i / K), kk = (int)(i % K); WT[i] = f2bf(W[(size_t)kk * N + nn]); }
}

__device__ __forceinline__ unsigned pk2bf(float lo, float hi) { return (unsigned)f2bf(lo) | ((unsigned)f2bf(hi) << 16); }
__device__ __forceinline__ void p0_transpose_item(const float* W, int K, int N, bf16_t* WT, LAS float* scr, int item, int lane) {
    const int nblk = N / 32, kb = item / nblk, nb = item % nblk, k0 = 64 * kb, n0 = 32 * nb;
#pragma unroll 8
    for (int i = 0; i < 32; ++i) { const int kk = 2 * i + (lane >> 5); scr[kk * 33 + (lane & 31)] = W[(size_t)(k0 + kk) * N + n0 + (lane & 31)]; }
    WAVE_LDS_SYNC();
    const int cch = lane & 7;
#pragma unroll
    for (int j = 0; j < 4; ++j) { const int n = (lane >> 3) + 8 * j; const LAS float* sp = scr + (8 * cch) * 33 + n;
        u32x4 o; o.x = pk2bf(sp[0 * 33], sp[1 * 33]); o.y = pk2bf(sp[2 * 33], sp[3 * 33]); o.z = pk2bf(sp[4 * 33], sp[5 * 33]); o.w = pk2bf(sp[6 * 33], sp[7 * 33]);
        *(u32x4*)(WT + (size_t)(n0 + n) * K + k0 + 8 * cch) = o; }
    WAVE_LDS_SYNC();
}
__device__ __forceinline__ void st_prologue_weights(KP p, const Ctx& c, LAS float* scr) {
    unsigned char* dob = (unsigned char*)p->out;
    constexpr int I_IN = 16 * 200, I_BR = 8 * 32, I_GLU = 8 * 16, I_OUT = 16 * 32, I_LAYER = I_IN + 3 * I_BR + I_GLU + I_OUT;
    for (int it = c.gw; it < DEPTH * I_LAYER; it += c.ngw) {
        const int l = it / I_LAYER; int r = it % I_LAYER;
        if (r < I_IN) { p0_transpose_item(p->in[9] + (size_t)l * 1024 * IN_COLS, 1024, IN_COLS, (bf16_t*)(dob + DO_WIN) + (size_t)l * IN_COLS * 1024, scr, r, c.lane); continue; } r -= I_IN;
        if (r < I_BR) { p0_transpose_item(p->in[11] + (size_t)l * 512 * 1024, 512, 1024, (bf16_t*)(dob + DO_WBR) + ((size_t)l * 3 + 0) * 1024 * 512, scr, r, c.lane); continue; } r -= I_BR;
        if (r < I_BR) { p0_transpose_item(p->in[21] + (size_t)l * 512 * 1024, 512, 1024, (bf16_t*)(dob + DO_WBR) + ((size_t)l * 3 + 1) * 1024 * 512, scr, r, c.lane); continue; } r -= I_BR;
        if (r < I_BR) { p0_transpose_item(p->in[29] + (size_t)l * 512 * 1024, 512, 1024, (bf16_t*)(dob + DO_WBR) + ((size_t)l * 3 + 2) * 1024 * 512, scr, r, c.lane); continue; } r -= I_BR;
        if (r < I_GLU) { p0_transpose_item(p->in[20] + (size_t)l * 512 * 512, 512, 512, (bf16_t*)(dob + DO_WGLU) + (size_t)l * 512 * 512, scr, r, c.lane); continue; } r -= I_GLU;
        p0_transpose_item(p->in[30] + (size_t)l * 1024 * 1024, 1024, 1024, (bf16_t*)(p->ws + WS_WOUT) + (size_t)l * 1024 * 1024, scr, r, c.lane);
    }
}
__device__ __forceinline__ void st_s5_tables(KP p, const Ctx& c) {
    float* AB = (float*)(p->ws + WS_TAB + TAB_AB);
    float* BB = (float*)(p->ws + WS_TAB + TAB_BB);
    for (size_t ii = c.gt; ii < (size_t)DEPTH * NG * NP; ii += c.ngt) {
        const int i = (int)ii, l = i / (NG * NP), g = (i / NP) % NG;
        const float lr = fminf(p->in[12][i], -1e-4f), li = p->in[13][i];
        const float step = expf(p->in[14][l * NG + g]);
        const float mag = expf(lr * step);
        float sn, cs; sincosf(li * step, &sn, &cs);
        const float ab_re = mag * cs, ab_im = mag * sn;
        const float den = lr * lr + li * li;
        const float f_re = ((ab_re - 1.0f) * lr + ab_im * li) / den;
        const float f_im = (ab_im * lr - (ab_re - 1.0f) * li) / den;
        AB[2 * i] = ab_re; AB[2 * i + 1] = ab_im;
        for (int cc = 0; cc < NC; ++cc) {
            const float bre = p->in[15][(size_t)i * NC + cc], bim = p->in[16][(size_t)i * NC + cc];
            BB[((size_t)i * NC + cc) * 2] = f_re * bre - f_im * bim;
            BB[((size_t)i * NC + cc) * 2 + 1] = f_re * bim + f_im * bre;
        }
    }
}

template <class Epi>
__device__ __forceinline__ void gemm_simple(const bf16_t* A, int lda, const bf16_t* Bt, int ldb, int M, int N, int K, Epi epi, const Ctx& c) {
    const int lane = c.lane;
    const int ntn = N / 32, ntiles = (M / 32) * ntn;
    for (int tile = c.gw; tile < ntiles; tile += c.ngw) {
        const int tm = tile / ntn, tn = tile % ntn;
        f32x16 acc = {};
        const bf16_t* ar = A + (size_t)(tm * 32 + (lane & 31)) * lda + 8 * (lane >> 5);
        const bf16_t* br = Bt + (size_t)(tn * 32 + (lane & 31)) * ldb + 8 * (lane >> 5);
        for (int k0 = 0; k0 < K; k0 += 16) {
            const bf16x8 a = *(const bf16x8*)(ar + k0);
            const bf16x8 b = *(const bf16x8*)(br + k0);
            acc = __builtin_amdgcn_mfma_f32_32x32x16_bf16(a, b, acc, 0, 0, 0);
        }
#pragma unroll
        for (int r = 0; r < 16; ++r) {
            const int row = tm * 32 + (r & 3) + 8 * (r >> 2) + 4 * (lane >> 5), col = tn * 32 + (lane & 31);
            epi(row, col, acc[r]);
        }
    }
}
struct EpiProj { bf16_t* PROJ; __device__ void operator()(int r, int c, float v) const { PROJ[(size_t)r * IN_COLS + c] = f2bf(v); } };

__device__ __forceinline__ void st_kv_out(KP p, int l, const Ctx& c) {
    const bf16_t* PROJ = (const bf16_t*)(p->ws + WS_PROJ);
    for (size_t ii = c.gt; ii < (size_t)BATCH * 3 * 512; ii += c.ngt) {
        const int i = (int)ii, b = i / 1536, j = (i / 512) % 3, ch = i % 512;
        p->out[O_CP + (size_t)l * BATCH * 1536 + i] = bf2f(PROJ[((size_t)b * SEQ + SEQ - 3 + j) * IN_COLS + C_XC + ch]);
    }
    for (size_t ii = c.gt; ii < (size_t)DEC_BATCH * 3 * 512; ii += c.ngt) {
        const int i = (int)ii, b = i / 1536, j = (i / 512) % 3, ch = i % 512;
        p->out[O_CS + (size_t)l * DEC_BATCH * 1536 + i] = bf2f(PROJ[((size_t)M_P + 4 * b + 1 + j) * IN_COLS + C_XC + ch]);
    }
    for (size_t ii = c.gt; ii < (size_t)DEC_BATCH * WINDOW * 128; ii += c.ngt) {
        const int i = (int)ii;
        if (i < BATCH * WINDOW * 128) {
            const int b = i / (WINDOW * 128), w = (i / 128) % WINDOW, cc = i % 128;
            const size_t row = (size_t)b * SEQ + (SEQ - WINDOW) + w;
            p->out[O_KP + (size_t)l * BATCH * WINDOW * 128 + i] = bf2f(PROJ[row * IN_COLS + C_K + cc]);
            p->out[O_VP + (size_t)l * BATCH * WINDOW * 128 + i] = bf2f(PROJ[row * IN_COLS + C_V + cc]);
        }
        {
            const int b = i / (WINDOW * 128), w = (i / 128) % WINDOW, cc = i % 128;
            float kv, vv;
            if (w < WINDOW - DEC_SEQ) {
                const size_t ci = (((size_t)l * DEC_BATCH + b) * WINDOW + (w + DEC_SEQ)) * 128 + cc;
                kv = p->in[2][ci]; vv = p->in[3][ci];
            } else {
                const size_t row = (size_t)M_P + b * DEC_SEQ + (w - (WINDOW - DEC_SEQ));
                kv = bf2f(PROJ[row * IN_COLS + C_K + cc]); vv = bf2f(PROJ[row * IN_COLS + C_V + cc]);
            }
            p->out[O_KS + (size_t)l * DEC_BATCH * WINDOW * 128 + i] = kv;
            p->out[O_VS + (size_t)l * DEC_BATCH * WINDOW * 128 + i] = vv;
        }
    }
}

__device__ __forceinline__ void st_attn_simple(KP p, int l, const Ctx& c, bool dry) {
    bf16_t* PROJ = (bf16_t*)(p->ws + WS_PROJ);
    const int lane = c.lane;
    const float* rel_bias = p->in[8];
    for (int item = c.gw; item < M_S * NQH; item += c.ngw) {
        const int m = M_P + item / NQH, h = item % NQH, kvh = h / 4;
        const bool samp = m >= M_P;
        const int b = samp ? (m - M_P) / DEC_SEQ : m / SEQ, t = samp ? (m - M_P) % DEC_SEQ : m % SEQ;
        float q[64];
        {
            const bf16_t* qp = PROJ + (size_t)m * IN_COLS + C_Q + h * 64;
#pragma unroll
            for (int d = 0; d < 64; ++d) q[d] = bf2f(qp[d]);
        }
        const float sink = p->in[10][l * NQH + h];
        float s[2];
#pragma unroll
        for (int j = 0; j < 2; ++j) {
            const int d = lane + 64 * j;
            const int tk = t - d;
            float sc = -1e30f;
            if (!samp) {
                if (tk >= 0) {
                    const bf16_t* kp = PROJ + ((size_t)b * SEQ + tk) * IN_COLS + C_K + kvh * 64;
                    float a = 0.f;
#pragma unroll
                    for (int e = 0; e < 64; ++e) a += q[e] * bf2f(kp[e]);
                    sc = a * 0.125f + rel_bias[T5_BUCKET[d] * NQH + h];
                }
            } else {
                float a = 0.f;
                if (tk >= 0) {
                    const bf16_t* kp = PROJ + ((size_t)M_P + b * DEC_SEQ + tk) * IN_COLS + C_K + kvh * 64;
#pragma unroll
                    for (int e = 0; e < 64; ++e) a += q[e] * bf2f(kp[e]);
                } else {
                    const float* kp = p->in[2] + ((((size_t)l * DEC_BATCH + b) * WINDOW + (WINDOW + tk)) * NKV + kvh) * HD;
#pragma unroll
                    for (int e = 0; e < 64; ++e) a += q[e] * kp[e];
                }
                sc = a * 0.125f + rel_bias[T5_BUCKET[d] * NQH + h];
            }
            s[j] = sc;
        }
        float mx = fmaxf(fmaxf(s[0], s[1]), sink);
        for (int o = 32; o > 0; o >>= 1) mx = fmaxf(mx, __shfl_xor(mx, o));
        const float p0 = s[0] > -1e29f ? __expf(s[0] - mx) : 0.f, p1 = s[1] > -1e29f ? __expf(s[1] - mx) : 0.f;
        float sum = p0 + p1;
        for (int o = 32; o > 0; o >>= 1) sum += __shfl_xor(sum, o);
        const float denom = sum + __expf(sink - mx);
        float o = 0.f;
        for (int d = 0; d < 128; ++d) {
            const float pj = __shfl(d < 64 ? p0 : p1, d & 63);
            const int tk = t - d;
            float vv = 0.f;
            if (!samp) { if (tk >= 0) vv = bf2f(PROJ[((size_t)b * SEQ + tk) * IN_COLS + C_V + kvh * 64 + lane]); }
            else if (tk >= 0) vv = bf2f(PROJ[((size_t)M_P + b * DEC_SEQ + tk) * IN_COLS + C_V + kvh * 64 + lane]);
            else vv = p->in[3][((((size_t)l * DEC_BATCH + b) * WINDOW + (WINDOW + tk)) * NKV + kvh) * HD + lane];
            o += pj * vv;
        }
        o /= denom;
        const float ga = bf2f(PROJ[(size_t)m * IN_COLS + C_GA + h * 64 + lane]);
        if (!dry) PROJ[(size_t)m * IN_COLS + C_Q + h * 64 + lane] = f2bf(o * siluf_(ga));
    }
}

typedef short s16x4 __attribute__((ext_vector_type(4)));
typedef short v4i16_t __attribute__((ext_vector_type(4)));
__device__ __forceinline__ bf16x8 pack8(float a0, float a1, float a2, float a3, float a4, float a5, float a6, float a7) {
    u32x4 p; p.x = cvtpk(a0, a1); p.y = cvtpk(a2, a3); p.z = cvtpk(a4, a5); p.w = cvtpk(a6, a7); return __builtin_bit_cast(bf16x8, p); }
__device__ __forceinline__ s16x4 tr_read(LAS const unsigned char* p) { return __builtin_bit_cast(s16x4, __builtin_amdgcn_ds_read_tr16_b64_v4i16((LAS v4i16_t*)p)); }
__device__ __forceinline__ bf16x8 cat8(s16x4 lo, s16x4 hi) { return __builtin_shufflevector(lo, hi, 0, 1, 2, 3, 4, 5, 6, 7); }
#define MFMA32(a, b, c) __builtin_amdgcn_mfma_f32_32x32x16_bf16((a), (b), (c), 0, 0, 0)
#define MFMA16(a, b, c) __builtin_amdgcn_mfma_f32_16x16x32_bf16((a), (b), (c), 0, 0, 0)

constexpr int AT_KSTR = 144, AT_VSTR = 192;
constexpr int AT_K = 0, AT_V = AT_K + 256 * AT_KSTR, AT_BIAS = AT_V + 256 * AT_VSTR, AT_WS = AT_BIAS + 4 * 128 * 4, AT_END = AT_WS + 8 * 256;
static_assert(AT_END <= 131072, "attention LDS");

__device__ __forceinline__ void st_attn_prompt(KP p, int l, LAS unsigned char* lds, bool dry) {
    int zv = 0; asm volatile("" : "+v"(zv));
    const int tid = (int)threadIdx.x + zv, lane = tid & 63, wave = __builtin_amdgcn_readfirstlane(tid >> 6);
    const int c31 = lane & 31, h = lane >> 5;
    bf16_t* PROJ = (bf16_t*)(p->ws + WS_PROJ);
    const float* rel_bias = p->in[8];
    for (int item = blockIdx.x; item < BATCH * 16 * NKV; item += gridDim.x) {
        const int b = item / 32, nb = (item >> 1) & 15, kvh = item & 1;
        const size_t rowq0 = (size_t)b * SEQ + (size_t)nb * 128;
#pragma unroll
        for (int i = 0; i < 4; ++i) {
            const int id = tid + 512 * i, row = id >> 3, pc = id & 7;
            u32x4 kk = (u32x4){0u, 0u, 0u, 0u}, vv = kk;
            if (nb > 0 || row >= 128) {
                const bf16_t* src = PROJ + (rowq0 - 128 + row) * IN_COLS + kvh * 64 + pc * 8;
                kk = *(const u32x4*)(src + C_K); vv = *(const u32x4*)(src + C_V);
            }
            *(LAS u32x4*)(lds + AT_K + row * AT_KSTR + pc * 16) = kk;
            *(LAS u32x4*)(lds + AT_V + row * AT_VSTR + pc * 16) = vv;
        }
        { const int g = tid >> 7, d = tid & 127; ((LAS float*)(lds + AT_BIAS))[tid] = rel_bias[T5_BUCKET[d] * NQH + kvh * 4 + g]; }
        __syncthreads();
        const int g = wave >> 1, hq = kvh * 4 + g;
        const float sink = p->in[10][l * NQH + hq];
        LAS const float* biasd = (LAS const float*)(lds + AT_BIAS) + g * 128;
        LAS float* wsf = (LAS float*)(lds + AT_WS + wave * 256);
#pragma unroll 1
        for (int qi = 0; qi < 2; ++qi) {
            const int qt = 2 * (wave & 1) + qi, q0 = 32 * qt;
            bf16x8 qf[4];
            { const bf16_t* qp = PROJ + (rowq0 + q0 + c31) * IN_COLS + C_Q + hq * 64 + 8 * h;
#pragma unroll
              for (int ks = 0; ks < 4; ++ks) qf[ks] = *(const bf16x8*)(qp + 16 * ks); }
            f32x16 S[5];
#pragma unroll
            for (int j = 0; j < 5; ++j) {
                S[j] = (f32x16){};
                LAS const unsigned char* kp = lds + AT_K + (32 * (qt + j) + c31) * AT_KSTR + 16 * h;
#pragma unroll
                for (int ks = 0; ks < 4; ++ks) S[j] = MFMA32(*(LAS const bf16x8*)(kp + 32 * ks), qf[ks], S[j]);
            }
            const int iq = q0 + c31;
            float mx = sink;
#pragma unroll
            for (int j = 0; j < 5; ++j)
#pragma unroll
                for (int r = 0; r < 16; ++r) {
                    const int kv = 32 * (qt + j) + (r & 3) + 8 * (r >> 2) + 4 * h;
                    const int dist = iq + 128 - kv;
                    const bool ok = (dist >= 0) && (dist < 128) && (nb > 0 || kv >= 128);
                    const float s = ok ? S[j][r] * 0.125f + biasd[dist & 127] : -1e30f;
                    S[j][r] = s; mx = fmaxf(mx, s);
                }
            mx = fmaxf(mx, __shfl_xor(mx, 32));
            float sum = 0.f;
#pragma unroll
            for (int j = 0; j < 5; ++j)
#pragma unroll
                for (int r = 0; r < 16; ++r) { const float e = S[j][r] > -1e29f ? __expf(S[j][r] - mx) : 0.f; S[j][r] = e; sum += e; }
            sum += __shfl_xor(sum, 32);
            const float rden = 1.0f / (sum + __expf(sink - mx));
            if (h == 0) wsf[c31] = rden;
            f32x16 O[2]; O[0] = (f32x16){}; O[1] = (f32x16){};
            const int i16 = lane & 15, qq = i16 >> 2, pp = i16 & 3, blk = (lane >> 4) & 1;
#pragma unroll
            for (int j = 0; j < 5; ++j)
#pragma unroll
                for (int s = 0; s < 2; ++s) {
                    const bf16x8 pf = pack8(S[j][8 * s], S[j][8 * s + 1], S[j][8 * s + 2], S[j][8 * s + 3], S[j][8 * s + 4], S[j][8 * s + 5], S[j][8 * s + 6], S[j][8 * s + 7]);
                    LAS const unsigned char* vp = lds + AT_V + (32 * (qt + j) + 16 * s + 4 * h + qq) * AT_VSTR + (16 * blk + 4 * pp) * 2;
#pragma unroll
                    for (int dt = 0; dt < 2; ++dt) {
                        const bf16x8 vf = cat8(tr_read(vp + dt * 64), tr_read(vp + dt * 64 + 8 * AT_VSTR));
                        O[dt] = MFMA32(pf, vf, O[dt]);
                    }
                }
            WAVE_LDS_SYNC();
#pragma unroll
            for (int r = 0; r < 16; ++r) {
                const int qr = (r & 3) + 8 * (r >> 2) + 4 * h;
                const float rd = wsf[qr];
                bf16_t* rowp = PROJ + (rowq0 + q0 + qr) * IN_COLS + hq * 64 + c31;
#pragma unroll
                for (int dt = 0; dt < 2; ++dt) {
                    const float ga = bf2f(rowp[C_GA + 32 * dt]);
                    if (!dry) rowp[C_Q + 32 * dt] = f2bf(O[dt][r] * rd * siluf_(ga));
                }
            }
            WAVE_LDS_SYNC();
        }
        __syncthreads();
    }
}

constexpr int S5_NPOW = 11, S5_NINV = 9, S5_NSEG = 8, S5_SEGLEN = 256;
__device__ __forceinline__ float neg_expm1_small(float y) {
    float q = 1.0f / 5040.0f; q = q * y + 1.0f / 720.0f; q = q * y + 1.0f / 120.0f; q = q * y + 1.0f / 24.0f; q = q * y + 1.0f / 6.0f; q = q * y + 0.5f; q = q * y + 1.0f; return -(q * y);
}
__device__ __forceinline__ f32x2_t cmul(f32x2_t a, f32x2_t b) { return (f32x2_t){a.x * b.x - a.y * b.y, a.x * b.y + a.y * b.x}; }

__device__ __forceinline__ void st_s5_tables2(KP p, const Ctx& c) {
    f32x2_t* POW = (f32x2_t*)(p->ws + WS_S5POW); f32x2_t* PINV = (f32x2_t*)(p->ws + WS_S5PINV);
    bf16_t* BCAT = (bf16_t*)(p->ws + WS_S5BCAT); bf16_t* CCAT = (bf16_t*)(p->ws + WS_S5CCAT);
    const float* BB = (const float*)(p->ws + WS_TAB + TAB_BB);
    for (size_t ii = c.gt; ii < (size_t)DEPTH * NG * NP; ii += c.ngt) {
        const int i = (int)ii, lg = i / NP, pp = i % NP;
        const double lr = (double)fminf(p->in[12][i], -1e-4f), li = (double)p->in[13][i];
        const double step = (double)expf(p->in[14][lg]);
        for (int k = 0; k < S5_NPOW + S5_NINV; ++k) {
            const int e = k < 9 ? k : (k == 9 ? 64 : (k == 10 ? 256 : -(k - S5_NPOW)));
            double t = (double)e * li * step * 0.15915494309189535; t -= rint(t);
            float sn, cs; sincosf((float)(t * 6.283185307179586), &sn, &cs);
            const float mag = expf((float)((double)e * lr * step));
            const f32x2_t v = {mag * cs, mag * sn};
            if (k < S5_NPOW) POW[((size_t)lg * S5_NPOW + k) * NP + pp] = v; else PINV[((size_t)lg * S5_NINV + (k - S5_NPOW)) * NP + pp] = v;
        }
    }
    for (size_t ii = c.gt; ii < (size_t)DEPTH * NG * 128 * NC; ii += c.ngt) {
        const int i = (int)ii, lg = i / (128 * NC), n = (i / NC) % 128, cc = i % NC, pp = n & 63;
        const int sidx = lg * NP + pp;
        const float lr = fminf(p->in[12][sidx], -1e-4f), li = p->in[13][sidx];
        const float step = expf(p->in[14][lg]);
        const float mag = expf(lr * step);
        float sn, cs; sincosf(li * step, &sn, &cs);
        const float ab_re = mag * cs, ab_im = mag * sn, den = lr * lr + li * li;
        const float f_re = ((ab_re - 1.0f) * lr + ab_im * li) / den, f_im = (ab_im * lr - (ab_re - 1.0f) * li) / den;
        const float bre = p->in[15][(size_t)sidx * NC + cc], bim = p->in[16][(size_t)sidx * NC + cc];
        BCAT[i] = f2bf(n < 64 ? f_re * bre - f_im * bim : f_re * bim + f_im * bre);
        const int c2 = (i / 128) % NC, n2 = i % 128, p2 = n2 & 63;
        const float cv = n2 < 64 ? p->in[17][((size_t)lg * NC + c2) * NP + p2] : -p->in[18][((size_t)lg * NC + c2) * NP + p2];
        CCAT[i] = f2bf(cv);
    }
}

__device__ __forceinline__ void s5_xtiles(f32x16 (&xr)[2], f32x16 (&xi)[2], const bf16x8 (&uf)[2], bf16x8 bre, bf16x8 bim) {
#pragma unroll
    for (int m = 0; m < 2; ++m) { xr[m] = MFMA32(uf[m], bre, (f32x16){}); xi[m] = MFMA32(uf[m], bim, (f32x16){}); }
}

__device__ __forceinline__ void st_s5_phaseA(KP p, int l, const Ctx& c) {
    const bf16_t* PROJ = (const bf16_t*)(p->ws + WS_PROJ);
    const f32x2_t* POW = (const f32x2_t*)(p->ws + WS_S5POW);
    const bf16_t* BCAT = (const bf16_t*)(p->ws + WS_S5BCAT);
    f32x2_t* SUM = (f32x2_t*)(p->ws + WS_S5SUM);
    const int lane = c.lane, c31 = lane & 31, h = lane >> 5;
    for (int item = c.gw; item < BATCH * S5_NSEG * NG; item += c.ngw) {
        const int g = item % NG, seg = (item / NG) % S5_NSEG, b = item / (NG * S5_NSEG);
        const int lg = l * NG + g;
        const size_t row0 = (size_t)b * SEQ + (size_t)seg * S5_SEGLEN;
#pragma unroll 1
        for (int pt = 0; pt < 2; ++pt) {
            const int pp = 32 * pt + c31;
            const f32x2_t* pw = POW + (size_t)lg * S5_NPOW * NP + pp;
            f32x2_t lo[4];
#pragma unroll
            for (int s = 0; s < 4; ++s) lo[s] = pw[(7 - 4 * h - s) * NP];
            const f32x2_t a8 = pw[8 * NP], a64 = pw[9 * NP];
            const bf16x8 bre = *(const bf16x8*)(BCAT + ((size_t)lg * 128 + pp) * NC + 8 * h);
            const bf16x8 bim = *(const bf16x8*)(BCAT + ((size_t)lg * 128 + 64 + pp) * NC + 8 * h);
            f32x2_t sseg = {0.f, 0.f};
#pragma unroll 1
            for (int ch = 0; ch < 4; ++ch) {
                bf16x8 uf[2];
#pragma unroll
                for (int m = 0; m < 2; ++m) uf[m] = *(const bf16x8*)(PROJ + (row0 + 64 * ch + 32 * m + c31) * IN_COLS + C_UB + 16 * g + 8 * h);
                f32x16 xr[2], xi[2];
                s5_xtiles(xr, xi, uf, bre, bim);
                f32x2_t f = {1.f, 0.f}, acc = {0.f, 0.f};
#pragma unroll
                for (int gi = 7; gi >= 0; --gi) {
                    const int m = gi >> 2, q = gi & 3;
                    f32x2_t t = {0.f, 0.f};
#pragma unroll
                    for (int s = 0; s < 4; ++s) { const f32x2_t x = {xr[m][4 * q + s], xi[m][4 * q + s]}; const f32x2_t w = cmul(lo[s], x); t.x += w.x; t.y += w.y; }
                    const f32x2_t w2 = cmul(f, t); acc.x += w2.x; acc.y += w2.y;
                    f = cmul(f, a8);
                }
                acc.x += __shfl_xor(acc.x, 32); acc.y += __shfl_xor(acc.y, 32);
                const f32x2_t d = cmul(a64, sseg); sseg.x = d.x + acc.x; sseg.y = d.y + acc.y;
            }
            if (h == 0) SUM[(((size_t)b * S5_NSEG + seg) * NG + g) * NP + pp] = sseg;
        }
    }
}

constexpr int S5_HT_STR = 144, S5_HT_BYTES = 64 * S5_HT_STR;
__device__ __forceinline__ void st_s5_phaseB(KP p, int l, const Ctx& c, LAS unsigned char* lds, bool dry) {
    bf16_t* PROJ = (bf16_t*)(p->ws + WS_PROJ);
    const f32x2_t* POW = (const f32x2_t*)(p->ws + WS_S5POW); const f32x2_t* PINV = (const f32x2_t*)(p->ws + WS_S5PINV);
    const bf16_t* BCAT = (const bf16_t*)(p->ws + WS_S5BCAT); const bf16_t* CCAT = (const bf16_t*)(p->ws + WS_S5CCAT);
    const f32x2_t* SUM = (const f32x2_t*)(p->ws + WS_S5SUM);
    const int lane = c.lane, c31 = lane & 31, h = lane >> 5, i16 = lane & 15, kg = lane >> 4, qq = i16 >> 2, p4 = i16 & 3;
    LAS unsigned char* ht = lds + c.wave * S5_HT_BYTES;
    bf16x8 tdiag[2], tones;
#pragma unroll
    for (int s = 0; s < 2; ++s)
#pragma unroll
        for (int j = 0; j < 8; ++j) tdiag[s][j] = (16 * s + 8 * (j >> 2) + 4 * h + (j & 3) <= c31) ? (short)0x3F80 : (short)0;
#pragma unroll
    for (int j = 0; j < 8; ++j) tones[j] = (short)0x3F80;
    for (int item = c.gw; item < BATCH * S5_NSEG * NG; item += c.ngw) {
        const int g = item % NG, seg = (item / NG) % S5_NSEG, b = item / (NG * S5_NSEG);
        const int lg = l * NG + g;
        const size_t row0 = (size_t)b * SEQ + (size_t)seg * S5_SEGLEN;
        f32x2_t hin[2];
#pragma unroll
        for (int pt = 0; pt < 2; ++pt) {
            const int pp = 32 * pt + c31;
            const f32x2_t a256 = POW[((size_t)lg * S5_NPOW + 10) * NP + pp];
            f32x2_t H = {0.f, 0.f};
#pragma unroll
            for (int k = 0; k < S5_NSEG - 1; ++k) if (k < seg) { const f32x2_t sk = SUM[(((size_t)b * S5_NSEG + k) * NG + g) * NP + pp]; const f32x2_t d = cmul(a256, H); H.x = d.x + sk.x; H.y = d.y + sk.y; }
            hin[pt] = H;
        }
        const float dd = p->in[19][l * 512 + g * 16 + i16];
#pragma unroll 1
        for (int ch = 0; ch < 4; ++ch) {
            const size_t crow0 = row0 + 64 * ch;
            bf16x8 uf[2];
#pragma unroll
            for (int m = 0; m < 2; ++m) uf[m] = *(const bf16x8*)(PROJ + (crow0 + 32 * m + c31) * IN_COLS + C_UB + 16 * g + 8 * h);
            f32x4 Y[4];
#pragma unroll
            for (int it = 0; it < 4; ++it) Y[it] = (f32x4){0.f, 0.f, 0.f, 0.f};
#pragma unroll
            for (int pt = 0; pt < 2; ++pt) {
                const int pp = 32 * pt + c31;
                const bf16x8 bre = *(const bf16x8*)(BCAT + ((size_t)lg * 128 + pp) * NC + 8 * h);
                const bf16x8 bim = *(const bf16x8*)(BCAT + ((size_t)lg * 128 + 64 + pp) * NC + 8 * h);
                const f32x2_t* pw = POW + (size_t)lg * S5_NPOW * NP + pp; const f32x2_t* pi = PINV + (size_t)lg * S5_NINV * NP + pp;
                asm volatile("" : "+v"(pw), "+v"(pi));
                f32x2_t ilo[4], plo[4];
#pragma unroll
                for (int s = 0; s < 4; ++s) { ilo[s] = pi[(4 * h + s) * NP]; plo[s] = pw[(4 * h + s) * NP]; }
                const f32x2_t ia8 = pi[8 * NP], a8 = pw[8 * NP], a1 = pw[1 * NP];
                bf16x8 wfr[2][2], wfi[2][2];
                {
                    f32x2_t f = {1.f, 0.f};
#pragma unroll
                    for (int m = 0; m < 2; ++m) {
                        f32x16 xr = MFMA32(uf[m], bre, (f32x16){}), xi = MFMA32(uf[m], bim, (f32x16){});
#pragma unroll
                        for (int q = 0; q < 4; ++q) {
#pragma unroll
                            for (int s = 0; s < 4; ++s) { const f32x2_t x = {xr[4 * q + s], xi[4 * q + s]}; const f32x2_t w = cmul(f, cmul(ilo[s], x)); xr[4 * q + s] = w.x; xi[4 * q + s] = w.y; }
                            f = cmul(f, ia8);
                        }
#pragma unroll
                        for (int s2 = 0; s2 < 2; ++s2) {
                            wfr[m][s2] = pack8(xr[8 * s2], xr[8 * s2 + 1], xr[8 * s2 + 2], xr[8 * s2 + 3], xr[8 * s2 + 4], xr[8 * s2 + 5], xr[8 * s2 + 6], xr[8 * s2 + 7]);
                            wfi[m][s2] = pack8(xi[8 * s2], xi[8 * s2 + 1], xi[8 * s2 + 2], xi[8 * s2 + 3], xi[8 * s2 + 4], xi[8 * s2 + 5], xi[8 * s2 + 6], xi[8 * s2 + 7]);
                        }
                        __builtin_amdgcn_sched_barrier(0);
                    }
                }
                const f32x2_t G = cmul(a1, hin[pt]);
                f32x2_t hlast = {0.f, 0.f};
                WAVE_LDS_SYNC();
                {
                    f32x2_t f = {1.f, 0.f};
#pragma unroll
                    for (int m = 0; m < 2; ++m) {
                        f32x16 cr, ci;
                        if (m == 0) { cr = MFMA32(tdiag[1], wfr[0][1], MFMA32(tdiag[0], wfr[0][0], (f32x16){})); ci = MFMA32(tdiag[1], wfi[0][1], MFMA32(tdiag[0], wfi[0][0], (f32x16){})); }
                        else { cr = MFMA32(tdiag[1], wfr[1][1], MFMA32(tdiag[0], wfr[1][0], MFMA32(tones, wfr[0][1], MFMA32(tones, wfr[0][0], (f32x16){}))));
                               ci = MFMA32(tdiag[1], wfi[1][1], MFMA32(tdiag[0], wfi[1][0], MFMA32(tones, wfi[0][1], MFMA32(tones, wfi[0][0], (f32x16){})))); }
#pragma unroll
                        for (int q = 0; q < 4; ++q) {
                            float hr[4], hi[4];
#pragma unroll
                            for (int s = 0; s < 4; ++s) { const f32x2_t v = {cr[4 * q + s] + G.x, ci[4 * q + s] + G.y}; const f32x2_t w = cmul(f, cmul(plo[s], v)); hr[s] = w.x; hi[s] = w.y; }
                            if (m == 1 && q == 3) { hlast.x = hr[3]; hlast.y = hi[3]; }
                            typedef unsigned u32x2_t __attribute__((ext_vector_type(2)));
                            u32x2_t wr_; wr_.x = cvtpk(hr[0], hr[1]); wr_.y = cvtpk(hr[2], hr[3]);
                            u32x2_t wi_; wi_.x = cvtpk(hi[0], hi[1]); wi_.y = cvtpk(hi[2], hi[3]);
                            *(LAS u32x2_t*)(ht + c31 * S5_HT_STR + (32 * m + 8 * q + 4 * h) * 2) = wr_;
                            *(LAS u32x2_t*)(ht + (32 + c31) * S5_HT_STR + (32 * m + 8 * q + 4 * h) * 2) = wi_;
                            f = cmul(f, a8);
                        }
                        __builtin_amdgcn_sched_barrier(0);
                    }
                }
                hin[pt].x = __shfl(hlast.x, c31 + 32); hin[pt].y = __shfl(hlast.y, c31 + 32);
                WAVE_LDS_SYNC();
#pragma unroll
                for (int ks = 0; ks < 2; ++ks) {
                    const bf16x8 cf = *(const bf16x8*)(CCAT + ((size_t)lg * NC + i16) * 128 + 64 * ks + 32 * pt + 8 * kg);
#pragma unroll
                    for (int it = 0; it < 4; ++it) {
                        LAS const unsigned char* ap = ht + (32 * ks + 8 * kg + qq) * S5_HT_STR + (16 * it + 4 * p4) * 2;
                        const bf16x8 af = cat8(tr_read(ap), tr_read(ap + 4 * S5_HT_STR));
                        Y[it] = MFMA16(af, cf, Y[it]);
                    }
                }
            }
#pragma unroll
            for (int it = 0; it < 4; ++it)
#pragma unroll
                for (int r = 0; r < 4; ++r) {
                    bf16_t* up = PROJ + (crow0 + 16 * it + 4 * kg + r) * IN_COLS + C_UB + 16 * g + i16;
                    const float y = Y[it][r] + dd * bf2f(*up);
                    if (!dry) *up = f2bf(gelu_tanh(y));
                }
        }
        if (seg == S5_NSEG - 1 && h == 0) {
#pragma unroll
            for (int pt = 0; pt < 2; ++pt) { const size_t oi = (((size_t)l * BATCH + b) * NG + g) * NP + 32 * pt + c31; p->out[O_SRP + oi] = hin[pt].x; p->out[O_SIP + oi] = hin[pt].y; }
        }
    }
}

__device__ __forceinline__ void st_s5_sample(KP p, int l, const Ctx& c, LAS unsigned char* lds, bool dry) {
    bf16_t* PROJ = (bf16_t*)(p->ws + WS_PROJ);
    const f32x2_t* POW = (const f32x2_t*)(p->ws + WS_S5POW); const f32x2_t* PINV = (const f32x2_t*)(p->ws + WS_S5PINV);
    const bf16_t* BCAT = (const bf16_t*)(p->ws + WS_S5BCAT); const bf16_t* CCAT = (const bf16_t*)(p->ws + WS_S5CCAT);
    LAS unsigned char* ht = lds + c.wave * S5_HT_BYTES;
    for (int item = c.gw; item < (DEC_BATCH / 16) * NG; item += c.ngw) {
        int zi = 0; asm volatile("" : "+v"(zi));
        const int lane = c.lane + zi, c31 = lane & 31, h = lane >> 5, i16 = lane & 15, kg = lane >> 4, qq = i16 >> 2, p4 = i16 & 3;
        const int g = item % NG, sg = item / NG, lg = l * NG + g;
        const size_t crow0 = (size_t)M_P + 64 * sg;
        bf16x8 tds[2];
#pragma unroll
        for (int s = 0; s < 2; ++s)
#pragma unroll
            for (int j = 0; j < 8; ++j) { const int kr = 16 * s + 8 * (j >> 2) + 4 * h + (j & 3); tds[s][j] = ((kr >> 2) == (c31 >> 2) && kr <= c31) ? (short)0x3F80 : (short)0; }
        const float dd = p->in[19][l * 512 + g * 16 + i16];
        bf16x8 uf[2];
#pragma unroll
        for (int m = 0; m < 2; ++m) uf[m] = *(const bf16x8*)(PROJ + (crow0 + 32 * m + c31) * IN_COLS + C_UB + 16 * g + 8 * h);
        f32x4 Y[4];
#pragma unroll
        for (int it = 0; it < 4; ++it) Y[it] = (f32x4){0.f, 0.f, 0.f, 0.f};
#pragma unroll
        for (int pt = 0; pt < 2; ++pt) {
            const int pp = 32 * pt + c31;
            const bf16x8 bre = *(const bf16x8*)(BCAT + ((size_t)lg * 128 + pp) * NC + 8 * h);
            const bf16x8 bim = *(const bf16x8*)(BCAT + ((size_t)lg * 128 + 64 + pp) * NC + 8 * h);
            const f32x2_t* pw = POW + (size_t)lg * S5_NPOW * NP + pp; const f32x2_t* pi = PINV + (size_t)lg * S5_NINV * NP + pp;
            f32x2_t ilo[4], plo[4];
#pragma unroll
            for (int s = 0; s < 4; ++s) { ilo[s] = pi[s * NP]; plo[s] = pw[s * NP]; }
            const f32x2_t a1 = pw[1 * NP];
            WAVE_LDS_SYNC();
#pragma unroll
            for (int m = 0; m < 2; ++m) {
                f32x16 xr = MFMA32(uf[m], bre, (f32x16){}), xi = MFMA32(uf[m], bim, (f32x16){});
#pragma unroll
                for (int q = 0; q < 4; ++q)
#pragma unroll
                    for (int s = 0; s < 4; ++s) { const f32x2_t x = {xr[4 * q + s], xi[4 * q + s]}; const f32x2_t w = cmul(ilo[s], x); xr[4 * q + s] = w.x; xi[4 * q + s] = w.y; }
                bf16x8 wr0 = pack8(xr[0], xr[1], xr[2], xr[3], xr[4], xr[5], xr[6], xr[7]), wr1 = pack8(xr[8], xr[9], xr[10], xr[11], xr[12], xr[13], xr[14], xr[15]);
                bf16x8 wi0 = pack8(xi[0], xi[1], xi[2], xi[3], xi[4], xi[5], xi[6], xi[7]), wi1 = pack8(xi[8], xi[9], xi[10], xi[11], xi[12], xi[13], xi[14], xi[15]);
                const f32x16 cr = MFMA32(tds[1], wr1, MFMA32(tds[0], wr0, (f32x16){})), ci = MFMA32(tds[1], wi1, MFMA32(tds[0], wi0, (f32x16){}));
#pragma unroll
                for (int q = 0; q < 4; ++q) {
                    const int seq = 16 * sg + 8 * m + 2 * q + h;
                    const size_t si = (((size_t)l * DEC_BATCH + seq) * NG + g) * NP + pp;
                    const f32x2_t G = cmul(a1, (f32x2_t){p->in[4][si], p->in[5][si]});
                    float hr[4], hi[4];
#pragma unroll
                    for (int s = 0; s < 4; ++s) { const f32x2_t v = {cr[4 * q + s] + G.x, ci[4 * q + s] + G.y}; const f32x2_t w = cmul(plo[s], v); hr[s] = w.x; hi[s] = w.y; }
                    p->out[O_SRS + si] = hr[3]; p->out[O_SIS + si] = hi[3];
                    typedef unsigned u32x2_t __attribute__((ext_vector_type(2)));
                    u32x2_t wr_; wr_.x = cvtpk(hr[0], hr[1]); wr_.y = cvtpk(hr[2], hr[3]);
                    u32x2_t wi_; wi_.x = cvtpk(hi[0], hi[1]); wi_.y = cvtpk(hi[2], hi[3]);
                    *(LAS u32x2_t*)(ht + c31 * S5_HT_STR + (32 * m + 8 * q + 4 * h) * 2) = wr_;
                    *(LAS u32x2_t*)(ht + (32 + c31) * S5_HT_STR + (32 * m + 8 * q + 4 * h) * 2) = wi_;
                }
                __builtin_amdgcn_sched_barrier(0);
            }
            WAVE_LDS_SYNC();
#pragma unroll
            for (int ks = 0; ks < 2; ++ks) {
                const bf16x8 cf = *(const bf16x8*)(CCAT + ((size_t)lg * NC + i16) * 128 + 64 * ks + 32 * pt + 8 * kg);
#pragma unroll
                for (int it = 0; it < 4; ++it) {
                    LAS const unsigned char* ap = ht + (32 * ks + 8 * kg + qq) * S5_HT_STR + (16 * it + 4 * p4) * 2;
                    const bf16x8 af = cat8(tr_read(ap), tr_read(ap + 4 * S5_HT_STR));
                    Y[it] = MFMA16(af, cf, Y[it]);
                }
            }
        }
#pragma unroll
        for (int it = 0; it < 4; ++it)
#pragma unroll
            for (int r = 0; r < 4; ++r) {
                bf16_t* up = PROJ + (crow0 + 16 * it + 4 * kg + r) * IN_COLS + C_UB + 16 * g + i16;
                const float y = Y[it][r] + dd * bf2f(*up);
                if (!dry) *up = f2bf(gelu_tanh(y));
            }
    }
}

__device__ __forceinline__ void st_lru_sample(KP p, int l, const Ctx& c, LAS unsigned char* lds, bool dry) {
    bf16_t* PROJ = (bf16_t*)(p->ws + WS_PROJ);
    const bf16_t* LRUW = (const bf16_t*)(p->ws + WS_LRUW);
    for (int item = c.gw; item < (DEC_BATCH / 16) * 8; item += c.ngw) {
        int zi = 0; asm volatile("" : "+v"(zi));
        const int lane = c.lane + zi, c31 = lane & 31, h = lane >> 5;
        const int n = item & 7, sg = item >> 3;
        const size_t row0 = (size_t)M_P + 64 * sg;
        const int ch0 = n * 64;
        LAS unsigned char* xim = lds + c.wave * 9216;
        WAVE_LDS_SYNC();
#pragma unroll 1
        for (int ks = 0; ks < 4; ++ks) {
            const int chb = ch0 + 16 * ks + 8 * h;
            float w[4][8], cb[8];
#pragma unroll
            for (int j = 0; j < 4; ++j) {
                const f32x4 w0 = *(const f32x4*)(p->in[22] + (l * 4 + j) * 512 + chb), w1 = *(const f32x4*)(p->in[22] + (l * 4 + j) * 512 + chb + 4);
                w[j][0] = w0[0]; w[j][1] = w0[1]; w[j][2] = w0[2]; w[j][3] = w0[3]; w[j][4] = w1[0]; w[j][5] = w1[1]; w[j][6] = w1[2]; w[j][7] = w1[3];
            }
            { const f32x4 b0 = *(const f32x4*)(p->in[23] + l * 512 + chb), b1 = *(const f32x4*)(p->in[23] + l * 512 + chb + 4);
              cb[0] = b0[0]; cb[1] = b0[1]; cb[2] = b0[2]; cb[3] = b0[3]; cb[4] = b1[0]; cb[5] = b1[1]; cb[6] = b1[2]; cb[7] = b1[3]; }
#pragma unroll
            for (int m = 0; m < 2; ++m) {
                const int i = 32 * m + c31, t = i & 3, seq = 16 * sg + (i >> 2);
                float xf[8];
#pragma unroll
                for (int e = 0; e < 8; ++e) xf[e] = cb[e];
#pragma unroll
                for (int j = 0; j < 4; ++j) {
                    const int tau = t - 3 + j;
                    float xv[8];
                    if (tau >= 0) {
                        const u32x4 xx = *(const u32x4*)(PROJ + ((size_t)M_P + 4 * seq + tau) * IN_COLS + C_XC + chb);
#pragma unroll
                        for (int e = 0; e < 4; ++e) { xv[2 * e] = __uint_as_float(xx[e] << 16); xv[2 * e + 1] = __uint_as_float(xx[e] & 0xffff0000u); }
                    } else {
                        const float* cp = p->in[7] + (((size_t)l * DEC_BATCH + seq) * 3 + (3 + tau)) * 512 + chb;
                        const f32x4 c0 = *(const f32x4*)cp, c1 = *(const f32x4*)(cp + 4);
                        xv[0] = c0[0]; xv[1] = c0[1]; xv[2] = c0[2]; xv[3] = c0[3]; xv[4] = c1[0]; xv[5] = c1[1]; xv[6] = c1[2]; xv[7] = c1[3];
                    }
#pragma unroll
                    for (int e = 0; e < 8; ++e) xf[e] += w[j][e] * xv[e];
                }
                *(LAS bf16x8*)(xim + (32 * m + c31) * 144 + (16 * ks + 8 * h) * 2) = pack8(xf[0], xf[1], xf[2], xf[3], xf[4], xf[5], xf[6], xf[7]);
            }
        }
        WAVE_LDS_SYNC();
#pragma unroll 1
        for (int et = 0; et < 2; ++et) {
            const int ch = ch0 + 32 * et + c31;
            const float ba = p->in[25][l * 512 + ch], bx = p->in[27][l * 512 + ch], lam = p->in[28][l * 512 + ch];
            const float lsig8 = -8.0f * log1pf(expf(-lam));
            const bf16_t* wp = LRUW + (((size_t)(l * 8 + n) * 2) * 64 + 32 * et + c31) * 64 + 8 * h;
#pragma unroll
            for (int m = 0; m < 2; ++m) {
                f32x16 X = (f32x16){}, R = (f32x16){}, I = (f32x16){};
#pragma unroll
                for (int ks = 0; ks < 4; ++ks) {
                    const bf16x8 wa = *(const bf16x8*)(wp + 16 * ks), wx = *(const bf16x8*)(wp + 64 * 64 + 16 * ks);
                    bf16x8 id;
#pragma unroll
                    for (int j = 0; j < 8; ++j) id[j] = (16 * ks + 8 * h + j == 32 * et + c31) ? (short)0x3F80 : (short)0;
                    const bf16x8 afr = *(LAS const bf16x8*)(xim + (32 * m + c31) * 144 + (16 * ks + 8 * h) * 2);
                    R = MFMA32(afr, wa, R); I = MFMA32(afr, wx, I); X = MFMA32(afr, id, X);
                }
#pragma unroll
                for (int q = 0; q < 4; ++q) {
                    const int seq = 16 * sg + 8 * m + 2 * q + h;
                    float hv = p->in[6][((size_t)l * DEC_BATCH + seq) * 512 + ch];
#pragma unroll
                    for (int s = 0; s < 4; ++s) {
                        const int r = 4 * q + s;
                        const float rg = sigmoidf_(R[r] + ba), ig = sigmoidf_(I[r] + bx);
                        const float la = rg * lsig8;
                        const float a = __expf(la);
                        const float bg = X[r] * ig * sqrtf(neg_expm1_small(2.0f * la));
                        hv = a * hv + bg;
                        bf16_t* gp = PROJ + ((size_t)M_P + 4 * seq + s) * IN_COLS + C_GC + ch;
                        const float gc = bf2f(*gp);
                        if (!dry) *gp = f2bf(hv * siluf_(gc));
                    }
                    p->out[O_LS + ((size_t)l * DEC_BATCH + seq) * 512 + ch] = hv;
                }
                __builtin_amdgcn_sched_barrier(0);
            }
        }
    }
}

__device__ __forceinline__ void st_attn_sample(KP p, int l, LAS unsigned char* lds, bool dry) {
    int zv = 0; asm volatile("" : "+v"(zv));
    const int tid = (int)threadIdx.x + zv, lane = tid & 63, wave = __builtin_amdgcn_readfirstlane(tid >> 6);
    const int c31 = lane & 31, h = lane >> 5;
    bf16_t* PROJ = (bf16_t*)(p->ws + WS_PROJ);
    const float* rel_bias = p->in[8];
    for (int item = blockIdx.x; item < DEC_BATCH * NKV; item += gridDim.x) {
        const int b = item >> 1, kvh = item & 1;
#pragma unroll
        for (int i = 0; i < 3; ++i) {
            const int id = tid + 512 * i, row = id >> 3, pc = id & 7;
            if (id < 160 * 8) {
                u32x4 kk = (u32x4){0u, 0u, 0u, 0u}, vv = kk;
                if (row < WINDOW) {
                    const size_t ci = ((((size_t)l * DEC_BATCH + b) * WINDOW + row) * NKV + kvh) * HD + pc * 8;
                    const f32x4 k0 = *(const f32x4*)(p->in[2] + ci), k1 = *(const f32x4*)(p->in[2] + ci + 4), v0 = *(const f32x4*)(p->in[3] + ci), v1 = *(const f32x4*)(p->in[3] + ci + 4);
                    kk.x = cvtpk(k0[0], k0[1]); kk.y = cvtpk(k0[2], k0[3]); kk.z = cvtpk(k1[0], k1[1]); kk.w = cvtpk(k1[2], k1[3]);
                    vv.x = cvtpk(v0[0], v0[1]); vv.y = cvtpk(v0[2], v0[3]); vv.z = cvtpk(v1[0], v1[1]); vv.w = cvtpk(v1[2], v1[3]);
                } else if (row < WINDOW + DEC_SEQ) {
                    const bf16_t* src = PROJ + ((size_t)M_P + 4 * b + (row - WINDOW)) * IN_COLS + kvh * 64 + pc * 8;
                    kk = *(const u32x4*)(src + C_K); vv = *(const u32x4*)(src + C_V);
                }
                *(LAS u32x4*)(lds + AT_K + row * AT_KSTR + pc * 16) = kk;
                *(LAS u32x4*)(lds + AT_V + row * AT_VSTR + pc * 16) = vv;
            }
        }
        { const int g = tid >> 7, d = tid & 127; ((LAS float*)(lds + AT_BIAS))[tid] = rel_bias[T5_BUCKET[d] * NQH + kvh * 4 + g]; }
        __syncthreads();
        if (wave == 0) {
            const int qc = c31 & 15, g = qc >> 2, iq = qc & 3, hq = kvh * 4 + g;
            const float sink = p->in[10][l * NQH + hq];
            LAS const float* biasd = (LAS const float*)(lds + AT_BIAS) + g * 128;
            LAS float* wsf = (LAS float*)(lds + AT_WS);
            bf16x8 qf[4];
            { const bf16_t* qp = PROJ + ((size_t)M_P + 4 * b + iq) * IN_COLS + C_Q + hq * 64 + 8 * h;
#pragma unroll
              for (int ks = 0; ks < 4; ++ks) qf[ks] = *(const bf16x8*)(qp + 16 * ks); }
            f32x16 S[5];
#pragma unroll
            for (int j = 0; j < 5; ++j) {
                S[j] = (f32x16){};
                LAS const unsigned char* kp = lds + AT_K + (32 * j + c31) * AT_KSTR + 16 * h;
#pragma unroll
                for (int ks = 0; ks < 4; ++ks) S[j] = MFMA32(*(LAS const bf16x8*)(kp + 32 * ks), qf[ks], S[j]);
            }
            float mx = sink;
#pragma unroll
            for (int j = 0; j < 5; ++j)
#pragma unroll
                for (int r = 0; r < 16; ++r) {
                    const int kv = 32 * j + (r & 3) + 8 * (r >> 2) + 4 * h;
                    const int dist = iq + 128 - kv;
                    const bool ok = (dist >= 0) && (dist < 128);
                    const float s = ok ? S[j][r] * 0.125f + biasd[dist & 127] : -1e30f;
                    S[j][r] = s; mx = fmaxf(mx, s);
                }
            mx = fmaxf(mx, __shfl_xor(mx, 32));
            float sum = 0.f;
#pragma unroll
            for (int j = 0; j < 5; ++j)
#pragma unroll
                for (int r = 0; r < 16; ++r) { const float e = S[j][r] > -1e29f ? __expf(S[j][r] - mx) : 0.f; S[j][r] = e; sum += e; }
            sum += __shfl_xor(sum, 32);
            const float rden = 1.0f / (sum + __expf(sink - mx));
            if (h == 0) wsf[c31] = rden;
            f32x16 O[2]; O[0] = (f32x16){}; O[1] = (f32x16){};
            const int i16 = lane & 15, qq = i16 >> 2, pp = i16 & 3, blk = (lane >> 4) & 1;
#pragma unroll
            for (int j = 0; j < 5; ++j)
#pragma unroll
                for (int s = 0; s < 2; ++s) {
                    const bf16x8 pf = pack8(S[j][8 * s], S[j][8 * s + 1], S[j][8 * s + 2], S[j][8 * s + 3], S[j][8 * s + 4], S[j][8 * s + 5], S[j][8 * s + 6], S[j][8 * s + 7]);
                    LAS const unsigned char* vp = lds + AT_V + (32 * j + 16 * s + 4 * h + qq) * AT_VSTR + (16 * blk + 4 * pp) * 2;
#pragma unroll
                    for (int dt = 0; dt < 2; ++dt) {
                        const bf16x8 vf = cat8(tr_read(vp + dt * 64), tr_read(vp + dt * 64 + 8 * AT_VSTR));
                        O[dt] = MFMA32(pf, vf, O[dt]);
                    }
                }
            WAVE_LDS_SYNC();
#pragma unroll
            for (int r = 0; r < 8; ++r) {
                const int qr = (r & 3) + 8 * (r >> 2) + 4 * h, g2 = qr >> 2, i2 = qr & 3;
                const float rd = wsf[qr];
                bf16_t* rowp = PROJ + ((size_t)M_P + 4 * b + i2) * IN_COLS + (kvh * 4 + g2) * 64 + c31;
#pragma unroll
                for (int dt = 0; dt < 2; ++dt) {
                    const float ga = bf2f(rowp[C_GA + 32 * dt]);
                    if (!dry) rowp[C_Q + 32 * dt] = f2bf(O[dt][r] * rd * siluf_(ga));
                }
            }
        }
        __syncthreads();
    }
}

__device__ __forceinline__ void st_s5_simple(KP p, int l, const Ctx& c, LAS float* wsm, bool dry) {
    bf16_t* PROJ = (bf16_t*)(p->ws + WS_PROJ);
    const float* AB = (const float*)(p->ws + WS_TAB + TAB_AB);
    const float* BB = (const float*)(p->ws + WS_TAB + TAB_BB);
    const int pp = c.lane;
    for (int item = c.gw; item < DEC_BATCH * NG; item += c.ngw) {
        const int seq = BATCH + item / NG, g = item % NG;
        const bool samp = seq >= BATCH;
        const int b = samp ? seq - BATCH : seq, T = samp ? DEC_SEQ : SEQ;
        const size_t row0 = samp ? (size_t)M_P + b * DEC_SEQ : (size_t)b * SEQ;
        const int sidx = (l * NG + g) * NP + pp;
        const float ab_re = AB[2 * sidx], ab_im = AB[2 * sidx + 1];
        float bbr[16], bbi[16], cr[16], ci[16];
#pragma unroll
        for (int cc = 0; cc < 16; ++cc) {
            bbr[cc] = BB[((size_t)sidx * NC + cc) * 2]; bbi[cc] = BB[((size_t)sidx * NC + cc) * 2 + 1];
            cr[cc] = p->in[17][((size_t)(l * NG + g) * NC + cc) * NP + pp]; ci[cc] = p->in[18][((size_t)(l * NG + g) * NC + cc) * NP + pp];
        }
        const float dd = pp < 16 ? p->in[19][l * 512 + g * 16 + pp] : 0.f;
        float hr = 0.f, hi = 0.f;
        if (samp) { const size_t si = (((size_t)l * DEC_BATCH + b) * NG + g) * NP + pp; hr = p->in[4][si]; hi = p->in[5][si]; }
        for (int t = 0; t < T; ++t) {
            bf16_t* up = PROJ + (row0 + t) * IN_COLS + C_UB + g * 16;
            float u[16];
#pragma unroll
            for (int cc = 0; cc < 16; ++cc) u[cc] = bf2f(up[cc]);
            float xr = 0.f, xi = 0.f;
#pragma unroll
            for (int cc = 0; cc < 16; ++cc) { xr += bbr[cc] * u[cc]; xi += bbi[cc] * u[cc]; }
            const float nr = ab_re * hr - ab_im * hi + xr, ni = ab_re * hi + ab_im * hr + xi;
            hr = nr; hi = ni;
#pragma unroll
            for (int cc = 0; cc < 16; ++cc) wsm[pp * 17 + cc] = cr[cc] * hr - ci[cc] * hi;
            WAVE_LDS_SYNC();
            if (pp < 16) {
                float y = 0.f;
                for (int q = 0; q < 64; ++q) y += wsm[q * 17 + pp];
                y += dd * bf2f(up[pp]);
                if (!dry) up[pp] = f2bf(gelu_tanh(y));
            }
            WAVE_LDS_SYNC();
        }
        if (!samp) { const size_t oi = (((size_t)l * BATCH + b) * NG + g) * NP + pp; p->out[O_SRP + oi] = hr; p->out[O_SIP + oi] = hi; }
        else { const size_t oi = (((size_t)l * DEC_BATCH + b) * NG + g) * NP + pp; p->out[O_SRS + oi] = hr; p->out[O_SIS + oi] = hi; }
    }
}

struct EpiGlu { bf16_t* PROJ; __device__ void operator()(int r, int c, float v) const {
    const float z = bf2f(PROJ[(size_t)r * IN_COLS + C_UB + c]), gb = bf2f(PROJ[(size_t)r * IN_COLS + C_GB + c]);
    PROJ[(size_t)r * IN_COLS + C_GB + c] = f2bf(z * sigmoidf_(v) * siluf_(gb)); } };

constexpr int LR_NSEG = 32;
template <bool PHASE_B>
__device__ __forceinline__ void st_lru_mfma(KP p, int l, const Ctx& c, LAS unsigned char* lds, bool dry) {
    bf16_t* PROJ = (bf16_t*)(p->ws + WS_PROJ);
    const bf16_t* LRUW = (const bf16_t*)(p->ws + WS_LRUW);
    f32x2_t* LSUM = (f32x2_t*)(p->ws + WS_LRSUM);
    for (int item = c.gw; item < BATCH * LR_NSEG * 8; item += c.ngw) {
        int zi = 0; asm volatile("" : "+v"(zi));
        const int lane = c.lane + zi, c31 = lane & 31, h = lane >> 5;
        const int n = item & 7, seg = (item >> 3) % LR_NSEG, b = item / (8 * LR_NSEG);
        const size_t row0 = (size_t)b * SEQ + (size_t)seg * 64;
        const int ch0 = n * 64;
        LAS unsigned char* xim = lds + c.wave * 9216;
        WAVE_LDS_SYNC();
#pragma unroll 1
        for (int ks = 0; ks < 4; ++ks) {
            const int chb = ch0 + 16 * ks + 8 * h;
            float w[4][8], cb[8];
#pragma unroll
            for (int j = 0; j < 4; ++j) {
                const f32x4 w0 = *(const f32x4*)(p->in[22] + (l * 4 + j) * 512 + chb), w1 = *(const f32x4*)(p->in[22] + (l * 4 + j) * 512 + chb + 4);
                w[j][0] = w0[0]; w[j][1] = w0[1]; w[j][2] = w0[2]; w[j][3] = w0[3]; w[j][4] = w1[0]; w[j][5] = w1[1]; w[j][6] = w1[2]; w[j][7] = w1[3];
            }
            { const f32x4 b0 = *(const f32x4*)(p->in[23] + l * 512 + chb), b1 = *(const f32x4*)(p->in[23] + l * 512 + chb + 4);
              cb[0] = b0[0]; cb[1] = b0[1]; cb[2] = b0[2]; cb[3] = b0[3]; cb[4] = b1[0]; cb[5] = b1[1]; cb[6] = b1[2]; cb[7] = b1[3]; }
#pragma unroll
            for (int m = 0; m < 2; ++m) {
                const int t = seg * 64 + 32 * m + c31;
                float xf[8];
#pragma unroll
                for (int e = 0; e < 8; ++e) xf[e] = cb[e];
#pragma unroll
                for (int j = 0; j < 4; ++j) {
                    u32x4 xx = (u32x4){0u, 0u, 0u, 0u};
                    if (t - 3 + j >= 0) xx = *(const u32x4*)(PROJ + (row0 + 32 * m + c31 - 3 + j) * IN_COLS + C_XC + chb);
#pragma unroll
                    for (int e = 0; e < 4; ++e) { xf[2 * e] += w[j][2 * e] * __uint_as_float(xx[e] << 16); xf[2 * e + 1] += w[j][2 * e + 1] * __uint_as_float(xx[e] & 0xffff0000u); }
                }
                *(LAS bf16x8*)(xim + (32 * m + c31) * 144 + (16 * ks + 8 * h) * 2) = pack8(xf[0], xf[1], xf[2], xf[3], xf[4], xf[5], xf[6], xf[7]);
            }
        }
        WAVE_LDS_SYNC();
#pragma unroll 1
        for (int et = 0; et < 2; ++et) {
            const int ch = ch0 + 32 * et + c31;
            const float ba = p->in[25][l * 512 + ch], bx = p->in[27][l * 512 + ch], lam = p->in[28][l * 512 + ch];
            const float lsig8 = -8.0f * log1pf(expf(-lam));
            const bf16_t* wp = LRUW + (((size_t)(l * 8 + n) * 2) * 64 + 32 * et + c31) * 64 + 8 * h;
            f32x16 R[2], I[2];
            float Ar[8], Br[8];
            __builtin_amdgcn_sched_barrier(0);
#pragma unroll
            for (int m = 0; m < 2; ++m) {
                f32x16 X = (f32x16){}; R[m] = (f32x16){}; I[m] = (f32x16){};
#pragma unroll
                for (int ks = 0; ks < 4; ++ks) {
                    const bf16x8 wa = *(const bf16x8*)(wp + 16 * ks), wx = *(const bf16x8*)(wp + 64 * 64 + 16 * ks);
                    bf16x8 id;
#pragma unroll
                    for (int j = 0; j < 8; ++j) id[j] = (16 * ks + 8 * h + j == 32 * et + c31) ? (short)0x3F80 : (short)0;
                    const bf16x8 afr = *(LAS const bf16x8*)(xim + (32 * m + c31) * 144 + (16 * ks + 8 * h) * 2);
                    R[m] = MFMA32(afr, wa, R[m]); I[m] = MFMA32(afr, wx, I[m]); X = MFMA32(afr, id, X);
                }
#pragma unroll
                for (int q = 0; q < 4; ++q) {
                    float cp = 1.f, hl = 0.f;
#pragma unroll
                    for (int s = 0; s < 4; ++s) {
                        const int r = 4 * q + s;
                        const float rg = sigmoidf_(R[m][r] + ba), ig = sigmoidf_(I[m][r] + bx);
                        const float la = rg * lsig8;
                        const float a = __expf(la);
                        const float bg = X[r] * ig * sqrtf(neg_expm1_small(2.0f * la));
                        cp *= a; hl = a * hl + bg;
                        R[m][r] = cp; I[m][r] = hl;
                    }
                    Ar[4 * m + q] = cp; Br[4 * m + q] = hl;
                }
                __builtin_amdgcn_sched_barrier(0);
            }
            float Hc = 0.f;
            if (PHASE_B) {
                for (int k0 = 0; k0 < seg; k0 += 8) {
                    f32x2_t ab[8];
#pragma unroll
                    for (int j = 0; j < 8; ++j) ab[j] = (k0 + j < seg) ? LSUM[((size_t)b * LR_NSEG + k0 + j) * 512 + ch] : (f32x2_t){1.f, 0.f};
#pragma unroll
                    for (int j = 0; j < 8; ++j) Hc = ab[j].x * Hc + ab[j].y;
                }
            }
            float st = Hc, At = 1.f, cin[8];
#pragma unroll
            for (int gi = 0; gi < 8; ++gi) {
                const float Ao = __shfl_xor(Ar[gi], 32), Bo = __shfl_xor(Br[gi], 32);
                const float A0 = h == 0 ? Ar[gi] : Ao, B0 = h == 0 ? Br[gi] : Bo, A1 = h == 0 ? Ao : Ar[gi], B1 = h == 0 ? Bo : Br[gi];
                const float s1 = A0 * st + B0;
                cin[gi] = h == 0 ? st : s1;
                st = A1 * s1 + B1; At *= A0 * A1;
            }
            if (!PHASE_B) {
                if (h == 0) LSUM[((size_t)b * LR_NSEG + seg) * 512 + ch] = (f32x2_t){At, st};
            } else {
#pragma unroll
                for (int m = 0; m < 2; ++m)
#pragma unroll
                    for (int r = 0; r < 16; ++r) {
                        const float hv = I[m][r] + R[m][r] * cin[4 * m + (r >> 2)];
                        bf16_t* gp = PROJ + (row0 + 32 * m + (r & 3) + 8 * (r >> 2) + 4 * h) * IN_COLS + C_GC + ch;
                        const float gc = bf2f(*gp);
                        if (!dry) *gp = f2bf(hv * siluf_(gc));
                        if (m == 1 && r == 15 && h == 1 && seg == LR_NSEG - 1) p->out[O_LP + ((size_t)l * BATCH + b) * 512 + ch] = hv;
                    }
            }
        }
    }
}

__device__ __forceinline__ void st_lru_simple(KP p, int l, const Ctx& c, LAS float* wsm, bool dry) {
    bf16_t* PROJ = (bf16_t*)(p->ws + WS_PROJ);
    const int e = c.lane;
    for (int item = c.gw; item < DEC_BATCH * 8; item += c.ngw) {
        const int seq = BATCH + item / 8, n = item % 8, ch = n * 64 + e;
        const bool samp = seq >= BATCH;
        const int b = samp ? seq - BATCH : seq, T = samp ? DEC_SEQ : SEQ;
        const size_t row0 = samp ? (size_t)M_P + b * DEC_SEQ : (size_t)b * SEQ;
        float wa[64], wx[64];
#pragma unroll
        for (int d = 0; d < 64; ++d) { wa[d] = p->in[24][(((size_t)l * 8 + n) * 64 + d) * 64 + e]; wx[d] = p->in[26][(((size_t)l * 8 + n) * 64 + d) * 64 + e]; }
        const float ba = p->in[25][l * 512 + ch], bx = p->in[27][l * 512 + ch], lam = p->in[28][l * 512 + ch];
        const float lsig = -log1pf(expf(-lam));
        const float cw0 = p->in[22][(l * 4 + 0) * 512 + ch], cw1 = p->in[22][(l * 4 + 1) * 512 + ch], cw2 = p->in[22][(l * 4 + 2) * 512 + ch], cw3 = p->in[22][(l * 4 + 3) * 512 + ch];
        const float cb = p->in[23][l * 512 + ch];
        float xm3 = 0.f, xm2 = 0.f, xm1 = 0.f, h = 0.f;
        if (samp) {
            const size_t ci = (((size_t)l * DEC_BATCH + b) * 3) * 512 + ch;
            xm3 = p->in[7][ci]; xm2 = p->in[7][ci + 512]; xm1 = p->in[7][ci + 1024];
            h = p->in[6][((size_t)l * DEC_BATCH + b) * 512 + ch];
        }
        for (int t = 0; t < T; ++t) {
            bf16_t* rp = PROJ + (row0 + t) * IN_COLS;
            const float xc = bf2f(rp[C_XC + ch]);
            const float xf = cb + cw0 * xm3 + cw1 * xm2 + cw2 * xm1 + cw3 * xc;
            xm3 = xm2; xm2 = xm1; xm1 = xc;
            wsm[e] = xf;
            WAVE_LDS_SYNC();
            float r = ba, i = bx;
#pragma unroll
            for (int d = 0; d < 64; ++d) { const float xv = wsm[d]; r += xv * wa[d]; i += xv * wx[d]; }
            WAVE_LDS_SYNC();
            r = sigmoidf_(r); i = sigmoidf_(i);
            const float log_a = 8.0f * r * lsig;
            const float a = expf(log_a);
            const float bt = xf * i * sqrtf(-expm1f(2.0f * log_a));
            h = a * h + bt;
            const float gc = bf2f(rp[C_GC + ch]);
            if (!dry) rp[C_GC + ch] = f2bf(h * siluf_(gc));
        }
        if (!samp) {
            p->out[O_LP + ((size_t)l * BATCH + b) * 512 + ch] = h;
            const size_t ci = (((size_t)l * BATCH + b) * 3) * 512 + ch;
            p->out[O_CP + ci] = xm3; p->out[O_CP + ci + 512] = xm2; p->out[O_CP + ci + 1024] = xm1;
        } else {
            p->out[O_LS + ((size_t)l * DEC_BATCH + b) * 512 + ch] = h;
            const size_t ci = (((size_t)l * DEC_BATCH + b) * 3) * 512 + ch;
            p->out[O_CS + ci] = xm3; p->out[O_CS + ci + 512] = xm2; p->out[O_CS + ci + 1024] = xm1;
        }
    }
}

__device__ __forceinline__ void st_branch_simple(KP p, int l, const Ctx& c) {
    bf16_t* PROJ = (bf16_t*)(p->ws + WS_PROJ);
    const bf16_t* WB = (const bf16_t*)((unsigned char*)p->out + DO_WBR) + (size_t)l * 3 * 1024 * 512;
    const int lane = c.lane;
    const int ntn = 1024 / 32, ntiles = (M_TOT / 32) * ntn;
    for (int tile = c.gw; tile < ntiles; tile += c.ngw) {
        const int tm = tile / ntn, tn = tile % ntn;
        f32x16 acc[3];
#pragma unroll
        for (int br = 0; br < 3; ++br) {
            const int acol = br == 0 ? C_Q : (br == 1 ? C_GB : C_XC);
            acc[br] = (f32x16){};
            const bf16_t* ar = PROJ + (size_t)(tm * 32 + (lane & 31)) * IN_COLS + acol + 8 * (lane >> 5);
            const bf16_t* bp = WB + (size_t)br * 1024 * 512 + (size_t)(tn * 32 + (lane & 31)) * 512 + 8 * (lane >> 5);
            for (int k0 = 0; k0 < 512; k0 += 16)
                acc[br] = __builtin_amdgcn_mfma_f32_32x32x16_bf16(*(const bf16x8*)(ar + k0), *(const bf16x8*)(bp + k0), acc[br], 0, 0, 0);
        }
#pragma unroll
        for (int r = 0; r < 16; ++r) {
            const int row = tm * 32 + (r & 3) + 8 * (r >> 2) + 4 * (lane >> 5), col = tn * 32 + (lane & 31);
            bf16_t* gp = PROJ + (size_t)row * IN_COLS + C_GM + col;
            const float m = sigmoidf_(bf2f(gp[0])) * acc[0][r] + sigmoidf_(bf2f(gp[1024])) * acc[1][r] + sigmoidf_(bf2f(gp[2048])) * acc[2][r];
            gp[0] = f2bf(m);
        }
    }
}

__device__ __forceinline__ float* pre_row(unsigned char* ws, int r) { return (float*)(ws + WS_PROJ + (size_t)r * IN_COLS * 2 + (size_t)(C_GM + 1024) * 2); }
struct EpiOut { KP p; int l; __device__ void operator()(int r, int c, float v) const {
    float x;
    if (l == 0) x = r < M_P ? p->in[0][(size_t)r * D_MODEL + c] : p->in[1][(size_t)(r - M_P) * D_MODEL + c];
    else x = bf2f(((const bf16_t*)(p->ws + WS_XB))[(size_t)r * D_MODEL + c]);
    pre_row(p->ws, r)[c] = DN_ALPHA * x + v; } };

__device__ __forceinline__ void st_ln(KP p, int l, const Ctx& c) {
    const int lane = c.lane;
    const float* g = p->in[31] + l * 1024; const float* bb = p->in[32] + l * 1024;
    f32x4 gv[4], bv[4];
#pragma unroll
    for (int j = 0; j < 4; ++j) { gv[j] = *(const f32x4*)(g + 4 * lane + 256 * j); bv[j] = *(const f32x4*)(bb + 4 * lane + 256 * j); }
    constexpr int NR = 3;
    for (int r0 = c.gw * NR; r0 < M_TOT; r0 += c.ngw * NR) {
        f32x4 v[NR][4];
#pragma unroll
        for (int k = 0; k < NR; ++k) { const int r = r0 + k < M_TOT ? r0 + k : M_TOT - 1; const float* pr = pre_row(p->ws, r);
#pragma unroll
            for (int j = 0; j < 4; ++j) v[k][j] = *(const f32x4*)(pr + 4 * lane + 256 * j); }
#pragma unroll
        for (int k = 0; k < NR; ++k) {
            const int r = r0 + k;
            float s = 0.f;
#pragma unroll
            for (int j = 0; j < 4; ++j) s += (v[k][j][0] + v[k][j][1]) + (v[k][j][2] + v[k][j][3]);
            for (int o = 32; o > 0; o >>= 1) s += __shfl_xor(s, o);
            const float mu = s * (1.0f / 1024.0f);
            float q = 0.f;
#pragma unroll
            for (int j = 0; j < 4; ++j) { const f32x4 d = v[k][j] - mu; q += (d[0] * d[0] + d[1] * d[1]) + (d[2] * d[2] + d[3] * d[3]); }
            for (int o = 32; o > 0; o >>= 1) q += __shfl_xor(q, o);
            const float rstd = rsqrtf(q * (1.0f / 1024.0f) + LN_EPS);
            if (r < M_TOT) {
#pragma unroll
                for (int j = 0; j < 4; ++j) {
                    const f32x4 y = (v[k][j] - mu) * rstd * gv[j] + bv[j];
                    const int cc = 4 * lane + 256 * j;
                    if (l == 0) { typedef unsigned u32x2_t __attribute__((ext_vector_type(2))); u32x2_t o; o.x = cvtpk(y[0], y[1]); o.y = cvtpk(y[2], y[3]);
                                  *(u32x2_t*)((bf16_t*)(p->ws + WS_XB) + (size_t)r * D_MODEL + cc) = o; }
                    else if (r < M_P) *(f32x4*)(p->out + O_YP + (size_t)r * D_MODEL + cc) = y;
                    else *(f32x4*)(p->out + O_YS + (size_t)(r - M_P) * D_MODEL + cc) = y;
                }
            }
        }
    }
}

template <int NBR, class Epi>
__device__ __forceinline__ void piece_gemm(LAS unsigned char* lds, const bf16_t* A0, const bf16_t* A1, const bf16_t* A2, int lda, const bf16_t* Bt, size_t bstride, int K, int row0, int col0, const Epi& epi) {
    int zv = 0; asm volatile("" : "+v"(zv));
    const int tid = (int)threadIdx.x + zv, lane = tid & 63, wave = __builtin_amdgcn_readfirstlane(tid >> 6), c31 = lane & 31, h = lane >> 5;
    LAS float* part = (LAS float*)lds;
    float outv[NBR][4];
    const int kw = K / 8;
#pragma unroll
    for (int br = 0; br < NBR; ++br) {
        const bf16_t* A = br == 0 ? A0 : (br == 1 ? A1 : A2);
        const bf16_t* ap = A + (size_t)(row0 + c31) * lda + wave * kw + 8 * h;
        const bf16_t* bp = Bt + br * bstride + (size_t)(col0 + c31) * K + wave * kw + 8 * h;
        f32x16 acc0 = (f32x16){}, acc1 = (f32x16){};
        for (int k = 0; k < kw; k += 16) {
            const bf16x8 a = *(const bf16x8*)(ap + k), b0 = *(const bf16x8*)(bp + k), b1 = *(const bf16x8*)(bp + (size_t)32 * K + k);
            acc0 = MFMA32(a, b0, acc0); acc1 = MFMA32(a, b1, acc1);
        }
        __syncthreads();
#pragma unroll
        for (int r = 0; r < 16; ++r) { part[((wave * 2 + 0) * 16 + r) * 64 + lane] = acc0[r]; part[((wave * 2 + 1) * 16 + r) * 64 + lane] = acc1[r]; }
        __syncthreads();
#pragma unroll
        for (int e = 0; e < 4; ++e) {
            const int idx = tid + 512 * e;
            float s = 0.f;
#pragma unroll
            for (int w = 0; w < 8; ++w) s += part[w * 2048 + idx];
            outv[br][e] = s;
        }
    }
#pragma unroll
    for (int e = 0; e < 4; ++e) {
        const int idx = tid + 512 * e, nt = idx >> 10, r = (idx >> 6) & 15, ln = idx & 63;
        const int row = row0 + (r & 3) + 8 * (r >> 2) + 4 * (ln >> 5), col = col0 + 32 * nt + (ln & 31);
        float v[NBR];
#pragma unroll
        for (int br = 0; br < NBR; ++br) v[br] = outv[br][e];
        epi(row, col, v);
    }
    __syncthreads();
}
struct PEpiGlu { bf16_t* PROJ; bool dry; __device__ __forceinline__ void operator()(int r, int c, const float (&v)[1]) const {
    bf16_t* rp = PROJ + (size_t)r * IN_COLS; const float z = bf2f(rp[C_UB + c]), gb = bf2f(rp[C_GB + c]);
    if (!dry) rp[C_GB + c] = f2bf(z * sigmoidf_(v[0]) * siluf_(gb)); } };
struct PEpiBranch { bf16_t* PROJ; bool dry; __device__ __forceinline__ void operator()(int r, int c, const float (&v)[3]) const {
    bf16_t* gp = PROJ + (size_t)r * IN_COLS + C_GM + c;
    const float m = sigmoidf_(bf2f(gp[0])) * v[0] + sigmoidf_(bf2f(gp[1024])) * v[1] + sigmoidf_(bf2f(gp[2048])) * v[2];
    if (!dry) gp[0] = f2bf(m); } };
struct PEpiOut { KP p; int l; __device__ __forceinline__ void operator()(int r, int c, const float (&v)[1]) const {
    float x;
    if (l == 0) x = p->in[1][(size_t)(r - M_P) * D_MODEL + c];
    else x = bf2f(((const bf16_t*)(p->ws + WS_XB))[(size_t)r * D_MODEL + c]);
    pre_row(p->ws, r)[c] = DN_ALPHA * x + v[0]; } };

__global__ void __launch_bounds__(NTHREADS, 2) mega_fwd(P p_unused) {
    extern __shared__ __attribute__((aligned(16))) unsigned char lds_raw[];
    LAS unsigned char* lds = (LAS unsigned char*)lds_raw;
    volatile LAS unsigned* misc = (volatile LAS unsigned*)(lds + LDS_MISC);
    if (threadIdx.x < 32) misc[threadIdx.x] = 0u;
    __syncthreads();
    XcdBarrier bar;
    { KP p = get_kp(); bar = xcd_barrier_post((unsigned*)(p->ws + WS_CTL), misc); }

    { KP p = get_kp(); const Ctx c = make_ctx(); unsigned char* dob = (unsigned char*)p->out;
      st_convert_x(p, c);
      st_prologue_weights(p, c, (LAS float*)(lds + c.wave * 9216));
      st_s5_tables(p, c); st_s5_tables2(p, c);
      { bf16_t* LRUW = (bf16_t*)(p->ws + WS_LRUW);
        for (size_t i = c.gt; i < (size_t)DEPTH * 8 * 2 * 64 * 64; i += c.ngt) {
            const int d = (int)(i & 63), e = (int)((i >> 6) & 63), mat = (int)((i >> 12) & 1), ln = (int)(i >> 13);
            LRUW[i] = f2bf(p->in[mat ? 26 : 24][((size_t)ln * 64 + d) * 64 + e]); } } }
    xcd_barrier(bar);

#ifndef PROBE
#define PROBE 0
#endif
#define PROBE_RUN(K, BODY) do { if (PROBE == (K)) { int d_ = 1; asm volatile("" : "+s"(d_)); const bool dry = d_ != 0; BODY; __syncthreads(); } { const bool dry = false; BODY; } } while (0)
#define PH_P1 { KP p = get_kp(); int zs = 0; asm volatile("" : "+s"(zs)); (void)dry; \
          pg8::Gemm g{(const bf16_t*)(p->ws + WS_XB), D_MODEL, (const bf16_t*)((unsigned char*)p->out + DO_WIN) + (size_t)l * IN_COLS * 1024, 1024}; \
          pg8::StaticOrder S; S.init(M_TOT, IN_COLS, (int)gridDim.x + zs, (int)blockIdx.x + zs); \
          pg8::gemm_phase<pg8::EpiProjB, pg8::StaticOrder, true, true>(lds, g, S, pg8::EpiProjB{(bf16_t*)(p->ws + WS_PROJ), IN_COLS}); }
#define PH_SAMPLE { KP p = get_kp(); const Ctx c = make_ctx(); st_s5_sample(p, l, c, lds, dry); st_lru_sample(p, l, c, lds, dry); }
#define PH_SUMM { KP p = get_kp(); const Ctx c = make_ctx(); (void)dry; st_kv_out(p, l, c); st_s5_phaseA(p, l, c); st_lru_mfma<false>(p, l, c, lds, false); }
#define PH_ATTN { __syncthreads(); KP p = get_kp(); st_attn_prompt(p, l, lds, dry); st_attn_sample(p, l, lds, dry); }
#define PH_S5B { KP p = get_kp(); const Ctx c = make_ctx(); st_s5_phaseB(p, l, c, lds, dry); }
#define PH_LRUB { KP p = get_kp(); const Ctx c = make_ctx(); st_lru_mfma<true>(p, l, c, lds, dry); }
#define PH_GLU { KP p = get_kp(); int zs = 0; asm volatile("" : "+s"(zs)); bf16_t* PROJ = (bf16_t*)(p->ws + WS_PROJ); \
          pg8::Gemm g{PROJ + C_UB, IN_COLS, (const bf16_t*)((unsigned char*)p->out + DO_WGLU) + (size_t)l * 512 * 512, 512}; \
          pg8::StaticOrder S; S.init(M_P, 512, (int)gridDim.x + zs, (int)blockIdx.x + zs); \
          pg8::gemm_phase<pg8::EpiGluB, pg8::StaticOrder, true, true>(lds, g, S, pg8::EpiGluB{PROJ, dry}); \
          const int nb_ = (int)gridDim.x + zs, bid_ = (int)blockIdx.x + zs; \
          for (int pc = nb_ - 1 - bid_; pc < 16 * 8; pc += nb_)   \
              piece_gemm<1>(lds, PROJ + C_UB, nullptr, nullptr, IN_COLS, g.Bt, 0, 512, M_P + 32 * (pc >> 3), 64 * (pc & 7), PEpiGlu{PROJ, dry}); }
#define PH_BRANCH { KP p = get_kp(); int zs = 0; asm volatile("" : "+s"(zs)); bf16_t* PROJ = (bf16_t*)(p->ws + WS_PROJ); \
          pg8::Gemm g{PROJ, IN_COLS, (const bf16_t*)((unsigned char*)p->out + DO_WBR) + (size_t)l * 3 * 1024 * 512, 512}; \
          pg8::BranchOrder S; S.init(M_P, 1024, (int)gridDim.x + zs, (int)blockIdx.x + zs); \
          pg8::gemm_phase<pg8::EpiBranchB, pg8::BranchOrder, true, true>(lds, g, S, pg8::EpiBranchB{PROJ, dry}); \
          const int nb_ = (int)gridDim.x + zs, bid_ = (int)blockIdx.x + zs; \
          for (int pc = bid_; pc < 16 * 16; pc += nb_) \
              piece_gemm<3>(lds, PROJ + C_Q, PROJ + C_GB, PROJ + C_GC, IN_COLS, g.Bt, (size_t)1024 * 512, 512, M_P + 32 * (pc >> 4), 64 * (pc & 15), PEpiBranch{PROJ, dry}); }
#define PH_OUT { KP p = get_kp(); int zs = 0; asm volatile("" : "+s"(zs)); bf16_t* PROJ = (bf16_t*)(p->ws + WS_PROJ); (void)dry; \
          pg8::Gemm g{PROJ + C_GM, IN_COLS, (const bf16_t*)(p->ws + WS_WOUT) + (size_t)l * 1024 * 1024, 1024}; \
          pg8::StaticOrder S; S.init(M_P, 1024, (int)gridDim.x + zs, (int)blockIdx.x + zs); \
          pg8::gemm_phase<pg8::EpiOutB, pg8::StaticOrder, true, true>(lds, g, S, pg8::EpiOutB{p->in[0], p->in[1], (const bf16_t*)(p->ws + WS_XB), p->ws, l}); \
          const int nb_ = (int)gridDim.x + zs, bid_ = (int)blockIdx.x + zs; \
          for (int pc = bid_; pc < 16 * 16; pc += nb_) \
              piece_gemm<1>(lds, PROJ + C_GM, nullptr, nullptr, IN_COLS, g.Bt, 0, 1024, M_P + 32 * (pc >> 4), 64 * (pc & 15), PEpiOut{p, l}); }
#define PH_LN { KP p = get_kp(); const Ctx c = make_ctx(); (void)dry; st_ln(p, l, c); }
    for (int l = 0; l < DEPTH; ++l) {
        PROBE_RUN(1, PH_P1);
        xcd_barrier(bar);
        PROBE_RUN(2, PH_SAMPLE);
        PROBE_RUN(3, PH_SUMM);
        PROBE_RUN(4, PH_ATTN);
        xcd_barrier(bar);
        PROBE_RUN(5, PH_S5B);
        PROBE_RUN(6, PH_LRUB);
        xcd_barrier(bar);
        PROBE_RUN(7, PH_GLU);
        xcd_barrier(bar);
        PROBE_RUN(8, PH_BRANCH);
        xcd_barrier(bar);
        PROBE_RUN(9, PH_OUT);
        xcd_barrier(bar);
        PROBE_RUN(10, PH_LN);
        if (l + 1 < DEPTH) xcd_barrier(bar);
    }
}

extern "C" void kernel_launch(void* const* d_in, const int* in_sizes, int n_in, void* d_out, int out_size, void* d_ws, size_t ws_size, hipStream_t stream) {
    static int grid = 0;
    if (grid == 0) {
        if (n_in != 33 || (size_t)out_size != O_END || ws_size < WS_CTL + CTL_BYTES) { fprintf(stderr, "kernel_launch: unexpected sizes n_in %d out %d ws %zu\n", n_in, out_size, ws_size); grid = -1; return; }
        int dev = 0, cus = 0, per_cu = 0;
        if (hipGetDevice(&dev) != hipSuccess || hipDeviceGetAttribute(&cus, hipDeviceAttributeMultiprocessorCount, dev) != hipSuccess) { grid = -1; return; }
        if (hipFuncSetAttribute((const void*)mega_fwd, hipFuncAttributeMaxDynamicSharedMemorySize, LDS_BYTES) != hipSuccess) { fprintf(stderr, "kernel_launch: hipFuncSetAttribute failed\n"); grid = -1; return; }
        if (hipOccupancyMaxActiveBlocksPerMultiprocessor(&per_cu, (const void*)mega_fwd, NTHREADS, LDS_BYTES) != hipSuccess || per_cu < 1) { fprintf(stderr, "kernel_launch: occupancy query says %d blocks/CU\n", per_cu); grid = -1; return; }
        grid = cus;
    }
    if (grid < 0) return;
    (void)hipMemsetAsync((unsigned char*)d_ws + WS_CTL, 0, CTL_BYTES, stream);
    P p{};
    for (int i = 0; i < 33; ++i) p.in[i] = (const float*)d_in[i];
    p.out = (float*)d_out; p.ws = (unsigned char*)d_ws;
    void* args[] = {&p};
    hipError_t e = hipLaunchCooperativeKernel((const void*)mega_fwd, dim3(grid), dim3(NTHREADS), args, LDS_BYTES, stream);
    if (e != hipSuccess) fprintf(stderr, "kernel_launch: cooperative launch failed: %s (grid %d)\n", hipGetErrorString(e), grid);
}
```

```cpp
#include <hip/hip_runtime.h>
#include <cstdint>
#include <cstdio>

typedef unsigned short bf16_t;
typedef short bf16x8 __attribute__((ext_vector_type(8)));
typedef float f32x16 __attribute__((ext_vector_type(16)));
typedef float f32x4 __attribute__((ext_vector_type(4)));

constexpr int D_MODEL = 1024, BATCH = 8, SEQ = 2048, DEPTH = 2, DEC_BATCH = 128, DEC_SEQ = 4;
constexpr int M_P = BATCH * SEQ;
constexpr int M_S = DEC_BATCH * DEC_SEQ;
constexpr int M_TOT = M_P + M_S;
constexpr int IN_COLS = 6400;
constexpr int C_Q = 0, C_GB = 512, C_GC = 1024, C_K = 1536, C_V = 1664, C_GA = 1792, C_UB = 2304, C_XC = 2816, C_GM = 3328;
__host__ __device__ constexpr int colperm32(int n0) {
    return n0 < 512 ? n0 : n0 < 640 ? C_K + (n0 - 512) : n0 < 768 ? C_V + (n0 - 640) : n0 < 1280 ? C_GA + (n0 - 768) : n0 < 1792 ? C_UB + (n0 - 1280)
         : n0 < 2304 ? C_GB + (n0 - 1792) : n0 < 2816 ? C_XC + (n0 - 2304) : n0 < 3328 ? C_GC + (n0 - 2816) : n0; }
constexpr int WINDOW = 128, NKV = 2, HD = 64, NQH = 8;
constexpr int NG = 32, NP = 64, NC = 16;
constexpr float DN_ALPHA = 1.4142135623730951f;
constexpr float LN_EPS = 1e-5f;

constexpr size_t O_YP = 0;
constexpr size_t O_YS = O_YP + (size_t)M_P * D_MODEL;
constexpr size_t O_KP = O_YS + (size_t)M_S * D_MODEL;
constexpr size_t SZ_KP = (size_t)DEPTH * BATCH * WINDOW * NKV * HD;
constexpr size_t O_VP = O_KP + SZ_KP;
constexpr size_t O_SRP = O_VP + SZ_KP;
constexpr size_t SZ_SP = (size_t)DEPTH * BATCH * NG * NP;
constexpr size_t O_SIP = O_SRP + SZ_SP;
constexpr size_t O_LP = O_SIP + SZ_SP;
constexpr size_t SZ_LP = (size_t)DEPTH * BATCH * 512;
constexpr size_t O_CP = O_LP + SZ_LP;
constexpr size_t SZ_CP = (size_t)DEPTH * BATCH * 3 * 512;
constexpr size_t O_KS = O_CP + SZ_CP;
constexpr size_t SZ_KS = (size_t)DEPTH * DEC_BATCH * WINDOW * NKV * HD;
constexpr size_t O_VS = O_KS + SZ_KS;
constexpr size_t O_SRS = O_VS + SZ_KS;
constexpr size_t SZ_SS = (size_t)DEPTH * DEC_BATCH * NG * NP;
constexpr size_t O_SIS = O_SRS + SZ_SS;
constexpr size_t O_LS = O_SIS + SZ_SS;
constexpr size_t SZ_LS = (size_t)DEPTH * DEC_BATCH * 512;
constexpr size_t O_CS = O_LS + SZ_LS;
constexpr size_t SZ_CS = (size_t)DEPTH * DEC_BATCH * 3 * 512;
constexpr size_t O_END = O_CS + SZ_CS;

constexpr size_t WS_PROJ = 0;
constexpr size_t WS_XB = WS_PROJ + (size_t)M_TOT * IN_COLS * 2;
constexpr size_t WS_WOUT = WS_XB + (size_t)M_TOT * D_MODEL * 2;
constexpr size_t WS_TAB = WS_WOUT + (size_t)DEPTH * 1024 * 1024 * 2;
constexpr size_t TAB_AB = 0;
constexpr size_t TAB_BB = TAB_AB + (size_t)DEPTH * NG * NP * 2 * 4;
constexpr size_t TAB_BYTES = TAB_BB + (size_t)DEPTH * NG * NP * NC * 2 * 4;
constexpr size_t WS_S5POW = WS_TAB + TAB_BYTES;
constexpr size_t WS_S5PINV = WS_S5POW + (size_t)DEPTH * NG * 11 * NP * 8;
constexpr size_t WS_S5BCAT = WS_S5PINV + (size_t)DEPTH * NG * 9 * NP * 8;
constexpr size_t WS_S5CCAT = WS_S5BCAT + (size_t)DEPTH * NG * 128 * NC * 2;
constexpr size_t WS_S5SUM = WS_S5CCAT + (size_t)DEPTH * NG * 128 * NC * 2;
constexpr size_t WS_LRUW = WS_S5SUM + (size_t)BATCH * 8 * NG * NP * 8;
constexpr size_t WS_LRSUM = WS_LRUW + (size_t)DEPTH * 8 * 2 * 64 * 64 * 2;
constexpr size_t WS_LSIG = WS_LRSUM + (size_t)BATCH * 32 * 512 * 8;
constexpr size_t WS_END = WS_LSIG + (size_t)DEPTH * 512 * 4;
constexpr size_t DO_WIN = 0;
constexpr size_t DO_WBR = DO_WIN + (size_t)DEPTH * IN_COLS * 1024 * 2;
constexpr size_t DO_WGLU = DO_WBR + (size_t)DEPTH * 3 * 1024 * 512 * 2;
constexpr size_t DO_LRUW = DO_WGLU + (size_t)DEPTH * 512 * 512 * 2;
constexpr size_t DO_END = DO_LRUW;
static_assert(DO_END <= (size_t)M_P * D_MODEL * 4, "weights fit in y_prompt region");
static_assert(WS_END <= 268435456ull, "workspace fits 256 MiB");

__constant__ unsigned char T5_BUCKET[128] = {0, 1, 2, 3, 4, 5, 6, 7, 8, 9, 10, 11, 12, 13, 14, 15, 16, 16, 16, 17, 17, 18, 18, 18, 19, 19, 19, 20, 20, 20, 20, 21, 21, 21, 21, 22, 22, 22, 22, 22, 23, 23, 23, 23, 23, 23, 24, 24, 24, 24, 24, 24, 25, 25, 25, 25, 25, 25, 25, 26, 26, 26, 26, 26, 26, 26, 26, 27, 27, 27, 27, 27, 27, 27, 27, 27, 27, 28, 28, 28, 28, 28, 28, 28, 28, 28, 28, 29, 29, 29, 29, 29, 29, 29, 29, 29, 29, 29, 29, 30, 30, 30, 30, 30, 30, 30, 30, 30, 30, 30, 30, 30, 30, 31, 31, 31, 31, 31, 31, 31, 31, 31, 31, 31, 31, 31, 31, 31};

typedef unsigned u32x4 __attribute__((ext_vector_type(4)));
typedef float f32x2_t __attribute__((ext_vector_type(2)));
typedef __bf16 bf16x2_t __attribute__((ext_vector_type(2)));
__device__ __forceinline__ unsigned cvtpk(float lo, float hi) { f32x2_t v = {lo, hi}; bf16x2_t b = __builtin_convertvector(v, bf16x2_t); return __builtin_bit_cast(unsigned, b); }
__device__ __forceinline__ float bf2f(bf16_t v) { return __uint_as_float(((unsigned)v) << 16); }
__device__ __forceinline__ bf16_t f2bf(float f) { return (bf16_t)cvtpk(f, 0.f); }
__device__ __forceinline__ float sigmoidf_(float x) { return __builtin_amdgcn_rcpf(1.0f + __builtin_amdgcn_exp2f(-1.4426950408889634f * x)); }
__device__ __forceinline__ float siluf_(float x) { return x * sigmoidf_(x); }
__device__ __forceinline__ float gelu_tanh(float y) { return y * sigmoidf_(1.5957691216057308f * (y + 0.044715f * y * y * y)); }

struct P {
    const float* in[33];
    float* out;
    unsigned char* ws;
};

typedef const P __attribute__((address_space(4)))* KP;
__device__ __forceinline__ KP get_kp() { KP k = (KP)__builtin_amdgcn_kernarg_segment_ptr(); asm volatile("" : "+s"(k)); return k; }

constexpr size_t WS_CTL = (WS_END + 4095) & ~(size_t)4095;
constexpr size_t CTL_BYTES = 65536;
static_assert(WS_CTL + CTL_BYTES <= 268435456ull, "workspace fits 256 MiB");
constexpr int NTHREADS = 512, NWAVES = 8;
constexpr int LDS_BYTES = 147456;
constexpr int LDS_MISC = 135168;

#define LAS __attribute__((address_space(3)))
#define XB_TMO      128
#define XB_XCNT(j)  (256  + 64 * (j))
#define XB_XSUB(j)  (1280 + 64 * (j))
#define XB_XGEN(j)  (2304 + 64 * (j))
#define XB_TOP      3328
#define XB_TOPGEN   3392
#define XCD_BAR_WORDS 3456
#define XB_SPIN_CAP (1u << 18)
__device__ __forceinline__ unsigned xb_ld(unsigned* p)              { return __hip_atomic_load(p, __ATOMIC_RELAXED, __HIP_MEMORY_SCOPE_AGENT); }
__device__ __forceinline__ unsigned xb_add(unsigned* p, unsigned v) { return __hip_atomic_fetch_add(p, v, __ATOMIC_RELAXED, __HIP_MEMORY_SCOPE_AGENT); }
__device__ __forceinline__ unsigned xb_xcc_id() { return (unsigned)__builtin_amdgcn_s_getreg((3 << 11) | 20) & 0xFu; }
#define XB_SPIN(cond, bar) do { unsigned _sp = 0; while (cond) { __builtin_amdgcn_s_sleep(1); \
    if ((++_sp & 255u) == 0u) { if (xb_ld(&(bar)[XB_TMO])) break; if (_sp > XB_SPIN_CAP) { atomicAdd(&(bar)[XB_TMO], 1u); break; } } } } while (0)
__device__ __forceinline__ int lane_id0() { return (int)__builtin_amdgcn_mbcnt_hi(~0u, __builtin_amdgcn_mbcnt_lo(~0u, 0u)); }
struct XcdBarrier { unsigned* bar; unsigned x; volatile LAS unsigned* st; int wave_s; };
__device__ __forceinline__ XcdBarrier xcd_barrier_post(unsigned* bar, volatile LAS unsigned* st, int wave_s) {
    XcdBarrier b; b.bar = bar; b.x = xb_xcc_id(); b.st = st; b.wave_s = wave_s;
    if (wave_s == 0 && lane_id0() == 0) (void)xb_add(&bar[XB_XCNT(b.x)], 1u);
    return b;
}
__device__ __forceinline__ void xcd_barrier_complete(unsigned* bar, unsigned x, unsigned& nloc, unsigned& nx) {
    const unsigned G = gridDim.x * gridDim.y * gridDim.z;
    unsigned sum, cnt, mine, sp = 0u;
    for (;;) {
        sum = 0u; cnt = 0u; mine = 0u;
#pragma unroll
        for (unsigned j = 0; j < 16; ++j) { const unsigned c = xb_ld(&bar[XB_XCNT(j)]); sum += c; cnt += (c > 0u) ? 1u : 0u; mine = (j == x) ? c : mine; }
        if (sum == G) break;
        __builtin_amdgcn_s_sleep(1);
        if ((++sp & 255u) == 0u) { if (xb_ld(&bar[XB_TMO])) break; if (sp > XB_SPIN_CAP) { atomicAdd(&bar[XB_TMO], 1u); break; } }
    }
    nloc = mine > 0u ? mine : 1u; nx = cnt > 0u ? cnt : 1u;
}
__device__ __forceinline__ void xcd_barrier(const XcdBarrier& b) {
    asm volatile("s_waitcnt vmcnt(0)" ::: "memory");
    __syncthreads();
    int zb_ = 0; asm volatile("" : "+v"(zb_));
    if (b.wave_s == 0 && (int)__builtin_amdgcn_mbcnt_hi(~0u, __builtin_amdgcn_mbcnt_lo(~0u, (unsigned)zb_)) == 0) {
        unsigned* bar = b.bar; asm volatile("" : "+s"(bar));
        unsigned bx = b.x; asm volatile("" : "+s"(bx));
        __builtin_amdgcn_s_waitcnt(0);
        unsigned nloc = b.st[0], nx = b.st[1];
        if (nloc == 0u) { xcd_barrier_complete(bar, bx, nloc, nx); b.st[0] = nloc; b.st[1] = nx; }
        const unsigned old = xb_add(&bar[XB_XSUB(bx)], 1u);
        const unsigned gen = old / nloc;
        if (old + 1u == (gen + 1u) * nloc) {
            __builtin_amdgcn_fence(__ATOMIC_RELEASE, "agent");
            asm volatile("s_waitcnt vmcnt(0)" ::: "memory");
            const unsigned og = xb_add(&bar[XB_TOP], 1u);
            const unsigned tg = og / nx;
            if (og + 1u == (tg + 1u) * nx) xb_add(&bar[XB_TOPGEN], 1u);
            else XB_SPIN(xb_ld(&bar[XB_TOPGEN]) == tg, bar);
            __builtin_amdgcn_fence(__ATOMIC_ACQUIRE, "agent");
            xb_add(&bar[XB_XGEN(bx)], 1u);
            asm volatile("s_waitcnt vmcnt(0)" ::: "memory");
        } else {
            XB_SPIN(xb_ld(&bar[XB_XGEN(bx)]) == gen, bar);
            __builtin_amdgcn_fence(__ATOMIC_ACQUIRE, "agent");
            asm volatile("s_waitcnt vmcnt(0)" ::: "memory");
        }
    }
    __syncthreads();
}

namespace pg8 {
#define PG8_LAS __attribute__((address_space(3)))
typedef unsigned short bf16_t;
typedef short bf16x8 __attribute__((ext_vector_type(8)));
typedef float f32x4 __attribute__((ext_vector_type(4)));
typedef unsigned u32x4 __attribute__((ext_vector_type(4)));
constexpr int BM = 256, BK = 64, HALF = 128, HTB = HALF * BK * 2  , STAGE_BYTES = 8 * HTB, NXCD = 8, WGM = 8;

__host__ __device__ __forceinline__ int lds_byte(int r, int c) { const int st = (r >> 4) * 2 + (c >> 5), rr = r & 15, cc = c & 31, ob = rr * 64 + cc * 2; return st * 1024 + (ob ^ (((ob >> 9) & 1) << 5)); }
__host__ __device__ __forceinline__ void stage_rc(int b, int& R, int& C) { const int st = b / 1024, sb = b % 1024, swz = sb ^ (((sb >> 9) & 1) << 5); R = (st >> 1) * 16 + swz / 64; C = (st & 1) * 32 + (swz % 64) / 2; }
__host__ __device__ __forceinline__ int perm32(int rho) { const int n = rho >> 4, i = rho & 15; return 8 * (i >> 2) + 4 * n + (i & 3); }

struct Unit { int pm, pn, z; };
struct Gemm { const bf16_t* A; int lda; const bf16_t* Bt; int K; };

struct StaticOrder {
    int nM, nN, nwg, G, c;
    __host__ __device__ void init(int M, int N, int G_, int c_) { nM = M / BM; nN = N / BM; nwg = nM * nN; G = G_; c = c_; }
    __host__ __device__ bool next(int i, Unit& u) const {
        const long L = (long)i * G + c; if (L >= nwg) return false;
        int wgid = (int)L; { const int q = nwg / NXCD, r = nwg % NXCD, xcd = wgid % NXCD, off = wgid / NXCD; wgid = (xcd < r ? xcd * (q + 1) : r * (q + 1) + (xcd - r) * q) + off; }
        const int nig = WGM * nN, gid = wgid / nig, fm = gid * WGM, gsz = (nM - fm) < WGM ? (nM - fm) : WGM;
        u.pm = fm + ((wgid % nig) % gsz); u.pn = (wgid % nig) / gsz; u.z = 0; return true;
    }
    __device__ __forceinline__ size_t a_off(const Unit&) const { return 0; }
    __device__ __forceinline__ size_t b_off(const Unit&) const { return 0; }
    __device__ __forceinline__ void a_ready(const Unit&) const {}
    __device__ __forceinline__ void done(const Unit&) const {}
};

__device__ __forceinline__ unsigned cvt_pk_bf16(float lo, float hi) { unsigned r; asm volatile("v_cvt_pk_bf16_f32 %0, %1, %2" : "=v"(r) : "v"(lo), "v"(hi)); return r; }
typedef float f32x2 __attribute__((ext_vector_type(2)));
__device__ __forceinline__ f32x2 gelu_pk(f32x2 v) {
    const f32x2 av = __builtin_elementwise_abs(v), d = av * 0.2316418882f + 1.0f;
    f32x2 t; t.x = __builtin_amdgcn_rcpf(d.x); t.y = __builtin_amdgcn_rcpf(d.y);
    f32x2 q = t * 0.5307027145f + (-0.7265760135f); q = q * t + 0.7107068705f; q = q * t + (-0.142248368f); q = q * t + 0.127414796f; q = q * t;
    const f32x2 s = (v * v) * (-0.72134752044f);
    f32x2 e; e.x = __builtin_amdgcn_exp2f(s.x); e.y = __builtin_amdgcn_exp2f(s.y);
    const f32x2 m = v * (q * e), r = v - m;
    f32x2 o; o.x = v.x < 0.f ? m.x : r.x; o.y = v.y < 0.f ? m.y : r.y; return o;
}

template <class Epi, class Sched, bool ALIGN_EPI = false, bool SP2 = false>
__device__ __forceinline__ void gemm_phase(PG8_LAS unsigned char* lds, const Gemm g, const Sched& S, const Epi& E, int wave_s) {
    int zv_ = 0; asm volatile("" : "+v"(zv_));
    const int tid = (wave_s << 6) | (int)__builtin_amdgcn_mbcnt_hi(~0u, __builtin_amdgcn_mbcnt_lo(~0u, (unsigned)zv_)), wid = __builtin_amdgcn_readfirstlane(tid >> 6), lane = tid & 63, wr = wid >> 2, wc = wid & 3, fr = lane & 15, fq = lane >> 4;
    const int K = g.K, nt = K / BK;
    unsigned voffA[2], voffB[2];
#pragma unroll
    for (int i = 0; i < 2; ++i) { int R, C; stage_rc(tid * 16 + i * 8192, R, C); const int Rb = Epi::PERM ? ((R & ~31) + perm32(R & 31)) : R;
        voffA[i] = (unsigned)(R * g.lda + C) * 2u; voffB[i] = (unsigned)(Rb * K + C) * 2u; }
    const size_t kstep = (size_t)(BK * 2);
    const size_t hstepA = (size_t)HALF * g.lda * 2, hstepB = (size_t)HALF * K * 2;
    const size_t tstepA = 2 * hstepA, tstepB = 2 * hstepB;
    const unsigned ldsw = (unsigned)wid * 1024u;
    const int aoff = lds_byte(wr * 64 + fr, fq * 8), boff = lds_byte(wc * 32 + fr, fq * 8);
#define PG8_SA(b, h) (((b) * 2 + (h)) * HTB)
#define PG8_SB(b, h) ((4 + (b) * 2 + (h)) * HTB)
#define PG8_STAGE(bufoff, gbase, voff) do { _Pragma("unroll") for (int _i = 0; _i < 2; ++_i) \
        __builtin_amdgcn_global_load_lds((const unsigned*)((const char*)(gbase) + (voff)[_i]), (PG8_LAS unsigned*)(lds + (bufoff) + ldsw + _i * 8192), 16, 0, 0); } while (0)
#define PG8_LDA(dst, b, h) do { _Pragma("unroll") for (int m = 0; m < 4; ++m) _Pragma("unroll") for (int k = 0; k < 2; ++k) dst[m][k] = *(const PG8_LAS bf16x8*)(lds + PG8_SA(b, h) + aoff + m * 2048 + k * 1024); } while (0)
#define PG8_LDB(dst, b, h) do { _Pragma("unroll") for (int n = 0; n < 2; ++n) _Pragma("unroll") for (int k = 0; k < 2; ++k) dst[n][k] = *(const PG8_LAS bf16x8*)(lds + PG8_SB(b, h) + boff + n * 2048 + k * 1024); } while (0)
#define PG8_MMA(ai, bj, At, Bt) do { __builtin_amdgcn_s_setprio(1); _Pragma("unroll") for (int m = 0; m < 4; ++m) _Pragma("unroll") for (int n = 0; n < 2; ++n) _Pragma("unroll") for (int k = 0; k < 2; ++k) \
        acc[ai][bj][m][n] = __builtin_amdgcn_mfma_f32_16x16x32_bf16(Bt[n][k], At[m][k], acc[ai][bj][m][n], 0, 0, 0); __builtin_amdgcn_s_setprio(0); } while (0)
#define PG8_WAIT_V(n) asm volatile("s_waitcnt vmcnt(" #n ")" ::: "memory")
#define PG8_WAIT_L(n) asm volatile("s_waitcnt lgkmcnt(" #n ")" ::: "memory")
#define PG8_BAR __builtin_amdgcn_s_barrier()
#define PG8_SCHED __builtin_amdgcn_sched_barrier(0)
    Unit cur, nxt; int ui = 0;
    if (!S.next(0, cur)) return;
    f32x4 acc[2][2][4][2];
#pragma unroll
    for (int a = 0; a < 2; ++a)
#pragma unroll
        for (int b = 0; b < 2; ++b)
#pragma unroll
            for (int m = 0; m < 4; ++m)
#pragma unroll
                for (int n = 0; n < 2; ++n) acc[a][b][m][n] = (f32x4){0.f, 0.f, 0.f, 0.f};
    bf16x8 At[4][2], B0[2][2], B1[2][2];
    const char* cA = (const char*)g.A + (size_t)cur.pm * tstepA + S.a_off(cur); const char* cB = (const char*)g.Bt + (size_t)cur.pn * tstepB + S.b_off(cur);
    S.a_ready(cur);
    if constexpr (SP2) {
        PG8_STAGE(PG8_SB(0, 0), cB, voffB); PG8_STAGE(PG8_SB(0, 1), cB + hstepB, voffB); PG8_STAGE(PG8_SA(0, 0), cA, voffA); PG8_STAGE(PG8_SA(0, 1), cA + hstepA, voffA);
        if (wr == 1) PG8_BAR;
        PG8_WAIT_V(2); PG8_BAR;
        PG8_STAGE(PG8_SB(1, 0), cB + kstep, voffB); PG8_STAGE(PG8_SA(1, 0), cA + kstep, voffA); PG8_STAGE(PG8_SB(1, 1), cB + hstepB + kstep, voffB);
        PG8_WAIT_V(6); PG8_BAR;
    } else {
        PG8_STAGE(PG8_SB(0, 0), cB, voffB); PG8_STAGE(PG8_SA(0, 0), cA, voffA); PG8_STAGE(PG8_SB(0, 1), cB + hstepB, voffB); PG8_STAGE(PG8_SA(0, 1), cA + hstepA, voffA);
        if (wr == 1) PG8_BAR;
        PG8_WAIT_V(4); PG8_BAR;
        PG8_STAGE(PG8_SB(1, 0), cB + kstep, voffB); PG8_STAGE(PG8_SA(1, 0), cA + kstep, voffA); PG8_STAGE(PG8_SB(1, 1), cB + hstepB + kstep, voffB);
        PG8_WAIT_V(6); PG8_BAR;
    }
    for (;;) {
        const bool has_next = S.next(ui + 1, nxt);
        const char* nA = has_next ? (const char*)g.A + (size_t)nxt.pm * tstepA + S.a_off(nxt) : cA; const char* nB = has_next ? (const char*)g.Bt + (size_t)nxt.pn * tstepB + S.b_off(nxt) : cB;
        for (int t = 0; t < nt; t += 2) {
            if constexpr (Epi::MIDSCALE) { if (t == 8 || t == 16) E.rescale(acc, cur, (t >> 3) - 1, wr, wc, fr, fq); }
            const bool last = (t == nt - 2);
            const char* a1 = cA + (size_t)(t + 1) * kstep;
            const char* a2 = last ? nA : cA + (size_t)(t + 2) * kstep; const char* b2 = last ? nB : cB + (size_t)(t + 2) * kstep;
            const char* a3 = a2 + kstep; const char* b3 = b2 + kstep;
            if (last && has_next) S.a_ready(nxt);
            if constexpr (SP2) {
            PG8_LDB(B0, 0, 0); PG8_LDB(B1, 0, 1); PG8_SCHED; PG8_LDA(At, 0, 0); PG8_STAGE(PG8_SA(1, 1), a1 + hstepA, voffA);
            PG8_WAIT_V(8); PG8_WAIT_L(0); PG8_BAR; PG8_MMA(0, 0, At, B0); PG8_MMA(0, 1, At, B1); PG8_BAR; PG8_SCHED;
            PG8_LDA(At, 0, 1); PG8_STAGE(PG8_SB(0, 0), b2, voffB); PG8_STAGE(PG8_SB(0, 1), b2 + hstepB, voffB); PG8_STAGE(PG8_SA(0, 0), a2, voffA);
            PG8_WAIT_V(8); PG8_WAIT_L(0); PG8_BAR; PG8_MMA(1, 0, At, B0); PG8_MMA(1, 1, At, B1); PG8_BAR; PG8_SCHED;
            PG8_LDB(B0, 1, 0); PG8_LDB(B1, 1, 1); PG8_SCHED; PG8_LDA(At, 1, 0); PG8_STAGE(PG8_SA(0, 1), a2 + hstepA, voffA);
            PG8_WAIT_V(8); PG8_WAIT_L(0); PG8_BAR; PG8_MMA(0, 0, At, B0); PG8_MMA(0, 1, At, B1); PG8_BAR; PG8_SCHED;
            PG8_LDA(At, 1, 1); PG8_STAGE(PG8_SB(1, 0), b3, voffB); PG8_STAGE(PG8_SB(1, 1), b3 + hstepB, voffB); PG8_STAGE(PG8_SA(1, 0), a3, voffA);
            PG8_WAIT_V(8); PG8_WAIT_L(0); PG8_BAR; PG8_MMA(1, 0, At, B0); PG8_MMA(1, 1, At, B1); PG8_BAR; PG8_SCHED;
            } else {
            PG8_LDB(B0, 0, 0); PG8_SCHED; PG8_LDA(At, 0, 0); PG8_STAGE(PG8_SA(1, 1), a1 + hstepA, voffA);
            PG8_WAIT_L(8); PG8_BAR; PG8_WAIT_L(0); PG8_MMA(0, 0, At, B0); PG8_BAR; PG8_SCHED;
            PG8_LDB(B1, 0, 1); PG8_STAGE(PG8_SB(0, 0), b2, voffB);
            PG8_BAR; PG8_WAIT_L(0); PG8_MMA(0, 1, At, B1); PG8_BAR;
            PG8_LDA(At, 0, 1); PG8_STAGE(PG8_SA(0, 0), a2, voffA);
            PG8_BAR; PG8_WAIT_L(0); PG8_MMA(1, 0, At, B0); PG8_BAR; PG8_SCHED;
            PG8_STAGE(PG8_SB(0, 1), b2 + hstepB, voffB);
            PG8_WAIT_V(6); PG8_BAR; PG8_MMA(1, 1, At, B1); PG8_BAR;
            PG8_LDB(B0, 1, 0); PG8_SCHED; PG8_LDA(At, 1, 0); PG8_STAGE(PG8_SA(0, 1), a2 + hstepA, voffA);
            PG8_WAIT_L(8); PG8_BAR; PG8_WAIT_L(0); PG8_MMA(0, 0, At, B0); PG8_BAR; PG8_SCHED;
            PG8_LDB(B1, 1, 1); PG8_STAGE(PG8_SB(1, 0), b3, voffB);
            PG8_BAR; PG8_WAIT_L(0); PG8_MMA(0, 1, At, B1); PG8_BAR;
            PG8_LDA(At, 1, 1); PG8_STAGE(PG8_SA(1, 0), a3, voffA);
            PG8_BAR; PG8_WAIT_L(0); PG8_MMA(1, 0, At, B0); PG8_BAR; PG8_SCHED;
            PG8_STAGE(PG8_SB(1, 1), b3 + hstepB, voffB);
            PG8_WAIT_V(6); PG8_BAR; PG8_MMA(1, 1, At, B1); PG8_BAR;
            }
        }
        if constexpr (ALIGN_EPI) { if (wr == 0) PG8_BAR; }
        if constexpr (!Epi::AFTER_DRAIN) { E(acc, cur, wr, wc, fr, fq); S.done(cur); }
        if (!has_next) break;
#pragma unroll
        for (int a = 0; a < 2; ++a)
#pragma unroll
            for (int b = 0; b < 2; ++b)
#pragma unroll
                for (int m = 0; m < 4; ++m)
#pragma unroll
                    for (int n = 0; n < 2; ++n) acc[a][b][m][n] = (f32x4){0.f, 0.f, 0.f, 0.f};
        cur = nxt; cA = nA; cB = nB; ++ui;
        if constexpr (ALIGN_EPI) { if (wr == 1) PG8_BAR; }
    }
    PG8_WAIT_V(0);
    if constexpr (!ALIGN_EPI) { if (wr == 0) PG8_BAR; }
    PG8_BAR;
    if constexpr (Epi::AFTER_DRAIN) { E.fused(acc, cur, wr, wc, fr, fq, lds, wid, lane); S.done(cur); }
#undef PG8_SA
#undef PG8_SB
#undef PG8_STAGE
#undef PG8_LDA
#undef PG8_LDB
#undef PG8_MMA
#undef PG8_WAIT_V
#undef PG8_WAIT_L
#undef PG8_BAR
#undef PG8_SCHED
}
}

namespace pg8 {
typedef unsigned u32x2 __attribute__((ext_vector_type(2)));
__device__ __forceinline__ float bflo(unsigned w) { return __uint_as_float(w << 16); }
__device__ __forceinline__ float bfhi(unsigned w) { return __uint_as_float(w & 0xffff0000u); }
__device__ __forceinline__ float sigm(float x) { return __builtin_amdgcn_rcpf(1.0f + __builtin_amdgcn_exp2f(-1.4426950408889634f * x)); }
struct EpiProjB {
    static constexpr bool PERM = true, AFTER_DRAIN = false, MIDSCALE = false;
    bf16_t* O; int ldc;
    __device__ __forceinline__ void operator()(const f32x4 (&acc)[2][2][4][2], const Unit& u, int wr, int wc, int fr, int fq) const {
        const int row0 = u.pm * BM + wr * 64 + fr, col0 = u.pn * BM + wc * 32 + 8 * fq;
        const bool gate = u.pn >= C_GM / BM;
#pragma unroll
        for (int ai = 0; ai < 2; ++ai)
#pragma unroll
            for (int m = 0; m < 4; ++m) { bf16_t* rowp = O + (size_t)(row0 + ai * HALF + m * 16) * ldc + col0;
#pragma unroll
                for (int bj = 0; bj < 2; ++bj) { f32x4 v0 = acc[ai][bj][m][0], v1 = acc[ai][bj][m][1];
                    if (gate) {
#pragma unroll
                        for (int e = 0; e < 4; ++e) { v0[e] = 1.0f + __builtin_amdgcn_exp2f(fminf(-1.4426950408889634f * v0[e], 100.f)); v1[e] = 1.0f + __builtin_amdgcn_exp2f(fminf(-1.4426950408889634f * v1[e], 100.f)); } }
                    u32x4 w; w.x = cvt_pk_bf16(v0[0], v0[1]); w.y = cvt_pk_bf16(v0[2], v0[3]); w.z = cvt_pk_bf16(v1[0], v1[1]); w.w = cvt_pk_bf16(v1[2], v1[3]);
                    *(u32x4*)(rowp + bj * HALF) = w; } }
    }
};
struct EpiGluB {
    static constexpr bool PERM = true, AFTER_DRAIN = false, MIDSCALE = false;
    bf16_t* PROJ; bool dry;
    __device__ __forceinline__ void operator()(const f32x4 (&acc)[2][2][4][2], const Unit& u, int wr, int wc, int fr, int fq) const {
        const int row0 = u.pm * BM + wr * 64 + fr, col0 = u.pn * BM + wc * 32 + 8 * fq;
        u32x4 zz[2][2][2], gg[2][2][2];
#define GL_ISSUE(g) do { const int ai_ = (g) >> 1, m0_ = 2 * ((g) & 1); _Pragma("unroll") for (int mm = 0; mm < 2; ++mm) { \
            const bf16_t* rowp = PROJ + (size_t)(row0 + ai_ * HALF + (m0_ + mm) * 16) * IN_COLS + col0; \
            _Pragma("unroll") for (int bj = 0; bj < 2; ++bj) { zz[(g) & 1][mm][bj] = *(const u32x4*)(rowp + C_UB + bj * HALF); gg[(g) & 1][mm][bj] = *(const u32x4*)(rowp + C_GB + bj * HALF); } } } while (0)
        GL_ISSUE(0);
#pragma unroll
        for (int ah = 0; ah < 4; ++ah) { const int ai = ah >> 1, m0 = 2 * (ah & 1);
            if (ah + 1 < 4) GL_ISSUE(ah + 1);
            __builtin_amdgcn_sched_barrier(0);
#pragma unroll
            for (int mm = 0; mm < 2; ++mm) { const int m = m0 + mm; bf16_t* rowp = PROJ + (size_t)(row0 + ai * HALF + m * 16) * IN_COLS + col0;
#pragma unroll
                for (int bj = 0; bj < 2; ++bj) {
                    const f32x4 v0 = acc[ai][bj][m][0], v1 = acc[ai][bj][m][1];
                    float o[8];
#pragma unroll
                    for (int e = 0; e < 4; ++e) {
                        const float va = e < 2 ? v0[2 * e] : v1[2 * (e - 2)], vb = e < 2 ? v0[2 * e + 1] : v1[2 * (e - 2) + 1];
                        const unsigned wz = zz[ah & 1][mm][bj][e], wg = gg[ah & 1][mm][bj][e];
                        const float za = bflo(wz), zb = bfhi(wz), ga = bflo(wg), gb = bfhi(wg);
                        o[2 * e] = za * sigm(va) * ga * sigm(ga); o[2 * e + 1] = zb * sigm(vb) * gb * sigm(gb);
                    }
                    u32x4 w; w.x = cvt_pk_bf16(o[0], o[1]); w.y = cvt_pk_bf16(o[2], o[3]); w.z = cvt_pk_bf16(o[4], o[5]); w.w = cvt_pk_bf16(o[6], o[7]);
                    if (!dry) *(u32x4*)(rowp + C_GB + bj * HALF) = w; } }
        }
#undef GL_ISSUE
    }
};
#ifndef RS_DEPTH
#define RS_DEPTH 1
#endif
struct EpiMergeB {
    static constexpr bool PERM = true, AFTER_DRAIN = false, MIDSCALE = true;
    bf16_t* PROJ; bool dry;
    __device__ __forceinline__ void rescale(f32x4 (&acc)[2][2][4][2], const Unit& u, int step, int wr, int wc, int fr, int fq) const {
        int zr = 0; asm volatile("" : "+v"(zr));
        const int row0 = u.pm * BM + wr * 64 + fr + zr, col0 = u.pn * BM + wc * 32 + 8 * fq;
        constexpr int DEPTH_ = RS_DEPTH;
        u32x4 ga[DEPTH_ + 1][2][2], gb[DEPTH_ + 1][2][2];
#define RS_ISSUE(g) do { const int ai_ = (g) >> 1, m0_ = 2 * ((g) & 1); _Pragma("unroll") for (int mm = 0; mm < 2; ++mm) { \
            const bf16_t* rowp = PROJ + (size_t)(row0 + ai_ * HALF + (m0_ + mm) * 16) * IN_COLS + C_GM + step * 1024 + col0; \
            _Pragma("unroll") for (int bj = 0; bj < 2; ++bj) { ga[(g) % (DEPTH_ + 1)][mm][bj] = *(const u32x4*)(rowp + bj * HALF); gb[(g) % (DEPTH_ + 1)][mm][bj] = *(const u32x4*)(rowp + 1024 + bj * HALF); } } } while (0)
#pragma unroll
        for (int g = 0; g < DEPTH_; ++g) RS_ISSUE(g);
#pragma unroll
        for (int ah = 0; ah < 4; ++ah) { const int ai = ah >> 1, m0 = 2 * (ah & 1);
            if (ah + DEPTH_ < 4) RS_ISSUE(ah + DEPTH_);
            __builtin_amdgcn_sched_barrier(0);
#pragma unroll
            for (int mm = 0; mm < 2; ++mm)
#pragma unroll
                for (int bj = 0; bj < 2; ++bj)
#pragma unroll
                    for (int e = 0; e < 4; ++e) { const int m = m0 + mm; const unsigned wa = ga[ah % (DEPTH_ + 1)][mm][bj][e], wb = gb[ah % (DEPTH_ + 1)][mm][bj][e];
                        const float r0 = bflo(wb) * __builtin_amdgcn_rcpf(bflo(wa)), r1 = bfhi(wb) * __builtin_amdgcn_rcpf(bfhi(wa));
                        if (e < 2) { acc[ai][bj][m][0][2 * e] *= r0; acc[ai][bj][m][0][2 * e + 1] *= r1; } else { acc[ai][bj][m][1][2 * (e - 2)] *= r0; acc[ai][bj][m][1][2 * (e - 2) + 1] *= r1; }
                    }
        }
#undef RS_ISSUE
    }
    __device__ __forceinline__ void operator()(const f32x4 (&acc)[2][2][4][2], const Unit& u, int wr, int wc, int fr, int fq) const {
        const int row0 = u.pm * BM + wr * 64 + fr, col0 = u.pn * BM + wc * 32 + 8 * fq;
        u32x4 gg[2][4][2];
#pragma unroll
        for (int ai = 0; ai < 2; ++ai)
#pragma unroll
            for (int m = 0; m < 4; ++m) { const bf16_t* rowp = PROJ + (size_t)(row0 + ai * HALF + m * 16) * IN_COLS + C_GM + 2048 + col0;
#pragma unroll
                for (int bj = 0; bj < 2; ++bj) gg[ai][m][bj] = *(const u32x4*)(rowp + bj * HALF); }
        __builtin_amdgcn_sched_barrier(0);
#pragma unroll
        for (int ai = 0; ai < 2; ++ai)
#pragma unroll
            for (int m = 0; m < 4; ++m) { bf16_t* rowp = PROJ + (size_t)(row0 + ai * HALF + m * 16) * IN_COLS + C_GM + col0;
#pragma unroll
                for (int bj = 0; bj < 2; ++bj) {
                    const f32x4 v0 = acc[ai][bj][m][0], v1 = acc[ai][bj][m][1];
                    float o[8];
#pragma unroll
                    for (int e = 0; e < 4; ++e) {
                        const float va = e < 2 ? v0[2 * e] : v1[2 * (e - 2)], vb = e < 2 ? v0[2 * e + 1] : v1[2 * (e - 2) + 1];
                        o[2 * e] = __builtin_amdgcn_rcpf(bflo(gg[ai][m][bj][e])) * va; o[2 * e + 1] = __builtin_amdgcn_rcpf(bfhi(gg[ai][m][bj][e])) * vb;
                    }
                    u32x4 w; w.x = cvt_pk_bf16(o[0], o[1]); w.y = cvt_pk_bf16(o[2], o[3]); w.z = cvt_pk_bf16(o[4], o[5]); w.w = cvt_pk_bf16(o[6], o[7]);
                    if (!dry) *(u32x4*)(rowp + bj * HALF) = w; } }
    }
};
struct EpiOutB {
    static constexpr bool PERM = true, AFTER_DRAIN = false, MIDSCALE = false;
    const bf16_t* XB; unsigned char* ws;
    __device__ __forceinline__ void operator()(const f32x4 (&acc)[2][2][4][2], const Unit& u, int wr, int wc, int fr, int fq) const {
        const int row0 = u.pm * BM + wr * 64 + fr, col0 = u.pn * BM + wc * 32 + 8 * fq;
        u32x4 xx[2][4][2];
#pragma unroll
        for (int ai = 0; ai < 2; ++ai)
#pragma unroll
            for (int m = 0; m < 4; ++m) { const bf16_t* xrow = XB + (size_t)(row0 + ai * HALF + m * 16) * D_MODEL + col0;
#pragma unroll
                for (int bj = 0; bj < 2; ++bj) xx[ai][m][bj] = *(const u32x4*)(xrow + bj * HALF); }
        __builtin_amdgcn_sched_barrier(0);
#pragma unroll
        for (int ai = 0; ai < 2; ++ai)
#pragma unroll
            for (int m = 0; m < 4; ++m) { const int r = row0 + ai * HALF + m * 16;
                float* prow = (float*)(ws + WS_PROJ + (size_t)r * IN_COLS * 2 + (size_t)(C_GM + 1024) * 2) + col0;
#pragma unroll
                for (int bj = 0; bj < 2; ++bj) { const u32x4 w = xx[ai][m][bj];
                    *(f32x4*)(prow + bj * HALF)     = (f32x4){bflo(w.x), bfhi(w.x), bflo(w.y), bfhi(w.y)} * DN_ALPHA + acc[ai][bj][m][0];
                    *(f32x4*)(prow + bj * HALF + 4) = (f32x4){bflo(w.z), bfhi(w.z), bflo(w.w), bfhi(w.w)} * DN_ALPHA + acc[ai][bj][m][1]; } }
    }
};
}

__device__ __forceinline__ int lane_id() { return (int)__builtin_amdgcn_mbcnt_hi(~0u, __builtin_amdgcn_mbcnt_lo(~0u, 0u)); }
__device__ __forceinline__ int tid_of(int wave_s, int zv) { return (wave_s << 6) | (int)__builtin_amdgcn_mbcnt_hi(~0u, __builtin_amdgcn_mbcnt_lo(~0u, (unsigned)zv)); }
struct Halves { float lo, hi; };
__device__ __forceinline__ Halves halves(float v) { const unsigned u = __float_as_uint(v); auto rr = __builtin_amdgcn_permlane32_swap(u, u, false, false); return Halves{__uint_as_float(rr[0]), __uint_as_float(rr[1])}; }
template <int O> __device__ __forceinline__ float xor_lane(float v) { return __int_as_float(__builtin_amdgcn_ds_swizzle(__float_as_int(v), (O << 10) | 0x1F)); }
__device__ __forceinline__ float wave_sum(float v) { v += xor_lane<1>(v); v += xor_lane<2>(v); v += xor_lane<4>(v); v += xor_lane<8>(v); v += xor_lane<16>(v); const Halves hh = halves(v); return hh.lo + hh.hi; }
struct Ctx { int tid, lane, wave, gw, ngw; size_t gt, ngt; };
__device__ __forceinline__ Ctx make_ctx(int wave_s) {
    int zv = 0; asm volatile("" : "+v"(zv)); int zs = 0; asm volatile("" : "+s"(zs));
    Ctx c; c.tid = tid_of(wave_s, zv); c.lane = c.tid & 63; c.wave = __builtin_amdgcn_readfirstlane(c.tid >> 6);
    const int bid = (int)blockIdx.x + zs, nb = (int)gridDim.x + zs;
    c.gw = c.wave * nb + bid; c.ngw = nb * NWAVES; c.gt = (size_t)bid * NTHREADS + c.tid; c.ngt = (size_t)nb * NTHREADS; return c;
}
__device__ __forceinline__ Ctx group_ctx(const Ctx& c, int w0, int nw) {
    Ctx g = c; const int nb = c.ngw / NWAVES, bid = c.gw - c.wave * nb; g.gw = (c.wave - w0) * nb + bid; g.ngw = nw * nb; return g; }
__device__ __forceinline__ Ctx waveset_ctx(const Ctx& c, int rank, int size) {
    Ctx g = c; const int nb = c.ngw / NWAVES, bid = c.gw - c.wave * nb; g.gw = rank * nb + bid; g.ngw = size * nb; return g; }
#define WAVE_LDS_SYNC() do { asm volatile("s_waitcnt lgkmcnt(0)" ::: "memory"); __builtin_amdgcn_wave_barrier(); } while (0)

__device__ __forceinline__ void st_convert_x(KP p, const Ctx& c) {
    u32x4* XB = (u32x4*)(p->ws + WS_XB);
    const size_t n8 = (size_t)M_TOT * D_MODEL / 8, np8 = (size_t)M_P * D_MODEL / 8;
    for (size_t i0 = c.gt; i0 < n8; i0 += 4 * c.ngt) {
        f32x4 a[4], b[4];
#pragma unroll
        for (int u = 0; u < 4; ++u) { const size_t i = i0 + u * c.ngt; if (i < n8) { const f32x4* src = i < np8 ? (const f32x4*)p->in[0] + 2 * i : (const f32x4*)p->in[1] + 2 * (i - np8); a[u] = src[0]; b[u] = src[1]; } }
#pragma unroll
        for (int u = 0; u < 4; ++u) { const size_t i = i0 + u * c.ngt; if (i < n8) { u32x4 o; o.x = cvtpk(a[u][0], a[u][1]); o.y = cvtpk(a[u][2], a[u][3]); o.z = cvtpk(b[u][0], b[u][1]); o.w = cvtpk(b[u][2], b[u][3]); XB[i] = o; } }
    }
}

__device__ __forceinline__ unsigned pk2bf(float lo, float hi) { return (unsigned)f2bf(lo) | ((unsigned)f2bf(hi) << 16); }
__device__ __forceinline__ void p0_transpose_item(const float* W, int K, int N, bf16_t* WT, int ldk, int koff, bool perm, LAS float* scr, int item, int lane) {
    const int nblk = N / 32, kb = item / nblk, nb = item % nblk, k0 = 64 * kb, n0 = 32 * nb, d0 = perm ? colperm32(n0) : n0;
    float wv[32];
#pragma unroll
    for (int i = 0; i < 32; ++i) wv[i] = W[(size_t)(k0 + 2 * i + (lane >> 5)) * N + n0 + (lane & 31)];
#pragma unroll
    for (int i = 0; i < 32; ++i) scr[(2 * i + (lane >> 5)) * 33 + (lane & 31)] = wv[i];
    WAVE_LDS_SYNC();
    const int cch = lane & 7;
#pragma unroll
    for (int j = 0; j < 4; ++j) { const int n = (lane >> 3) + 8 * j; const LAS float* sp = scr + (8 * cch) * 33 + n;
        u32x4 o; o.x = pk2bf(sp[0 * 33], sp[1 * 33]); o.y = pk2bf(sp[2 * 33], sp[3 * 33]); o.z = pk2bf(sp[4 * 33], sp[5 * 33]); o.w = pk2bf(sp[6 * 33], sp[7 * 33]);
        *(u32x4*)(WT + (size_t)(d0 + n) * ldk + koff + k0 + 8 * cch) = o; }
    WAVE_LDS_SYNC();
}
__device__ __forceinline__ void st_prologue_weights(KP p, const Ctx& c, LAS float* scr, int l_lo, int l_hi) {
    unsigned char* dob = (unsigned char*)p->out;
    constexpr int I_IN = 16 * 200, I_BR = 8 * 32, I_GLU = 8 * 16, I_OUT = 16 * 32, I_LAYER = I_IN + 3 * I_BR + I_GLU + I_OUT;
    for (int it = l_lo * I_LAYER + c.gw; it < l_hi * I_LAYER; it += c.ngw) {
        const int l = it / I_LAYER; int r = it % I_LAYER;
        if (r < I_IN) { p0_transpose_item(p->in[9] + (size_t)l * 1024 * IN_COLS, 1024, IN_COLS, (bf16_t*)(dob + DO_WIN) + (size_t)l * IN_COLS * 1024, 1024, 0, true, scr, r, c.lane); continue; } r -= I_IN;
        if (r < I_BR) { p0_transpose_item(p->in[11] + (size_t)l * 512 * 1024, 512, 1024, (bf16_t*)(dob + DO_WBR) + (size_t)l * 1024 * 1536, 1536, 0, false, scr, r, c.lane); continue; } r -= I_BR;
        if (r < I_BR) { p0_transpose_item(p->in[21] + (size_t)l * 512 * 1024, 512, 1024, (bf16_t*)(dob + DO_WBR) + (size_t)l * 1024 * 1536, 1536, 512, false, scr, r, c.lane); continue; } r -= I_BR;
        if (r < I_BR) { p0_transpose_item(p->in[29] + (size_t)l * 512 * 1024, 512, 1024, (bf16_t*)(dob + DO_WBR) + (size_t)l * 1024 * 1536, 1536, 1024, false, scr, r, c.lane); continue; } r -= I_BR;
        if (r < I_GLU) { p0_transpose_item(p->in[20] + (size_t)l * 512 * 512, 512, 512, (bf16_t*)(dob + DO_WGLU) + (size_t)l * 512 * 512, 512, 0, false, scr, r, c.lane); continue; } r -= I_GLU;
        p0_transpose_item(p->in[30] + (size_t)l * 1024 * 1024, 1024, 1024, (bf16_t*)(p->ws + WS_WOUT) + (size_t)l * 1024 * 1024, 1024, 0, false, scr, r, c.lane);
    }
}
__device__ __forceinline__ f32x4 ld_bf4(const bf16_t* q) { typedef unsigned u32x2_t __attribute__((ext_vector_type(2))); const u32x2_t w = *(const u32x2_t*)q;
    return (f32x4){__uint_as_float(w.x << 16), __uint_as_float(w.x & 0xffff0000u), __uint_as_float(w.y << 16), __uint_as_float(w.y & 0xffff0000u)}; }
__device__ __forceinline__ void st_kv_out(KP p, int l, const Ctx& c) {
    const bf16_t* PROJ = (const bf16_t*)(p->ws + WS_PROJ);
    for (size_t ii = c.gt; ii < (size_t)BATCH * 3 * 128; ii += c.ngt) {
        const int i = (int)ii, b = i / 384, j = (i / 128) % 3, c4 = i % 128;
        *(f32x4*)(p->out + O_CP + (size_t)l * BATCH * 1536 + (size_t)i * 4) = ld_bf4(PROJ + ((size_t)b * SEQ + SEQ - 3 + j) * IN_COLS + C_XC + 4 * c4);
    }
    for (size_t ii = c.gt; ii < (size_t)DEC_BATCH * 3 * 128; ii += c.ngt) {
        const int i = (int)ii, b = i / 384, j = (i / 128) % 3, c4 = i % 128;
        *(f32x4*)(p->out + O_CS + (size_t)l * DEC_BATCH * 1536 + (size_t)i * 4) = ld_bf4(PROJ + ((size_t)M_P + 4 * b + 1 + j) * IN_COLS + C_XC + 4 * c4);
    }
    for (size_t ii = c.gt; ii < (size_t)BATCH * WINDOW * 32; ii += c.ngt) {
        const int i = (int)ii, b = i / (WINDOW * 32), w = (i / 32) % WINDOW, c4 = i % 32;
        const bf16_t* src = PROJ + ((size_t)b * SEQ + (SEQ - WINDOW) + w) * IN_COLS + 4 * c4;
        *(f32x4*)(p->out + O_KP + (size_t)l * BATCH * WINDOW * 128 + (size_t)i * 4) = ld_bf4(src + C_K);
        *(f32x4*)(p->out + O_VP + (size_t)l * BATCH * WINDOW * 128 + (size_t)i * 4) = ld_bf4(src + C_V);
    }
    for (size_t ii = c.gt; ii < (size_t)DEC_BATCH * DEC_SEQ * 32; ii += c.ngt) {
        const int i = (int)ii, b = i / (DEC_SEQ * 32), t = (i / 32) % DEC_SEQ, c4 = i % 32;
        const bf16_t* src = PROJ + ((size_t)M_P + b * DEC_SEQ + t) * IN_COLS + 4 * c4;
        const size_t o = (((size_t)l * DEC_BATCH + b) * WINDOW + (WINDOW - DEC_SEQ) + t) * 128 + 4 * c4;
        *(f32x4*)(p->out + O_KS + o) = ld_bf4(src + C_K); *(f32x4*)(p->out + O_VS + o) = ld_bf4(src + C_V);
    }
    constexpr int NSH = DEC_BATCH * (WINDOW - DEC_SEQ) * 32;
    for (size_t i0 = c.gt; i0 < (size_t)NSH; i0 += 4 * c.ngt) {
        f32x4 kk[4], vv[4];
#pragma unroll
        for (int u = 0; u < 4; ++u) { const size_t ii = i0 + u * c.ngt; if (ii < (size_t)NSH) { const int i = (int)ii, b = i / ((WINDOW - DEC_SEQ) * 32), r = i % ((WINDOW - DEC_SEQ) * 32);
            const size_t ci = (((size_t)l * DEC_BATCH + b) * WINDOW + DEC_SEQ) * 128 + (size_t)r * 4; kk[u] = *(const f32x4*)(p->in[2] + ci); vv[u] = *(const f32x4*)(p->in[3] + ci); } }
#pragma unroll
        for (int u = 0; u < 4; ++u) { const size_t ii = i0 + u * c.ngt; if (ii < (size_t)NSH) { const int i = (int)ii, b = i / ((WINDOW - DEC_SEQ) * 32), r = i % ((WINDOW - DEC_SEQ) * 32);
            const size_t o = ((size_t)l * DEC_BATCH + b) * WINDOW * 128 + (size_t)r * 4; *(f32x4*)(p->out + O_KS + o) = kk[u]; *(f32x4*)(p->out + O_VS + o) = vv[u]; } }
    }
}

typedef short s16x4 __attribute__((ext_vector_type(4)));
typedef short v4i16_t __attribute__((ext_vector_type(4)));
__device__ __forceinline__ bf16x8 pack8(float a0, float a1, float a2, float a3, float a4, float a5, float a6, float a7) {
    u32x4 p; p.x = cvtpk(a0, a1); p.y = cvtpk(a2, a3); p.z = cvtpk(a4, a5); p.w = cvtpk(a6, a7); return __builtin_bit_cast(bf16x8, p); }
__device__ __forceinline__ s16x4 tr_read(LAS const unsigned char* p) { return __builtin_bit_cast(s16x4, __builtin_amdgcn_ds_read_tr16_b64_v4i16((LAS v4i16_t*)p)); }
__device__ __forceinline__ bf16x8 cat8(s16x4 lo, s16x4 hi) { return __builtin_shufflevector(lo, hi, 0, 1, 2, 3, 4, 5, 6, 7); }
#define MFMA_SETTLE2(a, b) asm volatile("s_nop 15\n\ts_nop 7" : "+v"(a), "+v"(b))
#define MFMA_SETTLE3(a, b, c) asm volatile("s_nop 15\n\ts_nop 7" : "+v"(a), "+v"(b), "+v"(c))
#define MFMA32(a, b, c) __builtin_amdgcn_mfma_f32_32x32x16_bf16((a), (b), (c), 0, 0, 0)
#define MFMA16(a, b, c) __builtin_amdgcn_mfma_f32_16x16x32_bf16((a), (b), (c), 0, 0, 0)

constexpr int AT_KSTR = 144, AT_VSTR = 192;
constexpr int AT_K = 0, AT_V = AT_K + 256 * AT_KSTR, AT_BIAS = AT_V + 256 * AT_VSTR, AT_WS = AT_BIAS + 4 * 128 * 4, AT_END = AT_WS + 8 * 256;
static_assert(AT_END <= 131072, "attention LDS");

__device__ __forceinline__ void st_attn_prompt(KP p, int l, LAS unsigned char* lds, bool dry, int wave_s) {
    int zv = 0; asm volatile("" : "+v"(zv));
    const int tid = tid_of(wave_s, zv), lane = tid & 63, wave = __builtin_amdgcn_readfirstlane(tid >> 6);
    const int c31 = lane & 31, h = lane >> 5;
    bf16_t* PROJ = (bf16_t*)(p->ws + WS_PROJ);
    const float* rel_bias = p->in[8];
    for (int item = blockIdx.x; item < BATCH * 16 * NKV; item += gridDim.x) {
        const int b = item / 32, nb = (item >> 1) & 15, kvh = item & 1;
        const size_t rowq0 = (size_t)b * SEQ + (size_t)nb * 128;
#pragma unroll
        for (int i = 0; i < 4; ++i) {
            const int id = tid + 512 * i, row = id >> 3, pc = id & 7;
            u32x4 kk = (u32x4){0u, 0u, 0u, 0u}, vv = kk;
            if (nb > 0 || row >= 128) {
                const bf16_t* src = PROJ + (rowq0 - 128 + row) * IN_COLS + kvh * 64 + pc * 8;
                kk = *(const u32x4*)(src + C_K); vv = *(const u32x4*)(src + C_V);
            }
            *(LAS u32x4*)(lds + AT_K + row * AT_KSTR + pc * 16) = kk;
            *(LAS u32x4*)(lds + AT_V + row * AT_VSTR + pc * 16) = vv;
        }
        { const int g = tid >> 7, d = tid & 127; ((LAS float*)(lds + AT_BIAS))[tid] = rel_bias[T5_BUCKET[d] * NQH + kvh * 4 + g]; }
        const int g = wave >> 1, hq = kvh * 4 + g;
        bf16x8 qfn[4];
        { const bf16_t* qp = PROJ + (rowq0 + 64 * (wave & 1) + c31) * IN_COLS + C_Q + hq * 64 + 8 * h;
#pragma unroll
          for (int ks = 0; ks < 4; ++ks) qfn[ks] = *(const bf16x8*)(qp + 16 * ks); }
        __syncthreads();
        const float sink = p->in[10][l * NQH + hq];
        LAS const float* biasd = (LAS const float*)(lds + AT_BIAS) + g * 128;
        LAS float* wsf = (LAS float*)(lds + AT_WS + wave * 256);
#pragma unroll 1
        for (int qi = 0; qi < 2; ++qi) {
            const int qt = 2 * (wave & 1) + qi, q0 = 32 * qt;
            bf16x8 qf[4];
#pragma unroll
            for (int ks = 0; ks < 4; ++ks) qf[ks] = qfn[ks];
            if (qi == 0) { const bf16_t* qp = PROJ + (rowq0 + q0 + 32 + c31) * IN_COLS + C_Q + hq * 64 + 8 * h;
#pragma unroll
                for (int ks = 0; ks < 4; ++ks) qfn[ks] = *(const bf16x8*)(qp + 16 * ks); }
            f32x16 S[5];
#pragma unroll
            for (int j = 0; j < 5; ++j) {
                S[j] = (f32x16){};
                LAS const unsigned char* kp = lds + AT_K + (32 * (qt + j) + c31) * AT_KSTR + 16 * h;
#pragma unroll
                for (int ks = 0; ks < 4; ++ks) S[j] = MFMA32(*(LAS const bf16x8*)(kp + 32 * ks), qf[ks], S[j]);
            }
            asm volatile("s_nop 15\n\ts_nop 7" : "+v"(S[0]), "+v"(S[1]), "+v"(S[2]), "+v"(S[3]), "+v"(S[4]));
            float gav[16][2];
#pragma unroll
            for (int r = 0; r < 16; ++r) {
                const bf16_t* rowp = PROJ + (rowq0 + q0 + (r & 3) + 8 * (r >> 2) + 4 * h) * IN_COLS + hq * 64 + c31;
                gav[r][0] = bf2f(rowp[C_GA]); gav[r][1] = bf2f(rowp[C_GA + 32]);
            }
            const int iq = q0 + c31;
            float mx = sink;
#pragma unroll
            for (int j = 0; j < 5; ++j)
#pragma unroll
                for (int r = 0; r < 16; ++r) {
                    const int kv = 32 * (qt + j) + (r & 3) + 8 * (r >> 2) + 4 * h;
                    const int dist = iq + 128 - kv;
                    const bool ok = (dist >= 0) && (dist < 128) && (nb > 0 || kv >= 128);
                    const float s = ok ? S[j][r] * 0.125f + biasd[dist & 127] : -1e30f;
                    S[j][r] = s; mx = fmaxf(mx, s);
                }
            { const Halves hh = halves(mx); mx = fmaxf(hh.lo, hh.hi); }
            float sum = 0.f;
#pragma unroll
            for (int j = 0; j < 5; ++j)
#pragma unroll
                for (int r = 0; r < 16; ++r) { const float e = S[j][r] > -1e29f ? __expf(S[j][r] - mx) : 0.f; S[j][r] = e; sum += e; }
            { const Halves hh = halves(sum); sum = hh.lo + hh.hi; }
            const float rden = 1.0f / (sum + __expf(sink - mx));
            if (h == 0) wsf[c31] = rden;
            f32x16 O[2]; O[0] = (f32x16){}; O[1] = (f32x16){};
            const int i16 = lane & 15, qq = i16 >> 2, pp = i16 & 3, blk = (lane >> 4) & 1;
#pragma unroll
            for (int j = 0; j < 5; ++j)
#pragma unroll
                for (int s = 0; s < 2; ++s) {
                    const bf16x8 pf = pack8(S[j][8 * s], S[j][8 * s + 1], S[j][8 * s + 2], S[j][8 * s + 3], S[j][8 * s + 4], S[j][8 * s + 5], S[j][8 * s + 6], S[j][8 * s + 7]);
                    LAS const unsigned char* vp = lds + AT_V + (32 * (qt + j) + 16 * s + 4 * h + qq) * AT_VSTR + (16 * blk + 4 * pp) * 2;
#pragma unroll
                    for (int dt = 0; dt < 2; ++dt) {
                        const bf16x8 vf = cat8(tr_read(vp + dt * 64), tr_read(vp + dt * 64 + 8 * AT_VSTR));
                        O[dt] = MFMA32(pf, vf, O[dt]);
                    }
                }
            MFMA_SETTLE2(O[0], O[1]);
            WAVE_LDS_SYNC();
#pragma unroll
            for (int r = 0; r < 16; ++r) {
                const int qr = (r & 3) + 8 * (r >> 2) + 4 * h;
                const float rd = wsf[qr];
                bf16_t* rowp = PROJ + (rowq0 + q0 + qr) * IN_COLS + hq * 64 + c31;
#pragma unroll
                for (int dt = 0; dt < 2; ++dt) if (!dry) rowp[C_Q + 32 * dt] = f2bf(O[dt][r] * rd * siluf_(gav[r][dt]));
            }
            WAVE_LDS_SYNC();
        }
        __syncthreads();
    }
}

constexpr int S5_NPOW = 11, S5_NINV = 9, S5_NSEG = 8, S5_SEGLEN = 256;
__device__ __forceinline__ float neg_expm1_small(float y) {
    float q = 1.0f / 5040.0f; q = q * y + 1.0f / 720.0f; q = q * y + 1.0f / 120.0f; q = q * y + 1.0f / 24.0f; q = q * y + 1.0f / 6.0f; q = q * y + 0.5f; q = q * y + 1.0f; return -(q * y);
}
__device__ __forceinline__ f32x2_t cmul(f32x2_t a, f32x2_t b) { return (f32x2_t){a.x * b.x - a.y * b.y, a.x * b.y + a.y * b.x}; }

__device__ __forceinline__ void st_s5_tables2(KP p, const Ctx& c) {
    f32x2_t* POW = (f32x2_t*)(p->ws + WS_S5POW); f32x2_t* PINV = (f32x2_t*)(p->ws + WS_S5PINV);
    bf16_t* BCAT = (bf16_t*)(p->ws + WS_S5BCAT); bf16_t* CCAT = (bf16_t*)(p->ws + WS_S5CCAT);
    const float* BB = (const float*)(p->ws + WS_TAB + TAB_BB);
    for (size_t ii = c.gt; ii < (size_t)DEPTH * NG * NP * (S5_NPOW + S5_NINV); ii += c.ngt) {
        const int k = (int)(ii % (S5_NPOW + S5_NINV)), i = (int)(ii / (S5_NPOW + S5_NINV)), lg = i / NP, pp = i % NP;
        const double lr = (double)fminf(p->in[12][i], -1e-4f), li = (double)p->in[13][i];
        const double step = (double)expf(p->in[14][lg]);
        const int e = k < 9 ? k : (k == 9 ? 64 : (k == 10 ? 256 : -(k - S5_NPOW)));
        double t = (double)e * li * step * 0.15915494309189535; t -= rint(t);
        float sn, cs; sincosf((float)(t * 6.283185307179586), &sn, &cs);
        const float mag = expf((float)((double)e * lr * step));
        const f32x2_t v = {mag * cs, mag * sn};
        if (k < S5_NPOW) POW[((size_t)lg * S5_NPOW + k) * NP + pp] = v; else PINV[((size_t)lg * S5_NINV + (k - S5_NPOW)) * NP + pp] = v;
    }
    for (size_t ii = c.gt; ii < (size_t)DEPTH * NG * 128 * NC; ii += c.ngt) {
        const int i = (int)ii, lg = i / (128 * NC), n = (i / NC) % 128, cc = i % NC, pp = n & 63;
        const int sidx = lg * NP + pp;
        const float lr = fminf(p->in[12][sidx], -1e-4f), li = p->in[13][sidx];
        const float step = expf(p->in[14][lg]);
        const float mag = expf(lr * step);
        float sn, cs; sincosf(li * step, &sn, &cs);
        const float ab_re = mag * cs, ab_im = mag * sn, den = lr * lr + li * li;
        const float f_re = ((ab_re - 1.0f) * lr + ab_im * li) / den, f_im = (ab_im * lr - (ab_re - 1.0f) * li) / den;
        const float bre = p->in[15][(size_t)sidx * NC + cc], bim = p->in[16][(size_t)sidx * NC + cc];
        BCAT[i] = f2bf(n < 64 ? f_re * bre - f_im * bim : f_re * bim + f_im * bre);
        const int c2 = (i / 128) % NC, n2 = i % 128, p2 = n2 & 63;
        const float cv = n2 < 64 ? p->in[17][((size_t)lg * NC + c2) * NP + p2] : -p->in[18][((size_t)lg * NC + c2) * NP + p2];
        CCAT[i] = f2bf(cv);
    }
}

__device__ __forceinline__ void s5_xtiles(f32x16 (&xr)[2], f32x16 (&xi)[2], const bf16x8 (&uf)[2], bf16x8 bre, bf16x8 bim) {
#pragma unroll
    for (int m = 0; m < 2; ++m) { xr[m] = MFMA32(uf[m], bre, (f32x16){}); xi[m] = MFMA32(uf[m], bim, (f32x16){}); }
    asm volatile("s_nop 15\n\ts_nop 7" : "+v"(xr[0]), "+v"(xr[1]), "+v"(xi[0]), "+v"(xi[1]));
}

__device__ __forceinline__ void st_s5_phaseA(KP p, int l, const Ctx& c) {
    const bf16_t* PROJ = (const bf16_t*)(p->ws + WS_PROJ);
    const f32x2_t* POW = (const f32x2_t*)(p->ws + WS_S5POW);
    const bf16_t* BCAT = (const bf16_t*)(p->ws + WS_S5BCAT);
    f32x2_t* SUM = (f32x2_t*)(p->ws + WS_S5SUM);
    const int lane = c.lane, c31 = lane & 31, h = lane >> 5;
    for (int item = c.gw; item < BATCH * S5_NSEG * NG; item += c.ngw) {
        const int g = item % NG, seg = (item / NG) % S5_NSEG, b = item / (NG * S5_NSEG);
        const int lg = l * NG + g;
        const size_t row0 = (size_t)b * SEQ + (size_t)seg * S5_SEGLEN;
#pragma unroll 1
        for (int pt = 0; pt < 2; ++pt) {
            const int pp = 32 * pt + c31;
            const f32x2_t* pw = POW + (size_t)lg * S5_NPOW * NP + pp;
            f32x2_t lo[4];
#pragma unroll
            for (int s = 0; s < 4; ++s) lo[s] = pw[(7 - 4 * h - s) * NP];
            const f32x2_t a8 = pw[8 * NP], a64 = pw[9 * NP];
            const bf16x8 bre = *(const bf16x8*)(BCAT + ((size_t)lg * 128 + pp) * NC + 8 * h);
            const bf16x8 bim = *(const bf16x8*)(BCAT + ((size_t)lg * 128 + 64 + pp) * NC + 8 * h);
            f32x2_t sseg = {0.f, 0.f};
            bf16x8 ufn[2];
#pragma unroll
            for (int m = 0; m < 2; ++m) ufn[m] = *(const bf16x8*)(PROJ + (row0 + 32 * m + c31) * IN_COLS + C_UB + 16 * g + 8 * h);
#pragma unroll 1
            for (int ch = 0; ch < 4; ++ch) {
                bf16x8 uf[2];
#pragma unroll
                for (int m = 0; m < 2; ++m) { uf[m] = ufn[m]; if (ch < 3) ufn[m] = *(const bf16x8*)(PROJ + (row0 + 64 * ch + 64 + 32 * m + c31) * IN_COLS + C_UB + 16 * g + 8 * h); }
                f32x16 xr[2], xi[2];
                s5_xtiles(xr, xi, uf, bre, bim);
                f32x2_t f = {1.f, 0.f}, acc = {0.f, 0.f};
#pragma unroll
                for (int gi = 7; gi >= 0; --gi) {
                    const int m = gi >> 2, q = gi & 3;
                    f32x2_t t = {0.f, 0.f};
#pragma unroll
                    for (int s = 0; s < 4; ++s) { const f32x2_t x = {xr[m][4 * q + s], xi[m][4 * q + s]}; const f32x2_t w = cmul(lo[s], x); t.x += w.x; t.y += w.y; }
                    const f32x2_t w2 = cmul(f, t); acc.x += w2.x; acc.y += w2.y;
                    f = cmul(f, a8);
                }
                { const Halves hx = halves(acc.x), hy = halves(acc.y); acc.x = hx.lo + hx.hi; acc.y = hy.lo + hy.hi; }
                const f32x2_t d = cmul(a64, sseg); sseg.x = d.x + acc.x; sseg.y = d.y + acc.y;
            }
            if (h == 0) SUM[(((size_t)b * S5_NSEG + seg) * NG + g) * NP + pp] = sseg;
        }
    }
}

constexpr int S5_HT_STR = 144, S5_HT_BYTES = 64 * S5_HT_STR;
__device__ __forceinline__ void st_s5_phaseB(KP p, int l, const Ctx& c, LAS unsigned char* lds, bool dry) {
    bf16_t* PROJ = (bf16_t*)(p->ws + WS_PROJ);
    const f32x2_t* POW = (const f32x2_t*)(p->ws + WS_S5POW); const f32x2_t* PINV = (const f32x2_t*)(p->ws + WS_S5PINV);
    const bf16_t* BCAT = (const bf16_t*)(p->ws + WS_S5BCAT); const bf16_t* CCAT = (const bf16_t*)(p->ws + WS_S5CCAT);
    const f32x2_t* SUM = (const f32x2_t*)(p->ws + WS_S5SUM);
    const int lane = c.lane, c31 = lane & 31, h = lane >> 5, i16 = lane & 15, kg = lane >> 4, qq = i16 >> 2, p4 = i16 & 3;
    LAS unsigned char* ht = lds + c.wave * S5_HT_BYTES;
    bf16x8 tdiag[2], tones;
#pragma unroll
    for (int s = 0; s < 2; ++s)
#pragma unroll
        for (int j = 0; j < 8; ++j) tdiag[s][j] = (16 * s + 8 * (j >> 2) + 4 * h + (j & 3) <= c31) ? (short)0x3F80 : (short)0;
#pragma unroll
    for (int j = 0; j < 8; ++j) tones[j] = (short)0x3F80;
    for (int item = c.gw; item < BATCH * S5_NSEG * NG; item += c.ngw) {
        const int g = item % NG, seg = (item / NG) % S5_NSEG, b = item / (NG * S5_NSEG);
        const int lg = l * NG + g;
        const size_t row0 = (size_t)b * SEQ + (size_t)seg * S5_SEGLEN;
        f32x2_t hin[2];
#pragma unroll
        for (int pt = 0; pt < 2; ++pt) {
            const int pp = 32 * pt + c31;
            const f32x2_t a256 = POW[((size_t)lg * S5_NPOW + 10) * NP + pp];
            f32x2_t H = {0.f, 0.f};
#pragma unroll
            for (int k = 0; k < S5_NSEG - 1; ++k) if (k < seg) { const f32x2_t sk = SUM[(((size_t)b * S5_NSEG + k) * NG + g) * NP + pp]; const f32x2_t d = cmul(a256, H); H.x = d.x + sk.x; H.y = d.y + sk.y; }
            hin[pt] = H;
        }
        const float dd = p->in[19][l * 512 + g * 16 + i16];
        bf16x8 ufn[2];
#pragma unroll
        for (int m = 0; m < 2; ++m) ufn[m] = *(const bf16x8*)(PROJ + (row0 + 32 * m + c31) * IN_COLS + C_UB + 16 * g + 8 * h);
#pragma unroll 1
        for (int ch = 0; ch < 4; ++ch) {
            const size_t crow0 = row0 + 64 * ch;
            bf16x8 uf[2];
#pragma unroll
            for (int m = 0; m < 2; ++m) { uf[m] = ufn[m]; if (ch < 3) ufn[m] = *(const bf16x8*)(PROJ + (crow0 + 64 + 32 * m + c31) * IN_COLS + C_UB + 16 * g + 8 * h); }
            f32x4 Y[4];
#pragma unroll
            for (int it = 0; it < 4; ++it) Y[it] = (f32x4){0.f, 0.f, 0.f, 0.f};
#pragma unroll 1
            for (int pt = 0; pt < 2; ++pt) {
                const f32x2_t hin_pt = pt ? hin[1] : hin[0];
                const int pp = 32 * pt + c31;
                const bf16x8 bre = *(const bf16x8*)(BCAT + ((size_t)lg * 128 + pp) * NC + 8 * h);
                const bf16x8 bim = *(const bf16x8*)(BCAT + ((size_t)lg * 128 + 64 + pp) * NC + 8 * h);
                const f32x2_t* pw = POW + (size_t)lg * S5_NPOW * NP + pp; const f32x2_t* pi = PINV + (size_t)lg * S5_NINV * NP + pp;
                asm volatile("" : "+v"(pw), "+v"(pi));
                f32x2_t ilo[4], plo[4];
#pragma unroll
                for (int s = 0; s < 4; ++s) { ilo[s] = pi[(4 * h + s) * NP]; plo[s] = pw[(4 * h + s) * NP]; }
                const f32x2_t ia8 = pi[8 * NP], a8 = pw[8 * NP], a1 = pw[1 * NP];
                bf16x8 cfv[2];
#pragma unroll
                for (int ks = 0; ks < 2; ++ks) cfv[ks] = *(const bf16x8*)(CCAT + ((size_t)lg * NC + i16) * 128 + 64 * ks + 32 * pt + 8 * kg);
                bf16x8 wfr[2][2], wfi[2][2];
                {
                    f32x2_t f = {1.f, 0.f};
#pragma unroll
                    for (int m = 0; m < 2; ++m) {
                        f32x16 xr = MFMA32(uf[m], bre, (f32x16){}), xi = MFMA32(uf[m], bim, (f32x16){});
                        MFMA_SETTLE2(xr, xi);
#pragma unroll
                        for (int q = 0; q < 4; ++q) {
#pragma unroll
                            for (int s = 0; s < 4; ++s) { const f32x2_t x = {xr[4 * q + s], xi[4 * q + s]}; const f32x2_t w = cmul(f, cmul(ilo[s], x)); xr[4 * q + s] = w.x; xi[4 * q + s] = w.y; }
                            f = cmul(f, ia8);
                        }
#pragma unroll
                        for (int s2 = 0; s2 < 2; ++s2) {
                            wfr[m][s2] = pack8(xr[8 * s2], xr[8 * s2 + 1], xr[8 * s2 + 2], xr[8 * s2 + 3], xr[8 * s2 + 4], xr[8 * s2 + 5], xr[8 * s2 + 6], xr[8 * s2 + 7]);
                            wfi[m][s2] = pack8(xi[8 * s2], xi[8 * s2 + 1], xi[8 * s2 + 2], xi[8 * s2 + 3], xi[8 * s2 + 4], xi[8 * s2 + 5], xi[8 * s2 + 6], xi[8 * s2 + 7]);
                        }
                        __builtin_amdgcn_sched_barrier(0);
                    }
                }
                const f32x2_t G = cmul(a1, hin_pt);
                f32x2_t hlast = {0.f, 0.f};
                WAVE_LDS_SYNC();
                {
                    f32x2_t f = {1.f, 0.f};
#pragma unroll
                    for (int m = 0; m < 2; ++m) {
                        f32x16 cr, ci;
                        if (m == 0) { cr = MFMA32(tdiag[1], wfr[0][1], MFMA32(tdiag[0], wfr[0][0], (f32x16){})); ci = MFMA32(tdiag[1], wfi[0][1], MFMA32(tdiag[0], wfi[0][0], (f32x16){})); }
                        else { cr = MFMA32(tdiag[1], wfr[1][1], MFMA32(tdiag[0], wfr[1][0], MFMA32(tones, wfr[0][1], MFMA32(tones, wfr[0][0], (f32x16){}))));
                               ci = MFMA32(tdiag[1], wfi[1][1], MFMA32(tdiag[0], wfi[1][0], MFMA32(tones, wfi[0][1], MFMA32(tones, wfi[0][0], (f32x16){})))); }
                        MFMA_SETTLE2(cr, ci);
#pragma unroll
                        for (int q = 0; q < 4; ++q) {
                            float hr[4], hi[4];
#pragma unroll
                            for (int s = 0; s < 4; ++s) { const f32x2_t v = {cr[4 * q + s] + G.x, ci[4 * q + s] + G.y}; const f32x2_t w = cmul(f, cmul(plo[s], v)); hr[s] = w.x; hi[s] = w.y; }
                            if (m == 1 && q == 3) { hlast.x = hr[3]; hlast.y = hi[3]; }
                            typedef unsigned u32x2_t __attribute__((ext_vector_type(2)));
                            u32x2_t wr_; wr_.x = cvtpk(hr[0], hr[1]); wr_.y = cvtpk(hr[2], hr[3]);
                            u32x2_t wi_; wi_.x = cvtpk(hi[0], hi[1]); wi_.y = cvtpk(hi[2], hi[3]);
                            *(LAS u32x2_t*)(ht + c31 * S5_HT_STR + (32 * m + 8 * q + 4 * h) * 2) = wr_;
                            *(LAS u32x2_t*)(ht + (32 + c31) * S5_HT_STR + (32 * m + 8 * q + 4 * h) * 2) = wi_;
                            f = cmul(f, a8);
                        }
                        __builtin_amdgcn_sched_barrier(0);
                    }
                }
                { const f32x2_t hn = {halves(hlast.x).hi, halves(hlast.y).hi}; if (pt) hin[1] = hn; else hin[0] = hn; }
                WAVE_LDS_SYNC();
#pragma unroll
                for (int ks = 0; ks < 2; ++ks) {
                    const bf16x8 cf = cfv[ks];
#pragma unroll
                    for (int it = 0; it < 4; ++it) {
                        LAS const unsigned char* ap = ht + (32 * ks + 8 * kg + qq) * S5_HT_STR + (16 * it + 4 * p4) * 2;
                        const bf16x8 af = cat8(tr_read(ap), tr_read(ap + 4 * S5_HT_STR));
                        Y[it] = MFMA16(af, cf, Y[it]);
                    }
                }
            }
            asm volatile("s_nop 15\n\ts_nop 7" : "+v"(Y[0]), "+v"(Y[1]), "+v"(Y[2]), "+v"(Y[3]));
            float uu[4][4];
#pragma unroll
            for (int it = 0; it < 4; ++it)
#pragma unroll
                for (int r = 0; r < 4; ++r) uu[it][r] = bf2f(PROJ[(crow0 + 16 * it + 4 * kg + r) * IN_COLS + C_UB + 16 * g + i16]);
#pragma unroll
            for (int it = 0; it < 4; ++it)
#pragma unroll
                for (int r = 0; r < 4; ++r) {
                    bf16_t* up = PROJ + (crow0 + 16 * it + 4 * kg + r) * IN_COLS + C_UB + 16 * g + i16;
                    const float y = Y[it][r] + dd * uu[it][r];
                    if (!dry) *up = f2bf(gelu_tanh(y));
                }
        }
        if (seg == S5_NSEG - 1 && h == 0) {
#pragma unroll
            for (int pt = 0; pt < 2; ++pt) { const size_t oi = (((size_t)l * BATCH + b) * NG + g) * NP + 32 * pt + c31; p->out[O_SRP + oi] = hin[pt].x; p->out[O_SIP + oi] = hin[pt].y; }
        }
    }
}

__device__ __forceinline__ void st_s5_sample(KP p, int l, const Ctx& c, LAS unsigned char* lds, bool dry) {
    bf16_t* PROJ = (bf16_t*)(p->ws + WS_PROJ);
    const f32x2_t* POW = (const f32x2_t*)(p->ws + WS_S5POW); const f32x2_t* PINV = (const f32x2_t*)(p->ws + WS_S5PINV);
    const bf16_t* BCAT = (const bf16_t*)(p->ws + WS_S5BCAT); const bf16_t* CCAT = (const bf16_t*)(p->ws + WS_S5CCAT);
    LAS unsigned char* ht = lds + c.wave * S5_HT_BYTES;
    for (int item = c.gw; item < (DEC_BATCH / 16) * NG; item += c.ngw) {
        int zi = 0; asm volatile("" : "+v"(zi));
        const int lane = c.lane + zi, c31 = lane & 31, h = lane >> 5, i16 = lane & 15, kg = lane >> 4, qq = i16 >> 2, p4 = i16 & 3;
        const int g = item % NG, sg = item / NG, lg = l * NG + g;
        const size_t crow0 = (size_t)M_P + 64 * sg;
        bf16x8 tds[2];
#pragma unroll
        for (int s = 0; s < 2; ++s)
#pragma unroll
            for (int j = 0; j < 8; ++j) { const int kr = 16 * s + 8 * (j >> 2) + 4 * h + (j & 3); tds[s][j] = ((kr >> 2) == (c31 >> 2) && kr <= c31) ? (short)0x3F80 : (short)0; }
        const float dd = p->in[19][l * 512 + g * 16 + i16];
        bf16x8 uf[2];
#pragma unroll
        for (int m = 0; m < 2; ++m) uf[m] = *(const bf16x8*)(PROJ + (crow0 + 32 * m + c31) * IN_COLS + C_UB + 16 * g + 8 * h);
        f32x4 Y[4];
#pragma unroll
        for (int it = 0; it < 4; ++it) Y[it] = (f32x4){0.f, 0.f, 0.f, 0.f};
#pragma unroll
        for (int pt = 0; pt < 2; ++pt) {
            const int pp = 32 * pt + c31;
            const bf16x8 bre = *(const bf16x8*)(BCAT + ((size_t)lg * 128 + pp) * NC + 8 * h);
            const bf16x8 bim = *(const bf16x8*)(BCAT + ((size_t)lg * 128 + 64 + pp) * NC + 8 * h);
            const f32x2_t* pw = POW + (size_t)lg * S5_NPOW * NP + pp; const f32x2_t* pi = PINV + (size_t)lg * S5_NINV * NP + pp;
            f32x2_t ilo[4], plo[4];
#pragma unroll
            for (int s = 0; s < 4; ++s) { ilo[s] = pi[s * NP]; plo[s] = pw[s * NP]; }
            const f32x2_t a1 = pw[1 * NP];
            WAVE_LDS_SYNC();
#pragma unroll
            for (int m = 0; m < 2; ++m) {
                f32x16 xr = MFMA32(uf[m], bre, (f32x16){}), xi = MFMA32(uf[m], bim, (f32x16){});
                MFMA_SETTLE2(xr, xi);
#pragma unroll
                for (int q = 0; q < 4; ++q)
#pragma unroll
                    for (int s = 0; s < 4; ++s) { const f32x2_t x = {xr[4 * q + s], xi[4 * q + s]}; const f32x2_t w = cmul(ilo[s], x); xr[4 * q + s] = w.x; xi[4 * q + s] = w.y; }
                bf16x8 wr0 = pack8(xr[0], xr[1], xr[2], xr[3], xr[4], xr[5], xr[6], xr[7]), wr1 = pack8(xr[8], xr[9], xr[10], xr[11], xr[12], xr[13], xr[14], xr[15]);
                bf16x8 wi0 = pack8(xi[0], xi[1], xi[2], xi[3], xi[4], xi[5], xi[6], xi[7]), wi1 = pack8(xi[8], xi[9], xi[10], xi[11], xi[12], xi[13], xi[14], xi[15]);
                f32x16 cr = MFMA32(tds[1], wr1, MFMA32(tds[0], wr0, (f32x16){})), ci = MFMA32(tds[1], wi1, MFMA32(tds[0], wi0, (f32x16){}));
                MFMA_SETTLE2(cr, ci);
#pragma unroll
                for (int q = 0; q < 4; ++q) {
                    const int seq = 16 * sg + 8 * m + 2 * q + h;
                    const size_t si = (((size_t)l * DEC_BATCH + seq) * NG + g) * NP + pp;
                    const f32x2_t G = cmul(a1, (f32x2_t){p->in[4][si], p->in[5][si]});
                    float hr[4], hi[4];
#pragma unroll
                    for (int s = 0; s < 4; ++s) { const f32x2_t v = {cr[4 * q + s] + G.x, ci[4 * q + s] + G.y}; const f32x2_t w = cmul(plo[s], v); hr[s] = w.x; hi[s] = w.y; }
                    p->out[O_SRS + si] = hr[3]; p->out[O_SIS + si] = hi[3];
                    typedef unsigned u32x2_t __attribute__((ext_vector_type(2)));
                    u32x2_t wr_; wr_.x = cvtpk(hr[0], hr[1]); wr_.y = cvtpk(hr[2], hr[3]);
                    u32x2_t wi_; wi_.x = cvtpk(hi[0], hi[1]); wi_.y = cvtpk(hi[2], hi[3]);
                    *(LAS u32x2_t*)(ht + c31 * S5_HT_STR + (32 * m + 8 * q + 4 * h) * 2) = wr_;
                    *(LAS u32x2_t*)(ht + (32 + c31) * S5_HT_STR + (32 * m + 8 * q + 4 * h) * 2) = wi_;
                }
                __builtin_amdgcn_sched_barrier(0);
            }
            WAVE_LDS_SYNC();
#pragma unroll
            for (int ks = 0; ks < 2; ++ks) {
                const bf16x8 cf = *(const bf16x8*)(CCAT + ((size_t)lg * NC + i16) * 128 + 64 * ks + 32 * pt + 8 * kg);
#pragma unroll
                for (int it = 0; it < 4; ++it) {
                    LAS const unsigned char* ap = ht + (32 * ks + 8 * kg + qq) * S5_HT_STR + (16 * it + 4 * p4) * 2;
                    const bf16x8 af = cat8(tr_read(ap), tr_read(ap + 4 * S5_HT_STR));
                    Y[it] = MFMA16(af, cf, Y[it]);
                }
            }
        }
        asm volatile("s_nop 15\n\ts_nop 7" : "+v"(Y[0]), "+v"(Y[1]), "+v"(Y[2]), "+v"(Y[3]));
        float uu[4][4];
#pragma unroll
        for (int it = 0; it < 4; ++it)
#pragma unroll
            for (int r = 0; r < 4; ++r) uu[it][r] = bf2f(PROJ[(crow0 + 16 * it + 4 * kg + r) * IN_COLS + C_UB + 16 * g + i16]);
#pragma unroll
        for (int it = 0; it < 4; ++it)
#pragma unroll
            for (int r = 0; r < 4; ++r) {
                bf16_t* up = PROJ + (crow0 + 16 * it + 4 * kg + r) * IN_COLS + C_UB + 16 * g + i16;
                const float y = Y[it][r] + dd * uu[it][r];
                if (!dry) *up = f2bf(gelu_tanh(y));
            }
    }
}

__device__ __forceinline__ void st_lru_sample(KP p, int l, const Ctx& c, LAS unsigned char* lds, bool dry) {
    bf16_t* PROJ = (bf16_t*)(p->ws + WS_PROJ);
    const bf16_t* LRUW = (const bf16_t*)(p->ws + WS_LRUW);
    for (int item = c.gw; item < (DEC_BATCH / 16) * 8; item += c.ngw) {
        int zi = 0; asm volatile("" : "+v"(zi));
        const int lane = c.lane + zi, c31 = lane & 31, h = lane >> 5;
        const int n = item & 7, sg = item >> 3;
        const size_t row0 = (size_t)M_P + 64 * sg;
        const int ch0 = n * 64;
        LAS unsigned char* xim = lds + c.wave * 9216;
        WAVE_LDS_SYNC();
#pragma unroll 1
        for (int ks = 0; ks < 4; ++ks) {
            const int chb = ch0 + 16 * ks + 8 * h;
            float w[4][8], cb[8];
#pragma unroll
            for (int j = 0; j < 4; ++j) {
                const f32x4 w0 = *(const f32x4*)(p->in[22] + (l * 4 + j) * 512 + chb), w1 = *(const f32x4*)(p->in[22] + (l * 4 + j) * 512 + chb + 4);
                w[j][0] = w0[0]; w[j][1] = w0[1]; w[j][2] = w0[2]; w[j][3] = w0[3]; w[j][4] = w1[0]; w[j][5] = w1[1]; w[j][6] = w1[2]; w[j][7] = w1[3];
            }
            { const f32x4 b0 = *(const f32x4*)(p->in[23] + l * 512 + chb), b1 = *(const f32x4*)(p->in[23] + l * 512 + chb + 4);
              cb[0] = b0[0]; cb[1] = b0[1]; cb[2] = b0[2]; cb[3] = b0[3]; cb[4] = b1[0]; cb[5] = b1[1]; cb[6] = b1[2]; cb[7] = b1[3]; }
#pragma unroll
            for (int m = 0; m < 2; ++m) {
                const int i = 32 * m + c31, t = i & 3, seq = 16 * sg + (i >> 2);
                float xf[8];
#pragma unroll
                for (int e = 0; e < 8; ++e) xf[e] = cb[e];
#pragma unroll
                for (int j = 0; j < 4; ++j) {
                    const int tau = t - 3 + j;
                    float xv[8];
                    if (tau >= 0) {
                        const u32x4 xx = *(const u32x4*)(PROJ + ((size_t)M_P + 4 * seq + tau) * IN_COLS + C_XC + chb);
#pragma unroll
                        for (int e = 0; e < 4; ++e) { xv[2 * e] = __uint_as_float(xx[e] << 16); xv[2 * e + 1] = __uint_as_float(xx[e] & 0xffff0000u); }
                    } else {
                        const float* cp = p->in[7] + (((size_t)l * DEC_BATCH + seq) * 3 + (3 + tau)) * 512 + chb;
                        const f32x4 c0 = *(const f32x4*)cp, c1 = *(const f32x4*)(cp + 4);
                        xv[0] = c0[0]; xv[1] = c0[1]; xv[2] = c0[2]; xv[3] = c0[3]; xv[4] = c1[0]; xv[5] = c1[1]; xv[6] = c1[2]; xv[7] = c1[3];
                    }
#pragma unroll
                    for (int e = 0; e < 8; ++e) xf[e] += w[j][e] * xv[e];
                }
                *(LAS bf16x8*)(xim + (32 * m + c31) * 144 + (16 * ks + 8 * h) * 2) = pack8(xf[0], xf[1], xf[2], xf[3], xf[4], xf[5], xf[6], xf[7]);
            }
        }
        WAVE_LDS_SYNC();
#pragma unroll 1
        for (int et = 0; et < 2; ++et) {
            const int ch = ch0 + 32 * et + c31;
            const float ba = p->in[25][l * 512 + ch], bx = p->in[27][l * 512 + ch];
            const float lsig8 = ((const float*)(p->ws + WS_LSIG))[l * 512 + ch];
            const bf16_t* wp = LRUW + (((size_t)(l * 8 + n) * 2) * 64 + 32 * et + c31) * 64 + 8 * h;
#pragma unroll
            for (int m = 0; m < 2; ++m) {
                f32x16 X = (f32x16){}, R = (f32x16){}, I = (f32x16){};
#pragma unroll
                for (int ks = 0; ks < 4; ++ks) {
                    const bf16x8 wa = *(const bf16x8*)(wp + 16 * ks), wx = *(const bf16x8*)(wp + 64 * 64 + 16 * ks);
                    bf16x8 id;
#pragma unroll
                    for (int j = 0; j < 8; ++j) id[j] = (16 * ks + 8 * h + j == 32 * et + c31) ? (short)0x3F80 : (short)0;
                    const bf16x8 afr = *(LAS const bf16x8*)(xim + (32 * m + c31) * 144 + (16 * ks + 8 * h) * 2);
                    R = MFMA32(afr, wa, R); I = MFMA32(afr, wx, I); X = MFMA32(afr, id, X);
                }
                MFMA_SETTLE3(R, I, X);
                float gcv[16], h0v[4];
#pragma unroll
                for (int q = 0; q < 4; ++q) {
                    const int seq = 16 * sg + 8 * m + 2 * q + h;
                    h0v[q] = p->in[6][((size_t)l * DEC_BATCH + seq) * 512 + ch];
#pragma unroll
                    for (int s = 0; s < 4; ++s) gcv[4 * q + s] = bf2f(PROJ[((size_t)M_P + 4 * seq + s) * IN_COLS + C_GC + ch]);
                }
#pragma unroll
                for (int q = 0; q < 4; ++q) {
                    const int seq = 16 * sg + 8 * m + 2 * q + h;
                    float hv = h0v[q];
#pragma unroll
                    for (int s = 0; s < 4; ++s) {
                        const int r = 4 * q + s;
                        const float rg = sigmoidf_(R[r] + ba), ig = sigmoidf_(I[r] + bx);
                        const float la = rg * lsig8;
                        const float a = __expf(la);
                        const float bg = X[r] * ig * __builtin_amdgcn_sqrtf((1.0f - a) * (1.0f + a));
                        hv = a * hv + bg;
                        bf16_t* gp = PROJ + ((size_t)M_P + 4 * seq + s) * IN_COLS + C_GC + ch;
                        const float gc = gcv[r];
                        if (!dry) *gp = f2bf(hv * siluf_(gc));
                    }
                    p->out[O_LS + ((size_t)l * DEC_BATCH + seq) * 512 + ch] = hv;
                }
                __builtin_amdgcn_sched_barrier(0);
            }
        }
    }
}

__device__ __forceinline__ void st_attn_sample(KP p, int l, LAS unsigned char* lds, bool dry, int wave_s) {
    int zv = 0; asm volatile("" : "+v"(zv));
    const int tid = tid_of(wave_s, zv), lane = tid & 63, wave = __builtin_amdgcn_readfirstlane(tid >> 6);
    const int c31 = lane & 31, h = lane >> 5;
    bf16_t* PROJ = (bf16_t*)(p->ws + WS_PROJ);
    const float* rel_bias = p->in[8];
    for (int item = blockIdx.x; item < DEC_BATCH * NKV; item += gridDim.x) {
        const int b = item >> 1, kvh = item & 1;
#pragma unroll
        for (int i = 0; i < 3; ++i) {
            const int id = tid + 512 * i, row = id >> 3, pc = id & 7;
            if (id < 160 * 8) {
                u32x4 kk = (u32x4){0u, 0u, 0u, 0u}, vv = kk;
                if (row < WINDOW) {
                    const size_t ci = ((((size_t)l * DEC_BATCH + b) * WINDOW + row) * NKV + kvh) * HD + pc * 8;
                    const f32x4 k0 = *(const f32x4*)(p->in[2] + ci), k1 = *(const f32x4*)(p->in[2] + ci + 4), v0 = *(const f32x4*)(p->in[3] + ci), v1 = *(const f32x4*)(p->in[3] + ci + 4);
                    kk.x = cvtpk(k0[0], k0[1]); kk.y = cvtpk(k0[2], k0[3]); kk.z = cvtpk(k1[0], k1[1]); kk.w = cvtpk(k1[2], k1[3]);
                    vv.x = cvtpk(v0[0], v0[1]); vv.y = cvtpk(v0[2], v0[3]); vv.z = cvtpk(v1[0], v1[1]); vv.w = cvtpk(v1[2], v1[3]);
                } else if (row < WINDOW + DEC_SEQ) {
                    const bf16_t* src = PROJ + ((size_t)M_P + 4 * b + (row - WINDOW)) * IN_COLS + kvh * 64 + pc * 8;
                    kk = *(const u32x4*)(src + C_K); vv = *(const u32x4*)(src + C_V);
                }
                *(LAS u32x4*)(lds + AT_K + row * AT_KSTR + pc * 16) = kk;
                *(LAS u32x4*)(lds + AT_V + row * AT_VSTR + pc * 16) = vv;
            }
        }
        { const int g = tid >> 7, d = tid & 127; ((LAS float*)(lds + AT_BIAS))[tid] = rel_bias[T5_BUCKET[d] * NQH + kvh * 4 + g]; }
        __syncthreads();
        if (wave == 0) {
            const int qc = c31 & 15, g = qc >> 2, iq = qc & 3, hq = kvh * 4 + g;
            const float sink = p->in[10][l * NQH + hq];
            LAS const float* biasd = (LAS const float*)(lds + AT_BIAS) + g * 128;
            LAS float* wsf = (LAS float*)(lds + AT_WS);
            bf16x8 qf[4];
            { const bf16_t* qp = PROJ + ((size_t)M_P + 4 * b + iq) * IN_COLS + C_Q + hq * 64 + 8 * h;
#pragma unroll
              for (int ks = 0; ks < 4; ++ks) qf[ks] = *(const bf16x8*)(qp + 16 * ks); }
            f32x16 S[5];
#pragma unroll
            for (int j = 0; j < 5; ++j) {
                S[j] = (f32x16){};
                LAS const unsigned char* kp = lds + AT_K + (32 * j + c31) * AT_KSTR + 16 * h;
#pragma unroll
                for (int ks = 0; ks < 4; ++ks) S[j] = MFMA32(*(LAS const bf16x8*)(kp + 32 * ks), qf[ks], S[j]);
            }
            asm volatile("s_nop 15\n\ts_nop 7" : "+v"(S[0]), "+v"(S[1]), "+v"(S[2]), "+v"(S[3]), "+v"(S[4]));
            float mx = sink;
#pragma unroll
            for (int j = 0; j < 5; ++j)
#pragma unroll
                for (int r = 0; r < 16; ++r) {
                    const int kv = 32 * j + (r & 3) + 8 * (r >> 2) + 4 * h;
                    const int dist = iq + 128 - kv;
                    const bool ok = (dist >= 0) && (dist < 128);
                    const float s = ok ? S[j][r] * 0.125f + biasd[dist & 127] : -1e30f;
                    S[j][r] = s; mx = fmaxf(mx, s);
                }
            { const Halves hh = halves(mx); mx = fmaxf(hh.lo, hh.hi); }
            float sum = 0.f;
#pragma unroll
            for (int j = 0; j < 5; ++j)
#pragma unroll
                for (int r = 0; r < 16; ++r) { const float e = S[j][r] > -1e29f ? __expf(S[j][r] - mx) : 0.f; S[j][r] = e; sum += e; }
            { const Halves hh = halves(sum); sum = hh.lo + hh.hi; }
            const float rden = 1.0f / (sum + __expf(sink - mx));
            if (h == 0) wsf[c31] = rden;
            f32x16 O[2]; O[0] = (f32x16){}; O[1] = (f32x16){};
            const int i16 = lane & 15, qq = i16 >> 2, pp = i16 & 3, blk = (lane >> 4) & 1;
#pragma unroll
            for (int j = 0; j < 5; ++j)
#pragma unroll
                for (int s = 0; s < 2; ++s) {
                    const bf16x8 pf = pack8(S[j][8 * s], S[j][8 * s + 1], S[j][8 * s + 2], S[j][8 * s + 3], S[j][8 * s + 4], S[j][8 * s + 5], S[j][8 * s + 6], S[j][8 * s + 7]);
                    LAS const unsigned char* vp = lds + AT_V + (32 * j + 16 * s + 4 * h + qq) * AT_VSTR + (16 * blk + 4 * pp) * 2;
#pragma unroll
                    for (int dt = 0; dt < 2; ++dt) {
                        const bf16x8 vf = cat8(tr_read(vp + dt * 64), tr_read(vp + dt * 64 + 8 * AT_VSTR));
                        O[dt] = MFMA32(pf, vf, O[dt]);
                    }
                }
            MFMA_SETTLE2(O[0], O[1]);
            WAVE_LDS_SYNC();
            float gav[8][2];
#pragma unroll
            for (int r = 0; r < 8; ++r) {
                const int qr = (r & 3) + 8 * (r >> 2) + 4 * h, g2 = qr >> 2, i2 = qr & 3;
                const bf16_t* rowp = PROJ + ((size_t)M_P + 4 * b + i2) * IN_COLS + (kvh * 4 + g2) * 64 + c31;
                gav[r][0] = bf2f(rowp[C_GA]); gav[r][1] = bf2f(rowp[C_GA + 32]);
            }
#pragma unroll
            for (int r = 0; r < 8; ++r) {
                const int qr = (r & 3) + 8 * (r >> 2) + 4 * h, g2 = qr >> 2, i2 = qr & 3;
                const float rd = wsf[qr];
                bf16_t* rowp = PROJ + ((size_t)M_P + 4 * b + i2) * IN_COLS + (kvh * 4 + g2) * 64 + c31;
#pragma unroll
                for (int dt = 0; dt < 2; ++dt) if (!dry) rowp[C_Q + 32 * dt] = f2bf(O[dt][r] * rd * siluf_(gav[r][dt]));
            }
        }
        __syncthreads();
    }
}

constexpr int LR_NSEG = 32;
template <bool PHASE_B>
__device__ __forceinline__ void st_lru_mfma(KP p, int l, const Ctx& c, LAS unsigned char* lds, bool dry) {
    bf16_t* PROJ = (bf16_t*)(p->ws + WS_PROJ);
    const bf16_t* LRUW = (const bf16_t*)(p->ws + WS_LRUW);
    f32x2_t* LSUM = (f32x2_t*)(p->ws + WS_LRSUM);
    for (int item = c.gw; item < BATCH * LR_NSEG * 8; item += c.ngw) {
        int zi = 0; asm volatile("" : "+v"(zi));
        const int lane = c.lane + zi, c31 = lane & 31, h = lane >> 5;
        const int n = item & 7, seg = (item >> 3) % LR_NSEG, b = item / (8 * LR_NSEG);
        const size_t row0 = (size_t)b * SEQ + (size_t)seg * 64;
        const int ch0 = n * 64;
        LAS unsigned char* xim = lds + c.wave * 9216;
        WAVE_LDS_SYNC();
#pragma unroll 2
        for (int ks = 0; ks < 4; ++ks) {
            const int chb = ch0 + 16 * ks + 8 * h;
            float w[4][8], cb[8];
#pragma unroll
            for (int j = 0; j < 4; ++j) {
                const f32x4 w0 = *(const f32x4*)(p->in[22] + (l * 4 + j) * 512 + chb), w1 = *(const f32x4*)(p->in[22] + (l * 4 + j) * 512 + chb + 4);
                w[j][0] = w0[0]; w[j][1] = w0[1]; w[j][2] = w0[2]; w[j][3] = w0[3]; w[j][4] = w1[0]; w[j][5] = w1[1]; w[j][6] = w1[2]; w[j][7] = w1[3];
            }
            { const f32x4 b0 = *(const f32x4*)(p->in[23] + l * 512 + chb), b1 = *(const f32x4*)(p->in[23] + l * 512 + chb + 4);
              cb[0] = b0[0]; cb[1] = b0[1]; cb[2] = b0[2]; cb[3] = b0[3]; cb[4] = b1[0]; cb[5] = b1[1]; cb[6] = b1[2]; cb[7] = b1[3]; }
            u32x4 xx4[2][4];
#pragma unroll
            for (int m = 0; m < 2; ++m)
#pragma unroll
                for (int j = 0; j < 4; ++j) { const int t = seg * 64 + 32 * m + c31; const int dr = (t - 3 + j >= 0) ? (32 * m + c31 - 3 + j) : 0; xx4[m][j] = *(const u32x4*)(PROJ + (row0 + dr) * IN_COLS + C_XC + chb); }
#pragma unroll
            for (int m = 0; m < 2; ++m) {
                const int t = seg * 64 + 32 * m + c31;
                float xf[8];
#pragma unroll
                for (int e = 0; e < 8; ++e) xf[e] = cb[e];
#pragma unroll
                for (int j = 0; j < 4; ++j) {
                    const u32x4 xx = (t - 3 + j >= 0) ? xx4[m][j] : (u32x4){0u, 0u, 0u, 0u};
#pragma unroll
                    for (int e = 0; e < 4; ++e) { xf[2 * e] += w[j][2 * e] * __uint_as_float(xx[e] << 16); xf[2 * e + 1] += w[j][2 * e + 1] * __uint_as_float(xx[e] & 0xffff0000u); }
                }
                *(LAS bf16x8*)(xim + (32 * m + c31) * 144 + (16 * ks + 8 * h) * 2) = pack8(xf[0], xf[1], xf[2], xf[3], xf[4], xf[5], xf[6], xf[7]);
            }
        }
        WAVE_LDS_SYNC();
#pragma unroll 1
        for (int et = 0; et < 2; ++et) {
            const int ch = ch0 + 32 * et + c31;
            const float ba = p->in[25][l * 512 + ch], bx = p->in[27][l * 512 + ch];
            const float lsig8 = ((const float*)(p->ws + WS_LSIG))[l * 512 + ch];
            const bf16_t* wp = LRUW + (((size_t)(l * 8 + n) * 2) * 64 + 32 * et + c31) * 64 + 8 * h;
            f32x16 R[2], I[2];
            float Ar[8], Br[8];
            __builtin_amdgcn_sched_barrier(0);
            bf16x8 waf[4], wxf[4];
#pragma unroll
            for (int ks = 0; ks < 4; ++ks) { waf[ks] = *(const bf16x8*)(wp + 16 * ks); wxf[ks] = *(const bf16x8*)(wp + 64 * 64 + 16 * ks); }
            bf16_t gcr[2][16];
            if (PHASE_B) {
#pragma unroll
                for (int m = 0; m < 2; ++m)
#pragma unroll
                    for (int r = 0; r < 16; ++r) gcr[m][r] = PROJ[(row0 + 32 * m + (r & 3) + 8 * (r >> 2) + 4 * h) * IN_COLS + C_GC + ch];
            }
            __builtin_amdgcn_sched_barrier(0);
#pragma unroll
            for (int m = 0; m < 2; ++m) {
                f32x16 X = (f32x16){}; R[m] = (f32x16){}; I[m] = (f32x16){};
#pragma unroll
                for (int ks = 0; ks < 4; ++ks) {
                    bf16x8 id;
#pragma unroll
                    for (int j = 0; j < 8; ++j) id[j] = (16 * ks + 8 * h + j == 32 * et + c31) ? (short)0x3F80 : (short)0;
                    const bf16x8 afr = *(LAS const bf16x8*)(xim + (32 * m + c31) * 144 + (16 * ks + 8 * h) * 2);
                    R[m] = MFMA32(afr, waf[ks], R[m]); I[m] = MFMA32(afr, wxf[ks], I[m]); X = MFMA32(afr, id, X);
                }
                MFMA_SETTLE3(R[m], I[m], X);
#pragma unroll
                for (int q = 0; q < 4; ++q) {
                    float cp = 1.f, hl = 0.f;
#pragma unroll
                    for (int s = 0; s < 4; ++s) {
                        const int r = 4 * q + s;
                        const float rg = sigmoidf_(R[m][r] + ba), ig = sigmoidf_(I[m][r] + bx);
                        const float la = rg * lsig8;
                        const float a = __expf(la);
                        const float bg = X[r] * ig * __builtin_amdgcn_sqrtf((1.0f - a) * (1.0f + a));
                        cp *= a; hl = a * hl + bg;
                        R[m][r] = cp; I[m][r] = hl;
                    }
                    Ar[4 * m + q] = cp; Br[4 * m + q] = hl;
                }
                __builtin_amdgcn_sched_barrier(0);
            }
            float Hc = 0.f;
            if (PHASE_B) {
                for (int k0 = 0; k0 < seg; k0 += 16) {
                    f32x2_t ab[16];
#pragma unroll
                    for (int j = 0; j < 16; ++j) ab[j] = (k0 + j < seg) ? LSUM[((size_t)b * LR_NSEG + k0 + j) * 512 + ch] : (f32x2_t){1.f, 0.f};
#pragma unroll
                    for (int j = 0; j < 16; ++j) Hc = ab[j].x * Hc + ab[j].y;
                }
            }
            float st = Hc, At = 1.f, cin[8];
#pragma unroll
            for (int gi = 0; gi < 8; ++gi) {
                const Halves ha = halves(Ar[gi]), hb = halves(Br[gi]);
                const float A0 = ha.lo, B0 = hb.lo, A1 = ha.hi, B1 = hb.hi;
                const float s1 = A0 * st + B0;
                cin[gi] = h == 0 ? st : s1;
                st = A1 * s1 + B1; At *= A0 * A1;
            }
            if (!PHASE_B) {
                if (h == 0) LSUM[((size_t)b * LR_NSEG + seg) * 512 + ch] = (f32x2_t){At, st};
            } else {
#pragma unroll
                for (int m = 0; m < 2; ++m) {
                    int h2 = h; asm volatile("" : "+v"(h2));
#pragma unroll
                    for (int r = 0; r < 16; ++r) {
                        const float hv = I[m][r] + R[m][r] * cin[4 * m + (r >> 2)];
                        bf16_t* gp = PROJ + (row0 + 32 * m + (r & 3) + 8 * (r >> 2) + 4 * h2) * IN_COLS + C_GC + ch;
                        const float gc = bf2f(gcr[m][r]);
                        if (!dry) *gp = f2bf(hv * siluf_(gc));
                        if (m == 1 && r == 15 && h == 1 && seg == LR_NSEG - 1) p->out[O_LP + ((size_t)l * BATCH + b) * 512 + ch] = hv;
                    }
                }
            }
        }
    }
}

__device__ __forceinline__ float* pre_row(unsigned char* ws, int r) { return (float*)(ws + WS_PROJ + (size_t)r * IN_COLS * 2 + (size_t)(C_GM + 1024) * 2); }
__device__ __forceinline__ void st_ln(KP p, int l, const Ctx& c) {
    const int lane = c.lane;
    const float* g = p->in[31] + l * 1024; const float* bb = p->in[32] + l * 1024;
    f32x4 gv[4], bv[4];
#pragma unroll
    for (int j = 0; j < 4; ++j) { gv[j] = *(const f32x4*)(g + 4 * lane + 256 * j); bv[j] = *(const f32x4*)(bb + 4 * lane + 256 * j); }
    constexpr int NR = 3;
    for (int r0 = c.gw * NR; r0 < M_TOT; r0 += c.ngw * NR) {
        f32x4 v[NR][4];
#pragma unroll
        for (int k = 0; k < NR; ++k) { const int r = r0 + k < M_TOT ? r0 + k : M_TOT - 1; const float* pr = pre_row(p->ws, r);
#pragma unroll
            for (int j = 0; j < 4; ++j) v[k][j] = *(const f32x4*)(pr + 4 * lane + 256 * j); }
#pragma unroll
        for (int k = 0; k < NR; ++k) {
            const int r = r0 + k;
            float s = 0.f;
#pragma unroll
            for (int j = 0; j < 4; ++j) s += (v[k][j][0] + v[k][j][1]) + (v[k][j][2] + v[k][j][3]);
            s = wave_sum(s);
            const float mu = s * (1.0f / 1024.0f);
            float q = 0.f;
#pragma unroll
            for (int j = 0; j < 4; ++j) { const f32x4 d = v[k][j] - mu; q += (d[0] * d[0] + d[1] * d[1]) + (d[2] * d[2] + d[3] * d[3]); }
            q = wave_sum(q);
            const float rstd = rsqrtf(q * (1.0f / 1024.0f) + LN_EPS);
            if (r < M_TOT) {
#pragma unroll
                for (int j = 0; j < 4; ++j) {
                    const f32x4 y = (v[k][j] - mu) * rstd * gv[j] + bv[j];
                    const int cc = 4 * lane + 256 * j;
                    if (l == 0) { typedef unsigned u32x2_t __attribute__((ext_vector_type(2))); u32x2_t o; o.x = cvtpk(y[0], y[1]); o.y = cvtpk(y[2], y[3]);
                                  *(u32x2_t*)((bf16_t*)(p->ws + WS_XB) + (size_t)r * D_MODEL + cc) = o; }
                    else if (r < M_P) *(f32x4*)(p->out + O_YP + (size_t)r * D_MODEL + cc) = y;
                    else *(f32x4*)(p->out + O_YS + (size_t)(r - M_P) * D_MODEL + cc) = y;
                }
            }
        }
    }
}

template <int NBR, int NS  , class Epi>
__device__ __forceinline__ void piece_gemm(LAS unsigned char* lds, const bf16_t* A0, const bf16_t* A1, const bf16_t* A2, int lda, const bf16_t* Bt, int ldb, int kboff, int row0, int col0, const Epi& epi, int wave_s) {
    int zv = 0; asm volatile("" : "+v"(zv));
    const int tid = tid_of(wave_s, zv), lane = tid & 63, wave = __builtin_amdgcn_readfirstlane(tid >> 6), c31 = lane & 31, h = lane >> 5;
    LAS float* part = (LAS float*)lds;
    float outv[NBR][4];
    constexpr int kw = 16 * NS;
    bf16x8 a[NBR][NS], b0[NBR][NS], b1[NBR][NS];
#pragma unroll
    for (int br = 0; br < NBR; ++br) {
        const bf16_t* A = br == 0 ? A0 : (br == 1 ? A1 : A2);
        const bf16_t* ap = A + (size_t)(row0 + c31) * lda + wave * kw + 8 * h;
        const bf16_t* bp = Bt + (size_t)(col0 + c31) * ldb + br * kboff + wave * kw + 8 * h;
#pragma unroll
        for (int s = 0; s < NS; ++s) { a[br][s] = *(const bf16x8*)(ap + 16 * s); b0[br][s] = *(const bf16x8*)(bp + 16 * s); b1[br][s] = *(const bf16x8*)(bp + (size_t)32 * ldb + 16 * s); }
    }
    typename Epi::Pre pre[4];
#pragma unroll
    for (int e = 0; e < 4; ++e) {
        const int idx = tid + 512 * e, nt = idx >> 10, r = (idx >> 6) & 15, ln = idx & 63;
        pre[e] = epi.load(row0 + (r & 3) + 8 * (r >> 2) + 4 * (ln >> 5), col0 + 32 * nt + (ln & 31));
    }
    __builtin_amdgcn_sched_barrier(0);
#pragma unroll
    for (int br = 0; br < NBR; ++br) {
        f32x16 acc0 = (f32x16){}, acc1 = (f32x16){};
#pragma unroll
        for (int s = 0; s < NS; ++s) { acc0 = MFMA32(a[br][s], b0[br][s], acc0); acc1 = MFMA32(a[br][s], b1[br][s], acc1); }
        MFMA_SETTLE2(acc0, acc1);
        __syncthreads();
#pragma unroll
        for (int r = 0; r < 16; ++r) { part[((wave * 2 + 0) * 16 + r) * 64 + lane] = acc0[r]; part[((wave * 2 + 1) * 16 + r) * 64 + lane] = acc1[r]; }
        __syncthreads();
#pragma unroll
        for (int e = 0; e < 4; ++e) {
            const int idx = tid + 512 * e;
            float s = 0.f;
#pragma unroll
            for (int w = 0; w < 8; ++w) s += part[w * 2048 + idx];
            outv[br][e] = s;
        }
    }
#pragma unroll
    for (int e = 0; e < 4; ++e) {
        const int idx = tid + 512 * e, nt = idx >> 10, r = (idx >> 6) & 15, ln = idx & 63;
        const int row = row0 + (r & 3) + 8 * (r >> 2) + 4 * (ln >> 5), col = col0 + 32 * nt + (ln & 31);
        float v[NBR];
#pragma unroll
        for (int br = 0; br < NBR; ++br) v[br] = outv[br][e];
        epi.store(row, col, pre[e], v);
    }
    __syncthreads();
}
struct PEpiGlu { bf16_t* PROJ; bool dry; struct Pre { bf16_t z, g; };
    __device__ __forceinline__ Pre load(int r, int c) const { const bf16_t* rp = PROJ + (size_t)r * IN_COLS; return Pre{rp[C_UB + c], rp[C_GB + c]}; }
    __device__ __forceinline__ void store(int r, int c, const Pre& q, const float (&v)[1]) const {
        if (!dry) PROJ[(size_t)r * IN_COLS + C_GB + c] = f2bf(bf2f(q.z) * sigmoidf_(v[0]) * siluf_(bf2f(q.g))); } };
struct PEpiBranch { bf16_t* PROJ; bool dry; struct Pre { bf16_t g0, g1, g2; };
    __device__ __forceinline__ Pre load(int r, int c) const { const bf16_t* gp = PROJ + (size_t)r * IN_COLS + C_GM + c; return Pre{gp[0], gp[1024], gp[2048]}; }
    __device__ __forceinline__ void store(int r, int c, const Pre& q, const float (&v)[3]) const {
        const float m = __builtin_amdgcn_rcpf(bf2f(q.g0)) * v[0] + __builtin_amdgcn_rcpf(bf2f(q.g1)) * v[1] + __builtin_amdgcn_rcpf(bf2f(q.g2)) * v[2];
        if (!dry) PROJ[(size_t)r * IN_COLS + C_GM + c] = f2bf(m); } };
struct PEpiOut { KP p; int l; struct Pre { float x; };
    __device__ __forceinline__ Pre load(int r, int c) const {
        return Pre{bf2f(((const bf16_t*)(p->ws + WS_XB))[(size_t)r * D_MODEL + c])}; }
    __device__ __forceinline__ void store(int r, int c, const Pre& q, const float (&v)[1]) const { pre_row(p->ws, r)[c] = DN_ALPHA * q.x + v[0]; } };

#ifndef TSEL
#define TSEL 0
#endif
#define TS_BEGIN(K) do { if (TSEL == (K) && blockIdx.x == 0 && wave_s == 0 && lane_id() == 0) *(volatile LAS unsigned long long*)(lds + LDS_MISC + 128) = __builtin_amdgcn_s_memrealtime(); } while (0)
#define TS_END(K) do { if (TSEL == (K) && blockIdx.x == 0 && wave_s == 0 && lane_id() == 0) *(volatile LAS unsigned long long*)(lds + LDS_MISC + 136) += __builtin_amdgcn_s_memrealtime() - *(volatile LAS unsigned long long*)(lds + LDS_MISC + 128); } while (0)
__global__ void __launch_bounds__(NTHREADS, 2) mega_fwd(P p_unused) {
    extern __shared__ __attribute__((aligned(16))) unsigned char lds_raw[];
    LAS unsigned char* lds = (LAS unsigned char*)lds_raw;
    volatile LAS unsigned* misc = (volatile LAS unsigned*)(lds + LDS_MISC);
    const int wave_s = __builtin_amdgcn_readfirstlane((int)threadIdx.x >> 6);
    if (wave_s == 0) misc[lane_id()] = 0u;
    __syncthreads();
    XcdBarrier bar;
    { KP p = get_kp(); bar = xcd_barrier_post((unsigned*)(p->ws + WS_CTL), misc, wave_s); }
    TS_BEGIN(100);

    { KP p = get_kp(); const Ctx c = make_ctx(wave_s); unsigned char* dob = (unsigned char*)p->out;
      st_convert_x(p, c);
      st_prologue_weights(p, c, (LAS float*)(lds + c.wave * 9216), 0, 1);
      st_s5_tables2(p, c);
      for (size_t i = c.gt; i < (size_t)DEPTH * 512; i += c.ngt) ((float*)(p->ws + WS_LSIG))[i] = -8.0f * log1pf(expf(-p->in[28][i]));
      { bf16_t* LRUW = (bf16_t*)(p->ws + WS_LRUW);
        for (size_t i = c.gt; i < (size_t)DEPTH * 8 * 2 * 64 * 64; i += c.ngt) {
            const int d = (int)(i & 63), e = (int)((i >> 6) & 63), mat = (int)((i >> 12) & 1), ln = (int)(i >> 13);
            LRUW[i] = f2bf(p->in[mat ? 26 : 24][((size_t)ln * 64 + d) * 64 + e]); } } }
    xcd_barrier(bar);
    TS_END(100);

#ifndef PROBE
#define PROBE 0
#endif
#define PROBE_RUN(K, BODY) do { if (PROBE == (K)) { int d_ = 1; asm volatile("" : "+s"(d_)); const bool dry = d_ != 0; BODY; __syncthreads(); } { const bool dry = false; BODY; } } while (0)
#define PH_P1 { KP p = get_kp(); int zs = 0; asm volatile("" : "+s"(zs)); (void)dry; \
          pg8::Gemm g{(const bf16_t*)(p->ws + WS_XB), D_MODEL, (const bf16_t*)((unsigned char*)p->out + DO_WIN) + (size_t)l * IN_COLS * 1024, 1024}; \
          pg8::StaticOrder S; S.init(M_TOT, IN_COLS, (int)gridDim.x + zs, (int)blockIdx.x + zs); \
          pg8::gemm_phase<pg8::EpiProjB, pg8::StaticOrder, true, true>(lds, g, S, pg8::EpiProjB{(bf16_t*)(p->ws + WS_PROJ), IN_COLS}, wave_s); \
          if (l == 0) {   \
              const int nb_ = (int)gridDim.x + zs, bid_ = (int)blockIdx.x + zs, short_ = ((M_TOT / 256) * (IN_COLS / 256)) % nb_; \
              if (short_ == 0 || bid_ >= short_) { const Ctx c = make_ctx(wave_s); Ctx gq = c; const int sz_ = short_ == 0 ? nb_ : nb_ - short_, rk_ = short_ == 0 ? bid_ : bid_ - short_; \
                  gq.gw = c.wave * sz_ + rk_; gq.ngw = NWAVES * sz_; st_prologue_weights(p, gq, (LAS float*)(lds + c.wave * 9216), 1, DEPTH); } } }
#define PH_SAMPLE { KP p = get_kp(); const Ctx c = make_ctx(wave_s); if (wave_s == 5) { const Ctx g = waveset_ctx(c, 0, 1); st_s5_sample(p, l, g, lds, dry); st_lru_sample(p, l, g, lds, dry); } }
#define PH_SUMM { KP p = get_kp(); const Ctx c = make_ctx(wave_s); (void)dry; \
          if (wave_s < 2 || wave_s == 4) st_s5_phaseA(p, l, waveset_ctx(c, wave_s == 4 ? 2 : wave_s, 3)); \
          if (wave_s == 2 || wave_s == 3 || wave_s >= 6) st_lru_mfma<false>(p, l, waveset_ctx(c, wave_s >= 6 ? wave_s - 4 : wave_s - 2, 4), lds, false); }
#define PH_ATTN { __syncthreads(); KP p = get_kp(); st_attn_prompt(p, l, lds, dry, wave_s); st_attn_sample(p, l, lds, dry, wave_s); }
#define PH_P3 { KP p = get_kp(); const Ctx c = make_ctx(wave_s); unsigned* ctl_ = (unsigned*)(p->ws + WS_CTL); \
          volatile LAS unsigned* ms_ = (volatile LAS unsigned*)(lds + LDS_MISC + 160); \
          if (wave_s == 0 && c.lane == 0) { const unsigned x_ = xb_xcc_id(); unsigned ne_ = 0, no_ = 0; \
              for (unsigned j = 0; j < 16; ++j) { const unsigned cj = xb_ld(&ctl_[XB_XCNT(j)]); if (j & 1) no_ += cj; else ne_ += cj; } \
              const unsigned role_ = x_ & 1u, both_ = (ne_ == 0u || no_ == 0u) ? 1u : 0u; \
              const unsigned rank_ = both_ ? (unsigned)(c.gw - c.wave * (c.ngw / NWAVES)) : xb_add(&ctl_[4096 + 64 * (2 * l + (int)role_)], 1u); \
              ms_[0] = both_ ? 2u : role_; ms_[1] = rank_; ms_[2] = both_ ? (unsigned)(c.ngw / NWAVES) : (role_ ? no_ : ne_); } \
          __syncthreads(); \
          const unsigned role_ = ms_[0]; Ctx g = c; g.gw = c.wave * (int)ms_[2] + (int)ms_[1]; g.ngw = NWAVES * (int)ms_[2]; \
          if (role_ == 0u || role_ == 2u) st_s5_phaseB(p, l, g, lds, dry); \
          if (role_ == 1u || role_ == 2u) st_lru_mfma<true>(p, l, g, lds, dry); }
#define PH_GLU { KP p = get_kp(); int zs = 0; asm volatile("" : "+s"(zs)); bf16_t* PROJ = (bf16_t*)(p->ws + WS_PROJ); \
          pg8::Gemm g{PROJ + C_UB, IN_COLS, (const bf16_t*)((unsigned char*)p->out + DO_WGLU) + (size_t)l * 512 * 512, 512}; \
          pg8::StaticOrder S; S.init(M_P, 512, (int)gridDim.x + zs, (int)blockIdx.x + zs); \
          pg8::gemm_phase<pg8::EpiGluB, pg8::StaticOrder, true, true>(lds, g, S, pg8::EpiGluB{PROJ, dry}, wave_s); \
          const int nb_ = (int)gridDim.x + zs, bid_ = (int)blockIdx.x + zs; \
          if (bid_ >= nb_ / 2) { const Ctx c = make_ctx(wave_s); Ctx g = c; g.gt = (size_t)(bid_ - nb_ / 2) * NTHREADS + c.tid; g.ngt = (size_t)(nb_ - nb_ / 2) * NTHREADS; st_kv_out(p, l, g); }   \
          for (int pc = nb_ - 1 - bid_; pc < 16 * 8; pc += nb_)   \
              piece_gemm<1, 4>(lds, PROJ + C_UB, nullptr, nullptr, IN_COLS, g.Bt, 512, 0, M_P + 32 * (pc >> 3), 64 * (pc & 7), PEpiGlu{PROJ, dry}, wave_s); }
#define PH_BRANCH { KP p = get_kp(); int zs = 0; asm volatile("" : "+s"(zs)); bf16_t* PROJ = (bf16_t*)(p->ws + WS_PROJ); \
          pg8::Gemm g{PROJ + C_Q, IN_COLS, (const bf16_t*)((unsigned char*)p->out + DO_WBR) + (size_t)l * 1024 * 1536, 1536}; \
          pg8::StaticOrder S; S.init(M_P, 1024, (int)gridDim.x + zs, (int)blockIdx.x + zs); \
          pg8::gemm_phase<pg8::EpiMergeB, pg8::StaticOrder, true, true>(lds, g, S, pg8::EpiMergeB{PROJ, dry}, wave_s); \
          const int nb_ = (int)gridDim.x + zs, bid_ = (int)blockIdx.x + zs; \
          for (int pc = bid_; pc < 16 * 16; pc += nb_) \
              piece_gemm<3, 4>(lds, PROJ + C_Q, PROJ + C_GB, PROJ + C_GC, IN_COLS, g.Bt, 1536, 512, M_P + 32 * (pc >> 4), 64 * (pc & 15), PEpiBranch{PROJ, dry}, wave_s); }
#define PH_OUT { KP p = get_kp(); int zs = 0; asm volatile("" : "+s"(zs)); bf16_t* PROJ = (bf16_t*)(p->ws + WS_PROJ); (void)dry; \
          pg8::Gemm g{PROJ + C_GM, IN_COLS, (const bf16_t*)(p->ws + WS_WOUT) + (size_t)l * 1024 * 1024, 1024}; \
          pg8::StaticOrder S; S.init(M_P, 1024, (int)gridDim.x + zs, (int)blockIdx.x + zs); \
          pg8::gemm_phase<pg8::EpiOutB, pg8::StaticOrder, true, true>(lds, g, S, pg8::EpiOutB{(const bf16_t*)(p->ws + WS_XB), p->ws}, wave_s); \
          const int nb_ = (int)gridDim.x + zs, bid_ = (int)blockIdx.x + zs; \
          for (int pc = bid_; pc < 16 * 16; pc += nb_) \
              piece_gemm<1, 8>(lds, PROJ + C_GM, nullptr, nullptr, IN_COLS, g.Bt, 1024, 0, M_P + 32 * (pc >> 4), 64 * (pc & 15), PEpiOut{p, l}, wave_s); }
#define PH_LN { KP p = get_kp(); const Ctx c = make_ctx(wave_s); (void)dry; st_ln(p, l, c); }
    for (int l = 0; l < DEPTH; ++l) {
        TS_BEGIN(1); PROBE_RUN(1, PH_P1);
        xcd_barrier(bar); TS_END(1);
#if TSEL >= 20
        TS_BEGIN(21); PROBE_RUN(2, PH_SAMPLE); xcd_barrier(bar); TS_END(21);
        TS_BEGIN(22); PROBE_RUN(3, PH_SUMM); xcd_barrier(bar); TS_END(22);
        TS_BEGIN(23); PROBE_RUN(4, PH_ATTN); xcd_barrier(bar); TS_END(23);
        { const bool dry = false; PH_P3; } xcd_barrier(bar);
#else
        TS_BEGIN(2); PROBE_RUN(2, PH_SAMPLE);
        PROBE_RUN(3, PH_SUMM);
        PROBE_RUN(4, PH_ATTN);
        xcd_barrier(bar); TS_END(2);
        TS_BEGIN(3); { const bool dry = false; PH_P3; }
        xcd_barrier(bar); TS_END(3);
#endif
        TS_BEGIN(4); PROBE_RUN(7, PH_GLU);
        xcd_barrier(bar); TS_END(4);
        TS_BEGIN(5); PROBE_RUN(8, PH_BRANCH);
        xcd_barrier(bar); TS_END(5);
        TS_BEGIN(6); PROBE_RUN(9, PH_OUT);
        xcd_barrier(bar); TS_END(6);
        TS_BEGIN(7); PROBE_RUN(10, PH_LN);
        if (l + 1 < DEPTH) xcd_barrier(bar);
        TS_END(7);
    }
    if (TSEL != 0 && blockIdx.x == 0 && wave_s == 0 && lane_id() == 0) { const unsigned long long te = __builtin_amdgcn_s_memrealtime(), ts_acc = *(volatile LAS unsigned long long*)(lds + LDS_MISC + 136); while (__builtin_amdgcn_s_memrealtime() - te < ts_acc) __builtin_amdgcn_s_sleep(4); }
}

extern "C" void kernel_launch(void* const* d_in, const int* in_sizes, int n_in, void* d_out, int out_size, void* d_ws, size_t ws_size, hipStream_t stream) {
    static int grid = 0;
    if (grid == 0) {
        if (n_in != 33 || (size_t)out_size != O_END || ws_size < WS_CTL + CTL_BYTES) { fprintf(stderr, "kernel_launch: unexpected sizes n_in %d out %d ws %zu\n", n_in, out_size, ws_size); grid = -1; return; }
        int dev = 0, cus = 0, per_cu = 0;
        if (hipGetDevice(&dev) != hipSuccess || hipDeviceGetAttribute(&cus, hipDeviceAttributeMultiprocessorCount, dev) != hipSuccess) { grid = -1; return; }
        if (hipFuncSetAttribute((const void*)mega_fwd, hipFuncAttributeMaxDynamicSharedMemorySize, LDS_BYTES) != hipSuccess) { fprintf(stderr, "kernel_launch: hipFuncSetAttribute failed\n"); grid = -1; return; }
        if (hipOccupancyMaxActiveBlocksPerMultiprocessor(&per_cu, (const void*)mega_fwd, NTHREADS, LDS_BYTES) != hipSuccess || per_cu < 1) { fprintf(stderr, "kernel_launch: occupancy query says %d blocks/CU\n", per_cu); grid = -1; return; }
        grid = cus;
    }
    if (grid < 0) return;
    (void)hipMemsetAsync((unsigned char*)d_ws + WS_CTL, 0, CTL_BYTES, stream);
    P p{};
    for (int i = 0; i < 33; ++i) p.in[i] = (const float*)d_in[i];
    p.out = (float*)d_out; p.ws = (unsigned char*)d_ws;
    void* args[] = {&p};
    hipError_t e = hipLaunchCooperativeKernel((const void*)mega_fwd, dim3(grid), dim3(NTHREADS), args, LDS_BYTES, stream);
    if (e != hipSuccess) fprintf(stderr, "kernel_launch: cooperative launch failed: %s (grid %d)\n", hipGetErrorString(e), grid);
}
```

```cpp
#include <hip/hip_runtime.h>
#include <cstdint>
#include <cstdio>

typedef unsigned short bf16_t;
typedef short bf16x8 __attribute__((ext_vector_type(8)));
typedef float f32x16 __attribute__((ext_vector_type(16)));
typedef float f32x4 __attribute__((ext_vector_type(4)));

constexpr int D_MODEL = 1024, BATCH = 8, SEQ = 2048, DEPTH = 2, DEC_BATCH = 128, DEC_SEQ = 4;
constexpr int M_P = BATCH * SEQ;
constexpr int M_S = DEC_BATCH * DEC_SEQ;
constexpr int M_TOT = M_P + M_S;
constexpr int IN_COLS = 6400;
constexpr int C_Q = 0, C_GB = 512, C_GC = 1024, C_K = 1536, C_V = 1664, C_GA = 1792, C_UB = 2304, C_XC = 2816, C_GM = 3328;
__host__ __device__ constexpr int colperm32(int n0) {
    return n0 < 512 ? n0 : n0 < 640 ? C_K + (n0 - 512) : n0 < 768 ? C_V + (n0 - 640) : n0 < 1280 ? C_GA + (n0 - 768) : n0 < 1792 ? C_UB + (n0 - 1280)
         : n0 < 2304 ? C_GB + (n0 - 1792) : n0 < 2816 ? C_XC + (n0 - 2304) : n0 < 3328 ? C_GC + (n0 - 2816) : n0; }
constexpr int WINDOW = 128, NKV = 2, HD = 64, NQH = 8;
constexpr int NG = 32, NP = 64, NC = 16;
constexpr float DN_ALPHA = 1.4142135623730951f;
constexpr float LN_EPS = 1e-5f;

constexpr size_t O_YP = 0;
constexpr size_t O_YS = O_YP + (size_t)M_P * D_MODEL;
constexpr size_t O_KP = O_YS + (size_t)M_S * D_MODEL;
constexpr size_t SZ_KP = (size_t)DEPTH * BATCH * WINDOW * NKV * HD;
constexpr size_t O_VP = O_KP + SZ_KP;
constexpr size_t O_SRP = O_VP + SZ_KP;
constexpr size_t SZ_SP = (size_t)DEPTH * BATCH * NG * NP;
constexpr size_t O_SIP = O_SRP + SZ_SP;
constexpr size_t O_LP = O_SIP + SZ_SP;
constexpr size_t SZ_LP = (size_t)DEPTH * BATCH * 512;
constexpr size_t O_CP = O_LP + SZ_LP;
constexpr size_t SZ_CP = (size_t)DEPTH * BATCH * 3 * 512;
constexpr size_t O_KS = O_CP + SZ_CP;
constexpr size_t SZ_KS = (size_t)DEPTH * DEC_BATCH * WINDOW * NKV * HD;
constexpr size_t O_VS = O_KS + SZ_KS;
constexpr size_t O_SRS = O_VS + SZ_KS;
constexpr size_t SZ_SS = (size_t)DEPTH * DEC_BATCH * NG * NP;
constexpr size_t O_SIS = O_SRS + SZ_SS;
constexpr size_t O_LS = O_SIS + SZ_SS;
constexpr size_t SZ_LS = (size_t)DEPTH * DEC_BATCH * 512;
constexpr size_t O_CS = O_LS + SZ_LS;
constexpr size_t SZ_CS = (size_t)DEPTH * DEC_BATCH * 3 * 512;
constexpr size_t O_END = O_CS + SZ_CS;

constexpr size_t WS_PROJ = 0;
constexpr size_t WS_XB = WS_PROJ + (size_t)M_TOT * IN_COLS * 2;
constexpr size_t WS_WOUT = WS_XB + (size_t)M_TOT * D_MODEL * 2;
constexpr size_t WS_TAB = WS_WOUT + (size_t)DEPTH * 1024 * 1024 * 2;
constexpr size_t TAB_AB = 0;
constexpr size_t TAB_BB = TAB_AB + (size_t)DEPTH * NG * NP * 2 * 4;
constexpr size_t TAB_BYTES = TAB_BB + (size_t)DEPTH * NG * NP * NC * 2 * 4;
constexpr size_t WS_S5POW = WS_TAB + TAB_BYTES;
constexpr size_t WS_S5PINV = WS_S5POW + (size_t)DEPTH * NG * 11 * NP * 8;
constexpr size_t WS_S5BCAT = WS_S5PINV + (size_t)DEPTH * NG * 9 * NP * 8;
constexpr size_t WS_S5CCAT = WS_S5BCAT + (size_t)DEPTH * NG * 128 * NC * 2;
constexpr size_t WS_S5SUM = WS_S5CCAT + (size_t)DEPTH * NG * 128 * NC * 2;
constexpr size_t WS_LRUW = WS_S5SUM + (size_t)BATCH * 8 * NG * NP * 8;
constexpr size_t WS_LRSUM = WS_LRUW + (size_t)DEPTH * 8 * 2 * 64 * 64 * 2;
constexpr size_t WS_LSIG = WS_LRSUM + (size_t)BATCH * 32 * 512 * 8;
constexpr size_t WS_END = WS_LSIG + (size_t)DEPTH * 512 * 4;
constexpr size_t DO_WIN = 0;
constexpr size_t DO_WBR = DO_WIN + (size_t)DEPTH * IN_COLS * 1024 * 2;
constexpr size_t DO_WGLU = DO_WBR + (size_t)DEPTH * 3 * 1024 * 512 * 2;
constexpr size_t DO_LRUW = DO_WGLU + (size_t)DEPTH * 512 * 512 * 2;
constexpr size_t DO_END = DO_LRUW;
static_assert(DO_END <= (size_t)M_P * D_MODEL * 4, "weights fit in y_prompt region");
static_assert(WS_END <= 268435456ull, "workspace fits 256 MiB");

__constant__ unsigned char T5_BUCKET[128] = {0, 1, 2, 3, 4, 5, 6, 7, 8, 9, 10, 11, 12, 13, 14, 15, 16, 16, 16, 17, 17, 18, 18, 18, 19, 19, 19, 20, 20, 20, 20, 21, 21, 21, 21, 22, 22, 22, 22, 22, 23, 23, 23, 23, 23, 23, 24, 24, 24, 24, 24, 24, 25, 25, 25, 25, 25, 25, 25, 26, 26, 26, 26, 26, 26, 26, 26, 27, 27, 27, 27, 27, 27, 27, 27, 27, 27, 28, 28, 28, 28, 28, 28, 28, 28, 28, 28, 29, 29, 29, 29, 29, 29, 29, 29, 29, 29, 29, 29, 30, 30, 30, 30, 30, 30, 30, 30, 30, 30, 30, 30, 30, 30, 31, 31, 31, 31, 31, 31, 31, 31, 31, 31, 31, 31, 31, 31, 31};

typedef unsigned u32x4 __attribute__((ext_vector_type(4)));
typedef float f32x2_t __attribute__((ext_vector_type(2)));
typedef __bf16 bf16x2_t __attribute__((ext_vector_type(2)));
__device__ __forceinline__ unsigned cvtpk(float lo, float hi) { f32x2_t v = {lo, hi}; bf16x2_t b = __builtin_convertvector(v, bf16x2_t); return __builtin_bit_cast(unsigned, b); }
__device__ __forceinline__ float bf2f(bf16_t v) { return __uint_as_float(((unsigned)v) << 16); }
__device__ __forceinline__ bf16_t f2bf(float f) { return (bf16_t)cvtpk(f, 0.f); }
__device__ __forceinline__ float sigmoidf_(float x) { return __builtin_amdgcn_rcpf(1.0f + __builtin_amdgcn_exp2f(-1.4426950408889634f * x)); }
__device__ __forceinline__ float siluf_(float x) { return x * sigmoidf_(x); }
__device__ __forceinline__ float gelu_tanh(float y) { return y * sigmoidf_(1.5957691216057308f * (y + 0.044715f * y * y * y)); }

struct P {
    const float* in[33];
    float* out;
    unsigned char* ws;
};

typedef const P __attribute__((address_space(4)))* KP;
__device__ __forceinline__ KP get_kp() { KP k = (KP)__builtin_amdgcn_kernarg_segment_ptr(); asm volatile("" : "+s"(k)); return k; }

constexpr size_t WS_CTL = (WS_END + 4095) & ~(size_t)4095;
constexpr size_t CTL_BYTES = 65536;
static_assert(WS_CTL + CTL_BYTES <= 268435456ull, "workspace fits 256 MiB");
constexpr int NTHREADS = 512, NWAVES = 8;
constexpr int LDS_BYTES = 147456;
constexpr int LDS_MISC = 135168;

#define LAS __attribute__((address_space(3)))
#define XB_TMO      128
#define XB_XCNT(j)  (256  + 64 * (j))
#define XB_XSUB(j)  (1280 + 64 * (j))
#define XB_XGEN(j)  (2304 + 64 * (j))
#define XB_TOP      3328
#define XB_TOPGEN   3392
#define XCD_BAR_WORDS 3456
#define XB_SPIN_CAP (1u << 18)
__device__ __forceinline__ unsigned xb_ld(unsigned* p)              { return __hip_atomic_load(p, __ATOMIC_RELAXED, __HIP_MEMORY_SCOPE_AGENT); }
__device__ __forceinline__ unsigned xb_add(unsigned* p, unsigned v) { return __hip_atomic_fetch_add(p, v, __ATOMIC_RELAXED, __HIP_MEMORY_SCOPE_AGENT); }
__device__ __forceinline__ unsigned xb_xcc_id() { return (unsigned)__builtin_amdgcn_s_getreg((3 << 11) | 20) & 0xFu; }
#define XB_SPIN(cond, bar) do { unsigned _sp = 0; while (cond) { __builtin_amdgcn_s_sleep(1); \
    if ((++_sp & 255u) == 0u) { if (xb_ld(&(bar)[XB_TMO])) break; if (_sp > XB_SPIN_CAP) { atomicAdd(&(bar)[XB_TMO], 1u); break; } } } } while (0)
__device__ __forceinline__ int lane_id0() { return (int)__builtin_amdgcn_mbcnt_hi(~0u, __builtin_amdgcn_mbcnt_lo(~0u, 0u)); }
struct XcdBarrier { unsigned* bar; unsigned x; volatile LAS unsigned* st; int wave_s; };
__device__ __forceinline__ XcdBarrier xcd_barrier_post(unsigned* bar, volatile LAS unsigned* st, int wave_s) {
    XcdBarrier b; b.bar = bar; b.x = xb_xcc_id(); b.st = st; b.wave_s = wave_s;
    if (wave_s == 0 && lane_id0() == 0) (void)xb_add(&bar[XB_XCNT(b.x)], 1u);
    return b;
}
__device__ __forceinline__ void xcd_barrier_complete(unsigned* bar, unsigned x, unsigned& nloc, unsigned& nx) {
    const unsigned G = gridDim.x * gridDim.y * gridDim.z;
    unsigned sum, cnt, mine, sp = 0u;
    for (;;) {
        sum = 0u; cnt = 0u; mine = 0u;
#pragma unroll
        for (unsigned j = 0; j < 16; ++j) { const unsigned c = xb_ld(&bar[XB_XCNT(j)]); sum += c; cnt += (c > 0u) ? 1u : 0u; mine = (j == x) ? c : mine; }
        if (sum == G) break;
        __builtin_amdgcn_s_sleep(1);
        if ((++sp & 255u) == 0u) { if (xb_ld(&bar[XB_TMO])) break; if (sp > XB_SPIN_CAP) { atomicAdd(&bar[XB_TMO], 1u); break; } }
    }
    nloc = mine > 0u ? mine : 1u; nx = cnt > 0u ? cnt : 1u;
}
__device__ __forceinline__ void xcd_barrier(const XcdBarrier& b) {
    asm volatile("s_waitcnt vmcnt(0)" ::: "memory");
    __syncthreads();
    int zb_ = 0; asm volatile("" : "+v"(zb_));
    if (b.wave_s == 0 && (int)__builtin_amdgcn_mbcnt_hi(~0u, __builtin_amdgcn_mbcnt_lo(~0u, (unsigned)zb_)) == 0) {
        unsigned* bar = b.bar; asm volatile("" : "+s"(bar));
        unsigned bx = b.x; asm volatile("" : "+s"(bx));
        __builtin_amdgcn_s_waitcnt(0);
        unsigned nloc = b.st[0], nx = b.st[1];
        if (nloc == 0u) { xcd_barrier_complete(bar, bx, nloc, nx); b.st[0] = nloc; b.st[1] = nx; }
        const unsigned old = xb_add(&bar[XB_XSUB(bx)], 1u);
        const unsigned gen = old / nloc;
        if (old + 1u == (gen + 1u) * nloc) {
            __builtin_amdgcn_fence(__ATOMIC_RELEASE, "agent");
            asm volatile("s_waitcnt vmcnt(0)" ::: "memory");
            const unsigned og = xb_add(&bar[XB_TOP], 1u);
            const unsigned tg = og / nx;
            if (og + 1u == (tg + 1u) * nx) xb_add(&bar[XB_TOPGEN], 1u);
            else XB_SPIN(xb_ld(&bar[XB_TOPGEN]) == tg, bar);
            __builtin_amdgcn_fence(__ATOMIC_ACQUIRE, "agent");
            xb_add(&bar[XB_XGEN(bx)], 1u);
            asm volatile("s_waitcnt vmcnt(0)" ::: "memory");
        } else {
            XB_SPIN(xb_ld(&bar[XB_XGEN(bx)]) == gen, bar);
            __builtin_amdgcn_fence(__ATOMIC_ACQUIRE, "agent");
            asm volatile("s_waitcnt vmcnt(0)" ::: "memory");
        }
    }
    __syncthreads();
}

namespace pg8 {
#define PG8_LAS __attribute__((address_space(3)))
typedef unsigned short bf16_t;
typedef short bf16x8 __attribute__((ext_vector_type(8)));
typedef float f32x4 __attribute__((ext_vector_type(4)));
typedef unsigned u32x4 __attribute__((ext_vector_type(4)));
constexpr int BM = 256, BK = 64, HALF = 128, HTB = HALF * BK * 2  , STAGE_BYTES = 8 * HTB, NXCD = 8, WGM = 8;

__host__ __device__ __forceinline__ int lds_byte(int r, int c) { const int st = (r >> 4) * 2 + (c >> 5), rr = r & 15, cc = c & 31, ob = rr * 64 + cc * 2; return st * 1024 + (ob ^ (((ob >> 9) & 1) << 5)); }
__host__ __device__ __forceinline__ void stage_rc(int b, int& R, int& C) { const int st = b / 1024, sb = b % 1024, swz = sb ^ (((sb >> 9) & 1) << 5); R = (st >> 1) * 16 + swz / 64; C = (st & 1) * 32 + (swz % 64) / 2; }
__host__ __device__ __forceinline__ int perm32(int rho) { const int n = rho >> 4, i = rho & 15; return 8 * (i >> 2) + 4 * n + (i & 3); }

struct Unit { int pm, pn, z; };
struct Gemm { const bf16_t* A; int lda; const bf16_t* Bt; int K; };

struct StaticOrder {
    int nM, nN, nwg, G, c;
    __host__ __device__ void init(int M, int N, int G_, int c_) { nM = M / BM; nN = N / BM; nwg = nM * nN; G = G_; c = c_; }
    __host__ __device__ bool next(int i, Unit& u) const {
        const long L = (long)i * G + c; if (L >= nwg) return false;
        int wgid = (int)L; { const int q = nwg / NXCD, r = nwg % NXCD, xcd = wgid % NXCD, off = wgid / NXCD; wgid = (xcd < r ? xcd * (q + 1) : r * (q + 1) + (xcd - r) * q) + off; }
        const int nig = WGM * nN, gid = wgid / nig, fm = gid * WGM, gsz = (nM - fm) < WGM ? (nM - fm) : WGM;
        u.pm = fm + ((wgid % nig) % gsz); u.pn = (wgid % nig) / gsz; u.z = 0; return true;
    }
    __device__ __forceinline__ size_t a_off(const Unit&) const { return 0; }
    __device__ __forceinline__ size_t b_off(const Unit&) const { return 0; }
    __device__ __forceinline__ void a_ready(const Unit&) const {}
    __device__ __forceinline__ void done(const Unit&) const {}
};

__device__ __forceinline__ unsigned cvt_pk_bf16(float lo, float hi) { unsigned r; asm volatile("v_cvt_pk_bf16_f32 %0, %1, %2" : "=v"(r) : "v"(lo), "v"(hi)); return r; }
typedef float f32x2 __attribute__((ext_vector_type(2)));
__device__ __forceinline__ f32x2 gelu_pk(f32x2 v) {
    const f32x2 av = __builtin_elementwise_abs(v), d = av * 0.2316418882f + 1.0f;
    f32x2 t; t.x = __builtin_amdgcn_rcpf(d.x); t.y = __builtin_amdgcn_rcpf(d.y);
    f32x2 q = t * 0.5307027145f + (-0.7265760135f); q = q * t + 0.7107068705f; q = q * t + (-0.142248368f); q = q * t + 0.127414796f; q = q * t;
    const f32x2 s = (v * v) * (-0.72134752044f);
    f32x2 e; e.x = __builtin_amdgcn_exp2f(s.x); e.y = __builtin_amdgcn_exp2f(s.y);
    const f32x2 m = v * (q * e), r = v - m;
    f32x2 o; o.x = v.x < 0.f ? m.x : r.x; o.y = v.y < 0.f ? m.y : r.y; return o;
}

template <class Epi, class Sched, bool ALIGN_EPI = false, bool SP2 = false>
__device__ __forceinline__ void gemm_phase(PG8_LAS unsigned char* lds, const Gemm g, const Sched& S, const Epi& E, int wave_s) {
    int zv_ = 0; asm volatile("" : "+v"(zv_));
    const int tid = (wave_s << 6) | (int)__builtin_amdgcn_mbcnt_hi(~0u, __builtin_amdgcn_mbcnt_lo(~0u, (unsigned)zv_)), wid = __builtin_amdgcn_readfirstlane(tid >> 6), lane = tid & 63, wr = wid >> 2, wc = wid & 3, fr = lane & 15, fq = lane >> 4;
    const int K = g.K, nt = K / BK;
    unsigned voffA[2], voffB[2];
#pragma unroll
    for (int i = 0; i < 2; ++i) { int R, C; stage_rc(tid * 16 + i * 8192, R, C); const int Rb = Epi::PERM ? ((R & ~31) + perm32(R & 31)) : R;
        voffA[i] = (unsigned)(R * g.lda + C) * 2u; voffB[i] = (unsigned)(Rb * K + C) * 2u; }
    const size_t kstep = (size_t)(BK * 2);
    const size_t hstepA = (size_t)HALF * g.lda * 2, hstepB = (size_t)HALF * K * 2;
    const size_t tstepA = 2 * hstepA, tstepB = 2 * hstepB;
    const unsigned ldsw = (unsigned)wid * 1024u;
    const int aoff = lds_byte(wr * 64 + fr, fq * 8), boff = lds_byte(wc * 32 + fr, fq * 8);
#define PG8_SA(b, h) (((b) * 2 + (h)) * HTB)
#define PG8_SB(b, h) ((4 + (b) * 2 + (h)) * HTB)
#define PG8_STAGE(bufoff, gbase, voff) do { _Pragma("unroll") for (int _i = 0; _i < 2; ++_i) \
        __builtin_amdgcn_global_load_lds((const unsigned*)((const char*)(gbase) + (voff)[_i]), (PG8_LAS unsigned*)(lds + (bufoff) + ldsw + _i * 8192), 16, 0, 0); } while (0)
#define PG8_LDA(dst, b, h) do { _Pragma("unroll") for (int m = 0; m < 4; ++m) _Pragma("unroll") for (int k = 0; k < 2; ++k) dst[m][k] = *(const PG8_LAS bf16x8*)(lds + PG8_SA(b, h) + aoff + m * 2048 + k * 1024); } while (0)
#define PG8_LDB(dst, b, h) do { _Pragma("unroll") for (int n = 0; n < 2; ++n) _Pragma("unroll") for (int k = 0; k < 2; ++k) dst[n][k] = *(const PG8_LAS bf16x8*)(lds + PG8_SB(b, h) + boff + n * 2048 + k * 1024); } while (0)
#define PG8_MMA(ai, bj, At, Bt) do { __builtin_amdgcn_s_setprio(1); _Pragma("unroll") for (int m = 0; m < 4; ++m) _Pragma("unroll") for (int n = 0; n < 2; ++n) _Pragma("unroll") for (int k = 0; k < 2; ++k) \
        acc[ai][bj][m][n] = __builtin_amdgcn_mfma_f32_16x16x32_bf16(Bt[n][k], At[m][k], acc[ai][bj][m][n], 0, 0, 0); __builtin_amdgcn_s_setprio(0); } while (0)
#define PG8_WAIT_V(n) asm volatile("s_waitcnt vmcnt(" #n ")" ::: "memory")
#define PG8_WAIT_L(n) asm volatile("s_waitcnt lgkmcnt(" #n ")" ::: "memory")
#define PG8_BAR __builtin_amdgcn_s_barrier()
#define PG8_SCHED __builtin_amdgcn_sched_barrier(0)
    Unit cur, nxt; int ui = 0;
    if (!S.next(0, cur)) return;
    f32x4 acc[2][2][4][2];
#pragma unroll
    for (int a = 0; a < 2; ++a)
#pragma unroll
        for (int b = 0; b < 2; ++b)
#pragma unroll
            for (int m = 0; m < 4; ++m)
#pragma unroll
                for (int n = 0; n < 2; ++n) acc[a][b][m][n] = (f32x4){0.f, 0.f, 0.f, 0.f};
    bf16x8 At[4][2], B0[2][2], B1[2][2];
    const char* cA = (const char*)g.A + (size_t)cur.pm * tstepA + S.a_off(cur); const char* cB = (const char*)g.Bt + (size_t)cur.pn * tstepB + S.b_off(cur);
    S.a_ready(cur);
    if constexpr (SP2) {
        PG8_STAGE(PG8_SB(0, 0), cB, voffB); PG8_STAGE(PG8_SB(0, 1), cB + hstepB, voffB); PG8_STAGE(PG8_SA(0, 0), cA, voffA); PG8_STAGE(PG8_SA(0, 1), cA + hstepA, voffA);
        if (wr == 1) PG8_BAR;
        PG8_WAIT_V(2); PG8_BAR;
        PG8_STAGE(PG8_SB(1, 0), cB + kstep, voffB); PG8_STAGE(PG8_SA(1, 0), cA + kstep, voffA); PG8_STAGE(PG8_SB(1, 1), cB + hstepB + kstep, voffB);
        PG8_WAIT_V(6); PG8_BAR;
    } else {
        PG8_STAGE(PG8_SB(0, 0), cB, voffB); PG8_STAGE(PG8_SA(0, 0), cA, voffA); PG8_STAGE(PG8_SB(0, 1), cB + hstepB, voffB); PG8_STAGE(PG8_SA(0, 1), cA + hstepA, voffA);
        if (wr == 1) PG8_BAR;
        PG8_WAIT_V(4); PG8_BAR;
        PG8_STAGE(PG8_SB(1, 0), cB + kstep, voffB); PG8_STAGE(PG8_SA(1, 0), cA + kstep, voffA); PG8_STAGE(PG8_SB(1, 1), cB + hstepB + kstep, voffB);
        PG8_WAIT_V(6); PG8_BAR;
    }
    for (;;) {
        const bool has_next = S.next(ui + 1, nxt);
        const char* nA = has_next ? (const char*)g.A + (size_t)nxt.pm * tstepA + S.a_off(nxt) : cA; const char* nB = has_next ? (const char*)g.Bt + (size_t)nxt.pn * tstepB + S.b_off(nxt) : cB;
        for (int t = 0; t < nt; t += 2) {
            if constexpr (Epi::MIDSCALE) { if (t == 8 || t == 16) E.rescale(acc, cur, (t >> 3) - 1, wr, wc, fr, fq); }
            const bool last = (t == nt - 2);
            const char* a1 = cA + (size_t)(t + 1) * kstep;
            const char* a2 = last ? nA : cA + (size_t)(t + 2) * kstep; const char* b2 = last ? nB : cB + (size_t)(t + 2) * kstep;
            const char* a3 = a2 + kstep; const char* b3 = b2 + kstep;
            if (last && has_next) S.a_ready(nxt);
            if constexpr (SP2) {
            PG8_LDB(B0, 0, 0); PG8_LDB(B1, 0, 1); PG8_SCHED; PG8_LDA(At, 0, 0); PG8_STAGE(PG8_SA(1, 1), a1 + hstepA, voffA);
            PG8_WAIT_V(8); PG8_WAIT_L(0); PG8_BAR; PG8_MMA(0, 0, At, B0); PG8_MMA(0, 1, At, B1); PG8_BAR; PG8_SCHED;
            PG8_LDA(At, 0, 1); PG8_STAGE(PG8_SB(0, 0), b2, voffB); PG8_STAGE(PG8_SB(0, 1), b2 + hstepB, voffB); PG8_STAGE(PG8_SA(0, 0), a2, voffA);
            PG8_WAIT_V(8); PG8_WAIT_L(0); PG8_BAR; PG8_MMA(1, 0, At, B0); PG8_MMA(1, 1, At, B1); PG8_BAR; PG8_SCHED;
            PG8_LDB(B0, 1, 0); PG8_LDB(B1, 1, 1); PG8_SCHED; PG8_LDA(At, 1, 0); PG8_STAGE(PG8_SA(0, 1), a2 + hstepA, voffA);
            PG8_WAIT_V(8); PG8_WAIT_L(0); PG8_BAR; PG8_MMA(0, 0, At, B0); PG8_MMA(0, 1, At, B1); PG8_BAR; PG8_SCHED;
            PG8_LDA(At, 1, 1); PG8_STAGE(PG8_SB(1, 0), b3, voffB); PG8_STAGE(PG8_SB(1, 1), b3 + hstepB, voffB); PG8_STAGE(PG8_SA(1, 0), a3, voffA);
            PG8_WAIT_V(8); PG8_WAIT_L(0); PG8_BAR; PG8_MMA(1, 0, At, B0); PG8_MMA(1, 1, At, B1); PG8_BAR; PG8_SCHED;
            } else {
            PG8_LDB(B0, 0, 0); PG8_SCHED; PG8_LDA(At, 0, 0); PG8_STAGE(PG8_SA(1, 1), a1 + hstepA, voffA);
            PG8_WAIT_L(8); PG8_BAR; PG8_WAIT_L(0); PG8_MMA(0, 0, At, B0); PG8_BAR; PG8_SCHED;
            PG8_LDB(B1, 0, 1); PG8_STAGE(PG8_SB(0, 0), b2, voffB);
            PG8_BAR; PG8_WAIT_L(0); PG8_MMA(0, 1, At, B1); PG8_BAR;
            PG8_LDA(At, 0, 1); PG8_STAGE(PG8_SA(0, 0), a2, voffA);
            PG8_BAR; PG8_WAIT_L(0); PG8_MMA(1, 0, At, B0); PG8_BAR; PG8_SCHED;
            PG8_STAGE(PG8_SB(0, 1), b2 + hstepB, voffB);
            PG8_WAIT_V(6); PG8_BAR; PG8_MMA(1, 1, At, B1); PG8_BAR;
            PG8_LDB(B0, 1, 0); PG8_SCHED; PG8_LDA(At, 1, 0); PG8_STAGE(PG8_SA(0, 1), a2 + hstepA, voffA);
            PG8_WAIT_L(8); PG8_BAR; PG8_WAIT_L(0); PG8_MMA(0, 0, At, B0); PG8_BAR; PG8_SCHED;
            PG8_LDB(B1, 1, 1); PG8_STAGE(PG8_SB(1, 0), b3, voffB);
            PG8_BAR; PG8_WAIT_L(0); PG8_MMA(0, 1, At, B1); PG8_BAR;
            PG8_LDA(At, 1, 1); PG8_STAGE(PG8_SA(1, 0), a3, voffA);
            PG8_BAR; PG8_WAIT_L(0); PG8_MMA(1, 0, At, B0); PG8_BAR; PG8_SCHED;
            PG8_STAGE(PG8_SB(1, 1), b3 + hstepB, voffB);
            PG8_WAIT_V(6); PG8_BAR; PG8_MMA(1, 1, At, B1); PG8_BAR;
            }
        }
        if constexpr (ALIGN_EPI) { if (wr == 0) PG8_BAR; }
        if constexpr (!Epi::AFTER_DRAIN) { E(acc, cur, wr, wc, fr, fq); S.done(cur); }
        if (!has_next) break;
#pragma unroll
        for (int a = 0; a < 2; ++a)
#pragma unroll
            for (int b = 0; b < 2; ++b)
#pragma unroll
                for (int m = 0; m < 4; ++m)
#pragma unroll
                    for (int n = 0; n < 2; ++n) acc[a][b][m][n] = (f32x4){0.f, 0.f, 0.f, 0.f};
        cur = nxt; cA = nA; cB = nB; ++ui;
        if constexpr (ALIGN_EPI) { if (wr == 1) PG8_BAR; }
    }
    PG8_WAIT_V(0);
    if constexpr (!ALIGN_EPI) { if (wr == 0) PG8_BAR; }
    PG8_BAR;
    if constexpr (Epi::AFTER_DRAIN) { E.fused(acc, cur, wr, wc, fr, fq, lds, wid, lane); S.done(cur); }
#undef PG8_SA
#undef PG8_SB
#undef PG8_STAGE
#undef PG8_LDA
#undef PG8_LDB
#undef PG8_MMA
#undef PG8_WAIT_V
#undef PG8_WAIT_L
#undef PG8_BAR
#undef PG8_SCHED
}
}

namespace pg8 {
typedef unsigned u32x2 __attribute__((ext_vector_type(2)));
__device__ __forceinline__ float bflo(unsigned w) { return __uint_as_float(w << 16); }
__device__ __forceinline__ float bfhi(unsigned w) { return __uint_as_float(w & 0xffff0000u); }
__device__ __forceinline__ float sigm(float x) { return __builtin_amdgcn_rcpf(1.0f + __builtin_amdgcn_exp2f(-1.4426950408889634f * x)); }
struct EpiProjB {
    static constexpr bool PERM = true, AFTER_DRAIN = false, MIDSCALE = false;
    bf16_t* O; int ldc;
    __device__ __forceinline__ void operator()(const f32x4 (&acc)[2][2][4][2], const Unit& u, int wr, int wc, int fr, int fq) const {
        const int row0 = u.pm * BM + wr * 64 + fr, col0 = u.pn * BM + wc * 32 + 8 * fq;
        const bool gate = u.pn >= C_GM / BM;
#pragma unroll
        for (int ai = 0; ai < 2; ++ai)
#pragma unroll
            for (int m = 0; m < 4; ++m) { bf16_t* rowp = O + (size_t)(row0 + ai * HALF + m * 16) * ldc + col0;
#pragma unroll
                for (int bj = 0; bj < 2; ++bj) { f32x4 v0 = acc[ai][bj][m][0], v1 = acc[ai][bj][m][1];
                    if (gate) {
#pragma unroll
                        for (int e = 0; e < 4; ++e) { v0[e] = 1.0f + __builtin_amdgcn_exp2f(fminf(-1.4426950408889634f * v0[e], 100.f)); v1[e] = 1.0f + __builtin_amdgcn_exp2f(fminf(-1.4426950408889634f * v1[e], 100.f)); } }
                    u32x4 w; w.x = cvt_pk_bf16(v0[0], v0[1]); w.y = cvt_pk_bf16(v0[2], v0[3]); w.z = cvt_pk_bf16(v1[0], v1[1]); w.w = cvt_pk_bf16(v1[2], v1[3]);
                    *(u32x4*)(rowp + bj * HALF) = w; } }
    }
};
struct EpiGluB {
    static constexpr bool PERM = true, AFTER_DRAIN = false, MIDSCALE = false;
    bf16_t* PROJ; bool dry;
    __device__ __forceinline__ void operator()(const f32x4 (&acc)[2][2][4][2], const Unit& u, int wr, int wc, int fr, int fq) const {
        const int row0 = u.pm * BM + wr * 64 + fr, col0 = u.pn * BM + wc * 32 + 8 * fq;
        u32x4 zz[2][2][2], gg[2][2][2];
#define GL_ISSUE(g) do { const int ai_ = (g) >> 1, m0_ = 2 * ((g) & 1); _Pragma("unroll") for (int mm = 0; mm < 2; ++mm) { \
            const bf16_t* rowp = PROJ + (size_t)(row0 + ai_ * HALF + (m0_ + mm) * 16) * IN_COLS + col0; \
            _Pragma("unroll") for (int bj = 0; bj < 2; ++bj) { zz[(g) & 1][mm][bj] = *(const u32x4*)(rowp + C_UB + bj * HALF); gg[(g) & 1][mm][bj] = *(const u32x4*)(rowp + C_GB + bj * HALF); } } } while (0)
        GL_ISSUE(0);
#pragma unroll
        for (int ah = 0; ah < 4; ++ah) { const int ai = ah >> 1, m0 = 2 * (ah & 1);
            if (ah + 1 < 4) GL_ISSUE(ah + 1);
            __builtin_amdgcn_sched_barrier(0);
#pragma unroll
            for (int mm = 0; mm < 2; ++mm) { const int m = m0 + mm; bf16_t* rowp = PROJ + (size_t)(row0 + ai * HALF + m * 16) * IN_COLS + col0;
#pragma unroll
                for (int bj = 0; bj < 2; ++bj) {
                    const f32x4 v0 = acc[ai][bj][m][0], v1 = acc[ai][bj][m][1];
                    float o[8];
#pragma unroll
                    for (int e = 0; e < 4; ++e) {
                        const float va = e < 2 ? v0[2 * e] : v1[2 * (e - 2)], vb = e < 2 ? v0[2 * e + 1] : v1[2 * (e - 2) + 1];
                        const unsigned wz = zz[ah & 1][mm][bj][e], wg = gg[ah & 1][mm][bj][e];
                        const float za = bflo(wz), zb = bfhi(wz), ga = bflo(wg), gb = bfhi(wg);
                        o[2 * e] = za * sigm(va) * ga * sigm(ga); o[2 * e + 1] = zb * sigm(vb) * gb * sigm(gb);
                    }
                    u32x4 w; w.x = cvt_pk_bf16(o[0], o[1]); w.y = cvt_pk_bf16(o[2], o[3]); w.z = cvt_pk_bf16(o[4], o[5]); w.w = cvt_pk_bf16(o[6], o[7]);
                    if (!dry) *(u32x4*)(rowp + C_GB + bj * HALF) = w; } }
        }
#undef GL_ISSUE
    }
};
#ifndef RS_DEPTH
#define RS_DEPTH 1
#endif
struct EpiMergeB {
    static constexpr bool PERM = true, AFTER_DRAIN = false, MIDSCALE = true;
    bf16_t* PROJ; bool dry;
    __device__ __forceinline__ void rescale(f32x4 (&acc)[2][2][4][2], const Unit& u, int step, int wr, int wc, int fr, int fq) const {
        int zr = 0; asm volatile("" : "+v"(zr));
        const int row0 = u.pm * BM + wr * 64 + fr + zr, col0 = u.pn * BM + wc * 32 + 8 * fq;
        constexpr int DEPTH_ = RS_DEPTH;
        u32x4 ga[DEPTH_ + 1][2][2], gb[DEPTH_ + 1][2][2];
#define RS_ISSUE(g) do { const int ai_ = (g) >> 1, m0_ = 2 * ((g) & 1); _Pragma("unroll") for (int mm = 0; mm < 2; ++mm) { \
            const bf16_t* rowp = PROJ + (size_t)(row0 + ai_ * HALF + (m0_ + mm) * 16) * IN_COLS + C_GM + step * 1024 + col0; \
            _Pragma("unroll") for (int bj = 0; bj < 2; ++bj) { ga[(g) % (DEPTH_ + 1)][mm][bj] = *(const u32x4*)(rowp + bj * HALF); gb[(g) % (DEPTH_ + 1)][mm][bj] = *(const u32x4*)(rowp + 1024 + bj * HALF); } } } while (0)
#pragma unroll
        for (int g = 0; g < DEPTH_; ++g) RS_ISSUE(g);
#pragma unroll
        for (int ah = 0; ah < 4; ++ah) { const int ai = ah >> 1, m0 = 2 * (ah & 1);
            if (ah + DEPTH_ < 4) RS_ISSUE(ah + DEPTH_);
            __builtin_amdgcn_sched_barrier(0);
#pragma unroll
            for (int mm = 0; mm < 2; ++mm)
#pragma unroll
                for (int bj = 0; bj < 2; ++bj)
#pragma unroll
                    for (int e = 0; e < 4; ++e) { const int m = m0 + mm; const unsigned wa = ga[ah % (DEPTH_ + 1)][mm][bj][e], wb = gb[ah % (DEPTH_ + 1)][mm][bj][e];
                        const float r0 = bflo(wb) * __builtin_amdgcn_rcpf(bflo(wa)), r1 = bfhi(wb) * __builtin_amdgcn_rcpf(bfhi(wa));
                        if (e < 2) { acc[ai][bj][m][0][2 * e] *= r0; acc[ai][bj][m][0][2 * e + 1] *= r1; } else { acc[ai][bj][m][1][2 * (e - 2)] *= r0; acc[ai][bj][m][1][2 * (e - 2) + 1] *= r1; }
                    }
        }
#undef RS_ISSUE
    }
    __device__ __forceinline__ void operator()(const f32x4 (&acc)[2][2][4][2], const Unit& u, int wr, int wc, int fr, int fq) const {
        const int row0 = u.pm * BM + wr * 64 + fr, col0 = u.pn * BM + wc * 32 + 8 * fq;
        u32x4 gg[2][4][2];
#pragma unroll
        for (int ai = 0; ai < 2; ++ai)
#pragma unroll
            for (int m = 0; m < 4; ++m) { const bf16_t* rowp = PROJ + (size_t)(row0 + ai * HALF + m * 16) * IN_COLS + C_GM + 2048 + col0;
#pragma unroll
                for (int bj = 0; bj < 2; ++bj) gg[ai][m][bj] = *(const u32x4*)(rowp + bj * HALF); }
        __builtin_amdgcn_sched_barrier(0);
#pragma unroll
        for (int ai = 0; ai < 2; ++ai)
#pragma unroll
            for (int m = 0; m < 4; ++m) { bf16_t* rowp = PROJ + (size_t)(row0 + ai * HALF + m * 16) * IN_COLS + C_GM + col0;
#pragma unroll
                for (int bj = 0; bj < 2; ++bj) {
                    const f32x4 v0 = acc[ai][bj][m][0], v1 = acc[ai][bj][m][1];
                    float o[8];
#pragma unroll
                    for (int e = 0; e < 4; ++e) {
                        const float va = e < 2 ? v0[2 * e] : v1[2 * (e - 2)], vb = e < 2 ? v0[2 * e + 1] : v1[2 * (e - 2) + 1];
                        o[2 * e] = __builtin_amdgcn_rcpf(bflo(gg[ai][m][bj][e])) * va; o[2 * e + 1] = __builtin_amdgcn_rcpf(bfhi(gg[ai][m][bj][e])) * vb;
                    }
                    u32x4 w; w.x = cvt_pk_bf16(o[0], o[1]); w.y = cvt_pk_bf16(o[2], o[3]); w.z = cvt_pk_bf16(o[4], o[5]); w.w = cvt_pk_bf16(o[6], o[7]);
                    if (!dry) *(u32x4*)(rowp + bj * HALF) = w; } }
    }
};
struct EpiOutB {
    static constexpr bool PERM = true, AFTER_DRAIN = false, MIDSCALE = false;
    const bf16_t* XB; unsigned char* ws;
    __device__ __forceinline__ void operator()(const f32x4 (&acc)[2][2][4][2], const Unit& u, int wr, int wc, int fr, int fq) const {
        const int row0 = u.pm * BM + wr * 64 + fr, col0 = u.pn * BM + wc * 32 + 8 * fq;
        u32x4 xx[2][4][2];
#pragma unroll
        for (int ai = 0; ai < 2; ++ai)
#pragma unroll
            for (int m = 0; m < 4; ++m) { const bf16_t* xrow = XB + (size_t)(row0 + ai * HALF + m * 16) * D_MODEL + col0;
#pragma unroll
                for (int bj = 0; bj < 2; ++bj) xx[ai][m][bj] = *(const u32x4*)(xrow + bj * HALF); }
        __builtin_amdgcn_sched_barrier(0);
#pragma unroll
        for (int ai = 0; ai < 2; ++ai)
#pragma unroll
            for (int m = 0; m < 4; ++m) { const int r = row0 + ai * HALF + m * 16;
                bf16_t* prow = (bf16_t*)(ws + WS_PROJ + (size_t)r * IN_COLS * 2 + (size_t)(C_GM + 1024) * 2) + col0;
#pragma unroll
                for (int bj = 0; bj < 2; ++bj) { const u32x4 w = xx[ai][m][bj];
                    const f32x4 o0 = (f32x4){bflo(w.x), bfhi(w.x), bflo(w.y), bfhi(w.y)} * DN_ALPHA + acc[ai][bj][m][0], o1 = (f32x4){bflo(w.z), bfhi(w.z), bflo(w.w), bfhi(w.w)} * DN_ALPHA + acc[ai][bj][m][1];
                    u32x4 ow; ow.x = cvt_pk_bf16(o0[0], o0[1]); ow.y = cvt_pk_bf16(o0[2], o0[3]); ow.z = cvt_pk_bf16(o1[0], o1[1]); ow.w = cvt_pk_bf16(o1[2], o1[3]);
                    *(u32x4*)(prow + bj * HALF) = ow; } }
    }
};
}

__device__ __forceinline__ int lane_id() { return (int)__builtin_amdgcn_mbcnt_hi(~0u, __builtin_amdgcn_mbcnt_lo(~0u, 0u)); }
__device__ __forceinline__ int tid_of(int wave_s, int zv) { return (wave_s << 6) | (int)__builtin_amdgcn_mbcnt_hi(~0u, __builtin_amdgcn_mbcnt_lo(~0u, (unsigned)zv)); }
struct Halves { float lo, hi; };
__device__ __forceinline__ Halves halves(float v) { const unsigned u = __float_as_uint(v); auto rr = __builtin_amdgcn_permlane32_swap(u, u, false, false); return Halves{__uint_as_float(rr[0]), __uint_as_float(rr[1])}; }
template <int O> __device__ __forceinline__ float xor_lane(float v) { return __int_as_float(__builtin_amdgcn_ds_swizzle(__float_as_int(v), (O << 10) | 0x1F)); }
__device__ __forceinline__ float wave_sum(float v) { v += xor_lane<1>(v); v += xor_lane<2>(v); v += xor_lane<4>(v); v += xor_lane<8>(v); v += xor_lane<16>(v); const Halves hh = halves(v); return hh.lo + hh.hi; }
struct Ctx { int tid, lane, wave, gw, ngw; size_t gt, ngt; };
__device__ __forceinline__ Ctx make_ctx(int wave_s) {
    int zv = 0; asm volatile("" : "+v"(zv)); int zs = 0; asm volatile("" : "+s"(zs));
    Ctx c; c.tid = tid_of(wave_s, zv); c.lane = c.tid & 63; c.wave = __builtin_amdgcn_readfirstlane(c.tid >> 6);
    const int bid = (int)blockIdx.x + zs, nb = (int)gridDim.x + zs;
    c.gw = c.wave * nb + bid; c.ngw = nb * NWAVES; c.gt = (size_t)bid * NTHREADS + c.tid; c.ngt = (size_t)nb * NTHREADS; return c;
}
__device__ __forceinline__ Ctx group_ctx(const Ctx& c, int w0, int nw) {
    Ctx g = c; const int nb = c.ngw / NWAVES, bid = c.gw - c.wave * nb; g.gw = (c.wave - w0) * nb + bid; g.ngw = nw * nb; return g; }
__device__ __forceinline__ Ctx waveset_ctx(const Ctx& c, int rank, int size) {
    Ctx g = c; const int nb = c.ngw / NWAVES, bid = c.gw - c.wave * nb; g.gw = rank * nb + bid; g.ngw = size * nb; return g; }
#define WAVE_LDS_SYNC() do { asm volatile("s_waitcnt lgkmcnt(0)" ::: "memory"); __builtin_amdgcn_wave_barrier(); } while (0)

__device__ __forceinline__ void st_convert_x(KP p, const Ctx& c) {
    u32x4* XB = (u32x4*)(p->ws + WS_XB);
    const size_t n8 = (size_t)M_TOT * D_MODEL / 8, np8 = (size_t)M_P * D_MODEL / 8;
    for (size_t i0 = c.gt; i0 < n8; i0 += 4 * c.ngt) {
        f32x4 a[4], b[4];
#pragma unroll
        for (int u = 0; u < 4; ++u) { const size_t i = i0 + u * c.ngt; if (i < n8) { const f32x4* src = i < np8 ? (const f32x4*)p->in[0] + 2 * i : (const f32x4*)p->in[1] + 2 * (i - np8); a[u] = src[0]; b[u] = src[1]; } }
#pragma unroll
        for (int u = 0; u < 4; ++u) { const size_t i = i0 + u * c.ngt; if (i < n8) { u32x4 o; o.x = cvtpk(a[u][0], a[u][1]); o.y = cvtpk(a[u][2], a[u][3]); o.z = cvtpk(b[u][0], b[u][1]); o.w = cvtpk(b[u][2], b[u][3]); XB[i] = o; } }
    }
}

__device__ __forceinline__ unsigned pk2bf(float lo, float hi) { return (unsigned)f2bf(lo) | ((unsigned)f2bf(hi) << 16); }
__device__ __forceinline__ void p0_transpose_item(const float* W, int K, int N, bf16_t* WT, int ldk, int koff, bool perm, LAS float* scr, int item, int lane) {
    const int nblk = N / 32, kb = item / nblk, nb = item % nblk, k0 = 64 * kb, n0 = 32 * nb, d0 = perm ? colperm32(n0) : n0;
    float wv[32];
#pragma unroll
    for (int i = 0; i < 32; ++i) wv[i] = W[(size_t)(k0 + 2 * i + (lane >> 5)) * N + n0 + (lane & 31)];
#pragma unroll
    for (int i = 0; i < 32; ++i) scr[(2 * i + (lane >> 5)) * 33 + (lane & 31)] = wv[i];
    WAVE_LDS_SYNC();
    const int cch = lane & 7;
#pragma unroll
    for (int j = 0; j < 4; ++j) { const int n = (lane >> 3) + 8 * j; const LAS float* sp = scr + (8 * cch) * 33 + n;
        u32x4 o; o.x = pk2bf(sp[0 * 33], sp[1 * 33]); o.y = pk2bf(sp[2 * 33], sp[3 * 33]); o.z = pk2bf(sp[4 * 33], sp[5 * 33]); o.w = pk2bf(sp[6 * 33], sp[7 * 33]);
        *(u32x4*)(WT + (size_t)(d0 + n) * ldk + koff + k0 + 8 * cch) = o; }
    WAVE_LDS_SYNC();
}
__device__ __forceinline__ void st_prologue_weights(KP p, const Ctx& c, LAS float* scr, int l_lo, int l_hi) {
    unsigned char* dob = (unsigned char*)p->out;
    constexpr int I_IN = 16 * 200, I_BR = 8 * 32, I_GLU = 8 * 16, I_OUT = 16 * 32, I_LAYER = I_IN + 3 * I_BR + I_GLU + I_OUT;
    for (int it = l_lo * I_LAYER + c.gw; it < l_hi * I_LAYER; it += c.ngw) {
        const int l = it / I_LAYER; int r = it % I_LAYER;
        if (r < I_IN) { p0_transpose_item(p->in[9] + (size_t)l * 1024 * IN_COLS, 1024, IN_COLS, (bf16_t*)(dob + DO_WIN) + (size_t)l * IN_COLS * 1024, 1024, 0, true, scr, r, c.lane); continue; } r -= I_IN;
        if (r < I_BR) { p0_transpose_item(p->in[11] + (size_t)l * 512 * 1024, 512, 1024, (bf16_t*)(dob + DO_WBR) + (size_t)l * 1024 * 1536, 1536, 0, false, scr, r, c.lane); continue; } r -= I_BR;
        if (r < I_BR) { p0_transpose_item(p->in[21] + (size_t)l * 512 * 1024, 512, 1024, (bf16_t*)(dob + DO_WBR) + (size_t)l * 1024 * 1536, 1536, 512, false, scr, r, c.lane); continue; } r -= I_BR;
        if (r < I_BR) { p0_transpose_item(p->in[29] + (size_t)l * 512 * 1024, 512, 1024, (bf16_t*)(dob + DO_WBR) + (size_t)l * 1024 * 1536, 1536, 1024, false, scr, r, c.lane); continue; } r -= I_BR;
        if (r < I_GLU) { p0_transpose_item(p->in[20] + (size_t)l * 512 * 512, 512, 512, (bf16_t*)(dob + DO_WGLU) + (size_t)l * 512 * 512, 512, 0, false, scr, r, c.lane); continue; } r -= I_GLU;
        p0_transpose_item(p->in[30] + (size_t)l * 1024 * 1024, 1024, 1024, (bf16_t*)(p->ws + WS_WOUT) + (size_t)l * 1024 * 1024, 1024, 0, false, scr, r, c.lane);
    }
}
__device__ __forceinline__ f32x4 ld_bf4(const bf16_t* q) { typedef unsigned u32x2_t __attribute__((ext_vector_type(2))); const u32x2_t w = *(const u32x2_t*)q;
    return (f32x4){__uint_as_float(w.x << 16), __uint_as_float(w.x & 0xffff0000u), __uint_as_float(w.y << 16), __uint_as_float(w.y & 0xffff0000u)}; }
__device__ __forceinline__ void st_kv_out(KP p, int l, const Ctx& c) {
    const bf16_t* PROJ = (const bf16_t*)(p->ws + WS_PROJ);
    for (size_t ii = c.gt; ii < (size_t)BATCH * 3 * 128; ii += c.ngt) {
        const int i = (int)ii, b = i / 384, j = (i / 128) % 3, c4 = i % 128;
        *(f32x4*)(p->out + O_CP + (size_t)l * BATCH * 1536 + (size_t)i * 4) = ld_bf4(PROJ + ((size_t)b * SEQ + SEQ - 3 + j) * IN_COLS + C_XC + 4 * c4);
    }
    for (size_t ii = c.gt; ii < (size_t)DEC_BATCH * 3 * 128; ii += c.ngt) {
        const int i = (int)ii, b = i / 384, j = (i / 128) % 3, c4 = i % 128;
        *(f32x4*)(p->out + O_CS + (size_t)l * DEC_BATCH * 1536 + (size_t)i * 4) = ld_bf4(PROJ + ((size_t)M_P + 4 * b + 1 + j) * IN_COLS + C_XC + 4 * c4);
    }
    for (size_t ii = c.gt; ii < (size_t)BATCH * WINDOW * 32; ii += c.ngt) {
        const int i = (int)ii, b = i / (WINDOW * 32), w = (i / 32) % WINDOW, c4 = i % 32;
        const bf16_t* src = PROJ + ((size_t)b * SEQ + (SEQ - WINDOW) + w) * IN_COLS + 4 * c4;
        *(f32x4*)(p->out + O_KP + (size_t)l * BATCH * WINDOW * 128 + (size_t)i * 4) = ld_bf4(src + C_K);
        *(f32x4*)(p->out + O_VP + (size_t)l * BATCH * WINDOW * 128 + (size_t)i * 4) = ld_bf4(src + C_V);
    }
    for (size_t ii = c.gt; ii < (size_t)DEC_BATCH * DEC_SEQ * 32; ii += c.ngt) {
        const int i = (int)ii, b = i / (DEC_SEQ * 32), t = (i / 32) % DEC_SEQ, c4 = i % 32;
        const bf16_t* src = PROJ + ((size_t)M_P + b * DEC_SEQ + t) * IN_COLS + 4 * c4;
        const size_t o = (((size_t)l * DEC_BATCH + b) * WINDOW + (WINDOW - DEC_SEQ) + t) * 128 + 4 * c4;
        *(f32x4*)(p->out + O_KS + o) = ld_bf4(src + C_K); *(f32x4*)(p->out + O_VS + o) = ld_bf4(src + C_V);
    }
    constexpr int NSH = DEC_BATCH * (WINDOW - DEC_SEQ) * 32;
    for (size_t i0 = c.gt; i0 < (size_t)NSH; i0 += 4 * c.ngt) {
        f32x4 kk[4], vv[4];
#pragma unroll
        for (int u = 0; u < 4; ++u) { const size_t ii = i0 + u * c.ngt; if (ii < (size_t)NSH) { const int i = (int)ii, b = i / ((WINDOW - DEC_SEQ) * 32), r = i % ((WINDOW - DEC_SEQ) * 32);
            const size_t ci = (((size_t)l * DEC_BATCH + b) * WINDOW + DEC_SEQ) * 128 + (size_t)r * 4; kk[u] = *(const f32x4*)(p->in[2] + ci); vv[u] = *(const f32x4*)(p->in[3] + ci); } }
#pragma unroll
        for (int u = 0; u < 4; ++u) { const size_t ii = i0 + u * c.ngt; if (ii < (size_t)NSH) { const int i = (int)ii, b = i / ((WINDOW - DEC_SEQ) * 32), r = i % ((WINDOW - DEC_SEQ) * 32);
            const size_t o = ((size_t)l * DEC_BATCH + b) * WINDOW * 128 + (size_t)r * 4; *(f32x4*)(p->out + O_KS + o) = kk[u]; *(f32x4*)(p->out + O_VS + o) = vv[u]; } }
    }
}

typedef short s16x4 __attribute__((ext_vector_type(4)));
typedef short v4i16_t __attribute__((ext_vector_type(4)));
__device__ __forceinline__ bf16x8 pack8(float a0, float a1, float a2, float a3, float a4, float a5, float a6, float a7) {
    u32x4 p; p.x = cvtpk(a0, a1); p.y = cvtpk(a2, a3); p.z = cvtpk(a4, a5); p.w = cvtpk(a6, a7); return __builtin_bit_cast(bf16x8, p); }
__device__ __forceinline__ s16x4 tr_read(LAS const unsigned char* p) { return __builtin_bit_cast(s16x4, __builtin_amdgcn_ds_read_tr16_b64_v4i16((LAS v4i16_t*)p)); }
__device__ __forceinline__ bf16x8 cat8(s16x4 lo, s16x4 hi) { return __builtin_shufflevector(lo, hi, 0, 1, 2, 3, 4, 5, 6, 7); }
#define MFMA_SETTLE2(a, b) asm volatile("s_nop 15\n\ts_nop 7" : "+v"(a), "+v"(b))
#define MFMA_SETTLE3(a, b, c) asm volatile("s_nop 15\n\ts_nop 7" : "+v"(a), "+v"(b), "+v"(c))
#define MFMA32(a, b, c) __builtin_amdgcn_mfma_f32_32x32x16_bf16((a), (b), (c), 0, 0, 0)
#define MFMA16(a, b, c) __builtin_amdgcn_mfma_f32_16x16x32_bf16((a), (b), (c), 0, 0, 0)

constexpr int AT_KSTR = 144, AT_VSTR = 192;
constexpr int AT_K = 0, AT_V = AT_K + 256 * AT_KSTR, AT_BIAS = AT_V + 256 * AT_VSTR, AT_WS = AT_BIAS + 4 * 128 * 4, AT_END = AT_WS + 8 * 256;
static_assert(AT_END <= 131072, "attention LDS");

__device__ __forceinline__ void st_attn_prompt(KP p, int l, LAS unsigned char* lds, bool dry, int wave_s) {
    int zv = 0; asm volatile("" : "+v"(zv));
    const int tid = tid_of(wave_s, zv), lane = tid & 63, wave = __builtin_amdgcn_readfirstlane(tid >> 6);
    const int c31 = lane & 31, h = lane >> 5;
    bf16_t* PROJ = (bf16_t*)(p->ws + WS_PROJ);
    const float* rel_bias = p->in[8];
    for (int item = blockIdx.x; item < BATCH * 16 * NKV; item += gridDim.x) {
        const int b = item / 32, nb = (item >> 1) & 15, kvh = item & 1;
        const size_t rowq0 = (size_t)b * SEQ + (size_t)nb * 128;
#pragma unroll
        for (int i = 0; i < 4; ++i) {
            const int id = tid + 512 * i, row = id >> 3, pc = id & 7;
            u32x4 kk = (u32x4){0u, 0u, 0u, 0u}, vv = kk;
            if (nb > 0 || row >= 128) {
                const bf16_t* src = PROJ + (rowq0 - 128 + row) * IN_COLS + kvh * 64 + pc * 8;
                kk = *(const u32x4*)(src + C_K); vv = *(const u32x4*)(src + C_V);
            }
            *(LAS u32x4*)(lds + AT_K + row * AT_KSTR + pc * 16) = kk;
            *(LAS u32x4*)(lds + AT_V + row * AT_VSTR + pc * 16) = vv;
        }
        { const int g = tid >> 7, d = tid & 127; ((LAS float*)(lds + AT_BIAS))[tid] = rel_bias[T5_BUCKET[d] * NQH + kvh * 4 + g]; }
        const int g = wave >> 1, hq = kvh * 4 + g;
        bf16x8 qfn[4];
        { const bf16_t* qp = PROJ + (rowq0 + 64 * (wave & 1) + c31) * IN_COLS + C_Q + hq * 64 + 8 * h;
#pragma unroll
          for (int ks = 0; ks < 4; ++ks) qfn[ks] = *(const bf16x8*)(qp + 16 * ks); }
        __syncthreads();
        const float sink = p->in[10][l * NQH + hq];
        LAS const float* biasd = (LAS const float*)(lds + AT_BIAS) + g * 128;
        LAS float* wsf = (LAS float*)(lds + AT_WS + wave * 256);
#pragma unroll 1
        for (int qi = 0; qi < 2; ++qi) {
            const int qt = 2 * (wave & 1) + qi, q0 = 32 * qt;
            bf16x8 qf[4];
#pragma unroll
            for (int ks = 0; ks < 4; ++ks) qf[ks] = qfn[ks];
            if (qi == 0) { const bf16_t* qp = PROJ + (rowq0 + q0 + 32 + c31) * IN_COLS + C_Q + hq * 64 + 8 * h;
#pragma unroll
                for (int ks = 0; ks < 4; ++ks) qfn[ks] = *(const bf16x8*)(qp + 16 * ks); }
            f32x16 S[5];
#pragma unroll
            for (int j = 0; j < 5; ++j) {
                S[j] = (f32x16){};
                LAS const unsigned char* kp = lds + AT_K + (32 * (qt + j) + c31) * AT_KSTR + 16 * h;
#pragma unroll
                for (int ks = 0; ks < 4; ++ks) S[j] = MFMA32(*(LAS const bf16x8*)(kp + 32 * ks), qf[ks], S[j]);
            }
            asm volatile("s_nop 15\n\ts_nop 7" : "+v"(S[0]), "+v"(S[1]), "+v"(S[2]), "+v"(S[3]), "+v"(S[4]));
            float gav[16][2];
#pragma unroll
            for (int r = 0; r < 16; ++r) {
                const bf16_t* rowp = PROJ + (rowq0 + q0 + (r & 3) + 8 * (r >> 2) + 4 * h) * IN_COLS + hq * 64 + c31;
                gav[r][0] = bf2f(rowp[C_GA]); gav[r][1] = bf2f(rowp[C_GA + 32]);
            }
            const int iq = q0 + c31;
            float mx = sink;
#pragma unroll
            for (int j = 0; j < 5; ++j)
#pragma unroll
                for (int r = 0; r < 16; ++r) {
                    const int kv = 32 * (qt + j) + (r & 3) + 8 * (r >> 2) + 4 * h;
                    const int dist = iq + 128 - kv;
                    const bool ok = (dist >= 0) && (dist < 128) && (nb > 0 || kv >= 128);
                    const float s = ok ? S[j][r] * 0.125f + biasd[dist & 127] : -1e30f;
                    S[j][r] = s; mx = fmaxf(mx, s);
                }
            { const Halves hh = halves(mx); mx = fmaxf(hh.lo, hh.hi); }
            float sum = 0.f;
#pragma unroll
            for (int j = 0; j < 5; ++j)
#pragma unroll
                for (int r = 0; r < 16; ++r) { const float e = S[j][r] > -1e29f ? __expf(S[j][r] - mx) : 0.f; S[j][r] = e; sum += e; }
            { const Halves hh = halves(sum); sum = hh.lo + hh.hi; }
            const float rden = 1.0f / (sum + __expf(sink - mx));
            if (h == 0) wsf[c31] = rden;
            f32x16 O[2]; O[0] = (f32x16){}; O[1] = (f32x16){};
            const int i16 = lane & 15, qq = i16 >> 2, pp = i16 & 3, blk = (lane >> 4) & 1;
#pragma unroll
            for (int j = 0; j < 5; ++j)
#pragma unroll
                for (int s = 0; s < 2; ++s) {
                    const bf16x8 pf = pack8(S[j][8 * s], S[j][8 * s + 1], S[j][8 * s + 2], S[j][8 * s + 3], S[j][8 * s + 4], S[j][8 * s + 5], S[j][8 * s + 6], S[j][8 * s + 7]);
                    LAS const unsigned char* vp = lds + AT_V + (32 * (qt + j) + 16 * s + 4 * h + qq) * AT_VSTR + (16 * blk + 4 * pp) * 2;
#pragma unroll
                    for (int dt = 0; dt < 2; ++dt) {
                        const bf16x8 vf = cat8(tr_read(vp + dt * 64), tr_read(vp + dt * 64 + 8 * AT_VSTR));
                        O[dt] = MFMA32(pf, vf, O[dt]);
                    }
                }
            MFMA_SETTLE2(O[0], O[1]);
            WAVE_LDS_SYNC();
#pragma unroll
            for (int r = 0; r < 16; ++r) {
                const int qr = (r & 3) + 8 * (r >> 2) + 4 * h;
                const float rd = wsf[qr];
                bf16_t* rowp = PROJ + (rowq0 + q0 + qr) * IN_COLS + hq * 64 + c31;
#pragma unroll
                for (int dt = 0; dt < 2; ++dt) if (!dry) rowp[C_Q + 32 * dt] = f2bf(O[dt][r] * rd * siluf_(gav[r][dt]));
            }
            WAVE_LDS_SYNC();
        }
        __syncthreads();
    }
}

constexpr int S5_NPOW = 11, S5_NINV = 9, S5_NSEG = 8, S5_SEGLEN = 256;
__device__ __forceinline__ float neg_expm1_small(float y) {
    float q = 1.0f / 5040.0f; q = q * y + 1.0f / 720.0f; q = q * y + 1.0f / 120.0f; q = q * y + 1.0f / 24.0f; q = q * y + 1.0f / 6.0f; q = q * y + 0.5f; q = q * y + 1.0f; return -(q * y);
}
__device__ __forceinline__ f32x2_t cmul(f32x2_t a, f32x2_t b) { return (f32x2_t){a.x * b.x - a.y * b.y, a.x * b.y + a.y * b.x}; }

__device__ __forceinline__ void st_s5_tables2(KP p, const Ctx& c) {
    f32x2_t* POW = (f32x2_t*)(p->ws + WS_S5POW); f32x2_t* PINV = (f32x2_t*)(p->ws + WS_S5PINV);
    bf16_t* BCAT = (bf16_t*)(p->ws + WS_S5BCAT); bf16_t* CCAT = (bf16_t*)(p->ws + WS_S5CCAT);
    const float* BB = (const float*)(p->ws + WS_TAB + TAB_BB);
    for (size_t ii = c.gt; ii < (size_t)DEPTH * NG * NP * (S5_NPOW + S5_NINV); ii += c.ngt) {
        const int k = (int)(ii % (S5_NPOW + S5_NINV)), i = (int)(ii / (S5_NPOW + S5_NINV)), lg = i / NP, pp = i % NP;
        const double lr = (double)fminf(p->in[12][i], -1e-4f), li = (double)p->in[13][i];
        const double step = (double)expf(p->in[14][lg]);
        const int e = k < 9 ? k : (k == 9 ? 64 : (k == 10 ? 256 : -(k - S5_NPOW)));
        double t = (double)e * li * step * 0.15915494309189535; t -= rint(t);
        float sn, cs; sincosf((float)(t * 6.283185307179586), &sn, &cs);
        const float mag = expf((float)((double)e * lr * step));
        const f32x2_t v = {mag * cs, mag * sn};
        if (k < S5_NPOW) POW[((size_t)lg * S5_NPOW + k) * NP + pp] = v; else PINV[((size_t)lg * S5_NINV + (k - S5_NPOW)) * NP + pp] = v;
    }
    for (size_t ii = c.gt; ii < (size_t)DEPTH * NG * 128 * NC; ii += c.ngt) {
        const int i = (int)ii, lg = i / (128 * NC), n = (i / NC) % 128, cc = i % NC, pp = n & 63;
        const int sidx = lg * NP + pp;
        const float lr = fminf(p->in[12][sidx], -1e-4f), li = p->in[13][sidx];
        const float step = expf(p->in[14][lg]);
        const float mag = expf(lr * step);
        float sn, cs; sincosf(li * step, &sn, &cs);
        const float ab_re = mag * cs, ab_im = mag * sn, den = lr * lr + li * li;
        const float f_re = ((ab_re - 1.0f) * lr + ab_im * li) / den, f_im = (ab_im * lr - (ab_re - 1.0f) * li) / den;
        const float bre = p->in[15][(size_t)sidx * NC + cc], bim = p->in[16][(size_t)sidx * NC + cc];
        BCAT[i] = f2bf(n < 64 ? f_re * bre - f_im * bim : f_re * bim + f_im * bre);
        const int c2 = (i / 128) % NC, n2 = i % 128, p2 = n2 & 63;
        const float cv = n2 < 64 ? p->in[17][((size_t)lg * NC + c2) * NP + p2] : -p->in[18][((size_t)lg * NC + c2) * NP + p2];
        CCAT[i] = f2bf(cv);
    }
}

__device__ __forceinline__ void s5_xtiles(f32x16 (&xr)[2], f32x16 (&xi)[2], const bf16x8 (&uf)[2], bf16x8 bre, bf16x8 bim) {
#pragma unroll
    for (int m = 0; m < 2; ++m) { xr[m] = MFMA32(uf[m], bre, (f32x16){}); xi[m] = MFMA32(uf[m], bim, (f32x16){}); }
    asm volatile("s_nop 15\n\ts_nop 7" : "+v"(xr[0]), "+v"(xr[1]), "+v"(xi[0]), "+v"(xi[1]));
}

__device__ __forceinline__ void st_s5_phaseA(KP p, int l, const Ctx& c) {
    const bf16_t* PROJ = (const bf16_t*)(p->ws + WS_PROJ);
    const f32x2_t* POW = (const f32x2_t*)(p->ws + WS_S5POW);
    const bf16_t* BCAT = (const bf16_t*)(p->ws + WS_S5BCAT);
    f32x2_t* SUM = (f32x2_t*)(p->ws + WS_S5SUM);
    const int lane = c.lane, c31 = lane & 31, h = lane >> 5;
    for (int item = c.gw; item < BATCH * S5_NSEG * NG; item += c.ngw) {
        const int g = item % NG, seg = (item / NG) % S5_NSEG, b = item / (NG * S5_NSEG);
        const int lg = l * NG + g;
        const size_t row0 = (size_t)b * SEQ + (size_t)seg * S5_SEGLEN;
#pragma unroll 1
        for (int pt = 0; pt < 2; ++pt) {
            const int pp = 32 * pt + c31;
            const f32x2_t* pw = POW + (size_t)lg * S5_NPOW * NP + pp;
            f32x2_t lo[4];
#pragma unroll
            for (int s = 0; s < 4; ++s) lo[s] = pw[(7 - 4 * h - s) * NP];
            const f32x2_t a8 = pw[8 * NP], a64 = pw[9 * NP];
            const bf16x8 bre = *(const bf16x8*)(BCAT + ((size_t)lg * 128 + pp) * NC + 8 * h);
            const bf16x8 bim = *(const bf16x8*)(BCAT + ((size_t)lg * 128 + 64 + pp) * NC + 8 * h);
            f32x2_t sseg = {0.f, 0.f};
            bf16x8 ufn[2];
#pragma unroll
            for (int m = 0; m < 2; ++m) ufn[m] = *(const bf16x8*)(PROJ + (row0 + 32 * m + c31) * IN_COLS + C_UB + 16 * g + 8 * h);
#pragma unroll 1
            for (int ch = 0; ch < 4; ++ch) {
                bf16x8 uf[2];
#pragma unroll
                for (int m = 0; m < 2; ++m) { uf[m] = ufn[m]; if (ch < 3) ufn[m] = *(const bf16x8*)(PROJ + (row0 + 64 * ch + 64 + 32 * m + c31) * IN_COLS + C_UB + 16 * g + 8 * h); }
                f32x16 xr[2], xi[2];
                s5_xtiles(xr, xi, uf, bre, bim);
                f32x2_t f = {1.f, 0.f}, acc = {0.f, 0.f};
#pragma unroll
                for (int gi = 7; gi >= 0; --gi) {
                    const int m = gi >> 2, q = gi & 3;
                    f32x2_t t = {0.f, 0.f};
#pragma unroll
                    for (int s = 0; s < 4; ++s) { const f32x2_t x = {xr[m][4 * q + s], xi[m][4 * q + s]}; const f32x2_t w = cmul(lo[s], x); t.x += w.x; t.y += w.y; }
                    const f32x2_t w2 = cmul(f, t); acc.x += w2.x; acc.y += w2.y;
                    f = cmul(f, a8);
                }
                { const Halves hx = halves(acc.x), hy = halves(acc.y); acc.x = hx.lo + hx.hi; acc.y = hy.lo + hy.hi; }
                const f32x2_t d = cmul(a64, sseg); sseg.x = d.x + acc.x; sseg.y = d.y + acc.y;
            }
            if (h == 0) SUM[(((size_t)b * S5_NSEG + seg) * NG + g) * NP + pp] = sseg;
        }
    }
}

constexpr int S5_HT_STR = 144, S5_HT_BYTES = 64 * S5_HT_STR;
__device__ __forceinline__ void st_s5_phaseB(KP p, int l, const Ctx& c, LAS unsigned char* lds, bool dry) {
    bf16_t* PROJ = (bf16_t*)(p->ws + WS_PROJ);
    const f32x2_t* POW = (const f32x2_t*)(p->ws + WS_S5POW); const f32x2_t* PINV = (const f32x2_t*)(p->ws + WS_S5PINV);
    const bf16_t* BCAT = (const bf16_t*)(p->ws + WS_S5BCAT); const bf16_t* CCAT = (const bf16_t*)(p->ws + WS_S5CCAT);
    const f32x2_t* SUM = (const f32x2_t*)(p->ws + WS_S5SUM);
    const int lane = c.lane, c31 = lane & 31, h = lane >> 5, i16 = lane & 15, kg = lane >> 4, qq = i16 >> 2, p4 = i16 & 3;
    LAS unsigned char* ht = lds + c.wave * S5_HT_BYTES;
    bf16x8 tdiag[2], tones;
#pragma unroll
    for (int s = 0; s < 2; ++s)
#pragma unroll
        for (int j = 0; j < 8; ++j) tdiag[s][j] = (16 * s + 8 * (j >> 2) + 4 * h + (j & 3) <= c31) ? (short)0x3F80 : (short)0;
#pragma unroll
    for (int j = 0; j < 8; ++j) tones[j] = (short)0x3F80;
    for (int item = c.gw; item < BATCH * S5_NSEG * NG; item += c.ngw) {
        const int g = item % NG, seg = (item / NG) % S5_NSEG, b = item / (NG * S5_NSEG);
        const int lg = l * NG + g;
        const size_t row0 = (size_t)b * SEQ + (size_t)seg * S5_SEGLEN;
        f32x2_t hin[2];
#pragma unroll
        for (int pt = 0; pt < 2; ++pt) {
            const int pp = 32 * pt + c31;
            const f32x2_t a256 = POW[((size_t)lg * S5_NPOW + 10) * NP + pp];
            f32x2_t H = {0.f, 0.f};
#pragma unroll
            for (int k = 0; k < S5_NSEG - 1; ++k) if (k < seg) { const f32x2_t sk = SUM[(((size_t)b * S5_NSEG + k) * NG + g) * NP + pp]; const f32x2_t d = cmul(a256, H); H.x = d.x + sk.x; H.y = d.y + sk.y; }
            hin[pt] = H;
        }
        const float dd = p->in[19][l * 512 + g * 16 + i16];
        bf16x8 ufn[2];
#pragma unroll
        for (int m = 0; m < 2; ++m) ufn[m] = *(const bf16x8*)(PROJ + (row0 + 32 * m + c31) * IN_COLS + C_UB + 16 * g + 8 * h);
#pragma unroll 1
        for (int ch = 0; ch < 4; ++ch) {
            const size_t crow0 = row0 + 64 * ch;
            bf16x8 uf[2];
#pragma unroll
            for (int m = 0; m < 2; ++m) { uf[m] = ufn[m]; if (ch < 3) ufn[m] = *(const bf16x8*)(PROJ + (crow0 + 64 + 32 * m + c31) * IN_COLS + C_UB + 16 * g + 8 * h); }
            f32x4 Y[4];
#pragma unroll
            for (int it = 0; it < 4; ++it) Y[it] = (f32x4){0.f, 0.f, 0.f, 0.f};
#pragma unroll 1
            for (int pt = 0; pt < 2; ++pt) {
                const f32x2_t hin_pt = pt ? hin[1] : hin[0];
                const int pp = 32 * pt + c31;
                const bf16x8 bre = *(const bf16x8*)(BCAT + ((size_t)lg * 128 + pp) * NC + 8 * h);
                const bf16x8 bim = *(const bf16x8*)(BCAT + ((size_t)lg * 128 + 64 + pp) * NC + 8 * h);
                const f32x2_t* pw = POW + (size_t)lg * S5_NPOW * NP + pp; const f32x2_t* pi = PINV + (size_t)lg * S5_NINV * NP + pp;
                asm volatile("" : "+v"(pw), "+v"(pi));
                f32x2_t ilo[4], plo[4];
#pragma unroll
                for (int s = 0; s < 4; ++s) { ilo[s] = pi[(4 * h + s) * NP]; plo[s] = pw[(4 * h + s) * NP]; }
                const f32x2_t ia8 = pi[8 * NP], a8 = pw[8 * NP], a1 = pw[1 * NP];
                bf16x8 cfv[2];
#pragma unroll
                for (int ks = 0; ks < 2; ++ks) cfv[ks] = *(const bf16x8*)(CCAT + ((size_t)lg * NC + i16) * 128 + 64 * ks + 32 * pt + 8 * kg);
                bf16x8 wfr[2][2], wfi[2][2];
                {
                    f32x2_t f = {1.f, 0.f};
#pragma unroll
                    for (int m = 0; m < 2; ++m) {
                        f32x16 xr = MFMA32(uf[m], bre, (f32x16){}), xi = MFMA32(uf[m], bim, (f32x16){});
                        MFMA_SETTLE2(xr, xi);
#pragma unroll
                        for (int q = 0; q < 4; ++q) {
#pragma unroll
                            for (int s = 0; s < 4; ++s) { const f32x2_t x = {xr[4 * q + s], xi[4 * q + s]}; const f32x2_t w = cmul(f, cmul(ilo[s], x)); xr[4 * q + s] = w.x; xi[4 * q + s] = w.y; }
                            f = cmul(f, ia8);
                        }
#pragma unroll
                        for (int s2 = 0; s2 < 2; ++s2) {
                            wfr[m][s2] = pack8(xr[8 * s2], xr[8 * s2 + 1], xr[8 * s2 + 2], xr[8 * s2 + 3], xr[8 * s2 + 4], xr[8 * s2 + 5], xr[8 * s2 + 6], xr[8 * s2 + 7]);
                            wfi[m][s2] = pack8(xi[8 * s2], xi[8 * s2 + 1], xi[8 * s2 + 2], xi[8 * s2 + 3], xi[8 * s2 + 4], xi[8 * s2 + 5], xi[8 * s2 + 6], xi[8 * s2 + 7]);
                        }
                        __builtin_amdgcn_sched_barrier(0);
                    }
                }
                const f32x2_t G = cmul(a1, hin_pt);
                f32x2_t hlast = {0.f, 0.f};
                WAVE_LDS_SYNC();
                {
                    f32x2_t f = {1.f, 0.f};
#pragma unroll
                    for (int m = 0; m < 2; ++m) {
                        f32x16 cr, ci;
                        if (m == 0) { cr = MFMA32(tdiag[1], wfr[0][1], MFMA32(tdiag[0], wfr[0][0], (f32x16){})); ci = MFMA32(tdiag[1], wfi[0][1], MFMA32(tdiag[0], wfi[0][0], (f32x16){})); }
                        else { cr = MFMA32(tdiag[1], wfr[1][1], MFMA32(tdiag[0], wfr[1][0], MFMA32(tones, wfr[0][1], MFMA32(tones, wfr[0][0], (f32x16){}))));
                               ci = MFMA32(tdiag[1], wfi[1][1], MFMA32(tdiag[0], wfi[1][0], MFMA32(tones, wfi[0][1], MFMA32(tones, wfi[0][0], (f32x16){})))); }
                        MFMA_SETTLE2(cr, ci);
#pragma unroll
                        for (int q = 0; q < 4; ++q) {
                            float hr[4], hi[4];
#pragma unroll
                            for (int s = 0; s < 4; ++s) { const f32x2_t v = {cr[4 * q + s] + G.x, ci[4 * q + s] + G.y}; const f32x2_t w = cmul(f, cmul(plo[s], v)); hr[s] = w.x; hi[s] = w.y; }
                            if (m == 1 && q == 3) { hlast.x = hr[3]; hlast.y = hi[3]; }
                            typedef unsigned u32x2_t __attribute__((ext_vector_type(2)));
                            u32x2_t wr_; wr_.x = cvtpk(hr[0], hr[1]); wr_.y = cvtpk(hr[2], hr[3]);
                            u32x2_t wi_; wi_.x = cvtpk(hi[0], hi[1]); wi_.y = cvtpk(hi[2], hi[3]);
                            *(LAS u32x2_t*)(ht + c31 * S5_HT_STR + (32 * m + 8 * q + 4 * h) * 2) = wr_;
                            *(LAS u32x2_t*)(ht + (32 + c31) * S5_HT_STR + (32 * m + 8 * q + 4 * h) * 2) = wi_;
                            f = cmul(f, a8);
                        }
                        __builtin_amdgcn_sched_barrier(0);
                    }
                }
                { const f32x2_t hn = {halves(hlast.x).hi, halves(hlast.y).hi}; if (pt) hin[1] = hn; else hin[0] = hn; }
                WAVE_LDS_SYNC();
#pragma unroll
                for (int ks = 0; ks < 2; ++ks) {
                    const bf16x8 cf = cfv[ks];
#pragma unroll
                    for (int it = 0; it < 4; ++it) {
                        LAS const unsigned char* ap = ht + (32 * ks + 8 * kg + qq) * S5_HT_STR + (16 * it + 4 * p4) * 2;
                        const bf16x8 af = cat8(tr_read(ap), tr_read(ap + 4 * S5_HT_STR));
                        Y[it] = MFMA16(af, cf, Y[it]);
                    }
                }
            }
            asm volatile("s_nop 15\n\ts_nop 7" : "+v"(Y[0]), "+v"(Y[1]), "+v"(Y[2]), "+v"(Y[3]));
            float uu[4][4];
#pragma unroll
            for (int it = 0; it < 4; ++it)
#pragma unroll
                for (int r = 0; r < 4; ++r) uu[it][r] = bf2f(PROJ[(crow0 + 16 * it + 4 * kg + r) * IN_COLS + C_UB + 16 * g + i16]);
#pragma unroll
            for (int it = 0; it < 4; ++it)
#pragma unroll
                for (int r = 0; r < 4; ++r) {
                    bf16_t* up = PROJ + (crow0 + 16 * it + 4 * kg + r) * IN_COLS + C_UB + 16 * g + i16;
                    const float y = Y[it][r] + dd * uu[it][r];
                    if (!dry) *up = f2bf(gelu_tanh(y));
                }
        }
        if (seg == S5_NSEG - 1 && h == 0) {
#pragma unroll
            for (int pt = 0; pt < 2; ++pt) { const size_t oi = (((size_t)l * BATCH + b) * NG + g) * NP + 32 * pt + c31; p->out[O_SRP + oi] = hin[pt].x; p->out[O_SIP + oi] = hin[pt].y; }
        }
    }
}

__device__ __forceinline__ void st_s5_sample(KP p, int l, const Ctx& c, LAS unsigned char* lds, bool dry) {
    bf16_t* PROJ = (bf16_t*)(p->ws + WS_PROJ);
    const f32x2_t* POW = (const f32x2_t*)(p->ws + WS_S5POW); const f32x2_t* PINV = (const f32x2_t*)(p->ws + WS_S5PINV);
    const bf16_t* BCAT = (const bf16_t*)(p->ws + WS_S5BCAT); const bf16_t* CCAT = (const bf16_t*)(p->ws + WS_S5CCAT);
    LAS unsigned char* ht = lds + c.wave * S5_HT_BYTES;
    for (int item = c.gw; item < (DEC_BATCH / 16) * NG; item += c.ngw) {
        int zi = 0; asm volatile("" : "+v"(zi));
        const int lane = c.lane + zi, c31 = lane & 31, h = lane >> 5, i16 = lane & 15, kg = lane >> 4, qq = i16 >> 2, p4 = i16 & 3;
        const int g = item % NG, sg = item / NG, lg = l * NG + g;
        const size_t crow0 = (size_t)M_P + 64 * sg;
        bf16x8 tds[2];
#pragma unroll
        for (int s = 0; s < 2; ++s)
#pragma unroll
            for (int j = 0; j < 8; ++j) { const int kr = 16 * s + 8 * (j >> 2) + 4 * h + (j & 3); tds[s][j] = ((kr >> 2) == (c31 >> 2) && kr <= c31) ? (short)0x3F80 : (short)0; }
        const float dd = p->in[19][l * 512 + g * 16 + i16];
        bf16x8 uf[2];
#pragma unroll
        for (int m = 0; m < 2; ++m) uf[m] = *(const bf16x8*)(PROJ + (crow0 + 32 * m + c31) * IN_COLS + C_UB + 16 * g + 8 * h);
        f32x4 Y[4];
#pragma unroll
        for (int it = 0; it < 4; ++it) Y[it] = (f32x4){0.f, 0.f, 0.f, 0.f};
#pragma unroll
        for (int pt = 0; pt < 2; ++pt) {
            const int pp = 32 * pt + c31;
            const bf16x8 bre = *(const bf16x8*)(BCAT + ((size_t)lg * 128 + pp) * NC + 8 * h);
            const bf16x8 bim = *(const bf16x8*)(BCAT + ((size_t)lg * 128 + 64 + pp) * NC + 8 * h);
            const f32x2_t* pw = POW + (size_t)lg * S5_NPOW * NP + pp; const f32x2_t* pi = PINV + (size_t)lg * S5_NINV * NP + pp;
            f32x2_t ilo[4], plo[4];
#pragma unroll
            for (int s = 0; s < 4; ++s) { ilo[s] = pi[s * NP]; plo[s] = pw[s * NP]; }
            const f32x2_t a1 = pw[1 * NP];
            WAVE_LDS_SYNC();
#pragma unroll
            for (int m = 0; m < 2; ++m) {
                f32x16 xr = MFMA32(uf[m], bre, (f32x16){}), xi = MFMA32(uf[m], bim, (f32x16){});
                MFMA_SETTLE2(xr, xi);
#pragma unroll
                for (int q = 0; q < 4; ++q)
#pragma unroll
                    for (int s = 0; s < 4; ++s) { const f32x2_t x = {xr[4 * q + s], xi[4 * q + s]}; const f32x2_t w = cmul(ilo[s], x); xr[4 * q + s] = w.x; xi[4 * q + s] = w.y; }
                bf16x8 wr0 = pack8(xr[0], xr[1], xr[2], xr[3], xr[4], xr[5], xr[6], xr[7]), wr1 = pack8(xr[8], xr[9], xr[10], xr[11], xr[12], xr[13], xr[14], xr[15]);
                bf16x8 wi0 = pack8(xi[0], xi[1], xi[2], xi[3], xi[4], xi[5], xi[6], xi[7]), wi1 = pack8(xi[8], xi[9], xi[10], xi[11], xi[12], xi[13], xi[14], xi[15]);
                f32x16 cr = MFMA32(tds[1], wr1, MFMA32(tds[0], wr0, (f32x16){})), ci = MFMA32(tds[1], wi1, MFMA32(tds[0], wi0, (f32x16){}));
                MFMA_SETTLE2(cr, ci);
#pragma unroll
                for (int q = 0; q < 4; ++q) {
                    const int seq = 16 * sg + 8 * m + 2 * q + h;
                    const size_t si = (((size_t)l * DEC_BATCH + seq) * NG + g) * NP + pp;
                    const f32x2_t G = cmul(a1, (f32x2_t){p->in[4][si], p->in[5][si]});
                    float hr[4], hi[4];
#pragma unroll
                    for (int s = 0; s < 4; ++s) { const f32x2_t v = {cr[4 * q + s] + G.x, ci[4 * q + s] + G.y}; const f32x2_t w = cmul(plo[s], v); hr[s] = w.x; hi[s] = w.y; }
                    p->out[O_SRS + si] = hr[3]; p->out[O_SIS + si] = hi[3];
                    typedef unsigned u32x2_t __attribute__((ext_vector_type(2)));
                    u32x2_t wr_; wr_.x = cvtpk(hr[0], hr[1]); wr_.y = cvtpk(hr[2], hr[3]);
                    u32x2_t wi_; wi_.x = cvtpk(hi[0], hi[1]); wi_.y = cvtpk(hi[2], hi[3]);
                    *(LAS u32x2_t*)(ht + c31 * S5_HT_STR + (32 * m + 8 * q + 4 * h) * 2) = wr_;
                    *(LAS u32x2_t*)(ht + (32 + c31) * S5_HT_STR + (32 * m + 8 * q + 4 * h) * 2) = wi_;
                }
                __builtin_amdgcn_sched_barrier(0);
            }
            WAVE_LDS_SYNC();
#pragma unroll
            for (int ks = 0; ks < 2; ++ks) {
                const bf16x8 cf = *(const bf16x8*)(CCAT + ((size_t)lg * NC + i16) * 128 + 64 * ks + 32 * pt + 8 * kg);
#pragma unroll
                for (int it = 0; it < 4; ++it) {
                    LAS const unsigned char* ap = ht + (32 * ks + 8 * kg + qq) * S5_HT_STR + (16 * it + 4 * p4) * 2;
                    const bf16x8 af = cat8(tr_read(ap), tr_read(ap + 4 * S5_HT_STR));
                    Y[it] = MFMA16(af, cf, Y[it]);
                }
            }
        }
        asm volatile("s_nop 15\n\ts_nop 7" : "+v"(Y[0]), "+v"(Y[1]), "+v"(Y[2]), "+v"(Y[3]));
        float uu[4][4];
#pragma unroll
        for (int it = 0; it < 4; ++it)
#pragma unroll
            for (int r = 0; r < 4; ++r) uu[it][r] = bf2f(PROJ[(crow0 + 16 * it + 4 * kg + r) * IN_COLS + C_UB + 16 * g + i16]);
#pragma unroll
        for (int it = 0; it < 4; ++it)
#pragma unroll
            for (int r = 0; r < 4; ++r) {
                bf16_t* up = PROJ + (crow0 + 16 * it + 4 * kg + r) * IN_COLS + C_UB + 16 * g + i16;
                const float y = Y[it][r] + dd * uu[it][r];
                if (!dry) *up = f2bf(gelu_tanh(y));
            }
    }
}

__device__ __forceinline__ void st_lru_sample(KP p, int l, const Ctx& c, LAS unsigned char* lds, bool dry) {
    bf16_t* PROJ = (bf16_t*)(p->ws + WS_PROJ);
    const bf16_t* LRUW = (const bf16_t*)(p->ws + WS_LRUW);
    for (int item = c.gw; item < (DEC_BATCH / 16) * 8; item += c.ngw) {
        int zi = 0; asm volatile("" : "+v"(zi));
        const int lane = c.lane + zi, c31 = lane & 31, h = lane >> 5;
        const int n = item & 7, sg = item >> 3;
        const size_t row0 = (size_t)M_P + 64 * sg;
        const int ch0 = n * 64;
        LAS unsigned char* xim = lds + c.wave * 9216;
        WAVE_LDS_SYNC();
#pragma unroll 1
        for (int ks = 0; ks < 4; ++ks) {
            const int chb = ch0 + 16 * ks + 8 * h;
            float w[4][8], cb[8];
#pragma unroll
            for (int j = 0; j < 4; ++j) {
                const f32x4 w0 = *(const f32x4*)(p->in[22] + (l * 4 + j) * 512 + chb), w1 = *(const f32x4*)(p->in[22] + (l * 4 + j) * 512 + chb + 4);
                w[j][0] = w0[0]; w[j][1] = w0[1]; w[j][2] = w0[2]; w[j][3] = w0[3]; w[j][4] = w1[0]; w[j][5] = w1[1]; w[j][6] = w1[2]; w[j][7] = w1[3];
            }
            { const f32x4 b0 = *(const f32x4*)(p->in[23] + l * 512 + chb), b1 = *(const f32x4*)(p->in[23] + l * 512 + chb + 4);
              cb[0] = b0[0]; cb[1] = b0[1]; cb[2] = b0[2]; cb[3] = b0[3]; cb[4] = b1[0]; cb[5] = b1[1]; cb[6] = b1[2]; cb[7] = b1[3]; }
#pragma unroll
            for (int m = 0; m < 2; ++m) {
                const int i = 32 * m + c31, t = i & 3, seq = 16 * sg + (i >> 2);
                float xf[8];
#pragma unroll
                for (int e = 0; e < 8; ++e) xf[e] = cb[e];
#pragma unroll
                for (int j = 0; j < 4; ++j) {
                    const int tau = t - 3 + j;
                    float xv[8];
                    if (tau >= 0) {
                        const u32x4 xx = *(const u32x4*)(PROJ + ((size_t)M_P + 4 * seq + tau) * IN_COLS + C_XC + chb);
#pragma unroll
                        for (int e = 0; e < 4; ++e) { xv[2 * e] = __uint_as_float(xx[e] << 16); xv[2 * e + 1] = __uint_as_float(xx[e] & 0xffff0000u); }
                    } else {
                        const float* cp = p->in[7] + (((size_t)l * DEC_BATCH + seq) * 3 + (3 + tau)) * 512 + chb;
                        const f32x4 c0 = *(const f32x4*)cp, c1 = *(const f32x4*)(cp + 4);
                        xv[0] = c0[0]; xv[1] = c0[1]; xv[2] = c0[2]; xv[3] = c0[3]; xv[4] = c1[0]; xv[5] = c1[1]; xv[6] = c1[2]; xv[7] = c1[3];
                    }
#pragma unroll
                    for (int e = 0; e < 8; ++e) xf[e] += w[j][e] * xv[e];
                }
                *(LAS bf16x8*)(xim + (32 * m + c31) * 144 + (16 * ks + 8 * h) * 2) = pack8(xf[0], xf[1], xf[2], xf[3], xf[4], xf[5], xf[6], xf[7]);
            }
        }
        WAVE_LDS_SYNC();
#pragma unroll 1
        for (int et = 0; et < 2; ++et) {
            const int ch = ch0 + 32 * et + c31;
            const float ba = p->in[25][l * 512 + ch], bx = p->in[27][l * 512 + ch];
            const float lsig8 = ((const float*)(p->ws + WS_LSIG))[l * 512 + ch];
            const bf16_t* wp = LRUW + (((size_t)(l * 8 + n) * 2) * 64 + 32 * et + c31) * 64 + 8 * h;
#pragma unroll
            for (int m = 0; m < 2; ++m) {
                f32x16 X = (f32x16){}, R = (f32x16){}, I = (f32x16){};
#pragma unroll
                for (int ks = 0; ks < 4; ++ks) {
                    const bf16x8 wa = *(const bf16x8*)(wp + 16 * ks), wx = *(const bf16x8*)(wp + 64 * 64 + 16 * ks);
                    bf16x8 id;
#pragma unroll
                    for (int j = 0; j < 8; ++j) id[j] = (16 * ks + 8 * h + j == 32 * et + c31) ? (short)0x3F80 : (short)0;
                    const bf16x8 afr = *(LAS const bf16x8*)(xim + (32 * m + c31) * 144 + (16 * ks + 8 * h) * 2);
                    R = MFMA32(afr, wa, R); I = MFMA32(afr, wx, I); X = MFMA32(afr, id, X);
                }
                MFMA_SETTLE3(R, I, X);
                float gcv[16], h0v[4];
#pragma unroll
                for (int q = 0; q < 4; ++q) {
                    const int seq = 16 * sg + 8 * m + 2 * q + h;
                    h0v[q] = p->in[6][((size_t)l * DEC_BATCH + seq) * 512 + ch];
#pragma unroll
                    for (int s = 0; s < 4; ++s) gcv[4 * q + s] = bf2f(PROJ[((size_t)M_P + 4 * seq + s) * IN_COLS + C_GC + ch]);
                }
#pragma unroll
                for (int q = 0; q < 4; ++q) {
                    const int seq = 16 * sg + 8 * m + 2 * q + h;
                    float hv = h0v[q];
#pragma unroll
                    for (int s = 0; s < 4; ++s) {
                        const int r = 4 * q + s;
                        const float rg = sigmoidf_(R[r] + ba), ig = sigmoidf_(I[r] + bx);
                        const float la = rg * lsig8;
                        const float a = __expf(la);
                        const float bg = X[r] * ig * __builtin_amdgcn_sqrtf((1.0f - a) * (1.0f + a));
                        hv = a * hv + bg;
                        bf16_t* gp = PROJ + ((size_t)M_P + 4 * seq + s) * IN_COLS + C_GC + ch;
                        const float gc = gcv[r];
                        if (!dry) *gp = f2bf(hv * siluf_(gc));
                    }
                    p->out[O_LS + ((size_t)l * DEC_BATCH + seq) * 512 + ch] = hv;
                }
                __builtin_amdgcn_sched_barrier(0);
            }
        }
    }
}

__device__ __forceinline__ void st_attn_sample(KP p, int l, LAS unsigned char* lds, bool dry, int wave_s) {
    int zv = 0; asm volatile("" : "+v"(zv));
    const int tid = tid_of(wave_s, zv), lane = tid & 63, wave = __builtin_amdgcn_readfirstlane(tid >> 6);
    const int c31 = lane & 31, h = lane >> 5;
    bf16_t* PROJ = (bf16_t*)(p->ws + WS_PROJ);
    const float* rel_bias = p->in[8];
    for (int item = blockIdx.x; item < DEC_BATCH * NKV; item += gridDim.x) {
        const int b = item >> 1, kvh = item & 1;
#pragma unroll
        for (int i = 0; i < 3; ++i) {
            const int id = tid + 512 * i, row = id >> 3, pc = id & 7;
            if (id < 160 * 8) {
                u32x4 kk = (u32x4){0u, 0u, 0u, 0u}, vv = kk;
                if (row < WINDOW) {
                    const size_t ci = ((((size_t)l * DEC_BATCH + b) * WINDOW + row) * NKV + kvh) * HD + pc * 8;
                    const f32x4 k0 = *(const f32x4*)(p->in[2] + ci), k1 = *(const f32x4*)(p->in[2] + ci + 4), v0 = *(const f32x4*)(p->in[3] + ci), v1 = *(const f32x4*)(p->in[3] + ci + 4);
                    kk.x = cvtpk(k0[0], k0[1]); kk.y = cvtpk(k0[2], k0[3]); kk.z = cvtpk(k1[0], k1[1]); kk.w = cvtpk(k1[2], k1[3]);
                    vv.x = cvtpk(v0[0], v0[1]); vv.y = cvtpk(v0[2], v0[3]); vv.z = cvtpk(v1[0], v1[1]); vv.w = cvtpk(v1[2], v1[3]);
                } else if (row < WINDOW + DEC_SEQ) {
                    const bf16_t* src = PROJ + ((size_t)M_P + 4 * b + (row - WINDOW)) * IN_COLS + kvh * 64 + pc * 8;
                    kk = *(const u32x4*)(src + C_K); vv = *(const u32x4*)(src + C_V);
                }
                *(LAS u32x4*)(lds + AT_K + row * AT_KSTR + pc * 16) = kk;
                *(LAS u32x4*)(lds + AT_V + row * AT_VSTR + pc * 16) = vv;
            }
        }
        { const int g = tid >> 7, d = tid & 127; ((LAS float*)(lds + AT_BIAS))[tid] = rel_bias[T5_BUCKET[d] * NQH + kvh * 4 + g]; }
        __syncthreads();
        if (wave == 0) {
            const int qc = c31 & 15, g = qc >> 2, iq = qc & 3, hq = kvh * 4 + g;
            const float sink = p->in[10][l * NQH + hq];
            LAS const float* biasd = (LAS const float*)(lds + AT_BIAS) + g * 128;
            LAS float* wsf = (LAS float*)(lds + AT_WS);
            bf16x8 qf[4];
            { const bf16_t* qp = PROJ + ((size_t)M_P + 4 * b + iq) * IN_COLS + C_Q + hq * 64 + 8 * h;
#pragma unroll
              for (int ks = 0; ks < 4; ++ks) qf[ks] = *(const bf16x8*)(qp + 16 * ks); }
            f32x16 S[5];
#pragma unroll
            for (int j = 0; j < 5; ++j) {
                S[j] = (f32x16){};
                LAS const unsigned char* kp = lds + AT_K + (32 * j + c31) * AT_KSTR + 16 * h;
#pragma unroll
                for (int ks = 0; ks < 4; ++ks) S[j] = MFMA32(*(LAS const bf16x8*)(kp + 32 * ks), qf[ks], S[j]);
            }
            asm volatile("s_nop 15\n\ts_nop 7" : "+v"(S[0]), "+v"(S[1]), "+v"(S[2]), "+v"(S[3]), "+v"(S[4]));
            float mx = sink;
#pragma unroll
            for (int j = 0; j < 5; ++j)
#pragma unroll
                for (int r = 0; r < 16; ++r) {
                    const int kv = 32 * j + (r & 3) + 8 * (r >> 2) + 4 * h;
                    const int dist = iq + 128 - kv;
                    const bool ok = (dist >= 0) && (dist < 128);
                    const float s = ok ? S[j][r] * 0.125f + biasd[dist & 127] : -1e30f;
                    S[j][r] = s; mx = fmaxf(mx, s);
                }
            { const Halves hh = halves(mx); mx = fmaxf(hh.lo, hh.hi); }
            float sum = 0.f;
#pragma unroll
            for (int j = 0; j < 5; ++j)
#pragma unroll
                for (int r = 0; r < 16; ++r) { const float e = S[j][r] > -1e29f ? __expf(S[j][r] - mx) : 0.f; S[j][r] = e; sum += e; }
            { const Halves hh = halves(sum); sum = hh.lo + hh.hi; }
            const float rden = 1.0f / (sum + __expf(sink - mx));
            if (h == 0) wsf[c31] = rden;
            f32x16 O[2]; O[0] = (f32x16){}; O[1] = (f32x16){};
            const int i16 = lane & 15, qq = i16 >> 2, pp = i16 & 3, blk = (lane >> 4) & 1;
#pragma unroll
            for (int j = 0; j < 5; ++j)
#pragma unroll
                for (int s = 0; s < 2; ++s) {
                    const bf16x8 pf = pack8(S[j][8 * s], S[j][8 * s + 1], S[j][8 * s + 2], S[j][8 * s + 3], S[j][8 * s + 4], S[j][8 * s + 5], S[j][8 * s + 6], S[j][8 * s + 7]);
                    LAS const unsigned char* vp = lds + AT_V + (32 * j + 16 * s + 4 * h + qq) * AT_VSTR + (16 * blk + 4 * pp) * 2;
#pragma unroll
                    for (int dt = 0; dt < 2; ++dt) {
                        const bf16x8 vf = cat8(tr_read(vp + dt * 64), tr_read(vp + dt * 64 + 8 * AT_VSTR));
                        O[dt] = MFMA32(pf, vf, O[dt]);
                    }
                }
            MFMA_SETTLE2(O[0], O[1]);
            WAVE_LDS_SYNC();
            float gav[8][2];
#pragma unroll
            for (int r = 0; r < 8; ++r) {
                const int qr = (r & 3) + 8 * (r >> 2) + 4 * h, g2 = qr >> 2, i2 = qr & 3;
                const bf16_t* rowp = PROJ + ((size_t)M_P + 4 * b + i2) * IN_COLS + (kvh * 4 + g2) * 64 + c31;
                gav[r][0] = bf2f(rowp[C_GA]); gav[r][1] = bf2f(rowp[C_GA + 32]);
            }
#pragma unroll
            for (int r = 0; r < 8; ++r) {
                const int qr = (r & 3) + 8 * (r >> 2) + 4 * h, g2 = qr >> 2, i2 = qr & 3;
                const float rd = wsf[qr];
                bf16_t* rowp = PROJ + ((size_t)M_P + 4 * b + i2) * IN_COLS + (kvh * 4 + g2) * 64 + c31;
#pragma unroll
                for (int dt = 0; dt < 2; ++dt) if (!dry) rowp[C_Q + 32 * dt] = f2bf(O[dt][r] * rd * siluf_(gav[r][dt]));
            }
        }
        __syncthreads();
    }
}

constexpr int LR_NSEG = 32;
template <bool PHASE_B>
__device__ __forceinline__ void st_lru_mfma(KP p, int l, const Ctx& c, LAS unsigned char* lds, bool dry) {
    bf16_t* PROJ = (bf16_t*)(p->ws + WS_PROJ);
    const bf16_t* LRUW = (const bf16_t*)(p->ws + WS_LRUW);
    f32x2_t* LSUM = (f32x2_t*)(p->ws + WS_LRSUM);
    for (int item = c.gw; item < BATCH * LR_NSEG * 8; item += c.ngw) {
        int zi = 0; asm volatile("" : "+v"(zi));
        const int lane = c.lane + zi, c31 = lane & 31, h = lane >> 5;
        const int n = item & 7, seg = (item >> 3) % LR_NSEG, b = item / (8 * LR_NSEG);
        const size_t row0 = (size_t)b * SEQ + (size_t)seg * 64;
        const int ch0 = n * 64;
        LAS unsigned char* xim = lds + c.wave * 9216;
        WAVE_LDS_SYNC();
#pragma unroll 2
        for (int ks = 0; ks < 4; ++ks) {
            const int chb = ch0 + 16 * ks + 8 * h;
            float w[4][8], cb[8];
#pragma unroll
            for (int j = 0; j < 4; ++j) {
                const f32x4 w0 = *(const f32x4*)(p->in[22] + (l * 4 + j) * 512 + chb), w1 = *(const f32x4*)(p->in[22] + (l * 4 + j) * 512 + chb + 4);
                w[j][0] = w0[0]; w[j][1] = w0[1]; w[j][2] = w0[2]; w[j][3] = w0[3]; w[j][4] = w1[0]; w[j][5] = w1[1]; w[j][6] = w1[2]; w[j][7] = w1[3];
            }
            { const f32x4 b0 = *(const f32x4*)(p->in[23] + l * 512 + chb), b1 = *(const f32x4*)(p->in[23] + l * 512 + chb + 4);
              cb[0] = b0[0]; cb[1] = b0[1]; cb[2] = b0[2]; cb[3] = b0[3]; cb[4] = b1[0]; cb[5] = b1[1]; cb[6] = b1[2]; cb[7] = b1[3]; }
            u32x4 xx4[2][4];
#pragma unroll
            for (int m = 0; m < 2; ++m)
#pragma unroll
                for (int j = 0; j < 4; ++j) { const int t = seg * 64 + 32 * m + c31; const int dr = (t - 3 + j >= 0) ? (32 * m + c31 - 3 + j) : 0; xx4[m][j] = *(const u32x4*)(PROJ + (row0 + dr) * IN_COLS + C_XC + chb); }
#pragma unroll
            for (int m = 0; m < 2; ++m) {
                const int t = seg * 64 + 32 * m + c31;
                float xf[8];
#pragma unroll
                for (int e = 0; e < 8; ++e) xf[e] = cb[e];
#pragma unroll
                for (int j = 0; j < 4; ++j) {
                    const u32x4 xx = (t - 3 + j >= 0) ? xx4[m][j] : (u32x4){0u, 0u, 0u, 0u};
#pragma unroll
                    for (int e = 0; e < 4; ++e) { xf[2 * e] += w[j][2 * e] * __uint_as_float(xx[e] << 16); xf[2 * e + 1] += w[j][2 * e + 1] * __uint_as_float(xx[e] & 0xffff0000u); }
                }
                *(LAS bf16x8*)(xim + (32 * m + c31) * 144 + (16 * ks + 8 * h) * 2) = pack8(xf[0], xf[1], xf[2], xf[3], xf[4], xf[5], xf[6], xf[7]);
            }
        }
        WAVE_LDS_SYNC();
#pragma unroll 1
        for (int et = 0; et < 2; ++et) {
            const int ch = ch0 + 32 * et + c31;
            const float ba = p->in[25][l * 512 + ch], bx = p->in[27][l * 512 + ch];
            const float lsig8 = ((const float*)(p->ws + WS_LSIG))[l * 512 + ch];
            const bf16_t* wp = LRUW + (((size_t)(l * 8 + n) * 2) * 64 + 32 * et + c31) * 64 + 8 * h;
            f32x16 R[2], I[2];
            float Ar[8], Br[8];
            __builtin_amdgcn_sched_barrier(0);
            bf16x8 waf[4], wxf[4];
#pragma unroll
            for (int ks = 0; ks < 4; ++ks) { waf[ks] = *(const bf16x8*)(wp + 16 * ks); wxf[ks] = *(const bf16x8*)(wp + 64 * 64 + 16 * ks); }
#pragma unroll
            for (int m = 0; m < 2; ++m) {
                f32x16 X = (f32x16){}; R[m] = (f32x16){}; I[m] = (f32x16){};
#pragma unroll
                for (int ks = 0; ks < 4; ++ks) {
                    bf16x8 id;
#pragma unroll
                    for (int j = 0; j < 8; ++j) id[j] = (16 * ks + 8 * h + j == 32 * et + c31) ? (short)0x3F80 : (short)0;
                    const bf16x8 afr = *(LAS const bf16x8*)(xim + (32 * m + c31) * 144 + (16 * ks + 8 * h) * 2);
                    R[m] = MFMA32(afr, waf[ks], R[m]); I[m] = MFMA32(afr, wxf[ks], I[m]); X = MFMA32(afr, id, X);
                }
                MFMA_SETTLE3(R[m], I[m], X);
#pragma unroll
                for (int q = 0; q < 4; ++q) {
                    float cp = 1.f, hl = 0.f;
#pragma unroll
                    for (int s = 0; s < 4; ++s) {
                        const int r = 4 * q + s;
                        const float rg = sigmoidf_(R[m][r] + ba), ig = sigmoidf_(I[m][r] + bx);
                        const float la = rg * lsig8;
                        const float a = __expf(la);
                        const float bg = X[r] * ig * __builtin_amdgcn_sqrtf((1.0f - a) * (1.0f + a));
                        cp *= a; hl = a * hl + bg;
                        R[m][r] = cp; I[m][r] = hl;
                    }
                    Ar[4 * m + q] = cp; Br[4 * m + q] = hl;
                }
                __builtin_amdgcn_sched_barrier(0);
            }
            float Hc = 0.f;
            if (PHASE_B) {
                for (int k0 = 0; k0 < seg; k0 += 16) {
                    f32x2_t ab[16];
#pragma unroll
                    for (int j = 0; j < 16; ++j) ab[j] = (k0 + j < seg) ? LSUM[((size_t)b * LR_NSEG + k0 + j) * 512 + ch] : (f32x2_t){1.f, 0.f};
#pragma unroll
                    for (int j = 0; j < 16; ++j) Hc = ab[j].x * Hc + ab[j].y;
                }
            }
            float st = Hc, At = 1.f, cin[8];
#pragma unroll
            for (int gi = 0; gi < 8; ++gi) {
                const Halves ha = halves(Ar[gi]), hb = halves(Br[gi]);
                const float A0 = ha.lo, B0 = hb.lo, A1 = ha.hi, B1 = hb.hi;
                const float s1 = A0 * st + B0;
                cin[gi] = h == 0 ? st : s1;
                st = A1 * s1 + B1; At *= A0 * A1;
            }
            if (!PHASE_B) {
                if (h == 0) LSUM[((size_t)b * LR_NSEG + seg) * 512 + ch] = (f32x2_t){At, st};
            } else {
#pragma unroll
                for (int m = 0; m < 2; ++m) {
                    float gcv[16];
#pragma unroll
                    for (int r = 0; r < 16; ++r) gcv[r] = bf2f(PROJ[(row0 + 32 * m + (r & 3) + 8 * (r >> 2) + 4 * h) * IN_COLS + C_GC + ch]);
#pragma unroll
                    for (int r = 0; r < 16; ++r) {
                        const float hv = I[m][r] + R[m][r] * cin[4 * m + (r >> 2)];
                        bf16_t* gp = PROJ + (row0 + 32 * m + (r & 3) + 8 * (r >> 2) + 4 * h) * IN_COLS + C_GC + ch;
                        const float gc = gcv[r];
                        if (!dry) *gp = f2bf(hv * siluf_(gc));
                        if (m == 1 && r == 15 && h == 1 && seg == LR_NSEG - 1) p->out[O_LP + ((size_t)l * BATCH + b) * 512 + ch] = hv;
                    }
                }
            }
        }
    }
}

__device__ __forceinline__ bf16_t* pre_row(unsigned char* ws, int r) { return (bf16_t*)(ws + WS_PROJ + (size_t)r * IN_COLS * 2 + (size_t)(C_GM + 1024) * 2); }
__device__ __forceinline__ void st_ln(KP p, int l, const Ctx& c) {
    const int lane = c.lane;
    const float* g = p->in[31] + l * 1024; const float* bb = p->in[32] + l * 1024;
    f32x4 gv[4], bv[4];
#pragma unroll
    for (int j = 0; j < 4; ++j) { const int cc = 512 * (j >> 1) + 8 * lane + 4 * (j & 1); gv[j] = *(const f32x4*)(g + cc); bv[j] = *(const f32x4*)(bb + cc); }
    constexpr int NR = 4;
    u32x4 cur[NR][2], nxt[NR][2];
#define LN_LOAD(dst, rb) do { _Pragma("unroll") for (int k = 0; k < NR; ++k) { const int r_ = (rb) + k < M_TOT ? (rb) + k : M_TOT - 1; const bf16_t* pr = pre_row(p->ws, r_); \
        dst[k][0] = *(const u32x4*)(pr + 8 * lane); dst[k][1] = *(const u32x4*)(pr + 512 + 8 * lane); } } while (0)
    int r0 = c.gw * NR;
    if (r0 < M_TOT) LN_LOAD(cur, r0);
    for (; r0 < M_TOT; r0 += c.ngw * NR) {
        const int rn = r0 + c.ngw * NR;
        if (rn < M_TOT) LN_LOAD(nxt, rn);
#pragma unroll
        for (int k = 0; k < NR; ++k) {
            const int r = r0 + k;
            f32x4 v[4];
#pragma unroll
            for (int q = 0; q < 2; ++q) { const u32x4 w = cur[k][q]; v[2 * q] = (f32x4){pg8::bflo(w.x), pg8::bfhi(w.x), pg8::bflo(w.y), pg8::bfhi(w.y)}; v[2 * q + 1] = (f32x4){pg8::bflo(w.z), pg8::bfhi(w.z), pg8::bflo(w.w), pg8::bfhi(w.w)}; }
            float s = 0.f;
#pragma unroll
            for (int j = 0; j < 4; ++j) s += (v[j][0] + v[j][1]) + (v[j][2] + v[j][3]);
            s = wave_sum(s);
            const float mu = s * (1.0f / 1024.0f);
            float q2 = 0.f;
#pragma unroll
            for (int j = 0; j < 4; ++j) { const f32x4 d = v[j] - mu; q2 += (d[0] * d[0] + d[1] * d[1]) + (d[2] * d[2] + d[3] * d[3]); }
            q2 = wave_sum(q2);
            const float rstd = rsqrtf(q2 * (1.0f / 1024.0f) + LN_EPS);
            if (r < M_TOT) {
#pragma unroll
                for (int q = 0; q < 2; ++q) {
                    const f32x4 y0 = (v[2 * q] - mu) * rstd * gv[2 * q] + bv[2 * q], y1 = (v[2 * q + 1] - mu) * rstd * gv[2 * q + 1] + bv[2 * q + 1];
                    const int cc = 512 * q + 8 * lane;
                    if (l == 0) { u32x4 o; o.x = cvtpk(y0[0], y0[1]); o.y = cvtpk(y0[2], y0[3]); o.z = cvtpk(y1[0], y1[1]); o.w = cvtpk(y1[2], y1[3]);
                                  *(u32x4*)((bf16_t*)(p->ws + WS_XB) + (size_t)r * D_MODEL + cc) = o; }
                    else { float* yo = (r < M_P ? p->out + O_YP + (size_t)r * D_MODEL : p->out + O_YS + (size_t)(r - M_P) * D_MODEL) + cc; *(f32x4*)yo = y0; *(f32x4*)(yo + 4) = y1; }
                }
            }
        }
#pragma unroll
        for (int k = 0; k < NR; ++k) { cur[k][0] = nxt[k][0]; cur[k][1] = nxt[k][1]; }
    }
#undef LN_LOAD
}

template <int NBR, int NS  , class Epi>
__device__ __forceinline__ void piece_gemm(LAS unsigned char* lds, const bf16_t* A0, const bf16_t* A1, const bf16_t* A2, int lda, const bf16_t* Bt, int ldb, int kboff, int row0, int col0, const Epi& epi, int wave_s) {
    int zv = 0; asm volatile("" : "+v"(zv));
    const int tid = tid_of(wave_s, zv), lane = tid & 63, wave = __builtin_amdgcn_readfirstlane(tid >> 6), c31 = lane & 31, h = lane >> 5;
    LAS float* part = (LAS float*)lds;
    float outv[NBR][4];
    constexpr int kw = 16 * NS;
    bf16x8 a[NBR][NS], b0[NBR][NS], b1[NBR][NS];
#pragma unroll
    for (int br = 0; br < NBR; ++br) {
        const bf16_t* A = br == 0 ? A0 : (br == 1 ? A1 : A2);
        const bf16_t* ap = A + (size_t)(row0 + c31) * lda + wave * kw + 8 * h;
        const bf16_t* bp = Bt + (size_t)(col0 + c31) * ldb + br * kboff + wave * kw + 8 * h;
#pragma unroll
        for (int s = 0; s < NS; ++s) { a[br][s] = *(const bf16x8*)(ap + 16 * s); b0[br][s] = *(const bf16x8*)(bp + 16 * s); b1[br][s] = *(const bf16x8*)(bp + (size_t)32 * ldb + 16 * s); }
    }
    typename Epi::Pre pre[4];
#pragma unroll
    for (int e = 0; e < 4; ++e) {
        const int idx = tid + 512 * e, nt = idx >> 10, r = (idx >> 6) & 15, ln = idx & 63;
        pre[e] = epi.load(row0 + (r & 3) + 8 * (r >> 2) + 4 * (ln >> 5), col0 + 32 * nt + (ln & 31));
    }
    __builtin_amdgcn_sched_barrier(0);
#pragma unroll
    for (int br = 0; br < NBR; ++br) {
        f32x16 acc0 = (f32x16){}, acc1 = (f32x16){};
#pragma unroll
        for (int s = 0; s < NS; ++s) { acc0 = MFMA32(a[br][s], b0[br][s], acc0); acc1 = MFMA32(a[br][s], b1[br][s], acc1); }
        MFMA_SETTLE2(acc0, acc1);
        __syncthreads();
#pragma unroll
        for (int r = 0; r < 16; ++r) { part[((wave * 2 + 0) * 16 + r) * 64 + lane] = acc0[r]; part[((wave * 2 + 1) * 16 + r) * 64 + lane] = acc1[r]; }
        __syncthreads();
#pragma unroll
        for (int e = 0; e < 4; ++e) {
            const int idx = tid + 512 * e;
            float s = 0.f;
#pragma unroll
            for (int w = 0; w < 8; ++w) s += part[w * 2048 + idx];
            outv[br][e] = s;
        }
    }
#pragma unroll
    for (int e = 0; e < 4; ++e) {
        const int idx = tid + 512 * e, nt = idx >> 10, r = (idx >> 6) & 15, ln = idx & 63;
        const int row = row0 + (r & 3) + 8 * (r >> 2) + 4 * (ln >> 5), col = col0 + 32 * nt + (ln & 31);
        float v[NBR];
#pragma unroll
        for (int br = 0; br < NBR; ++br) v[br] = outv[br][e];
        epi.store(row, col, pre[e], v);
    }
    __syncthreads();
}
struct PEpiGlu { bf16_t* PROJ; bool dry; struct Pre { bf16_t z, g; };
    __device__ __forceinline__ Pre load(int r, int c) const { const bf16_t* rp = PROJ + (size_t)r * IN_COLS; return Pre{rp[C_UB + c], rp[C_GB + c]}; }
    __device__ __forceinline__ void store(int r, int c, const Pre& q, const float (&v)[1]) const {
        if (!dry) PROJ[(size_t)r * IN_COLS + C_GB + c] = f2bf(bf2f(q.z) * sigmoidf_(v[0]) * siluf_(bf2f(q.g))); } };
struct PEpiBranch { bf16_t* PROJ; bool dry; struct Pre { bf16_t g0, g1, g2; };
    __device__ __forceinline__ Pre load(int r, int c) const { const bf16_t* gp = PROJ + (size_t)r * IN_COLS + C_GM + c; return Pre{gp[0], gp[1024], gp[2048]}; }
    __device__ __forceinline__ void store(int r, int c, const Pre& q, const float (&v)[3]) const {
        const float m = __builtin_amdgcn_rcpf(bf2f(q.g0)) * v[0] + __builtin_amdgcn_rcpf(bf2f(q.g1)) * v[1] + __builtin_amdgcn_rcpf(bf2f(q.g2)) * v[2];
        if (!dry) PROJ[(size_t)r * IN_COLS + C_GM + c] = f2bf(m); } };
struct PEpiOut { KP p; int l; struct Pre { float x; };
    __device__ __forceinline__ Pre load(int r, int c) const {
        return Pre{bf2f(((const bf16_t*)(p->ws + WS_XB))[(size_t)r * D_MODEL + c])}; }
    __device__ __forceinline__ void store(int r, int c, const Pre& q, const float (&v)[1]) const { pre_row(p->ws, r)[c] = f2bf(DN_ALPHA * q.x + v[0]); } };

#ifndef TSEL
#define TSEL 0
#endif
#define TS_BEGIN(K) do { if (TSEL == (K) && blockIdx.x == 0 && wave_s == 0 && lane_id() == 0) *(volatile LAS unsigned long long*)(lds + LDS_MISC + 128) = __builtin_amdgcn_s_memrealtime(); } while (0)
#define TS_END(K) do { if (TSEL == (K) && blockIdx.x == 0 && wave_s == 0 && lane_id() == 0) *(volatile LAS unsigned long long*)(lds + LDS_MISC + 136) += __builtin_amdgcn_s_memrealtime() - *(volatile LAS unsigned long long*)(lds + LDS_MISC + 128); } while (0)
__global__ void __launch_bounds__(NTHREADS, 2) mega_fwd(P p_unused) {
    extern __shared__ __attribute__((aligned(16))) unsigned char lds_raw[];
    LAS unsigned char* lds = (LAS unsigned char*)lds_raw;
    volatile LAS unsigned* misc = (volatile LAS unsigned*)(lds + LDS_MISC);
    const int wave_s = __builtin_amdgcn_readfirstlane((int)threadIdx.x >> 6);
    if (wave_s == 0) misc[lane_id()] = 0u;
    __syncthreads();
    XcdBarrier bar;
    { KP p = get_kp(); bar = xcd_barrier_post((unsigned*)(p->ws + WS_CTL), misc, wave_s); }
    TS_BEGIN(100);

    { KP p = get_kp(); const Ctx c = make_ctx(wave_s); unsigned char* dob = (unsigned char*)p->out;
      st_convert_x(p, c);
      st_prologue_weights(p, c, (LAS float*)(lds + c.wave * 9216), 0, 1);
      st_s5_tables2(p, c);
      for (size_t i = c.gt; i < (size_t)DEPTH * 512; i += c.ngt) ((float*)(p->ws + WS_LSIG))[i] = -8.0f * log1pf(expf(-p->in[28][i]));
      { bf16_t* LRUW = (bf16_t*)(p->ws + WS_LRUW);
        for (size_t i = c.gt; i < (size_t)DEPTH * 8 * 2 * 64 * 64; i += c.ngt) {
            const int d = (int)(i & 63), e = (int)((i >> 6) & 63), mat = (int)((i >> 12) & 1), ln = (int)(i >> 13);
            LRUW[i] = f2bf(p->in[mat ? 26 : 24][((size_t)ln * 64 + d) * 64 + e]); } } }
    xcd_barrier(bar);
    TS_END(100);

#ifndef PROBE
#define PROBE 0
#endif
#define PROBE_RUN(K, BODY) do { if (PROBE == (K)) { int d_ = 1; asm volatile("" : "+s"(d_)); const bool dry = d_ != 0; BODY; __syncthreads(); } { const bool dry = false; BODY; } } while (0)
#define PH_P1 { KP p = get_kp(); int zs = 0; asm volatile("" : "+s"(zs)); (void)dry; \
          pg8::Gemm g{(const bf16_t*)(p->ws + WS_XB), D_MODEL, (const bf16_t*)((unsigned char*)p->out + DO_WIN) + (size_t)l * IN_COLS * 1024, 1024}; \
          pg8::StaticOrder S; S.init(M_TOT, IN_COLS, (int)gridDim.x + zs, (int)blockIdx.x + zs); \
          pg8::gemm_phase<pg8::EpiProjB, pg8::StaticOrder, true, true>(lds, g, S, pg8::EpiProjB{(bf16_t*)(p->ws + WS_PROJ), IN_COLS}, wave_s); \
          if (l == 0) {   \
              const int nb_ = (int)gridDim.x + zs, bid_ = (int)blockIdx.x + zs, short_ = ((M_TOT / 256) * (IN_COLS / 256)) % nb_; \
              if (short_ == 0 || bid_ >= short_) { const Ctx c = make_ctx(wave_s); Ctx gq = c; const int sz_ = short_ == 0 ? nb_ : nb_ - short_, rk_ = short_ == 0 ? bid_ : bid_ - short_; \
                  gq.gw = c.wave * sz_ + rk_; gq.ngw = NWAVES * sz_; st_prologue_weights(p, gq, (LAS float*)(lds + c.wave * 9216), 1, DEPTH); } } }
#define PH_SAMPLE { KP p = get_kp(); const Ctx c = make_ctx(wave_s); if (wave_s == 5) { const Ctx g = waveset_ctx(c, 0, 1); st_s5_sample(p, l, g, lds, dry); st_lru_sample(p, l, g, lds, dry); } }
#define PH_SUMM { KP p = get_kp(); const Ctx c = make_ctx(wave_s); (void)dry; \
          if (wave_s < 2 || wave_s == 4) st_s5_phaseA(p, l, waveset_ctx(c, wave_s == 4 ? 2 : wave_s, 3)); \
          if (wave_s == 2 || wave_s == 3 || wave_s >= 6) st_lru_mfma<false>(p, l, waveset_ctx(c, wave_s >= 6 ? wave_s - 4 : wave_s - 2, 4), lds, false); }
#define PH_ATTN { __syncthreads(); KP p = get_kp(); st_attn_prompt(p, l, lds, dry, wave_s); st_attn_sample(p, l, lds, dry, wave_s); }
#define PH_P3 { KP p = get_kp(); const Ctx c = make_ctx(wave_s); unsigned* ctl_ = (unsigned*)(p->ws + WS_CTL); \
          volatile LAS unsigned* ms_ = (volatile LAS unsigned*)(lds + LDS_MISC + 160); \
          if (wave_s == 0 && c.lane == 0) { const unsigned x_ = xb_xcc_id(); unsigned ne_ = 0, no_ = 0; \
              for (unsigned j = 0; j < 16; ++j) { const unsigned cj = xb_ld(&ctl_[XB_XCNT(j)]); if (j & 1) no_ += cj; else ne_ += cj; } \
              const unsigned role_ = x_ & 1u, both_ = (ne_ == 0u || no_ == 0u) ? 1u : 0u; \
              const unsigned rank_ = both_ ? (unsigned)(c.gw - c.wave * (c.ngw / NWAVES)) : xb_add(&ctl_[4096 + 64 * (2 * l + (int)role_)], 1u); \
              ms_[0] = both_ ? 2u : role_; ms_[1] = rank_; ms_[2] = both_ ? (unsigned)(c.ngw / NWAVES) : (role_ ? no_ : ne_); } \
          __syncthreads(); \
          const unsigned role_ = ms_[0]; Ctx g = c; g.gw = c.wave * (int)ms_[2] + (int)ms_[1]; g.ngw = NWAVES * (int)ms_[2]; \
          if (role_ == 0u || role_ == 2u) st_s5_phaseB(p, l, g, lds, dry); \
          if (role_ == 1u || role_ == 2u) st_lru_mfma<true>(p, l, g, lds, dry); }
#define PH_GLU { KP p = get_kp(); int zs = 0; asm volatile("" : "+s"(zs)); bf16_t* PROJ = (bf16_t*)(p->ws + WS_PROJ); \
          pg8::Gemm g{PROJ + C_UB, IN_COLS, (const bf16_t*)((unsigned char*)p->out + DO_WGLU) + (size_t)l * 512 * 512, 512}; \
          pg8::StaticOrder S; S.init(M_P, 512, (int)gridDim.x + zs, (int)blockIdx.x + zs); \
          pg8::gemm_phase<pg8::EpiGluB, pg8::StaticOrder, true, true>(lds, g, S, pg8::EpiGluB{PROJ, dry}, wave_s); \
          const int nb_ = (int)gridDim.x + zs, bid_ = (int)blockIdx.x + zs; \
          if (bid_ >= nb_ / 2) { const Ctx c = make_ctx(wave_s); Ctx g = c; g.gt = (size_t)(bid_ - nb_ / 2) * NTHREADS + c.tid; g.ngt = (size_t)(nb_ - nb_ / 2) * NTHREADS; st_kv_out(p, l, g); }   \
          for (int pc = nb_ - 1 - bid_; pc < 16 * 8; pc += nb_)   \
              piece_gemm<1, 4>(lds, PROJ + C_UB, nullptr, nullptr, IN_COLS, g.Bt, 512, 0, M_P + 32 * (pc >> 3), 64 * (pc & 7), PEpiGlu{PROJ, dry}, wave_s); }
#define PH_BRANCH { KP p = get_kp(); int zs = 0; asm volatile("" : "+s"(zs)); bf16_t* PROJ = (bf16_t*)(p->ws + WS_PROJ); \
          pg8::Gemm g{PROJ + C_Q, IN_COLS, (const bf16_t*)((unsigned char*)p->out + DO_WBR) + (size_t)l * 1024 * 1536, 1536}; \
          pg8::StaticOrder S; S.init(M_P, 1024, (int)gridDim.x + zs, (int)blockIdx.x + zs); \
          pg8::gemm_phase<pg8::EpiMergeB, pg8::StaticOrder, true, true>(lds, g, S, pg8::EpiMergeB{PROJ, dry}, wave_s); \
          const int nb_ = (int)gridDim.x + zs, bid_ = (int)blockIdx.x + zs; \
          for (int pc = bid_; pc < 16 * 16; pc += nb_) \
              piece_gemm<3, 4>(lds, PROJ + C_Q, PROJ + C_GB, PROJ + C_GC, IN_COLS, g.Bt, 1536, 512, M_P + 32 * (pc >> 4), 64 * (pc & 15), PEpiBranch{PROJ, dry}, wave_s); }
#define PH_OUT { KP p = get_kp(); int zs = 0; asm volatile("" : "+s"(zs)); bf16_t* PROJ = (bf16_t*)(p->ws + WS_PROJ); (void)dry; \
          pg8::Gemm g{PROJ + C_GM, IN_COLS, (const bf16_t*)(p->ws + WS_WOUT) + (size_t)l * 1024 * 1024, 1024}; \
          pg8::StaticOrder S; S.init(M_P, 1024, (int)gridDim.x + zs, (int)blockIdx.x + zs); \
          pg8::gemm_phase<pg8::EpiOutB, pg8::StaticOrder, true, true>(lds, g, S, pg8::EpiOutB{(const bf16_t*)(p->ws + WS_XB), p->ws}, wave_s); \
          const int nb_ = (int)gridDim.x + zs, bid_ = (int)blockIdx.x + zs; \
          for (int pc = bid_; pc < 16 * 16; pc += nb_) \
              piece_gemm<1, 8>(lds, PROJ + C_GM, nullptr, nullptr, IN_COLS, g.Bt, 1024, 0, M_P + 32 * (pc >> 4), 64 * (pc & 15), PEpiOut{p, l}, wave_s); }
#define PH_LN { KP p = get_kp(); const Ctx c = make_ctx(wave_s); (void)dry; st_ln(p, l, c); }
    for (int l = 0; l < DEPTH; ++l) {
        TS_BEGIN(1); PROBE_RUN(1, PH_P1);
        xcd_barrier(bar); TS_END(1);
#if TSEL >= 20
        TS_BEGIN(21); PROBE_RUN(2, PH_SAMPLE); xcd_barrier(bar); TS_END(21);
        TS_BEGIN(22); PROBE_RUN(3, PH_SUMM); xcd_barrier(bar); TS_END(22);
        TS_BEGIN(23); PROBE_RUN(4, PH_ATTN); xcd_barrier(bar); TS_END(23);
        { const bool dry = false; PH_P3; } xcd_barrier(bar);
#else
        TS_BEGIN(2); PROBE_RUN(2, PH_SAMPLE);
        PROBE_RUN(3, PH_SUMM);
        PROBE_RUN(4, PH_ATTN);
        xcd_barrier(bar); TS_END(2);
        TS_BEGIN(3); { const bool dry = false; PH_P3; }
        xcd_barrier(bar); TS_END(3);
#endif
        TS_BEGIN(4); PROBE_RUN(7, PH_GLU);
        xcd_barrier(bar); TS_END(4);
        TS_BEGIN(5); PROBE_RUN(8, PH_BRANCH);
        xcd_barrier(bar); TS_END(5);
        TS_BEGIN(6); PROBE_RUN(9, PH_OUT);
        xcd_barrier(bar); TS_END(6);
        TS_BEGIN(7); PROBE_RUN(10, PH_LN);
        if (l + 1 < DEPTH) xcd_barrier(bar);
        TS_END(7);
    }
    if (TSEL != 0 && blockIdx.x == 0 && wave_s == 0 && lane_id() == 0) { const unsigned long long te = __builtin_amdgcn_s_memrealtime(), ts_acc = *(volatile LAS unsigned long long*)(lds + LDS_MISC + 136); while (__builtin_amdgcn_s_memrealtime() - te < ts_acc) __builtin_amdgcn_s_sleep(4); }
}

extern "C" void kernel_launch(void* const* d_in, const int* in_sizes, int n_in, void* d_out, int out_size, void* d_ws, size_t ws_size, hipStream_t stream) {
    static int grid = 0;
    if (grid == 0) {
        if (n_in != 33 || (size_t)out_size != O_END || ws_size < WS_CTL + CTL_BYTES) { fprintf(stderr, "kernel_launch: unexpected sizes n_in %d out %d ws %zu\n", n_in, out_size, ws_size); grid = -1; return; }
        int dev = 0, cus = 0, per_cu = 0;
        if (hipGetDevice(&dev) != hipSuccess || hipDeviceGetAttribute(&cus, hipDeviceAttributeMultiprocessorCount, dev) != hipSuccess) { grid = -1; return; }
        if (hipFuncSetAttribute((const void*)mega_fwd, hipFuncAttributeMaxDynamicSharedMemorySize, LDS_BYTES) != hipSuccess) { fprintf(stderr, "kernel_launch: hipFuncSetAttribute failed\n"); grid = -1; return; }
        if (hipOccupancyMaxActiveBlocksPerMultiprocessor(&per_cu, (const void*)mega_fwd, NTHREADS, LDS_BYTES) != hipSuccess || per_cu < 1) { fprintf(stderr, "kernel_launch: occupancy query says %d blocks/CU\n", per_cu); grid = -1; return; }
        grid = cus;
    }
    if (grid < 0) return;
    (void)hipMemsetAsync((unsigned char*)d_ws + WS_CTL, 0, CTL_BYTES, stream);
    P p{};
    for (int i = 0; i < 33; ++i) p.in[i] = (const float*)d_in[i];
    p.out = (float*)d_out; p.ws = (unsigned char*)d_ws;
    void* args[] = {&p};
    hipError_t e = hipLaunchCooperativeKernel((const void*)mega_fwd, dim3(grid), dim3(NTHREADS), args, LDS_BYTES, stream);
    if (e != hipSuccess) fprintf(stderr, "kernel_launch: cooperative launch failed: %s (grid %d)\n", hipGetErrorString(e), grid);
}
```

```cpp
#include <hip/hip_runtime.h>
#include <cstdint>
#include <cstdio>

typedef unsigned short bf16_t;
typedef short bf16x8 __attribute__((ext_vector_type(8)));
typedef float f32x16 __attribute__((ext_vector_type(16)));
typedef float f32x4 __attribute__((ext_vector_type(4)));

constexpr int D_MODEL = 1024, BATCH = 8, SEQ = 2048, DEPTH = 2, DEC_BATCH = 128, DEC_SEQ = 4;
constexpr int M_P = BATCH * SEQ;
constexpr int M_S = DEC_BATCH * DEC_SEQ;
constexpr int M_TOT = M_P + M_S;
constexpr int IN_COLS = 6400;
constexpr int C_Q = 0, C_GB = 512, C_GC = 1024, C_K = 1536, C_V = 1664, C_GA = 1792, C_UB = 2304, C_XC = 2816, C_GM = 3328;
__host__ __device__ constexpr int colperm32(int n0) {
    return n0 < 512 ? n0 : n0 < 640 ? C_K + (n0 - 512) : n0 < 768 ? C_V + (n0 - 640) : n0 < 1280 ? C_GA + (n0 - 768) : n0 < 1792 ? C_UB + (n0 - 1280)
         : n0 < 2304 ? C_GB + (n0 - 1792) : n0 < 2816 ? C_XC + (n0 - 2304) : n0 < 3328 ? C_GC + (n0 - 2816) : n0; }
constexpr int WINDOW = 128, NKV = 2, HD = 64, NQH = 8;
constexpr int NG = 32, NP = 64, NC = 16;
constexpr float DN_ALPHA = 1.4142135623730951f;
constexpr float LN_EPS = 1e-5f;

constexpr size_t O_YP = 0;
constexpr size_t O_YS = O_YP + (size_t)M_P * D_MODEL;
constexpr size_t O_KP = O_YS + (size_t)M_S * D_MODEL;
constexpr size_t SZ_KP = (size_t)DEPTH * BATCH * WINDOW * NKV * HD;
constexpr size_t O_VP = O_KP + SZ_KP;
constexpr size_t O_SRP = O_VP + SZ_KP;
constexpr size_t SZ_SP = (size_t)DEPTH * BATCH * NG * NP;
constexpr size_t O_SIP = O_SRP + SZ_SP;
constexpr size_t O_LP = O_SIP + SZ_SP;
constexpr size_t SZ_LP = (size_t)DEPTH * BATCH * 512;
constexpr size_t O_CP = O_LP + SZ_LP;
constexpr size_t SZ_CP = (size_t)DEPTH * BATCH * 3 * 512;
constexpr size_t O_KS = O_CP + SZ_CP;
constexpr size_t SZ_KS = (size_t)DEPTH * DEC_BATCH * WINDOW * NKV * HD;
constexpr size_t O_VS = O_KS + SZ_KS;
constexpr size_t O_SRS = O_VS + SZ_KS;
constexpr size_t SZ_SS = (size_t)DEPTH * DEC_BATCH * NG * NP;
constexpr size_t O_SIS = O_SRS + SZ_SS;
constexpr size_t O_LS = O_SIS + SZ_SS;
constexpr size_t SZ_LS = (size_t)DEPTH * DEC_BATCH * 512;
constexpr size_t O_CS = O_LS + SZ_LS;
constexpr size_t SZ_CS = (size_t)DEPTH * DEC_BATCH * 3 * 512;
constexpr size_t O_END = O_CS + SZ_CS;

constexpr size_t WS_PROJ = 0;
constexpr size_t WS_XB = WS_PROJ + (size_t)M_TOT * IN_COLS * 2;
constexpr size_t WS_WOUT = WS_XB + (size_t)M_TOT * D_MODEL * 2;
constexpr size_t WS_TAB = WS_WOUT + (size_t)DEPTH * 1024 * 1024 * 2;
constexpr size_t TAB_AB = 0;
constexpr size_t TAB_BB = TAB_AB + (size_t)DEPTH * NG * NP * 2 * 4;
constexpr size_t TAB_BYTES = TAB_BB + (size_t)DEPTH * NG * NP * NC * 2 * 4;
constexpr size_t WS_S5POW = WS_TAB + TAB_BYTES;
constexpr size_t WS_S5PINV = WS_S5POW + (size_t)DEPTH * NG * 11 * NP * 8;
constexpr size_t WS_S5BCAT = WS_S5PINV + (size_t)DEPTH * NG * 9 * NP * 8;
constexpr size_t WS_S5CCAT = WS_S5BCAT + (size_t)DEPTH * NG * 128 * NC * 2;
constexpr size_t WS_S5SUM = WS_S5CCAT + (size_t)DEPTH * NG * 128 * NC * 2;
constexpr size_t WS_LRUW = WS_S5SUM + (size_t)BATCH * 8 * NG * NP * 8;
constexpr size_t WS_LRSUM = WS_LRUW + (size_t)DEPTH * 8 * 2 * 64 * 64 * 2;
constexpr size_t WS_LSIG = WS_LRSUM + (size_t)BATCH * 32 * 512 * 8;
constexpr size_t WS_END = WS_LSIG + (size_t)DEPTH * 512 * 4;
constexpr size_t DO_WIN = 0;
constexpr size_t DO_WBR = DO_WIN + (size_t)DEPTH * IN_COLS * 1024 * 2;
constexpr size_t DO_WGLU = DO_WBR + (size_t)DEPTH * 3 * 1024 * 512 * 2;
constexpr size_t DO_LRUW = DO_WGLU + (size_t)DEPTH * 512 * 512 * 2;
constexpr size_t DO_END = DO_LRUW;
static_assert(DO_END <= (size_t)M_P * D_MODEL * 4, "weights fit in y_prompt region");
static_assert(WS_END <= 268435456ull, "workspace fits 256 MiB");

__constant__ unsigned char T5_BUCKET[128] = {0, 1, 2, 3, 4, 5, 6, 7, 8, 9, 10, 11, 12, 13, 14, 15, 16, 16, 16, 17, 17, 18, 18, 18, 19, 19, 19, 20, 20, 20, 20, 21, 21, 21, 21, 22, 22, 22, 22, 22, 23, 23, 23, 23, 23, 23, 24, 24, 24, 24, 24, 24, 25, 25, 25, 25, 25, 25, 25, 26, 26, 26, 26, 26, 26, 26, 26, 27, 27, 27, 27, 27, 27, 27, 27, 27, 27, 28, 28, 28, 28, 28, 28, 28, 28, 28, 28, 29, 29, 29, 29, 29, 29, 29, 29, 29, 29, 29, 29, 30, 30, 30, 30, 30, 30, 30, 30, 30, 30, 30, 30, 30, 30, 31, 31, 31, 31, 31, 31, 31, 31, 31, 31, 31, 31, 31, 31, 31};

typedef unsigned u32x4 __attribute__((ext_vector_type(4)));
typedef float f32x2_t __attribute__((ext_vector_type(2)));
typedef __bf16 bf16x2_t __attribute__((ext_vector_type(2)));
__device__ __forceinline__ unsigned cvtpk(float lo, float hi) { f32x2_t v = {lo, hi}; bf16x2_t b = __builtin_convertvector(v, bf16x2_t); return __builtin_bit_cast(unsigned, b); }
__device__ __forceinline__ float bf2f(bf16_t v) { return __uint_as_float(((unsigned)v) << 16); }
__device__ __forceinline__ bf16_t f2bf(float f) { return (bf16_t)cvtpk(f, 0.f); }
__device__ __forceinline__ float sigmoidf_(float x) { return __builtin_amdgcn_rcpf(1.0f + __builtin_amdgcn_exp2f(-1.4426950408889634f * x)); }
__device__ __forceinline__ float siluf_(float x) { return x * sigmoidf_(x); }
__device__ __forceinline__ float gelu_tanh(float y) { return y * sigmoidf_(1.5957691216057308f * (y + 0.044715f * y * y * y)); }

struct P {
    const float* in[33];
    float* out;
    unsigned char* ws;
};

typedef const P __attribute__((address_space(4)))* KP;
__device__ __forceinline__ KP get_kp() { KP k = (KP)__builtin_amdgcn_kernarg_segment_ptr(); asm volatile("" : "+s"(k)); return k; }

constexpr size_t WS_CTL = (WS_END + 4095) & ~(size_t)4095;
constexpr size_t CTL_BYTES = 65536;
static_assert(WS_CTL + CTL_BYTES <= 268435456ull, "workspace fits 256 MiB");
constexpr int NTHREADS = 512, NWAVES = 8;
constexpr int LDS_BYTES = 147456;
constexpr int LDS_MISC = 135168;

#define LAS __attribute__((address_space(3)))
#define XB_TMO      128
#define XB_XCNT(j)  (256  + 64 * (j))
#define XB_XSUB(j)  (1280 + 64 * (j))
#define XB_XGEN(j)  (2304 + 64 * (j))
#define XB_TOP      3328
#define XB_TOPGEN   3392
#define XCD_BAR_WORDS 3456
#define XB_SPIN_CAP (1u << 18)
__device__ __forceinline__ unsigned xb_ld(unsigned* p)              { return __hip_atomic_load(p, __ATOMIC_RELAXED, __HIP_MEMORY_SCOPE_AGENT); }
__device__ __forceinline__ unsigned xb_add(unsigned* p, unsigned v) { return __hip_atomic_fetch_add(p, v, __ATOMIC_RELAXED, __HIP_MEMORY_SCOPE_AGENT); }
__device__ __forceinline__ unsigned xb_xcc_id() { return (unsigned)__builtin_amdgcn_s_getreg((3 << 11) | 20) & 0xFu; }
#define XB_SPIN(cond, bar) do { unsigned _sp = 0; while (cond) { __builtin_amdgcn_s_sleep(1); \
    if ((++_sp & 255u) == 0u) { if (xb_ld(&(bar)[XB_TMO])) break; if (_sp > XB_SPIN_CAP) { atomicAdd(&(bar)[XB_TMO], 1u); break; } } } } while (0)
__device__ __forceinline__ int lane_id0() { return (int)__builtin_amdgcn_mbcnt_hi(~0u, __builtin_amdgcn_mbcnt_lo(~0u, 0u)); }
struct XcdBarrier { unsigned* bar; unsigned x; volatile LAS unsigned* st; int wave_s; };
__device__ __forceinline__ XcdBarrier xcd_barrier_post(unsigned* bar, volatile LAS unsigned* st, int wave_s) {
    XcdBarrier b; b.bar = bar; b.x = xb_xcc_id(); b.st = st; b.wave_s = wave_s;
    if (wave_s == 0 && lane_id0() == 0) (void)xb_add(&bar[XB_XCNT(b.x)], 1u);
    return b;
}
__device__ __forceinline__ void xcd_barrier_complete(unsigned* bar, unsigned x, unsigned& nloc, unsigned& nx) {
    const unsigned G = gridDim.x * gridDim.y * gridDim.z;
    unsigned sum, cnt, mine, sp = 0u;
    for (;;) {
        sum = 0u; cnt = 0u; mine = 0u;
#pragma unroll
        for (unsigned j = 0; j < 16; ++j) { const unsigned c = xb_ld(&bar[XB_XCNT(j)]); sum += c; cnt += (c > 0u) ? 1u : 0u; mine = (j == x) ? c : mine; }
        if (sum == G) break;
        __builtin_amdgcn_s_sleep(1);
        if ((++sp & 255u) == 0u) { if (xb_ld(&bar[XB_TMO])) break; if (sp > XB_SPIN_CAP) { atomicAdd(&bar[XB_TMO], 1u); break; } }
    }
    nloc = mine > 0u ? mine : 1u; nx = cnt > 0u ? cnt : 1u;
}
__device__ __forceinline__ void xcd_barrier(const XcdBarrier& b) {
    asm volatile("s_waitcnt vmcnt(0)" ::: "memory");
    __syncthreads();
    int zb_ = 0; asm volatile("" : "+v"(zb_));
    if (b.wave_s == 0 && (int)__builtin_amdgcn_mbcnt_hi(~0u, __builtin_amdgcn_mbcnt_lo(~0u, (unsigned)zb_)) == 0) {
        unsigned* bar = b.bar; asm volatile("" : "+s"(bar));
        unsigned bx = b.x; asm volatile("" : "+s"(bx));
        __builtin_amdgcn_s_waitcnt(0);
        unsigned nloc = b.st[0], nx = b.st[1];
        if (nloc == 0u) { xcd_barrier_complete(bar, bx, nloc, nx); b.st[0] = nloc; b.st[1] = nx; }
        const unsigned old = xb_add(&bar[XB_XSUB(bx)], 1u);
        const unsigned gen = old / nloc;
        if (old + 1u == (gen + 1u) * nloc) {
            __builtin_amdgcn_fence(__ATOMIC_RELEASE, "agent");
            asm volatile("s_waitcnt vmcnt(0)" ::: "memory");
            const unsigned og = xb_add(&bar[XB_TOP], 1u);
            const unsigned tg = og / nx;
            if (og + 1u == (tg + 1u) * nx) xb_add(&bar[XB_TOPGEN], 1u);
            else XB_SPIN(xb_ld(&bar[XB_TOPGEN]) == tg, bar);
            __builtin_amdgcn_fence(__ATOMIC_ACQUIRE, "agent");
            xb_add(&bar[XB_XGEN(bx)], 1u);
            asm volatile("s_waitcnt vmcnt(0)" ::: "memory");
        } else {
            XB_SPIN(xb_ld(&bar[XB_XGEN(bx)]) == gen, bar);
            __builtin_amdgcn_fence(__ATOMIC_ACQUIRE, "agent");
            asm volatile("s_waitcnt vmcnt(0)" ::: "memory");
        }
    }
    __syncthreads();
}

namespace pg8 {
#define PG8_LAS __attribute__((address_space(3)))
typedef unsigned short bf16_t;
typedef short bf16x8 __attribute__((ext_vector_type(8)));
typedef float f32x4 __attribute__((ext_vector_type(4)));
typedef unsigned u32x4 __attribute__((ext_vector_type(4)));
constexpr int BM = 256, BK = 64, HALF = 128, HTB = HALF * BK * 2  , STAGE_BYTES = 8 * HTB, NXCD = 8, WGM = 8;

__host__ __device__ __forceinline__ int lds_byte(int r, int c) { const int st = (r >> 4) * 2 + (c >> 5), rr = r & 15, cc = c & 31, ob = rr * 64 + cc * 2; return st * 1024 + (ob ^ (((ob >> 9) & 1) << 5)); }
__host__ __device__ __forceinline__ void stage_rc(int b, int& R, int& C) { const int st = b / 1024, sb = b % 1024, swz = sb ^ (((sb >> 9) & 1) << 5); R = (st >> 1) * 16 + swz / 64; C = (st & 1) * 32 + (swz % 64) / 2; }
__host__ __device__ __forceinline__ int perm32(int rho) { const int n = rho >> 4, i = rho & 15; return 8 * (i >> 2) + 4 * n + (i & 3); }

struct Unit { int pm, pn, z; };
struct Gemm { const bf16_t* A; int lda; const bf16_t* Bt; int K; };

struct StaticOrder {
    int nM, nN, nwg, G, c;
    __host__ __device__ void init(int M, int N, int G_, int c_) { nM = M / BM; nN = N / BM; nwg = nM * nN; G = G_; c = c_; }
    __host__ __device__ bool next(int i, Unit& u) const {
        const long L = (long)i * G + c; if (L >= nwg) return false;
        int wgid = (int)L; { const int q = nwg / NXCD, r = nwg % NXCD, xcd = wgid % NXCD, off = wgid / NXCD; wgid = (xcd < r ? xcd * (q + 1) : r * (q + 1) + (xcd - r) * q) + off; }
        const int nig = WGM * nN, gid = wgid / nig, fm = gid * WGM, gsz = (nM - fm) < WGM ? (nM - fm) : WGM;
        u.pm = fm + ((wgid % nig) % gsz); u.pn = (wgid % nig) / gsz; u.z = 0; return true;
    }
    __device__ __forceinline__ size_t a_off(const Unit&) const { return 0; }
    __device__ __forceinline__ size_t b_off(const Unit&) const { return 0; }
    __device__ __forceinline__ void a_ready(const Unit&) const {}
    __device__ __forceinline__ void done(const Unit&) const {}
};

__device__ __forceinline__ unsigned cvt_pk_bf16(float lo, float hi) { unsigned r; asm volatile("v_cvt_pk_bf16_f32 %0, %1, %2" : "=v"(r) : "v"(lo), "v"(hi)); return r; }
typedef float f32x2 __attribute__((ext_vector_type(2)));
__device__ __forceinline__ f32x2 gelu_pk(f32x2 v) {
    const f32x2 av = __builtin_elementwise_abs(v), d = av * 0.2316418882f + 1.0f;
    f32x2 t; t.x = __builtin_amdgcn_rcpf(d.x); t.y = __builtin_amdgcn_rcpf(d.y);
    f32x2 q = t * 0.5307027145f + (-0.7265760135f); q = q * t + 0.7107068705f; q = q * t + (-0.142248368f); q = q * t + 0.127414796f; q = q * t;
    const f32x2 s = (v * v) * (-0.72134752044f);
    f32x2 e; e.x = __builtin_amdgcn_exp2f(s.x); e.y = __builtin_amdgcn_exp2f(s.y);
    const f32x2 m = v * (q * e), r = v - m;
    f32x2 o; o.x = v.x < 0.f ? m.x : r.x; o.y = v.y < 0.f ? m.y : r.y; return o;
}

template <class Epi, class Sched, bool ALIGN_EPI = false, bool SP2 = false>
__device__ __forceinline__ void gemm_phase(PG8_LAS unsigned char* lds, const Gemm g, const Sched& S, const Epi& E, int wave_s) {
    int zv_ = 0; asm volatile("" : "+v"(zv_));
    const int tid = (wave_s << 6) | (int)__builtin_amdgcn_mbcnt_hi(~0u, __builtin_amdgcn_mbcnt_lo(~0u, (unsigned)zv_)), wid = __builtin_amdgcn_readfirstlane(tid >> 6), lane = tid & 63, wr = wid >> 2, wc = wid & 3, fr = lane & 15, fq = lane >> 4;
    const int K = g.K, nt = K / BK;
    unsigned voffA[2], voffB[2];
#pragma unroll
    for (int i = 0; i < 2; ++i) { int R, C; stage_rc(tid * 16 + i * 8192, R, C); const int Rb = Epi::PERM ? ((R & ~31) + perm32(R & 31)) : R;
        voffA[i] = (unsigned)(R * g.lda + C) * 2u; voffB[i] = (unsigned)(Rb * K + C) * 2u; }
    const size_t kstep = (size_t)(BK * 2);
    const size_t hstepA = (size_t)HALF * g.lda * 2, hstepB = (size_t)HALF * K * 2;
    const size_t tstepA = 2 * hstepA, tstepB = 2 * hstepB;
    const unsigned ldsw = (unsigned)wid * 1024u;
    const int aoff = lds_byte(wr * 64 + fr, fq * 8), boff = lds_byte(wc * 32 + fr, fq * 8);
#define PG8_SA(b, h) (((b) * 2 + (h)) * HTB)
#define PG8_SB(b, h) ((4 + (b) * 2 + (h)) * HTB)
#define PG8_STAGE(bufoff, gbase, voff) do { _Pragma("unroll") for (int _i = 0; _i < 2; ++_i) \
        __builtin_amdgcn_global_load_lds((const unsigned*)((const char*)(gbase) + (voff)[_i]), (PG8_LAS unsigned*)(lds + (bufoff) + ldsw + _i * 8192), 16, 0, 0); } while (0)
#define PG8_LDA(dst, b, h) do { _Pragma("unroll") for (int m = 0; m < 4; ++m) _Pragma("unroll") for (int k = 0; k < 2; ++k) dst[m][k] = *(const PG8_LAS bf16x8*)(lds + PG8_SA(b, h) + aoff + m * 2048 + k * 1024); } while (0)
#define PG8_LDB(dst, b, h) do { _Pragma("unroll") for (int n = 0; n < 2; ++n) _Pragma("unroll") for (int k = 0; k < 2; ++k) dst[n][k] = *(const PG8_LAS bf16x8*)(lds + PG8_SB(b, h) + boff + n * 2048 + k * 1024); } while (0)
#define PG8_MMA(ai, bj, At, Bt) do { __builtin_amdgcn_s_setprio(1); _Pragma("unroll") for (int m = 0; m < 4; ++m) _Pragma("unroll") for (int n = 0; n < 2; ++n) _Pragma("unroll") for (int k = 0; k < 2; ++k) \
        acc[ai][bj][m][n] = __builtin_amdgcn_mfma_f32_16x16x32_bf16(Bt[n][k], At[m][k], acc[ai][bj][m][n], 0, 0, 0); __builtin_amdgcn_s_setprio(0); } while (0)
#define PG8_WAIT_V(n) asm volatile("s_waitcnt vmcnt(" #n ")" ::: "memory")
#define PG8_WAIT_L(n) asm volatile("s_waitcnt lgkmcnt(" #n ")" ::: "memory")
#define PG8_BAR __builtin_amdgcn_s_barrier()
#define PG8_SCHED __builtin_amdgcn_sched_barrier(0)
    Unit cur, nxt; int ui = 0;
    if (!S.next(0, cur)) return;
    f32x4 acc[2][2][4][2];
#pragma unroll
    for (int a = 0; a < 2; ++a)
#pragma unroll
        for (int b = 0; b < 2; ++b)
#pragma unroll
            for (int m = 0; m < 4; ++m)
#pragma unroll
                for (int n = 0; n < 2; ++n) acc[a][b][m][n] = (f32x4){0.f, 0.f, 0.f, 0.f};
    bf16x8 At[4][2], B0[2][2], B1[2][2];
    const char* cA = (const char*)g.A + (size_t)cur.pm * tstepA + S.a_off(cur); const char* cB = (const char*)g.Bt + (size_t)cur.pn * tstepB + S.b_off(cur);
    S.a_ready(cur);
    if constexpr (SP2) {
        PG8_STAGE(PG8_SB(0, 0), cB, voffB); PG8_STAGE(PG8_SB(0, 1), cB + hstepB, voffB); PG8_STAGE(PG8_SA(0, 0), cA, voffA); PG8_STAGE(PG8_SA(0, 1), cA + hstepA, voffA);
        if (wr == 1) PG8_BAR;
        PG8_WAIT_V(2); PG8_BAR;
        PG8_STAGE(PG8_SB(1, 0), cB + kstep, voffB); PG8_STAGE(PG8_SA(1, 0), cA + kstep, voffA); PG8_STAGE(PG8_SB(1, 1), cB + hstepB + kstep, voffB);
        PG8_WAIT_V(6); PG8_BAR;
    } else {
        PG8_STAGE(PG8_SB(0, 0), cB, voffB); PG8_STAGE(PG8_SA(0, 0), cA, voffA); PG8_STAGE(PG8_SB(0, 1), cB + hstepB, voffB); PG8_STAGE(PG8_SA(0, 1), cA + hstepA, voffA);
        if (wr == 1) PG8_BAR;
        PG8_WAIT_V(4); PG8_BAR;
        PG8_STAGE(PG8_SB(1, 0), cB + kstep, voffB); PG8_STAGE(PG8_SA(1, 0), cA + kstep, voffA); PG8_STAGE(PG8_SB(1, 1), cB + hstepB + kstep, voffB);
        PG8_WAIT_V(6); PG8_BAR;
    }
    for (;;) {
        const bool has_next = S.next(ui + 1, nxt);
        const char* nA = has_next ? (const char*)g.A + (size_t)nxt.pm * tstepA + S.a_off(nxt) : cA; const char* nB = has_next ? (const char*)g.Bt + (size_t)nxt.pn * tstepB + S.b_off(nxt) : cB;
        for (int t = 0; t < nt; t += 2) {
            if constexpr (Epi::MIDSCALE) { if (t == 8 || t == 16) E.rescale(acc, cur, (t >> 3) - 1, wr, wc, fr, fq); }
            const bool last = (t == nt - 2);
            const char* a1 = cA + (size_t)(t + 1) * kstep;
            const char* a2 = last ? nA : cA + (size_t)(t + 2) * kstep; const char* b2 = last ? nB : cB + (size_t)(t + 2) * kstep;
            const char* a3 = a2 + kstep; const char* b3 = b2 + kstep;
            if (last && has_next) S.a_ready(nxt);
            if constexpr (SP2) {
            PG8_LDB(B0, 0, 0); PG8_LDB(B1, 0, 1); PG8_SCHED; PG8_LDA(At, 0, 0); PG8_STAGE(PG8_SA(1, 1), a1 + hstepA, voffA);
            PG8_WAIT_V(8); PG8_WAIT_L(0); PG8_BAR; PG8_MMA(0, 0, At, B0); PG8_MMA(0, 1, At, B1); PG8_BAR; PG8_SCHED;
            PG8_LDA(At, 0, 1); PG8_STAGE(PG8_SB(0, 0), b2, voffB); PG8_STAGE(PG8_SB(0, 1), b2 + hstepB, voffB); PG8_STAGE(PG8_SA(0, 0), a2, voffA);
            PG8_WAIT_V(8); PG8_WAIT_L(0); PG8_BAR; PG8_MMA(1, 0, At, B0); PG8_MMA(1, 1, At, B1); PG8_BAR; PG8_SCHED;
            PG8_LDB(B0, 1, 0); PG8_LDB(B1, 1, 1); PG8_SCHED; PG8_LDA(At, 1, 0); PG8_STAGE(PG8_SA(0, 1), a2 + hstepA, voffA);
            PG8_WAIT_V(8); PG8_WAIT_L(0); PG8_BAR; PG8_MMA(0, 0, At, B0); PG8_MMA(0, 1, At, B1); PG8_BAR; PG8_SCHED;
            PG8_LDA(At, 1, 1); PG8_STAGE(PG8_SB(1, 0), b3, voffB); PG8_STAGE(PG8_SB(1, 1), b3 + hstepB, voffB); PG8_STAGE(PG8_SA(1, 0), a3, voffA);
            PG8_WAIT_V(8); PG8_WAIT_L(0); PG8_BAR; PG8_MMA(1, 0, At, B0); PG8_MMA(1, 1, At, B1); PG8_BAR; PG8_SCHED;
            } else {
            PG8_LDB(B0, 0, 0); PG8_SCHED; PG8_LDA(At, 0, 0); PG8_STAGE(PG8_SA(1, 1), a1 + hstepA, voffA);
            PG8_WAIT_L(8); PG8_BAR; PG8_WAIT_L(0); PG8_MMA(0, 0, At, B0); PG8_BAR; PG8_SCHED;
            PG8_LDB(B1, 0, 1); PG8_STAGE(PG8_SB(0, 0), b2, voffB);
            PG8_BAR; PG8_WAIT_L(0); PG8_MMA(0, 1, At, B1); PG8_BAR;
            PG8_LDA(At, 0, 1); PG8_STAGE(PG8_SA(0, 0), a2, voffA);
            PG8_BAR; PG8_WAIT_L(0); PG8_MMA(1, 0, At, B0); PG8_BAR; PG8_SCHED;
            PG8_STAGE(PG8_SB(0, 1), b2 + hstepB, voffB);
            PG8_WAIT_V(6); PG8_BAR; PG8_MMA(1, 1, At, B1); PG8_BAR;
            PG8_LDB(B0, 1, 0); PG8_SCHED; PG8_LDA(At, 1, 0); PG8_STAGE(PG8_SA(0, 1), a2 + hstepA, voffA);
            PG8_WAIT_L(8); PG8_BAR; PG8_WAIT_L(0); PG8_MMA(0, 0, At, B0); PG8_BAR; PG8_SCHED;
            PG8_LDB(B1, 1, 1); PG8_STAGE(PG8_SB(1, 0), b3, voffB);
            PG8_BAR; PG8_WAIT_L(0); PG8_MMA(0, 1, At, B1); PG8_BAR;
            PG8_LDA(At, 1, 1); PG8_STAGE(PG8_SA(1, 0), a3, voffA);
            PG8_BAR; PG8_WAIT_L(0); PG8_MMA(1, 0, At, B0); PG8_BAR; PG8_SCHED;
            PG8_STAGE(PG8_SB(1, 1), b3 + hstepB, voffB);
            PG8_WAIT_V(6); PG8_BAR; PG8_MMA(1, 1, At, B1); PG8_BAR;
            }
        }
        if constexpr (ALIGN_EPI) { if (wr == 0) PG8_BAR; }
        if constexpr (!Epi::AFTER_DRAIN) { E(acc, cur, wr, wc, fr, fq); S.done(cur); }
        if (!has_next) break;
#pragma unroll
        for (int a = 0; a < 2; ++a)
#pragma unroll
            for (int b = 0; b < 2; ++b)
#pragma unroll
                for (int m = 0; m < 4; ++m)
#pragma unroll
                    for (int n = 0; n < 2; ++n) acc[a][b][m][n] = (f32x4){0.f, 0.f, 0.f, 0.f};
        cur = nxt; cA = nA; cB = nB; ++ui;
        if constexpr (ALIGN_EPI) { if (wr == 1) PG8_BAR; }
    }
    PG8_WAIT_V(0);
    if constexpr (!ALIGN_EPI) { if (wr == 0) PG8_BAR; }
    PG8_BAR;
    if constexpr (Epi::AFTER_DRAIN) { E.fused(acc, cur, wr, wc, fr, fq, lds, wid, lane); S.done(cur); }
#undef PG8_SA
#undef PG8_SB
#undef PG8_STAGE
#undef PG8_LDA
#undef PG8_LDB
#undef PG8_MMA
#undef PG8_WAIT_V
#undef PG8_WAIT_L
#undef PG8_BAR
#undef PG8_SCHED
}
}

namespace pg8 {
typedef unsigned u32x2 __attribute__((ext_vector_type(2)));
__device__ __forceinline__ float bflo(unsigned w) { return __uint_as_float(w << 16); }
__device__ __forceinline__ float bfhi(unsigned w) { return __uint_as_float(w & 0xffff0000u); }
__device__ __forceinline__ float sigm(float x) { return __builtin_amdgcn_rcpf(1.0f + __builtin_amdgcn_exp2f(-1.4426950408889634f * x)); }
struct EpiProjB {
    static constexpr bool PERM = true, AFTER_DRAIN = false, MIDSCALE = false;
    bf16_t* O; int ldc;
    __device__ __forceinline__ void operator()(const f32x4 (&acc)[2][2][4][2], const Unit& u, int wr, int wc, int fr, int fq) const {
        const int row0 = u.pm * BM + wr * 64 + fr, col0 = u.pn * BM + wc * 32 + 8 * fq;
        const bool gate = u.pn >= C_GM / BM;
#pragma unroll
        for (int ai = 0; ai < 2; ++ai)
#pragma unroll
            for (int m = 0; m < 4; ++m) { bf16_t* rowp = O + (size_t)(row0 + ai * HALF + m * 16) * ldc + col0;
#pragma unroll
                for (int bj = 0; bj < 2; ++bj) { f32x4 v0 = acc[ai][bj][m][0], v1 = acc[ai][bj][m][1];
                    if (gate) {
#pragma unroll
                        for (int e = 0; e < 4; ++e) { v0[e] = 1.0f + __builtin_amdgcn_exp2f(fminf(-1.4426950408889634f * v0[e], 100.f)); v1[e] = 1.0f + __builtin_amdgcn_exp2f(fminf(-1.4426950408889634f * v1[e], 100.f)); } }
                    u32x4 w; w.x = cvt_pk_bf16(v0[0], v0[1]); w.y = cvt_pk_bf16(v0[2], v0[3]); w.z = cvt_pk_bf16(v1[0], v1[1]); w.w = cvt_pk_bf16(v1[2], v1[3]);
                    *(u32x4*)(rowp + bj * HALF) = w; } }
    }
};
struct EpiGluB {
    static constexpr bool PERM = true, AFTER_DRAIN = false, MIDSCALE = false;
    bf16_t* PROJ; bool dry;
    __device__ __forceinline__ void operator()(const f32x4 (&acc)[2][2][4][2], const Unit& u, int wr, int wc, int fr, int fq) const {
        const int row0 = u.pm * BM + wr * 64 + fr, col0 = u.pn * BM + wc * 32 + 8 * fq;
        u32x4 zz[2][2][2], gg[2][2][2];
#define GL_ISSUE(g) do { const int ai_ = (g) >> 1, m0_ = 2 * ((g) & 1); _Pragma("unroll") for (int mm = 0; mm < 2; ++mm) { \
            const bf16_t* rowp = PROJ + (size_t)(row0 + ai_ * HALF + (m0_ + mm) * 16) * IN_COLS + col0; \
            _Pragma("unroll") for (int bj = 0; bj < 2; ++bj) { zz[(g) & 1][mm][bj] = *(const u32x4*)(rowp + C_UB + bj * HALF); gg[(g) & 1][mm][bj] = *(const u32x4*)(rowp + C_GB + bj * HALF); } } } while (0)
        GL_ISSUE(0);
#pragma unroll
        for (int ah = 0; ah < 4; ++ah) { const int ai = ah >> 1, m0 = 2 * (ah & 1);
            if (ah + 1 < 4) GL_ISSUE(ah + 1);
            __builtin_amdgcn_sched_barrier(0);
#pragma unroll
            for (int mm = 0; mm < 2; ++mm) { const int m = m0 + mm; bf16_t* rowp = PROJ + (size_t)(row0 + ai * HALF + m * 16) * IN_COLS + col0;
#pragma unroll
                for (int bj = 0; bj < 2; ++bj) {
                    const f32x4 v0 = acc[ai][bj][m][0], v1 = acc[ai][bj][m][1];
                    float o[8];
#pragma unroll
                    for (int e = 0; e < 4; ++e) {
                        const float va = e < 2 ? v0[2 * e] : v1[2 * (e - 2)], vb = e < 2 ? v0[2 * e + 1] : v1[2 * (e - 2) + 1];
                        const unsigned wz = zz[ah & 1][mm][bj][e], wg = gg[ah & 1][mm][bj][e];
                        const float za = bflo(wz), zb = bfhi(wz), ga = bflo(wg), gb = bfhi(wg);
                        o[2 * e] = za * sigm(va) * ga * sigm(ga); o[2 * e + 1] = zb * sigm(vb) * gb * sigm(gb);
                    }
                    u32x4 w; w.x = cvt_pk_bf16(o[0], o[1]); w.y = cvt_pk_bf16(o[2], o[3]); w.z = cvt_pk_bf16(o[4], o[5]); w.w = cvt_pk_bf16(o[6], o[7]);
                    if (!dry) *(u32x4*)(rowp + C_GB + bj * HALF) = w; } }
        }
#undef GL_ISSUE
    }
};
#ifndef RS_DEPTH
#define RS_DEPTH 1
#endif
struct EpiMergeB {
    static constexpr bool PERM = true, AFTER_DRAIN = false, MIDSCALE = true;
    bf16_t* PROJ; bool dry;
    __device__ __forceinline__ void rescale(f32x4 (&acc)[2][2][4][2], const Unit& u, int step, int wr, int wc, int fr, int fq) const {
        int zr = 0; asm volatile("" : "+v"(zr));
        const int row0 = u.pm * BM + wr * 64 + fr + zr, col0 = u.pn * BM + wc * 32 + 8 * fq;
        constexpr int DEPTH_ = RS_DEPTH;
        u32x4 ga[DEPTH_ + 1][2][2], gb[DEPTH_ + 1][2][2];
#define RS_ISSUE(g) do { const int ai_ = (g) >> 1, m0_ = 2 * ((g) & 1); _Pragma("unroll") for (int mm = 0; mm < 2; ++mm) { \
            const bf16_t* rowp = PROJ + (size_t)(row0 + ai_ * HALF + (m0_ + mm) * 16) * IN_COLS + C_GM + step * 1024 + col0; \
            _Pragma("unroll") for (int bj = 0; bj < 2; ++bj) { ga[(g) % (DEPTH_ + 1)][mm][bj] = *(const u32x4*)(rowp + bj * HALF); gb[(g) % (DEPTH_ + 1)][mm][bj] = *(const u32x4*)(rowp + 1024 + bj * HALF); } } } while (0)
#pragma unroll
        for (int g = 0; g < DEPTH_; ++g) RS_ISSUE(g);
#pragma unroll
        for (int ah = 0; ah < 4; ++ah) { const int ai = ah >> 1, m0 = 2 * (ah & 1);
            if (ah + DEPTH_ < 4) RS_ISSUE(ah + DEPTH_);
            __builtin_amdgcn_sched_barrier(0);
#pragma unroll
            for (int mm = 0; mm < 2; ++mm)
#pragma unroll
                for (int bj = 0; bj < 2; ++bj)
#pragma unroll
                    for (int e = 0; e < 4; ++e) { const int m = m0 + mm; const unsigned wa = ga[ah % (DEPTH_ + 1)][mm][bj][e], wb = gb[ah % (DEPTH_ + 1)][mm][bj][e];
                        const float r0 = bflo(wb) * __builtin_amdgcn_rcpf(bflo(wa)), r1 = bfhi(wb) * __builtin_amdgcn_rcpf(bfhi(wa));
                        if (e < 2) { acc[ai][bj][m][0][2 * e] *= r0; acc[ai][bj][m][0][2 * e + 1] *= r1; } else { acc[ai][bj][m][1][2 * (e - 2)] *= r0; acc[ai][bj][m][1][2 * (e - 2) + 1] *= r1; }
                    }
        }
#undef RS_ISSUE
    }
    __device__ __forceinline__ void operator()(const f32x4 (&acc)[2][2][4][2], const Unit& u, int wr, int wc, int fr, int fq) const {
        const int row0 = u.pm * BM + wr * 64 + fr, col0 = u.pn * BM + wc * 32 + 8 * fq;
        u32x4 gg[2][4][2];
#pragma unroll
        for (int ai = 0; ai < 2; ++ai)
#pragma unroll
            for (int m = 0; m < 4; ++m) { const bf16_t* rowp = PROJ + (size_t)(row0 + ai * HALF + m * 16) * IN_COLS + C_GM + 2048 + col0;
#pragma unroll
                for (int bj = 0; bj < 2; ++bj) gg[ai][m][bj] = *(const u32x4*)(rowp + bj * HALF); }
        __builtin_amdgcn_sched_barrier(0);
#pragma unroll
        for (int ai = 0; ai < 2; ++ai)
#pragma unroll
            for (int m = 0; m < 4; ++m) { bf16_t* rowp = PROJ + (size_t)(row0 + ai * HALF + m * 16) * IN_COLS + C_GM + col0;
#pragma unroll
                for (int bj = 0; bj < 2; ++bj) {
                    const f32x4 v0 = acc[ai][bj][m][0], v1 = acc[ai][bj][m][1];
                    float o[8];
#pragma unroll
                    for (int e = 0; e < 4; ++e) {
                        const float va = e < 2 ? v0[2 * e] : v1[2 * (e - 2)], vb = e < 2 ? v0[2 * e + 1] : v1[2 * (e - 2) + 1];
                        o[2 * e] = __builtin_amdgcn_rcpf(bflo(gg[ai][m][bj][e])) * va; o[2 * e + 1] = __builtin_amdgcn_rcpf(bfhi(gg[ai][m][bj][e])) * vb;
                    }
                    u32x4 w; w.x = cvt_pk_bf16(o[0], o[1]); w.y = cvt_pk_bf16(o[2], o[3]); w.z = cvt_pk_bf16(o[4], o[5]); w.w = cvt_pk_bf16(o[6], o[7]);
                    if (!dry) *(u32x4*)(rowp + bj * HALF) = w; } }
    }
};
struct EpiOutB {
    static constexpr bool PERM = true, AFTER_DRAIN = false, MIDSCALE = false;
    const bf16_t* XB; unsigned char* ws;
    __device__ __forceinline__ void operator()(const f32x4 (&acc)[2][2][4][2], const Unit& u, int wr, int wc, int fr, int fq) const {
        const int row0 = u.pm * BM + wr * 64 + fr, col0 = u.pn * BM + wc * 32 + 8 * fq;
        u32x4 xx[2][4][2];
#pragma unroll
        for (int ai = 0; ai < 2; ++ai)
#pragma unroll
            for (int m = 0; m < 4; ++m) { const bf16_t* xrow = XB + (size_t)(row0 + ai * HALF + m * 16) * D_MODEL + col0;
#pragma unroll
                for (int bj = 0; bj < 2; ++bj) xx[ai][m][bj] = *(const u32x4*)(xrow + bj * HALF); }
        __builtin_amdgcn_sched_barrier(0);
#pragma unroll
        for (int ai = 0; ai < 2; ++ai)
#pragma unroll
            for (int m = 0; m < 4; ++m) { const int r = row0 + ai * HALF + m * 16;
                bf16_t* prow = (bf16_t*)(ws + WS_PROJ + (size_t)r * IN_COLS * 2 + (size_t)(C_GM + 1024) * 2) + col0;
#pragma unroll
                for (int bj = 0; bj < 2; ++bj) { const u32x4 w = xx[ai][m][bj];
                    const f32x4 o0 = (f32x4){bflo(w.x), bfhi(w.x), bflo(w.y), bfhi(w.y)} * DN_ALPHA + acc[ai][bj][m][0], o1 = (f32x4){bflo(w.z), bfhi(w.z), bflo(w.w), bfhi(w.w)} * DN_ALPHA + acc[ai][bj][m][1];
                    u32x4 ow; ow.x = cvt_pk_bf16(o0[0], o0[1]); ow.y = cvt_pk_bf16(o0[2], o0[3]); ow.z = cvt_pk_bf16(o1[0], o1[1]); ow.w = cvt_pk_bf16(o1[2], o1[3]);
                    *(u32x4*)(prow + bj * HALF) = ow; } }
    }
};
}

__device__ __forceinline__ int lane_id() { return (int)__builtin_amdgcn_mbcnt_hi(~0u, __builtin_amdgcn_mbcnt_lo(~0u, 0u)); }
__device__ __forceinline__ int tid_of(int wave_s, int zv) { return (wave_s << 6) | (int)__builtin_amdgcn_mbcnt_hi(~0u, __builtin_amdgcn_mbcnt_lo(~0u, (unsigned)zv)); }
struct Halves { float lo, hi; };
__device__ __forceinline__ Halves halves(float v) { const unsigned u = __float_as_uint(v); auto rr = __builtin_amdgcn_permlane32_swap(u, u, false, false); return Halves{__uint_as_float(rr[0]), __uint_as_float(rr[1])}; }
template <int O> __device__ __forceinline__ float xor_lane(float v) { return __int_as_float(__builtin_amdgcn_ds_swizzle(__float_as_int(v), (O << 10) | 0x1F)); }
__device__ __forceinline__ float wave_sum(float v) { v += xor_lane<1>(v); v += xor_lane<2>(v); v += xor_lane<4>(v); v += xor_lane<8>(v); v += xor_lane<16>(v); const Halves hh = halves(v); return hh.lo + hh.hi; }
struct Ctx { int tid, lane, wave, gw, ngw; size_t gt, ngt; };
__device__ __forceinline__ Ctx make_ctx(int wave_s) {
    int zv = 0; asm volatile("" : "+v"(zv)); int zs = 0; asm volatile("" : "+s"(zs));
    Ctx c; c.tid = tid_of(wave_s, zv); c.lane = c.tid & 63; c.wave = __builtin_amdgcn_readfirstlane(c.tid >> 6);
    const int bid = (int)blockIdx.x + zs, nb = (int)gridDim.x + zs;
    c.gw = c.wave * nb + bid; c.ngw = nb * NWAVES; c.gt = (size_t)bid * NTHREADS + c.tid; c.ngt = (size_t)nb * NTHREADS; return c;
}
__device__ __forceinline__ Ctx group_ctx(const Ctx& c, int w0, int nw) {
    Ctx g = c; const int nb = c.ngw / NWAVES, bid = c.gw - c.wave * nb; g.gw = (c.wave - w0) * nb + bid; g.ngw = nw * nb; return g; }
__device__ __forceinline__ Ctx waveset_ctx(const Ctx& c, int rank, int size) {
    Ctx g = c; const int nb = c.ngw / NWAVES, bid = c.gw - c.wave * nb; g.gw = rank * nb + bid; g.ngw = size * nb; return g; }
#define WAVE_LDS_SYNC() do { asm volatile("s_waitcnt lgkmcnt(0)" ::: "memory"); __builtin_amdgcn_wave_barrier(); } while (0)

__device__ __forceinline__ void st_convert_x(KP p, const Ctx& c) {
    u32x4* XB = (u32x4*)(p->ws + WS_XB);
    const size_t n8 = (size_t)M_TOT * D_MODEL / 8, np8 = (size_t)M_P * D_MODEL / 8;
    for (size_t i0 = c.gt; i0 < n8; i0 += 4 * c.ngt) {
        f32x4 a[4], b[4];
#pragma unroll
        for (int u = 0; u < 4; ++u) { const size_t i = i0 + u * c.ngt; if (i < n8) { const f32x4* src = i < np8 ? (const f32x4*)p->in[0] + 2 * i : (const f32x4*)p->in[1] + 2 * (i - np8); a[u] = src[0]; b[u] = src[1]; } }
#pragma unroll
        for (int u = 0; u < 4; ++u) { const size_t i = i0 + u * c.ngt; if (i < n8) { u32x4 o; o.x = cvtpk(a[u][0], a[u][1]); o.y = cvtpk(a[u][2], a[u][3]); o.z = cvtpk(b[u][0], b[u][1]); o.w = cvtpk(b[u][2], b[u][3]); XB[i] = o; } }
    }
}

__device__ __forceinline__ unsigned pk2bf(float lo, float hi) { return (unsigned)f2bf(lo) | ((unsigned)f2bf(hi) << 16); }
__device__ __forceinline__ void p0_transpose_item(const float* W, int K, int N, bf16_t* WT, int ldk, int koff, bool perm, LAS float* scr, int item, int lane) {
    const int nblk = N / 32, kb = item / nblk, nb = item % nblk, k0 = 64 * kb, n0 = 32 * nb, d0 = perm ? colperm32(n0) : n0;
    float wv[32];
#pragma unroll
    for (int i = 0; i < 32; ++i) wv[i] = W[(size_t)(k0 + 2 * i + (lane >> 5)) * N + n0 + (lane & 31)];
#pragma unroll
    for (int i = 0; i < 32; ++i) scr[(2 * i + (lane >> 5)) * 33 + (lane & 31)] = wv[i];
    WAVE_LDS_SYNC();
    const int cch = lane & 7;
#pragma unroll
    for (int j = 0; j < 4; ++j) { const int n = (lane >> 3) + 8 * j; const LAS float* sp = scr + (8 * cch) * 33 + n;
        u32x4 o; o.x = pk2bf(sp[0 * 33], sp[1 * 33]); o.y = pk2bf(sp[2 * 33], sp[3 * 33]); o.z = pk2bf(sp[4 * 33], sp[5 * 33]); o.w = pk2bf(sp[6 * 33], sp[7 * 33]);
        *(u32x4*)(WT + (size_t)(d0 + n) * ldk + koff + k0 + 8 * cch) = o; }
    WAVE_LDS_SYNC();
}
__device__ __forceinline__ void st_prologue_weights(KP p, const Ctx& c, LAS float* scr, int it_lo, int it_hi) {
    unsigned char* dob = (unsigned char*)p->out;
    constexpr int I_IN = 16 * 200, I_BR = 8 * 32, I_GLU = 8 * 16, I_OUT = 16 * 32, I_LAYER = I_IN + 3 * I_BR + I_GLU + I_OUT;
    if (it_hi < 0) it_hi = DEPTH * I_LAYER;
    for (int it = it_lo + c.gw; it < it_hi; it += c.ngw) {
        const int l = it / I_LAYER; int r = it % I_LAYER;
        if (r < I_IN) { p0_transpose_item(p->in[9] + (size_t)l * 1024 * IN_COLS, 1024, IN_COLS, (bf16_t*)(dob + DO_WIN) + (size_t)l * IN_COLS * 1024, 1024, 0, true, scr, r, c.lane); continue; } r -= I_IN;
        if (r < I_BR) { p0_transpose_item(p->in[11] + (size_t)l * 512 * 1024, 512, 1024, (bf16_t*)(dob + DO_WBR) + (size_t)l * 1024 * 1536, 1536, 0, false, scr, r, c.lane); continue; } r -= I_BR;
        if (r < I_BR) { p0_transpose_item(p->in[21] + (size_t)l * 512 * 1024, 512, 1024, (bf16_t*)(dob + DO_WBR) + (size_t)l * 1024 * 1536, 1536, 512, false, scr, r, c.lane); continue; } r -= I_BR;
        if (r < I_BR) { p0_transpose_item(p->in[29] + (size_t)l * 512 * 1024, 512, 1024, (bf16_t*)(dob + DO_WBR) + (size_t)l * 1024 * 1536, 1536, 1024, false, scr, r, c.lane); continue; } r -= I_BR;
        if (r < I_GLU) { p0_transpose_item(p->in[20] + (size_t)l * 512 * 512, 512, 512, (bf16_t*)(dob + DO_WGLU) + (size_t)l * 512 * 512, 512, 0, false, scr, r, c.lane); continue; } r -= I_GLU;
        p0_transpose_item(p->in[30] + (size_t)l * 1024 * 1024, 1024, 1024, (bf16_t*)(p->ws + WS_WOUT) + (size_t)l * 1024 * 1024, 1024, 0, false, scr, r, c.lane);
    }
}
__device__ __forceinline__ f32x4 ld_bf4(const bf16_t* q) { typedef unsigned u32x2_t __attribute__((ext_vector_type(2))); const u32x2_t w = *(const u32x2_t*)q;
    return (f32x4){__uint_as_float(w.x << 16), __uint_as_float(w.x & 0xffff0000u), __uint_as_float(w.y << 16), __uint_as_float(w.y & 0xffff0000u)}; }
__device__ __forceinline__ void st_kv_out(KP p, int l, const Ctx& c) {
    const bf16_t* PROJ = (const bf16_t*)(p->ws + WS_PROJ);
    for (size_t ii = c.gt; ii < (size_t)BATCH * 3 * 128; ii += c.ngt) {
        const int i = (int)ii, b = i / 384, j = (i / 128) % 3, c4 = i % 128;
        *(f32x4*)(p->out + O_CP + (size_t)l * BATCH * 1536 + (size_t)i * 4) = ld_bf4(PROJ + ((size_t)b * SEQ + SEQ - 3 + j) * IN_COLS + C_XC + 4 * c4);
    }
    for (size_t ii = c.gt; ii < (size_t)DEC_BATCH * 3 * 128; ii += c.ngt) {
        const int i = (int)ii, b = i / 384, j = (i / 128) % 3, c4 = i % 128;
        *(f32x4*)(p->out + O_CS + (size_t)l * DEC_BATCH * 1536 + (size_t)i * 4) = ld_bf4(PROJ + ((size_t)M_P + 4 * b + 1 + j) * IN_COLS + C_XC + 4 * c4);
    }
    for (size_t ii = c.gt; ii < (size_t)BATCH * WINDOW * 32; ii += c.ngt) {
        const int i = (int)ii, b = i / (WINDOW * 32), w = (i / 32) % WINDOW, c4 = i % 32;
        const bf16_t* src = PROJ + ((size_t)b * SEQ + (SEQ - WINDOW) + w) * IN_COLS + 4 * c4;
        *(f32x4*)(p->out + O_KP + (size_t)l * BATCH * WINDOW * 128 + (size_t)i * 4) = ld_bf4(src + C_K);
        *(f32x4*)(p->out + O_VP + (size_t)l * BATCH * WINDOW * 128 + (size_t)i * 4) = ld_bf4(src + C_V);
    }
    for (size_t ii = c.gt; ii < (size_t)DEC_BATCH * DEC_SEQ * 32; ii += c.ngt) {
        const int i = (int)ii, b = i / (DEC_SEQ * 32), t = (i / 32) % DEC_SEQ, c4 = i % 32;
        const bf16_t* src = PROJ + ((size_t)M_P + b * DEC_SEQ + t) * IN_COLS + 4 * c4;
        const size_t o = (((size_t)l * DEC_BATCH + b) * WINDOW + (WINDOW - DEC_SEQ) + t) * 128 + 4 * c4;
        *(f32x4*)(p->out + O_KS + o) = ld_bf4(src + C_K); *(f32x4*)(p->out + O_VS + o) = ld_bf4(src + C_V);
    }
    constexpr int NSH = DEC_BATCH * (WINDOW - DEC_SEQ) * 32;
    for (size_t i0 = c.gt; i0 < (size_t)NSH; i0 += 4 * c.ngt) {
        f32x4 kk[4], vv[4];
#pragma unroll
        for (int u = 0; u < 4; ++u) { const size_t ii = i0 + u * c.ngt; if (ii < (size_t)NSH) { const int i = (int)ii, b = i / ((WINDOW - DEC_SEQ) * 32), r = i % ((WINDOW - DEC_SEQ) * 32);
            const size_t ci = (((size_t)l * DEC_BATCH + b) * WINDOW + DEC_SEQ) * 128 + (size_t)r * 4; kk[u] = *(const f32x4*)(p->in[2] + ci); vv[u] = *(const f32x4*)(p->in[3] + ci); } }
#pragma unroll
        for (int u = 0; u < 4; ++u) { const size_t ii = i0 + u * c.ngt; if (ii < (size_t)NSH) { const int i = (int)ii, b = i / ((WINDOW - DEC_SEQ) * 32), r = i % ((WINDOW - DEC_SEQ) * 32);
            const size_t o = ((size_t)l * DEC_BATCH + b) * WINDOW * 128 + (size_t)r * 4; *(f32x4*)(p->out + O_KS + o) = kk[u]; *(f32x4*)(p->out + O_VS + o) = vv[u]; } }
    }
}

typedef short s16x4 __attribute__((ext_vector_type(4)));
typedef short v4i16_t __attribute__((ext_vector_type(4)));
__device__ __forceinline__ bf16x8 pack8(float a0, float a1, float a2, float a3, float a4, float a5, float a6, float a7) {
    u32x4 p; p.x = cvtpk(a0, a1); p.y = cvtpk(a2, a3); p.z = cvtpk(a4, a5); p.w = cvtpk(a6, a7); return __builtin_bit_cast(bf16x8, p); }
__device__ __forceinline__ s16x4 tr_read(LAS const unsigned char* p) { return __builtin_bit_cast(s16x4, __builtin_amdgcn_ds_read_tr16_b64_v4i16((LAS v4i16_t*)p)); }
__device__ __forceinline__ bf16x8 cat8(s16x4 lo, s16x4 hi) { return __builtin_shufflevector(lo, hi, 0, 1, 2, 3, 4, 5, 6, 7); }
#define MFMA_SETTLE2(a, b) asm volatile("s_nop 15\n\ts_nop 7" : "+v"(a), "+v"(b))
#define MFMA_SETTLE3(a, b, c) asm volatile("s_nop 15\n\ts_nop 7" : "+v"(a), "+v"(b), "+v"(c))
#define MFMA32(a, b, c) __builtin_amdgcn_mfma_f32_32x32x16_bf16((a), (b), (c), 0, 0, 0)
#define MFMA16(a, b, c) __builtin_amdgcn_mfma_f32_16x16x32_bf16((a), (b), (c), 0, 0, 0)

constexpr int AT_KSTR = 144, AT_VSTR = 192;
constexpr int AT_K = 0, AT_V = AT_K + 256 * AT_KSTR, AT_BIAS = AT_V + 256 * AT_VSTR, AT_WS = AT_BIAS + 4 * 128 * 4, AT_END = AT_WS + 8 * 256;
static_assert(AT_END <= 131072, "attention LDS");

__device__ __forceinline__ void st_attn_prompt(KP p, int l, LAS unsigned char* lds, bool dry, int wave_s) {
    int zv = 0; asm volatile("" : "+v"(zv));
    const int tid = tid_of(wave_s, zv), lane = tid & 63, wave = __builtin_amdgcn_readfirstlane(tid >> 6);
    const int c31 = lane & 31, h = lane >> 5;
    bf16_t* PROJ = (bf16_t*)(p->ws + WS_PROJ);
    const float* rel_bias = p->in[8];
    for (int item = blockIdx.x; item < BATCH * 16 * NKV; item += gridDim.x) {
        const int b = item / 32, nb = (item >> 1) & 15, kvh = item & 1;
        const size_t rowq0 = (size_t)b * SEQ + (size_t)nb * 128;
#pragma unroll
        for (int i = 0; i < 4; ++i) {
            const int id = tid + 512 * i, row = id >> 3, pc = id & 7;
            u32x4 kk = (u32x4){0u, 0u, 0u, 0u}, vv = kk;
            if (nb > 0 || row >= 128) {
                const bf16_t* src = PROJ + (rowq0 - 128 + row) * IN_COLS + kvh * 64 + pc * 8;
                kk = *(const u32x4*)(src + C_K); vv = *(const u32x4*)(src + C_V);
            }
            *(LAS u32x4*)(lds + AT_K + row * AT_KSTR + pc * 16) = kk;
            *(LAS u32x4*)(lds + AT_V + row * AT_VSTR + pc * 16) = vv;
        }
        { const int g = tid >> 7, d = tid & 127; ((LAS float*)(lds + AT_BIAS))[tid] = rel_bias[T5_BUCKET[d] * NQH + kvh * 4 + g]; }
        const int g = wave >> 1, hq = kvh * 4 + g;
        bf16x8 qfn[4];
        { const bf16_t* qp = PROJ + (rowq0 + 64 * (wave & 1) + c31) * IN_COLS + C_Q + hq * 64 + 8 * h;
#pragma unroll
          for (int ks = 0; ks < 4; ++ks) qfn[ks] = *(const bf16x8*)(qp + 16 * ks); }
        __syncthreads();
        const float sink = p->in[10][l * NQH + hq];
        LAS const float* biasd = (LAS const float*)(lds + AT_BIAS) + g * 128;
        LAS float* wsf = (LAS float*)(lds + AT_WS + wave * 256);
#pragma unroll 1
        for (int qi = 0; qi < 2; ++qi) {
            const int qt = 2 * (wave & 1) + qi, q0 = 32 * qt;
            bf16x8 qf[4];
#pragma unroll
            for (int ks = 0; ks < 4; ++ks) qf[ks] = qfn[ks];
            if (qi == 0) { const bf16_t* qp = PROJ + (rowq0 + q0 + 32 + c31) * IN_COLS + C_Q + hq * 64 + 8 * h;
#pragma unroll
                for (int ks = 0; ks < 4; ++ks) qfn[ks] = *(const bf16x8*)(qp + 16 * ks); }
            f32x16 S[5];
#pragma unroll
            for (int j = 0; j < 5; ++j) {
                S[j] = (f32x16){};
                LAS const unsigned char* kp = lds + AT_K + (32 * (qt + j) + c31) * AT_KSTR + 16 * h;
#pragma unroll
                for (int ks = 0; ks < 4; ++ks) S[j] = MFMA32(*(LAS const bf16x8*)(kp + 32 * ks), qf[ks], S[j]);
            }
            asm volatile("s_nop 15\n\ts_nop 7" : "+v"(S[0]), "+v"(S[1]), "+v"(S[2]), "+v"(S[3]), "+v"(S[4]));
            float gav[16][2];
#pragma unroll
            for (int r = 0; r < 16; ++r) {
                const bf16_t* rowp = PROJ + (rowq0 + q0 + (r & 3) + 8 * (r >> 2) + 4 * h) * IN_COLS + hq * 64 + c31;
                gav[r][0] = bf2f(rowp[C_GA]); gav[r][1] = bf2f(rowp[C_GA + 32]);
            }
            const int iq = q0 + c31;
            float mx = sink;
#pragma unroll
            for (int j = 0; j < 5; ++j)
#pragma unroll
                for (int r = 0; r < 16; ++r) {
                    const int kv = 32 * (qt + j) + (r & 3) + 8 * (r >> 2) + 4 * h;
                    const int dist = iq + 128 - kv;
                    const bool ok = (dist >= 0) && (dist < 128) && (nb > 0 || kv >= 128);
                    const float s = ok ? S[j][r] * 0.125f + biasd[dist & 127] : -1e30f;
                    S[j][r] = s; mx = fmaxf(mx, s);
                }
            { const Halves hh = halves(mx); mx = fmaxf(hh.lo, hh.hi); }
            float sum = 0.f;
#pragma unroll
            for (int j = 0; j < 5; ++j)
#pragma unroll
                for (int r = 0; r < 16; ++r) { const float e = S[j][r] > -1e29f ? __expf(S[j][r] - mx) : 0.f; S[j][r] = e; sum += e; }
            { const Halves hh = halves(sum); sum = hh.lo + hh.hi; }
            const float rden = 1.0f / (sum + __expf(sink - mx));
            if (h == 0) wsf[c31] = rden;
            f32x16 O[2]; O[0] = (f32x16){}; O[1] = (f32x16){};
            const int i16 = lane & 15, qq = i16 >> 2, pp = i16 & 3, blk = (lane >> 4) & 1;
#pragma unroll
            for (int j = 0; j < 5; ++j)
#pragma unroll
                for (int s = 0; s < 2; ++s) {
                    const bf16x8 pf = pack8(S[j][8 * s], S[j][8 * s + 1], S[j][8 * s + 2], S[j][8 * s + 3], S[j][8 * s + 4], S[j][8 * s + 5], S[j][8 * s + 6], S[j][8 * s + 7]);
                    LAS const unsigned char* vp = lds + AT_V + (32 * (qt + j) + 16 * s + 4 * h + qq) * AT_VSTR + (16 * blk + 4 * pp) * 2;
#pragma unroll
                    for (int dt = 0; dt < 2; ++dt) {
                        const bf16x8 vf = cat8(tr_read(vp + dt * 64), tr_read(vp + dt * 64 + 8 * AT_VSTR));
                        O[dt] = MFMA32(pf, vf, O[dt]);
                    }
                }
            MFMA_SETTLE2(O[0], O[1]);
            WAVE_LDS_SYNC();
#pragma unroll
            for (int r = 0; r < 16; ++r) {
                const int qr = (r & 3) + 8 * (r >> 2) + 4 * h;
                const float rd = wsf[qr];
                bf16_t* rowp = PROJ + (rowq0 + q0 + qr) * IN_COLS + hq * 64 + c31;
#pragma unroll
                for (int dt = 0; dt < 2; ++dt) if (!dry) rowp[C_Q + 32 * dt] = f2bf(O[dt][r] * rd * siluf_(gav[r][dt]));
            }
            WAVE_LDS_SYNC();
        }
        __syncthreads();
    }
}

constexpr int S5_NPOW = 11, S5_NINV = 9, S5_NSEG = 8, S5_SEGLEN = 256;
__device__ __forceinline__ float neg_expm1_small(float y) {
    float q = 1.0f / 5040.0f; q = q * y + 1.0f / 720.0f; q = q * y + 1.0f / 120.0f; q = q * y + 1.0f / 24.0f; q = q * y + 1.0f / 6.0f; q = q * y + 0.5f; q = q * y + 1.0f; return -(q * y);
}
__device__ __forceinline__ f32x2_t cmul(f32x2_t a, f32x2_t b) { return (f32x2_t){a.x * b.x - a.y * b.y, a.x * b.y + a.y * b.x}; }

__device__ __forceinline__ void st_s5_tables2(KP p, const Ctx& c) {
    f32x2_t* POW = (f32x2_t*)(p->ws + WS_S5POW); f32x2_t* PINV = (f32x2_t*)(p->ws + WS_S5PINV);
    bf16_t* BCAT = (bf16_t*)(p->ws + WS_S5BCAT); bf16_t* CCAT = (bf16_t*)(p->ws + WS_S5CCAT);
    const float* BB = (const float*)(p->ws + WS_TAB + TAB_BB);
    for (size_t ii = c.gt; ii < (size_t)DEPTH * NG * NP * (S5_NPOW + S5_NINV); ii += c.ngt) {
        const int k = (int)(ii % (S5_NPOW + S5_NINV)), i = (int)(ii / (S5_NPOW + S5_NINV)), lg = i / NP, pp = i % NP;
        const double lr = (double)fminf(p->in[12][i], -1e-4f), li = (double)p->in[13][i];
        const double step = (double)expf(p->in[14][lg]);
        const int e = k < 9 ? k : (k == 9 ? 64 : (k == 10 ? 256 : -(k - S5_NPOW)));
        double t = (double)e * li * step * 0.15915494309189535; t -= rint(t);
        float sn, cs; sincosf((float)(t * 6.283185307179586), &sn, &cs);
        const float mag = expf((float)((double)e * lr * step));
        const f32x2_t v = {mag * cs, mag * sn};
        if (k < S5_NPOW) POW[((size_t)lg * S5_NPOW + k) * NP + pp] = v; else PINV[((size_t)lg * S5_NINV + (k - S5_NPOW)) * NP + pp] = v;
    }
    for (size_t ii = c.gt; ii < (size_t)DEPTH * NG * 128 * NC; ii += c.ngt) {
        const int i = (int)ii, lg = i / (128 * NC), n = (i / NC) % 128, cc = i % NC, pp = n & 63;
        const int sidx = lg * NP + pp;
        const float lr = fminf(p->in[12][sidx], -1e-4f), li = p->in[13][sidx];
        const float step = expf(p->in[14][lg]);
        const float mag = expf(lr * step);
        float sn, cs; sincosf(li * step, &sn, &cs);
        const float ab_re = mag * cs, ab_im = mag * sn, den = lr * lr + li * li;
        const float f_re = ((ab_re - 1.0f) * lr + ab_im * li) / den, f_im = (ab_im * lr - (ab_re - 1.0f) * li) / den;
        const float bre = p->in[15][(size_t)sidx * NC + cc], bim = p->in[16][(size_t)sidx * NC + cc];
        BCAT[i] = f2bf(n < 64 ? f_re * bre - f_im * bim : f_re * bim + f_im * bre);
        const int c2 = (i / 128) % NC, n2 = i % 128, p2 = n2 & 63;
        const float cv = n2 < 64 ? p->in[17][((size_t)lg * NC + c2) * NP + p2] : -p->in[18][((size_t)lg * NC + c2) * NP + p2];
        CCAT[i] = f2bf(cv);
    }
}

__device__ __forceinline__ void s5_xtiles(f32x16 (&xr)[2], f32x16 (&xi)[2], const bf16x8 (&uf)[2], bf16x8 bre, bf16x8 bim) {
#pragma unroll
    for (int m = 0; m < 2; ++m) { xr[m] = MFMA32(uf[m], bre, (f32x16){}); xi[m] = MFMA32(uf[m], bim, (f32x16){}); }
    asm volatile("s_nop 15\n\ts_nop 7" : "+v"(xr[0]), "+v"(xr[1]), "+v"(xi[0]), "+v"(xi[1]));
}

__device__ __forceinline__ void st_s5_phaseA(KP p, int l, const Ctx& c) {
    const bf16_t* PROJ = (const bf16_t*)(p->ws + WS_PROJ);
    const f32x2_t* POW = (const f32x2_t*)(p->ws + WS_S5POW);
    const bf16_t* BCAT = (const bf16_t*)(p->ws + WS_S5BCAT);
    f32x2_t* SUM = (f32x2_t*)(p->ws + WS_S5SUM);
    const int lane = c.lane, c31 = lane & 31, h = lane >> 5;
    for (int item = c.gw; item < BATCH * S5_NSEG * NG; item += c.ngw) {
        const int g = item % NG, seg = (item / NG) % S5_NSEG, b = item / (NG * S5_NSEG);
        const int lg = l * NG + g;
        const size_t row0 = (size_t)b * SEQ + (size_t)seg * S5_SEGLEN;
#pragma unroll 1
        for (int pt = 0; pt < 2; ++pt) {
            const int pp = 32 * pt + c31;
            const f32x2_t* pw = POW + (size_t)lg * S5_NPOW * NP + pp;
            f32x2_t lo[4];
#pragma unroll
            for (int s = 0; s < 4; ++s) lo[s] = pw[(7 - 4 * h - s) * NP];
            const f32x2_t a8 = pw[8 * NP], a64 = pw[9 * NP];
            const bf16x8 bre = *(const bf16x8*)(BCAT + ((size_t)lg * 128 + pp) * NC + 8 * h);
            const bf16x8 bim = *(const bf16x8*)(BCAT + ((size_t)lg * 128 + 64 + pp) * NC + 8 * h);
            f32x2_t sseg = {0.f, 0.f};
            bf16x8 ufn[2];
#pragma unroll
            for (int m = 0; m < 2; ++m) ufn[m] = *(const bf16x8*)(PROJ + (row0 + 32 * m + c31) * IN_COLS + C_UB + 16 * g + 8 * h);
#pragma unroll 1
            for (int ch = 0; ch < 4; ++ch) {
                bf16x8 uf[2];
#pragma unroll
                for (int m = 0; m < 2; ++m) { uf[m] = ufn[m]; if (ch < 3) ufn[m] = *(const bf16x8*)(PROJ + (row0 + 64 * ch + 64 + 32 * m + c31) * IN_COLS + C_UB + 16 * g + 8 * h); }
                f32x16 xr[2], xi[2];
                s5_xtiles(xr, xi, uf, bre, bim);
                f32x2_t f = {1.f, 0.f}, acc = {0.f, 0.f};
#pragma unroll
                for (int gi = 7; gi >= 0; --gi) {
                    const int m = gi >> 2, q = gi & 3;
                    f32x2_t t = {0.f, 0.f};
#pragma unroll
                    for (int s = 0; s < 4; ++s) { const f32x2_t x = {xr[m][4 * q + s], xi[m][4 * q + s]}; const f32x2_t w = cmul(lo[s], x); t.x += w.x; t.y += w.y; }
                    const f32x2_t w2 = cmul(f, t); acc.x += w2.x; acc.y += w2.y;
                    f = cmul(f, a8);
                }
                { const Halves hx = halves(acc.x), hy = halves(acc.y); acc.x = hx.lo + hx.hi; acc.y = hy.lo + hy.hi; }
                const f32x2_t d = cmul(a64, sseg); sseg.x = d.x + acc.x; sseg.y = d.y + acc.y;
            }
            if (h == 0) SUM[(((size_t)b * S5_NSEG + seg) * NG + g) * NP + pp] = sseg;
        }
    }
}

constexpr int S5_HT_STR = 144, S5_HT_BYTES = 64 * S5_HT_STR;
__device__ __forceinline__ void st_s5_phaseB(KP p, int l, const Ctx& c, LAS unsigned char* lds, bool dry) {
    bf16_t* PROJ = (bf16_t*)(p->ws + WS_PROJ);
    const f32x2_t* POW = (const f32x2_t*)(p->ws + WS_S5POW); const f32x2_t* PINV = (const f32x2_t*)(p->ws + WS_S5PINV);
    const bf16_t* BCAT = (const bf16_t*)(p->ws + WS_S5BCAT); const bf16_t* CCAT = (const bf16_t*)(p->ws + WS_S5CCAT);
    const f32x2_t* SUM = (const f32x2_t*)(p->ws + WS_S5SUM);
    const int lane = c.lane, c31 = lane & 31, h = lane >> 5, i16 = lane & 15, kg = lane >> 4, qq = i16 >> 2, p4 = i16 & 3;
    LAS unsigned char* ht = lds + c.wave * S5_HT_BYTES;
    bf16x8 tdiag[2], tones;
#pragma unroll
    for (int s = 0; s < 2; ++s)
#pragma unroll
        for (int j = 0; j < 8; ++j) tdiag[s][j] = (16 * s + 8 * (j >> 2) + 4 * h + (j & 3) <= c31) ? (short)0x3F80 : (short)0;
#pragma unroll
    for (int j = 0; j < 8; ++j) tones[j] = (short)0x3F80;
    for (int item = c.gw; item < BATCH * S5_NSEG * NG; item += c.ngw) {
        const int g = item % NG, seg = (item / NG) % S5_NSEG, b = item / (NG * S5_NSEG);
        const int lg = l * NG + g;
        const size_t row0 = (size_t)b * SEQ + (size_t)seg * S5_SEGLEN;
        f32x2_t hin[2];
#pragma unroll
        for (int pt = 0; pt < 2; ++pt) {
            const int pp = 32 * pt + c31;
            const f32x2_t a256 = POW[((size_t)lg * S5_NPOW + 10) * NP + pp];
            f32x2_t H = {0.f, 0.f};
#pragma unroll
            for (int k = 0; k < S5_NSEG - 1; ++k) if (k < seg) { const f32x2_t sk = SUM[(((size_t)b * S5_NSEG + k) * NG + g) * NP + pp]; const f32x2_t d = cmul(a256, H); H.x = d.x + sk.x; H.y = d.y + sk.y; }
            hin[pt] = H;
        }
        const float dd = p->in[19][l * 512 + g * 16 + i16];
        bf16x8 ufn[2];
#pragma unroll
        for (int m = 0; m < 2; ++m) ufn[m] = *(const bf16x8*)(PROJ + (row0 + 32 * m + c31) * IN_COLS + C_UB + 16 * g + 8 * h);
#pragma unroll 1
        for (int ch = 0; ch < 4; ++ch) {
            const size_t crow0 = row0 + 64 * ch;
            bf16x8 uf[2];
#pragma unroll
            for (int m = 0; m < 2; ++m) { uf[m] = ufn[m]; if (ch < 3) ufn[m] = *(const bf16x8*)(PROJ + (crow0 + 64 + 32 * m + c31) * IN_COLS + C_UB + 16 * g + 8 * h); }
            f32x4 Y[4];
#pragma unroll
            for (int it = 0; it < 4; ++it) Y[it] = (f32x4){0.f, 0.f, 0.f, 0.f};
#pragma unroll 1
            for (int pt = 0; pt < 2; ++pt) {
                const f32x2_t hin_pt = pt ? hin[1] : hin[0];
                const int pp = 32 * pt + c31;
                const bf16x8 bre = *(const bf16x8*)(BCAT + ((size_t)lg * 128 + pp) * NC + 8 * h);
                const bf16x8 bim = *(const bf16x8*)(BCAT + ((size_t)lg * 128 + 64 + pp) * NC + 8 * h);
                const f32x2_t* pw = POW + (size_t)lg * S5_NPOW * NP + pp; const f32x2_t* pi = PINV + (size_t)lg * S5_NINV * NP + pp;
                asm volatile("" : "+v"(pw), "+v"(pi));
                f32x2_t ilo[4], plo[4];
#pragma unroll
                for (int s = 0; s < 4; ++s) { ilo[s] = pi[(4 * h + s) * NP]; plo[s] = pw[(4 * h + s) * NP]; }
                const f32x2_t ia8 = pi[8 * NP], a8 = pw[8 * NP], a1 = pw[1 * NP];
                bf16x8 cfv[2];
#pragma unroll
                for (int ks = 0; ks < 2; ++ks) cfv[ks] = *(const bf16x8*)(CCAT + ((size_t)lg * NC + i16) * 128 + 64 * ks + 32 * pt + 8 * kg);
                bf16x8 wfr[2][2], wfi[2][2];
                {
                    f32x2_t f = {1.f, 0.f};
#pragma unroll
                    for (int m = 0; m < 2; ++m) {
                        f32x16 xr = MFMA32(uf[m], bre, (f32x16){}), xi = MFMA32(uf[m], bim, (f32x16){});
                        MFMA_SETTLE2(xr, xi);
#pragma unroll
                        for (int q = 0; q < 4; ++q) {
#pragma unroll
                            for (int s = 0; s < 4; ++s) { const f32x2_t x = {xr[4 * q + s], xi[4 * q + s]}; const f32x2_t w = cmul(f, cmul(ilo[s], x)); xr[4 * q + s] = w.x; xi[4 * q + s] = w.y; }
                            f = cmul(f, ia8);
                        }
#pragma unroll
                        for (int s2 = 0; s2 < 2; ++s2) {
                            wfr[m][s2] = pack8(xr[8 * s2], xr[8 * s2 + 1], xr[8 * s2 + 2], xr[8 * s2 + 3], xr[8 * s2 + 4], xr[8 * s2 + 5], xr[8 * s2 + 6], xr[8 * s2 + 7]);
                            wfi[m][s2] = pack8(xi[8 * s2], xi[8 * s2 + 1], xi[8 * s2 + 2], xi[8 * s2 + 3], xi[8 * s2 + 4], xi[8 * s2 + 5], xi[8 * s2 + 6], xi[8 * s2 + 7]);
                        }
                        __builtin_amdgcn_sched_barrier(0);
                    }
                }
                const f32x2_t G = cmul(a1, hin_pt);
                f32x2_t hlast = {0.f, 0.f};
                WAVE_LDS_SYNC();
                {
                    f32x2_t f = {1.f, 0.f};
#pragma unroll
                    for (int m = 0; m < 2; ++m) {
                        f32x16 cr, ci;
                        if (m == 0) { cr = MFMA32(tdiag[1], wfr[0][1], MFMA32(tdiag[0], wfr[0][0], (f32x16){})); ci = MFMA32(tdiag[1], wfi[0][1], MFMA32(tdiag[0], wfi[0][0], (f32x16){})); }
                        else { cr = MFMA32(tdiag[1], wfr[1][1], MFMA32(tdiag[0], wfr[1][0], MFMA32(tones, wfr[0][1], MFMA32(tones, wfr[0][0], (f32x16){}))));
                               ci = MFMA32(tdiag[1], wfi[1][1], MFMA32(tdiag[0], wfi[1][0], MFMA32(tones, wfi[0][1], MFMA32(tones, wfi[0][0], (f32x16){})))); }
                        MFMA_SETTLE2(cr, ci);
#pragma unroll
                        for (int q = 0; q < 4; ++q) {
                            float hr[4], hi[4];
#pragma unroll
                            for (int s = 0; s < 4; ++s) { const f32x2_t v = {cr[4 * q + s] + G.x, ci[4 * q + s] + G.y}; const f32x2_t w = cmul(f, cmul(plo[s], v)); hr[s] = w.x; hi[s] = w.y; }
                            if (m == 1 && q == 3) { hlast.x = hr[3]; hlast.y = hi[3]; }
                            typedef unsigned u32x2_t __attribute__((ext_vector_type(2)));
                            u32x2_t wr_; wr_.x = cvtpk(hr[0], hr[1]); wr_.y = cvtpk(hr[2], hr[3]);
                            u32x2_t wi_; wi_.x = cvtpk(hi[0], hi[1]); wi_.y = cvtpk(hi[2], hi[3]);
                            *(LAS u32x2_t*)(ht + c31 * S5_HT_STR + (32 * m + 8 * q + 4 * h) * 2) = wr_;
                            *(LAS u32x2_t*)(ht + (32 + c31) * S5_HT_STR + (32 * m + 8 * q + 4 * h) * 2) = wi_;
                            f = cmul(f, a8);
                        }
                        __builtin_amdgcn_sched_barrier(0);
                    }
                }
                { const f32x2_t hn = {halves(hlast.x).hi, halves(hlast.y).hi}; if (pt) hin[1] = hn; else hin[0] = hn; }
                WAVE_LDS_SYNC();
#pragma unroll
                for (int ks = 0; ks < 2; ++ks) {
                    const bf16x8 cf = cfv[ks];
#pragma unroll
                    for (int it = 0; it < 4; ++it) {
                        LAS const unsigned char* ap = ht + (32 * ks + 8 * kg + qq) * S5_HT_STR + (16 * it + 4 * p4) * 2;
                        const bf16x8 af = cat8(tr_read(ap), tr_read(ap + 4 * S5_HT_STR));
                        Y[it] = MFMA16(af, cf, Y[it]);
                    }
                }
            }
            asm volatile("s_nop 15\n\ts_nop 7" : "+v"(Y[0]), "+v"(Y[1]), "+v"(Y[2]), "+v"(Y[3]));
            float uu[4][4];
#pragma unroll
            for (int it = 0; it < 4; ++it)
#pragma unroll
                for (int r = 0; r < 4; ++r) uu[it][r] = bf2f(PROJ[(crow0 + 16 * it + 4 * kg + r) * IN_COLS + C_UB + 16 * g + i16]);
#pragma unroll
            for (int it = 0; it < 4; ++it)
#pragma unroll
                for (int r = 0; r < 4; ++r) {
                    bf16_t* up = PROJ + (crow0 + 16 * it + 4 * kg + r) * IN_COLS + C_UB + 16 * g + i16;
                    const float y = Y[it][r] + dd * uu[it][r];
                    if (!dry) *up = f2bf(gelu_tanh(y));
                }
        }
        if (seg == S5_NSEG - 1 && h == 0) {
#pragma unroll
            for (int pt = 0; pt < 2; ++pt) { const size_t oi = (((size_t)l * BATCH + b) * NG + g) * NP + 32 * pt + c31; p->out[O_SRP + oi] = hin[pt].x; p->out[O_SIP + oi] = hin[pt].y; }
        }
    }
}

__device__ __forceinline__ void st_s5_sample(KP p, int l, const Ctx& c, LAS unsigned char* lds, bool dry) {
    bf16_t* PROJ = (bf16_t*)(p->ws + WS_PROJ);
    const f32x2_t* POW = (const f32x2_t*)(p->ws + WS_S5POW); const f32x2_t* PINV = (const f32x2_t*)(p->ws + WS_S5PINV);
    const bf16_t* BCAT = (const bf16_t*)(p->ws + WS_S5BCAT); const bf16_t* CCAT = (const bf16_t*)(p->ws + WS_S5CCAT);
    LAS unsigned char* ht = lds + c.wave * S5_HT_BYTES;
    for (int item = c.gw; item < (DEC_BATCH / 16) * NG; item += c.ngw) {
        int zi = 0; asm volatile("" : "+v"(zi));
        const int lane = c.lane + zi, c31 = lane & 31, h = lane >> 5, i16 = lane & 15, kg = lane >> 4, qq = i16 >> 2, p4 = i16 & 3;
        const int g = item % NG, sg = item / NG, lg = l * NG + g;
        const size_t crow0 = (size_t)M_P + 64 * sg;
        bf16x8 tds[2];
#pragma unroll
        for (int s = 0; s < 2; ++s)
#pragma unroll
            for (int j = 0; j < 8; ++j) { const int kr = 16 * s + 8 * (j >> 2) + 4 * h + (j & 3); tds[s][j] = ((kr >> 2) == (c31 >> 2) && kr <= c31) ? (short)0x3F80 : (short)0; }
        const float dd = p->in[19][l * 512 + g * 16 + i16];
        bf16x8 uf[2];
#pragma unroll
        for (int m = 0; m < 2; ++m) uf[m] = *(const bf16x8*)(PROJ + (crow0 + 32 * m + c31) * IN_COLS + C_UB + 16 * g + 8 * h);
        f32x4 Y[4];
#pragma unroll
        for (int it = 0; it < 4; ++it) Y[it] = (f32x4){0.f, 0.f, 0.f, 0.f};
#pragma unroll
        for (int pt = 0; pt < 2; ++pt) {
            const int pp = 32 * pt + c31;
            const bf16x8 bre = *(const bf16x8*)(BCAT + ((size_t)lg * 128 + pp) * NC + 8 * h);
            const bf16x8 bim = *(const bf16x8*)(BCAT + ((size_t)lg * 128 + 64 + pp) * NC + 8 * h);
            const f32x2_t* pw = POW + (size_t)lg * S5_NPOW * NP + pp; const f32x2_t* pi = PINV + (size_t)lg * S5_NINV * NP + pp;
            f32x2_t ilo[4], plo[4];
#pragma unroll
            for (int s = 0; s < 4; ++s) { ilo[s] = pi[s * NP]; plo[s] = pw[s * NP]; }
            const f32x2_t a1 = pw[1 * NP];
            WAVE_LDS_SYNC();
#pragma unroll
            for (int m = 0; m < 2; ++m) {
                f32x16 xr = MFMA32(uf[m], bre, (f32x16){}), xi = MFMA32(uf[m], bim, (f32x16){});
                MFMA_SETTLE2(xr, xi);
#pragma unroll
                for (int q = 0; q < 4; ++q)
#pragma unroll
                    for (int s = 0; s < 4; ++s) { const f32x2_t x = {xr[4 * q + s], xi[4 * q + s]}; const f32x2_t w = cmul(ilo[s], x); xr[4 * q + s] = w.x; xi[4 * q + s] = w.y; }
                bf16x8 wr0 = pack8(xr[0], xr[1], xr[2], xr[3], xr[4], xr[5], xr[6], xr[7]), wr1 = pack8(xr[8], xr[9], xr[10], xr[11], xr[12], xr[13], xr[14], xr[15]);
                bf16x8 wi0 = pack8(xi[0], xi[1], xi[2], xi[3], xi[4], xi[5], xi[6], xi[7]), wi1 = pack8(xi[8], xi[9], xi[10], xi[11], xi[12], xi[13], xi[14], xi[15]);
                f32x16 cr = MFMA32(tds[1], wr1, MFMA32(tds[0], wr0, (f32x16){})), ci = MFMA32(tds[1], wi1, MFMA32(tds[0], wi0, (f32x16){}));
                MFMA_SETTLE2(cr, ci);
#pragma unroll
                for (int q = 0; q < 4; ++q) {
                    const int seq = 16 * sg + 8 * m + 2 * q + h;
                    const size_t si = (((size_t)l * DEC_BATCH + seq) * NG + g) * NP + pp;
                    const f32x2_t G = cmul(a1, (f32x2_t){p->in[4][si], p->in[5][si]});
                    float hr[4], hi[4];
#pragma unroll
                    for (int s = 0; s < 4; ++s) { const f32x2_t v = {cr[4 * q + s] + G.x, ci[4 * q + s] + G.y}; const f32x2_t w = cmul(plo[s], v); hr[s] = w.x; hi[s] = w.y; }
                    p->out[O_SRS + si] = hr[3]; p->out[O_SIS + si] = hi[3];
                    typedef unsigned u32x2_t __attribute__((ext_vector_type(2)));
                    u32x2_t wr_; wr_.x = cvtpk(hr[0], hr[1]); wr_.y = cvtpk(hr[2], hr[3]);
                    u32x2_t wi_; wi_.x = cvtpk(hi[0], hi[1]); wi_.y = cvtpk(hi[2], hi[3]);
                    *(LAS u32x2_t*)(ht + c31 * S5_HT_STR + (32 * m + 8 * q + 4 * h) * 2) = wr_;
                    *(LAS u32x2_t*)(ht + (32 + c31) * S5_HT_STR + (32 * m + 8 * q + 4 * h) * 2) = wi_;
                }
                __builtin_amdgcn_sched_barrier(0);
            }
            WAVE_LDS_SYNC();
#pragma unroll
            for (int ks = 0; ks < 2; ++ks) {
                const bf16x8 cf = *(const bf16x8*)(CCAT + ((size_t)lg * NC + i16) * 128 + 64 * ks + 32 * pt + 8 * kg);
#pragma unroll
                for (int it = 0; it < 4; ++it) {
                    LAS const unsigned char* ap = ht + (32 * ks + 8 * kg + qq) * S5_HT_STR + (16 * it + 4 * p4) * 2;
                    const bf16x8 af = cat8(tr_read(ap), tr_read(ap + 4 * S5_HT_STR));
                    Y[it] = MFMA16(af, cf, Y[it]);
                }
            }
        }
        asm volatile("s_nop 15\n\ts_nop 7" : "+v"(Y[0]), "+v"(Y[1]), "+v"(Y[2]), "+v"(Y[3]));
        float uu[4][4];
#pragma unroll
        for (int it = 0; it < 4; ++it)
#pragma unroll
            for (int r = 0; r < 4; ++r) uu[it][r] = bf2f(PROJ[(crow0 + 16 * it + 4 * kg + r) * IN_COLS + C_UB + 16 * g + i16]);
#pragma unroll
        for (int it = 0; it < 4; ++it)
#pragma unroll
            for (int r = 0; r < 4; ++r) {
                bf16_t* up = PROJ + (crow0 + 16 * it + 4 * kg + r) * IN_COLS + C_UB + 16 * g + i16;
                const float y = Y[it][r] + dd * uu[it][r];
                if (!dry) *up = f2bf(gelu_tanh(y));
            }
    }
}

__device__ __forceinline__ void st_lru_sample(KP p, int l, const Ctx& c, LAS unsigned char* lds, bool dry) {
    bf16_t* PROJ = (bf16_t*)(p->ws + WS_PROJ);
    const bf16_t* LRUW = (const bf16_t*)(p->ws + WS_LRUW);
    for (int item = c.gw; item < (DEC_BATCH / 16) * 8; item += c.ngw) {
        int zi = 0; asm volatile("" : "+v"(zi));
        const int lane = c.lane + zi, c31 = lane & 31, h = lane >> 5;
        const int n = item & 7, sg = item >> 3;
        const size_t row0 = (size_t)M_P + 64 * sg;
        const int ch0 = n * 64;
        LAS unsigned char* xim = lds + c.wave * 9216;
        WAVE_LDS_SYNC();
#pragma unroll 1
        for (int ks = 0; ks < 4; ++ks) {
            const int chb = ch0 + 16 * ks + 8 * h;
            float w[4][8], cb[8];
#pragma unroll
            for (int j = 0; j < 4; ++j) {
                const f32x4 w0 = *(const f32x4*)(p->in[22] + (l * 4 + j) * 512 + chb), w1 = *(const f32x4*)(p->in[22] + (l * 4 + j) * 512 + chb + 4);
                w[j][0] = w0[0]; w[j][1] = w0[1]; w[j][2] = w0[2]; w[j][3] = w0[3]; w[j][4] = w1[0]; w[j][5] = w1[1]; w[j][6] = w1[2]; w[j][7] = w1[3];
            }
            { const f32x4 b0 = *(const f32x4*)(p->in[23] + l * 512 + chb), b1 = *(const f32x4*)(p->in[23] + l * 512 + chb + 4);
              cb[0] = b0[0]; cb[1] = b0[1]; cb[2] = b0[2]; cb[3] = b0[3]; cb[4] = b1[0]; cb[5] = b1[1]; cb[6] = b1[2]; cb[7] = b1[3]; }
#pragma unroll
            for (int m = 0; m < 2; ++m) {
                const int i = 32 * m + c31, t = i & 3, seq = 16 * sg + (i >> 2);
                float xf[8];
#pragma unroll
                for (int e = 0; e < 8; ++e) xf[e] = cb[e];
#pragma unroll
                for (int j = 0; j < 4; ++j) {
                    const int tau = t - 3 + j;
                    float xv[8];
                    if (tau >= 0) {
                        const u32x4 xx = *(const u32x4*)(PROJ + ((size_t)M_P + 4 * seq + tau) * IN_COLS + C_XC + chb);
#pragma unroll
                        for (int e = 0; e < 4; ++e) { xv[2 * e] = __uint_as_float(xx[e] << 16); xv[2 * e + 1] = __uint_as_float(xx[e] & 0xffff0000u); }
                    } else {
                        const float* cp = p->in[7] + (((size_t)l * DEC_BATCH + seq) * 3 + (3 + tau)) * 512 + chb;
                        const f32x4 c0 = *(const f32x4*)cp, c1 = *(const f32x4*)(cp + 4);
                        xv[0] = c0[0]; xv[1] = c0[1]; xv[2] = c0[2]; xv[3] = c0[3]; xv[4] = c1[0]; xv[5] = c1[1]; xv[6] = c1[2]; xv[7] = c1[3];
                    }
#pragma unroll
                    for (int e = 0; e < 8; ++e) xf[e] += w[j][e] * xv[e];
                }
                *(LAS bf16x8*)(xim + (32 * m + c31) * 144 + (16 * ks + 8 * h) * 2) = pack8(xf[0], xf[1], xf[2], xf[3], xf[4], xf[5], xf[6], xf[7]);
            }
        }
        WAVE_LDS_SYNC();
#pragma unroll 1
        for (int et = 0; et < 2; ++et) {
            const int ch = ch0 + 32 * et + c31;
            const float ba = p->in[25][l * 512 + ch], bx = p->in[27][l * 512 + ch];
            const float lsig8 = ((const float*)(p->ws + WS_LSIG))[l * 512 + ch];
            const bf16_t* wp = LRUW + (((size_t)(l * 8 + n) * 2) * 64 + 32 * et + c31) * 64 + 8 * h;
#pragma unroll
            for (int m = 0; m < 2; ++m) {
                f32x16 X = (f32x16){}, R = (f32x16){}, I = (f32x16){};
#pragma unroll
                for (int ks = 0; ks < 4; ++ks) {
                    const bf16x8 wa = *(const bf16x8*)(wp + 16 * ks), wx = *(const bf16x8*)(wp + 64 * 64 + 16 * ks);
                    bf16x8 id;
#pragma unroll
                    for (int j = 0; j < 8; ++j) id[j] = (16 * ks + 8 * h + j == 32 * et + c31) ? (short)0x3F80 : (short)0;
                    const bf16x8 afr = *(LAS const bf16x8*)(xim + (32 * m + c31) * 144 + (16 * ks + 8 * h) * 2);
                    R = MFMA32(afr, wa, R); I = MFMA32(afr, wx, I); X = MFMA32(afr, id, X);
                }
                MFMA_SETTLE3(R, I, X);
                float gcv[16], h0v[4];
#pragma unroll
                for (int q = 0; q < 4; ++q) {
                    const int seq = 16 * sg + 8 * m + 2 * q + h;
                    h0v[q] = p->in[6][((size_t)l * DEC_BATCH + seq) * 512 + ch];
#pragma unroll
                    for (int s = 0; s < 4; ++s) gcv[4 * q + s] = bf2f(PROJ[((size_t)M_P + 4 * seq + s) * IN_COLS + C_GC + ch]);
                }
#pragma unroll
                for (int q = 0; q < 4; ++q) {
                    const int seq = 16 * sg + 8 * m + 2 * q + h;
                    float hv = h0v[q];
#pragma unroll
                    for (int s = 0; s < 4; ++s) {
                        const int r = 4 * q + s;
                        const float rg = sigmoidf_(R[r] + ba), ig = sigmoidf_(I[r] + bx);
                        const float la = rg * lsig8;
                        const float a = __expf(la);
                        const float bg = X[r] * ig * __builtin_amdgcn_sqrtf((1.0f - a) * (1.0f + a));
                        hv = a * hv + bg;
                        bf16_t* gp = PROJ + ((size_t)M_P + 4 * seq + s) * IN_COLS + C_GC + ch;
                        const float gc = gcv[r];
                        if (!dry) *gp = f2bf(hv * siluf_(gc));
                    }
                    p->out[O_LS + ((size_t)l * DEC_BATCH + seq) * 512 + ch] = hv;
                }
                __builtin_amdgcn_sched_barrier(0);
            }
        }
    }
}

__device__ __forceinline__ void st_attn_sample(KP p, int l, LAS unsigned char* lds, bool dry, int wave_s) {
    int zv = 0; asm volatile("" : "+v"(zv));
    const int tid = tid_of(wave_s, zv), lane = tid & 63, wave = __builtin_amdgcn_readfirstlane(tid >> 6);
    const int c31 = lane & 31, h = lane >> 5;
    bf16_t* PROJ = (bf16_t*)(p->ws + WS_PROJ);
    const float* rel_bias = p->in[8];
    for (int item = blockIdx.x; item < DEC_BATCH * NKV; item += gridDim.x) {
        const int b = item >> 1, kvh = item & 1;
#pragma unroll
        for (int i = 0; i < 3; ++i) {
            const int id = tid + 512 * i, row = id >> 3, pc = id & 7;
            if (id < 160 * 8) {
                u32x4 kk = (u32x4){0u, 0u, 0u, 0u}, vv = kk;
                if (row < WINDOW) {
                    const size_t ci = ((((size_t)l * DEC_BATCH + b) * WINDOW + row) * NKV + kvh) * HD + pc * 8;
                    const f32x4 k0 = *(const f32x4*)(p->in[2] + ci), k1 = *(const f32x4*)(p->in[2] + ci + 4), v0 = *(const f32x4*)(p->in[3] + ci), v1 = *(const f32x4*)(p->in[3] + ci + 4);
                    kk.x = cvtpk(k0[0], k0[1]); kk.y = cvtpk(k0[2], k0[3]); kk.z = cvtpk(k1[0], k1[1]); kk.w = cvtpk(k1[2], k1[3]);
                    vv.x = cvtpk(v0[0], v0[1]); vv.y = cvtpk(v0[2], v0[3]); vv.z = cvtpk(v1[0], v1[1]); vv.w = cvtpk(v1[2], v1[3]);
                } else if (row < WINDOW + DEC_SEQ) {
                    const bf16_t* src = PROJ + ((size_t)M_P + 4 * b + (row - WINDOW)) * IN_COLS + kvh * 64 + pc * 8;
                    kk = *(const u32x4*)(src + C_K); vv = *(const u32x4*)(src + C_V);
                }
                *(LAS u32x4*)(lds + AT_K + row * AT_KSTR + pc * 16) = kk;
                *(LAS u32x4*)(lds + AT_V + row * AT_VSTR + pc * 16) = vv;
            }
        }
        { const int g = tid >> 7, d = tid & 127; ((LAS float*)(lds + AT_BIAS))[tid] = rel_bias[T5_BUCKET[d] * NQH + kvh * 4 + g]; }
        __syncthreads();
        if (wave == 0) {
            const int qc = c31 & 15, g = qc >> 2, iq = qc & 3, hq = kvh * 4 + g;
            const float sink = p->in[10][l * NQH + hq];
            LAS const float* biasd = (LAS const float*)(lds + AT_BIAS) + g * 128;
            LAS float* wsf = (LAS float*)(lds + AT_WS);
            bf16x8 qf[4];
            { const bf16_t* qp = PROJ + ((size_t)M_P + 4 * b + iq) * IN_COLS + C_Q + hq * 64 + 8 * h;
#pragma unroll
              for (int ks = 0; ks < 4; ++ks) qf[ks] = *(const bf16x8*)(qp + 16 * ks); }
            f32x16 S[5];
#pragma unroll
            for (int j = 0; j < 5; ++j) {
                S[j] = (f32x16){};
                LAS const unsigned char* kp = lds + AT_K + (32 * j + c31) * AT_KSTR + 16 * h;
#pragma unroll
                for (int ks = 0; ks < 4; ++ks) S[j] = MFMA32(*(LAS const bf16x8*)(kp + 32 * ks), qf[ks], S[j]);
            }
            asm volatile("s_nop 15\n\ts_nop 7" : "+v"(S[0]), "+v"(S[1]), "+v"(S[2]), "+v"(S[3]), "+v"(S[4]));
            float mx = sink;
#pragma unroll
            for (int j = 0; j < 5; ++j)
#pragma unroll
                for (int r = 0; r < 16; ++r) {
                    const int kv = 32 * j + (r & 3) + 8 * (r >> 2) + 4 * h;
                    const int dist = iq + 128 - kv;
                    const bool ok = (dist >= 0) && (dist < 128);
                    const float s = ok ? S[j][r] * 0.125f + biasd[dist & 127] : -1e30f;
                    S[j][r] = s; mx = fmaxf(mx, s);
                }
            { const Halves hh = halves(mx); mx = fmaxf(hh.lo, hh.hi); }
            float sum = 0.f;
#pragma unroll
            for (int j = 0; j < 5; ++j)
#pragma unroll
                for (int r = 0; r < 16; ++r) { const float e = S[j][r] > -1e29f ? __expf(S[j][r] - mx) : 0.f; S[j][r] = e; sum += e; }
            { const Halves hh = halves(sum); sum = hh.lo + hh.hi; }
            const float rden = 1.0f / (sum + __expf(sink - mx));
            if (h == 0) wsf[c31] = rden;
            f32x16 O[2]; O[0] = (f32x16){}; O[1] = (f32x16){};
            const int i16 = lane & 15, qq = i16 >> 2, pp = i16 & 3, blk = (lane >> 4) & 1;
#pragma unroll
            for (int j = 0; j < 5; ++j)
#pragma unroll
                for (int s = 0; s < 2; ++s) {
                    const bf16x8 pf = pack8(S[j][8 * s], S[j][8 * s + 1], S[j][8 * s + 2], S[j][8 * s + 3], S[j][8 * s + 4], S[j][8 * s + 5], S[j][8 * s + 6], S[j][8 * s + 7]);
                    LAS const unsigned char* vp = lds + AT_V + (32 * j + 16 * s + 4 * h + qq) * AT_VSTR + (16 * blk + 4 * pp) * 2;
#pragma unroll
                    for (int dt = 0; dt < 2; ++dt) {
                        const bf16x8 vf = cat8(tr_read(vp + dt * 64), tr_read(vp + dt * 64 + 8 * AT_VSTR));
                        O[dt] = MFMA32(pf, vf, O[dt]);
                    }
                }
            MFMA_SETTLE2(O[0], O[1]);
            WAVE_LDS_SYNC();
            float gav[8][2];
#pragma unroll
            for (int r = 0; r < 8; ++r) {
                const int qr = (r & 3) + 8 * (r >> 2) + 4 * h, g2 = qr >> 2, i2 = qr & 3;
                const bf16_t* rowp = PROJ + ((size_t)M_P + 4 * b + i2) * IN_COLS + (kvh * 4 + g2) * 64 + c31;
                gav[r][0] = bf2f(rowp[C_GA]); gav[r][1] = bf2f(rowp[C_GA + 32]);
            }
#pragma unroll
            for (int r = 0; r < 8; ++r) {
                const int qr = (r & 3) + 8 * (r >> 2) + 4 * h, g2 = qr >> 2, i2 = qr & 3;
                const float rd = wsf[qr];
                bf16_t* rowp = PROJ + ((size_t)M_P + 4 * b + i2) * IN_COLS + (kvh * 4 + g2) * 64 + c31;
#pragma unroll
                for (int dt = 0; dt < 2; ++dt) if (!dry) rowp[C_Q + 32 * dt] = f2bf(O[dt][r] * rd * siluf_(gav[r][dt]));
            }
        }
        __syncthreads();
    }
}

constexpr int LR_NSEG = 32;
template <bool PHASE_B>
__device__ __forceinline__ void st_lru_mfma(KP p, int l, const Ctx& c, LAS unsigned char* lds, bool dry) {
    bf16_t* PROJ = (bf16_t*)(p->ws + WS_PROJ);
    const bf16_t* LRUW = (const bf16_t*)(p->ws + WS_LRUW);
    f32x2_t* LSUM = (f32x2_t*)(p->ws + WS_LRSUM);
    for (int item = c.gw; item < BATCH * LR_NSEG * 8; item += c.ngw) {
        int zi = 0; asm volatile("" : "+v"(zi));
        const int lane = c.lane + zi, c31 = lane & 31, h = lane >> 5;
        const int n = item & 7, seg = (item >> 3) % LR_NSEG, b = item / (8 * LR_NSEG);
        const size_t row0 = (size_t)b * SEQ + (size_t)seg * 64;
        const int ch0 = n * 64;
        LAS unsigned char* xim = lds + c.wave * 9216;
        WAVE_LDS_SYNC();
#pragma unroll 2
        for (int ks = 0; ks < 4; ++ks) {
            const int chb = ch0 + 16 * ks + 8 * h;
            float w[4][8], cb[8];
#pragma unroll
            for (int j = 0; j < 4; ++j) {
                const f32x4 w0 = *(const f32x4*)(p->in[22] + (l * 4 + j) * 512 + chb), w1 = *(const f32x4*)(p->in[22] + (l * 4 + j) * 512 + chb + 4);
                w[j][0] = w0[0]; w[j][1] = w0[1]; w[j][2] = w0[2]; w[j][3] = w0[3]; w[j][4] = w1[0]; w[j][5] = w1[1]; w[j][6] = w1[2]; w[j][7] = w1[3];
            }
            { const f32x4 b0 = *(const f32x4*)(p->in[23] + l * 512 + chb), b1 = *(const f32x4*)(p->in[23] + l * 512 + chb + 4);
              cb[0] = b0[0]; cb[1] = b0[1]; cb[2] = b0[2]; cb[3] = b0[3]; cb[4] = b1[0]; cb[5] = b1[1]; cb[6] = b1[2]; cb[7] = b1[3]; }
            u32x4 xx4[2][4];
#pragma unroll
            for (int m = 0; m < 2; ++m)
#pragma unroll
                for (int j = 0; j < 4; ++j) { const int t = seg * 64 + 32 * m + c31; const int dr = (t - 3 + j >= 0) ? (32 * m + c31 - 3 + j) : 0; xx4[m][j] = *(const u32x4*)(PROJ + (row0 + dr) * IN_COLS + C_XC + chb); }
#pragma unroll
            for (int m = 0; m < 2; ++m) {
                const int t = seg * 64 + 32 * m + c31;
                float xf[8];
#pragma unroll
                for (int e = 0; e < 8; ++e) xf[e] = cb[e];
#pragma unroll
                for (int j = 0; j < 4; ++j) {
                    const u32x4 xx = (t - 3 + j >= 0) ? xx4[m][j] : (u32x4){0u, 0u, 0u, 0u};
#pragma unroll
                    for (int e = 0; e < 4; ++e) { xf[2 * e] += w[j][2 * e] * __uint_as_float(xx[e] << 16); xf[2 * e + 1] += w[j][2 * e + 1] * __uint_as_float(xx[e] & 0xffff0000u); }
                }
                *(LAS bf16x8*)(xim + (32 * m + c31) * 144 + (16 * ks + 8 * h) * 2) = pack8(xf[0], xf[1], xf[2], xf[3], xf[4], xf[5], xf[6], xf[7]);
            }
        }
        WAVE_LDS_SYNC();
#pragma unroll 1
        for (int et = 0; et < 2; ++et) {
            const int ch = ch0 + 32 * et + c31;
            const float ba = p->in[25][l * 512 + ch], bx = p->in[27][l * 512 + ch];
            const float lsig8 = ((const float*)(p->ws + WS_LSIG))[l * 512 + ch];
            const bf16_t* wp = LRUW + (((size_t)(l * 8 + n) * 2) * 64 + 32 * et + c31) * 64 + 8 * h;
            f32x16 R[2], I[2];
            float Ar[8], Br[8];
            __builtin_amdgcn_sched_barrier(0);
            bf16x8 waf[4], wxf[4];
#pragma unroll
            for (int ks = 0; ks < 4; ++ks) { waf[ks] = *(const bf16x8*)(wp + 16 * ks); wxf[ks] = *(const bf16x8*)(wp + 64 * 64 + 16 * ks); }
#pragma unroll
            for (int m = 0; m < 2; ++m) {
                f32x16 X = (f32x16){}; R[m] = (f32x16){}; I[m] = (f32x16){};
#pragma unroll
                for (int ks = 0; ks < 4; ++ks) {
                    bf16x8 id;
#pragma unroll
                    for (int j = 0; j < 8; ++j) id[j] = (16 * ks + 8 * h + j == 32 * et + c31) ? (short)0x3F80 : (short)0;
                    const bf16x8 afr = *(LAS const bf16x8*)(xim + (32 * m + c31) * 144 + (16 * ks + 8 * h) * 2);
                    R[m] = MFMA32(afr, waf[ks], R[m]); I[m] = MFMA32(afr, wxf[ks], I[m]); X = MFMA32(afr, id, X);
                }
                MFMA_SETTLE3(R[m], I[m], X);
#pragma unroll
                for (int q = 0; q < 4; ++q) {
                    float cp = 1.f, hl = 0.f;
#pragma unroll
                    for (int s = 0; s < 4; ++s) {
                        const int r = 4 * q + s;
                        const float rg = sigmoidf_(R[m][r] + ba), ig = sigmoidf_(I[m][r] + bx);
                        const float la = rg * lsig8;
                        const float a = __expf(la);
                        const float bg = X[r] * ig * __builtin_amdgcn_sqrtf((1.0f - a) * (1.0f + a));
                        cp *= a; hl = a * hl + bg;
                        R[m][r] = cp; I[m][r] = hl;
                    }
                    Ar[4 * m + q] = cp; Br[4 * m + q] = hl;
                }
                __builtin_amdgcn_sched_barrier(0);
            }
            float Hc = 0.f;
            if (PHASE_B) {
                for (int k0 = 0; k0 < seg; k0 += 16) {
                    f32x2_t ab[16];
#pragma unroll
                    for (int j = 0; j < 16; ++j) ab[j] = (k0 + j < seg) ? LSUM[((size_t)b * LR_NSEG + k0 + j) * 512 + ch] : (f32x2_t){1.f, 0.f};
#pragma unroll
                    for (int j = 0; j < 16; ++j) Hc = ab[j].x * Hc + ab[j].y;
                }
            }
            float st = Hc, At = 1.f, cin[8];
#pragma unroll
            for (int gi = 0; gi < 8; ++gi) {
                const Halves ha = halves(Ar[gi]), hb = halves(Br[gi]);
                const float A0 = ha.lo, B0 = hb.lo, A1 = ha.hi, B1 = hb.hi;
                const float s1 = A0 * st + B0;
                cin[gi] = h == 0 ? st : s1;
                st = A1 * s1 + B1; At *= A0 * A1;
            }
            if (!PHASE_B) {
                if (h == 0) LSUM[((size_t)b * LR_NSEG + seg) * 512 + ch] = (f32x2_t){At, st};
            } else {
#pragma unroll
                for (int m = 0; m < 2; ++m) {
                    float gcv[16];
#pragma unroll
                    for (int r = 0; r < 16; ++r) gcv[r] = bf2f(PROJ[(row0 + 32 * m + (r & 3) + 8 * (r >> 2) + 4 * h) * IN_COLS + C_GC + ch]);
#pragma unroll
                    for (int r = 0; r < 16; ++r) {
                        const float hv = I[m][r] + R[m][r] * cin[4 * m + (r >> 2)];
                        bf16_t* gp = PROJ + (row0 + 32 * m + (r & 3) + 8 * (r >> 2) + 4 * h) * IN_COLS + C_GC + ch;
                        const float gc = gcv[r];
                        if (!dry) *gp = f2bf(hv * siluf_(gc));
                        if (m == 1 && r == 15 && h == 1 && seg == LR_NSEG - 1) p->out[O_LP + ((size_t)l * BATCH + b) * 512 + ch] = hv;
                    }
                }
            }
        }
    }
}

__device__ __forceinline__ bf16_t* pre_row(unsigned char* ws, int r) { return (bf16_t*)(ws + WS_PROJ + (size_t)r * IN_COLS * 2 + (size_t)(C_GM + 1024) * 2); }
__device__ __forceinline__ void st_ln(KP p, int l, const Ctx& c) {
    const int lane = c.lane;
    const float* g = p->in[31] + l * 1024; const float* bb = p->in[32] + l * 1024;
    f32x4 gv[4], bv[4];
#pragma unroll
    for (int j = 0; j < 4; ++j) { const int cc = 512 * (j >> 1) + 8 * lane + 4 * (j & 1); gv[j] = *(const f32x4*)(g + cc); bv[j] = *(const f32x4*)(bb + cc); }
    constexpr int NR = 4;
    u32x4 cur[NR][2], nxt[NR][2];
#define LN_LOAD(dst, rb) do { _Pragma("unroll") for (int k = 0; k < NR; ++k) { const int r_ = (rb) + k < M_TOT ? (rb) + k : M_TOT - 1; const bf16_t* pr = pre_row(p->ws, r_); \
        dst[k][0] = *(const u32x4*)(pr + 8 * lane); dst[k][1] = *(const u32x4*)(pr + 512 + 8 * lane); } } while (0)
    int r0 = c.gw * NR;
    if (r0 < M_TOT) LN_LOAD(cur, r0);
    for (; r0 < M_TOT; r0 += c.ngw * NR) {
        const int rn = r0 + c.ngw * NR;
        if (rn < M_TOT) LN_LOAD(nxt, rn);
#pragma unroll
        for (int k = 0; k < NR; ++k) {
            const int r = r0 + k;
            f32x4 v[4];
#pragma unroll
            for (int q = 0; q < 2; ++q) { const u32x4 w = cur[k][q]; v[2 * q] = (f32x4){pg8::bflo(w.x), pg8::bfhi(w.x), pg8::bflo(w.y), pg8::bfhi(w.y)}; v[2 * q + 1] = (f32x4){pg8::bflo(w.z), pg8::bfhi(w.z), pg8::bflo(w.w), pg8::bfhi(w.w)}; }
            float s = 0.f;
#pragma unroll
            for (int j = 0; j < 4; ++j) s += (v[j][0] + v[j][1]) + (v[j][2] + v[j][3]);
            s = wave_sum(s);
            const float mu = s * (1.0f / 1024.0f);
            float q2 = 0.f;
#pragma unroll
            for (int j = 0; j < 4; ++j) { const f32x4 d = v[j] - mu; q2 += (d[0] * d[0] + d[1] * d[1]) + (d[2] * d[2] + d[3] * d[3]); }
            q2 = wave_sum(q2);
            const float rstd = rsqrtf(q2 * (1.0f / 1024.0f) + LN_EPS);
            if (r < M_TOT) {
#pragma unroll
                for (int q = 0; q < 2; ++q) {
                    const f32x4 y0 = (v[2 * q] - mu) * rstd * gv[2 * q] + bv[2 * q], y1 = (v[2 * q + 1] - mu) * rstd * gv[2 * q + 1] + bv[2 * q + 1];
                    const int cc = 512 * q + 8 * lane;
                    if (l == 0) { u32x4 o; o.x = cvtpk(y0[0], y0[1]); o.y = cvtpk(y0[2], y0[3]); o.z = cvtpk(y1[0], y1[1]); o.w = cvtpk(y1[2], y1[3]);
                                  *(u32x4*)((bf16_t*)(p->ws + WS_XB) + (size_t)r * D_MODEL + cc) = o; }
                    else { float* yo = (r < M_P ? p->out + O_YP + (size_t)r * D_MODEL : p->out + O_YS + (size_t)(r - M_P) * D_MODEL) + cc; *(f32x4*)yo = y0; *(f32x4*)(yo + 4) = y1; }
                }
            }
        }
#pragma unroll
        for (int k = 0; k < NR; ++k) { cur[k][0] = nxt[k][0]; cur[k][1] = nxt[k][1]; }
    }
#undef LN_LOAD
}

template <int NBR, int NS  , class Epi>
__device__ __forceinline__ void piece_gemm(LAS unsigned char* lds, const bf16_t* A0, const bf16_t* A1, const bf16_t* A2, int lda, const bf16_t* Bt, int ldb, int kboff, int row0, int col0, const Epi& epi, int wave_s) {
    int zv = 0; asm volatile("" : "+v"(zv));
    const int tid = tid_of(wave_s, zv), lane = tid & 63, wave = __builtin_amdgcn_readfirstlane(tid >> 6), c31 = lane & 31, h = lane >> 5;
    LAS float* part = (LAS float*)lds;
    float outv[NBR][4];
    constexpr int kw = 16 * NS;
    bf16x8 a[NBR][NS], b0[NBR][NS], b1[NBR][NS];
#pragma unroll
    for (int br = 0; br < NBR; ++br) {
        const bf16_t* A = br == 0 ? A0 : (br == 1 ? A1 : A2);
        const bf16_t* ap = A + (size_t)(row0 + c31) * lda + wave * kw + 8 * h;
        const bf16_t* bp = Bt + (size_t)(col0 + c31) * ldb + br * kboff + wave * kw + 8 * h;
#pragma unroll
        for (int s = 0; s < NS; ++s) { a[br][s] = *(const bf16x8*)(ap + 16 * s); b0[br][s] = *(const bf16x8*)(bp + 16 * s); b1[br][s] = *(const bf16x8*)(bp + (size_t)32 * ldb + 16 * s); }
    }
    typename Epi::Pre pre[4];
#pragma unroll
    for (int e = 0; e < 4; ++e) {
        const int idx = tid + 512 * e, nt = idx >> 10, r = (idx >> 6) & 15, ln = idx & 63;
        pre[e] = epi.load(row0 + (r & 3) + 8 * (r >> 2) + 4 * (ln >> 5), col0 + 32 * nt + (ln & 31));
    }
    __builtin_amdgcn_sched_barrier(0);
#pragma unroll
    for (int br = 0; br < NBR; ++br) {
        f32x16 acc0 = (f32x16){}, acc1 = (f32x16){};
#pragma unroll
        for (int s = 0; s < NS; ++s) { acc0 = MFMA32(a[br][s], b0[br][s], acc0); acc1 = MFMA32(a[br][s], b1[br][s], acc1); }
        MFMA_SETTLE2(acc0, acc1);
        __syncthreads();
#pragma unroll
        for (int r = 0; r < 16; ++r) { part[((wave * 2 + 0) * 16 + r) * 64 + lane] = acc0[r]; part[((wave * 2 + 1) * 16 + r) * 64 + lane] = acc1[r]; }
        __syncthreads();
#pragma unroll
        for (int e = 0; e < 4; ++e) {
            const int idx = tid + 512 * e;
            float s = 0.f;
#pragma unroll
            for (int w = 0; w < 8; ++w) s += part[w * 2048 + idx];
            outv[br][e] = s;
        }
    }
#pragma unroll
    for (int e = 0; e < 4; ++e) {
        const int idx = tid + 512 * e, nt = idx >> 10, r = (idx >> 6) & 15, ln = idx & 63;
        const int row = row0 + (r & 3) + 8 * (r >> 2) + 4 * (ln >> 5), col = col0 + 32 * nt + (ln & 31);
        float v[NBR];
#pragma unroll
        for (int br = 0; br < NBR; ++br) v[br] = outv[br][e];
        epi.store(row, col, pre[e], v);
    }
    __syncthreads();
}
struct PEpiGlu { bf16_t* PROJ; bool dry; struct Pre { bf16_t z, g; };
    __device__ __forceinline__ Pre load(int r, int c) const { const bf16_t* rp = PROJ + (size_t)r * IN_COLS; return Pre{rp[C_UB + c], rp[C_GB + c]}; }
    __device__ __forceinline__ void store(int r, int c, const Pre& q, const float (&v)[1]) const {
        if (!dry) PROJ[(size_t)r * IN_COLS + C_GB + c] = f2bf(bf2f(q.z) * sigmoidf_(v[0]) * siluf_(bf2f(q.g))); } };
struct PEpiBranch { bf16_t* PROJ; bool dry; struct Pre { bf16_t g0, g1, g2; };
    __device__ __forceinline__ Pre load(int r, int c) const { const bf16_t* gp = PROJ + (size_t)r * IN_COLS + C_GM + c; return Pre{gp[0], gp[1024], gp[2048]}; }
    __device__ __forceinline__ void store(int r, int c, const Pre& q, const float (&v)[3]) const {
        const float m = __builtin_amdgcn_rcpf(bf2f(q.g0)) * v[0] + __builtin_amdgcn_rcpf(bf2f(q.g1)) * v[1] + __builtin_amdgcn_rcpf(bf2f(q.g2)) * v[2];
        if (!dry) PROJ[(size_t)r * IN_COLS + C_GM + c] = f2bf(m); } };
struct PEpiOut { KP p; int l; struct Pre { float x; };
    __device__ __forceinline__ Pre load(int r, int c) const {
        return Pre{bf2f(((const bf16_t*)(p->ws + WS_XB))[(size_t)r * D_MODEL + c])}; }
    __device__ __forceinline__ void store(int r, int c, const Pre& q, const float (&v)[1]) const { pre_row(p->ws, r)[c] = f2bf(DN_ALPHA * q.x + v[0]); } };

#ifndef TSEL
#define TSEL 0
#endif
#define TS_BEGIN(K) do { if (TSEL == (K) && blockIdx.x == 0 && wave_s == 0 && lane_id() == 0) *(volatile LAS unsigned long long*)(lds + LDS_MISC + 128) = __builtin_amdgcn_s_memrealtime(); } while (0)
#define TS_END(K) do { if (TSEL == (K) && blockIdx.x == 0 && wave_s == 0 && lane_id() == 0) *(volatile LAS unsigned long long*)(lds + LDS_MISC + 136) += __builtin_amdgcn_s_memrealtime() - *(volatile LAS unsigned long long*)(lds + LDS_MISC + 128); } while (0)
__global__ void __launch_bounds__(NTHREADS, 2) mega_fwd(P p_unused) {
    extern __shared__ __attribute__((aligned(16))) unsigned char lds_raw[];
    LAS unsigned char* lds = (LAS unsigned char*)lds_raw;
    volatile LAS unsigned* misc = (volatile LAS unsigned*)(lds + LDS_MISC);
    const int wave_s = __builtin_amdgcn_readfirstlane((int)threadIdx.x >> 6);
    if (wave_s == 0) misc[lane_id()] = 0u;
    __syncthreads();
    XcdBarrier bar;
    { KP p = get_kp(); bar = xcd_barrier_post((unsigned*)(p->ws + WS_CTL), misc, wave_s); }
    TS_BEGIN(100);

    { KP p = get_kp(); const Ctx c = make_ctx(wave_s); unsigned char* dob = (unsigned char*)p->out;
      st_convert_x(p, c);
      st_prologue_weights(p, c, (LAS float*)(lds + c.wave * 9216), 0, 16 * 200);
      st_s5_tables2(p, c);
      for (size_t i = c.gt; i < (size_t)DEPTH * 512; i += c.ngt) ((float*)(p->ws + WS_LSIG))[i] = -8.0f * log1pf(expf(-p->in[28][i]));
      { bf16_t* LRUW = (bf16_t*)(p->ws + WS_LRUW);
        for (size_t i = c.gt; i < (size_t)DEPTH * 8 * 2 * 64 * 64; i += c.ngt) {
            const int d = (int)(i & 63), e = (int)((i >> 6) & 63), mat = (int)((i >> 12) & 1), ln = (int)(i >> 13);
            LRUW[i] = f2bf(p->in[mat ? 26 : 24][((size_t)ln * 64 + d) * 64 + e]); } } }
    xcd_barrier(bar);
    TS_END(100);

#ifndef PROBE
#define PROBE 0
#endif
#define PROBE_RUN(K, BODY) do { if (PROBE == (K)) { int d_ = 1; asm volatile("" : "+s"(d_)); const bool dry = d_ != 0; BODY; __syncthreads(); } { const bool dry = false; BODY; } } while (0)
#define PH_P1 { KP p = get_kp(); int zs = 0; asm volatile("" : "+s"(zs)); (void)dry; \
          pg8::Gemm g{(const bf16_t*)(p->ws + WS_XB), D_MODEL, (const bf16_t*)((unsigned char*)p->out + DO_WIN) + (size_t)l * IN_COLS * 1024, 1024}; \
          pg8::StaticOrder S; S.init(M_TOT, IN_COLS, (int)gridDim.x + zs, (int)blockIdx.x + zs); \
          pg8::gemm_phase<pg8::EpiProjB, pg8::StaticOrder, true, true>(lds, g, S, pg8::EpiProjB{(bf16_t*)(p->ws + WS_PROJ), IN_COLS}, wave_s); \
          if (l == 0) {   \
              const int nb_ = (int)gridDim.x + zs, bid_ = (int)blockIdx.x + zs, short_ = ((M_TOT / 256) * (IN_COLS / 256)) % nb_; \
              if (short_ == 0 || bid_ >= short_) { const Ctx c = make_ctx(wave_s); Ctx gq = c; const int sz_ = short_ == 0 ? nb_ : nb_ - short_, rk_ = short_ == 0 ? bid_ : bid_ - short_; \
                  gq.gw = c.wave * sz_ + rk_; gq.ngw = NWAVES * sz_; st_prologue_weights(p, gq, (LAS float*)(lds + c.wave * 9216), 16 * 200, -1); } } }
#define PH_SAMPLE { KP p = get_kp(); const Ctx c = make_ctx(wave_s); if (wave_s == 5) { const Ctx g = waveset_ctx(c, 0, 1); st_s5_sample(p, l, g, lds, dry); st_lru_sample(p, l, g, lds, dry); } }
#define PH_SUMM { KP p = get_kp(); const Ctx c = make_ctx(wave_s); (void)dry; \
          if (wave_s < 2 || wave_s == 4) st_s5_phaseA(p, l, waveset_ctx(c, wave_s == 4 ? 2 : wave_s, 3)); \
          if (wave_s == 2 || wave_s == 3 || wave_s >= 6) st_lru_mfma<false>(p, l, waveset_ctx(c, wave_s >= 6 ? wave_s - 4 : wave_s - 2, 4), lds, false); }
#define PH_ATTN { __syncthreads(); KP p = get_kp(); st_attn_prompt(p, l, lds, dry, wave_s); st_attn_sample(p, l, lds, dry, wave_s); }
#define PH_P3 { KP p = get_kp(); const Ctx c = make_ctx(wave_s); unsigned* ctl_ = (unsigned*)(p->ws + WS_CTL); \
          volatile LAS unsigned* ms_ = (volatile LAS unsigned*)(lds + LDS_MISC + 160); \
          if (wave_s == 0 && c.lane == 0) { const unsigned x_ = xb_xcc_id(); unsigned ne_ = 0, no_ = 0; \
              for (unsigned j = 0; j < 16; ++j) { const unsigned cj = xb_ld(&ctl_[XB_XCNT(j)]); if (j & 1) no_ += cj; else ne_ += cj; } \
              const unsigned role_ = x_ & 1u, both_ = (ne_ == 0u || no_ == 0u) ? 1u : 0u; \
              const unsigned rank_ = both_ ? (unsigned)(c.gw - c.wave * (c.ngw / NWAVES)) : xb_add(&ctl_[4096 + 64 * (2 * l + (int)role_)], 1u); \
              ms_[0] = both_ ? 2u : role_; ms_[1] = rank_; ms_[2] = both_ ? (unsigned)(c.ngw / NWAVES) : (role_ ? no_ : ne_); } \
          __syncthreads(); \
          const unsigned role_ = ms_[0]; Ctx g = c; g.gw = c.wave * (int)ms_[2] + (int)ms_[1]; g.ngw = NWAVES * (int)ms_[2]; \
          if (role_ == 0u || role_ == 2u) st_s5_phaseB(p, l, g, lds, dry); \
          if (role_ == 1u || role_ == 2u) st_lru_mfma<true>(p, l, g, lds, dry); }
#define PH_GLU { KP p = get_kp(); int zs = 0; asm volatile("" : "+s"(zs)); bf16_t* PROJ = (bf16_t*)(p->ws + WS_PROJ); \
          pg8::Gemm g{PROJ + C_UB, IN_COLS, (const bf16_t*)((unsigned char*)p->out + DO_WGLU) + (size_t)l * 512 * 512, 512}; \
          pg8::StaticOrder S; S.init(M_P, 512, (int)gridDim.x + zs, (int)blockIdx.x + zs); \
          pg8::gemm_phase<pg8::EpiGluB, pg8::StaticOrder, true, true>(lds, g, S, pg8::EpiGluB{PROJ, dry}, wave_s); \
          const int nb_ = (int)gridDim.x + zs, bid_ = (int)blockIdx.x + zs; \
          if (bid_ >= nb_ / 2) { const Ctx c = make_ctx(wave_s); Ctx g = c; g.gt = (size_t)(bid_ - nb_ / 2) * NTHREADS + c.tid; g.ngt = (size_t)(nb_ - nb_ / 2) * NTHREADS; st_kv_out(p, l, g); }   \
          for (int pc = nb_ - 1 - bid_; pc < 16 * 8; pc += nb_)   \
              piece_gemm<1, 4>(lds, PROJ + C_UB, nullptr, nullptr, IN_COLS, g.Bt, 512, 0, M_P + 32 * (pc >> 3), 64 * (pc & 7), PEpiGlu{PROJ, dry}, wave_s); }
#define PH_BRANCH { KP p = get_kp(); int zs = 0; asm volatile("" : "+s"(zs)); bf16_t* PROJ = (bf16_t*)(p->ws + WS_PROJ); \
          pg8::Gemm g{PROJ + C_Q, IN_COLS, (const bf16_t*)((unsigned char*)p->out + DO_WBR) + (size_t)l * 1024 * 1536, 1536}; \
          pg8::StaticOrder S; S.init(M_P, 1024, (int)gridDim.x + zs, (int)blockIdx.x + zs); \
          pg8::gemm_phase<pg8::EpiMergeB, pg8::StaticOrder, true, true>(lds, g, S, pg8::EpiMergeB{PROJ, dry}, wave_s); \
          const int nb_ = (int)gridDim.x + zs, bid_ = (int)blockIdx.x + zs; \
          for (int pc = bid_; pc < 16 * 16; pc += nb_) \
              piece_gemm<3, 4>(lds, PROJ + C_Q, PROJ + C_GB, PROJ + C_GC, IN_COLS, g.Bt, 1536, 512, M_P + 32 * (pc >> 4), 64 * (pc & 15), PEpiBranch{PROJ, dry}, wave_s); }
#define PH_OUT { KP p = get_kp(); int zs = 0; asm volatile("" : "+s"(zs)); bf16_t* PROJ = (bf16_t*)(p->ws + WS_PROJ); (void)dry; \
          pg8::Gemm g{PROJ + C_GM, IN_COLS, (const bf16_t*)(p->ws + WS_WOUT) + (size_t)l * 1024 * 1024, 1024}; \
          pg8::StaticOrder S; S.init(M_P, 1024, (int)gridDim.x + zs, (int)blockIdx.x + zs); \
          pg8::gemm_phase<pg8::EpiOutB, pg8::StaticOrder, true, true>(lds, g, S, pg8::EpiOutB{(const bf16_t*)(p->ws + WS_XB), p->ws}, wave_s); \
          const int nb_ = (int)gridDim.x + zs, bid_ = (int)blockIdx.x + zs; \
          for (int pc = bid_; pc < 16 * 16; pc += nb_) \
              piece_gemm<1, 8>(lds, PROJ + C_GM, nullptr, nullptr, IN_COLS, g.Bt, 1024, 0, M_P + 32 * (pc >> 4), 64 * (pc & 15), PEpiOut{p, l}, wave_s); }
#define PH_LN { KP p = get_kp(); const Ctx c = make_ctx(wave_s); (void)dry; st_ln(p, l, c); }
    for (int l = 0; l < DEPTH; ++l) {
        TS_BEGIN(1); PROBE_RUN(1, PH_P1);
        xcd_barrier(bar); TS_END(1);
#if TSEL >= 20
        TS_BEGIN(21); PROBE_RUN(2, PH_SAMPLE); xcd_barrier(bar); TS_END(21);
        TS_BEGIN(22); PROBE_RUN(3, PH_SUMM); xcd_barrier(bar); TS_END(22);
        TS_BEGIN(23); PROBE_RUN(4, PH_ATTN); xcd_barrier(bar); TS_END(23);
        { const bool dry = false; PH_P3; } xcd_barrier(bar);
#else
        TS_BEGIN(2); PROBE_RUN(2, PH_SAMPLE);
        PROBE_RUN(3, PH_SUMM);
        PROBE_RUN(4, PH_ATTN);
        xcd_barrier(bar); TS_END(2);
        TS_BEGIN(3); { const bool dry = false; PH_P3; }
        xcd_barrier(bar); TS_END(3);
#endif
        TS_BEGIN(4); PROBE_RUN(7, PH_GLU);
        xcd_barrier(bar); TS_END(4);
        TS_BEGIN(5); PROBE_RUN(8, PH_BRANCH);
        xcd_barrier(bar); TS_END(5);
        TS_BEGIN(6); PROBE_RUN(9, PH_OUT);
        xcd_barrier(bar); TS_END(6);
        TS_BEGIN(7); PROBE_RUN(10, PH_LN);
        if (l + 1 < DEPTH) xcd_barrier(bar);
        TS_END(7);
    }
    if (TSEL != 0 && blockIdx.x == 0 && wave_s == 0 && lane_id() == 0) { const unsigned long long te = __builtin_amdgcn_s_memrealtime(), ts_acc = *(volatile LAS unsigned long long*)(lds + LDS_MISC + 136); while (__builtin_amdgcn_s_memrealtime() - te < ts_acc) __builtin_amdgcn_s_sleep(4); }
}

extern "C" void kernel_launch(void* const* d_in, const int* in_sizes, int n_in, void* d_out, int out_size, void* d_ws, size_t ws_size, hipStream_t stream) {
    static int grid = 0;
    if (grid == 0) {
        if (n_in != 33 || (size_t)out_size != O_END || ws_size < WS_CTL + CTL_BYTES) { fprintf(stderr, "kernel_launch: unexpected sizes n_in %d out %d ws %zu\n", n_in, out_size, ws_size); grid = -1; return; }
        int dev = 0, cus = 0, per_cu = 0;
        if (hipGetDevice(&dev) != hipSuccess || hipDeviceGetAttribute(&cus, hipDeviceAttributeMultiprocessorCount, dev) != hipSuccess) { grid = -1; return; }
        if (hipFuncSetAttribute((const void*)mega_fwd, hipFuncAttributeMaxDynamicSharedMemorySize, LDS_BYTES) != hipSuccess) { fprintf(stderr, "kernel_launch: hipFuncSetAttribute failed\n"); grid = -1; return; }
        if (hipOccupancyMaxActiveBlocksPerMultiprocessor(&per_cu, (const void*)mega_fwd, NTHREADS, LDS_BYTES) != hipSuccess || per_cu < 1) { fprintf(stderr, "kernel_launch: occupancy query says %d blocks/CU\n", per_cu); grid = -1; return; }
        grid = cus;
    }
    if (grid < 0) return;
    (void)hipMemsetAsync((unsigned char*)d_ws + WS_CTL, 0, CTL_BYTES, stream);
    P p{};
    for (int i = 0; i < 33; ++i) p.in[i] = (const float*)d_in[i];
    p.out = (float*)d_out; p.ws = (unsigned char*)d_ws;
    void* args[] = {&p};
    hipError_t e = hipLaunchCooperativeKernel((const void*)mega_fwd, dim3(grid), dim3(NTHREADS), args, LDS_BYTES, stream);
    if (e != hipSuccess) fprintf(stderr, "kernel_launch: cooperative launch failed: %s (grid %d)\n", hipGetErrorString(e), grid);
}
```

```cpp
#include <hip/hip_runtime.h>
#include <cstdint>
#include <cstdio>

typedef unsigned short bf16_t;
typedef short bf16x8 __attribute__((ext_vector_type(8)));
typedef float f32x16 __attribute__((ext_vector_type(16)));
typedef float f32x4 __attribute__((ext_vector_type(4)));

constexpr int D_MODEL = 1024, BATCH = 8, SEQ = 2048, DEPTH = 2, DEC_BATCH = 128, DEC_SEQ = 4;
constexpr int M_P = BATCH * SEQ;
constexpr int M_S = DEC_BATCH * DEC_SEQ;
constexpr int M_TOT = M_P + M_S;
constexpr int IN_COLS = 6400;
constexpr int C_Q = 0, C_GB = 512, C_GC = 1024, C_K = 1536, C_V = 1664, C_GA = 1792, C_UB = 2304, C_XC = 2816, C_GM = 3328;
__host__ __device__ constexpr int colperm32(int n0) {
    return n0 < 512 ? n0 : n0 < 640 ? C_K + (n0 - 512) : n0 < 768 ? C_V + (n0 - 640) : n0 < 1280 ? C_GA + (n0 - 768) : n0 < 1792 ? C_UB + (n0 - 1280)
         : n0 < 2304 ? C_GB + (n0 - 1792) : n0 < 2816 ? C_XC + (n0 - 2304) : n0 < 3328 ? C_GC + (n0 - 2816) : n0; }
constexpr int WINDOW = 128, NKV = 2, HD = 64, NQH = 8;
constexpr int NG = 32, NP = 64, NC = 16;
constexpr float DN_ALPHA = 1.4142135623730951f;
constexpr float LN_EPS = 1e-5f;

constexpr size_t O_YP = 0;
constexpr size_t O_YS = O_YP + (size_t)M_P * D_MODEL;
constexpr size_t O_KP = O_YS + (size_t)M_S * D_MODEL;
constexpr size_t SZ_KP = (size_t)DEPTH * BATCH * WINDOW * NKV * HD;
constexpr size_t O_VP = O_KP + SZ_KP;
constexpr size_t O_SRP = O_VP + SZ_KP;
constexpr size_t SZ_SP = (size_t)DEPTH * BATCH * NG * NP;
constexpr size_t O_SIP = O_SRP + SZ_SP;
constexpr size_t O_LP = O_SIP + SZ_SP;
constexpr size_t SZ_LP = (size_t)DEPTH * BATCH * 512;
constexpr size_t O_CP = O_LP + SZ_LP;
constexpr size_t SZ_CP = (size_t)DEPTH * BATCH * 3 * 512;
constexpr size_t O_KS = O_CP + SZ_CP;
constexpr size_t SZ_KS = (size_t)DEPTH * DEC_BATCH * WINDOW * NKV * HD;
constexpr size_t O_VS = O_KS + SZ_KS;
constexpr size_t O_SRS = O_VS + SZ_KS;
constexpr size_t SZ_SS = (size_t)DEPTH * DEC_BATCH * NG * NP;
constexpr size_t O_SIS = O_SRS + SZ_SS;
constexpr size_t O_LS = O_SIS + SZ_SS;
constexpr size_t SZ_LS = (size_t)DEPTH * DEC_BATCH * 512;
constexpr size_t O_CS = O_LS + SZ_LS;
constexpr size_t SZ_CS = (size_t)DEPTH * DEC_BATCH * 3 * 512;
constexpr size_t O_END = O_CS + SZ_CS;

constexpr size_t WS_PROJ = 0;
constexpr size_t WS_XB = WS_PROJ + (size_t)M_TOT * IN_COLS * 2;
constexpr size_t WS_WOUT = WS_XB + (size_t)M_TOT * D_MODEL * 2;
constexpr size_t WS_TAB = WS_WOUT + (size_t)DEPTH * 1024 * 1024 * 2;
constexpr size_t TAB_AB = 0;
constexpr size_t TAB_BB = TAB_AB + (size_t)DEPTH * NG * NP * 2 * 4;
constexpr size_t TAB_BYTES = TAB_BB + (size_t)DEPTH * NG * NP * NC * 2 * 4;
constexpr size_t WS_S5POW = WS_TAB + TAB_BYTES;
constexpr size_t WS_S5PINV = WS_S5POW + (size_t)DEPTH * NG * 11 * NP * 8;
constexpr size_t WS_S5BCAT = WS_S5PINV + (size_t)DEPTH * NG * 9 * NP * 8;
constexpr size_t WS_S5CCAT = WS_S5BCAT + (size_t)DEPTH * NG * 128 * NC * 2;
constexpr size_t WS_S5SUM = WS_S5CCAT + (size_t)DEPTH * NG * 128 * NC * 2;
constexpr size_t WS_LRUW = WS_S5SUM + (size_t)BATCH * 8 * NG * NP * 8;
constexpr size_t WS_LRSUM = WS_LRUW + (size_t)DEPTH * 8 * 2 * 64 * 64 * 2;
constexpr size_t WS_LSIG = WS_LRSUM + (size_t)BATCH * 32 * 512 * 8;
constexpr size_t WS_END = WS_LSIG + (size_t)DEPTH * 512 * 4;
constexpr size_t DO_WIN = 0;
constexpr size_t DO_WBR = DO_WIN + (size_t)DEPTH * IN_COLS * 1024 * 2;
constexpr size_t DO_WGLU = DO_WBR + (size_t)DEPTH * 3 * 1024 * 512 * 2;
constexpr size_t DO_LRUW = DO_WGLU + (size_t)DEPTH * 512 * 512 * 2;
constexpr size_t DO_END = DO_LRUW;
static_assert(DO_END <= (size_t)M_P * D_MODEL * 4, "weights fit in y_prompt region");
static_assert(WS_END <= 268435456ull, "workspace fits 256 MiB");

__constant__ unsigned char T5_BUCKET[128] = {0, 1, 2, 3, 4, 5, 6, 7, 8, 9, 10, 11, 12, 13, 14, 15, 16, 16, 16, 17, 17, 18, 18, 18, 19, 19, 19, 20, 20, 20, 20, 21, 21, 21, 21, 22, 22, 22, 22, 22, 23, 23, 23, 23, 23, 23, 24, 24, 24, 24, 24, 24, 25, 25, 25, 25, 25, 25, 25, 26, 26, 26, 26, 26, 26, 26, 26, 27, 27, 27, 27, 27, 27, 27, 27, 27, 27, 28, 28, 28, 28, 28, 28, 28, 28, 28, 28, 29, 29, 29, 29, 29, 29, 29, 29, 29, 29, 29, 29, 30, 30, 30, 30, 30, 30, 30, 30, 30, 30, 30, 30, 30, 30, 31, 31, 31, 31, 31, 31, 31, 31, 31, 31, 31, 31, 31, 31, 31};

typedef unsigned u32x4 __attribute__((ext_vector_type(4)));
typedef float f32x2_t __attribute__((ext_vector_type(2)));
typedef __bf16 bf16x2_t __attribute__((ext_vector_type(2)));
__device__ __forceinline__ unsigned cvtpk(float lo, float hi) { f32x2_t v = {lo, hi}; bf16x2_t b = __builtin_convertvector(v, bf16x2_t); return __builtin_bit_cast(unsigned, b); }
__device__ __forceinline__ float bf2f(bf16_t v) { return __uint_as_float(((unsigned)v) << 16); }
__device__ __forceinline__ bf16_t f2bf(float f) { return (bf16_t)cvtpk(f, 0.f); }
__device__ __forceinline__ float sigmoidf_(float x) { return __builtin_amdgcn_rcpf(1.0f + __builtin_amdgcn_exp2f(-1.4426950408889634f * x)); }
__device__ __forceinline__ float siluf_(float x) { return x * sigmoidf_(x); }
__device__ __forceinline__ float gelu_tanh(float y) { return y * sigmoidf_(1.5957691216057308f * (y + 0.044715f * y * y * y)); }

struct P {
    const float* in[33];
    float* out;
    unsigned char* ws;
};

typedef const P __attribute__((address_space(4)))* KP;
__device__ __forceinline__ KP get_kp() { KP k = (KP)__builtin_amdgcn_kernarg_segment_ptr(); asm volatile("" : "+s"(k)); return k; }

constexpr size_t WS_CTL = (WS_END + 4095) & ~(size_t)4095;
constexpr size_t CTL_BYTES = 65536;
static_assert(WS_CTL + CTL_BYTES <= 268435456ull, "workspace fits 256 MiB");
constexpr int NTHREADS = 512, NWAVES = 8;
constexpr int LDS_BYTES = 147456;
constexpr int LDS_MISC = 135168;

#define LAS __attribute__((address_space(3)))
#define XB_TMO      128
#define XB_XCNT(j)  (256  + 64 * (j))
#define XB_XSUB(j)  (1280 + 64 * (j))
#define XB_XGEN(j)  (2304 + 64 * (j))
#define XB_TOP      3328
#define XB_TOPGEN   3392
#define XCD_BAR_WORDS 3456
#define XB_SPIN_CAP (1u << 18)
__device__ __forceinline__ unsigned xb_ld(unsigned* p)              { return __hip_atomic_load(p, __ATOMIC_RELAXED, __HIP_MEMORY_SCOPE_AGENT); }
__device__ __forceinline__ unsigned xb_add(unsigned* p, unsigned v) { return __hip_atomic_fetch_add(p, v, __ATOMIC_RELAXED, __HIP_MEMORY_SCOPE_AGENT); }
__device__ __forceinline__ unsigned xb_xcc_id() { return (unsigned)__builtin_amdgcn_s_getreg((3 << 11) | 20) & 0xFu; }
#define XB_SPIN(cond, bar) do { unsigned _sp = 0; while (cond) { __builtin_amdgcn_s_sleep(1); \
    if ((++_sp & 255u) == 0u) { if (xb_ld(&(bar)[XB_TMO])) break; if (_sp > XB_SPIN_CAP) { atomicAdd(&(bar)[XB_TMO], 1u); break; } } } } while (0)
__device__ __forceinline__ int lane_id0() { return (int)__builtin_amdgcn_mbcnt_hi(~0u, __builtin_amdgcn_mbcnt_lo(~0u, 0u)); }
struct XcdBarrier { unsigned* bar; unsigned x; volatile LAS unsigned* st; int wave_s; };
__device__ __forceinline__ XcdBarrier xcd_barrier_post(unsigned* bar, volatile LAS unsigned* st, int wave_s) {
    XcdBarrier b; b.bar = bar; b.x = xb_xcc_id(); b.st = st; b.wave_s = wave_s;
    if (wave_s == 0 && lane_id0() == 0) (void)xb_add(&bar[XB_XCNT(b.x)], 1u);
    return b;
}
__device__ __forceinline__ void xcd_barrier_complete(unsigned* bar, unsigned x, unsigned& nloc, unsigned& nx) {
    const unsigned G = gridDim.x * gridDim.y * gridDim.z;
    unsigned sum, cnt, mine, sp = 0u;
    for (;;) {
        sum = 0u; cnt = 0u; mine = 0u;
#pragma unroll
        for (unsigned j = 0; j < 16; ++j) { const unsigned c = xb_ld(&bar[XB_XCNT(j)]); sum += c; cnt += (c > 0u) ? 1u : 0u; mine = (j == x) ? c : mine; }
        if (sum == G) break;
        __builtin_amdgcn_s_sleep(1);
        if ((++sp & 255u) == 0u) { if (xb_ld(&bar[XB_TMO])) break; if (sp > XB_SPIN_CAP) { atomicAdd(&bar[XB_TMO], 1u); break; } }
    }
    nloc = mine > 0u ? mine : 1u; nx = cnt > 0u ? cnt : 1u;
}
__device__ __forceinline__ void xcd_barrier(const XcdBarrier& b) {
    asm volatile("s_waitcnt vmcnt(0)" ::: "memory");
    __syncthreads();
    int zb_ = 0; asm volatile("" : "+v"(zb_));
    if (b.wave_s == 0 && (int)__builtin_amdgcn_mbcnt_hi(~0u, __builtin_amdgcn_mbcnt_lo(~0u, (unsigned)zb_)) == 0) {
        unsigned* bar = b.bar; asm volatile("" : "+s"(bar));
        unsigned bx = b.x; asm volatile("" : "+s"(bx));
        __builtin_amdgcn_s_waitcnt(0);
        unsigned nloc = b.st[0], nx = b.st[1];
        if (nloc == 0u) { xcd_barrier_complete(bar, bx, nloc, nx); b.st[0] = nloc; b.st[1] = nx; }
        const unsigned old = xb_add(&bar[XB_XSUB(bx)], 1u);
        const unsigned gen = old / nloc;
        if (old + 1u == (gen + 1u) * nloc) {
            __builtin_amdgcn_fence(__ATOMIC_RELEASE, "agent");
            asm volatile("s_waitcnt vmcnt(0)" ::: "memory");
            const unsigned og = xb_add(&bar[XB_TOP], 1u);
            const unsigned tg = og / nx;
            if (og + 1u == (tg + 1u) * nx) xb_add(&bar[XB_TOPGEN], 1u);
            else XB_SPIN(xb_ld(&bar[XB_TOPGEN]) == tg, bar);
            __builtin_amdgcn_fence(__ATOMIC_ACQUIRE, "agent");
            xb_add(&bar[XB_XGEN(bx)], 1u);
            asm volatile("s_waitcnt vmcnt(0)" ::: "memory");
        } else {
            XB_SPIN(xb_ld(&bar[XB_XGEN(bx)]) == gen, bar);
            __builtin_amdgcn_fence(__ATOMIC_ACQUIRE, "agent");
            asm volatile("s_waitcnt vmcnt(0)" ::: "memory");
        }
    }
    __syncthreads();
}

namespace pg8 {
#define PG8_LAS __attribute__((address_space(3)))
typedef unsigned short bf16_t;
typedef short bf16x8 __attribute__((ext_vector_type(8)));
typedef float f32x4 __attribute__((ext_vector_type(4)));
typedef unsigned u32x4 __attribute__((ext_vector_type(4)));
constexpr int BM = 256, BK = 64, HALF = 128, HTB = HALF * BK * 2  , STAGE_BYTES = 8 * HTB, NXCD = 8, WGM = 8;

__host__ __device__ __forceinline__ int lds_byte(int r, int c) { const int st = (r >> 4) * 2 + (c >> 5), rr = r & 15, cc = c & 31, ob = rr * 64 + cc * 2; return st * 1024 + (ob ^ (((ob >> 9) & 1) << 5)); }
__host__ __device__ __forceinline__ void stage_rc(int b, int& R, int& C) { const int st = b / 1024, sb = b % 1024, swz = sb ^ (((sb >> 9) & 1) << 5); R = (st >> 1) * 16 + swz / 64; C = (st & 1) * 32 + (swz % 64) / 2; }
__host__ __device__ __forceinline__ int perm32(int rho) { const int n = rho >> 4, i = rho & 15; return 8 * (i >> 2) + 4 * n + (i & 3); }

struct Unit { int pm, pn, z; };
struct Gemm { const bf16_t* A; int lda; const bf16_t* Bt; int K; };

struct StaticOrder {
    int nM, nN, nwg, G, c;
    __host__ __device__ void init(int M, int N, int G_, int c_) { nM = M / BM; nN = N / BM; nwg = nM * nN; G = G_; c = c_; }
    __host__ __device__ bool next(int i, Unit& u) const {
        const long L = (long)i * G + c; if (L >= nwg) return false;
        int wgid = (int)L; { const int q = nwg / NXCD, r = nwg % NXCD, xcd = wgid % NXCD, off = wgid / NXCD; wgid = (xcd < r ? xcd * (q + 1) : r * (q + 1) + (xcd - r) * q) + off; }
        const int nig = WGM * nN, gid = wgid / nig, fm = gid * WGM, gsz = (nM - fm) < WGM ? (nM - fm) : WGM;
        u.pm = fm + ((wgid % nig) % gsz); u.pn = (wgid % nig) / gsz; u.z = 0; return true;
    }
    __device__ __forceinline__ size_t a_off(const Unit&) const { return 0; }
    __device__ __forceinline__ size_t b_off(const Unit&) const { return 0; }
    __device__ __forceinline__ void a_ready(const Unit&) const {}
    __device__ __forceinline__ void done(const Unit&) const {}
};

__device__ __forceinline__ unsigned cvt_pk_bf16(float lo, float hi) { unsigned r; asm volatile("v_cvt_pk_bf16_f32 %0, %1, %2" : "=v"(r) : "v"(lo), "v"(hi)); return r; }
typedef float f32x2 __attribute__((ext_vector_type(2)));
__device__ __forceinline__ f32x2 gelu_pk(f32x2 v) {
    const f32x2 av = __builtin_elementwise_abs(v), d = av * 0.2316418882f + 1.0f;
    f32x2 t; t.x = __builtin_amdgcn_rcpf(d.x); t.y = __builtin_amdgcn_rcpf(d.y);
    f32x2 q = t * 0.5307027145f + (-0.7265760135f); q = q * t + 0.7107068705f; q = q * t + (-0.142248368f); q = q * t + 0.127414796f; q = q * t;
    const f32x2 s = (v * v) * (-0.72134752044f);
    f32x2 e; e.x = __builtin_amdgcn_exp2f(s.x); e.y = __builtin_amdgcn_exp2f(s.y);
    const f32x2 m = v * (q * e), r = v - m;
    f32x2 o; o.x = v.x < 0.f ? m.x : r.x; o.y = v.y < 0.f ? m.y : r.y; return o;
}

template <class Epi, class Sched, bool ALIGN_EPI = false, bool SP2 = false>
__device__ __forceinline__ void gemm_phase(PG8_LAS unsigned char* lds, const Gemm g, const Sched& S, const Epi& E, int wave_s) {
    int zv_ = 0; asm volatile("" : "+v"(zv_));
    const int tid = (wave_s << 6) | (int)__builtin_amdgcn_mbcnt_hi(~0u, __builtin_amdgcn_mbcnt_lo(~0u, (unsigned)zv_)), wid = __builtin_amdgcn_readfirstlane(tid >> 6), lane = tid & 63, wr = wid >> 2, wc = wid & 3, fr = lane & 15, fq = lane >> 4;
    const int K = g.K, nt = K / BK;
    unsigned voffA[2], voffB[2];
#pragma unroll
    for (int i = 0; i < 2; ++i) { int R, C; stage_rc(tid * 16 + i * 8192, R, C); const int Rb = Epi::PERM ? ((R & ~31) + perm32(R & 31)) : R;
        voffA[i] = (unsigned)(R * g.lda + C) * 2u; voffB[i] = (unsigned)(Rb * K + C) * 2u; }
    const size_t kstep = (size_t)(BK * 2);
    const size_t hstepA = (size_t)HALF * g.lda * 2, hstepB = (size_t)HALF * K * 2;
    const size_t tstepA = 2 * hstepA, tstepB = 2 * hstepB;
    const unsigned ldsw = (unsigned)wid * 1024u;
    const int aoff = lds_byte(wr * 64 + fr, fq * 8), boff = lds_byte(wc * 32 + fr, fq * 8);
#define PG8_SA(b, h) (((b) * 2 + (h)) * HTB)
#define PG8_SB(b, h) ((4 + (b) * 2 + (h)) * HTB)
#define PG8_STAGE(bufoff, gbase, voff) do { _Pragma("unroll") for (int _i = 0; _i < 2; ++_i) \
        __builtin_amdgcn_global_load_lds((const unsigned*)((const char*)(gbase) + (voff)[_i]), (PG8_LAS unsigned*)(lds + (bufoff) + ldsw + _i * 8192), 16, 0, 0); } while (0)
#define PG8_LDA(dst, b, h) do { _Pragma("unroll") for (int m = 0; m < 4; ++m) _Pragma("unroll") for (int k = 0; k < 2; ++k) dst[m][k] = *(const PG8_LAS bf16x8*)(lds + PG8_SA(b, h) + aoff + m * 2048 + k * 1024); } while (0)
#define PG8_LDB(dst, b, h) do { _Pragma("unroll") for (int n = 0; n < 2; ++n) _Pragma("unroll") for (int k = 0; k < 2; ++k) dst[n][k] = *(const PG8_LAS bf16x8*)(lds + PG8_SB(b, h) + boff + n * 2048 + k * 1024); } while (0)
#define PG8_MMA(ai, bj, At, Bt) do { __builtin_amdgcn_s_setprio(1); _Pragma("unroll") for (int m = 0; m < 4; ++m) _Pragma("unroll") for (int n = 0; n < 2; ++n) _Pragma("unroll") for (int k = 0; k < 2; ++k) \
        acc[ai][bj][m][n] = __builtin_amdgcn_mfma_f32_16x16x32_bf16(Bt[n][k], At[m][k], acc[ai][bj][m][n], 0, 0, 0); __builtin_amdgcn_s_setprio(0); } while (0)
#define PG8_WAIT_V(n) asm volatile("s_waitcnt vmcnt(" #n ")" ::: "memory")
#define PG8_WAIT_L(n) asm volatile("s_waitcnt lgkmcnt(" #n ")" ::: "memory")
#define PG8_BAR __builtin_amdgcn_s_barrier()
#define PG8_SCHED __builtin_amdgcn_sched_barrier(0)
    Unit cur, nxt; int ui = 0;
    if (!S.next(0, cur)) return;
    f32x4 acc[2][2][4][2];
#pragma unroll
    for (int a = 0; a < 2; ++a)
#pragma unroll
        for (int b = 0; b < 2; ++b)
#pragma unroll
            for (int m = 0; m < 4; ++m)
#pragma unroll
                for (int n = 0; n < 2; ++n) acc[a][b][m][n] = (f32x4){0.f, 0.f, 0.f, 0.f};
    bf16x8 At[4][2], B0[2][2], B1[2][2];
    const char* cA = (const char*)g.A + (size_t)cur.pm * tstepA + S.a_off(cur); const char* cB = (const char*)g.Bt + (size_t)cur.pn * tstepB + S.b_off(cur);
    S.a_ready(cur);
    if constexpr (SP2) {
        PG8_STAGE(PG8_SB(0, 0), cB, voffB); PG8_STAGE(PG8_SB(0, 1), cB + hstepB, voffB); PG8_STAGE(PG8_SA(0, 0), cA, voffA); PG8_STAGE(PG8_SA(0, 1), cA + hstepA, voffA);
        if (wr == 1) PG8_BAR;
        PG8_WAIT_V(2); PG8_BAR;
        PG8_STAGE(PG8_SB(1, 0), cB + kstep, voffB); PG8_STAGE(PG8_SA(1, 0), cA + kstep, voffA); PG8_STAGE(PG8_SB(1, 1), cB + hstepB + kstep, voffB);
        PG8_WAIT_V(6); PG8_BAR;
    } else {
        PG8_STAGE(PG8_SB(0, 0), cB, voffB); PG8_STAGE(PG8_SA(0, 0), cA, voffA); PG8_STAGE(PG8_SB(0, 1), cB + hstepB, voffB); PG8_STAGE(PG8_SA(0, 1), cA + hstepA, voffA);
        if (wr == 1) PG8_BAR;
        PG8_WAIT_V(4); PG8_BAR;
        PG8_STAGE(PG8_SB(1, 0), cB + kstep, voffB); PG8_STAGE(PG8_SA(1, 0), cA + kstep, voffA); PG8_STAGE(PG8_SB(1, 1), cB + hstepB + kstep, voffB);
        PG8_WAIT_V(6); PG8_BAR;
    }
    for (;;) {
        const bool has_next = S.next(ui + 1, nxt);
        const char* nA = has_next ? (const char*)g.A + (size_t)nxt.pm * tstepA + S.a_off(nxt) : cA; const char* nB = has_next ? (const char*)g.Bt + (size_t)nxt.pn * tstepB + S.b_off(nxt) : cB;
        for (int t = 0; t < nt; t += 2) {
            if constexpr (Epi::MIDSCALE) { if (t == 8 || t == 16) E.rescale(acc, cur, (t >> 3) - 1, wr, wc, fr, fq); }
            const bool last = (t == nt - 2);
            const char* a1 = cA + (size_t)(t + 1) * kstep;
            const char* a2 = last ? nA : cA + (size_t)(t + 2) * kstep; const char* b2 = last ? nB : cB + (size_t)(t + 2) * kstep;
            const char* a3 = a2 + kstep; const char* b3 = b2 + kstep;
            if (last && has_next) S.a_ready(nxt);
            if constexpr (SP2) {
            PG8_LDB(B0, 0, 0); PG8_LDB(B1, 0, 1); PG8_SCHED; PG8_LDA(At, 0, 0); PG8_STAGE(PG8_SA(1, 1), a1 + hstepA, voffA);
            PG8_WAIT_V(8); PG8_WAIT_L(0); PG8_BAR; PG8_MMA(0, 0, At, B0); PG8_MMA(0, 1, At, B1); PG8_BAR; PG8_SCHED;
            PG8_LDA(At, 0, 1); PG8_STAGE(PG8_SB(0, 0), b2, voffB); PG8_STAGE(PG8_SB(0, 1), b2 + hstepB, voffB); PG8_STAGE(PG8_SA(0, 0), a2, voffA);
            PG8_WAIT_V(8); PG8_WAIT_L(0); PG8_BAR; PG8_MMA(1, 0, At, B0); PG8_MMA(1, 1, At, B1); PG8_BAR; PG8_SCHED;
            PG8_LDB(B0, 1, 0); PG8_LDB(B1, 1, 1); PG8_SCHED; PG8_LDA(At, 1, 0); PG8_STAGE(PG8_SA(0, 1), a2 + hstepA, voffA);
            PG8_WAIT_V(8); PG8_WAIT_L(0); PG8_BAR; PG8_MMA(0, 0, At, B0); PG8_MMA(0, 1, At, B1); PG8_BAR; PG8_SCHED;
            PG8_LDA(At, 1, 1); PG8_STAGE(PG8_SB(1, 0), b3, voffB); PG8_STAGE(PG8_SB(1, 1), b3 + hstepB, voffB); PG8_STAGE(PG8_SA(1, 0), a3, voffA);
            PG8_WAIT_V(8); PG8_WAIT_L(0); PG8_BAR; PG8_MMA(1, 0, At, B0); PG8_MMA(1, 1, At, B1); PG8_BAR; PG8_SCHED;
            } else {
            PG8_LDB(B0, 0, 0); PG8_SCHED; PG8_LDA(At, 0, 0); PG8_STAGE(PG8_SA(1, 1), a1 + hstepA, voffA);
            PG8_WAIT_L(8); PG8_BAR; PG8_WAIT_L(0); PG8_MMA(0, 0, At, B0); PG8_BAR; PG8_SCHED;
            PG8_LDB(B1, 0, 1); PG8_STAGE(PG8_SB(0, 0), b2, voffB);
            PG8_BAR; PG8_WAIT_L(0); PG8_MMA(0, 1, At, B1); PG8_BAR;
            PG8_LDA(At, 0, 1); PG8_STAGE(PG8_SA(0, 0), a2, voffA);
            PG8_BAR; PG8_WAIT_L(0); PG8_MMA(1, 0, At, B0); PG8_BAR; PG8_SCHED;
            PG8_STAGE(PG8_SB(0, 1), b2 + hstepB, voffB);
            PG8_WAIT_V(6); PG8_BAR; PG8_MMA(1, 1, At, B1); PG8_BAR;
            PG8_LDB(B0, 1, 0); PG8_SCHED; PG8_LDA(At, 1, 0); PG8_STAGE(PG8_SA(0, 1), a2 + hstepA, voffA);
            PG8_WAIT_L(8); PG8_BAR; PG8_WAIT_L(0); PG8_MMA(0, 0, At, B0); PG8_BAR; PG8_SCHED;
            PG8_LDB(B1, 1, 1); PG8_STAGE(PG8_SB(1, 0), b3, voffB);
            PG8_BAR; PG8_WAIT_L(0); PG8_MMA(0, 1, At, B1); PG8_BAR;
            PG8_LDA(At, 1, 1); PG8_STAGE(PG8_SA(1, 0), a3, voffA);
            PG8_BAR; PG8_WAIT_L(0); PG8_MMA(1, 0, At, B0); PG8_BAR; PG8_SCHED;
            PG8_STAGE(PG8_SB(1, 1), b3 + hstepB, voffB);
            PG8_WAIT_V(6); PG8_BAR; PG8_MMA(1, 1, At, B1); PG8_BAR;
            }
        }
        if constexpr (ALIGN_EPI) { if (wr == 0) PG8_BAR; }
        if constexpr (!Epi::AFTER_DRAIN) { E(acc, cur, wr, wc, fr, fq); S.done(cur); }
        if (!has_next) break;
#pragma unroll
        for (int a = 0; a < 2; ++a)
#pragma unroll
            for (int b = 0; b < 2; ++b)
#pragma unroll
                for (int m = 0; m < 4; ++m)
#pragma unroll
                    for (int n = 0; n < 2; ++n) acc[a][b][m][n] = (f32x4){0.f, 0.f, 0.f, 0.f};
        cur = nxt; cA = nA; cB = nB; ++ui;
        if constexpr (ALIGN_EPI) { if (wr == 1) PG8_BAR; }
    }
    PG8_WAIT_V(0);
    if constexpr (!ALIGN_EPI) { if (wr == 0) PG8_BAR; }
    PG8_BAR;
    if constexpr (Epi::AFTER_DRAIN) { E.fused(acc, cur, wr, wc, fr, fq, lds, wid, lane); S.done(cur); }
#undef PG8_SA
#undef PG8_SB
#undef PG8_STAGE
#undef PG8_LDA
#undef PG8_LDB
#undef PG8_MMA
#undef PG8_WAIT_V
#undef PG8_WAIT_L
#undef PG8_BAR
#undef PG8_SCHED
}
}

namespace pg8 {
typedef unsigned u32x2 __attribute__((ext_vector_type(2)));
__device__ __forceinline__ float bflo(unsigned w) { return __uint_as_float(w << 16); }
__device__ __forceinline__ float bfhi(unsigned w) { return __uint_as_float(w & 0xffff0000u); }
__device__ __forceinline__ float sigm(float x) { return __builtin_amdgcn_rcpf(1.0f + __builtin_amdgcn_exp2f(-1.4426950408889634f * x)); }
struct EpiProjB {
    static constexpr bool PERM = true, AFTER_DRAIN = false, MIDSCALE = false;
    bf16_t* O; int ldc;
    __device__ __forceinline__ void operator()(const f32x4 (&acc)[2][2][4][2], const Unit& u, int wr, int wc, int fr, int fq) const {
        const int row0 = u.pm * BM + wr * 64 + fr, col0 = u.pn * BM + wc * 32 + 8 * fq;
        const bool gate = u.pn >= C_GM / BM;
#pragma unroll
        for (int ai = 0; ai < 2; ++ai)
#pragma unroll
            for (int m = 0; m < 4; ++m) { bf16_t* rowp = O + (size_t)(row0 + ai * HALF + m * 16) * ldc + col0;
#pragma unroll
                for (int bj = 0; bj < 2; ++bj) { f32x4 v0 = acc[ai][bj][m][0], v1 = acc[ai][bj][m][1];
                    if (gate) {
#pragma unroll
                        for (int e = 0; e < 4; ++e) { v0[e] = 1.0f + __builtin_amdgcn_exp2f(fminf(-1.4426950408889634f * v0[e], 100.f)); v1[e] = 1.0f + __builtin_amdgcn_exp2f(fminf(-1.4426950408889634f * v1[e], 100.f)); } }
                    u32x4 w; w.x = cvt_pk_bf16(v0[0], v0[1]); w.y = cvt_pk_bf16(v0[2], v0[3]); w.z = cvt_pk_bf16(v1[0], v1[1]); w.w = cvt_pk_bf16(v1[2], v1[3]);
                    *(u32x4*)(rowp + bj * HALF) = w; } }
    }
};
struct EpiGluB {
    static constexpr bool PERM = true, AFTER_DRAIN = false, MIDSCALE = false;
    bf16_t* PROJ; bool dry;
    __device__ __forceinline__ void operator()(const f32x4 (&acc)[2][2][4][2], const Unit& u, int wr, int wc, int fr, int fq) const {
        const int row0 = u.pm * BM + wr * 64 + fr, col0 = u.pn * BM + wc * 32 + 8 * fq;
        u32x4 zz[2][2][2], gg[2][2][2];
#define GL_ISSUE(g) do { const int ai_ = (g) >> 1, m0_ = 2 * ((g) & 1); _Pragma("unroll") for (int mm = 0; mm < 2; ++mm) { \
            const bf16_t* rowp = PROJ + (size_t)(row0 + ai_ * HALF + (m0_ + mm) * 16) * IN_COLS + col0; \
            _Pragma("unroll") for (int bj = 0; bj < 2; ++bj) { zz[(g) & 1][mm][bj] = *(const u32x4*)(rowp + C_UB + bj * HALF); gg[(g) & 1][mm][bj] = *(const u32x4*)(rowp + C_GB + bj * HALF); } } } while (0)
        GL_ISSUE(0);
#pragma unroll
        for (int ah = 0; ah < 4; ++ah) { const int ai = ah >> 1, m0 = 2 * (ah & 1);
            if (ah + 1 < 4) GL_ISSUE(ah + 1);
            __builtin_amdgcn_sched_barrier(0);
#pragma unroll
            for (int mm = 0; mm < 2; ++mm) { const int m = m0 + mm; bf16_t* rowp = PROJ + (size_t)(row0 + ai * HALF + m * 16) * IN_COLS + col0;
#pragma unroll
                for (int bj = 0; bj < 2; ++bj) {
                    const f32x4 v0 = acc[ai][bj][m][0], v1 = acc[ai][bj][m][1];
                    float o[8];
#pragma unroll
                    for (int e = 0; e < 4; ++e) {
                        const float va = e < 2 ? v0[2 * e] : v1[2 * (e - 2)], vb = e < 2 ? v0[2 * e + 1] : v1[2 * (e - 2) + 1];
                        const unsigned wz = zz[ah & 1][mm][bj][e], wg = gg[ah & 1][mm][bj][e];
                        const float za = bflo(wz), zb = bfhi(wz), ga = bflo(wg), gb = bfhi(wg);
                        o[2 * e] = za * sigm(va) * ga * sigm(ga); o[2 * e + 1] = zb * sigm(vb) * gb * sigm(gb);
                    }
                    u32x4 w; w.x = cvt_pk_bf16(o[0], o[1]); w.y = cvt_pk_bf16(o[2], o[3]); w.z = cvt_pk_bf16(o[4], o[5]); w.w = cvt_pk_bf16(o[6], o[7]);
                    if (!dry) *(u32x4*)(rowp + C_GB + bj * HALF) = w; } }
        }
#undef GL_ISSUE
    }
};
#ifndef RS_DEPTH
#define RS_DEPTH 1
#endif
struct EpiMergeB {
    static constexpr bool PERM = true, AFTER_DRAIN = false, MIDSCALE = true;
    bf16_t* PROJ; bool dry;
    __device__ __forceinline__ void rescale(f32x4 (&acc)[2][2][4][2], const Unit& u, int step, int wr, int wc, int fr, int fq) const {
        int zr = 0; asm volatile("" : "+v"(zr));
        const int row0 = u.pm * BM + wr * 64 + fr + zr, col0 = u.pn * BM + wc * 32 + 8 * fq;
        constexpr int DEPTH_ = RS_DEPTH;
        u32x4 ga[DEPTH_ + 1][2][2], gb[DEPTH_ + 1][2][2];
#define RS_ISSUE(g) do { const int ai_ = (g) >> 1, m0_ = 2 * ((g) & 1); _Pragma("unroll") for (int mm = 0; mm < 2; ++mm) { \
            const bf16_t* rowp = PROJ + (size_t)(row0 + ai_ * HALF + (m0_ + mm) * 16) * IN_COLS + C_GM + step * 1024 + col0; \
            _Pragma("unroll") for (int bj = 0; bj < 2; ++bj) { ga[(g) % (DEPTH_ + 1)][mm][bj] = *(const u32x4*)(rowp + bj * HALF); gb[(g) % (DEPTH_ + 1)][mm][bj] = *(const u32x4*)(rowp + 1024 + bj * HALF); } } } while (0)
#pragma unroll
        for (int g = 0; g < DEPTH_; ++g) RS_ISSUE(g);
#pragma unroll
        for (int ah = 0; ah < 4; ++ah) { const int ai = ah >> 1, m0 = 2 * (ah & 1);
            if (ah + DEPTH_ < 4) RS_ISSUE(ah + DEPTH_);
            __builtin_amdgcn_sched_barrier(0);
#pragma unroll
            for (int mm = 0; mm < 2; ++mm)
#pragma unroll
                for (int bj = 0; bj < 2; ++bj)
#pragma unroll
                    for (int e = 0; e < 4; ++e) { const int m = m0 + mm; const unsigned wa = ga[ah % (DEPTH_ + 1)][mm][bj][e], wb = gb[ah % (DEPTH_ + 1)][mm][bj][e];
                        const float r0 = bflo(wb) * __builtin_amdgcn_rcpf(bflo(wa)), r1 = bfhi(wb) * __builtin_amdgcn_rcpf(bfhi(wa));
                        if (e < 2) { acc[ai][bj][m][0][2 * e] *= r0; acc[ai][bj][m][0][2 * e + 1] *= r1; } else { acc[ai][bj][m][1][2 * (e - 2)] *= r0; acc[ai][bj][m][1][2 * (e - 2) + 1] *= r1; }
                    }
        }
#undef RS_ISSUE
    }
    __device__ __forceinline__ void operator()(const f32x4 (&acc)[2][2][4][2], const Unit& u, int wr, int wc, int fr, int fq) const {
        const int row0 = u.pm * BM + wr * 64 + fr, col0 = u.pn * BM + wc * 32 + 8 * fq;
        u32x4 gg[2][4][2];
#pragma unroll
        for (int ai = 0; ai < 2; ++ai)
#pragma unroll
            for (int m = 0; m < 4; ++m) { const bf16_t* rowp = PROJ + (size_t)(row0 + ai * HALF + m * 16) * IN_COLS + C_GM + 2048 + col0;
#pragma unroll
                for (int bj = 0; bj < 2; ++bj) gg[ai][m][bj] = *(const u32x4*)(rowp + bj * HALF); }
        __builtin_amdgcn_sched_barrier(0);
#pragma unroll
        for (int ai = 0; ai < 2; ++ai)
#pragma unroll
            for (int m = 0; m < 4; ++m) { bf16_t* rowp = PROJ + (size_t)(row0 + ai * HALF + m * 16) * IN_COLS + C_GM + col0;
#pragma unroll
                for (int bj = 0; bj < 2; ++bj) {
                    const f32x4 v0 = acc[ai][bj][m][0], v1 = acc[ai][bj][m][1];
                    float o[8];
#pragma unroll
                    for (int e = 0; e < 4; ++e) {
                        const float va = e < 2 ? v0[2 * e] : v1[2 * (e - 2)], vb = e < 2 ? v0[2 * e + 1] : v1[2 * (e - 2) + 1];
                        o[2 * e] = __builtin_amdgcn_rcpf(bflo(gg[ai][m][bj][e])) * va; o[2 * e + 1] = __builtin_amdgcn_rcpf(bfhi(gg[ai][m][bj][e])) * vb;
                    }
                    u32x4 w; w.x = cvt_pk_bf16(o[0], o[1]); w.y = cvt_pk_bf16(o[2], o[3]); w.z = cvt_pk_bf16(o[4], o[5]); w.w = cvt_pk_bf16(o[6], o[7]);
                    if (!dry) *(u32x4*)(rowp + bj * HALF) = w; } }
    }
};
struct EpiOutB {
    static constexpr bool PERM = true, AFTER_DRAIN = false, MIDSCALE = false;
    const bf16_t* XB; unsigned char* ws;
    __device__ __forceinline__ void operator()(const f32x4 (&acc)[2][2][4][2], const Unit& u, int wr, int wc, int fr, int fq) const {
        const int row0 = u.pm * BM + wr * 64 + fr, col0 = u.pn * BM + wc * 32 + 8 * fq;
        u32x4 xx[2][4][2];
#pragma unroll
        for (int ai = 0; ai < 2; ++ai)
#pragma unroll
            for (int m = 0; m < 4; ++m) { const bf16_t* xrow = XB + (size_t)(row0 + ai * HALF + m * 16) * D_MODEL + col0;
#pragma unroll
                for (int bj = 0; bj < 2; ++bj) xx[ai][m][bj] = *(const u32x4*)(xrow + bj * HALF); }
        __builtin_amdgcn_sched_barrier(0);
#pragma unroll
        for (int ai = 0; ai < 2; ++ai)
#pragma unroll
            for (int m = 0; m < 4; ++m) { const int r = row0 + ai * HALF + m * 16;
                bf16_t* prow = (bf16_t*)(ws + WS_PROJ + (size_t)r * IN_COLS * 2 + (size_t)(C_GM + 1024) * 2) + col0;
#pragma unroll
                for (int bj = 0; bj < 2; ++bj) { const u32x4 w = xx[ai][m][bj];
                    const f32x4 o0 = (f32x4){bflo(w.x), bfhi(w.x), bflo(w.y), bfhi(w.y)} * DN_ALPHA + acc[ai][bj][m][0], o1 = (f32x4){bflo(w.z), bfhi(w.z), bflo(w.w), bfhi(w.w)} * DN_ALPHA + acc[ai][bj][m][1];
                    u32x4 ow; ow.x = cvt_pk_bf16(o0[0], o0[1]); ow.y = cvt_pk_bf16(o0[2], o0[3]); ow.z = cvt_pk_bf16(o1[0], o1[1]); ow.w = cvt_pk_bf16(o1[2], o1[3]);
                    *(u32x4*)(prow + bj * HALF) = ow; } }
    }
};
}

__device__ __forceinline__ int lane_id() { return (int)__builtin_amdgcn_mbcnt_hi(~0u, __builtin_amdgcn_mbcnt_lo(~0u, 0u)); }
__device__ __forceinline__ int tid_of(int wave_s, int zv) { return (wave_s << 6) | (int)__builtin_amdgcn_mbcnt_hi(~0u, __builtin_amdgcn_mbcnt_lo(~0u, (unsigned)zv)); }
struct Halves { float lo, hi; };
__device__ __forceinline__ Halves halves(float v) { const unsigned u = __float_as_uint(v); auto rr = __builtin_amdgcn_permlane32_swap(u, u, false, false); return Halves{__uint_as_float(rr[0]), __uint_as_float(rr[1])}; }
template <int O> __device__ __forceinline__ float xor_lane(float v) { return __int_as_float(__builtin_amdgcn_ds_swizzle(__float_as_int(v), (O << 10) | 0x1F)); }
__device__ __forceinline__ float wave_sum(float v) { v += xor_lane<1>(v); v += xor_lane<2>(v); v += xor_lane<4>(v); v += xor_lane<8>(v); v += xor_lane<16>(v); const Halves hh = halves(v); return hh.lo + hh.hi; }
struct Ctx { int tid, lane, wave, gw, ngw; size_t gt, ngt; };
__device__ __forceinline__ Ctx make_ctx(int wave_s) {
    int zv = 0; asm volatile("" : "+v"(zv)); int zs = 0; asm volatile("" : "+s"(zs));
    Ctx c; c.tid = tid_of(wave_s, zv); c.lane = c.tid & 63; c.wave = __builtin_amdgcn_readfirstlane(c.tid >> 6);
    const int bid = (int)blockIdx.x + zs, nb = (int)gridDim.x + zs;
    c.gw = c.wave * nb + bid; c.ngw = nb * NWAVES; c.gt = (size_t)bid * NTHREADS + c.tid; c.ngt = (size_t)nb * NTHREADS; return c;
}
__device__ __forceinline__ Ctx group_ctx(const Ctx& c, int w0, int nw) {
    Ctx g = c; const int nb = c.ngw / NWAVES, bid = c.gw - c.wave * nb; g.gw = (c.wave - w0) * nb + bid; g.ngw = nw * nb; return g; }
__device__ __forceinline__ Ctx waveset_ctx(const Ctx& c, int rank, int size) {
    Ctx g = c; const int nb = c.ngw / NWAVES, bid = c.gw - c.wave * nb; g.gw = rank * nb + bid; g.ngw = size * nb; return g; }
#define WAVE_LDS_SYNC() do { asm volatile("s_waitcnt lgkmcnt(0)" ::: "memory"); __builtin_amdgcn_wave_barrier(); } while (0)

__device__ __forceinline__ void st_convert_x(KP p, const Ctx& c) {
    u32x4* XB = (u32x4*)(p->ws + WS_XB);
    const size_t n8 = (size_t)M_TOT * D_MODEL / 8, np8 = (size_t)M_P * D_MODEL / 8;
    for (size_t i0 = c.gt; i0 < n8; i0 += 4 * c.ngt) {
        f32x4 a[4], b[4];
#pragma unroll
        for (int u = 0; u < 4; ++u) { const size_t i = i0 + u * c.ngt; if (i < n8) { const f32x4* src = i < np8 ? (const f32x4*)p->in[0] + 2 * i : (const f32x4*)p->in[1] + 2 * (i - np8); a[u] = src[0]; b[u] = src[1]; } }
#pragma unroll
        for (int u = 0; u < 4; ++u) { const size_t i = i0 + u * c.ngt; if (i < n8) { u32x4 o; o.x = cvtpk(a[u][0], a[u][1]); o.y = cvtpk(a[u][2], a[u][3]); o.z = cvtpk(b[u][0], b[u][1]); o.w = cvtpk(b[u][2], b[u][3]); XB[i] = o; } }
    }
}

__device__ __forceinline__ unsigned pk2bf(float lo, float hi) { return (unsigned)f2bf(lo) | ((unsigned)f2bf(hi) << 16); }
__device__ __forceinline__ void p0_transpose_item(const float* W, int K, int N, bf16_t* WT, int ldk, int koff, bool perm, LAS float* scr, int item, int lane) {
    const int nblk = N / 32, kb = item / nblk, nb = item % nblk, k0 = 64 * kb, n0 = 32 * nb, d0 = perm ? colperm32(n0) : n0;
    float wv[32];
#pragma unroll
    for (int i = 0; i < 32; ++i) wv[i] = W[(size_t)(k0 + 2 * i + (lane >> 5)) * N + n0 + (lane & 31)];
#pragma unroll
    for (int i = 0; i < 32; ++i) scr[(2 * i + (lane >> 5)) * 33 + (lane & 31)] = wv[i];
    WAVE_LDS_SYNC();
    const int cch = lane & 7;
#pragma unroll
    for (int j = 0; j < 4; ++j) { const int n = (lane >> 3) + 8 * j; const LAS float* sp = scr + (8 * cch) * 33 + n;
        u32x4 o; o.x = pk2bf(sp[0 * 33], sp[1 * 33]); o.y = pk2bf(sp[2 * 33], sp[3 * 33]); o.z = pk2bf(sp[4 * 33], sp[5 * 33]); o.w = pk2bf(sp[6 * 33], sp[7 * 33]);
        *(u32x4*)(WT + (size_t)(d0 + n) * ldk + koff + k0 + 8 * cch) = o; }
    WAVE_LDS_SYNC();
}
__device__ __forceinline__ void st_prologue_weights(KP p, const Ctx& c, LAS float* scr, int it_lo, int it_hi) {
    unsigned char* dob = (unsigned char*)p->out;
    constexpr int I_IN = 16 * 200, I_BR = 8 * 32, I_GLU = 8 * 16, I_OUT = 16 * 32, I_LAYER = I_IN + 3 * I_BR + I_GLU + I_OUT;
    if (it_hi < 0) it_hi = DEPTH * I_LAYER;
    for (int it = it_lo + c.gw; it < it_hi; it += c.ngw) {
        const int l = it / I_LAYER; int r = it % I_LAYER;
        if (r < I_IN) { p0_transpose_item(p->in[9] + (size_t)l * 1024 * IN_COLS, 1024, IN_COLS, (bf16_t*)(dob + DO_WIN) + (size_t)l * IN_COLS * 1024, 1024, 0, true, scr, r, c.lane); continue; } r -= I_IN;
        if (r < I_BR) { p0_transpose_item(p->in[11] + (size_t)l * 512 * 1024, 512, 1024, (bf16_t*)(dob + DO_WBR) + (size_t)l * 1024 * 1536, 1536, 0, false, scr, r, c.lane); continue; } r -= I_BR;
        if (r < I_BR) { p0_transpose_item(p->in[21] + (size_t)l * 512 * 1024, 512, 1024, (bf16_t*)(dob + DO_WBR) + (size_t)l * 1024 * 1536, 1536, 512, false, scr, r, c.lane); continue; } r -= I_BR;
        if (r < I_BR) { p0_transpose_item(p->in[29] + (size_t)l * 512 * 1024, 512, 1024, (bf16_t*)(dob + DO_WBR) + (size_t)l * 1024 * 1536, 1536, 1024, false, scr, r, c.lane); continue; } r -= I_BR;
        if (r < I_GLU) { p0_transpose_item(p->in[20] + (size_t)l * 512 * 512, 512, 512, (bf16_t*)(dob + DO_WGLU) + (size_t)l * 512 * 512, 512, 0, false, scr, r, c.lane); continue; } r -= I_GLU;
        p0_transpose_item(p->in[30] + (size_t)l * 1024 * 1024, 1024, 1024, (bf16_t*)(p->ws + WS_WOUT) + (size_t)l * 1024 * 1024, 1024, 0, false, scr, r, c.lane);
    }
}
__device__ __forceinline__ f32x4 ld_bf4(const bf16_t* q) { typedef unsigned u32x2_t __attribute__((ext_vector_type(2))); const u32x2_t w = *(const u32x2_t*)q;
    return (f32x4){__uint_as_float(w.x << 16), __uint_as_float(w.x & 0xffff0000u), __uint_as_float(w.y << 16), __uint_as_float(w.y & 0xffff0000u)}; }
__device__ __forceinline__ void st_kv_out(KP p, int l, const Ctx& c) {
    const bf16_t* PROJ = (const bf16_t*)(p->ws + WS_PROJ);
    for (size_t ii = c.gt; ii < (size_t)BATCH * 3 * 128; ii += c.ngt) {
        const int i = (int)ii, b = i / 384, j = (i / 128) % 3, c4 = i % 128;
        *(f32x4*)(p->out + O_CP + (size_t)l * BATCH * 1536 + (size_t)i * 4) = ld_bf4(PROJ + ((size_t)b * SEQ + SEQ - 3 + j) * IN_COLS + C_XC + 4 * c4);
    }
    for (size_t ii = c.gt; ii < (size_t)DEC_BATCH * 3 * 128; ii += c.ngt) {
        const int i = (int)ii, b = i / 384, j = (i / 128) % 3, c4 = i % 128;
        *(f32x4*)(p->out + O_CS + (size_t)l * DEC_BATCH * 1536 + (size_t)i * 4) = ld_bf4(PROJ + ((size_t)M_P + 4 * b + 1 + j) * IN_COLS + C_XC + 4 * c4);
    }
    for (size_t ii = c.gt; ii < (size_t)BATCH * WINDOW * 32; ii += c.ngt) {
        const int i = (int)ii, b = i / (WINDOW * 32), w = (i / 32) % WINDOW, c4 = i % 32;
        const bf16_t* src = PROJ + ((size_t)b * SEQ + (SEQ - WINDOW) + w) * IN_COLS + 4 * c4;
        *(f32x4*)(p->out + O_KP + (size_t)l * BATCH * WINDOW * 128 + (size_t)i * 4) = ld_bf4(src + C_K);
        *(f32x4*)(p->out + O_VP + (size_t)l * BATCH * WINDOW * 128 + (size_t)i * 4) = ld_bf4(src + C_V);
    }
    for (size_t ii = c.gt; ii < (size_t)DEC_BATCH * DEC_SEQ * 32; ii += c.ngt) {
        const int i = (int)ii, b = i / (DEC_SEQ * 32), t = (i / 32) % DEC_SEQ, c4 = i % 32;
        const bf16_t* src = PROJ + ((size_t)M_P + b * DEC_SEQ + t) * IN_COLS + 4 * c4;
        const size_t o = (((size_t)l * DEC_BATCH + b) * WINDOW + (WINDOW - DEC_SEQ) + t) * 128 + 4 * c4;
        *(f32x4*)(p->out + O_KS + o) = ld_bf4(src + C_K); *(f32x4*)(p->out + O_VS + o) = ld_bf4(src + C_V);
    }
    constexpr int NSH = DEC_BATCH * (WINDOW - DEC_SEQ) * 32;
    for (size_t i0 = c.gt; i0 < (size_t)NSH; i0 += 4 * c.ngt) {
        f32x4 kk[4], vv[4];
#pragma unroll
        for (int u = 0; u < 4; ++u) { const size_t ii = i0 + u * c.ngt; if (ii < (size_t)NSH) { const int i = (int)ii, b = i / ((WINDOW - DEC_SEQ) * 32), r = i % ((WINDOW - DEC_SEQ) * 32);
            const size_t ci = (((size_t)l * DEC_BATCH + b) * WINDOW + DEC_SEQ) * 128 + (size_t)r * 4; kk[u] = *(const f32x4*)(p->in[2] + ci); vv[u] = *(const f32x4*)(p->in[3] + ci); } }
#pragma unroll
        for (int u = 0; u < 4; ++u) { const size_t ii = i0 + u * c.ngt; if (ii < (size_t)NSH) { const int i = (int)ii, b = i / ((WINDOW - DEC_SEQ) * 32), r = i % ((WINDOW - DEC_SEQ) * 32);
            const size_t o = ((size_t)l * DEC_BATCH + b) * WINDOW * 128 + (size_t)r * 4; *(f32x4*)(p->out + O_KS + o) = kk[u]; *(f32x4*)(p->out + O_VS + o) = vv[u]; } }
    }
}

typedef short s16x4 __attribute__((ext_vector_type(4)));
typedef short v4i16_t __attribute__((ext_vector_type(4)));
__device__ __forceinline__ bf16x8 pack8(float a0, float a1, float a2, float a3, float a4, float a5, float a6, float a7) {
    u32x4 p; p.x = cvtpk(a0, a1); p.y = cvtpk(a2, a3); p.z = cvtpk(a4, a5); p.w = cvtpk(a6, a7); return __builtin_bit_cast(bf16x8, p); }
__device__ __forceinline__ s16x4 tr_read(LAS const unsigned char* p) { return __builtin_bit_cast(s16x4, __builtin_amdgcn_ds_read_tr16_b64_v4i16((LAS v4i16_t*)p)); }
__device__ __forceinline__ bf16x8 cat8(s16x4 lo, s16x4 hi) { return __builtin_shufflevector(lo, hi, 0, 1, 2, 3, 4, 5, 6, 7); }
#define MFMA_SETTLE2(a, b) asm volatile("s_nop 15\n\ts_nop 7" : "+v"(a), "+v"(b))
#define MFMA_SETTLE3(a, b, c) asm volatile("s_nop 15\n\ts_nop 7" : "+v"(a), "+v"(b), "+v"(c))
#define MFMA32(a, b, c) __builtin_amdgcn_mfma_f32_32x32x16_bf16((a), (b), (c), 0, 0, 0)
#define MFMA16(a, b, c) __builtin_amdgcn_mfma_f32_16x16x32_bf16((a), (b), (c), 0, 0, 0)

constexpr int AT_KSTR = 144, AT_VSTR = 192;
constexpr int AT_K = 0, AT_V = AT_K + 256 * AT_KSTR, AT_BIAS = AT_V + 256 * AT_VSTR, AT_WS = AT_BIAS + 4 * 128 * 4, AT_END = AT_WS + 8 * 256;
static_assert(AT_END <= 131072, "attention LDS");

__device__ __forceinline__ void st_attn_prompt(KP p, int l, LAS unsigned char* lds, bool dry, int wave_s) {
    int zv = 0; asm volatile("" : "+v"(zv));
    const int tid = tid_of(wave_s, zv), lane = tid & 63, wave = __builtin_amdgcn_readfirstlane(tid >> 6);
    const int c31 = lane & 31, h = lane >> 5;
    bf16_t* PROJ = (bf16_t*)(p->ws + WS_PROJ);
    const float* rel_bias = p->in[8];
    for (int item = blockIdx.x; item < BATCH * 16 * NKV; item += gridDim.x) {
        const int b = item / 32, nb = (item >> 1) & 15, kvh = item & 1;
        const size_t rowq0 = (size_t)b * SEQ + (size_t)nb * 128;
#pragma unroll
        for (int i = 0; i < 4; ++i) {
            const int id = tid + 512 * i, row = id >> 3, pc = id & 7;
            u32x4 kk = (u32x4){0u, 0u, 0u, 0u}, vv = kk;
            if (nb > 0 || row >= 128) {
                const bf16_t* src = PROJ + (rowq0 - 128 + row) * IN_COLS + kvh * 64 + pc * 8;
                kk = *(const u32x4*)(src + C_K); vv = *(const u32x4*)(src + C_V);
            }
            *(LAS u32x4*)(lds + AT_K + row * AT_KSTR + pc * 16) = kk;
            *(LAS u32x4*)(lds + AT_V + row * AT_VSTR + pc * 16) = vv;
        }
        { const int g = tid >> 7, d = tid & 127; ((LAS float*)(lds + AT_BIAS))[tid] = rel_bias[T5_BUCKET[d] * NQH + kvh * 4 + g]; }
        const int g = wave >> 1, hq = kvh * 4 + g;
        bf16x8 qfn[4];
        { const bf16_t* qp = PROJ + (rowq0 + 64 * (wave & 1) + c31) * IN_COLS + C_Q + hq * 64 + 8 * h;
#pragma unroll
          for (int ks = 0; ks < 4; ++ks) qfn[ks] = *(const bf16x8*)(qp + 16 * ks); }
        __syncthreads();
        const float sink = p->in[10][l * NQH + hq];
        LAS const float* biasd = (LAS const float*)(lds + AT_BIAS) + g * 128;
        LAS float* wsf = (LAS float*)(lds + AT_WS + wave * 256);
#pragma unroll 1
        for (int qi = 0; qi < 2; ++qi) {
            const int qt = 2 * (wave & 1) + qi, q0 = 32 * qt;
            bf16x8 qf[4];
#pragma unroll
            for (int ks = 0; ks < 4; ++ks) qf[ks] = qfn[ks];
            if (qi == 0) { const bf16_t* qp = PROJ + (rowq0 + q0 + 32 + c31) * IN_COLS + C_Q + hq * 64 + 8 * h;
#pragma unroll
                for (int ks = 0; ks < 4; ++ks) qfn[ks] = *(const bf16x8*)(qp + 16 * ks); }
            f32x16 S[5];
#pragma unroll
            for (int j = 0; j < 5; ++j) {
                S[j] = (f32x16){};
                LAS const unsigned char* kp = lds + AT_K + (32 * (qt + j) + c31) * AT_KSTR + 16 * h;
#pragma unroll
                for (int ks = 0; ks < 4; ++ks) S[j] = MFMA32(*(LAS const bf16x8*)(kp + 32 * ks), qf[ks], S[j]);
            }
            asm volatile("s_nop 15\n\ts_nop 7" : "+v"(S[0]), "+v"(S[1]), "+v"(S[2]), "+v"(S[3]), "+v"(S[4]));
            float gav[16][2];
#pragma unroll
            for (int r = 0; r < 16; ++r) {
                const bf16_t* rowp = PROJ + (rowq0 + q0 + (r & 3) + 8 * (r >> 2) + 4 * h) * IN_COLS + hq * 64 + c31;
                gav[r][0] = bf2f(rowp[C_GA]); gav[r][1] = bf2f(rowp[C_GA + 32]);
            }
            const int iq = q0 + c31;
            float mx = sink;
#pragma unroll
            for (int j = 0; j < 5; ++j)
#pragma unroll
                for (int r = 0; r < 16; ++r) {
                    const int kv = 32 * (qt + j) + (r & 3) + 8 * (r >> 2) + 4 * h;
                    const int dist = iq + 128 - kv;
                    const bool ok = (dist >= 0) && (dist < 128) && (nb > 0 || kv >= 128);
                    const float s = ok ? S[j][r] * 0.125f + biasd[dist & 127] : -1e30f;
                    S[j][r] = s; mx = fmaxf(mx, s);
                }
            { const Halves hh = halves(mx); mx = fmaxf(hh.lo, hh.hi); }
            float sum = 0.f;
#pragma unroll
            for (int j = 0; j < 5; ++j)
#pragma unroll
                for (int r = 0; r < 16; ++r) { const float e = S[j][r] > -1e29f ? __expf(S[j][r] - mx) : 0.f; S[j][r] = e; sum += e; }
            { const Halves hh = halves(sum); sum = hh.lo + hh.hi; }
            const float rden = 1.0f / (sum + __expf(sink - mx));
            if (h == 0) wsf[c31] = rden;
            f32x16 O[2]; O[0] = (f32x16){}; O[1] = (f32x16){};
            const int i16 = lane & 15, qq = i16 >> 2, pp = i16 & 3, blk = (lane >> 4) & 1;
#pragma unroll
            for (int j = 0; j < 5; ++j)
#pragma unroll
                for (int s = 0; s < 2; ++s) {
                    const bf16x8 pf = pack8(S[j][8 * s], S[j][8 * s + 1], S[j][8 * s + 2], S[j][8 * s + 3], S[j][8 * s + 4], S[j][8 * s + 5], S[j][8 * s + 6], S[j][8 * s + 7]);
                    LAS const unsigned char* vp = lds + AT_V + (32 * (qt + j) + 16 * s + 4 * h + qq) * AT_VSTR + (16 * blk + 4 * pp) * 2;
#pragma unroll
                    for (int dt = 0; dt < 2; ++dt) {
                        const bf16x8 vf = cat8(tr_read(vp + dt * 64), tr_read(vp + dt * 64 + 8 * AT_VSTR));
                        O[dt] = MFMA32(pf, vf, O[dt]);
                    }
                }
            MFMA_SETTLE2(O[0], O[1]);
            WAVE_LDS_SYNC();
#pragma unroll
            for (int r = 0; r < 16; ++r) {
                const int qr = (r & 3) + 8 * (r >> 2) + 4 * h;
                const float rd = wsf[qr];
                bf16_t* rowp = PROJ + (rowq0 + q0 + qr) * IN_COLS + hq * 64 + c31;
#pragma unroll
                for (int dt = 0; dt < 2; ++dt) if (!dry) rowp[C_Q + 32 * dt] = f2bf(O[dt][r] * rd * siluf_(gav[r][dt]));
            }
            WAVE_LDS_SYNC();
        }
        __syncthreads();
    }
}

constexpr int S5_NPOW = 11, S5_NINV = 9, S5_NSEG = 8, S5_SEGLEN = 256;
__device__ __forceinline__ float neg_expm1_small(float y) {
    float q = 1.0f / 5040.0f; q = q * y + 1.0f / 720.0f; q = q * y + 1.0f / 120.0f; q = q * y + 1.0f / 24.0f; q = q * y + 1.0f / 6.0f; q = q * y + 0.5f; q = q * y + 1.0f; return -(q * y);
}
__device__ __forceinline__ f32x2_t cmul(f32x2_t a, f32x2_t b) { return (f32x2_t){a.x * b.x - a.y * b.y, a.x * b.y + a.y * b.x}; }

__device__ __forceinline__ void st_s5_tables2(KP p, const Ctx& c) {
    f32x2_t* POW = (f32x2_t*)(p->ws + WS_S5POW); f32x2_t* PINV = (f32x2_t*)(p->ws + WS_S5PINV);
    bf16_t* BCAT = (bf16_t*)(p->ws + WS_S5BCAT); bf16_t* CCAT = (bf16_t*)(p->ws + WS_S5CCAT);
    const float* BB = (const float*)(p->ws + WS_TAB + TAB_BB);
    for (size_t ii = c.gt; ii < (size_t)DEPTH * NG * NP * (S5_NPOW + S5_NINV); ii += c.ngt) {
        const int k = (int)(ii % (S5_NPOW + S5_NINV)), i = (int)(ii / (S5_NPOW + S5_NINV)), lg = i / NP, pp = i % NP;
        const double lr = (double)fminf(p->in[12][i], -1e-4f), li = (double)p->in[13][i];
        const double step = (double)expf(p->in[14][lg]);
        const int e = k < 9 ? k : (k == 9 ? 64 : (k == 10 ? 256 : -(k - S5_NPOW)));
        double t = (double)e * li * step * 0.15915494309189535; t -= rint(t);
        float sn, cs; sincosf((float)(t * 6.283185307179586), &sn, &cs);
        const float mag = expf((float)((double)e * lr * step));
        const f32x2_t v = {mag * cs, mag * sn};
        if (k < S5_NPOW) POW[((size_t)lg * S5_NPOW + k) * NP + pp] = v; else PINV[((size_t)lg * S5_NINV + (k - S5_NPOW)) * NP + pp] = v;
    }
    for (size_t ii = c.gt; ii < (size_t)DEPTH * NG * 128 * NC; ii += c.ngt) {
        const int i = (int)ii, lg = i / (128 * NC), n = (i / NC) % 128, cc = i % NC, pp = n & 63;
        const int sidx = lg * NP + pp;
        const float lr = fminf(p->in[12][sidx], -1e-4f), li = p->in[13][sidx];
        const float step = expf(p->in[14][lg]);
        const float mag = expf(lr * step);
        float sn, cs; sincosf(li * step, &sn, &cs);
        const float ab_re = mag * cs, ab_im = mag * sn, den = lr * lr + li * li;
        const float f_re = ((ab_re - 1.0f) * lr + ab_im * li) / den, f_im = (ab_im * lr - (ab_re - 1.0f) * li) / den;
        const float bre = p->in[15][(size_t)sidx * NC + cc], bim = p->in[16][(size_t)sidx * NC + cc];
        BCAT[i] = f2bf(n < 64 ? f_re * bre - f_im * bim : f_re * bim + f_im * bre);
        const int c2 = (i / 128) % NC, n2 = i % 128, p2 = n2 & 63;
        const float cv = n2 < 64 ? p->in[17][((size_t)lg * NC + c2) * NP + p2] : -p->in[18][((size_t)lg * NC + c2) * NP + p2];
        CCAT[i] = f2bf(cv);
    }
}

__device__ __forceinline__ void s5_xtiles(f32x16 (&xr)[2], f32x16 (&xi)[2], const bf16x8 (&uf)[2], bf16x8 bre, bf16x8 bim) {
#pragma unroll
    for (int m = 0; m < 2; ++m) { xr[m] = MFMA32(uf[m], bre, (f32x16){}); xi[m] = MFMA32(uf[m], bim, (f32x16){}); }
    asm volatile("s_nop 15\n\ts_nop 7" : "+v"(xr[0]), "+v"(xr[1]), "+v"(xi[0]), "+v"(xi[1]));
}

__device__ __forceinline__ void st_s5_phaseA(KP p, int l, const Ctx& c) {
    const bf16_t* PROJ = (const bf16_t*)(p->ws + WS_PROJ);
    const f32x2_t* POW = (const f32x2_t*)(p->ws + WS_S5POW);
    const bf16_t* BCAT = (const bf16_t*)(p->ws + WS_S5BCAT);
    f32x2_t* SUM = (f32x2_t*)(p->ws + WS_S5SUM);
    const int lane = c.lane, c31 = lane & 31, h = lane >> 5;
    for (int item = c.gw; item < BATCH * S5_NSEG * NG; item += c.ngw) {
        const int g = item % NG, seg = (item / NG) % S5_NSEG, b = item / (NG * S5_NSEG);
        const int lg = l * NG + g;
        const size_t row0 = (size_t)b * SEQ + (size_t)seg * S5_SEGLEN;
#pragma unroll 1
        for (int pt = 0; pt < 2; ++pt) {
            const int pp = 32 * pt + c31;
            const f32x2_t* pw = POW + (size_t)lg * S5_NPOW * NP + pp;
            f32x2_t lo[4];
#pragma unroll
            for (int s = 0; s < 4; ++s) lo[s] = pw[(7 - 4 * h - s) * NP];
            const f32x2_t a8 = pw[8 * NP], a64 = pw[9 * NP];
            const bf16x8 bre = *(const bf16x8*)(BCAT + ((size_t)lg * 128 + pp) * NC + 8 * h);
            const bf16x8 bim = *(const bf16x8*)(BCAT + ((size_t)lg * 128 + 64 + pp) * NC + 8 * h);
            f32x2_t sseg = {0.f, 0.f};
            bf16x8 ufn[2];
#pragma unroll
            for (int m = 0; m < 2; ++m) ufn[m] = *(const bf16x8*)(PROJ + (row0 + 32 * m + c31) * IN_COLS + C_UB + 16 * g + 8 * h);
#pragma unroll 1
            for (int ch = 0; ch < 4; ++ch) {
                bf16x8 uf[2];
#pragma unroll
                for (int m = 0; m < 2; ++m) { uf[m] = ufn[m]; if (ch < 3) ufn[m] = *(const bf16x8*)(PROJ + (row0 + 64 * ch + 64 + 32 * m + c31) * IN_COLS + C_UB + 16 * g + 8 * h); }
                f32x16 xr[2], xi[2];
                s5_xtiles(xr, xi, uf, bre, bim);
                f32x2_t f = {1.f, 0.f}, acc = {0.f, 0.f};
#pragma unroll
                for (int gi = 7; gi >= 0; --gi) {
                    const int m = gi >> 2, q = gi & 3;
                    f32x2_t t = {0.f, 0.f};
#pragma unroll
                    for (int s = 0; s < 4; ++s) { const f32x2_t x = {xr[m][4 * q + s], xi[m][4 * q + s]}; const f32x2_t w = cmul(lo[s], x); t.x += w.x; t.y += w.y; }
                    const f32x2_t w2 = cmul(f, t); acc.x += w2.x; acc.y += w2.y;
                    f = cmul(f, a8);
                }
                { const Halves hx = halves(acc.x), hy = halves(acc.y); acc.x = hx.lo + hx.hi; acc.y = hy.lo + hy.hi; }
                const f32x2_t d = cmul(a64, sseg); sseg.x = d.x + acc.x; sseg.y = d.y + acc.y;
            }
            if (h == 0) SUM[(((size_t)b * S5_NSEG + seg) * NG + g) * NP + pp] = sseg;
        }
    }
}

constexpr int S5_HT_STR = 144, S5_HT_BYTES = 64 * S5_HT_STR;
__device__ __forceinline__ void st_s5_phaseB(KP p, int l, const Ctx& c, LAS unsigned char* lds, bool dry) {
    bf16_t* PROJ = (bf16_t*)(p->ws + WS_PROJ);
    const f32x2_t* POW = (const f32x2_t*)(p->ws + WS_S5POW); const f32x2_t* PINV = (const f32x2_t*)(p->ws + WS_S5PINV);
    const bf16_t* BCAT = (const bf16_t*)(p->ws + WS_S5BCAT); const bf16_t* CCAT = (const bf16_t*)(p->ws + WS_S5CCAT);
    const f32x2_t* SUM = (const f32x2_t*)(p->ws + WS_S5SUM);
    const int lane = c.lane, c31 = lane & 31, h = lane >> 5, i16 = lane & 15, kg = lane >> 4, qq = i16 >> 2, p4 = i16 & 3;
    LAS unsigned char* ht = lds + c.wave * S5_HT_BYTES;
    bf16x8 tdiag[2], tones;
#pragma unroll
    for (int s = 0; s < 2; ++s)
#pragma unroll
        for (int j = 0; j < 8; ++j) tdiag[s][j] = (16 * s + 8 * (j >> 2) + 4 * h + (j & 3) <= c31) ? (short)0x3F80 : (short)0;
#pragma unroll
    for (int j = 0; j < 8; ++j) tones[j] = (short)0x3F80;
    for (int item = c.gw; item < BATCH * S5_NSEG * NG; item += c.ngw) {
        const int g = item % NG, seg = (item / NG) % S5_NSEG, b = item / (NG * S5_NSEG);
        const int lg = l * NG + g;
        const size_t row0 = (size_t)b * SEQ + (size_t)seg * S5_SEGLEN;
        f32x2_t hin[2];
#pragma unroll
        for (int pt = 0; pt < 2; ++pt) {
            const int pp = 32 * pt + c31;
            const f32x2_t a256 = POW[((size_t)lg * S5_NPOW + 10) * NP + pp];
            f32x2_t H = {0.f, 0.f};
#pragma unroll
            for (int k = 0; k < S5_NSEG - 1; ++k) if (k < seg) { const f32x2_t sk = SUM[(((size_t)b * S5_NSEG + k) * NG + g) * NP + pp]; const f32x2_t d = cmul(a256, H); H.x = d.x + sk.x; H.y = d.y + sk.y; }
            hin[pt] = H;
        }
        const float dd = p->in[19][l * 512 + g * 16 + i16];
        bf16x8 ufn[2];
#pragma unroll
        for (int m = 0; m < 2; ++m) ufn[m] = *(const bf16x8*)(PROJ + (row0 + 32 * m + c31) * IN_COLS + C_UB + 16 * g + 8 * h);
#pragma unroll 1
        for (int ch = 0; ch < 4; ++ch) {
            const size_t crow0 = row0 + 64 * ch;
            bf16x8 uf[2];
#pragma unroll
            for (int m = 0; m < 2; ++m) { uf[m] = ufn[m]; if (ch < 3) ufn[m] = *(const bf16x8*)(PROJ + (crow0 + 64 + 32 * m + c31) * IN_COLS + C_UB + 16 * g + 8 * h); }
            f32x4 Y[4];
#pragma unroll
            for (int it = 0; it < 4; ++it) Y[it] = (f32x4){0.f, 0.f, 0.f, 0.f};
#pragma unroll 1
            for (int pt = 0; pt < 2; ++pt) {
                const f32x2_t hin_pt = pt ? hin[1] : hin[0];
                const int pp = 32 * pt + c31;
                const bf16x8 bre = *(const bf16x8*)(BCAT + ((size_t)lg * 128 + pp) * NC + 8 * h);
                const bf16x8 bim = *(const bf16x8*)(BCAT + ((size_t)lg * 128 + 64 + pp) * NC + 8 * h);
                const f32x2_t* pw = POW + (size_t)lg * S5_NPOW * NP + pp; const f32x2_t* pi = PINV + (size_t)lg * S5_NINV * NP + pp;
                asm volatile("" : "+v"(pw), "+v"(pi));
                f32x2_t ilo[4], plo[4];
#pragma unroll
                for (int s = 0; s < 4; ++s) { ilo[s] = pi[(4 * h + s) * NP]; plo[s] = pw[(4 * h + s) * NP]; }
                const f32x2_t ia8 = pi[8 * NP], a8 = pw[8 * NP], a1 = pw[1 * NP];
                bf16x8 cfv[2];
#pragma unroll
                for (int ks = 0; ks < 2; ++ks) cfv[ks] = *(const bf16x8*)(CCAT + ((size_t)lg * NC + i16) * 128 + 64 * ks + 32 * pt + 8 * kg);
                bf16x8 wfr[2][2], wfi[2][2];
                {
                    f32x2_t f = {1.f, 0.f};
#pragma unroll
                    for (int m = 0; m < 2; ++m) {
                        f32x16 xr = MFMA32(uf[m], bre, (f32x16){}), xi = MFMA32(uf[m], bim, (f32x16){});
                        MFMA_SETTLE2(xr, xi);
#pragma unroll
                        for (int q = 0; q < 4; ++q) {
#pragma unroll
                            for (int s = 0; s < 4; ++s) { const f32x2_t x = {xr[4 * q + s], xi[4 * q + s]}; const f32x2_t w = cmul(f, cmul(ilo[s], x)); xr[4 * q + s] = w.x; xi[4 * q + s] = w.y; }
                            f = cmul(f, ia8);
                        }
#pragma unroll
                        for (int s2 = 0; s2 < 2; ++s2) {
                            wfr[m][s2] = pack8(xr[8 * s2], xr[8 * s2 + 1], xr[8 * s2 + 2], xr[8 * s2 + 3], xr[8 * s2 + 4], xr[8 * s2 + 5], xr[8 * s2 + 6], xr[8 * s2 + 7]);
                            wfi[m][s2] = pack8(xi[8 * s2], xi[8 * s2 + 1], xi[8 * s2 + 2], xi[8 * s2 + 3], xi[8 * s2 + 4], xi[8 * s2 + 5], xi[8 * s2 + 6], xi[8 * s2 + 7]);
                        }
                        __builtin_amdgcn_sched_barrier(0);
                    }
                }
                const f32x2_t G = cmul(a1, hin_pt);
                f32x2_t hlast = {0.f, 0.f};
                WAVE_LDS_SYNC();
                {
                    f32x2_t f = {1.f, 0.f};
#pragma unroll
                    for (int m = 0; m < 2; ++m) {
                        f32x16 cr, ci;
                        if (m == 0) { cr = MFMA32(tdiag[1], wfr[0][1], MFMA32(tdiag[0], wfr[0][0], (f32x16){})); ci = MFMA32(tdiag[1], wfi[0][1], MFMA32(tdiag[0], wfi[0][0], (f32x16){})); }
                        else { cr = MFMA32(tdiag[1], wfr[1][1], MFMA32(tdiag[0], wfr[1][0], MFMA32(tones, wfr[0][1], MFMA32(tones, wfr[0][0], (f32x16){}))));
                               ci = MFMA32(tdiag[1], wfi[1][1], MFMA32(tdiag[0], wfi[1][0], MFMA32(tones, wfi[0][1], MFMA32(tones, wfi[0][0], (f32x16){})))); }
                        MFMA_SETTLE2(cr, ci);
#pragma unroll
                        for (int q = 0; q < 4; ++q) {
                            float hr[4], hi[4];
#pragma unroll
                            for (int s = 0; s < 4; ++s) { const f32x2_t v = {cr[4 * q + s] + G.x, ci[4 * q + s] + G.y}; const f32x2_t w = cmul(f, cmul(plo[s], v)); hr[s] = w.x; hi[s] = w.y; }
                            if (m == 1 && q == 3) { hlast.x = hr[3]; hlast.y = hi[3]; }
                            typedef unsigned u32x2_t __attribute__((ext_vector_type(2)));
                            u32x2_t wr_; wr_.x = cvtpk(hr[0], hr[1]); wr_.y = cvtpk(hr[2], hr[3]);
                            u32x2_t wi_; wi_.x = cvtpk(hi[0], hi[1]); wi_.y = cvtpk(hi[2], hi[3]);
                            *(LAS u32x2_t*)(ht + c31 * S5_HT_STR + (32 * m + 8 * q + 4 * h) * 2) = wr_;
                            *(LAS u32x2_t*)(ht + (32 + c31) * S5_HT_STR + (32 * m + 8 * q + 4 * h) * 2) = wi_;
                            f = cmul(f, a8);
                        }
                        __builtin_amdgcn_sched_barrier(0);
                    }
                }
                { const f32x2_t hn = {halves(hlast.x).hi, halves(hlast.y).hi}; if (pt) hin[1] = hn; else hin[0] = hn; }
                WAVE_LDS_SYNC();
#pragma unroll
                for (int ks = 0; ks < 2; ++ks) {
                    const bf16x8 cf = cfv[ks];
#pragma unroll
                    for (int it = 0; it < 4; ++it) {
                        LAS const unsigned char* ap = ht + (32 * ks + 8 * kg + qq) * S5_HT_STR + (16 * it + 4 * p4) * 2;
                        const bf16x8 af = cat8(tr_read(ap), tr_read(ap + 4 * S5_HT_STR));
                        Y[it] = MFMA16(af, cf, Y[it]);
                    }
                }
            }
            asm volatile("s_nop 15\n\ts_nop 7" : "+v"(Y[0]), "+v"(Y[1]), "+v"(Y[2]), "+v"(Y[3]));
            float uu[4][4];
#pragma unroll
            for (int it = 0; it < 4; ++it)
#pragma unroll
                for (int r = 0; r < 4; ++r) uu[it][r] = bf2f(PROJ[(crow0 + 16 * it + 4 * kg + r) * IN_COLS + C_UB + 16 * g + i16]);
#pragma unroll
            for (int it = 0; it < 4; ++it)
#pragma unroll
                for (int r = 0; r < 4; ++r) {
                    bf16_t* up = PROJ + (crow0 + 16 * it + 4 * kg + r) * IN_COLS + C_UB + 16 * g + i16;
                    const float y = Y[it][r] + dd * uu[it][r];
                    if (!dry) *up = f2bf(gelu_tanh(y));
                }
        }
        if (seg == S5_NSEG - 1 && h == 0) {
#pragma unroll
            for (int pt = 0; pt < 2; ++pt) { const size_t oi = (((size_t)l * BATCH + b) * NG + g) * NP + 32 * pt + c31; p->out[O_SRP + oi] = hin[pt].x; p->out[O_SIP + oi] = hin[pt].y; }
        }
    }
}

__device__ __forceinline__ void st_s5_sample(KP p, int l, const Ctx& c, LAS unsigned char* lds, bool dry) {
    bf16_t* PROJ = (bf16_t*)(p->ws + WS_PROJ);
    const f32x2_t* POW = (const f32x2_t*)(p->ws + WS_S5POW); const f32x2_t* PINV = (const f32x2_t*)(p->ws + WS_S5PINV);
    const bf16_t* BCAT = (const bf16_t*)(p->ws + WS_S5BCAT); const bf16_t* CCAT = (const bf16_t*)(p->ws + WS_S5CCAT);
    LAS unsigned char* ht = lds + c.wave * S5_HT_BYTES;
    for (int item = c.gw; item < (DEC_BATCH / 16) * NG; item += c.ngw) {
        int zi = 0; asm volatile("" : "+v"(zi));
        const int lane = c.lane + zi, c31 = lane & 31, h = lane >> 5, i16 = lane & 15, kg = lane >> 4, qq = i16 >> 2, p4 = i16 & 3;
        const int g = item % NG, sg = item / NG, lg = l * NG + g;
        const size_t crow0 = (size_t)M_P + 64 * sg;
        bf16x8 tds[2];
#pragma unroll
        for (int s = 0; s < 2; ++s)
#pragma unroll
            for (int j = 0; j < 8; ++j) { const int kr = 16 * s + 8 * (j >> 2) + 4 * h + (j & 3); tds[s][j] = ((kr >> 2) == (c31 >> 2) && kr <= c31) ? (short)0x3F80 : (short)0; }
        const float dd = p->in[19][l * 512 + g * 16 + i16];
        bf16x8 uf[2];
#pragma unroll
        for (int m = 0; m < 2; ++m) uf[m] = *(const bf16x8*)(PROJ + (crow0 + 32 * m + c31) * IN_COLS + C_UB + 16 * g + 8 * h);
        f32x4 Y[4];
#pragma unroll
        for (int it = 0; it < 4; ++it) Y[it] = (f32x4){0.f, 0.f, 0.f, 0.f};
#pragma unroll
        for (int pt = 0; pt < 2; ++pt) {
            const int pp = 32 * pt + c31;
            const bf16x8 bre = *(const bf16x8*)(BCAT + ((size_t)lg * 128 + pp) * NC + 8 * h);
            const bf16x8 bim = *(const bf16x8*)(BCAT + ((size_t)lg * 128 + 64 + pp) * NC + 8 * h);
            const f32x2_t* pw = POW + (size_t)lg * S5_NPOW * NP + pp; const f32x2_t* pi = PINV + (size_t)lg * S5_NINV * NP + pp;
            f32x2_t ilo[4], plo[4];
#pragma unroll
            for (int s = 0; s < 4; ++s) { ilo[s] = pi[s * NP]; plo[s] = pw[s * NP]; }
            const f32x2_t a1 = pw[1 * NP];
            WAVE_LDS_SYNC();
#pragma unroll
            for (int m = 0; m < 2; ++m) {
                f32x16 xr = MFMA32(uf[m], bre, (f32x16){}), xi = MFMA32(uf[m], bim, (f32x16){});
                MFMA_SETTLE2(xr, xi);
#pragma unroll
                for (int q = 0; q < 4; ++q)
#pragma unroll
                    for (int s = 0; s < 4; ++s) { const f32x2_t x = {xr[4 * q + s], xi[4 * q + s]}; const f32x2_t w = cmul(ilo[s], x); xr[4 * q + s] = w.x; xi[4 * q + s] = w.y; }
                bf16x8 wr0 = pack8(xr[0], xr[1], xr[2], xr[3], xr[4], xr[5], xr[6], xr[7]), wr1 = pack8(xr[8], xr[9], xr[10], xr[11], xr[12], xr[13], xr[14], xr[15]);
                bf16x8 wi0 = pack8(xi[0], xi[1], xi[2], xi[3], xi[4], xi[5], xi[6], xi[7]), wi1 = pack8(xi[8], xi[9], xi[10], xi[11], xi[12], xi[13], xi[14], xi[15]);
                f32x16 cr = MFMA32(tds[1], wr1, MFMA32(tds[0], wr0, (f32x16){})), ci = MFMA32(tds[1], wi1, MFMA32(tds[0], wi0, (f32x16){}));
                MFMA_SETTLE2(cr, ci);
#pragma unroll
                for (int q = 0; q < 4; ++q) {
                    const int seq = 16 * sg + 8 * m + 2 * q + h;
                    const size_t si = (((size_t)l * DEC_BATCH + seq) * NG + g) * NP + pp;
                    const f32x2_t G = cmul(a1, (f32x2_t){p->in[4][si], p->in[5][si]});
                    float hr[4], hi[4];
#pragma unroll
                    for (int s = 0; s < 4; ++s) { const f32x2_t v = {cr[4 * q + s] + G.x, ci[4 * q + s] + G.y}; const f32x2_t w = cmul(plo[s], v); hr[s] = w.x; hi[s] = w.y; }
                    p->out[O_SRS + si] = hr[3]; p->out[O_SIS + si] = hi[3];
                    typedef unsigned u32x2_t __attribute__((ext_vector_type(2)));
                    u32x2_t wr_; wr_.x = cvtpk(hr[0], hr[1]); wr_.y = cvtpk(hr[2], hr[3]);
                    u32x2_t wi_; wi_.x = cvtpk(hi[0], hi[1]); wi_.y = cvtpk(hi[2], hi[3]);
                    *(LAS u32x2_t*)(ht + c31 * S5_HT_STR + (32 * m + 8 * q + 4 * h) * 2) = wr_;
                    *(LAS u32x2_t*)(ht + (32 + c31) * S5_HT_STR + (32 * m + 8 * q + 4 * h) * 2) = wi_;
                }
                __builtin_amdgcn_sched_barrier(0);
            }
            WAVE_LDS_SYNC();
#pragma unroll
            for (int ks = 0; ks < 2; ++ks) {
                const bf16x8 cf = *(const bf16x8*)(CCAT + ((size_t)lg * NC + i16) * 128 + 64 * ks + 32 * pt + 8 * kg);
#pragma unroll
                for (int it = 0; it < 4; ++it) {
                    LAS const unsigned char* ap = ht + (32 * ks + 8 * kg + qq) * S5_HT_STR + (16 * it + 4 * p4) * 2;
                    const bf16x8 af = cat8(tr_read(ap), tr_read(ap + 4 * S5_HT_STR));
                    Y[it] = MFMA16(af, cf, Y[it]);
                }
            }
        }
        asm volatile("s_nop 15\n\ts_nop 7" : "+v"(Y[0]), "+v"(Y[1]), "+v"(Y[2]), "+v"(Y[3]));
        float uu[4][4];
#pragma unroll
        for (int it = 0; it < 4; ++it)
#pragma unroll
            for (int r = 0; r < 4; ++r) uu[it][r] = bf2f(PROJ[(crow0 + 16 * it + 4 * kg + r) * IN_COLS + C_UB + 16 * g + i16]);
#pragma unroll
        for (int it = 0; it < 4; ++it)
#pragma unroll
            for (int r = 0; r < 4; ++r) {
                bf16_t* up = PROJ + (crow0 + 16 * it + 4 * kg + r) * IN_COLS + C_UB + 16 * g + i16;
                const float y = Y[it][r] + dd * uu[it][r];
                if (!dry) *up = f2bf(gelu_tanh(y));
            }
    }
}

__device__ __forceinline__ void st_lru_sample(KP p, int l, const Ctx& c, LAS unsigned char* lds, bool dry) {
    bf16_t* PROJ = (bf16_t*)(p->ws + WS_PROJ);
    const bf16_t* LRUW = (const bf16_t*)(p->ws + WS_LRUW);
    for (int item = c.gw; item < (DEC_BATCH / 16) * 8; item += c.ngw) {
        int zi = 0; asm volatile("" : "+v"(zi));
        const int lane = c.lane + zi, c31 = lane & 31, h = lane >> 5;
        const int n = item & 7, sg = item >> 3;
        const size_t row0 = (size_t)M_P + 64 * sg;
        const int ch0 = n * 64;
        LAS unsigned char* xim = lds + c.wave * 9216;
        WAVE_LDS_SYNC();
#pragma unroll 1
        for (int ks = 0; ks < 4; ++ks) {
            const int chb = ch0 + 16 * ks + 8 * h;
            float w[4][8], cb[8];
#pragma unroll
            for (int j = 0; j < 4; ++j) {
                const f32x4 w0 = *(const f32x4*)(p->in[22] + (l * 4 + j) * 512 + chb), w1 = *(const f32x4*)(p->in[22] + (l * 4 + j) * 512 + chb + 4);
                w[j][0] = w0[0]; w[j][1] = w0[1]; w[j][2] = w0[2]; w[j][3] = w0[3]; w[j][4] = w1[0]; w[j][5] = w1[1]; w[j][6] = w1[2]; w[j][7] = w1[3];
            }
            { const f32x4 b0 = *(const f32x4*)(p->in[23] + l * 512 + chb), b1 = *(const f32x4*)(p->in[23] + l * 512 + chb + 4);
              cb[0] = b0[0]; cb[1] = b0[1]; cb[2] = b0[2]; cb[3] = b0[3]; cb[4] = b1[0]; cb[5] = b1[1]; cb[6] = b1[2]; cb[7] = b1[3]; }
#pragma unroll
            for (int m = 0; m < 2; ++m) {
                const int i = 32 * m + c31, t = i & 3, seq = 16 * sg + (i >> 2);
                float xf[8];
#pragma unroll
                for (int e = 0; e < 8; ++e) xf[e] = cb[e];
#pragma unroll
                for (int j = 0; j < 4; ++j) {
                    const int tau = t - 3 + j;
                    float xv[8];
                    if (tau >= 0) {
                        const u32x4 xx = *(const u32x4*)(PROJ + ((size_t)M_P + 4 * seq + tau) * IN_COLS + C_XC + chb);
#pragma unroll
                        for (int e = 0; e < 4; ++e) { xv[2 * e] = __uint_as_float(xx[e] << 16); xv[2 * e + 1] = __uint_as_float(xx[e] & 0xffff0000u); }
                    } else {
                        const float* cp = p->in[7] + (((size_t)l * DEC_BATCH + seq) * 3 + (3 + tau)) * 512 + chb;
                        const f32x4 c0 = *(const f32x4*)cp, c1 = *(const f32x4*)(cp + 4);
                        xv[0] = c0[0]; xv[1] = c0[1]; xv[2] = c0[2]; xv[3] = c0[3]; xv[4] = c1[0]; xv[5] = c1[1]; xv[6] = c1[2]; xv[7] = c1[3];
                    }
#pragma unroll
                    for (int e = 0; e < 8; ++e) xf[e] += w[j][e] * xv[e];
                }
                *(LAS bf16x8*)(xim + (32 * m + c31) * 144 + (16 * ks + 8 * h) * 2) = pack8(xf[0], xf[1], xf[2], xf[3], xf[4], xf[5], xf[6], xf[7]);
            }
        }
        WAVE_LDS_SYNC();
#pragma unroll 1
        for (int et = 0; et < 2; ++et) {
            const int ch = ch0 + 32 * et + c31;
            const float ba = p->in[25][l * 512 + ch], bx = p->in[27][l * 512 + ch];
            const float lsig8 = ((const float*)(p->ws + WS_LSIG))[l * 512 + ch];
            const bf16_t* wp = LRUW + (((size_t)(l * 8 + n) * 2) * 64 + 32 * et + c31) * 64 + 8 * h;
#pragma unroll
            for (int m = 0; m < 2; ++m) {
                f32x16 X = (f32x16){}, R = (f32x16){}, I = (f32x16){};
#pragma unroll
                for (int ks = 0; ks < 4; ++ks) {
                    const bf16x8 wa = *(const bf16x8*)(wp + 16 * ks), wx = *(const bf16x8*)(wp + 64 * 64 + 16 * ks);
                    bf16x8 id;
#pragma unroll
                    for (int j = 0; j < 8; ++j) id[j] = (16 * ks + 8 * h + j == 32 * et + c31) ? (short)0x3F80 : (short)0;
                    const bf16x8 afr = *(LAS const bf16x8*)(xim + (32 * m + c31) * 144 + (16 * ks + 8 * h) * 2);
                    R = MFMA32(afr, wa, R); I = MFMA32(afr, wx, I); X = MFMA32(afr, id, X);
                }
                MFMA_SETTLE3(R, I, X);
                float gcv[16], h0v[4];
#pragma unroll
                for (int q = 0; q < 4; ++q) {
                    const int seq = 16 * sg + 8 * m + 2 * q + h;
                    h0v[q] = p->in[6][((size_t)l * DEC_BATCH + seq) * 512 + ch];
#pragma unroll
                    for (int s = 0; s < 4; ++s) gcv[4 * q + s] = bf2f(PROJ[((size_t)M_P + 4 * seq + s) * IN_COLS + C_GC + ch]);
                }
#pragma unroll
                for (int q = 0; q < 4; ++q) {
                    const int seq = 16 * sg + 8 * m + 2 * q + h;
                    float hv = h0v[q];
#pragma unroll
                    for (int s = 0; s < 4; ++s) {
                        const int r = 4 * q + s;
                        const float rg = sigmoidf_(R[r] + ba), ig = sigmoidf_(I[r] + bx);
                        const float la = rg * lsig8;
                        const float a = __expf(la);
                        const float bg = X[r] * ig * __builtin_amdgcn_sqrtf((1.0f - a) * (1.0f + a));
                        hv = a * hv + bg;
                        bf16_t* gp = PROJ + ((size_t)M_P + 4 * seq + s) * IN_COLS + C_GC + ch;
                        const float gc = gcv[r];
                        if (!dry) *gp = f2bf(hv * siluf_(gc));
                    }
                    p->out[O_LS + ((size_t)l * DEC_BATCH + seq) * 512 + ch] = hv;
                }
                __builtin_amdgcn_sched_barrier(0);
            }
        }
    }
}

__device__ __forceinline__ void st_attn_sample(KP p, int l, LAS unsigned char* lds, bool dry, int wave_s) {
    int zv = 0; asm volatile("" : "+v"(zv));
    const int tid = tid_of(wave_s, zv), lane = tid & 63, wave = __builtin_amdgcn_readfirstlane(tid >> 6);
    const int c31 = lane & 31, h = lane >> 5;
    bf16_t* PROJ = (bf16_t*)(p->ws + WS_PROJ);
    const float* rel_bias = p->in[8];
    for (int item = blockIdx.x; item < DEC_BATCH * NKV; item += gridDim.x) {
        const int b = item >> 1, kvh = item & 1;
#pragma unroll
        for (int i = 0; i < 3; ++i) {
            const int id = tid + 512 * i, row = id >> 3, pc = id & 7;
            if (id < 160 * 8) {
                u32x4 kk = (u32x4){0u, 0u, 0u, 0u}, vv = kk;
                if (row < WINDOW) {
                    const size_t ci = ((((size_t)l * DEC_BATCH + b) * WINDOW + row) * NKV + kvh) * HD + pc * 8;
                    const f32x4 k0 = *(const f32x4*)(p->in[2] + ci), k1 = *(const f32x4*)(p->in[2] + ci + 4), v0 = *(const f32x4*)(p->in[3] + ci), v1 = *(const f32x4*)(p->in[3] + ci + 4);
                    kk.x = cvtpk(k0[0], k0[1]); kk.y = cvtpk(k0[2], k0[3]); kk.z = cvtpk(k1[0], k1[1]); kk.w = cvtpk(k1[2], k1[3]);
                    vv.x = cvtpk(v0[0], v0[1]); vv.y = cvtpk(v0[2], v0[3]); vv.z = cvtpk(v1[0], v1[1]); vv.w = cvtpk(v1[2], v1[3]);
                } else if (row < WINDOW + DEC_SEQ) {
                    const bf16_t* src = PROJ + ((size_t)M_P + 4 * b + (row - WINDOW)) * IN_COLS + kvh * 64 + pc * 8;
                    kk = *(const u32x4*)(src + C_K); vv = *(const u32x4*)(src + C_V);
                }
                *(LAS u32x4*)(lds + AT_K + row * AT_KSTR + pc * 16) = kk;
                *(LAS u32x4*)(lds + AT_V + row * AT_VSTR + pc * 16) = vv;
            }
        }
        { const int g = tid >> 7, d = tid & 127; ((LAS float*)(lds + AT_BIAS))[tid] = rel_bias[T5_BUCKET[d] * NQH + kvh * 4 + g]; }
        __syncthreads();
        if (wave == 0) {
            const int qc = c31 & 15, g = qc >> 2, iq = qc & 3, hq = kvh * 4 + g;
            const float sink = p->in[10][l * NQH + hq];
            LAS const float* biasd = (LAS const float*)(lds + AT_BIAS) + g * 128;
            LAS float* wsf = (LAS float*)(lds + AT_WS);
            bf16x8 qf[4];
            { const bf16_t* qp = PROJ + ((size_t)M_P + 4 * b + iq) * IN_COLS + C_Q + hq * 64 + 8 * h;
#pragma unroll
              for (int ks = 0; ks < 4; ++ks) qf[ks] = *(const bf16x8*)(qp + 16 * ks); }
            f32x16 S[5];
#pragma unroll
            for (int j = 0; j < 5; ++j) {
                S[j] = (f32x16){};
                LAS const unsigned char* kp = lds + AT_K + (32 * j + c31) * AT_KSTR + 16 * h;
#pragma unroll
                for (int ks = 0; ks < 4; ++ks) S[j] = MFMA32(*(LAS const bf16x8*)(kp + 32 * ks), qf[ks], S[j]);
            }
            asm volatile("s_nop 15\n\ts_nop 7" : "+v"(S[0]), "+v"(S[1]), "+v"(S[2]), "+v"(S[3]), "+v"(S[4]));
            float mx = sink;
#pragma unroll
            for (int j = 0; j < 5; ++j)
#pragma unroll
                for (int r = 0; r < 16; ++r) {
                    const int kv = 32 * j + (r & 3) + 8 * (r >> 2) + 4 * h;
                    const int dist = iq + 128 - kv;
                    const bool ok = (dist >= 0) && (dist < 128);
                    const float s = ok ? S[j][r] * 0.125f + biasd[dist & 127] : -1e30f;
                    S[j][r] = s; mx = fmaxf(mx, s);
                }
            { const Halves hh = halves(mx); mx = fmaxf(hh.lo, hh.hi); }
            float sum = 0.f;
#pragma unroll
            for (int j = 0; j < 5; ++j)
#pragma unroll
                for (int r = 0; r < 16; ++r) { const float e = S[j][r] > -1e29f ? __expf(S[j][r] - mx) : 0.f; S[j][r] = e; sum += e; }
            { const Halves hh = halves(sum); sum = hh.lo + hh.hi; }
            const float rden = 1.0f / (sum + __expf(sink - mx));
            if (h == 0) wsf[c31] = rden;
            f32x16 O[2]; O[0] = (f32x16){}; O[1] = (f32x16){};
            const int i16 = lane & 15, qq = i16 >> 2, pp = i16 & 3, blk = (lane >> 4) & 1;
#pragma unroll
            for (int j = 0; j < 5; ++j)
#pragma unroll
                for (int s = 0; s < 2; ++s) {
                    const bf16x8 pf = pack8(S[j][8 * s], S[j][8 * s + 1], S[j][8 * s + 2], S[j][8 * s + 3], S[j][8 * s + 4], S[j][8 * s + 5], S[j][8 * s + 6], S[j][8 * s + 7]);
                    LAS const unsigned char* vp = lds + AT_V + (32 * j + 16 * s + 4 * h + qq) * AT_VSTR + (16 * blk + 4 * pp) * 2;
#pragma unroll
                    for (int dt = 0; dt < 2; ++dt) {
                        const bf16x8 vf = cat8(tr_read(vp + dt * 64), tr_read(vp + dt * 64 + 8 * AT_VSTR));
                        O[dt] = MFMA32(pf, vf, O[dt]);
                    }
                }
            MFMA_SETTLE2(O[0], O[1]);
            WAVE_LDS_SYNC();
            float gav[8][2];
#pragma unroll
            for (int r = 0; r < 8; ++r) {
                const int qr = (r & 3) + 8 * (r >> 2) + 4 * h, g2 = qr >> 2, i2 = qr & 3;
                const bf16_t* rowp = PROJ + ((size_t)M_P + 4 * b + i2) * IN_COLS + (kvh * 4 + g2) * 64 + c31;
                gav[r][0] = bf2f(rowp[C_GA]); gav[r][1] = bf2f(rowp[C_GA + 32]);
            }
#pragma unroll
            for (int r = 0; r < 8; ++r) {
                const int qr = (r & 3) + 8 * (r >> 2) + 4 * h, g2 = qr >> 2, i2 = qr & 3;
                const float rd = wsf[qr];
                bf16_t* rowp = PROJ + ((size_t)M_P + 4 * b + i2) * IN_COLS + (kvh * 4 + g2) * 64 + c31;
#pragma unroll
                for (int dt = 0; dt < 2; ++dt) if (!dry) rowp[C_Q + 32 * dt] = f2bf(O[dt][r] * rd * siluf_(gav[r][dt]));
            }
        }
        __syncthreads();
    }
}

constexpr int LR_NSEG = 32;
template <bool PHASE_B>
__device__ __forceinline__ void st_lru_mfma(KP p, int l, const Ctx& c, LAS unsigned char* lds, bool dry) {
    bf16_t* PROJ = (bf16_t*)(p->ws + WS_PROJ);
    const bf16_t* LRUW = (const bf16_t*)(p->ws + WS_LRUW);
    f32x2_t* LSUM = (f32x2_t*)(p->ws + WS_LRSUM);
    for (int item = c.gw; item < BATCH * LR_NSEG * 8; item += c.ngw) {
        int zi = 0; asm volatile("" : "+v"(zi));
        const int lane = c.lane + zi, c31 = lane & 31, h = lane >> 5;
        const int n = item & 7, seg = (item >> 3) % LR_NSEG, b = item / (8 * LR_NSEG);
        const size_t row0 = (size_t)b * SEQ + (size_t)seg * 64;
        const int ch0 = n * 64;
        LAS unsigned char* xim = lds + c.wave * 9216;
        WAVE_LDS_SYNC();
#pragma unroll 2
        for (int ks = 0; ks < 4; ++ks) {
            const int chb = ch0 + 16 * ks + 8 * h;
            float w[4][8], cb[8];
#pragma unroll
            for (int j = 0; j < 4; ++j) {
                const f32x4 w0 = *(const f32x4*)(p->in[22] + (l * 4 + j) * 512 + chb), w1 = *(const f32x4*)(p->in[22] + (l * 4 + j) * 512 + chb + 4);
                w[j][0] = w0[0]; w[j][1] = w0[1]; w[j][2] = w0[2]; w[j][3] = w0[3]; w[j][4] = w1[0]; w[j][5] = w1[1]; w[j][6] = w1[2]; w[j][7] = w1[3];
            }
            { const f32x4 b0 = *(const f32x4*)(p->in[23] + l * 512 + chb), b1 = *(const f32x4*)(p->in[23] + l * 512 + chb + 4);
              cb[0] = b0[0]; cb[1] = b0[1]; cb[2] = b0[2]; cb[3] = b0[3]; cb[4] = b1[0]; cb[5] = b1[1]; cb[6] = b1[2]; cb[7] = b1[3]; }
            u32x4 xx4[2][4];
#pragma unroll
            for (int m = 0; m < 2; ++m)
#pragma unroll
                for (int j = 0; j < 4; ++j) { const int t = seg * 64 + 32 * m + c31; const int dr = (t - 3 + j >= 0) ? (32 * m + c31 - 3 + j) : 0; xx4[m][j] = *(const u32x4*)(PROJ + (row0 + dr) * IN_COLS + C_XC + chb); }
#pragma unroll
            for (int m = 0; m < 2; ++m) {
                const int t = seg * 64 + 32 * m + c31;
                float xf[8];
#pragma unroll
                for (int e = 0; e < 8; ++e) xf[e] = cb[e];
#pragma unroll
                for (int j = 0; j < 4; ++j) {
                    const u32x4 xx = (t - 3 + j >= 0) ? xx4[m][j] : (u32x4){0u, 0u, 0u, 0u};
#pragma unroll
                    for (int e = 0; e < 4; ++e) { xf[2 * e] += w[j][2 * e] * __uint_as_float(xx[e] << 16); xf[2 * e + 1] += w[j][2 * e + 1] * __uint_as_float(xx[e] & 0xffff0000u); }
                }
                *(LAS bf16x8*)(xim + (32 * m + c31) * 144 + (16 * ks + 8 * h) * 2) = pack8(xf[0], xf[1], xf[2], xf[3], xf[4], xf[5], xf[6], xf[7]);
            }
        }
        WAVE_LDS_SYNC();
#pragma unroll 1
        for (int et = 0; et < 2; ++et) {
            const int ch = ch0 + 32 * et + c31;
            const float ba = -1.4426950408889634f * p->in[25][l * 512 + ch], bx = -1.4426950408889634f * p->in[27][l * 512 + ch];
            const float lsig8 = 1.4426950408889634f * ((const float*)(p->ws + WS_LSIG))[l * 512 + ch];
            const bf16_t* wp = LRUW + (((size_t)(l * 8 + n) * 2) * 64 + 32 * et + c31) * 64 + 8 * h;
            f32x16 R[2], I[2];
            float Ar[8], Br[8];
            __builtin_amdgcn_sched_barrier(0);
            bf16x8 waf[4], wxf[4];
#pragma unroll
            for (int ks = 0; ks < 4; ++ks) { waf[ks] = *(const bf16x8*)(wp + 16 * ks); wxf[ks] = *(const bf16x8*)(wp + 64 * 64 + 16 * ks); }
#pragma unroll
            for (int m = 0; m < 2; ++m) {
                f32x16 X = (f32x16){}; R[m] = (f32x16){}; I[m] = (f32x16){};
#pragma unroll
                for (int ks = 0; ks < 4; ++ks) {
                    bf16x8 id;
#pragma unroll
                    for (int j = 0; j < 8; ++j) id[j] = (16 * ks + 8 * h + j == 32 * et + c31) ? (short)0x3F80 : (short)0;
                    const bf16x8 afr = *(LAS const bf16x8*)(xim + (32 * m + c31) * 144 + (16 * ks + 8 * h) * 2);
                    R[m] = MFMA32(afr, waf[ks], R[m]); I[m] = MFMA32(afr, wxf[ks], I[m]); X = MFMA32(afr, id, X);
                }
                MFMA_SETTLE3(R[m], I[m], X);
#pragma unroll
                for (int q = 0; q < 4; ++q) {
                    float cp = 1.f, hl = 0.f;
#pragma unroll
                    for (int s = 0; s < 4; ++s) {
                        const int r = 4 * q + s;
                        const float rg = __builtin_amdgcn_rcpf(1.0f + __builtin_amdgcn_exp2f(__builtin_fmaf(R[m][r], -1.4426950408889634f, ba)));
                        const float ig = __builtin_amdgcn_rcpf(1.0f + __builtin_amdgcn_exp2f(__builtin_fmaf(I[m][r], -1.4426950408889634f, bx)));
                        const float a = __builtin_amdgcn_exp2f(rg * lsig8);
                        const float bg = X[r] * ig * __builtin_amdgcn_sqrtf((1.0f - a) * (1.0f + a));
                        cp *= a; hl = a * hl + bg;
                        R[m][r] = cp; I[m][r] = hl;
                    }
                    Ar[4 * m + q] = cp; Br[4 * m + q] = hl;
                }
                __builtin_amdgcn_sched_barrier(0);
            }
            float Hc = 0.f;
            if (PHASE_B) {
                for (int k0 = 0; k0 < seg; k0 += 16) {
                    f32x2_t ab[16];
#pragma unroll
                    for (int j = 0; j < 16; ++j) ab[j] = (k0 + j < seg) ? LSUM[((size_t)b * LR_NSEG + k0 + j) * 512 + ch] : (f32x2_t){1.f, 0.f};
#pragma unroll
                    for (int j = 0; j < 16; ++j) Hc = ab[j].x * Hc + ab[j].y;
                }
            }
            float st = Hc, At = 1.f, cin[8];
#pragma unroll
            for (int gi = 0; gi < 8; ++gi) {
                const Halves ha = halves(Ar[gi]), hb = halves(Br[gi]);
                const float A0 = ha.lo, B0 = hb.lo, A1 = ha.hi, B1 = hb.hi;
                const float s1 = A0 * st + B0;
                cin[gi] = h == 0 ? st : s1;
                st = A1 * s1 + B1; At *= A0 * A1;
            }
            if (!PHASE_B) {
                if (h == 0) LSUM[((size_t)b * LR_NSEG + seg) * 512 + ch] = (f32x2_t){At, st};
            } else {
#pragma unroll
                for (int m = 0; m < 2; ++m) {
                    float gcv[16];
#pragma unroll
                    for (int r = 0; r < 16; ++r) gcv[r] = bf2f(PROJ[(row0 + 32 * m + (r & 3) + 8 * (r >> 2) + 4 * h) * IN_COLS + C_GC + ch]);
#pragma unroll
                    for (int r = 0; r < 16; ++r) {
                        const float hv = I[m][r] + R[m][r] * cin[4 * m + (r >> 2)];
                        bf16_t* gp = PROJ + (row0 + 32 * m + (r & 3) + 8 * (r >> 2) + 4 * h) * IN_COLS + C_GC + ch;
                        const float gc = gcv[r];
                        if (!dry) *gp = f2bf(hv * siluf_(gc));
                        if (m == 1 && r == 15 && h == 1 && seg == LR_NSEG - 1) p->out[O_LP + ((size_t)l * BATCH + b) * 512 + ch] = hv;
                    }
                }
            }
        }
    }
}

__device__ __forceinline__ bf16_t* pre_row(unsigned char* ws, int r) { return (bf16_t*)(ws + WS_PROJ + (size_t)r * IN_COLS * 2 + (size_t)(C_GM + 1024) * 2); }
__device__ __forceinline__ void st_ln(KP p, int l, const Ctx& c) {
    const int lane = c.lane;
    const float* g = p->in[31] + l * 1024; const float* bb = p->in[32] + l * 1024;
    f32x4 gv[4], bv[4];
#pragma unroll
    for (int j = 0; j < 4; ++j) { const int cc = 512 * (j >> 1) + 8 * lane + 4 * (j & 1); gv[j] = *(const f32x4*)(g + cc); bv[j] = *(const f32x4*)(bb + cc); }
    constexpr int NR = 4;
    u32x4 cur[NR][2], nxt[NR][2];
#define LN_LOAD(dst, rb) do { _Pragma("unroll") for (int k = 0; k < NR; ++k) { const int r_ = (rb) + k < M_TOT ? (rb) + k : M_TOT - 1; const bf16_t* pr = pre_row(p->ws, r_); \
        dst[k][0] = *(const u32x4*)(pr + 8 * lane); dst[k][1] = *(const u32x4*)(pr + 512 + 8 * lane); } } while (0)
    int r0 = c.gw * NR;
    if (r0 < M_TOT) LN_LOAD(cur, r0);
    for (; r0 < M_TOT; r0 += c.ngw * NR) {
        const int rn = r0 + c.ngw * NR;
        if (rn < M_TOT) LN_LOAD(nxt, rn);
#pragma unroll
        for (int k = 0; k < NR; ++k) {
            const int r = r0 + k;
            f32x4 v[4];
#pragma unroll
            for (int q = 0; q < 2; ++q) { const u32x4 w = cur[k][q]; v[2 * q] = (f32x4){pg8::bflo(w.x), pg8::bfhi(w.x), pg8::bflo(w.y), pg8::bfhi(w.y)}; v[2 * q + 1] = (f32x4){pg8::bflo(w.z), pg8::bfhi(w.z), pg8::bflo(w.w), pg8::bfhi(w.w)}; }
            float s = 0.f;
#pragma unroll
            for (int j = 0; j < 4; ++j) s += (v[j][0] + v[j][1]) + (v[j][2] + v[j][3]);
            s = wave_sum(s);
            const float mu = s * (1.0f / 1024.0f);
            float q2 = 0.f;
#pragma unroll
            for (int j = 0; j < 4; ++j) { const f32x4 d = v[j] - mu; q2 += (d[0] * d[0] + d[1] * d[1]) + (d[2] * d[2] + d[3] * d[3]); }
            q2 = wave_sum(q2);
            const float rstd = rsqrtf(q2 * (1.0f / 1024.0f) + LN_EPS);
            if (r < M_TOT) {
#pragma unroll
                for (int q = 0; q < 2; ++q) {
                    const f32x4 y0 = (v[2 * q] - mu) * rstd * gv[2 * q] + bv[2 * q], y1 = (v[2 * q + 1] - mu) * rstd * gv[2 * q + 1] + bv[2 * q + 1];
                    const int cc = 512 * q + 8 * lane;
                    if (l == 0) { u32x4 o; o.x = cvtpk(y0[0], y0[1]); o.y = cvtpk(y0[2], y0[3]); o.z = cvtpk(y1[0], y1[1]); o.w = cvtpk(y1[2], y1[3]);
                                  *(u32x4*)((bf16_t*)(p->ws + WS_XB) + (size_t)r * D_MODEL + cc) = o; }
                    else { float* yo = (r < M_P ? p->out + O_YP + (size_t)r * D_MODEL : p->out + O_YS + (size_t)(r - M_P) * D_MODEL) + cc; *(f32x4*)yo = y0; *(f32x4*)(yo + 4) = y1; }
                }
            }
        }
#pragma unroll
        for (int k = 0; k < NR; ++k) { cur[k][0] = nxt[k][0]; cur[k][1] = nxt[k][1]; }
    }
#undef LN_LOAD
}

template <int NBR, int NS  , class Epi>
__device__ __forceinline__ void piece_gemm(LAS unsigned char* lds, const bf16_t* A0, const bf16_t* A1, const bf16_t* A2, int lda, const bf16_t* Bt, int ldb, int kboff, int row0, int col0, const Epi& epi, int wave_s) {
    int zv = 0; asm volatile("" : "+v"(zv));
    const int tid = tid_of(wave_s, zv), lane = tid & 63, wave = __builtin_amdgcn_readfirstlane(tid >> 6), c31 = lane & 31, h = lane >> 5;
    LAS float* part = (LAS float*)lds;
    float outv[NBR][4];
    constexpr int kw = 16 * NS;
    bf16x8 a[NBR][NS], b0[NBR][NS], b1[NBR][NS];
#pragma unroll
    for (int br = 0; br < NBR; ++br) {
        const bf16_t* A = br == 0 ? A0 : (br == 1 ? A1 : A2);
        const bf16_t* ap = A + (size_t)(row0 + c31) * lda + wave * kw + 8 * h;
        const bf16_t* bp = Bt + (size_t)(col0 + c31) * ldb + br * kboff + wave * kw + 8 * h;
#pragma unroll
        for (int s = 0; s < NS; ++s) { a[br][s] = *(const bf16x8*)(ap + 16 * s); b0[br][s] = *(const bf16x8*)(bp + 16 * s); b1[br][s] = *(const bf16x8*)(bp + (size_t)32 * ldb + 16 * s); }
    }
    typename Epi::Pre pre[4];
#pragma unroll
    for (int e = 0; e < 4; ++e) {
        const int idx = tid + 512 * e, nt = idx >> 10, r = (idx >> 6) & 15, ln = idx & 63;
        pre[e] = epi.load(row0 + (r & 3) + 8 * (r >> 2) + 4 * (ln >> 5), col0 + 32 * nt + (ln & 31));
    }
    __builtin_amdgcn_sched_barrier(0);
#pragma unroll
    for (int br = 0; br < NBR; ++br) {
        f32x16 acc0 = (f32x16){}, acc1 = (f32x16){};
#pragma unroll
        for (int s = 0; s < NS; ++s) { acc0 = MFMA32(a[br][s], b0[br][s], acc0); acc1 = MFMA32(a[br][s], b1[br][s], acc1); }
        MFMA_SETTLE2(acc0, acc1);
        __syncthreads();
#pragma unroll
        for (int r = 0; r < 16; ++r) { part[((wave * 2 + 0) * 16 + r) * 64 + lane] = acc0[r]; part[((wave * 2 + 1) * 16 + r) * 64 + lane] = acc1[r]; }
        __syncthreads();
#pragma unroll
        for (int e = 0; e < 4; ++e) {
            const int idx = tid + 512 * e;
            float s = 0.f;
#pragma unroll
            for (int w = 0; w < 8; ++w) s += part[w * 2048 + idx];
            outv[br][e] = s;
        }
    }
#pragma unroll
    for (int e = 0; e < 4; ++e) {
        const int idx = tid + 512 * e, nt = idx >> 10, r = (idx >> 6) & 15, ln = idx & 63;
        const int row = row0 + (r & 3) + 8 * (r >> 2) + 4 * (ln >> 5), col = col0 + 32 * nt + (ln & 31);
        float v[NBR];
#pragma unroll
        for (int br = 0; br < NBR; ++br) v[br] = outv[br][e];
        epi.store(row, col, pre[e], v);
    }
    __syncthreads();
}
struct PEpiGlu { bf16_t* PROJ; bool dry; struct Pre { bf16_t z, g; };
    __device__ __forceinline__ Pre load(int r, int c) const { const bf16_t* rp = PROJ + (size_t)r * IN_COLS; return Pre{rp[C_UB + c], rp[C_GB + c]}; }
    __device__ __forceinline__ void store(int r, int c, const Pre& q, const float (&v)[1]) const {
        if (!dry) PROJ[(size_t)r * IN_COLS + C_GB + c] = f2bf(bf2f(q.z) * sigmoidf_(v[0]) * siluf_(bf2f(q.g))); } };
struct PEpiBranch { bf16_t* PROJ; bool dry; struct Pre { bf16_t g0, g1, g2; };
    __device__ __forceinline__ Pre load(int r, int c) const { const bf16_t* gp = PROJ + (size_t)r * IN_COLS + C_GM + c; return Pre{gp[0], gp[1024], gp[2048]}; }
    __device__ __forceinline__ void store(int r, int c, const Pre& q, const float (&v)[3]) const {
        const float m = __builtin_amdgcn_rcpf(bf2f(q.g0)) * v[0] + __builtin_amdgcn_rcpf(bf2f(q.g1)) * v[1] + __builtin_amdgcn_rcpf(bf2f(q.g2)) * v[2];
        if (!dry) PROJ[(size_t)r * IN_COLS + C_GM + c] = f2bf(m); } };
struct PEpiOut { KP p; int l; struct Pre { float x; };
    __device__ __forceinline__ Pre load(int r, int c) const {
        return Pre{bf2f(((const bf16_t*)(p->ws + WS_XB))[(size_t)r * D_MODEL + c])}; }
    __device__ __forceinline__ void store(int r, int c, const Pre& q, const float (&v)[1]) const { pre_row(p->ws, r)[c] = f2bf(DN_ALPHA * q.x + v[0]); } };

#ifndef TSEL
#define TSEL 0
#endif
#define TS_BEGIN(K) do { if (TSEL == (K) && blockIdx.x == 0 && wave_s == 0 && lane_id() == 0) *(volatile LAS unsigned long long*)(lds + LDS_MISC + 128) = __builtin_amdgcn_s_memrealtime(); } while (0)
#define TS_END(K) do { if (TSEL == (K) && blockIdx.x == 0 && wave_s == 0 && lane_id() == 0) *(volatile LAS unsigned long long*)(lds + LDS_MISC + 136) += __builtin_amdgcn_s_memrealtime() - *(volatile LAS unsigned long long*)(lds + LDS_MISC + 128); } while (0)
__global__ void __launch_bounds__(NTHREADS, 2) mega_fwd(P p_unused) {
    extern __shared__ __attribute__((aligned(16))) unsigned char lds_raw[];
    LAS unsigned char* lds = (LAS unsigned char*)lds_raw;
    volatile LAS unsigned* misc = (volatile LAS unsigned*)(lds + LDS_MISC);
    const int wave_s = __builtin_amdgcn_readfirstlane((int)threadIdx.x >> 6);
    if (wave_s == 0) misc[lane_id()] = 0u;
    __syncthreads();
    XcdBarrier bar;
    { KP p = get_kp(); bar = xcd_barrier_post((unsigned*)(p->ws + WS_CTL), misc, wave_s); }
    TS_BEGIN(100);

    { KP p = get_kp(); const Ctx c = make_ctx(wave_s); unsigned char* dob = (unsigned char*)p->out;
      st_convert_x(p, c);
      st_prologue_weights(p, c, (LAS float*)(lds + c.wave * 9216), 0, 16 * 200);
      st_s5_tables2(p, c);
      for (size_t i = c.gt; i < (size_t)DEPTH * 512; i += c.ngt) ((float*)(p->ws + WS_LSIG))[i] = -8.0f * log1pf(expf(-p->in[28][i]));
      { bf16_t* LRUW = (bf16_t*)(p->ws + WS_LRUW);
        for (size_t i = c.gt; i < (size_t)DEPTH * 8 * 2 * 64 * 64; i += c.ngt) {
            const int d = (int)(i & 63), e = (int)((i >> 6) & 63), mat = (int)((i >> 12) & 1), ln = (int)(i >> 13);
            LRUW[i] = f2bf(p->in[mat ? 26 : 24][((size_t)ln * 64 + d) * 64 + e]); } } }
    xcd_barrier(bar);
    TS_END(100);

#ifndef PROBE
#define PROBE 0
#endif
#define PROBE_RUN(K, BODY) do { if (PROBE == (K)) { int d_ = 1; asm volatile("" : "+s"(d_)); const bool dry = d_ != 0; BODY; __syncthreads(); } { const bool dry = false; BODY; } } while (0)
#define PH_P1 { KP p = get_kp(); int zs = 0; asm volatile("" : "+s"(zs)); (void)dry; \
          pg8::Gemm g{(const bf16_t*)(p->ws + WS_XB), D_MODEL, (const bf16_t*)((unsigned char*)p->out + DO_WIN) + (size_t)l * IN_COLS * 1024, 1024}; \
          pg8::StaticOrder S; S.init(M_TOT, IN_COLS, (int)gridDim.x + zs, (int)blockIdx.x + zs); \
          pg8::gemm_phase<pg8::EpiProjB, pg8::StaticOrder, true, true>(lds, g, S, pg8::EpiProjB{(bf16_t*)(p->ws + WS_PROJ), IN_COLS}, wave_s); \
          if (l == 0) {   \
              const int nb_ = (int)gridDim.x + zs, bid_ = (int)blockIdx.x + zs, short_ = ((M_TOT / 256) * (IN_COLS / 256)) % nb_; \
              if (short_ == 0 || bid_ >= short_) { const Ctx c = make_ctx(wave_s); Ctx gq = c; const int sz_ = short_ == 0 ? nb_ : nb_ - short_, rk_ = short_ == 0 ? bid_ : bid_ - short_; \
                  gq.gw = c.wave * sz_ + rk_; gq.ngw = NWAVES * sz_; st_prologue_weights(p, gq, (LAS float*)(lds + c.wave * 9216), 16 * 200, -1); } } }
#define PH_SAMPLE { KP p = get_kp(); const Ctx c = make_ctx(wave_s); if (wave_s == 5) { const Ctx g = waveset_ctx(c, 0, 1); st_s5_sample(p, l, g, lds, dry); st_lru_sample(p, l, g, lds, dry); } }
#define PH_SUMM { KP p = get_kp(); const Ctx c = make_ctx(wave_s); (void)dry; \
          if (wave_s < 2 || wave_s == 4) st_s5_phaseA(p, l, waveset_ctx(c, wave_s == 4 ? 2 : wave_s, 3)); \
          if (wave_s == 2 || wave_s == 3 || wave_s >= 6) st_lru_mfma<false>(p, l, waveset_ctx(c, wave_s >= 6 ? wave_s - 4 : wave_s - 2, 4), lds, false); }
#define PH_ATTN { __syncthreads(); KP p = get_kp(); st_attn_prompt(p, l, lds, dry, wave_s); st_attn_sample(p, l, lds, dry, wave_s); }
#define PH_P3 { KP p = get_kp(); const Ctx c = make_ctx(wave_s); unsigned* ctl_ = (unsigned*)(p->ws + WS_CTL); \
          volatile LAS unsigned* ms_ = (volatile LAS unsigned*)(lds + LDS_MISC + 160); \
          if (wave_s == 0 && c.lane == 0) { const unsigned x_ = xb_xcc_id(); unsigned ne_ = 0, no_ = 0; \
              for (unsigned j = 0; j < 16; ++j) { const unsigned cj = xb_ld(&ctl_[XB_XCNT(j)]); if (j & 1) no_ += cj; else ne_ += cj; } \
              const unsigned role_ = x_ & 1u, both_ = (ne_ == 0u || no_ == 0u) ? 1u : 0u; \
              const unsigned rank_ = both_ ? (unsigned)(c.gw - c.wave * (c.ngw / NWAVES)) : xb_add(&ctl_[4096 + 64 * (2 * l + (int)role_)], 1u); \
              ms_[0] = both_ ? 2u : role_; ms_[1] = rank_; ms_[2] = both_ ? (unsigned)(c.ngw / NWAVES) : (role_ ? no_ : ne_); } \
          __syncthreads(); \
          const unsigned role_ = ms_[0]; Ctx g = c; g.gw = c.wave * (int)ms_[2] + (int)ms_[1]; g.ngw = NWAVES * (int)ms_[2]; \
          if (role_ == 0u || role_ == 2u) st_s5_phaseB(p, l, g, lds, dry); \
          if (role_ == 1u || role_ == 2u) st_lru_mfma<true>(p, l, g, lds, dry); }
#define PH_GLU { KP p = get_kp(); int zs = 0; asm volatile("" : "+s"(zs)); bf16_t* PROJ = (bf16_t*)(p->ws + WS_PROJ); \
          pg8::Gemm g{PROJ + C_UB, IN_COLS, (const bf16_t*)((unsigned char*)p->out + DO_WGLU) + (size_t)l * 512 * 512, 512}; \
          pg8::StaticOrder S; S.init(M_P, 512, (int)gridDim.x + zs, (int)blockIdx.x + zs); \
          pg8::gemm_phase<pg8::EpiGluB, pg8::StaticOrder, true, true>(lds, g, S, pg8::EpiGluB{PROJ, dry}, wave_s); \
          const int nb_ = (int)gridDim.x + zs, bid_ = (int)blockIdx.x + zs; \
          if (bid_ >= nb_ / 2) { const Ctx c = make_ctx(wave_s); Ctx g = c; g.gt = (size_t)(bid_ - nb_ / 2) * NTHREADS + c.tid; g.ngt = (size_t)(nb_ - nb_ / 2) * NTHREADS; st_kv_out(p, l, g); }   \
          for (int pc = nb_ - 1 - bid_; pc < 16 * 8; pc += nb_)   \
              piece_gemm<1, 4>(lds, PROJ + C_UB, nullptr, nullptr, IN_COLS, g.Bt, 512, 0, M_P + 32 * (pc >> 3), 64 * (pc & 7), PEpiGlu{PROJ, dry}, wave_s); }
#define PH_BRANCH { KP p = get_kp(); int zs = 0; asm volatile("" : "+s"(zs)); bf16_t* PROJ = (bf16_t*)(p->ws + WS_PROJ); \
          pg8::Gemm g{PROJ + C_Q, IN_COLS, (const bf16_t*)((unsigned char*)p->out + DO_WBR) + (size_t)l * 1024 * 1536, 1536}; \
          pg8::StaticOrder S; S.init(M_P, 1024, (int)gridDim.x + zs, (int)blockIdx.x + zs); \
          pg8::gemm_phase<pg8::EpiMergeB, pg8::StaticOrder, true, true>(lds, g, S, pg8::EpiMergeB{PROJ, dry}, wave_s); \
          const int nb_ = (int)gridDim.x + zs, bid_ = (int)blockIdx.x + zs; \
          for (int pc = bid_; pc < 16 * 16; pc += nb_) \
              piece_gemm<3, 4>(lds, PROJ + C_Q, PROJ + C_GB, PROJ + C_GC, IN_COLS, g.Bt, 1536, 512, M_P + 32 * (pc >> 4), 64 * (pc & 15), PEpiBranch{PROJ, dry}, wave_s); }
#define PH_OUT { KP p = get_kp(); int zs = 0; asm volatile("" : "+s"(zs)); bf16_t* PROJ = (bf16_t*)(p->ws + WS_PROJ); (void)dry; \
          pg8::Gemm g{PROJ + C_GM, IN_COLS, (const bf16_t*)(p->ws + WS_WOUT) + (size_t)l * 1024 * 1024, 1024}; \
          pg8::StaticOrder S; S.init(M_P, 1024, (int)gridDim.x + zs, (int)blockIdx.x + zs); \
          pg8::gemm_phase<pg8::EpiOutB, pg8::StaticOrder, true, true>(lds, g, S, pg8::EpiOutB{(const bf16_t*)(p->ws + WS_XB), p->ws}, wave_s); \
          const int nb_ = (int)gridDim.x + zs, bid_ = (int)blockIdx.x + zs; \
          for (int pc = bid_; pc < 16 * 16; pc += nb_) \
              piece_gemm<1, 8>(lds, PROJ + C_GM, nullptr, nullptr, IN_COLS, g.Bt, 1024, 0, M_P + 32 * (pc >> 4), 64 * (pc & 15), PEpiOut{p, l}, wave_s); }
#define PH_LN { KP p = get_kp(); const Ctx c = make_ctx(wave_s); (void)dry; st_ln(p, l, c); }
    for (int l = 0; l < DEPTH; ++l) {
        TS_BEGIN(1); PROBE_RUN(1, PH_P1);
        xcd_barrier(bar); TS_END(1);
#if TSEL >= 20
        TS_BEGIN(21); PROBE_RUN(2, PH_SAMPLE); xcd_barrier(bar); TS_END(21);
        TS_BEGIN(22); PROBE_RUN(3, PH_SUMM); xcd_barrier(bar); TS_END(22);
        TS_BEGIN(23); PROBE_RUN(4, PH_ATTN); xcd_barrier(bar); TS_END(23);
        { const bool dry = false; PH_P3; } xcd_barrier(bar);
#else
        TS_BEGIN(2); PROBE_RUN(2, PH_SAMPLE);
        PROBE_RUN(3, PH_SUMM);
        PROBE_RUN(4, PH_ATTN);
        xcd_barrier(bar); TS_END(2);
        TS_BEGIN(3); { const bool dry = false; PH_P3; }
        xcd_barrier(bar); TS_END(3);
#endif
        TS_BEGIN(4); PROBE_RUN(7, PH_GLU);
        xcd_barrier(bar); TS_END(4);
        TS_BEGIN(5); PROBE_RUN(8, PH_BRANCH);
        xcd_barrier(bar); TS_END(5);
        TS_BEGIN(6); PROBE_RUN(9, PH_OUT);
        xcd_barrier(bar); TS_END(6);
        TS_BEGIN(7); PROBE_RUN(10, PH_LN);
        if (l + 1 < DEPTH) xcd_barrier(bar);
        TS_END(7);
    }
    if (TSEL != 0 && blockIdx.x == 0 && wave_s == 0 && lane_id() == 0) { const unsigned long long te = __builtin_amdgcn_s_memrealtime(), ts_acc = *(volatile LAS unsigned long long*)(lds + LDS_MISC + 136); while (__builtin_amdgcn_s_memrealtime() - te < ts_acc) __builtin_amdgcn_s_sleep(4); }
}

extern "C" void kernel_launch(void* const* d_in, const int* in_sizes, int n_in, void* d_out, int out_size, void* d_ws, size_t ws_size, hipStream_t stream) {
    static int grid = 0;
    if (grid == 0) {
        if (n_in != 33 || (size_t)out_size != O_END || ws_size < WS_CTL + CTL_BYTES) { fprintf(stderr, "kernel_launch: unexpected sizes n_in %d out %d ws %zu\n", n_in, out_size, ws_size); grid = -1; return; }
        int dev = 0, cus = 0, per_cu = 0;
        if (hipGetDevice(&dev) != hipSuccess || hipDeviceGetAttribute(&cus, hipDeviceAttributeMultiprocessorCount, dev) != hipSuccess) { grid = -1; return; }
        if (hipFuncSetAttribute((const void*)mega_fwd, hipFuncAttributeMaxDynamicSharedMemorySize, LDS_BYTES) != hipSuccess) { fprintf(stderr, "kernel_launch: hipFuncSetAttribute failed\n"); grid = -1; return; }
        if (hipOccupancyMaxActiveBlocksPerMultiprocessor(&per_cu, (const void*)mega_fwd, NTHREADS, LDS_BYTES) != hipSuccess || per_cu < 1) { fprintf(stderr, "kernel_launch: occupancy query says %d blocks/CU\n", per_cu); grid = -1; return; }
        grid = cus;
    }
    if (grid < 0) return;
    (void)hipMemsetAsync((unsigned char*)d_ws + WS_CTL, 0, CTL_BYTES, stream);
    P p{};
    for (int i = 0; i < 33; ++i) p.in[i] = (const float*)d_in[i];
    p.out = (float*)d_out; p.ws = (unsigned char*)d_ws;
    void* args[] = {&p};
    hipError_t e = hipLaunchCooperativeKernel((const void*)mega_fwd, dim3(grid), dim3(NTHREADS), args, LDS_BYTES, stream);
    if (e != hipSuccess) fprintf(stderr, "kernel_launch: cooperative launch failed: %s (grid %d)\n", hipGetErrorString(e), grid);
}
```

```cpp
#include <hip/hip_runtime.h>
#include <cstdint>
#include <cstdio>

typedef unsigned short bf16_t;
typedef short bf16x8 __attribute__((ext_vector_type(8)));
typedef float f32x16 __attribute__((ext_vector_type(16)));
typedef float f32x4 __attribute__((ext_vector_type(4)));

constexpr int D_MODEL = 1024, BATCH = 8, SEQ = 2048, DEPTH = 2, DEC_BATCH = 128, DEC_SEQ = 4;
constexpr int M_P = BATCH * SEQ;
constexpr int M_S = DEC_BATCH * DEC_SEQ;
constexpr int M_TOT = M_P + M_S;
constexpr int IN_COLS = 6400;
constexpr int C_Q = 0, C_GB = 512, C_GC = 1024, C_K = 1536, C_V = 1664, C_GA = 1792, C_UB = 2304, C_XC = 2816, C_GM = 3328;
__host__ __device__ constexpr int colperm32(int n0) {
    return n0 < 512 ? n0 : n0 < 640 ? C_K + (n0 - 512) : n0 < 768 ? C_V + (n0 - 640) : n0 < 1280 ? C_GA + (n0 - 768) : n0 < 1792 ? C_UB + (n0 - 1280)
         : n0 < 2304 ? C_GB + (n0 - 1792) : n0 < 2816 ? C_XC + (n0 - 2304) : n0 < 3328 ? C_GC + (n0 - 2816) : n0; }
constexpr int WINDOW = 128, NKV = 2, HD = 64, NQH = 8;
constexpr int NG = 32, NP = 64, NC = 16;
constexpr float DN_ALPHA = 1.4142135623730951f;
constexpr float LN_EPS = 1e-5f;

constexpr size_t O_YP = 0;
constexpr size_t O_YS = O_YP + (size_t)M_P * D_MODEL;
constexpr size_t O_KP = O_YS + (size_t)M_S * D_MODEL;
constexpr size_t SZ_KP = (size_t)DEPTH * BATCH * WINDOW * NKV * HD;
constexpr size_t O_VP = O_KP + SZ_KP;
constexpr size_t O_SRP = O_VP + SZ_KP;
constexpr size_t SZ_SP = (size_t)DEPTH * BATCH * NG * NP;
constexpr size_t O_SIP = O_SRP + SZ_SP;
constexpr size_t O_LP = O_SIP + SZ_SP;
constexpr size_t SZ_LP = (size_t)DEPTH * BATCH * 512;
constexpr size_t O_CP = O_LP + SZ_LP;
constexpr size_t SZ_CP = (size_t)DEPTH * BATCH * 3 * 512;
constexpr size_t O_KS = O_CP + SZ_CP;
constexpr size_t SZ_KS = (size_t)DEPTH * DEC_BATCH * WINDOW * NKV * HD;
constexpr size_t O_VS = O_KS + SZ_KS;
constexpr size_t O_SRS = O_VS + SZ_KS;
constexpr size_t SZ_SS = (size_t)DEPTH * DEC_BATCH * NG * NP;
constexpr size_t O_SIS = O_SRS + SZ_SS;
constexpr size_t O_LS = O_SIS + SZ_SS;
constexpr size_t SZ_LS = (size_t)DEPTH * DEC_BATCH * 512;
constexpr size_t O_CS = O_LS + SZ_LS;
constexpr size_t SZ_CS = (size_t)DEPTH * DEC_BATCH * 3 * 512;
constexpr size_t O_END = O_CS + SZ_CS;

constexpr size_t WS_PROJ = 0;
constexpr size_t WS_XB = WS_PROJ + (size_t)M_TOT * IN_COLS * 2;
constexpr size_t WS_WOUT = WS_XB + (size_t)M_TOT * D_MODEL * 2;
constexpr size_t WS_TAB = WS_WOUT + (size_t)DEPTH * 1024 * 1024 * 2;
constexpr size_t TAB_AB = 0;
constexpr size_t TAB_BB = TAB_AB + (size_t)DEPTH * NG * NP * 2 * 4;
constexpr size_t TAB_BYTES = TAB_BB + (size_t)DEPTH * NG * NP * NC * 2 * 4;
constexpr size_t WS_S5POW = WS_TAB + TAB_BYTES;
constexpr size_t WS_S5PINV = WS_S5POW + (size_t)DEPTH * NG * 11 * NP * 8;
constexpr size_t WS_S5BCAT = WS_S5PINV + (size_t)DEPTH * NG * 9 * NP * 8;
constexpr size_t WS_S5CCAT = WS_S5BCAT + (size_t)DEPTH * NG * 128 * NC * 2;
constexpr size_t WS_S5SUM = WS_S5CCAT + (size_t)DEPTH * NG * 128 * NC * 2;
constexpr size_t WS_LRUW = WS_S5SUM + (size_t)BATCH * 8 * NG * NP * 8;
constexpr size_t WS_LRSUM = WS_LRUW + (size_t)DEPTH * 8 * 2 * 64 * 64 * 2;
constexpr size_t WS_LSIG = WS_LRSUM + (size_t)BATCH * 32 * 512 * 8;
constexpr size_t WS_END = WS_LSIG + (size_t)DEPTH * 512 * 4;
constexpr size_t DO_WIN = 0;
constexpr size_t DO_WBR = DO_WIN + (size_t)DEPTH * IN_COLS * 1024 * 2;
constexpr size_t DO_WGLU = DO_WBR + (size_t)DEPTH * 3 * 1024 * 512 * 2;
constexpr size_t DO_LRUW = DO_WGLU + (size_t)DEPTH * 512 * 512 * 2;
constexpr size_t DO_END = DO_LRUW;
static_assert(DO_END <= (size_t)M_P * D_MODEL * 4, "weights fit in y_prompt region");
static_assert(WS_END <= 268435456ull, "workspace fits 256 MiB");

__constant__ unsigned char T5_BUCKET[128] = {0, 1, 2, 3, 4, 5, 6, 7, 8, 9, 10, 11, 12, 13, 14, 15, 16, 16, 16, 17, 17, 18, 18, 18, 19, 19, 19, 20, 20, 20, 20, 21, 21, 21, 21, 22, 22, 22, 22, 22, 23, 23, 23, 23, 23, 23, 24, 24, 24, 24, 24, 24, 25, 25, 25, 25, 25, 25, 25, 26, 26, 26, 26, 26, 26, 26, 26, 27, 27, 27, 27, 27, 27, 27, 27, 27, 27, 28, 28, 28, 28, 28, 28, 28, 28, 28, 28, 29, 29, 29, 29, 29, 29, 29, 29, 29, 29, 29, 29, 30, 30, 30, 30, 30, 30, 30, 30, 30, 30, 30, 30, 30, 30, 31, 31, 31, 31, 31, 31, 31, 31, 31, 31, 31, 31, 31, 31, 31};

typedef unsigned u32x4 __attribute__((ext_vector_type(4)));
typedef float f32x2_t __attribute__((ext_vector_type(2)));
typedef __bf16 bf16x2_t __attribute__((ext_vector_type(2)));
__device__ __forceinline__ unsigned cvtpk(float lo, float hi) { f32x2_t v = {lo, hi}; bf16x2_t b = __builtin_convertvector(v, bf16x2_t); return __builtin_bit_cast(unsigned, b); }
__device__ __forceinline__ float bf2f(bf16_t v) { return __uint_as_float(((unsigned)v) << 16); }
__device__ __forceinline__ bf16_t f2bf(float f) { return (bf16_t)cvtpk(f, 0.f); }
__device__ __forceinline__ float sigmoidf_(float x) { return __builtin_amdgcn_rcpf(1.0f + __builtin_amdgcn_exp2f(-1.4426950408889634f * x)); }
__device__ __forceinline__ float siluf_(float x) { return x * sigmoidf_(x); }
__device__ __forceinline__ float gelu_tanh(float y) { return y * sigmoidf_(1.5957691216057308f * (y + 0.044715f * y * y * y)); }

struct P {
    const float* in[33];
    float* out;
    unsigned char* ws;
};

typedef const P __attribute__((address_space(4)))* KP;
__device__ __forceinline__ KP get_kp() { KP k = (KP)__builtin_amdgcn_kernarg_segment_ptr(); asm volatile("" : "+s"(k)); return k; }

constexpr size_t WS_CTL = (WS_END + 4095) & ~(size_t)4095;
constexpr size_t CTL_BYTES = 65536;
static_assert(WS_CTL + CTL_BYTES <= 268435456ull, "workspace fits 256 MiB");
constexpr int NTHREADS = 512, NWAVES = 8;
constexpr int LDS_BYTES = 147456;
constexpr int LDS_MISC = 135168;

#define LAS __attribute__((address_space(3)))
#define XB_TMO      128
#define XB_XCNT(j)  (256  + 64 * (j))
#define XB_XSUB(j)  (1280 + 64 * (j))
#define XB_XGEN(j)  (2304 + 64 * (j))
#define XB_TOP      3328
#define XB_TOPGEN   3392
#define XCD_BAR_WORDS 3456
#define XB_SPIN_CAP (1u << 18)
__device__ __forceinline__ unsigned xb_ld(unsigned* p)              { return __hip_atomic_load(p, __ATOMIC_RELAXED, __HIP_MEMORY_SCOPE_AGENT); }
__device__ __forceinline__ unsigned xb_add(unsigned* p, unsigned v) { return __hip_atomic_fetch_add(p, v, __ATOMIC_RELAXED, __HIP_MEMORY_SCOPE_AGENT); }
__device__ __forceinline__ unsigned xb_xcc_id() { return (unsigned)__builtin_amdgcn_s_getreg((3 << 11) | 20) & 0xFu; }
#define XB_SPIN(cond, bar) do { unsigned _sp = 0; while (cond) { __builtin_amdgcn_s_sleep(1); \
    if ((++_sp & 255u) == 0u) { if (xb_ld(&(bar)[XB_TMO])) break; if (_sp > XB_SPIN_CAP) { atomicAdd(&(bar)[XB_TMO], 1u); break; } } } } while (0)
__device__ __forceinline__ int lane_id0() { return (int)__builtin_amdgcn_mbcnt_hi(~0u, __builtin_amdgcn_mbcnt_lo(~0u, 0u)); }
struct XcdBarrier { unsigned* bar; unsigned x; volatile LAS unsigned* st; int wave_s; };
__device__ __forceinline__ XcdBarrier xcd_barrier_post(unsigned* bar, volatile LAS unsigned* st, int wave_s) {
    XcdBarrier b; b.bar = bar; b.x = xb_xcc_id(); b.st = st; b.wave_s = wave_s;
    if (wave_s == 0 && lane_id0() == 0) (void)xb_add(&bar[XB_XCNT(b.x)], 1u);
    return b;
}
__device__ __forceinline__ void xcd_barrier_complete(unsigned* bar, unsigned x, unsigned& nloc, unsigned& nx) {
    const unsigned G = gridDim.x * gridDim.y * gridDim.z;
    unsigned sum, cnt, mine, sp = 0u;
    for (;;) {
        sum = 0u; cnt = 0u; mine = 0u;
#pragma unroll
        for (unsigned j = 0; j < 16; ++j) { const unsigned c = xb_ld(&bar[XB_XCNT(j)]); sum += c; cnt += (c > 0u) ? 1u : 0u; mine = (j == x) ? c : mine; }
        if (sum == G) break;
        __builtin_amdgcn_s_sleep(1);
        if ((++sp & 255u) == 0u) { if (xb_ld(&bar[XB_TMO])) break; if (sp > XB_SPIN_CAP) { atomicAdd(&bar[XB_TMO], 1u); break; } }
    }
    nloc = mine > 0u ? mine : 1u; nx = cnt > 0u ? cnt : 1u;
}
__device__ __forceinline__ void xcd_barrier(const XcdBarrier& b) {
    asm volatile("s_waitcnt vmcnt(0)" ::: "memory");
    __syncthreads();
    int zb_ = 0; asm volatile("" : "+v"(zb_));
    if (b.wave_s == 0 && (int)__builtin_amdgcn_mbcnt_hi(~0u, __builtin_amdgcn_mbcnt_lo(~0u, (unsigned)zb_)) == 0) {
        unsigned* bar = b.bar; asm volatile("" : "+s"(bar));
        unsigned bx = b.x; asm volatile("" : "+s"(bx));
        __builtin_amdgcn_s_waitcnt(0);
        unsigned nloc = b.st[0], nx = b.st[1];
        if (nloc == 0u) { xcd_barrier_complete(bar, bx, nloc, nx); b.st[0] = nloc; b.st[1] = nx; }
        const unsigned old = xb_add(&bar[XB_XSUB(bx)], 1u);
        const unsigned gen = old / nloc;
        if (old + 1u == (gen + 1u) * nloc) {
            __builtin_amdgcn_fence(__ATOMIC_RELEASE, "agent");
            asm volatile("s_waitcnt vmcnt(0)" ::: "memory");
            const unsigned og = xb_add(&bar[XB_TOP], 1u);
            const unsigned tg = og / nx;
            if (og + 1u == (tg + 1u) * nx) xb_add(&bar[XB_TOPGEN], 1u);
            else XB_SPIN(xb_ld(&bar[XB_TOPGEN]) == tg, bar);
            __builtin_amdgcn_fence(__ATOMIC_ACQUIRE, "agent");
            xb_add(&bar[XB_XGEN(bx)], 1u);
            asm volatile("s_waitcnt vmcnt(0)" ::: "memory");
        } else {
            XB_SPIN(xb_ld(&bar[XB_XGEN(bx)]) == gen, bar);
            __builtin_amdgcn_fence(__ATOMIC_ACQUIRE, "agent");
            asm volatile("s_waitcnt vmcnt(0)" ::: "memory");
        }
    }
    __syncthreads();
}

namespace pg8 {
#define PG8_LAS __attribute__((address_space(3)))
typedef unsigned short bf16_t;
typedef short bf16x8 __attribute__((ext_vector_type(8)));
typedef float f32x4 __attribute__((ext_vector_type(4)));
typedef unsigned u32x4 __attribute__((ext_vector_type(4)));
constexpr int BM = 256, BK = 64, HALF = 128, HTB = HALF * BK * 2  , STAGE_BYTES = 8 * HTB, NXCD = 8, WGM = 8;

__host__ __device__ __forceinline__ int lds_byte(int r, int c) { const int st = (r >> 4) * 2 + (c >> 5), rr = r & 15, cc = c & 31, ob = rr * 64 + cc * 2; return st * 1024 + (ob ^ (((ob >> 9) & 1) << 5)); }
__host__ __device__ __forceinline__ void stage_rc(int b, int& R, int& C) { const int st = b / 1024, sb = b % 1024, swz = sb ^ (((sb >> 9) & 1) << 5); R = (st >> 1) * 16 + swz / 64; C = (st & 1) * 32 + (swz % 64) / 2; }
__host__ __device__ __forceinline__ int perm32(int rho) { const int n = rho >> 4, i = rho & 15; return 8 * (i >> 2) + 4 * n + (i & 3); }

struct Unit { int pm, pn, z; };
struct Gemm { const bf16_t* A; int lda; const bf16_t* Bt; int K; };

struct StaticOrder {
    int nM, nN, nwg, G, c;
    __host__ __device__ void init(int M, int N, int G_, int c_) { nM = M / BM; nN = N / BM; nwg = nM * nN; G = G_; c = c_; }
    __host__ __device__ bool next(int i, Unit& u) const {
        const long L = (long)i * G + c; if (L >= nwg) return false;
        int wgid = (int)L; { const int q = nwg / NXCD, r = nwg % NXCD, xcd = wgid % NXCD, off = wgid / NXCD; wgid = (xcd < r ? xcd * (q + 1) : r * (q + 1) + (xcd - r) * q) + off; }
        const int nig = WGM * nN, gid = wgid / nig, fm = gid * WGM, gsz = (nM - fm) < WGM ? (nM - fm) : WGM;
        u.pm = fm + ((wgid % nig) % gsz); u.pn = (wgid % nig) / gsz; u.z = 0; return true;
    }
    __device__ __forceinline__ size_t a_off(const Unit&) const { return 0; }
    __device__ __forceinline__ size_t b_off(const Unit&) const { return 0; }
    __device__ __forceinline__ void a_ready(const Unit&) const {}
    __device__ __forceinline__ void done(const Unit&) const {}
};

__device__ __forceinline__ unsigned cvt_pk_bf16(float lo, float hi) { unsigned r; asm volatile("v_cvt_pk_bf16_f32 %0, %1, %2" : "=v"(r) : "v"(lo), "v"(hi)); return r; }
typedef float f32x2 __attribute__((ext_vector_type(2)));
__device__ __forceinline__ f32x2 gelu_pk(f32x2 v) {
    const f32x2 av = __builtin_elementwise_abs(v), d = av * 0.2316418882f + 1.0f;
    f32x2 t; t.x = __builtin_amdgcn_rcpf(d.x); t.y = __builtin_amdgcn_rcpf(d.y);
    f32x2 q = t * 0.5307027145f + (-0.7265760135f); q = q * t + 0.7107068705f; q = q * t + (-0.142248368f); q = q * t + 0.127414796f; q = q * t;
    const f32x2 s = (v * v) * (-0.72134752044f);
    f32x2 e; e.x = __builtin_amdgcn_exp2f(s.x); e.y = __builtin_amdgcn_exp2f(s.y);
    const f32x2 m = v * (q * e), r = v - m;
    f32x2 o; o.x = v.x < 0.f ? m.x : r.x; o.y = v.y < 0.f ? m.y : r.y; return o;
}

template <class Epi, class Sched, bool ALIGN_EPI = false, bool SP2 = false>
__device__ __forceinline__ void gemm_phase(PG8_LAS unsigned char* lds, const Gemm g, const Sched& S, const Epi& E, int wave_s) {
    int zv_ = 0; asm volatile("" : "+v"(zv_));
    const int tid = (wave_s << 6) | (int)__builtin_amdgcn_mbcnt_hi(~0u, __builtin_amdgcn_mbcnt_lo(~0u, (unsigned)zv_)), wid = __builtin_amdgcn_readfirstlane(tid >> 6), lane = tid & 63, wr = wid >> 2, wc = wid & 3, fr = lane & 15, fq = lane >> 4;
    const int K = g.K, nt = K / BK;
    unsigned voffA[2], voffB[2];
#pragma unroll
    for (int i = 0; i < 2; ++i) { int R, C; stage_rc(tid * 16 + i * 8192, R, C); const int Rb = Epi::PERM ? ((R & ~31) + perm32(R & 31)) : R;
        voffA[i] = (unsigned)(R * g.lda + C) * 2u; voffB[i] = (unsigned)(Rb * K + C) * 2u; }
    const size_t kstep = (size_t)(BK * 2);
    const size_t hstepA = (size_t)HALF * g.lda * 2, hstepB = (size_t)HALF * K * 2;
    const size_t tstepA = 2 * hstepA, tstepB = 2 * hstepB;
    const unsigned ldsw = (unsigned)wid * 1024u;
    const int aoff = lds_byte(wr * 64 + fr, fq * 8), boff = lds_byte(wc * 32 + fr, fq * 8);
#define PG8_SA(b, h) (((b) * 2 + (h)) * HTB)
#define PG8_SB(b, h) ((4 + (b) * 2 + (h)) * HTB)
#define PG8_STAGE(bufoff, gbase, voff) do { _Pragma("unroll") for (int _i = 0; _i < 2; ++_i) \
        __builtin_amdgcn_global_load_lds((const unsigned*)((const char*)(gbase) + (voff)[_i]), (PG8_LAS unsigned*)(lds + (bufoff) + ldsw + _i * 8192), 16, 0, 0); } while (0)
#define PG8_LDA(dst, b, h) do { _Pragma("unroll") for (int m = 0; m < 4; ++m) _Pragma("unroll") for (int k = 0; k < 2; ++k) dst[m][k] = *(const PG8_LAS bf16x8*)(lds + PG8_SA(b, h) + aoff + m * 2048 + k * 1024); } while (0)
#define PG8_LDB(dst, b, h) do { _Pragma("unroll") for (int n = 0; n < 2; ++n) _Pragma("unroll") for (int k = 0; k < 2; ++k) dst[n][k] = *(const PG8_LAS bf16x8*)(lds + PG8_SB(b, h) + boff + n * 2048 + k * 1024); } while (0)
#define PG8_MMA(ai, bj, At, Bt) do { __builtin_amdgcn_s_setprio(1); _Pragma("unroll") for (int m = 0; m < 4; ++m) _Pragma("unroll") for (int n = 0; n < 2; ++n) _Pragma("unroll") for (int k = 0; k < 2; ++k) \
        acc[ai][bj][m][n] = __builtin_amdgcn_mfma_f32_16x16x32_bf16(Bt[n][k], At[m][k], acc[ai][bj][m][n], 0, 0, 0); __builtin_amdgcn_s_setprio(0); } while (0)
#define PG8_WAIT_V(n) asm volatile("s_waitcnt vmcnt(" #n ")" ::: "memory")
#define PG8_WAIT_L(n) asm volatile("s_waitcnt lgkmcnt(" #n ")" ::: "memory")
#define PG8_BAR __builtin_amdgcn_s_barrier()
#define PG8_SCHED __builtin_amdgcn_sched_barrier(0)
    Unit cur, nxt; int ui = 0;
    if (!S.next(0, cur)) return;
    f32x4 acc[2][2][4][2];
#pragma unroll
    for (int a = 0; a < 2; ++a)
#pragma unroll
        for (int b = 0; b < 2; ++b)
#pragma unroll
            for (int m = 0; m < 4; ++m)
#pragma unroll
                for (int n = 0; n < 2; ++n) acc[a][b][m][n] = (f32x4){0.f, 0.f, 0.f, 0.f};
    bf16x8 At[4][2], B0[2][2], B1[2][2];
    const char* cA = (const char*)g.A + (size_t)cur.pm * tstepA + S.a_off(cur); const char* cB = (const char*)g.Bt + (size_t)cur.pn * tstepB + S.b_off(cur);
    S.a_ready(cur);
    if constexpr (SP2) {
        PG8_STAGE(PG8_SB(0, 0), cB, voffB); PG8_STAGE(PG8_SB(0, 1), cB + hstepB, voffB); PG8_STAGE(PG8_SA(0, 0), cA, voffA); PG8_STAGE(PG8_SA(0, 1), cA + hstepA, voffA);
        if (wr == 1) PG8_BAR;
        PG8_WAIT_V(2); PG8_BAR;
        PG8_STAGE(PG8_SB(1, 0), cB + kstep, voffB); PG8_STAGE(PG8_SA(1, 0), cA + kstep, voffA); PG8_STAGE(PG8_SB(1, 1), cB + hstepB + kstep, voffB);
        PG8_WAIT_V(6); PG8_BAR;
    } else {
        PG8_STAGE(PG8_SB(0, 0), cB, voffB); PG8_STAGE(PG8_SA(0, 0), cA, voffA); PG8_STAGE(PG8_SB(0, 1), cB + hstepB, voffB); PG8_STAGE(PG8_SA(0, 1), cA + hstepA, voffA);
        if (wr == 1) PG8_BAR;
        PG8_WAIT_V(4); PG8_BAR;
        PG8_STAGE(PG8_SB(1, 0), cB + kstep, voffB); PG8_STAGE(PG8_SA(1, 0), cA + kstep, voffA); PG8_STAGE(PG8_SB(1, 1), cB + hstepB + kstep, voffB);
        PG8_WAIT_V(6); PG8_BAR;
    }
    for (;;) {
        const bool has_next = S.next(ui + 1, nxt);
        const char* nA = has_next ? (const char*)g.A + (size_t)nxt.pm * tstepA + S.a_off(nxt) : cA; const char* nB = has_next ? (const char*)g.Bt + (size_t)nxt.pn * tstepB + S.b_off(nxt) : cB;
        for (int t = 0; t < nt; t += 2) {
            if constexpr (Epi::MIDSCALE) { if (t == 8 || t == 16) E.rescale(acc, cur, (t >> 3) - 1, wr, wc, fr, fq); }
            const bool last = (t == nt - 2);
            const char* a1 = cA + (size_t)(t + 1) * kstep;
            const char* a2 = last ? nA : cA + (size_t)(t + 2) * kstep; const char* b2 = last ? nB : cB + (size_t)(t + 2) * kstep;
            const char* a3 = a2 + kstep; const char* b3 = b2 + kstep;
            if (last && has_next) S.a_ready(nxt);
            if constexpr (SP2) {
            PG8_LDB(B0, 0, 0); PG8_LDB(B1, 0, 1); PG8_SCHED; PG8_LDA(At, 0, 0); PG8_STAGE(PG8_SA(1, 1), a1 + hstepA, voffA);
            PG8_WAIT_V(8); PG8_WAIT_L(0); PG8_BAR; PG8_MMA(0, 0, At, B0); PG8_MMA(0, 1, At, B1); PG8_BAR; PG8_SCHED;
            PG8_LDA(At, 0, 1); PG8_STAGE(PG8_SB(0, 0), b2, voffB); PG8_STAGE(PG8_SB(0, 1), b2 + hstepB, voffB); PG8_STAGE(PG8_SA(0, 0), a2, voffA);
            PG8_WAIT_V(8); PG8_WAIT_L(0); PG8_BAR; PG8_MMA(1, 0, At, B0); PG8_MMA(1, 1, At, B1); PG8_BAR; PG8_SCHED;
            PG8_LDB(B0, 1, 0); PG8_LDB(B1, 1, 1); PG8_SCHED; PG8_LDA(At, 1, 0); PG8_STAGE(PG8_SA(0, 1), a2 + hstepA, voffA);
            PG8_WAIT_V(8); PG8_WAIT_L(0); PG8_BAR; PG8_MMA(0, 0, At, B0); PG8_MMA(0, 1, At, B1); PG8_BAR; PG8_SCHED;
            PG8_LDA(At, 1, 1); PG8_STAGE(PG8_SB(1, 0), b3, voffB); PG8_STAGE(PG8_SB(1, 1), b3 + hstepB, voffB); PG8_STAGE(PG8_SA(1, 0), a3, voffA);
            PG8_WAIT_V(8); PG8_WAIT_L(0); PG8_BAR; PG8_MMA(1, 0, At, B0); PG8_MMA(1, 1, At, B1); PG8_BAR; PG8_SCHED;
            } else {
            PG8_LDB(B0, 0, 0); PG8_SCHED; PG8_LDA(At, 0, 0); PG8_STAGE(PG8_SA(1, 1), a1 + hstepA, voffA);
            PG8_WAIT_L(8); PG8_BAR; PG8_WAIT_L(0); PG8_MMA(0, 0, At, B0); PG8_BAR; PG8_SCHED;
            PG8_LDB(B1, 0, 1); PG8_STAGE(PG8_SB(0, 0), b2, voffB);
            PG8_BAR; PG8_WAIT_L(0); PG8_MMA(0, 1, At, B1); PG8_BAR;
            PG8_LDA(At, 0, 1); PG8_STAGE(PG8_SA(0, 0), a2, voffA);
            PG8_BAR; PG8_WAIT_L(0); PG8_MMA(1, 0, At, B0); PG8_BAR; PG8_SCHED;
            PG8_STAGE(PG8_SB(0, 1), b2 + hstepB, voffB);
            PG8_WAIT_V(6); PG8_BAR; PG8_MMA(1, 1, At, B1); PG8_BAR;
            PG8_LDB(B0, 1, 0); PG8_SCHED; PG8_LDA(At, 1, 0); PG8_STAGE(PG8_SA(0, 1), a2 + hstepA, voffA);
            PG8_WAIT_L(8); PG8_BAR; PG8_WAIT_L(0); PG8_MMA(0, 0, At, B0); PG8_BAR; PG8_SCHED;
            PG8_LDB(B1, 1, 1); PG8_STAGE(PG8_SB(1, 0), b3, voffB);
            PG8_BAR; PG8_WAIT_L(0); PG8_MMA(0, 1, At, B1); PG8_BAR;
            PG8_LDA(At, 1, 1); PG8_STAGE(PG8_SA(1, 0), a3, voffA);
            PG8_BAR; PG8_WAIT_L(0); PG8_MMA(1, 0, At, B0); PG8_BAR; PG8_SCHED;
            PG8_STAGE(PG8_SB(1, 1), b3 + hstepB, voffB);
            PG8_WAIT_V(6); PG8_BAR; PG8_MMA(1, 1, At, B1); PG8_BAR;
            }
        }
        if constexpr (ALIGN_EPI) { if (wr == 0) PG8_BAR; }
        if constexpr (!Epi::AFTER_DRAIN) { E(acc, cur, wr, wc, fr, fq); S.done(cur); }
        if (!has_next) break;
#pragma unroll
        for (int a = 0; a < 2; ++a)
#pragma unroll
            for (int b = 0; b < 2; ++b)
#pragma unroll
                for (int m = 0; m < 4; ++m)
#pragma unroll
                    for (int n = 0; n < 2; ++n) acc[a][b][m][n] = (f32x4){0.f, 0.f, 0.f, 0.f};
        cur = nxt; cA = nA; cB = nB; ++ui;
        if constexpr (ALIGN_EPI) { if (wr == 1) PG8_BAR; }
    }
    PG8_WAIT_V(0);
    if constexpr (!ALIGN_EPI) { if (wr == 0) PG8_BAR; }
    PG8_BAR;
    if constexpr (Epi::AFTER_DRAIN) { E.fused(acc, cur, wr, wc, fr, fq, lds, wid, lane); S.done(cur); }
#undef PG8_SA
#undef PG8_SB
#undef PG8_STAGE
#undef PG8_LDA
#undef PG8_LDB
#undef PG8_MMA
#undef PG8_WAIT_V
#undef PG8_WAIT_L
#undef PG8_BAR
#undef PG8_SCHED
}
}

namespace pg8 {
typedef unsigned u32x2 __attribute__((ext_vector_type(2)));
__device__ __forceinline__ float bflo(unsigned w) { return __uint_as_float(w << 16); }
__device__ __forceinline__ float bfhi(unsigned w) { return __uint_as_float(w & 0xffff0000u); }
__device__ __forceinline__ float sigm(float x) { return __builtin_amdgcn_rcpf(1.0f + __builtin_amdgcn_exp2f(-1.4426950408889634f * x)); }
struct EpiProjB {
    static constexpr bool PERM = true, AFTER_DRAIN = false, MIDSCALE = false;
    bf16_t* O; int ldc;
    __device__ __forceinline__ void operator()(const f32x4 (&acc)[2][2][4][2], const Unit& u, int wr, int wc, int fr, int fq) const {
        const int row0 = u.pm * BM + wr * 64 + fr, col0 = u.pn * BM + wc * 32 + 8 * fq;
        const bool gate = u.pn >= C_GM / BM;
#pragma unroll
        for (int ai = 0; ai < 2; ++ai)
#pragma unroll
            for (int m = 0; m < 4; ++m) { bf16_t* rowp = O + (size_t)(row0 + ai * HALF + m * 16) * ldc + col0;
#pragma unroll
                for (int bj = 0; bj < 2; ++bj) { f32x4 v0 = acc[ai][bj][m][0], v1 = acc[ai][bj][m][1];
                    if (gate) {
#pragma unroll
                        for (int e = 0; e < 4; ++e) { v0[e] = 1.0f + __builtin_amdgcn_exp2f(fminf(-1.4426950408889634f * v0[e], 100.f)); v1[e] = 1.0f + __builtin_amdgcn_exp2f(fminf(-1.4426950408889634f * v1[e], 100.f)); } }
                    u32x4 w; w.x = cvt_pk_bf16(v0[0], v0[1]); w.y = cvt_pk_bf16(v0[2], v0[3]); w.z = cvt_pk_bf16(v1[0], v1[1]); w.w = cvt_pk_bf16(v1[2], v1[3]);
                    *(u32x4*)(rowp + bj * HALF) = w; } }
    }
};
struct EpiGluB {
    static constexpr bool PERM = true, AFTER_DRAIN = false, MIDSCALE = false;
    bf16_t* PROJ; bool dry;
    __device__ __forceinline__ void operator()(const f32x4 (&acc)[2][2][4][2], const Unit& u, int wr, int wc, int fr, int fq) const {
        const int row0 = u.pm * BM + wr * 64 + fr, col0 = u.pn * BM + wc * 32 + 8 * fq;
        u32x4 zz[2][2][2], gg[2][2][2];
#define GL_ISSUE(g) do { const int ai_ = (g) >> 1, m0_ = 2 * ((g) & 1); _Pragma("unroll") for (int mm = 0; mm < 2; ++mm) { \
            const bf16_t* rowp = PROJ + (size_t)(row0 + ai_ * HALF + (m0_ + mm) * 16) * IN_COLS + col0; \
            _Pragma("unroll") for (int bj = 0; bj < 2; ++bj) { zz[(g) & 1][mm][bj] = *(const u32x4*)(rowp + C_UB + bj * HALF); gg[(g) & 1][mm][bj] = *(const u32x4*)(rowp + C_GB + bj * HALF); } } } while (0)
        GL_ISSUE(0);
#pragma unroll
        for (int ah = 0; ah < 4; ++ah) { const int ai = ah >> 1, m0 = 2 * (ah & 1);
            if (ah + 1 < 4) GL_ISSUE(ah + 1);
            __builtin_amdgcn_sched_barrier(0);
#pragma unroll
            for (int mm = 0; mm < 2; ++mm) { const int m = m0 + mm; bf16_t* rowp = PROJ + (size_t)(row0 + ai * HALF + m * 16) * IN_COLS + col0;
#pragma unroll
                for (int bj = 0; bj < 2; ++bj) {
                    const f32x4 v0 = acc[ai][bj][m][0], v1 = acc[ai][bj][m][1];
                    float o[8];
#pragma unroll
                    for (int e = 0; e < 4; ++e) {
                        const float va = e < 2 ? v0[2 * e] : v1[2 * (e - 2)], vb = e < 2 ? v0[2 * e + 1] : v1[2 * (e - 2) + 1];
                        const unsigned wz = zz[ah & 1][mm][bj][e], wg = gg[ah & 1][mm][bj][e];
                        const float za = bflo(wz), zb = bfhi(wz), ga = bflo(wg), gb = bfhi(wg);
                        o[2 * e] = za * sigm(va) * ga * sigm(ga); o[2 * e + 1] = zb * sigm(vb) * gb * sigm(gb);
                    }
                    u32x4 w; w.x = cvt_pk_bf16(o[0], o[1]); w.y = cvt_pk_bf16(o[2], o[3]); w.z = cvt_pk_bf16(o[4], o[5]); w.w = cvt_pk_bf16(o[6], o[7]);
                    if (!dry) *(u32x4*)(rowp + C_GB + bj * HALF) = w; } }
        }
#undef GL_ISSUE
    }
};
#ifndef RS_DEPTH
#define RS_DEPTH 1
#endif
struct EpiMergeB {
    static constexpr bool PERM = true, AFTER_DRAIN = false, MIDSCALE = true;
    bf16_t* PROJ; bool dry;
    __device__ __forceinline__ void rescale(f32x4 (&acc)[2][2][4][2], const Unit& u, int step, int wr, int wc, int fr, int fq) const {
        int zr = 0; asm volatile("" : "+v"(zr));
        const int row0 = u.pm * BM + wr * 64 + fr + zr, col0 = u.pn * BM + wc * 32 + 8 * fq;
        constexpr int DEPTH_ = RS_DEPTH;
        u32x4 ga[DEPTH_ + 1][2][2], gb[DEPTH_ + 1][2][2];
#define RS_ISSUE(g) do { const int ai_ = (g) >> 1, m0_ = 2 * ((g) & 1); _Pragma("unroll") for (int mm = 0; mm < 2; ++mm) { \
            const bf16_t* rowp = PROJ + (size_t)(row0 + ai_ * HALF + (m0_ + mm) * 16) * IN_COLS + C_GM + step * 1024 + col0; \
            _Pragma("unroll") for (int bj = 0; bj < 2; ++bj) { ga[(g) % (DEPTH_ + 1)][mm][bj] = *(const u32x4*)(rowp + bj * HALF); gb[(g) % (DEPTH_ + 1)][mm][bj] = *(const u32x4*)(rowp + 1024 + bj * HALF); } } } while (0)
#pragma unroll
        for (int g = 0; g < DEPTH_; ++g) RS_ISSUE(g);
#pragma unroll
        for (int ah = 0; ah < 4; ++ah) { const int ai = ah >> 1, m0 = 2 * (ah & 1);
            if (ah + DEPTH_ < 4) RS_ISSUE(ah + DEPTH_);
            __builtin_amdgcn_sched_barrier(0);
#pragma unroll
            for (int mm = 0; mm < 2; ++mm)
#pragma unroll
                for (int bj = 0; bj < 2; ++bj)
#pragma unroll
                    for (int e = 0; e < 4; ++e) { const int m = m0 + mm; const unsigned wa = ga[ah % (DEPTH_ + 1)][mm][bj][e], wb = gb[ah % (DEPTH_ + 1)][mm][bj][e];
                        const float r0 = bflo(wb) * __builtin_amdgcn_rcpf(bflo(wa)), r1 = bfhi(wb) * __builtin_amdgcn_rcpf(bfhi(wa));
                        if (e < 2) { acc[ai][bj][m][0][2 * e] *= r0; acc[ai][bj][m][0][2 * e + 1] *= r1; } else { acc[ai][bj][m][1][2 * (e - 2)] *= r0; acc[ai][bj][m][1][2 * (e - 2) + 1] *= r1; }
                    }
        }
#undef RS_ISSUE
    }
    __device__ __forceinline__ void operator()(const f32x4 (&acc)[2][2][4][2], const Unit& u, int wr, int wc, int fr, int fq) const {
        const int row0 = u.pm * BM + wr * 64 + fr, col0 = u.pn * BM + wc * 32 + 8 * fq;
        u32x4 gg[2][4][2];
#pragma unroll
        for (int ai = 0; ai < 2; ++ai)
#pragma unroll
            for (int m = 0; m < 4; ++m) { const bf16_t* rowp = PROJ + (size_t)(row0 + ai * HALF + m * 16) * IN_COLS + C_GM + 2048 + col0;
#pragma unroll
                for (int bj = 0; bj < 2; ++bj) gg[ai][m][bj] = *(const u32x4*)(rowp + bj * HALF); }
        __builtin_amdgcn_sched_barrier(0);
#pragma unroll
        for (int ai = 0; ai < 2; ++ai)
#pragma unroll
            for (int m = 0; m < 4; ++m) { bf16_t* rowp = PROJ + (size_t)(row0 + ai * HALF + m * 16) * IN_COLS + C_GM + col0;
#pragma unroll
                for (int bj = 0; bj < 2; ++bj) {
                    const f32x4 v0 = acc[ai][bj][m][0], v1 = acc[ai][bj][m][1];
                    float o[8];
#pragma unroll
                    for (int e = 0; e < 4; ++e) {
                        const float va = e < 2 ? v0[2 * e] : v1[2 * (e - 2)], vb = e < 2 ? v0[2 * e + 1] : v1[2 * (e - 2) + 1];
                        o[2 * e] = __builtin_amdgcn_rcpf(bflo(gg[ai][m][bj][e])) * va; o[2 * e + 1] = __builtin_amdgcn_rcpf(bfhi(gg[ai][m][bj][e])) * vb;
                    }
                    u32x4 w; w.x = cvt_pk_bf16(o[0], o[1]); w.y = cvt_pk_bf16(o[2], o[3]); w.z = cvt_pk_bf16(o[4], o[5]); w.w = cvt_pk_bf16(o[6], o[7]);
                    if (!dry) *(u32x4*)(rowp + bj * HALF) = w; } }
    }
};
struct EpiOutB {
    static constexpr bool PERM = true, AFTER_DRAIN = false, MIDSCALE = false;
    const bf16_t* XB; unsigned char* ws;
    __device__ __forceinline__ void operator()(const f32x4 (&acc)[2][2][4][2], const Unit& u, int wr, int wc, int fr, int fq) const {
        const int row0 = u.pm * BM + wr * 64 + fr, col0 = u.pn * BM + wc * 32 + 8 * fq;
        u32x4 xx[2][4][2];
#pragma unroll
        for (int ai = 0; ai < 2; ++ai)
#pragma unroll
            for (int m = 0; m < 4; ++m) { const bf16_t* xrow = XB + (size_t)(row0 + ai * HALF + m * 16) * D_MODEL + col0;
#pragma unroll
                for (int bj = 0; bj < 2; ++bj) xx[ai][m][bj] = *(const u32x4*)(xrow + bj * HALF); }
        __builtin_amdgcn_sched_barrier(0);
#pragma unroll
        for (int ai = 0; ai < 2; ++ai)
#pragma unroll
            for (int m = 0; m < 4; ++m) { const int r = row0 + ai * HALF + m * 16;
                bf16_t* prow = (bf16_t*)(ws + WS_PROJ + (size_t)r * IN_COLS * 2 + (size_t)(C_GM + 1024) * 2) + col0;
#pragma unroll
                for (int bj = 0; bj < 2; ++bj) { const u32x4 w = xx[ai][m][bj];
                    const f32x4 o0 = (f32x4){bflo(w.x), bfhi(w.x), bflo(w.y), bfhi(w.y)} * DN_ALPHA + acc[ai][bj][m][0], o1 = (f32x4){bflo(w.z), bfhi(w.z), bflo(w.w), bfhi(w.w)} * DN_ALPHA + acc[ai][bj][m][1];
                    u32x4 ow; ow.x = cvt_pk_bf16(o0[0], o0[1]); ow.y = cvt_pk_bf16(o0[2], o0[3]); ow.z = cvt_pk_bf16(o1[0], o1[1]); ow.w = cvt_pk_bf16(o1[2], o1[3]);
                    *(u32x4*)(prow + bj * HALF) = ow; } }
    }
};
}

__device__ __forceinline__ int lane_id() { return (int)__builtin_amdgcn_mbcnt_hi(~0u, __builtin_amdgcn_mbcnt_lo(~0u, 0u)); }
__device__ __forceinline__ int tid_of(int wave_s, int zv) { return (wave_s << 6) | (int)__builtin_amdgcn_mbcnt_hi(~0u, __builtin_amdgcn_mbcnt_lo(~0u, (unsigned)zv)); }
struct Halves { float lo, hi; };
__device__ __forceinline__ Halves halves(float v) { const unsigned u = __float_as_uint(v); auto rr = __builtin_amdgcn_permlane32_swap(u, u, false, false); return Halves{__uint_as_float(rr[0]), __uint_as_float(rr[1])}; }
template <int O> __device__ __forceinline__ float xor_lane(float v) { return __int_as_float(__builtin_amdgcn_ds_swizzle(__float_as_int(v), (O << 10) | 0x1F)); }
__device__ __forceinline__ float wave_sum(float v) { v += xor_lane<1>(v); v += xor_lane<2>(v); v += xor_lane<4>(v); v += xor_lane<8>(v); v += xor_lane<16>(v); const Halves hh = halves(v); return hh.lo + hh.hi; }
struct Ctx { int tid, lane, wave, gw, ngw; size_t gt, ngt; };
__device__ __forceinline__ Ctx make_ctx(int wave_s) {
    int zv = 0; asm volatile("" : "+v"(zv)); int zs = 0; asm volatile("" : "+s"(zs));
    Ctx c; c.tid = tid_of(wave_s, zv); c.lane = c.tid & 63; c.wave = __builtin_amdgcn_readfirstlane(c.tid >> 6);
    const int bid = (int)blockIdx.x + zs, nb = (int)gridDim.x + zs;
    c.gw = c.wave * nb + bid; c.ngw = nb * NWAVES; c.gt = (size_t)bid * NTHREADS + c.tid; c.ngt = (size_t)nb * NTHREADS; return c;
}
__device__ __forceinline__ Ctx group_ctx(const Ctx& c, int w0, int nw) {
    Ctx g = c; const int nb = c.ngw / NWAVES, bid = c.gw - c.wave * nb; g.gw = (c.wave - w0) * nb + bid; g.ngw = nw * nb; return g; }
__device__ __forceinline__ Ctx waveset_ctx(const Ctx& c, int rank, int size) {
    Ctx g = c; const int nb = c.ngw / NWAVES, bid = c.gw - c.wave * nb; g.gw = rank * nb + bid; g.ngw = size * nb; return g; }
#define WAVE_LDS_SYNC() do { asm volatile("s_waitcnt lgkmcnt(0)" ::: "memory"); __builtin_amdgcn_wave_barrier(); } while (0)

__device__ __forceinline__ void st_convert_x(KP p, const Ctx& c) {
    u32x4* XB = (u32x4*)(p->ws + WS_XB);
    const size_t n8 = (size_t)M_TOT * D_MODEL / 8, np8 = (size_t)M_P * D_MODEL / 8;
    for (size_t i0 = c.gt; i0 < n8; i0 += 4 * c.ngt) {
        f32x4 a[4], b[4];
#pragma unroll
        for (int u = 0; u < 4; ++u) { const size_t i = i0 + u * c.ngt; if (i < n8) { const f32x4* src = i < np8 ? (const f32x4*)p->in[0] + 2 * i : (const f32x4*)p->in[1] + 2 * (i - np8); a[u] = src[0]; b[u] = src[1]; } }
#pragma unroll
        for (int u = 0; u < 4; ++u) { const size_t i = i0 + u * c.ngt; if (i < n8) { u32x4 o; o.x = cvtpk(a[u][0], a[u][1]); o.y = cvtpk(a[u][2], a[u][3]); o.z = cvtpk(b[u][0], b[u][1]); o.w = cvtpk(b[u][2], b[u][3]); XB[i] = o; } }
    }
}

__device__ __forceinline__ unsigned pk2bf(float lo, float hi) { return (unsigned)f2bf(lo) | ((unsigned)f2bf(hi) << 16); }
__device__ __forceinline__ void p0_transpose_item(const float* W, int K, int N, bf16_t* WT, int ldk, int koff, bool perm, LAS float* scr, int item, int lane) {
    const int nblk = N / 32, kb = item / nblk, nb = item % nblk, k0 = 64 * kb, n0 = 32 * nb, d0 = perm ? colperm32(n0) : n0;
    float wv[32];
#pragma unroll
    for (int i = 0; i < 32; ++i) wv[i] = W[(size_t)(k0 + 2 * i + (lane >> 5)) * N + n0 + (lane & 31)];
#pragma unroll
    for (int i = 0; i < 32; ++i) scr[(2 * i + (lane >> 5)) * 33 + (lane & 31)] = wv[i];
    WAVE_LDS_SYNC();
    const int cch = lane & 7;
#pragma unroll
    for (int j = 0; j < 4; ++j) { const int n = (lane >> 3) + 8 * j; const LAS float* sp = scr + (8 * cch) * 33 + n;
        u32x4 o; o.x = pk2bf(sp[0 * 33], sp[1 * 33]); o.y = pk2bf(sp[2 * 33], sp[3 * 33]); o.z = pk2bf(sp[4 * 33], sp[5 * 33]); o.w = pk2bf(sp[6 * 33], sp[7 * 33]);
        *(u32x4*)(WT + (size_t)(d0 + n) * ldk + koff + k0 + 8 * cch) = o; }
    WAVE_LDS_SYNC();
}
__device__ __forceinline__ void st_prologue_weights(KP p, const Ctx& c, LAS float* scr, int it_lo, int it_hi) {
    unsigned char* dob = (unsigned char*)p->out;
    constexpr int I_IN = 16 * 200, I_BR = 8 * 32, I_GLU = 8 * 16, I_OUT = 16 * 32, I_LAYER = I_IN + 3 * I_BR + I_GLU + I_OUT;
    if (it_hi < 0) it_hi = DEPTH * I_LAYER;
    for (int it = it_lo + c.gw; it < it_hi; it += c.ngw) {
        const int l = it / I_LAYER; int r = it % I_LAYER;
        if (r < I_IN) { p0_transpose_item(p->in[9] + (size_t)l * 1024 * IN_COLS, 1024, IN_COLS, (bf16_t*)(dob + DO_WIN) + (size_t)l * IN_COLS * 1024, 1024, 0, true, scr, r, c.lane); continue; } r -= I_IN;
        if (r < I_BR) { p0_transpose_item(p->in[11] + (size_t)l * 512 * 1024, 512, 1024, (bf16_t*)(dob + DO_WBR) + (size_t)l * 1024 * 1536, 1536, 0, false, scr, r, c.lane); continue; } r -= I_BR;
        if (r < I_BR) { p0_transpose_item(p->in[21] + (size_t)l * 512 * 1024, 512, 1024, (bf16_t*)(dob + DO_WBR) + (size_t)l * 1024 * 1536, 1536, 512, false, scr, r, c.lane); continue; } r -= I_BR;
        if (r < I_BR) { p0_transpose_item(p->in[29] + (size_t)l * 512 * 1024, 512, 1024, (bf16_t*)(dob + DO_WBR) + (size_t)l * 1024 * 1536, 1536, 1024, false, scr, r, c.lane); continue; } r -= I_BR;
        if (r < I_GLU) { p0_transpose_item(p->in[20] + (size_t)l * 512 * 512, 512, 512, (bf16_t*)(dob + DO_WGLU) + (size_t)l * 512 * 512, 512, 0, false, scr, r, c.lane); continue; } r -= I_GLU;
        p0_transpose_item(p->in[30] + (size_t)l * 1024 * 1024, 1024, 1024, (bf16_t*)(p->ws + WS_WOUT) + (size_t)l * 1024 * 1024, 1024, 0, false, scr, r, c.lane);
    }
}
__device__ __forceinline__ f32x4 ld_bf4(const bf16_t* q) { typedef unsigned u32x2_t __attribute__((ext_vector_type(2))); const u32x2_t w = *(const u32x2_t*)q;
    return (f32x4){__uint_as_float(w.x << 16), __uint_as_float(w.x & 0xffff0000u), __uint_as_float(w.y << 16), __uint_as_float(w.y & 0xffff0000u)}; }
__device__ __forceinline__ void st_kv_out(KP p, int l, const Ctx& c) {
    const bf16_t* PROJ = (const bf16_t*)(p->ws + WS_PROJ);
    for (size_t ii = c.gt; ii < (size_t)BATCH * 3 * 128; ii += c.ngt) {
        const int i = (int)ii, b = i / 384, j = (i / 128) % 3, c4 = i % 128;
        *(f32x4*)(p->out + O_CP + (size_t)l * BATCH * 1536 + (size_t)i * 4) = ld_bf4(PROJ + ((size_t)b * SEQ + SEQ - 3 + j) * IN_COLS + C_XC + 4 * c4);
    }
    for (size_t ii = c.gt; ii < (size_t)DEC_BATCH * 3 * 128; ii += c.ngt) {
        const int i = (int)ii, b = i / 384, j = (i / 128) % 3, c4 = i % 128;
        *(f32x4*)(p->out + O_CS + (size_t)l * DEC_BATCH * 1536 + (size_t)i * 4) = ld_bf4(PROJ + ((size_t)M_P + 4 * b + 1 + j) * IN_COLS + C_XC + 4 * c4);
    }
    for (size_t ii = c.gt; ii < (size_t)BATCH * WINDOW * 32; ii += c.ngt) {
        const int i = (int)ii, b = i / (WINDOW * 32), w = (i / 32) % WINDOW, c4 = i % 32;
        const bf16_t* src = PROJ + ((size_t)b * SEQ + (SEQ - WINDOW) + w) * IN_COLS + 4 * c4;
        *(f32x4*)(p->out + O_KP + (size_t)l * BATCH * WINDOW * 128 + (size_t)i * 4) = ld_bf4(src + C_K);
        *(f32x4*)(p->out + O_VP + (size_t)l * BATCH * WINDOW * 128 + (size_t)i * 4) = ld_bf4(src + C_V);
    }
    for (size_t ii = c.gt; ii < (size_t)DEC_BATCH * DEC_SEQ * 32; ii += c.ngt) {
        const int i = (int)ii, b = i / (DEC_SEQ * 32), t = (i / 32) % DEC_SEQ, c4 = i % 32;
        const bf16_t* src = PROJ + ((size_t)M_P + b * DEC_SEQ + t) * IN_COLS + 4 * c4;
        const size_t o = (((size_t)l * DEC_BATCH + b) * WINDOW + (WINDOW - DEC_SEQ) + t) * 128 + 4 * c4;
        *(f32x4*)(p->out + O_KS + o) = ld_bf4(src + C_K); *(f32x4*)(p->out + O_VS + o) = ld_bf4(src + C_V);
    }
    constexpr int NSH = DEC_BATCH * (WINDOW - DEC_SEQ) * 32;
    for (size_t i0 = c.gt; i0 < (size_t)NSH; i0 += 4 * c.ngt) {
        f32x4 kk[4], vv[4];
#pragma unroll
        for (int u = 0; u < 4; ++u) { const size_t ii = i0 + u * c.ngt; if (ii < (size_t)NSH) { const int i = (int)ii, b = i / ((WINDOW - DEC_SEQ) * 32), r = i % ((WINDOW - DEC_SEQ) * 32);
            const size_t ci = (((size_t)l * DEC_BATCH + b) * WINDOW + DEC_SEQ) * 128 + (size_t)r * 4; kk[u] = *(const f32x4*)(p->in[2] + ci); vv[u] = *(const f32x4*)(p->in[3] + ci); } }
#pragma unroll
        for (int u = 0; u < 4; ++u) { const size_t ii = i0 + u * c.ngt; if (ii < (size_t)NSH) { const int i = (int)ii, b = i / ((WINDOW - DEC_SEQ) * 32), r = i % ((WINDOW - DEC_SEQ) * 32);
            const size_t o = ((size_t)l * DEC_BATCH + b) * WINDOW * 128 + (size_t)r * 4; *(f32x4*)(p->out + O_KS + o) = kk[u]; *(f32x4*)(p->out + O_VS + o) = vv[u]; } }
    }
}

typedef short s16x4 __attribute__((ext_vector_type(4)));
typedef short v4i16_t __attribute__((ext_vector_type(4)));
__device__ __forceinline__ bf16x8 pack8(float a0, float a1, float a2, float a3, float a4, float a5, float a6, float a7) {
    u32x4 p; p.x = cvtpk(a0, a1); p.y = cvtpk(a2, a3); p.z = cvtpk(a4, a5); p.w = cvtpk(a6, a7); return __builtin_bit_cast(bf16x8, p); }
__device__ __forceinline__ s16x4 tr_read(LAS const unsigned char* p) { return __builtin_bit_cast(s16x4, __builtin_amdgcn_ds_read_tr16_b64_v4i16((LAS v4i16_t*)p)); }
__device__ __forceinline__ bf16x8 cat8(s16x4 lo, s16x4 hi) { return __builtin_shufflevector(lo, hi, 0, 1, 2, 3, 4, 5, 6, 7); }
#define MFMA_SETTLE2(a, b) asm volatile("s_nop 15\n\ts_nop 7" : "+v"(a), "+v"(b))
#define MFMA_SETTLE3(a, b, c) asm volatile("s_nop 15\n\ts_nop 7" : "+v"(a), "+v"(b), "+v"(c))
#define MFMA32(a, b, c) __builtin_amdgcn_mfma_f32_32x32x16_bf16((a), (b), (c), 0, 0, 0)
#define MFMA16(a, b, c) __builtin_amdgcn_mfma_f32_16x16x32_bf16((a), (b), (c), 0, 0, 0)

constexpr int AT_KSTR = 144, AT_VSTR = 192;
constexpr int AT_K = 0, AT_V = AT_K + 256 * AT_KSTR, AT_BIAS = AT_V + 256 * AT_VSTR, AT_WS = AT_BIAS + 4 * 128 * 4, AT_END = AT_WS + 8 * 256;
static_assert(AT_END <= 131072, "attention LDS");

__device__ __forceinline__ void st_attn_prompt(KP p, int l, LAS unsigned char* lds, bool dry, int wave_s) {
    int zv = 0; asm volatile("" : "+v"(zv));
    const int tid = tid_of(wave_s, zv), lane = tid & 63, wave = __builtin_amdgcn_readfirstlane(tid >> 6);
    const int c31 = lane & 31, h = lane >> 5;
    bf16_t* PROJ = (bf16_t*)(p->ws + WS_PROJ);
    const float* rel_bias = p->in[8];
    for (int item = blockIdx.x; item < BATCH * 16 * NKV; item += gridDim.x) {
        const int b = item / 32, nb = (item >> 1) & 15, kvh = item & 1;
        const size_t rowq0 = (size_t)b * SEQ + (size_t)nb * 128;
#pragma unroll
        for (int i = 0; i < 4; ++i) {
            const int id = tid + 512 * i, row = id >> 3, pc = id & 7;
            u32x4 kk = (u32x4){0u, 0u, 0u, 0u}, vv = kk;
            if (nb > 0 || row >= 128) {
                const bf16_t* src = PROJ + (rowq0 - 128 + row) * IN_COLS + kvh * 64 + pc * 8;
                kk = *(const u32x4*)(src + C_K); vv = *(const u32x4*)(src + C_V);
            }
            *(LAS u32x4*)(lds + AT_K + row * AT_KSTR + pc * 16) = kk;
            *(LAS u32x4*)(lds + AT_V + row * AT_VSTR + pc * 16) = vv;
        }
        { const int g = tid >> 7, d = tid & 127; ((LAS float*)(lds + AT_BIAS))[tid] = rel_bias[T5_BUCKET[d] * NQH + kvh * 4 + g]; }
        const int g = wave >> 1, hq = kvh * 4 + g;
        bf16x8 qfn[4];
        { const bf16_t* qp = PROJ + (rowq0 + 64 * (wave & 1) + c31) * IN_COLS + C_Q + hq * 64 + 8 * h;
#pragma unroll
          for (int ks = 0; ks < 4; ++ks) qfn[ks] = *(const bf16x8*)(qp + 16 * ks); }
        __syncthreads();
        const float sink = p->in[10][l * NQH + hq];
        LAS const float* biasd = (LAS const float*)(lds + AT_BIAS) + g * 128;
        LAS float* wsf = (LAS float*)(lds + AT_WS + wave * 256);
#pragma unroll 1
        for (int qi = 0; qi < 2; ++qi) {
            const int qt = 2 * (wave & 1) + qi, q0 = 32 * qt;
            bf16x8 qf[4];
#pragma unroll
            for (int ks = 0; ks < 4; ++ks) qf[ks] = qfn[ks];
            if (qi == 0) { const bf16_t* qp = PROJ + (rowq0 + q0 + 32 + c31) * IN_COLS + C_Q + hq * 64 + 8 * h;
#pragma unroll
                for (int ks = 0; ks < 4; ++ks) qfn[ks] = *(const bf16x8*)(qp + 16 * ks); }
            f32x16 S[5];
#pragma unroll
            for (int j = 0; j < 5; ++j) {
                S[j] = (f32x16){};
                LAS const unsigned char* kp = lds + AT_K + (32 * (qt + j) + c31) * AT_KSTR + 16 * h;
#pragma unroll
                for (int ks = 0; ks < 4; ++ks) S[j] = MFMA32(*(LAS const bf16x8*)(kp + 32 * ks), qf[ks], S[j]);
            }
            asm volatile("s_nop 15\n\ts_nop 7" : "+v"(S[0]), "+v"(S[1]), "+v"(S[2]), "+v"(S[3]), "+v"(S[4]));
            float gav[16][2];
#pragma unroll
            for (int r = 0; r < 16; ++r) {
                const bf16_t* rowp = PROJ + (rowq0 + q0 + (r & 3) + 8 * (r >> 2) + 4 * h) * IN_COLS + hq * 64 + c31;
                gav[r][0] = bf2f(rowp[C_GA]); gav[r][1] = bf2f(rowp[C_GA + 32]);
            }
            const int iq = q0 + c31;
            float mx = sink;
#pragma unroll
            for (int j = 0; j < 5; ++j)
#pragma unroll
                for (int r = 0; r < 16; ++r) {
                    const int kv = 32 * (qt + j) + (r & 3) + 8 * (r >> 2) + 4 * h;
                    const int dist = iq + 128 - kv;
                    const bool ok = (dist >= 0) && (dist < 128) && (nb > 0 || kv >= 128);
                    const float s = ok ? S[j][r] * 0.125f + biasd[dist & 127] : -1e30f;
                    S[j][r] = s; mx = fmaxf(mx, s);
                }
            { const Halves hh = halves(mx); mx = fmaxf(hh.lo, hh.hi); }
            float sum = 0.f;
#pragma unroll
            for (int j = 0; j < 5; ++j)
#pragma unroll
                for (int r = 0; r < 16; ++r) { const float e = S[j][r] > -1e29f ? __expf(S[j][r] - mx) : 0.f; S[j][r] = e; sum += e; }
            { const Halves hh = halves(sum); sum = hh.lo + hh.hi; }
            const float rden = 1.0f / (sum + __expf(sink - mx));
            if (h == 0) wsf[c31] = rden;
            f32x16 O[2]; O[0] = (f32x16){}; O[1] = (f32x16){};
            const int i16 = lane & 15, qq = i16 >> 2, pp = i16 & 3, blk = (lane >> 4) & 1;
#pragma unroll
            for (int j = 0; j < 5; ++j)
#pragma unroll
                for (int s = 0; s < 2; ++s) {
                    const bf16x8 pf = pack8(S[j][8 * s], S[j][8 * s + 1], S[j][8 * s + 2], S[j][8 * s + 3], S[j][8 * s + 4], S[j][8 * s + 5], S[j][8 * s + 6], S[j][8 * s + 7]);
                    LAS const unsigned char* vp = lds + AT_V + (32 * (qt + j) + 16 * s + 4 * h + qq) * AT_VSTR + (16 * blk + 4 * pp) * 2;
#pragma unroll
                    for (int dt = 0; dt < 2; ++dt) {
                        const bf16x8 vf = cat8(tr_read(vp + dt * 64), tr_read(vp + dt * 64 + 8 * AT_VSTR));
                        O[dt] = MFMA32(pf, vf, O[dt]);
                    }
                }
            MFMA_SETTLE2(O[0], O[1]);
            WAVE_LDS_SYNC();
#pragma unroll
            for (int r = 0; r < 16; ++r) {
                const int qr = (r & 3) + 8 * (r >> 2) + 4 * h;
                const float rd = wsf[qr];
                bf16_t* rowp = PROJ + (rowq0 + q0 + qr) * IN_COLS + hq * 64 + c31;
#pragma unroll
                for (int dt = 0; dt < 2; ++dt) if (!dry) rowp[C_Q + 32 * dt] = f2bf(O[dt][r] * rd * siluf_(gav[r][dt]));
            }
            WAVE_LDS_SYNC();
        }
        __syncthreads();
    }
}

constexpr int S5_NPOW = 11, S5_NINV = 9, S5_NSEG = 8, S5_SEGLEN = 256;
__device__ __forceinline__ float neg_expm1_small(float y) {
    float q = 1.0f / 5040.0f; q = q * y + 1.0f / 720.0f; q = q * y + 1.0f / 120.0f; q = q * y + 1.0f / 24.0f; q = q * y + 1.0f / 6.0f; q = q * y + 0.5f; q = q * y + 1.0f; return -(q * y);
}
__device__ __forceinline__ f32x2_t cmul(f32x2_t a, f32x2_t b) { return (f32x2_t){a.x * b.x - a.y * b.y, a.x * b.y + a.y * b.x}; }

__device__ __forceinline__ void st_s5_tables2(KP p, const Ctx& c) {
    f32x2_t* POW = (f32x2_t*)(p->ws + WS_S5POW); f32x2_t* PINV = (f32x2_t*)(p->ws + WS_S5PINV);
    bf16_t* BCAT = (bf16_t*)(p->ws + WS_S5BCAT); bf16_t* CCAT = (bf16_t*)(p->ws + WS_S5CCAT);
    const float* BB = (const float*)(p->ws + WS_TAB + TAB_BB);
    for (size_t ii = c.gt; ii < (size_t)DEPTH * NG * NP * (S5_NPOW + S5_NINV); ii += c.ngt) {
        const int k = (int)(ii % (S5_NPOW + S5_NINV)), i = (int)(ii / (S5_NPOW + S5_NINV)), lg = i / NP, pp = i % NP;
        const double lr = (double)fminf(p->in[12][i], -1e-4f), li = (double)p->in[13][i];
        const double step = (double)expf(p->in[14][lg]);
        const int e = k < 9 ? k : (k == 9 ? 64 : (k == 10 ? 256 : -(k - S5_NPOW)));
        double t = (double)e * li * step * 0.15915494309189535; t -= rint(t);
        float sn, cs; sincosf((float)(t * 6.283185307179586), &sn, &cs);
        const float mag = expf((float)((double)e * lr * step));
        const f32x2_t v = {mag * cs, mag * sn};
        if (k < S5_NPOW) POW[((size_t)lg * S5_NPOW + k) * NP + pp] = v; else PINV[((size_t)lg * S5_NINV + (k - S5_NPOW)) * NP + pp] = v;
    }
    for (size_t ii = c.gt; ii < (size_t)DEPTH * NG * 128 * NC; ii += c.ngt) {
        const int i = (int)ii, lg = i / (128 * NC), n = (i / NC) % 128, cc = i % NC, pp = n & 63;
        const int sidx = lg * NP + pp;
        const float lr = fminf(p->in[12][sidx], -1e-4f), li = p->in[13][sidx];
        const float step = expf(p->in[14][lg]);
        const float mag = expf(lr * step);
        float sn, cs; sincosf(li * step, &sn, &cs);
        const float ab_re = mag * cs, ab_im = mag * sn, den = lr * lr + li * li;
        const float f_re = ((ab_re - 1.0f) * lr + ab_im * li) / den, f_im = (ab_im * lr - (ab_re - 1.0f) * li) / den;
        const float bre = p->in[15][(size_t)sidx * NC + cc], bim = p->in[16][(size_t)sidx * NC + cc];
        BCAT[i] = f2bf(n < 64 ? f_re * bre - f_im * bim : f_re * bim + f_im * bre);
        const int c2 = (i / 128) % NC, n2 = i % 128, p2 = n2 & 63;
        const float cv = n2 < 64 ? p->in[17][((size_t)lg * NC + c2) * NP + p2] : -p->in[18][((size_t)lg * NC + c2) * NP + p2];
        CCAT[i] = f2bf(cv);
    }
}

__device__ __forceinline__ void s5_xtiles(f32x16 (&xr)[2], f32x16 (&xi)[2], const bf16x8 (&uf)[2], bf16x8 bre, bf16x8 bim) {
#pragma unroll
    for (int m = 0; m < 2; ++m) { xr[m] = MFMA32(uf[m], bre, (f32x16){}); xi[m] = MFMA32(uf[m], bim, (f32x16){}); }
    asm volatile("s_nop 15\n\ts_nop 7" : "+v"(xr[0]), "+v"(xr[1]), "+v"(xi[0]), "+v"(xi[1]));
}

__device__ __forceinline__ void st_s5_phaseA(KP p, int l, const Ctx& c) {
    const bf16_t* PROJ = (const bf16_t*)(p->ws + WS_PROJ);
    const f32x2_t* POW = (const f32x2_t*)(p->ws + WS_S5POW);
    const bf16_t* BCAT = (const bf16_t*)(p->ws + WS_S5BCAT);
    f32x2_t* SUM = (f32x2_t*)(p->ws + WS_S5SUM);
    const int lane = c.lane, c31 = lane & 31, h = lane >> 5;
    for (int item = c.gw; item < BATCH * S5_NSEG * NG; item += c.ngw) {
        const int g = item % NG, seg = (item / NG) % S5_NSEG, b = item / (NG * S5_NSEG);
        const int lg = l * NG + g;
        const size_t row0 = (size_t)b * SEQ + (size_t)seg * S5_SEGLEN;
#pragma unroll 1
        for (int pt = 0; pt < 2; ++pt) {
            const int pp = 32 * pt + c31;
            const f32x2_t* pw = POW + (size_t)lg * S5_NPOW * NP + pp;
            f32x2_t lo[4];
#pragma unroll
            for (int s = 0; s < 4; ++s) lo[s] = pw[(7 - 4 * h - s) * NP];
            const f32x2_t a8 = pw[8 * NP], a64 = pw[9 * NP];
            const bf16x8 bre = *(const bf16x8*)(BCAT + ((size_t)lg * 128 + pp) * NC + 8 * h);
            const bf16x8 bim = *(const bf16x8*)(BCAT + ((size_t)lg * 128 + 64 + pp) * NC + 8 * h);
            f32x2_t sseg = {0.f, 0.f};
            bf16x8 ufn[2];
#pragma unroll
            for (int m = 0; m < 2; ++m) ufn[m] = *(const bf16x8*)(PROJ + (row0 + 32 * m + c31) * IN_COLS + C_UB + 16 * g + 8 * h);
#pragma unroll 1
            for (int ch = 0; ch < 4; ++ch) {
                bf16x8 uf[2];
#pragma unroll
                for (int m = 0; m < 2; ++m) { uf[m] = ufn[m]; if (ch < 3) ufn[m] = *(const bf16x8*)(PROJ + (row0 + 64 * ch + 64 + 32 * m + c31) * IN_COLS + C_UB + 16 * g + 8 * h); }
                f32x16 xr[2], xi[2];
                s5_xtiles(xr, xi, uf, bre, bim);
                f32x2_t f = {1.f, 0.f}, acc = {0.f, 0.f};
#pragma unroll
                for (int gi = 7; gi >= 0; --gi) {
                    const int m = gi >> 2, q = gi & 3;
                    f32x2_t t = {0.f, 0.f};
#pragma unroll
                    for (int s = 0; s < 4; ++s) { const f32x2_t x = {xr[m][4 * q + s], xi[m][4 * q + s]}; const f32x2_t w = cmul(lo[s], x); t.x += w.x; t.y += w.y; }
                    const f32x2_t w2 = cmul(f, t); acc.x += w2.x; acc.y += w2.y;
                    f = cmul(f, a8);
                }
                { const Halves hx = halves(acc.x), hy = halves(acc.y); acc.x = hx.lo + hx.hi; acc.y = hy.lo + hy.hi; }
                const f32x2_t d = cmul(a64, sseg); sseg.x = d.x + acc.x; sseg.y = d.y + acc.y;
            }
            if (h == 0) SUM[(((size_t)b * S5_NSEG + seg) * NG + g) * NP + pp] = sseg;
        }
    }
}

constexpr int S5_HT_STR = 144, S5_HT_BYTES = 64 * S5_HT_STR;
__device__ __forceinline__ void st_s5_phaseB(KP p, int l, const Ctx& c, LAS unsigned char* lds, bool dry) {
    bf16_t* PROJ = (bf16_t*)(p->ws + WS_PROJ);
    const f32x2_t* POW = (const f32x2_t*)(p->ws + WS_S5POW); const f32x2_t* PINV = (const f32x2_t*)(p->ws + WS_S5PINV);
    const bf16_t* BCAT = (const bf16_t*)(p->ws + WS_S5BCAT); const bf16_t* CCAT = (const bf16_t*)(p->ws + WS_S5CCAT);
    const f32x2_t* SUM = (const f32x2_t*)(p->ws + WS_S5SUM);
    const int lane = c.lane, c31 = lane & 31, h = lane >> 5, i16 = lane & 15, kg = lane >> 4, qq = i16 >> 2, p4 = i16 & 3;
    LAS unsigned char* ht = lds + c.wave * S5_HT_BYTES;
    bf16x8 tdiag[2], tones;
#pragma unroll
    for (int s = 0; s < 2; ++s)
#pragma unroll
        for (int j = 0; j < 8; ++j) tdiag[s][j] = (16 * s + 8 * (j >> 2) + 4 * h + (j & 3) <= c31) ? (short)0x3F80 : (short)0;
#pragma unroll
    for (int j = 0; j < 8; ++j) tones[j] = (short)0x3F80;
    for (int item = c.gw; item < BATCH * S5_NSEG * NG; item += c.ngw) {
        const int g = item % NG, seg = (item / NG) % S5_NSEG, b = item / (NG * S5_NSEG);
        const int lg = l * NG + g;
        const size_t row0 = (size_t)b * SEQ + (size_t)seg * S5_SEGLEN;
        f32x2_t hin[2];
#pragma unroll
        for (int pt = 0; pt < 2; ++pt) {
            const int pp = 32 * pt + c31;
            const f32x2_t a256 = POW[((size_t)lg * S5_NPOW + 10) * NP + pp];
            f32x2_t H = {0.f, 0.f};
#pragma unroll
            for (int k = 0; k < S5_NSEG - 1; ++k) if (k < seg) { const f32x2_t sk = SUM[(((size_t)b * S5_NSEG + k) * NG + g) * NP + pp]; const f32x2_t d = cmul(a256, H); H.x = d.x + sk.x; H.y = d.y + sk.y; }
            hin[pt] = H;
        }
        const float dd = p->in[19][l * 512 + g * 16 + i16];
        bf16x8 ufn[2];
#pragma unroll
        for (int m = 0; m < 2; ++m) ufn[m] = *(const bf16x8*)(PROJ + (row0 + 32 * m + c31) * IN_COLS + C_UB + 16 * g + 8 * h);
#pragma unroll 1
        for (int ch = 0; ch < 4; ++ch) {
            const size_t crow0 = row0 + 64 * ch;
            bf16x8 uf[2];
#pragma unroll
            for (int m = 0; m < 2; ++m) { uf[m] = ufn[m]; if (ch < 3) ufn[m] = *(const bf16x8*)(PROJ + (crow0 + 64 + 32 * m + c31) * IN_COLS + C_UB + 16 * g + 8 * h); }
            f32x4 Y[4];
#pragma unroll
            for (int it = 0; it < 4; ++it) Y[it] = (f32x4){0.f, 0.f, 0.f, 0.f};
#pragma unroll 1
            for (int pt = 0; pt < 2; ++pt) {
                const f32x2_t hin_pt = pt ? hin[1] : hin[0];
                const int pp = 32 * pt + c31;
                const bf16x8 bre = *(const bf16x8*)(BCAT + ((size_t)lg * 128 + pp) * NC + 8 * h);
                const bf16x8 bim = *(const bf16x8*)(BCAT + ((size_t)lg * 128 + 64 + pp) * NC + 8 * h);
                const f32x2_t* pw = POW + (size_t)lg * S5_NPOW * NP + pp; const f32x2_t* pi = PINV + (size_t)lg * S5_NINV * NP + pp;
                asm volatile("" : "+v"(pw), "+v"(pi));
                f32x2_t ilo[4], plo[4];
#pragma unroll
                for (int s = 0; s < 4; ++s) { ilo[s] = pi[(4 * h + s) * NP]; plo[s] = pw[(4 * h + s) * NP]; }
                const f32x2_t ia8 = pi[8 * NP], a8 = pw[8 * NP], a1 = pw[1 * NP];
                bf16x8 cfv[2];
#pragma unroll
                for (int ks = 0; ks < 2; ++ks) cfv[ks] = *(const bf16x8*)(CCAT + ((size_t)lg * NC + i16) * 128 + 64 * ks + 32 * pt + 8 * kg);
                bf16x8 wfr[2][2], wfi[2][2];
                {
                    f32x2_t f = {1.f, 0.f};
#pragma unroll
                    for (int m = 0; m < 2; ++m) {
                        f32x16 xr = MFMA32(uf[m], bre, (f32x16){}), xi = MFMA32(uf[m], bim, (f32x16){});
                        MFMA_SETTLE2(xr, xi);
#pragma unroll
                        for (int q = 0; q < 4; ++q) {
#pragma unroll
                            for (int s = 0; s < 4; ++s) { const f32x2_t x = {xr[4 * q + s], xi[4 * q + s]}; const f32x2_t w = cmul(f, cmul(ilo[s], x)); xr[4 * q + s] = w.x; xi[4 * q + s] = w.y; }
                            f = cmul(f, ia8);
                        }
#pragma unroll
                        for (int s2 = 0; s2 < 2; ++s2) {
                            wfr[m][s2] = pack8(xr[8 * s2], xr[8 * s2 + 1], xr[8 * s2 + 2], xr[8 * s2 + 3], xr[8 * s2 + 4], xr[8 * s2 + 5], xr[8 * s2 + 6], xr[8 * s2 + 7]);
                            wfi[m][s2] = pack8(xi[8 * s2], xi[8 * s2 + 1], xi[8 * s2 + 2], xi[8 * s2 + 3], xi[8 * s2 + 4], xi[8 * s2 + 5], xi[8 * s2 + 6], xi[8 * s2 + 7]);
                        }
                        __builtin_amdgcn_sched_barrier(0);
                    }
                }
                const f32x2_t G = cmul(a1, hin_pt);
                f32x2_t hlast = {0.f, 0.f};
                WAVE_LDS_SYNC();
                {
                    f32x2_t f = {1.f, 0.f};
#pragma unroll
                    for (int m = 0; m < 2; ++m) {
                        f32x16 cr, ci;
                        if (m == 0) { cr = MFMA32(tdiag[1], wfr[0][1], MFMA32(tdiag[0], wfr[0][0], (f32x16){})); ci = MFMA32(tdiag[1], wfi[0][1], MFMA32(tdiag[0], wfi[0][0], (f32x16){})); }
                        else { cr = MFMA32(tdiag[1], wfr[1][1], MFMA32(tdiag[0], wfr[1][0], MFMA32(tones, wfr[0][1], MFMA32(tones, wfr[0][0], (f32x16){}))));
                               ci = MFMA32(tdiag[1], wfi[1][1], MFMA32(tdiag[0], wfi[1][0], MFMA32(tones, wfi[0][1], MFMA32(tones, wfi[0][0], (f32x16){})))); }
                        MFMA_SETTLE2(cr, ci);
#pragma unroll
                        for (int q = 0; q < 4; ++q) {
                            float hr[4], hi[4];
#pragma unroll
                            for (int s = 0; s < 4; ++s) { const f32x2_t v = {cr[4 * q + s] + G.x, ci[4 * q + s] + G.y}; const f32x2_t w = cmul(f, cmul(plo[s], v)); hr[s] = w.x; hi[s] = w.y; }
                            if (m == 1 && q == 3) { hlast.x = hr[3]; hlast.y = hi[3]; }
                            typedef unsigned u32x2_t __attribute__((ext_vector_type(2)));
                            u32x2_t wr_; wr_.x = cvtpk(hr[0], hr[1]); wr_.y = cvtpk(hr[2], hr[3]);
                            u32x2_t wi_; wi_.x = cvtpk(hi[0], hi[1]); wi_.y = cvtpk(hi[2], hi[3]);
                            *(LAS u32x2_t*)(ht + c31 * S5_HT_STR + (32 * m + 8 * q + 4 * h) * 2) = wr_;
                            *(LAS u32x2_t*)(ht + (32 + c31) * S5_HT_STR + (32 * m + 8 * q + 4 * h) * 2) = wi_;
                            f = cmul(f, a8);
                        }
                        __builtin_amdgcn_sched_barrier(0);
                    }
                }
                { const f32x2_t hn = {halves(hlast.x).hi, halves(hlast.y).hi}; if (pt) hin[1] = hn; else hin[0] = hn; }
                WAVE_LDS_SYNC();
#pragma unroll
                for (int ks = 0; ks < 2; ++ks) {
                    const bf16x8 cf = cfv[ks];
#pragma unroll
                    for (int it = 0; it < 4; ++it) {
                        LAS const unsigned char* ap = ht + (32 * ks + 8 * kg + qq) * S5_HT_STR + (16 * it + 4 * p4) * 2;
                        const bf16x8 af = cat8(tr_read(ap), tr_read(ap + 4 * S5_HT_STR));
                        Y[it] = MFMA16(af, cf, Y[it]);
                    }
                }
            }
            asm volatile("s_nop 15\n\ts_nop 7" : "+v"(Y[0]), "+v"(Y[1]), "+v"(Y[2]), "+v"(Y[3]));
            float uu[4][4];
#pragma unroll
            for (int it = 0; it < 4; ++it)
#pragma unroll
                for (int r = 0; r < 4; ++r) uu[it][r] = bf2f(PROJ[(crow0 + 16 * it + 4 * kg + r) * IN_COLS + C_UB + 16 * g + i16]);
#pragma unroll
            for (int it = 0; it < 4; ++it)
#pragma unroll
                for (int r = 0; r < 4; ++r) {
                    bf16_t* up = PROJ + (crow0 + 16 * it + 4 * kg + r) * IN_COLS + C_UB + 16 * g + i16;
                    const float y = Y[it][r] + dd * uu[it][r];
                    if (!dry) *up = f2bf(gelu_tanh(y));
                }
        }
        if (seg == S5_NSEG - 1 && h == 0) {
#pragma unroll
            for (int pt = 0; pt < 2; ++pt) { const size_t oi = (((size_t)l * BATCH + b) * NG + g) * NP + 32 * pt + c31; p->out[O_SRP + oi] = hin[pt].x; p->out[O_SIP + oi] = hin[pt].y; }
        }
    }
}

__device__ __forceinline__ void st_s5_sample(KP p, int l, const Ctx& c, LAS unsigned char* lds, bool dry) {
    bf16_t* PROJ = (bf16_t*)(p->ws + WS_PROJ);
    const f32x2_t* POW = (const f32x2_t*)(p->ws + WS_S5POW); const f32x2_t* PINV = (const f32x2_t*)(p->ws + WS_S5PINV);
    const bf16_t* BCAT = (const bf16_t*)(p->ws + WS_S5BCAT); const bf16_t* CCAT = (const bf16_t*)(p->ws + WS_S5CCAT);
    LAS unsigned char* ht = lds + c.wave * S5_HT_BYTES;
    for (int item = c.gw; item < (DEC_BATCH / 16) * NG; item += c.ngw) {
        int zi = 0; asm volatile("" : "+v"(zi));
        const int lane = c.lane + zi, c31 = lane & 31, h = lane >> 5, i16 = lane & 15, kg = lane >> 4, qq = i16 >> 2, p4 = i16 & 3;
        const int g = item % NG, sg = item / NG, lg = l * NG + g;
        const size_t crow0 = (size_t)M_P + 64 * sg;
        bf16x8 tds[2];
#pragma unroll
        for (int s = 0; s < 2; ++s)
#pragma unroll
            for (int j = 0; j < 8; ++j) { const int kr = 16 * s + 8 * (j >> 2) + 4 * h + (j & 3); tds[s][j] = ((kr >> 2) == (c31 >> 2) && kr <= c31) ? (short)0x3F80 : (short)0; }
        const float dd = p->in[19][l * 512 + g * 16 + i16];
        bf16x8 uf[2];
#pragma unroll
        for (int m = 0; m < 2; ++m) uf[m] = *(const bf16x8*)(PROJ + (crow0 + 32 * m + c31) * IN_COLS + C_UB + 16 * g + 8 * h);
        f32x4 Y[4];
#pragma unroll
        for (int it = 0; it < 4; ++it) Y[it] = (f32x4){0.f, 0.f, 0.f, 0.f};
#pragma unroll
        for (int pt = 0; pt < 2; ++pt) {
            const int pp = 32 * pt + c31;
            const bf16x8 bre = *(const bf16x8*)(BCAT + ((size_t)lg * 128 + pp) * NC + 8 * h);
            const bf16x8 bim = *(const bf16x8*)(BCAT + ((size_t)lg * 128 + 64 + pp) * NC + 8 * h);
            const f32x2_t* pw = POW + (size_t)lg * S5_NPOW * NP + pp; const f32x2_t* pi = PINV + (size_t)lg * S5_NINV * NP + pp;
            f32x2_t ilo[4], plo[4];
#pragma unroll
            for (int s = 0; s < 4; ++s) { ilo[s] = pi[s * NP]; plo[s] = pw[s * NP]; }
            const f32x2_t a1 = pw[1 * NP];
            WAVE_LDS_SYNC();
#pragma unroll
            for (int m = 0; m < 2; ++m) {
                f32x16 xr = MFMA32(uf[m], bre, (f32x16){}), xi = MFMA32(uf[m], bim, (f32x16){});
                MFMA_SETTLE2(xr, xi);
#pragma unroll
                for (int q = 0; q < 4; ++q)
#pragma unroll
                    for (int s = 0; s < 4; ++s) { const f32x2_t x = {xr[4 * q + s], xi[4 * q + s]}; const f32x2_t w = cmul(ilo[s], x); xr[4 * q + s] = w.x; xi[4 * q + s] = w.y; }
                bf16x8 wr0 = pack8(xr[0], xr[1], xr[2], xr[3], xr[4], xr[5], xr[6], xr[7]), wr1 = pack8(xr[8], xr[9], xr[10], xr[11], xr[12], xr[13], xr[14], xr[15]);
                bf16x8 wi0 = pack8(xi[0], xi[1], xi[2], xi[3], xi[4], xi[5], xi[6], xi[7]), wi1 = pack8(xi[8], xi[9], xi[10], xi[11], xi[12], xi[13], xi[14], xi[15]);
                f32x16 cr = MFMA32(tds[1], wr1, MFMA32(tds[0], wr0, (f32x16){})), ci = MFMA32(tds[1], wi1, MFMA32(tds[0], wi0, (f32x16){}));
                MFMA_SETTLE2(cr, ci);
#pragma unroll
                for (int q = 0; q < 4; ++q) {
                    const int seq = 16 * sg + 8 * m + 2 * q + h;
                    const size_t si = (((size_t)l * DEC_BATCH + seq) * NG + g) * NP + pp;
                    const f32x2_t G = cmul(a1, (f32x2_t){p->in[4][si], p->in[5][si]});
                    float hr[4], hi[4];
#pragma unroll
                    for (int s = 0; s < 4; ++s) { const f32x2_t v = {cr[4 * q + s] + G.x, ci[4 * q + s] + G.y}; const f32x2_t w = cmul(plo[s], v); hr[s] = w.x; hi[s] = w.y; }
                    p->out[O_SRS + si] = hr[3]; p->out[O_SIS + si] = hi[3];
                    typedef unsigned u32x2_t __attribute__((ext_vector_type(2)));
                    u32x2_t wr_; wr_.x = cvtpk(hr[0], hr[1]); wr_.y = cvtpk(hr[2], hr[3]);
                    u32x2_t wi_; wi_.x = cvtpk(hi[0], hi[1]); wi_.y = cvtpk(hi[2], hi[3]);
                    *(LAS u32x2_t*)(ht + c31 * S5_HT_STR + (32 * m + 8 * q + 4 * h) * 2) = wr_;
                    *(LAS u32x2_t*)(ht + (32 + c31) * S5_HT_STR + (32 * m + 8 * q + 4 * h) * 2) = wi_;
                }
                __builtin_amdgcn_sched_barrier(0);
            }
            WAVE_LDS_SYNC();
#pragma unroll
            for (int ks = 0; ks < 2; ++ks) {
                const bf16x8 cf = *(const bf16x8*)(CCAT + ((size_t)lg * NC + i16) * 128 + 64 * ks + 32 * pt + 8 * kg);
#pragma unroll
                for (int it = 0; it < 4; ++it) {
                    LAS const unsigned char* ap = ht + (32 * ks + 8 * kg + qq) * S5_HT_STR + (16 * it + 4 * p4) * 2;
                    const bf16x8 af = cat8(tr_read(ap), tr_read(ap + 4 * S5_HT_STR));
                    Y[it] = MFMA16(af, cf, Y[it]);
                }
            }
        }
        asm volatile("s_nop 15\n\ts_nop 7" : "+v"(Y[0]), "+v"(Y[1]), "+v"(Y[2]), "+v"(Y[3]));
        float uu[4][4];
#pragma unroll
        for (int it = 0; it < 4; ++it)
#pragma unroll
            for (int r = 0; r < 4; ++r) uu[it][r] = bf2f(PROJ[(crow0 + 16 * it + 4 * kg + r) * IN_COLS + C_UB + 16 * g + i16]);
#pragma unroll
        for (int it = 0; it < 4; ++it)
#pragma unroll
            for (int r = 0; r < 4; ++r) {
                bf16_t* up = PROJ + (crow0 + 16 * it + 4 * kg + r) * IN_COLS + C_UB + 16 * g + i16;
                const float y = Y[it][r] + dd * uu[it][r];
                if (!dry) *up = f2bf(gelu_tanh(y));
            }
    }
}

__device__ __forceinline__ void st_lru_sample(KP p, int l, const Ctx& c, LAS unsigned char* lds, bool dry) {
    bf16_t* PROJ = (bf16_t*)(p->ws + WS_PROJ);
    const bf16_t* LRUW = (const bf16_t*)(p->ws + WS_LRUW);
    for (int item = c.gw; item < (DEC_BATCH / 16) * 8; item += c.ngw) {
        int zi = 0; asm volatile("" : "+v"(zi));
        const int lane = c.lane + zi, c31 = lane & 31, h = lane >> 5;
        const int n = item & 7, sg = item >> 3;
        const size_t row0 = (size_t)M_P + 64 * sg;
        const int ch0 = n * 64;
        LAS unsigned char* xim = lds + c.wave * 9216;
        WAVE_LDS_SYNC();
#pragma unroll 1
        for (int ks = 0; ks < 4; ++ks) {
            const int chb = ch0 + 16 * ks + 8 * h;
            float w[4][8], cb[8];
#pragma unroll
            for (int j = 0; j < 4; ++j) {
                const f32x4 w0 = *(const f32x4*)(p->in[22] + (l * 4 + j) * 512 + chb), w1 = *(const f32x4*)(p->in[22] + (l * 4 + j) * 512 + chb + 4);
                w[j][0] = w0[0]; w[j][1] = w0[1]; w[j][2] = w0[2]; w[j][3] = w0[3]; w[j][4] = w1[0]; w[j][5] = w1[1]; w[j][6] = w1[2]; w[j][7] = w1[3];
            }
            { const f32x4 b0 = *(const f32x4*)(p->in[23] + l * 512 + chb), b1 = *(const f32x4*)(p->in[23] + l * 512 + chb + 4);
              cb[0] = b0[0]; cb[1] = b0[1]; cb[2] = b0[2]; cb[3] = b0[3]; cb[4] = b1[0]; cb[5] = b1[1]; cb[6] = b1[2]; cb[7] = b1[3]; }
#pragma unroll
            for (int m = 0; m < 2; ++m) {
                const int i = 32 * m + c31, t = i & 3, seq = 16 * sg + (i >> 2);
                float xf[8];
#pragma unroll
                for (int e = 0; e < 8; ++e) xf[e] = cb[e];
#pragma unroll
                for (int j = 0; j < 4; ++j) {
                    const int tau = t - 3 + j;
                    float xv[8];
                    if (tau >= 0) {
                        const u32x4 xx = *(const u32x4*)(PROJ + ((size_t)M_P + 4 * seq + tau) * IN_COLS + C_XC + chb);
#pragma unroll
                        for (int e = 0; e < 4; ++e) { xv[2 * e] = __uint_as_float(xx[e] << 16); xv[2 * e + 1] = __uint_as_float(xx[e] & 0xffff0000u); }
                    } else {
                        const float* cp = p->in[7] + (((size_t)l * DEC_BATCH + seq) * 3 + (3 + tau)) * 512 + chb;
                        const f32x4 c0 = *(const f32x4*)cp, c1 = *(const f32x4*)(cp + 4);
                        xv[0] = c0[0]; xv[1] = c0[1]; xv[2] = c0[2]; xv[3] = c0[3]; xv[4] = c1[0]; xv[5] = c1[1]; xv[6] = c1[2]; xv[7] = c1[3];
                    }
#pragma unroll
                    for (int e = 0; e < 8; ++e) xf[e] += w[j][e] * xv[e];
                }
                *(LAS bf16x8*)(xim + (32 * m + c31) * 144 + (16 * ks + 8 * h) * 2) = pack8(xf[0], xf[1], xf[2], xf[3], xf[4], xf[5], xf[6], xf[7]);
            }
        }
        WAVE_LDS_SYNC();
#pragma unroll 1
        for (int et = 0; et < 2; ++et) {
            const int ch = ch0 + 32 * et + c31;
            const float ba = p->in[25][l * 512 + ch], bx = p->in[27][l * 512 + ch];
            const float lsig8 = ((const float*)(p->ws + WS_LSIG))[l * 512 + ch];
            const bf16_t* wp = LRUW + (((size_t)(l * 8 + n) * 2) * 64 + 32 * et + c31) * 64 + 8 * h;
#pragma unroll
            for (int m = 0; m < 2; ++m) {
                f32x16 X = (f32x16){}, R = (f32x16){}, I = (f32x16){};
#pragma unroll
                for (int ks = 0; ks < 4; ++ks) {
                    const bf16x8 wa = *(const bf16x8*)(wp + 16 * ks), wx = *(const bf16x8*)(wp + 64 * 64 + 16 * ks);
                    bf16x8 id;
#pragma unroll
                    for (int j = 0; j < 8; ++j) id[j] = (16 * ks + 8 * h + j == 32 * et + c31) ? (short)0x3F80 : (short)0;
                    const bf16x8 afr = *(LAS const bf16x8*)(xim + (32 * m + c31) * 144 + (16 * ks + 8 * h) * 2);
                    R = MFMA32(afr, wa, R); I = MFMA32(afr, wx, I); X = MFMA32(afr, id, X);
                }
                MFMA_SETTLE3(R, I, X);
                float gcv[16], h0v[4];
#pragma unroll
                for (int q = 0; q < 4; ++q) {
                    const int seq = 16 * sg + 8 * m + 2 * q + h;
                    h0v[q] = p->in[6][((size_t)l * DEC_BATCH + seq) * 512 + ch];
#pragma unroll
                    for (int s = 0; s < 4; ++s) gcv[4 * q + s] = bf2f(PROJ[((size_t)M_P + 4 * seq + s) * IN_COLS + C_GC + ch]);
                }
#pragma unroll
                for (int q = 0; q < 4; ++q) {
                    const int seq = 16 * sg + 8 * m + 2 * q + h;
                    float hv = h0v[q];
#pragma unroll
                    for (int s = 0; s < 4; ++s) {
                        const int r = 4 * q + s;
                        const float rg = sigmoidf_(R[r] + ba), ig = sigmoidf_(I[r] + bx);
                        const float la = rg * lsig8;
                        const float a = __expf(la);
                        const float bg = X[r] * ig * __builtin_amdgcn_sqrtf((1.0f - a) * (1.0f + a));
                        hv = a * hv + bg;
                        bf16_t* gp = PROJ + ((size_t)M_P + 4 * seq + s) * IN_COLS + C_GC + ch;
                        const float gc = gcv[r];
                        if (!dry) *gp = f2bf(hv * siluf_(gc));
                    }
                    p->out[O_LS + ((size_t)l * DEC_BATCH + seq) * 512 + ch] = hv;
                }
                __builtin_amdgcn_sched_barrier(0);
            }
        }
    }
}

__device__ __forceinline__ void st_attn_sample(KP p, int l, LAS unsigned char* lds, bool dry, int wave_s) {
    int zv = 0; asm volatile("" : "+v"(zv));
    const int tid = tid_of(wave_s, zv), lane = tid & 63, wave = __builtin_amdgcn_readfirstlane(tid >> 6);
    const int c31 = lane & 31, h = lane >> 5;
    bf16_t* PROJ = (bf16_t*)(p->ws + WS_PROJ);
    const float* rel_bias = p->in[8];
    for (int item = blockIdx.x; item < DEC_BATCH * NKV; item += gridDim.x) {
        const int b = item >> 1, kvh = item & 1;
#pragma unroll
        for (int i = 0; i < 3; ++i) {
            const int id = tid + 512 * i, row = id >> 3, pc = id & 7;
            if (id < 160 * 8) {
                u32x4 kk = (u32x4){0u, 0u, 0u, 0u}, vv = kk;
                if (row < WINDOW) {
                    const size_t ci = ((((size_t)l * DEC_BATCH + b) * WINDOW + row) * NKV + kvh) * HD + pc * 8;
                    const f32x4 k0 = *(const f32x4*)(p->in[2] + ci), k1 = *(const f32x4*)(p->in[2] + ci + 4), v0 = *(const f32x4*)(p->in[3] + ci), v1 = *(const f32x4*)(p->in[3] + ci + 4);
                    kk.x = cvtpk(k0[0], k0[1]); kk.y = cvtpk(k0[2], k0[3]); kk.z = cvtpk(k1[0], k1[1]); kk.w = cvtpk(k1[2], k1[3]);
                    vv.x = cvtpk(v0[0], v0[1]); vv.y = cvtpk(v0[2], v0[3]); vv.z = cvtpk(v1[0], v1[1]); vv.w = cvtpk(v1[2], v1[3]);
                } else if (row < WINDOW + DEC_SEQ) {
                    const bf16_t* src = PROJ + ((size_t)M_P + 4 * b + (row - WINDOW)) * IN_COLS + kvh * 64 + pc * 8;
                    kk = *(const u32x4*)(src + C_K); vv = *(const u32x4*)(src + C_V);
                }
                *(LAS u32x4*)(lds + AT_K + row * AT_KSTR + pc * 16) = kk;
                *(LAS u32x4*)(lds + AT_V + row * AT_VSTR + pc * 16) = vv;
            }
        }
        { const int g = tid >> 7, d = tid & 127; ((LAS float*)(lds + AT_BIAS))[tid] = rel_bias[T5_BUCKET[d] * NQH + kvh * 4 + g]; }
        __syncthreads();
        if (wave == 0) {
            const int qc = c31 & 15, g = qc >> 2, iq = qc & 3, hq = kvh * 4 + g;
            const float sink = p->in[10][l * NQH + hq];
            LAS const float* biasd = (LAS const float*)(lds + AT_BIAS) + g * 128;
            LAS float* wsf = (LAS float*)(lds + AT_WS);
            bf16x8 qf[4];
            { const bf16_t* qp = PROJ + ((size_t)M_P + 4 * b + iq) * IN_COLS + C_Q + hq * 64 + 8 * h;
#pragma unroll
              for (int ks = 0; ks < 4; ++ks) qf[ks] = *(const bf16x8*)(qp + 16 * ks); }
            f32x16 S[5];
#pragma unroll
            for (int j = 0; j < 5; ++j) {
                S[j] = (f32x16){};
                LAS const unsigned char* kp = lds + AT_K + (32 * j + c31) * AT_KSTR + 16 * h;
#pragma unroll
                for (int ks = 0; ks < 4; ++ks) S[j] = MFMA32(*(LAS const bf16x8*)(kp + 32 * ks), qf[ks], S[j]);
            }
            asm volatile("s_nop 15\n\ts_nop 7" : "+v"(S[0]), "+v"(S[1]), "+v"(S[2]), "+v"(S[3]), "+v"(S[4]));
            float mx = sink;
#pragma unroll
            for (int j = 0; j < 5; ++j)
#pragma unroll
                for (int r = 0; r < 16; ++r) {
                    const int kv = 32 * j + (r & 3) + 8 * (r >> 2) + 4 * h;
                    const int dist = iq + 128 - kv;
                    const bool ok = (dist >= 0) && (dist < 128);
                    const float s = ok ? S[j][r] * 0.125f + biasd[dist & 127] : -1e30f;
                    S[j][r] = s; mx = fmaxf(mx, s);
                }
            { const Halves hh = halves(mx); mx = fmaxf(hh.lo, hh.hi); }
            float sum = 0.f;
#pragma unroll
            for (int j = 0; j < 5; ++j)
#pragma unroll
                for (int r = 0; r < 16; ++r) { const float e = S[j][r] > -1e29f ? __expf(S[j][r] - mx) : 0.f; S[j][r] = e; sum += e; }
            { const Halves hh = halves(sum); sum = hh.lo + hh.hi; }
            const float rden = 1.0f / (sum + __expf(sink - mx));
            if (h == 0) wsf[c31] = rden;
            f32x16 O[2]; O[0] = (f32x16){}; O[1] = (f32x16){};
            const int i16 = lane & 15, qq = i16 >> 2, pp = i16 & 3, blk = (lane >> 4) & 1;
#pragma unroll
            for (int j = 0; j < 5; ++j)
#pragma unroll
                for (int s = 0; s < 2; ++s) {
                    const bf16x8 pf = pack8(S[j][8 * s], S[j][8 * s + 1], S[j][8 * s + 2], S[j][8 * s + 3], S[j][8 * s + 4], S[j][8 * s + 5], S[j][8 * s + 6], S[j][8 * s + 7]);
                    LAS const unsigned char* vp = lds + AT_V + (32 * j + 16 * s + 4 * h + qq) * AT_VSTR + (16 * blk + 4 * pp) * 2;
#pragma unroll
                    for (int dt = 0; dt < 2; ++dt) {
                        const bf16x8 vf = cat8(tr_read(vp + dt * 64), tr_read(vp + dt * 64 + 8 * AT_VSTR));
                        O[dt] = MFMA32(pf, vf, O[dt]);
                    }
                }
            MFMA_SETTLE2(O[0], O[1]);
            WAVE_LDS_SYNC();
            float gav[8][2];
#pragma unroll
            for (int r = 0; r < 8; ++r) {
                const int qr = (r & 3) + 8 * (r >> 2) + 4 * h, g2 = qr >> 2, i2 = qr & 3;
                const bf16_t* rowp = PROJ + ((size_t)M_P + 4 * b + i2) * IN_COLS + (kvh * 4 + g2) * 64 + c31;
                gav[r][0] = bf2f(rowp[C_GA]); gav[r][1] = bf2f(rowp[C_GA + 32]);
            }
#pragma unroll
            for (int r = 0; r < 8; ++r) {
                const int qr = (r & 3) + 8 * (r >> 2) + 4 * h, g2 = qr >> 2, i2 = qr & 3;
                const float rd = wsf[qr];
                bf16_t* rowp = PROJ + ((size_t)M_P + 4 * b + i2) * IN_COLS + (kvh * 4 + g2) * 64 + c31;
#pragma unroll
                for (int dt = 0; dt < 2; ++dt) if (!dry) rowp[C_Q + 32 * dt] = f2bf(O[dt][r] * rd * siluf_(gav[r][dt]));
            }
        }
        __syncthreads();
    }
}

constexpr int LR_NSEG = 32;
template <bool PHASE_B>
__device__ __forceinline__ void st_lru_mfma(KP p, int l, const Ctx& c, LAS unsigned char* lds, bool dry) {
    bf16_t* PROJ = (bf16_t*)(p->ws + WS_PROJ);
    const bf16_t* LRUW = (const bf16_t*)(p->ws + WS_LRUW);
    f32x2_t* LSUM = (f32x2_t*)(p->ws + WS_LRSUM);
    for (int item = c.gw; item < BATCH * LR_NSEG * 8; item += c.ngw) {
        int zi = 0; asm volatile("" : "+v"(zi));
        const int lane = c.lane + zi, c31 = lane & 31, h = lane >> 5;
        const int n = item & 7, seg = (item >> 3) % LR_NSEG, b = item / (8 * LR_NSEG);
        const size_t row0 = (size_t)b * SEQ + (size_t)seg * 64;
        const int ch0 = n * 64;
        LAS unsigned char* xim = lds + c.wave * 9216;
        WAVE_LDS_SYNC();
#pragma unroll 2
        for (int ks = 0; ks < 4; ++ks) {
            const int chb = ch0 + 16 * ks + 8 * h;
            float w[4][8], cb[8];
#pragma unroll
            for (int j = 0; j < 4; ++j) {
                const f32x4 w0 = *(const f32x4*)(p->in[22] + (l * 4 + j) * 512 + chb), w1 = *(const f32x4*)(p->in[22] + (l * 4 + j) * 512 + chb + 4);
                w[j][0] = w0[0]; w[j][1] = w0[1]; w[j][2] = w0[2]; w[j][3] = w0[3]; w[j][4] = w1[0]; w[j][5] = w1[1]; w[j][6] = w1[2]; w[j][7] = w1[3];
            }
            { const f32x4 b0 = *(const f32x4*)(p->in[23] + l * 512 + chb), b1 = *(const f32x4*)(p->in[23] + l * 512 + chb + 4);
              cb[0] = b0[0]; cb[1] = b0[1]; cb[2] = b0[2]; cb[3] = b0[3]; cb[4] = b1[0]; cb[5] = b1[1]; cb[6] = b1[2]; cb[7] = b1[3]; }
            u32x4 xx4[2][4];
#pragma unroll
            for (int m = 0; m < 2; ++m)
#pragma unroll
                for (int j = 0; j < 4; ++j) { const int t = seg * 64 + 32 * m + c31; const int dr = (t - 3 + j >= 0) ? (32 * m + c31 - 3 + j) : 0; xx4[m][j] = *(const u32x4*)(PROJ + (row0 + dr) * IN_COLS + C_XC + chb); }
#pragma unroll
            for (int m = 0; m < 2; ++m) {
                const int t = seg * 64 + 32 * m + c31;
                float xf[8];
#pragma unroll
                for (int e = 0; e < 8; ++e) xf[e] = cb[e];
#pragma unroll
                for (int j = 0; j < 4; ++j) {
                    const u32x4 xx = (t - 3 + j >= 0) ? xx4[m][j] : (u32x4){0u, 0u, 0u, 0u};
#pragma unroll
                    for (int e = 0; e < 4; ++e) { xf[2 * e] += w[j][2 * e] * __uint_as_float(xx[e] << 16); xf[2 * e + 1] += w[j][2 * e + 1] * __uint_as_float(xx[e] & 0xffff0000u); }
                }
                *(LAS bf16x8*)(xim + (32 * m + c31) * 144 + (16 * ks + 8 * h) * 2) = pack8(xf[0], xf[1], xf[2], xf[3], xf[4], xf[5], xf[6], xf[7]);
            }
        }
        WAVE_LDS_SYNC();
#pragma unroll 1
        for (int et = 0; et < 2; ++et) {
            const int ch = ch0 + 32 * et + c31;
            const float ba = -1.4426950408889634f * p->in[25][l * 512 + ch], bx = -1.4426950408889634f * p->in[27][l * 512 + ch];
            const float lsig8 = 1.4426950408889634f * ((const float*)(p->ws + WS_LSIG))[l * 512 + ch];
            const bf16_t* wp = LRUW + (((size_t)(l * 8 + n) * 2) * 64 + 32 * et + c31) * 64 + 8 * h;
            f32x16 R[2], I[2];
            float Ar[8], Br[8];
            __builtin_amdgcn_sched_barrier(0);
            bf16x8 waf[4], wxf[4];
#pragma unroll
            for (int ks = 0; ks < 4; ++ks) { waf[ks] = *(const bf16x8*)(wp + 16 * ks); wxf[ks] = *(const bf16x8*)(wp + 64 * 64 + 16 * ks); }
#pragma unroll
            for (int m = 0; m < 2; ++m) {
                f32x16 X = (f32x16){}; R[m] = (f32x16){}; I[m] = (f32x16){};
#pragma unroll
                for (int ks = 0; ks < 4; ++ks) {
                    bf16x8 id;
#pragma unroll
                    for (int j = 0; j < 8; ++j) id[j] = (16 * ks + 8 * h + j == 32 * et + c31) ? (short)0x3F80 : (short)0;
                    const bf16x8 afr = *(LAS const bf16x8*)(xim + (32 * m + c31) * 144 + (16 * ks + 8 * h) * 2);
                    R[m] = MFMA32(afr, waf[ks], R[m]); I[m] = MFMA32(afr, wxf[ks], I[m]); X = MFMA32(afr, id, X);
                }
                MFMA_SETTLE3(R[m], I[m], X);
#pragma unroll
                for (int q = 0; q < 4; ++q) {
                    float cp = 1.f, hl = 0.f;
#pragma unroll
                    for (int s = 0; s < 4; ++s) {
                        const int r = 4 * q + s;
                        const float rg = __builtin_amdgcn_rcpf(1.0f + __builtin_amdgcn_exp2f(__builtin_fmaf(R[m][r], -1.4426950408889634f, ba)));
                        const float ig = __builtin_amdgcn_rcpf(1.0f + __builtin_amdgcn_exp2f(__builtin_fmaf(I[m][r], -1.4426950408889634f, bx)));
                        const float a = __builtin_amdgcn_exp2f(rg * lsig8);
                        const float bg = X[r] * ig * __builtin_amdgcn_sqrtf((1.0f - a) * (1.0f + a));
                        cp *= a; hl = a * hl + bg;
                        R[m][r] = cp; I[m][r] = hl;
                    }
                    Ar[4 * m + q] = cp; Br[4 * m + q] = hl;
                }
                __builtin_amdgcn_sched_barrier(0);
            }
            float Hc = 0.f;
            if (PHASE_B) {
                for (int k0 = 0; k0 < seg; k0 += 16) {
                    f32x2_t ab[16];
#pragma unroll
                    for (int j = 0; j < 16; ++j) ab[j] = (k0 + j < seg) ? LSUM[((size_t)b * LR_NSEG + k0 + j) * 512 + ch] : (f32x2_t){1.f, 0.f};
#pragma unroll
                    for (int j = 0; j < 16; ++j) Hc = ab[j].x * Hc + ab[j].y;
                }
            }
            float st = Hc, At = 1.f, cin[8];
#pragma unroll
            for (int gi = 0; gi < 8; ++gi) {
                const Halves ha = halves(Ar[gi]), hb = halves(Br[gi]);
                const float A0 = ha.lo, B0 = hb.lo, A1 = ha.hi, B1 = hb.hi;
                const float s1 = A0 * st + B0;
                cin[gi] = h == 0 ? st : s1;
                st = A1 * s1 + B1; At *= A0 * A1;
            }
            if (!PHASE_B) {
                if (h == 0) LSUM[((size_t)b * LR_NSEG + seg) * 512 + ch] = (f32x2_t){At, st};
            } else {
#pragma unroll
                for (int m = 0; m < 2; ++m) {
                    float gcv[16];
#pragma unroll
                    for (int r = 0; r < 16; ++r) gcv[r] = bf2f(PROJ[(row0 + 32 * m + (r & 3) + 8 * (r >> 2) + 4 * h) * IN_COLS + C_GC + ch]);
#pragma unroll
                    for (int r = 0; r < 16; ++r) {
                        const float hv = I[m][r] + R[m][r] * cin[4 * m + (r >> 2)];
                        bf16_t* gp = PROJ + (row0 + 32 * m + (r & 3) + 8 * (r >> 2) + 4 * h) * IN_COLS + C_GC + ch;
                        const float gc = gcv[r];
                        if (!dry) *gp = f2bf(hv * siluf_(gc));
                        if (m == 1 && r == 15 && h == 1 && seg == LR_NSEG - 1) p->out[O_LP + ((size_t)l * BATCH + b) * 512 + ch] = hv;
                    }
                }
            }
        }
    }
}

__device__ __forceinline__ bf16_t* pre_row(unsigned char* ws, int r) { return (bf16_t*)(ws + WS_PROJ + (size_t)r * IN_COLS * 2 + (size_t)(C_GM + 1024) * 2); }
__device__ __forceinline__ void st_ln(KP p, int l, const Ctx& c) {
    const int lane = c.lane;
    const float* g = p->in[31] + l * 1024; const float* bb = p->in[32] + l * 1024;
    f32x4 gv[4], bv[4];
#pragma unroll
    for (int j = 0; j < 4; ++j) { const int cc = 512 * (j >> 1) + 8 * lane + 4 * (j & 1); gv[j] = *(const f32x4*)(g + cc); bv[j] = *(const f32x4*)(bb + cc); }
    constexpr int NR = 4;
    u32x4 cur[NR][2], nxt[NR][2];
#define LN_LOAD(dst, rb) do { _Pragma("unroll") for (int k = 0; k < NR; ++k) { const int r_ = (rb) + k < M_TOT ? (rb) + k : M_TOT - 1; const bf16_t* pr = pre_row(p->ws, r_); \
        dst[k][0] = *(const u32x4*)(pr + 8 * lane); dst[k][1] = *(const u32x4*)(pr + 512 + 8 * lane); } } while (0)
    int r0 = c.gw * NR;
    if (r0 < M_TOT) LN_LOAD(cur, r0);
    for (; r0 < M_TOT; r0 += c.ngw * NR) {
        const int rn = r0 + c.ngw * NR;
        if (rn < M_TOT) LN_LOAD(nxt, rn);
#pragma unroll
        for (int k = 0; k < NR; ++k) {
            const int r = r0 + k;
            f32x4 v[4];
#pragma unroll
            for (int q = 0; q < 2; ++q) { const u32x4 w = cur[k][q]; v[2 * q] = (f32x4){pg8::bflo(w.x), pg8::bfhi(w.x), pg8::bflo(w.y), pg8::bfhi(w.y)}; v[2 * q + 1] = (f32x4){pg8::bflo(w.z), pg8::bfhi(w.z), pg8::bflo(w.w), pg8::bfhi(w.w)}; }
            float s = 0.f;
#pragma unroll
            for (int j = 0; j < 4; ++j) s += (v[j][0] + v[j][1]) + (v[j][2] + v[j][3]);
            s = wave_sum(s);
            const float mu = s * (1.0f / 1024.0f);
            float q2 = 0.f;
#pragma unroll
            for (int j = 0; j < 4; ++j) { const f32x4 d = v[j] - mu; q2 += (d[0] * d[0] + d[1] * d[1]) + (d[2] * d[2] + d[3] * d[3]); }
            q2 = wave_sum(q2);
            const float rstd = rsqrtf(q2 * (1.0f / 1024.0f) + LN_EPS);
            if (r < M_TOT) {
#pragma unroll
                for (int q = 0; q < 2; ++q) {
                    const f32x4 y0 = (v[2 * q] - mu) * rstd * gv[2 * q] + bv[2 * q], y1 = (v[2 * q + 1] - mu) * rstd * gv[2 * q + 1] + bv[2 * q + 1];
                    const int cc = 512 * q + 8 * lane;
                    if (l == 0) { u32x4 o; o.x = cvtpk(y0[0], y0[1]); o.y = cvtpk(y0[2], y0[3]); o.z = cvtpk(y1[0], y1[1]); o.w = cvtpk(y1[2], y1[3]);
                                  *(u32x4*)((bf16_t*)(p->ws + WS_XB) + (size_t)r * D_MODEL + cc) = o; }
                    else { float* yo = (r < M_P ? p->out + O_YP + (size_t)r * D_MODEL : p->out + O_YS + (size_t)(r - M_P) * D_MODEL) + cc; *(f32x4*)yo = y0; *(f32x4*)(yo + 4) = y1; }
                }
            }
        }
#pragma unroll
        for (int k = 0; k < NR; ++k) { cur[k][0] = nxt[k][0]; cur[k][1] = nxt[k][1]; }
    }
#undef LN_LOAD
}

template <int NBR, int NS  , class Epi>
__device__ __forceinline__ void piece_gemm(LAS unsigned char* lds, const bf16_t* A0, const bf16_t* A1, const bf16_t* A2, int lda, const bf16_t* Bt, int ldb, int kboff, int row0, int col0, const Epi& epi, int wave_s) {
    int zv = 0; asm volatile("" : "+v"(zv));
    const int tid = tid_of(wave_s, zv), lane = tid & 63, wave = __builtin_amdgcn_readfirstlane(tid >> 6), c31 = lane & 31, h = lane >> 5;
    LAS float* part = (LAS float*)lds;
    float outv[NBR][4];
    constexpr int kw = 16 * NS;
    bf16x8 a[NBR][NS], b0[NBR][NS], b1[NBR][NS];
#pragma unroll
    for (int br = 0; br < NBR; ++br) {
        const bf16_t* A = br == 0 ? A0 : (br == 1 ? A1 : A2);
        const bf16_t* ap = A + (size_t)(row0 + c31) * lda + wave * kw + 8 * h;
        const bf16_t* bp = Bt + (size_t)(col0 + c31) * ldb + br * kboff + wave * kw + 8 * h;
#pragma unroll
        for (int s = 0; s < NS; ++s) { a[br][s] = *(const bf16x8*)(ap + 16 * s); b0[br][s] = *(const bf16x8*)(bp + 16 * s); b1[br][s] = *(const bf16x8*)(bp + (size_t)32 * ldb + 16 * s); }
    }
    typename Epi::Pre pre[4];
#pragma unroll
    for (int e = 0; e < 4; ++e) {
        const int idx = tid + 512 * e, nt = idx >> 10, r = (idx >> 6) & 15, ln = idx & 63;
        pre[e] = epi.load(row0 + (r & 3) + 8 * (r >> 2) + 4 * (ln >> 5), col0 + 32 * nt + (ln & 31));
    }
    __builtin_amdgcn_sched_barrier(0);
#pragma unroll
    for (int br = 0; br < NBR; ++br) {
        f32x16 acc0 = (f32x16){}, acc1 = (f32x16){};
#pragma unroll
        for (int s = 0; s < NS; ++s) { acc0 = MFMA32(a[br][s], b0[br][s], acc0); acc1 = MFMA32(a[br][s], b1[br][s], acc1); }
        MFMA_SETTLE2(acc0, acc1);
        __syncthreads();
#pragma unroll
        for (int r = 0; r < 16; ++r) { part[((wave * 2 + 0) * 16 + r) * 64 + lane] = acc0[r]; part[((wave * 2 + 1) * 16 + r) * 64 + lane] = acc1[r]; }
        __syncthreads();
#pragma unroll
        for (int e = 0; e < 4; ++e) {
            const int idx = tid + 512 * e;
            float s = 0.f;
#pragma unroll
            for (int w = 0; w < 8; ++w) s += part[w * 2048 + idx];
            outv[br][e] = s;
        }
    }
#pragma unroll
    for (int e = 0; e < 4; ++e) {
        const int idx = tid + 512 * e, nt = idx >> 10, r = (idx >> 6) & 15, ln = idx & 63;
        const int row = row0 + (r & 3) + 8 * (r >> 2) + 4 * (ln >> 5), col = col0 + 32 * nt + (ln & 31);
        float v[NBR];
#pragma unroll
        for (int br = 0; br < NBR; ++br) v[br] = outv[br][e];
        epi.store(row, col, pre[e], v);
    }
    __syncthreads();
}
struct PEpiGlu { bf16_t* PROJ; bool dry; struct Pre { bf16_t z, g; };
    __device__ __forceinline__ Pre load(int r, int c) const { const bf16_t* rp = PROJ + (size_t)r * IN_COLS; return Pre{rp[C_UB + c], rp[C_GB + c]}; }
    __device__ __forceinline__ void store(int r, int c, const Pre& q, const float (&v)[1]) const {
        if (!dry) PROJ[(size_t)r * IN_COLS + C_GB + c] = f2bf(bf2f(q.z) * sigmoidf_(v[0]) * siluf_(bf2f(q.g))); } };
struct PEpiBranch { bf16_t* PROJ; bool dry; struct Pre { bf16_t g0, g1, g2; };
    __device__ __forceinline__ Pre load(int r, int c) const { const bf16_t* gp = PROJ + (size_t)r * IN_COLS + C_GM + c; return Pre{gp[0], gp[1024], gp[2048]}; }
    __device__ __forceinline__ void store(int r, int c, const Pre& q, const float (&v)[3]) const {
        const float m = __builtin_amdgcn_rcpf(bf2f(q.g0)) * v[0] + __builtin_amdgcn_rcpf(bf2f(q.g1)) * v[1] + __builtin_amdgcn_rcpf(bf2f(q.g2)) * v[2];
        if (!dry) PROJ[(size_t)r * IN_COLS + C_GM + c] = f2bf(m); } };
struct PEpiOut { KP p; int l; struct Pre { float x; };
    __device__ __forceinline__ Pre load(int r, int c) const {
        return Pre{bf2f(((const bf16_t*)(p->ws + WS_XB))[(size_t)r * D_MODEL + c])}; }
    __device__ __forceinline__ void store(int r, int c, const Pre& q, const float (&v)[1]) const { pre_row(p->ws, r)[c] = f2bf(DN_ALPHA * q.x + v[0]); } };

#ifndef TSEL
#define TSEL 0
#endif
#define TS_BEGIN(K) do { if (TSEL == (K) && blockIdx.x == 0 && wave_s == 0 && lane_id() == 0) *(volatile LAS unsigned long long*)(lds + LDS_MISC + 128) = __builtin_amdgcn_s_memrealtime(); } while (0)
#define TS_END(K) do { if (TSEL == (K) && blockIdx.x == 0 && wave_s == 0 && lane_id() == 0) *(volatile LAS unsigned long long*)(lds + LDS_MISC + 136) += __builtin_amdgcn_s_memrealtime() - *(volatile LAS unsigned long long*)(lds + LDS_MISC + 128); } while (0)
__device__ __forceinline__ void st_small_tables(KP p, const Ctx& c) {
    st_s5_tables2(p, c);
    for (size_t i = c.gt; i < (size_t)DEPTH * 512; i += c.ngt) ((float*)(p->ws + WS_LSIG))[i] = -8.0f * log1pf(expf(-p->in[28][i]));
    bf16_t* LRUW = (bf16_t*)(p->ws + WS_LRUW);
    for (size_t i = c.gt; i < (size_t)DEPTH * 8 * 2 * 64 * 64; i += c.ngt) {
        const int d = (int)(i & 63), e = (int)((i >> 6) & 63), mat = (int)((i >> 12) & 1), ln = (int)(i >> 13);
        LRUW[i] = f2bf(p->in[mat ? 26 : 24][((size_t)ln * 64 + d) * 64 + e]); }
}
__global__ void __launch_bounds__(NTHREADS, 2) mega_fwd(P p_unused) {
    extern __shared__ __attribute__((aligned(16))) unsigned char lds_raw[];
    LAS unsigned char* lds = (LAS unsigned char*)lds_raw;
    volatile LAS unsigned* misc = (volatile LAS unsigned*)(lds + LDS_MISC);
    const int wave_s = __builtin_amdgcn_readfirstlane((int)threadIdx.x >> 6);
    if (wave_s == 0) misc[lane_id()] = 0u;
    __syncthreads();
    XcdBarrier bar;
    { KP p = get_kp(); bar = xcd_barrier_post((unsigned*)(p->ws + WS_CTL), misc, wave_s); }
    TS_BEGIN(100);

    { KP p = get_kp(); const Ctx c = make_ctx(wave_s); unsigned char* dob = (unsigned char*)p->out;
      st_convert_x(p, c);
      st_prologue_weights(p, c, (LAS float*)(lds + c.wave * 9216), 0, 16 * 200);
      }
    xcd_barrier(bar);
    TS_END(100);

#ifndef PROBE
#define PROBE 0
#endif
#define PROBE_RUN(K, BODY) do { if (PROBE == (K)) { int d_ = 1; asm volatile("" : "+s"(d_)); const bool dry = d_ != 0; BODY; __syncthreads(); } { const bool dry = false; BODY; } } while (0)
#define PH_P1 { KP p = get_kp(); int zs = 0; asm volatile("" : "+s"(zs)); (void)dry; \
          pg8::Gemm g{(const bf16_t*)(p->ws + WS_XB), D_MODEL, (const bf16_t*)((unsigned char*)p->out + DO_WIN) + (size_t)l * IN_COLS * 1024, 1024}; \
          pg8::StaticOrder S; S.init(M_TOT, IN_COLS, (int)gridDim.x + zs, (int)blockIdx.x + zs); \
          pg8::gemm_phase<pg8::EpiProjB, pg8::StaticOrder, true, true>(lds, g, S, pg8::EpiProjB{(bf16_t*)(p->ws + WS_PROJ), IN_COLS}, wave_s); \
          if (l == 0) {   \
              const int nb_ = (int)gridDim.x + zs, bid_ = (int)blockIdx.x + zs, short_ = ((M_TOT / 256) * (IN_COLS / 256)) % nb_; \
              if (short_ == 0 || bid_ >= short_) { const Ctx c = make_ctx(wave_s); Ctx gq = c; const int sz_ = short_ == 0 ? nb_ : nb_ - short_, rk_ = short_ == 0 ? bid_ : bid_ - short_; \
                  gq.gw = c.wave * sz_ + rk_; gq.ngw = NWAVES * sz_; gq.gt = (size_t)rk_ * NTHREADS + c.tid; gq.ngt = (size_t)sz_ * NTHREADS; st_small_tables(p, gq); st_prologue_weights(p, gq, (LAS float*)(lds + c.wave * 9216), 16 * 200, -1); } } }
#define PH_SAMPLE { KP p = get_kp(); const Ctx c = make_ctx(wave_s); if (wave_s == 5) { const Ctx g = waveset_ctx(c, 0, 1); st_s5_sample(p, l, g, lds, dry); st_lru_sample(p, l, g, lds, dry); } }
#define PH_SUMM { KP p = get_kp(); const Ctx c = make_ctx(wave_s); (void)dry; \
          if (wave_s < 2 || wave_s == 4) st_s5_phaseA(p, l, waveset_ctx(c, wave_s == 4 ? 2 : wave_s, 3)); \
          if (wave_s == 2 || wave_s == 3 || wave_s >= 6) st_lru_mfma<false>(p, l, waveset_ctx(c, wave_s >= 6 ? wave_s - 4 : wave_s - 2, 4), lds, false); }
#define PH_ATTN { __syncthreads(); KP p = get_kp(); st_attn_prompt(p, l, lds, dry, wave_s); st_attn_sample(p, l, lds, dry, wave_s); }
#define PH_P3 { KP p = get_kp(); const Ctx c = make_ctx(wave_s); unsigned* ctl_ = (unsigned*)(p->ws + WS_CTL); \
          volatile LAS unsigned* ms_ = (volatile LAS unsigned*)(lds + LDS_MISC + 160); \
          if (wave_s == 0 && c.lane == 0) { const unsigned x_ = xb_xcc_id(); unsigned ne_ = 0, no_ = 0; \
              for (unsigned j = 0; j < 16; ++j) { const unsigned cj = xb_ld(&ctl_[XB_XCNT(j)]); if (j & 1) no_ += cj; else ne_ += cj; } \
              const unsigned role_ = x_ & 1u, both_ = (ne_ == 0u || no_ == 0u) ? 1u : 0u; \
              const unsigned rank_ = both_ ? (unsigned)(c.gw - c.wave * (c.ngw / NWAVES)) : xb_add(&ctl_[4096 + 64 * (2 * l + (int)role_)], 1u); \
              ms_[0] = both_ ? 2u : role_; ms_[1] = rank_; ms_[2] = both_ ? (unsigned)(c.ngw / NWAVES) : (role_ ? no_ : ne_); } \
          __syncthreads(); \
          const unsigned role_ = ms_[0]; Ctx g = c; g.gw = c.wave * (int)ms_[2] + (int)ms_[1]; g.ngw = NWAVES * (int)ms_[2]; \
          if (role_ == 0u || role_ == 2u) st_s5_phaseB(p, l, g, lds, dry); \
          if (role_ == 1u || role_ == 2u) st_lru_mfma<true>(p, l, g, lds, dry); }
#define PH_GLU { KP p = get_kp(); int zs = 0; asm volatile("" : "+s"(zs)); bf16_t* PROJ = (bf16_t*)(p->ws + WS_PROJ); \
          pg8::Gemm g{PROJ + C_UB, IN_COLS, (const bf16_t*)((unsigned char*)p->out + DO_WGLU) + (size_t)l * 512 * 512, 512}; \
          pg8::StaticOrder S; S.init(M_P, 512, (int)gridDim.x + zs, (int)blockIdx.x + zs); \
          pg8::gemm_phase<pg8::EpiGluB, pg8::StaticOrder, true, true>(lds, g, S, pg8::EpiGluB{PROJ, dry}, wave_s); \
          const int nb_ = (int)gridDim.x + zs, bid_ = (int)blockIdx.x + zs; \
          if (bid_ >= nb_ / 2) { const Ctx c = make_ctx(wave_s); Ctx g = c; g.gt = (size_t)(bid_ - nb_ / 2) * NTHREADS + c.tid; g.ngt = (size_t)(nb_ - nb_ / 2) * NTHREADS; st_kv_out(p, l, g); }   \
          for (int pc = nb_ - 1 - bid_; pc < 16 * 8; pc += nb_)   \
              piece_gemm<1, 4>(lds, PROJ + C_UB, nullptr, nullptr, IN_COLS, g.Bt, 512, 0, M_P + 32 * (pc >> 3), 64 * (pc & 7), PEpiGlu{PROJ, dry}, wave_s); }
#define PH_BRANCH { KP p = get_kp(); int zs = 0; asm volatile("" : "+s"(zs)); bf16_t* PROJ = (bf16_t*)(p->ws + WS_PROJ); \
          pg8::Gemm g{PROJ + C_Q, IN_COLS, (const bf16_t*)((unsigned char*)p->out + DO_WBR) + (size_t)l * 1024 * 1536, 1536}; \
          pg8::StaticOrder S; S.init(M_P, 1024, (int)gridDim.x + zs, (int)blockIdx.x + zs); \
          pg8::gemm_phase<pg8::EpiMergeB, pg8::StaticOrder, true, true>(lds, g, S, pg8::EpiMergeB{PROJ, dry}, wave_s); \
          const int nb_ = (int)gridDim.x + zs, bid_ = (int)blockIdx.x + zs; \
          for (int pc = bid_; pc < 16 * 16; pc += nb_) \
              piece_gemm<3, 4>(lds, PROJ + C_Q, PROJ + C_GB, PROJ + C_GC, IN_COLS, g.Bt, 1536, 512, M_P + 32 * (pc >> 4), 64 * (pc & 15), PEpiBranch{PROJ, dry}, wave_s); }
#define PH_OUT { KP p = get_kp(); int zs = 0; asm volatile("" : "+s"(zs)); bf16_t* PROJ = (bf16_t*)(p->ws + WS_PROJ); (void)dry; \
          pg8::Gemm g{PROJ + C_GM, IN_COLS, (const bf16_t*)(p->ws + WS_WOUT) + (size_t)l * 1024 * 1024, 1024}; \
          pg8::StaticOrder S; S.init(M_P, 1024, (int)gridDim.x + zs, (int)blockIdx.x + zs); \
          pg8::gemm_phase<pg8::EpiOutB, pg8::StaticOrder, true, true>(lds, g, S, pg8::EpiOutB{(const bf16_t*)(p->ws + WS_XB), p->ws}, wave_s); \
          const int nb_ = (int)gridDim.x + zs, bid_ = (int)blockIdx.x + zs; \
          for (int pc = bid_; pc < 16 * 16; pc += nb_) \
              piece_gemm<1, 8>(lds, PROJ + C_GM, nullptr, nullptr, IN_COLS, g.Bt, 1024, 0, M_P + 32 * (pc >> 4), 64 * (pc & 15), PEpiOut{p, l}, wave_s); }
#define PH_LN { KP p = get_kp(); const Ctx c = make_ctx(wave_s); (void)dry; st_ln(p, l, c); }
    for (int l = 0; l < DEPTH; ++l) {
        TS_BEGIN(1); PROBE_RUN(1, PH_P1);
        xcd_barrier(bar); TS_END(1);
#if TSEL >= 20
        TS_BEGIN(21); PROBE_RUN(2, PH_SAMPLE); xcd_barrier(bar); TS_END(21);
        TS_BEGIN(22); PROBE_RUN(3, PH_SUMM); xcd_barrier(bar); TS_END(22);
        TS_BEGIN(23); PROBE_RUN(4, PH_ATTN); xcd_barrier(bar); TS_END(23);
        { const bool dry = false; PH_P3; } xcd_barrier(bar);
#else
        TS_BEGIN(2); PROBE_RUN(2, PH_SAMPLE);
        PROBE_RUN(3, PH_SUMM);
        PROBE_RUN(4, PH_ATTN);
        xcd_barrier(bar); TS_END(2);
        TS_BEGIN(3); { const bool dry = false; PH_P3; }
        xcd_barrier(bar); TS_END(3);
#endif
        TS_BEGIN(4); PROBE_RUN(7, PH_GLU);
        xcd_barrier(bar); TS_END(4);
        TS_BEGIN(5); PROBE_RUN(8, PH_BRANCH);
        xcd_barrier(bar); TS_END(5);
        TS_BEGIN(6); PROBE_RUN(9, PH_OUT);
        xcd_barrier(bar); TS_END(6);
        TS_BEGIN(7); PROBE_RUN(10, PH_LN);
        if (l + 1 < DEPTH) xcd_barrier(bar);
        TS_END(7);
    }
    if (TSEL != 0 && blockIdx.x == 0 && wave_s == 0 && lane_id() == 0) { const unsigned long long te = __builtin_amdgcn_s_memrealtime(), ts_acc = *(volatile LAS unsigned long long*)(lds + LDS_MISC + 136); while (__builtin_amdgcn_s_memrealtime() - te < ts_acc) __builtin_amdgcn_s_sleep(4); }
}

extern "C" void kernel_launch(void* const* d_in, const int* in_sizes, int n_in, void* d_out, int out_size, void* d_ws, size_t ws_size, hipStream_t stream) {
    static int grid = 0;
    if (grid == 0) {
        if (n_in != 33 || (size_t)out_size != O_END || ws_size < WS_CTL + CTL_BYTES) { fprintf(stderr, "kernel_launch: unexpected sizes n_in %d out %d ws %zu\n", n_in, out_size, ws_size); grid = -1; return; }
        int dev = 0, cus = 0, per_cu = 0;
        if (hipGetDevice(&dev) != hipSuccess || hipDeviceGetAttribute(&cus, hipDeviceAttributeMultiprocessorCount, dev) != hipSuccess) { grid = -1; return; }
        if (hipFuncSetAttribute((const void*)mega_fwd, hipFuncAttributeMaxDynamicSharedMemorySize, LDS_BYTES) != hipSuccess) { fprintf(stderr, "kernel_launch: hipFuncSetAttribute failed\n"); grid = -1; return; }
        if (hipOccupancyMaxActiveBlocksPerMultiprocessor(&per_cu, (const void*)mega_fwd, NTHREADS, LDS_BYTES) != hipSuccess || per_cu < 1) { fprintf(stderr, "kernel_launch: occupancy query says %d blocks/CU\n", per_cu); grid = -1; return; }
        grid = cus;
    }
    if (grid < 0) return;
    (void)hipMemsetAsync((unsigned char*)d_ws + WS_CTL, 0, CTL_BYTES, stream);
    P p{};
    for (int i = 0; i < 33; ++i) p.in[i] = (const float*)d_in[i];
    p.out = (float*)d_out; p.ws = (unsigned char*)d_ws;
    void* args[] = {&p};
    hipError_t e = hipLaunchCooperativeKernel((const void*)mega_fwd, dim3(grid), dim3(NTHREADS), args, LDS_BYTES, stream);
    if (e != hipSuccess) fprintf(stderr, "kernel_launch: cooperative launch failed: %s (grid %d)\n", hipGetErrorString(e), grid);
}
```
